# Optimizing an MI355X kernel written in HIP

```python
import jax, jax.numpy as jnp
from jax import lax
import numpy as np

D_MODEL = 1024
BATCH = 8
SEQ = 2048
DEPTH = 2

N_HEADS_A = 8
HEAD_DIM_A = 64
ROPE_DIM = HEAD_DIM_A // 4
NOPE_DIM = HEAD_DIM_A - ROPE_DIM
KV_LATENT = 128
N_IDX_HEADS = 8
IDX_DIM = 64
TOPK_MAX = 256
Q_BLOCK = 128
ROPE_THETA = 500000.0
WIDTH_A = N_HEADS_A * HEAD_DIM_A
N_GROUPS_B = 8
GROUP_DIM_B = 64
WIDTH_B = N_GROUPS_B * GROUP_DIM_B
CHUNK = 128
D_FF = -(-8 * D_MODEL // (3 * 256)) * 256
EPS = 1e-6

IN_SIZES = [WIDTH_A,
            KV_LATENT,
            ROPE_DIM,
            N_IDX_HEADS * IDX_DIM,
            IDX_DIM,
            N_IDX_HEADS,
            2 * WIDTH_B,
            2 * D_MODEL]
D_IN = sum(IN_SIZES)
SPLITS = tuple(int(v) for v in np.cumsum(IN_SIZES)[:-1])

kernel_name = "hybrid_dsa_gmlp_gated_block"


def rms_norm(x, g):
    xf = x.astype(jnp.float32)
    y = xf * lax.rsqrt(jnp.mean(xf * xf, axis=-1, keepdims=True) + EPS)
    return (y * g.astype(jnp.float32)).astype(x.dtype)


def layer_norm(x, g, b):
    xf = x.astype(jnp.float32)
    mu = jnp.mean(xf, axis=-1, keepdims=True)
    var = jnp.mean(jnp.square(xf - mu), axis=-1, keepdims=True)
    y = (xf - mu) * lax.rsqrt(var + 1e-5)
    return (y * g.astype(jnp.float32) + b.astype(jnp.float32)).astype(x.dtype)


def rope_tables(positions):
    inv = ROPE_THETA ** (-jnp.arange(0, ROPE_DIM, 2, dtype=jnp.float32) / ROPE_DIM)
    ang = positions.astype(jnp.float32)[..., None] * inv
    return jnp.cos(ang), jnp.sin(ang)


def partial_rope(x, cos, sin):
    extra = x.ndim - cos.ndim
    shape = cos.shape[:2] + (1,) * extra + cos.shape[2:]
    c, s = cos.reshape(shape), sin.reshape(shape)
    xr = x[..., :ROPE_DIM].astype(jnp.float32)
    x1, x2 = xr[..., :ROPE_DIM // 2], xr[..., ROPE_DIM // 2:]
    rot = jnp.concatenate([x1 * c - x2 * s, x2 * c + x1 * s], axis=-1).astype(x.dtype)
    return jnp.concatenate([rot, x[..., ROPE_DIM:]], axis=-1)


def dsa_mixer(q, c_kv, k_rope, q_idx, k_idx, w_idx, w_uk, w_uv, cos, sin):
    B, S = q.shape[:2]
    top_k = min(TOPK_MAX, S // 4)
    nb = S // Q_BLOCK
    q = partial_rope(q.reshape(B, S, N_HEADS_A, HEAD_DIM_A), cos, sin)
    q_rope, q_nope = q[..., :ROPE_DIM], q[..., ROPE_DIM:]
    q_lat = jnp.einsum('bshn,hnc->bshc', q_nope, w_uk)
    k_rope = partial_rope(k_rope, cos, sin)
    q_idx = partial_rope(q_idx.reshape(B, S, N_IDX_HEADS, IDX_DIM), cos, sin)
    k_idx = partial_rope(k_idx, cos, sin)
    w_idx = w_idx * (N_IDX_HEADS ** -0.5)
    key_pos = jnp.arange(S)
    gather = jax.vmap(lambda a, i: a[i])

    def to_blocks(a):
        return jnp.moveaxis(a.reshape((B, nb, Q_BLOCK) + a.shape[2:]), 1, 0)

    def block(args):
        ql, qr, qi, wi, qpos = args
        isc = jnp.einsum('bthd,bsd->bths', qi, k_idx,
                         preferred_element_type=jnp.float32) * (IDX_DIM ** -0.5)
        isc = jnp.einsum('bths,bth->bts', jax.nn.relu(isc), wi.astype(jnp.float32))
        causal = key_pos[None, :] <= qpos[:, None]
        isc = jnp.where(causal[None], isc, -jnp.inf)
        _, sel = lax.top_k(isc, top_k)
        valid = sel <= qpos[None, :, None]
        c_sel = gather(c_kv, sel)
        kr_sel = gather(k_rope, sel)
        sc = (jnp.einsum('bthc,btkc->bthk', ql, c_sel, preferred_element_type=jnp.float32)
              + jnp.einsum('bthr,btkr->bthk', qr, kr_sel, preferred_element_type=jnp.float32)
              ) * (HEAD_DIM_A ** -0.5)
        sc = jnp.where(valid[:, :, None, :], sc, -jnp.inf)
        p = jax.nn.softmax(sc, axis=-1).astype(c_sel.dtype)
        o_lat = jnp.einsum('bthk,btkc->bthc', p, c_sel)
        return jnp.einsum('bthc,hcd->bthd', o_lat, w_uv)

    out = lax.map(block, (to_blocks(q_lat), to_blocks(q_rope), to_blocks(q_idx),
                          to_blocks(w_idx), key_pos.reshape(nb, Q_BLOCK)))
    return jnp.moveaxis(out, 0, 1).reshape(B, S, WIDTH_A)


def chunked_gmlp(uv, ln_g, ln_b, w_s, b_s):
    B, S = uv.shape[:2]
    uv = jax.nn.gelu(uv)
    u, v = jnp.split(uv, 2, axis=-1)
    v = layer_norm(v, ln_g, ln_b)
    nc = S // CHUNK
    v = v.reshape(B, nc, CHUNK, N_GROUPS_B, GROUP_DIM_B)
    mask = jnp.tril(jnp.ones((CHUNK, CHUNK), dtype=bool))
    ws = jnp.where(mask[None], w_s, 0.0)
    s = jnp.einsum('gts,bcsgd->bctgd', ws, v) + b_s.T[None, None, :, :, None]
    return u * s.reshape(B, S, WIDTH_B)


def setup_inputs(seed: int = 0) -> dict:
    key = jax.random.key(seed)
    ks = jax.random.split(key, 20)
    f32 = jnp.float32

    def nrm(k, shape, fan_in):
        return jax.random.normal(k, shape, f32) * (fan_in ** -0.5)

    def gain(k, shape):
        return 1.0 + 0.02 * jax.random.normal(k, shape, f32)

    L = DEPTH
    return {
        "x": jax.random.normal(ks[0], (BATCH, SEQ, D_MODEL), f32),
        "positions": jnp.broadcast_to(jnp.arange(SEQ, dtype=jnp.int32), (BATCH, SEQ)),
        "norm_mix": gain(ks[1], (L, D_MODEL)),
        "w_in": nrm(ks[2], (L, D_MODEL, D_IN), D_MODEL),
        "kv_norm": gain(ks[3], (L, KV_LATENT)),
        "w_uk": nrm(ks[4], (L, N_HEADS_A, NOPE_DIM, KV_LATENT), NOPE_DIM),
        "w_uv": nrm(ks[5], (L, N_HEADS_A, KV_LATENT, HEAD_DIM_A), KV_LATENT),
        "ln_v_g": gain(ks[6], (L, WIDTH_B)),
        "ln_v_b": 0.02 * jax.random.normal(ks[7], (L, WIDTH_B), f32),
        "w_s": nrm(ks[8], (L, N_GROUPS_B, CHUNK, CHUNK), CHUNK),
        "b_s": 1.0 + 0.01 * jax.random.normal(ks[9], (L, N_GROUPS_B, CHUNK), f32),
        "w_proj_a": nrm(ks[10], (L, WIDTH_A, D_MODEL), WIDTH_A),
        "w_proj_b": nrm(ks[11], (L, WIDTH_B, D_MODEL), WIDTH_B),
        "w_out": nrm(ks[12], (L, D_MODEL, D_MODEL), D_MODEL),
        "norm_ffn": gain(ks[13], (L, D_MODEL)),
        "w_gate": nrm(ks[14], (L, D_MODEL, D_FF), D_MODEL),
        "w_up": nrm(ks[15], (L, D_MODEL, D_FF), D_MODEL),
        "w_down": nrm(ks[16], (L, D_FF, D_MODEL), D_FF),
        "final_norm": gain(ks[17], (D_MODEL,)),
    }


def reference(x, positions, norm_mix, w_in, kv_norm, w_uk, w_uv, ln_v_g, ln_v_b, w_s, b_s,
              w_proj_a, w_proj_b, w_out, norm_ffn, w_gate, w_up, w_down, final_norm):
    cos, sin = rope_tables(positions)
    for l in range(DEPTH):
        h = rms_norm(x, norm_mix[l])
        z = h @ w_in[l]
        q, c_kv, k_rope, q_idx, k_idx, w_idx, uv, gates = jnp.split(z, SPLITS, axis=-1)
        c_kv = rms_norm(c_kv, kv_norm[l])
        y_a = dsa_mixer(q, c_kv, k_rope, q_idx, k_idx, w_idx, w_uk[l], w_uv[l], cos, sin)
        y_b = chunked_gmlp(uv, ln_v_g[l], ln_v_b[l], w_s[l], b_s[l])
        g_a, g_b = jnp.split(jax.nn.sigmoid(gates), 2, axis=-1)
        merged = g_a * (y_a @ w_proj_a[l]) + g_b * (y_b @ w_proj_b[l])
        x = x + merged @ w_out[l]
        h = rms_norm(x, norm_ffn[l])
        x = x + (jax.nn.silu(h @ w_gate[l]) * (h @ w_up[l])) @ w_down[l]
    return rms_norm(x, final_norm)
```

```cpp
#include <hip/hip_runtime.h>
#include <math.h>

namespace nv {
constexpr int DM = 1024, S = 2048, NB = 8, DIN = 4312, DFF = 2816;
constexpr int OQ = 0, OCKV = 512, OKR = 640, OQI = 656, OKI = 1168, OWI = 1232, OUV = 1240, OG = 2264;
__constant__ float c_inv[8] = {1.0f, 0.19392274474868576f, 0.03760603093086393f, 0.007292664737217109f, 0.001414213562373095f, 0.0002742481756762073f, 5.318295896944988e-05f, 1.031338537721246e-05f};

__device__ __forceinline__ float block_sum_256(float v, float* red) {
    for (int o = 32; o > 0; o >>= 1) v += __shfl_xor(v, o);
    __syncthreads();
    if ((threadIdx.x & 63) == 0) red[threadIdx.x >> 6] = v;
    __syncthreads();
    return red[0] + red[1] + red[2] + red[3];
}

__global__ void __launch_bounds__(256) k_rmsnorm(const float* x, const float* g, float* y) {
    __shared__ float red[4];
    const size_t row = blockIdx.x;
    float v[4]; float s = 0.f;
#pragma unroll
    for (int i = 0; i < 4; ++i) { v[i] = x[row * DM + threadIdx.x + 256 * i]; s += v[i] * v[i]; }
    const float tot = block_sum_256(s, red);
    const float r = rsqrtf(tot * (1.0f / DM) + 1e-6f);
#pragma unroll
    for (int i = 0; i < 4; ++i) y[row * DM + threadIdx.x + 256 * i] = v[i] * r * g[threadIdx.x + 256 * i];
}

__global__ void __launch_bounds__(256) k_gemm(const float* A, int lda, const float* B, int ldb, float* C, int ldc, int N, int K, const float* R, int ldr) {
    __shared__ float As[8][128 + 4], Bs[8][128 + 4];
    const int tid = threadIdx.x, tx = tid & 15, ty = tid >> 4;
    const int m0 = blockIdx.y * 128, n0 = blockIdx.x * 128;
    float acc[8][8];
#pragma unroll
    for (int i = 0; i < 8; ++i)
#pragma unroll
        for (int j = 0; j < 8; ++j) acc[i][j] = 0.f;
    for (int k0 = 0; k0 < K; k0 += 8) {
#pragma unroll
        for (int i = 0; i < 4; ++i) { const int idx = tid + 256 * i, r = idx >> 3, c = idx & 7; As[c][r] = A[(size_t)(m0 + r) * lda + k0 + c]; }
#pragma unroll
        for (int i = 0; i < 4; ++i) { const int idx = tid + 256 * i, r = idx >> 7, c = idx & 127; Bs[r][c] = (n0 + c < N) ? B[(size_t)(k0 + r) * ldb + n0 + c] : 0.f; }
        __syncthreads();
#pragma unroll
        for (int kk = 0; kk < 8; ++kk) {
            float a[8], b[8];
#pragma unroll
            for (int i = 0; i < 8; ++i) a[i] = As[kk][ty * 8 + i];
#pragma unroll
            for (int j = 0; j < 8; ++j) b[j] = Bs[kk][tx * 8 + j];
#pragma unroll
            for (int i = 0; i < 8; ++i)
#pragma unroll
                for (int j = 0; j < 8; ++j) acc[i][j] = fmaf(a[i], b[j], acc[i][j]);
        }
        __syncthreads();
    }
#pragma unroll
    for (int i = 0; i < 8; ++i) {
        const int m = m0 + ty * 8 + i;
#pragma unroll
        for (int j = 0; j < 8; ++j) { const int n = n0 + tx * 8 + j; if (n < N) C[(size_t)m * ldc + n] = (R ? R[(size_t)m * ldr + n] : 0.f) + acc[i][j]; }
    }
}

__global__ void __launch_bounds__(256) k_postz(const float* z, const int* pos, const float* kv_norm, const float* w_uk,
                                               float* QR, float* QLAT, float* CKV, float* KR, float* QI, float* KI, float* WI) {
    __shared__ float cs[8], sn[8], red[4], zq[512];
    const int t = blockIdx.x, tid = threadIdx.x;
    const float* zr = z + (size_t)t * DIN;
    if (tid < 8) { const float ang = (float)pos[t] * c_inv[tid]; cs[tid] = cosf(ang); sn[tid] = sinf(ang); }
    zq[tid] = zr[OQ + tid]; zq[tid + 256] = zr[OQ + tid + 256];
    __syncthreads();
    for (int i = tid; i < 512; i += 256) { const int d = i & 63; float v = zq[i];
        if (d < 8) v = zq[i] * cs[d] - zq[i + 8] * sn[d]; else if (d < 16) v = zq[i] * cs[d - 8] + zq[i - 8] * sn[d - 8];
        QR[(size_t)t * 512 + i] = v; }
    for (int i = tid; i < 1024; i += 256) { const int h = i >> 7, c = i & 127; float a = 0.f;
        for (int n = 0; n < 48; ++n) a = fmaf(zq[h * 64 + 16 + n], w_uk[((size_t)h * 48 + n) * 128 + c], a);
        QLAT[(size_t)t * 1024 + i] = a; }
    { float v = (tid < 128) ? zr[OCKV + tid] : 0.f; const float tot = block_sum_256(v * v, red);
      if (tid < 128) CKV[(size_t)t * 128 + tid] = v * rsqrtf(tot * (1.0f / 128.f) + 1e-6f) * kv_norm[tid]; }
    if (tid < 16) { const float a = zr[OKR + tid]; float v;
        if (tid < 8) v = a * cs[tid] - zr[OKR + tid + 8] * sn[tid]; else v = a * cs[tid - 8] + zr[OKR + tid - 8] * sn[tid - 8];
        KR[(size_t)t * 16 + tid] = v; }
    for (int i = tid; i < 512; i += 256) { const int d = i & 63; float v = zr[OQI + i];
        if (d < 8) v = zr[OQI + i] * cs[d] - zr[OQI + i + 8] * sn[d]; else if (d < 16) v = zr[OQI + i] * cs[d - 8] + zr[OQI + i - 8] * sn[d - 8];
        QI[(size_t)t * 512 + i] = v; }
    if (tid < 64) { const int d = tid; float v = zr[OKI + d];
        if (d < 8) v = zr[OKI + d] * cs[d] - zr[OKI + d + 8] * sn[d]; else if (d < 16) v = zr[OKI + d] * cs[d - 8] + zr[OKI + d - 8] * sn[d - 8];
        KI[(size_t)t * 64 + d] = v; }
    if (tid < 8) WI[(size_t)t * 8 + tid] = zr[OWI + tid] * 0.35355339059327373f;
}

__global__ void __launch_bounds__(256) k_select(const float* QI, const float* KI, const float* WI, unsigned char* SEL) {
    __shared__ float q[512], w[8], sc[S];
    const int t = blockIdx.x, tid = threadIdx.x;
    q[tid] = QI[(size_t)t * 512 + tid]; q[tid + 256] = QI[(size_t)t * 512 + tid + 256];
    if (tid < 8) w[tid] = WI[(size_t)t * 8 + tid];
    __syncthreads();
    for (int s = tid; s < S; s += 256) {
        float v = -INFINITY;
        if (s <= t) { const float* k = KI + (size_t)s * 64; v = 0.f;
            for (int h = 0; h < 8; ++h) { float d = 0.f; for (int i = 0; i < 64; ++i) d = fmaf(q[h * 64 + i], k[i], d); d *= 0.125f; v += fmaxf(d, 0.f) * w[h]; } }
        sc[s] = v;
    }
    __syncthreads();
    for (int s = tid; s < S; s += 256) {
        unsigned char sel = 0;
        if (s <= t) {
            if (t + 1 <= 256) sel = 1;
            else { const float v = sc[s]; int rank = 0;
                for (int s2 = 0; s2 <= t; ++s2) { const float u = sc[s2]; rank += (u > v || (u == v && s2 < s)) ? 1 : 0; }
                sel = rank < 256 ? 1 : 0; }
        }
        SEL[(size_t)t * S + s] = sel;
    }
}

__global__ void __launch_bounds__(64) k_attn(const float* QLAT, const float* QR, const float* CKV, const float* KR, const unsigned char* SEL, const float* w_uv, float* YA) {
    __shared__ float sc[S], ql[128], qr[16], ol[128];
    const int h = blockIdx.x, t = blockIdx.y, lane = threadIdx.x;
    ql[lane] = QLAT[(size_t)t * 1024 + h * 128 + lane]; ql[lane + 64] = QLAT[(size_t)t * 1024 + h * 128 + lane + 64];
    if (lane < 16) qr[lane] = QR[(size_t)t * 512 + h * 64 + lane];
    __syncthreads();
    float m = -INFINITY;
    for (int s = lane; s <= t; s += 64) {
        float v = -INFINITY;
        if (SEL[(size_t)t * S + s]) { const float* c = CKV + (size_t)s * 128; const float* kr = KR + (size_t)s * 16; float d = 0.f;
            for (int i = 0; i < 128; ++i) d = fmaf(ql[i], c[i], d);
            for (int i = 0; i < 16; ++i) d = fmaf(qr[i], kr[i], d);
            v = d * 0.125f; }
        sc[s] = v; m = fmaxf(m, v);
    }
    for (int o = 32; o > 0; o >>= 1) m = fmaxf(m, __shfl_xor(m, o));
    float l = 0.f;
    for (int s = lane; s <= t; s += 64) { const float p = (sc[s] == -INFINITY) ? 0.f : expf(sc[s] - m); sc[s] = p; l += p; }
    for (int o = 32; o > 0; o >>= 1) l += __shfl_xor(l, o);
    __syncthreads();
    float o0 = 0.f, o1 = 0.f;
    for (int s = 0; s <= t; ++s) { const float p = sc[s]; if (p != 0.f) { o0 = fmaf(p, CKV[(size_t)s * 128 + lane], o0); o1 = fmaf(p, CKV[(size_t)s * 128 + lane + 64], o1); } }
    ol[lane] = o0 / l; ol[lane + 64] = o1 / l;
    __syncthreads();
    float y = 0.f;
    for (int c = 0; c < 128; ++c) y = fmaf(ol[c], w_uv[((size_t)h * 128 + c) * 64 + lane], y);
    YA[(size_t)t * 512 + h * 64 + lane] = y;
}

__device__ __forceinline__ float gelu_tanh(float x) { return 0.5f * x * (1.0f + tanhf(0.7978845608028654f * (x + 0.044715f * x * x * x))); }

__global__ void __launch_bounds__(256) k_gelu_ln(const float* z, const float* ln_g, const float* ln_b, float* U, float* VN) {
    __shared__ float red[4];
    const int t = blockIdx.x, tid = threadIdx.x;
    const float* zr = z + (size_t)t * DIN + OUV;
    U[(size_t)t * 512 + tid] = gelu_tanh(zr[tid]); U[(size_t)t * 512 + tid + 256] = gelu_tanh(zr[tid + 256]);
    const float v0 = gelu_tanh(zr[512 + tid]), v1 = gelu_tanh(zr[512 + tid + 256]);
    const float mu = block_sum_256(v0 + v1, red) * (1.0f / 512.f);
    const float d0 = v0 - mu, d1 = v1 - mu;
    const float var = block_sum_256(d0 * d0 + d1 * d1, red) * (1.0f / 512.f);
    const float r = rsqrtf(var + 1e-5f);
    VN[(size_t)t * 512 + tid] = d0 * r * ln_g[tid] + ln_b[tid];
    VN[(size_t)t * 512 + tid + 256] = d1 * r * ln_g[tid + 256] + ln_b[tid + 256];
}

__global__ void __launch_bounds__(256) k_gmlp(const float* U, const float* VN, const float* w_s, const float* b_s, float* YB) {
    const int g = blockIdx.x, ch = blockIdx.y, tid = threadIdx.x;
    const int d = tid & 63;
    for (int tt = tid >> 6; tt < 128; tt += 4) {
        float a = 0.f;
        for (int s = 0; s <= tt; ++s) a = fmaf(w_s[((size_t)g * 128 + tt) * 128 + s], VN[(size_t)(ch * 128 + s) * 512 + g * 64 + d], a);
        a += b_s[g * 128 + tt];
        const size_t o = (size_t)(ch * 128 + tt) * 512 + g * 64 + d;
        YB[o] = U[o] * a;
    }
}

__device__ __forceinline__ float sigm(float x) { return 1.0f / (1.0f + expf(-x)); }
__global__ void __launch_bounds__(256) k_merge(const float* z, const float* PA, const float* PB, float* MG) {
    const int t = blockIdx.x;
    for (int n = threadIdx.x; n < 1024; n += 256) {
        const float ga = sigm(z[(size_t)t * DIN + OG + n]), gb = sigm(z[(size_t)t * DIN + OG + 1024 + n]);
        MG[(size_t)t * 1024 + n] = ga * PA[(size_t)t * 1024 + n] + gb * PB[(size_t)t * 1024 + n];
    }
}
__global__ void __launch_bounds__(256) k_swiglu(const float* G, const float* Uu, float* ACT, int n) {
    const size_t i = (size_t)blockIdx.x * 256 + threadIdx.x;
    if (i < (size_t)n) { const float g = G[i]; ACT[i] = g * sigm(g) * Uu[i]; }
}
}

extern "C" void kernel_launch(void* const* d_in, const int* in_sizes, int n_in, void* d_out, int out_size, void* d_ws, size_t ws_size, hipStream_t stream) {
    using namespace nv;
    const float* x = (const float*)d_in[0]; const int* positions = (const int*)d_in[1];
    const float* norm_mix = (const float*)d_in[2]; const float* w_in = (const float*)d_in[3]; const float* kv_norm = (const float*)d_in[4];
    const float* w_uk = (const float*)d_in[5]; const float* w_uv = (const float*)d_in[6]; const float* ln_v_g = (const float*)d_in[7]; const float* ln_v_b = (const float*)d_in[8];
    const float* w_s = (const float*)d_in[9]; const float* b_s = (const float*)d_in[10]; const float* w_proj_a = (const float*)d_in[11]; const float* w_proj_b = (const float*)d_in[12];
    const float* w_out = (const float*)d_in[13]; const float* norm_ffn = (const float*)d_in[14]; const float* w_gate = (const float*)d_in[15]; const float* w_up = (const float*)d_in[16];
    const float* w_down = (const float*)d_in[17]; const float* final_norm = (const float*)d_in[18];
    float* out = (float*)d_out;
    float* ws = (float*)d_ws; size_t o = 0;
    auto take = [&](size_t n) { float* p = ws + o; o += (n + 63) & ~(size_t)63; return p; };
    float* H = take((size_t)S * DM); float* Z = take((size_t)S * DIN);
    float* QR = take((size_t)S * 512); float* QLAT = take((size_t)S * 1024); float* CKV = take((size_t)S * 128); float* KR = take((size_t)S * 16);
    float* QI = take((size_t)S * 512); float* KI = take((size_t)S * 64); float* WI = take((size_t)S * 8);
    unsigned char* SEL = (unsigned char*)take((size_t)S * S / 4);
    float* YA = take((size_t)S * 512); float* U = take((size_t)S * 512); float* VN = take((size_t)S * 512); float* YB = take((size_t)S * 512);
    float* PA = take((size_t)S * 1024); float* PB = take((size_t)S * 1024); float* MG = take((size_t)S * 1024);
    float* G = take((size_t)S * DFF); float* UU = take((size_t)S * DFF); float* ACT = take((size_t)S * DFF);
    if (o * 4 > ws_size) return;
    for (int b = 0; b < NB; ++b) {
        const float* xb = x + (size_t)b * S * DM; float* ob = out + (size_t)b * S * DM; const int* pb = positions + (size_t)b * S;
        for (int l = 0; l < 2; ++l) {
            const float* xin = (l == 0) ? xb : ob;
            const float* Win = w_in + (size_t)l * DM * DIN;
            k_rmsnorm<<<S, 256, 0, stream>>>(xin, norm_mix + l * DM, H);
            k_gemm<<<dim3((DIN + 127) / 128, S / 128), 256, 0, stream>>>(H, DM, Win, DIN, Z, DIN, DIN, DM, nullptr, 0);
            k_postz<<<S, 256, 0, stream>>>(Z, pb, kv_norm + l * 128, w_uk + (size_t)l * 8 * 48 * 128, QR, QLAT, CKV, KR, QI, KI, WI);
            k_select<<<S, 256, 0, stream>>>(QI, KI, WI, SEL);
            k_attn<<<dim3(8, S), 64, 0, stream>>>(QLAT, QR, CKV, KR, SEL, w_uv + (size_t)l * 8 * 128 * 64, YA);
            k_gelu_ln<<<S, 256, 0, stream>>>(Z, ln_v_g + l * 512, ln_v_b + l * 512, U, VN);
            k_gmlp<<<dim3(8, 16), 256, 0, stream>>>(U, VN, w_s + (size_t)l * 8 * 128 * 128, b_s + (size_t)l * 8 * 128, YB);
            k_gemm<<<dim3(1024 / 128, S / 128), 256, 0, stream>>>(YA, 512, w_proj_a + (size_t)l * 512 * 1024, 1024, PA, 1024, 1024, 512, nullptr, 0);
            k_gemm<<<dim3(1024 / 128, S / 128), 256, 0, stream>>>(YB, 512, w_proj_b + (size_t)l * 512 * 1024, 1024, PB, 1024, 1024, 512, nullptr, 0);
            k_merge<<<S, 256, 0, stream>>>(Z, PA, PB, MG);
            k_gemm<<<dim3(1024 / 128, S / 128), 256, 0, stream>>>(MG, 1024, w_out + (size_t)l * 1024 * 1024, 1024, ob, 1024, 1024, 1024, xin, 1024);
            k_rmsnorm<<<S, 256, 0, stream>>>(ob, norm_ffn + l * DM, H);
            k_gemm<<<dim3(DFF / 128, S / 128), 256, 0, stream>>>(H, DM, w_gate + (size_t)l * DM * DFF, DFF, G, DFF, DFF, DM, nullptr, 0);
            k_gemm<<<dim3(DFF / 128, S / 128), 256, 0, stream>>>(H, DM, w_up + (size_t)l * DM * DFF, DFF, UU, DFF, DFF, DM, nullptr, 0);
            k_swiglu<<<(S * DFF + 255) / 256, 256, 0, stream>>>(G, UU, ACT, S * DFF);
            k_gemm<<<dim3(1024 / 128, S / 128), 256, 0, stream>>>(ACT, DFF, w_down + (size_t)l * DFF * 1024, 1024, ob, 1024, 1024, DFF, ob, 1024);
        }
        k_rmsnorm<<<S, 256, 0, stream>>>(ob, final_norm, ob);
    }
}
```

```cpp
#define MK_N_LAUNCHES 16
#include <hip/hip_runtime.h>
#include <stdint.h>
#include <math.h>
#include <cstdio>

#define LAS __attribute__((address_space(3)))
#define GAS __attribute__((address_space(1)))
typedef _Float16 h16;
typedef h16 h16x8 __attribute__((ext_vector_type(8)));
typedef h16 h16x4 __attribute__((ext_vector_type(4)));
typedef h16 h16x2 __attribute__((ext_vector_type(2)));
typedef float f32x2 __attribute__((ext_vector_type(2)));
typedef float f32x4 __attribute__((ext_vector_type(4)));
typedef float f32x16 __attribute__((ext_vector_type(16)));
typedef unsigned u32x2 __attribute__((ext_vector_type(2)));
typedef unsigned u32x4 __attribute__((ext_vector_type(4)));
typedef short v4i16_t __attribute__((ext_vector_type(4)));

__device__ __forceinline__ unsigned pkh(float lo, float hi) { h16x2 v = {(h16)lo, (h16)hi}; return __builtin_bit_cast(unsigned, v); }
__device__ __forceinline__ float h2f_lo(unsigned u) { h16x2 v = __builtin_bit_cast(h16x2, u); return (float)v[0]; }
__device__ __forceinline__ float h2f_hi(unsigned u) { h16x2 v = __builtin_bit_cast(h16x2, u); return (float)v[1]; }

namespace pg8 {
constexpr int BM = 256, BK = 64, HALF = 128, HTB = HALF * BK * 2, STAGE_BYTES = 8 * HTB, NXCD = 8, WGM = 8;
__host__ __device__ __forceinline__ int lds_byte(int r, int c) { const int st = (r >> 4) * 2 + (c >> 5), rr = r & 15, cc = c & 31, ob = rr * 64 + cc * 2; return st * 1024 + (ob ^ (((ob >> 9) & 1) << 5)); }
__host__ __device__ __forceinline__ void stage_rc(int b, int& R, int& C) { const int st = b / 1024, sb = b % 1024, swz = sb ^ (((sb >> 9) & 1) << 5); R = (st >> 1) * 16 + swz / 64; C = (st & 1) * 32 + (swz % 64) / 2; }
__host__ __device__ __forceinline__ int perm32(int rho) { const int n = rho >> 4, i = rho & 15; return 8 * (i >> 2) + 4 * n + (i & 3); }

struct Unit { int pm, pn, kind; };
struct Gemm { const h16* A; const h16* Bt; int lda, ldb, K, nM, nN, nkind, koff; };

struct Order {
    int nM, nN, nwg, G, c, nk;
    __device__ void init(int nM_, int nN_, int G_, int c_, int nk_) { nM = nM_; nN = nN_; nwg = nM * nN; G = G_; c = c_; nk = nk_; }
    __device__ bool next(int i, Unit& u) const {
        const int ti = i / nk; u.kind = i - ti * nk;
        const long L = (long)ti * G + c; if (L >= nwg) return false;
        int wgid = (int)L; { const int q = nwg / NXCD, r = nwg % NXCD, xcd = wgid % NXCD, off = wgid / NXCD; wgid = (xcd < r ? xcd * (q + 1) : r * (q + 1) + (xcd - r) * q) + off; }
        const int nig = WGM * nN, gid = wgid / nig, fm = gid * WGM, gsz = (nM - fm) < WGM ? (nM - fm) : WGM;
        u.pm = fm + ((wgid % nig) % gsz); u.pn = (wgid % nig) / gsz; return true;
    }
};

template <class Epi>
__device__ __forceinline__ void gemm_phase(LAS unsigned char* lds, const Gemm g, const Order& S, const Epi& E) {
    const int tid = threadIdx.x, wid = __builtin_amdgcn_readfirstlane(tid >> 6), lane = tid & 63, wr = wid >> 2, wc = wid & 3, fr = lane & 15, fq = lane >> 4;
    const int nt = g.K / BK;
    unsigned voffA[2], voffB[2];
#pragma unroll
    for (int i = 0; i < 2; ++i) { int R, C; stage_rc(tid * 16 + i * 8192, R, C); const int Rb = Epi::PERM ? ((R & ~31) + perm32(R & 31)) : R;
        voffA[i] = (unsigned)(R * g.lda + C) * 2u; voffB[i] = (unsigned)(Rb * g.ldb + C) * 2u; }
    const size_t kstep = (size_t)(BK * 2);
    const size_t hstepA = (size_t)HALF * g.lda * 2, hstepB = (size_t)HALF * g.ldb * 2;
    const unsigned ldsw = (unsigned)wid * 1024u;
    const int aoff = lds_byte(wr * 64 + fr, fq * 8), boff = lds_byte(wc * 32 + fr, fq * 8);
#define PG8_SA(b, h) (((b) * 2 + (h)) * HTB)
#define PG8_SB(b, h) ((4 + (b) * 2 + (h)) * HTB)
#define PG8_STAGE(bufoff, gbase, voff) do { _Pragma("unroll") for (int _i = 0; _i < 2; ++_i) \
        __builtin_amdgcn_global_load_lds((const unsigned*)((const char*)(gbase) + (voff)[_i]), (LAS unsigned*)(lds + (bufoff) + ldsw + _i * 8192), 16, 0, 0); } while (0)
#define PG8_LDA(dst, b, h) do { _Pragma("unroll") for (int m = 0; m < 4; ++m) _Pragma("unroll") for (int k = 0; k < 2; ++k) dst[m][k] = *(const LAS h16x8*)(lds + PG8_SA(b, h) + aoff + m * 2048 + k * 1024); } while (0)
#define PG8_LDB(dst, b, h) do { _Pragma("unroll") for (int n = 0; n < 2; ++n) _Pragma("unroll") for (int k = 0; k < 2; ++k) dst[n][k] = *(const LAS h16x8*)(lds + PG8_SB(b, h) + boff + n * 2048 + k * 1024); } while (0)
#define PG8_MMA(ai, bj, At, Bt) do { __builtin_amdgcn_s_setprio(1); _Pragma("unroll") for (int m = 0; m < 4; ++m) _Pragma("unroll") for (int n = 0; n < 2; ++n) _Pragma("unroll") for (int k = 0; k < 2; ++k) \
        acc[ai][bj][m][n] = __builtin_amdgcn_mfma_f32_16x16x32_f16(Bt[n][k], At[m][k], acc[ai][bj][m][n], 0, 0, 0); __builtin_amdgcn_s_setprio(0); } while (0)
#define PG8_WAIT_V(n) asm volatile("s_waitcnt vmcnt(" #n ")" ::: "memory")
#define PG8_WAIT_L(n) asm volatile("s_waitcnt lgkmcnt(" #n ")" ::: "memory")
#define PG8_BAR __builtin_amdgcn_s_barrier()
#define PG8_SCHED __builtin_amdgcn_sched_barrier(0)
#define PG8_PA(u) ((const char*)g.A + ((size_t)(u).pm * 256 * g.lda + (size_t)(u).kind * g.koff) * 2)
#define PG8_PB(u) ((const char*)g.Bt + ((size_t)(u).pn * 256 * g.ldb + (size_t)(u).kind * g.koff) * 2)
    Unit cur, nxt; int ui = 0;
    if (!S.next(0, cur)) return;
    f32x4 acc[2][2][4][2];
#pragma unroll
    for (int a = 0; a < 2; ++a)
#pragma unroll
        for (int b = 0; b < 2; ++b)
#pragma unroll
            for (int m = 0; m < 4; ++m)
#pragma unroll
                for (int n = 0; n < 2; ++n) acc[a][b][m][n] = (f32x4){0.f, 0.f, 0.f, 0.f};
    h16x8 At[4][2], B0[2][2], B1[2][2];
    const char* cA = PG8_PA(cur); const char* cB = PG8_PB(cur);
    PG8_STAGE(PG8_SB(0, 0), cB, voffB); PG8_STAGE(PG8_SB(0, 1), cB + hstepB, voffB); PG8_STAGE(PG8_SA(0, 0), cA, voffA); PG8_STAGE(PG8_SA(0, 1), cA + hstepA, voffA);
    if (wr == 1) PG8_BAR;
    PG8_WAIT_V(2); PG8_BAR;
    PG8_STAGE(PG8_SB(1, 0), cB + kstep, voffB); PG8_STAGE(PG8_SA(1, 0), cA + kstep, voffA); PG8_STAGE(PG8_SB(1, 1), cB + hstepB + kstep, voffB);
    PG8_WAIT_V(6); PG8_BAR;
    for (;;) {
        const bool has_next = S.next(ui + 1, nxt);
        const char* nA = has_next ? PG8_PA(nxt) : cA; const char* nB = has_next ? PG8_PB(nxt) : cB;
        for (int t = 0; t < nt; t += 2) {
            const bool last = (t == nt - 2);
            const char* a1 = cA + (size_t)(t + 1) * kstep;
            const char* a2 = last ? nA : cA + (size_t)(t + 2) * kstep; const char* b2 = last ? nB : cB + (size_t)(t + 2) * kstep;
            const char* a3 = a2 + kstep; const char* b3 = b2 + kstep;
            PG8_LDB(B0, 0, 0); PG8_LDB(B1, 0, 1); PG8_SCHED; PG8_LDA(At, 0, 0); PG8_STAGE(PG8_SA(1, 1), a1 + hstepA, voffA);
            PG8_WAIT_V(8); PG8_WAIT_L(0); PG8_BAR; PG8_MMA(0, 0, At, B0); PG8_MMA(0, 1, At, B1); PG8_BAR; PG8_SCHED;
            PG8_LDA(At, 0, 1); PG8_STAGE(PG8_SB(0, 0), b2, voffB); PG8_STAGE(PG8_SB(0, 1), b2 + hstepB, voffB); PG8_STAGE(PG8_SA(0, 0), a2, voffA);
            PG8_WAIT_V(8); PG8_WAIT_L(0); PG8_BAR; PG8_MMA(1, 0, At, B0); PG8_MMA(1, 1, At, B1); PG8_BAR; PG8_SCHED;
            PG8_LDB(B0, 1, 0); PG8_LDB(B1, 1, 1); PG8_SCHED; PG8_LDA(At, 1, 0); PG8_STAGE(PG8_SA(0, 1), a2 + hstepA, voffA);
            PG8_WAIT_V(8); PG8_WAIT_L(0); PG8_BAR; PG8_MMA(0, 0, At, B0); PG8_MMA(0, 1, At, B1); PG8_BAR; PG8_SCHED;
            PG8_LDA(At, 1, 1); PG8_STAGE(PG8_SB(1, 0), b3, voffB); PG8_STAGE(PG8_SB(1, 1), b3 + hstepB, voffB); PG8_STAGE(PG8_SA(1, 0), a3, voffA);
            PG8_WAIT_V(8); PG8_WAIT_L(0); PG8_BAR; PG8_MMA(1, 0, At, B0); PG8_MMA(1, 1, At, B1); PG8_BAR; PG8_SCHED;
        }
        if (wr == 0) PG8_BAR;
        { int fr_ = fr, fq_ = fq; asm volatile("" : "+v"(fr_), "+v"(fq_)); E(acc, cur, wr, wc, fr_, fq_); }
        if (!has_next) break;
        if (nxt.kind == 0) {
#pragma unroll
            for (int a = 0; a < 2; ++a)
#pragma unroll
                for (int b = 0; b < 2; ++b)
#pragma unroll
                    for (int m = 0; m < 4; ++m)
#pragma unroll
                        for (int n = 0; n < 2; ++n) acc[a][b][m][n] = (f32x4){0.f, 0.f, 0.f, 0.f};
        }
        cur = nxt; cA = nA; cB = nB; ++ui;
        if (wr == 1) PG8_BAR;
    }
    PG8_WAIT_V(0);
    PG8_BAR;
#undef PG8_SA
#undef PG8_SB
#undef PG8_STAGE
#undef PG8_LDA
#undef PG8_LDB
#undef PG8_MMA
#undef PG8_WAIT_V
#undef PG8_WAIT_L
#undef PG8_BAR
#undef PG8_SCHED
#undef PG8_PA
#undef PG8_PB
}
}
constexpr int NWAVES = 8, NTHREADS = 512;
constexpr int NB = 8, SEQ = 2048, DM = 1024, M = NB * SEQ, DIN = 4312, DFF = 2816, NLAYER = 2;
constexpr int NZ = 4352;
constexpr int NGU = 2 * DFF;
constexpr float EPS_RMS = 1e-6f;
constexpr float LOG2E = 1.4426950408889634f;
constexpr float QSCALE = 0.125f * LOG2E;
constexpr int KVP = 152;

constexpr size_t MiB = 1u << 20;
constexpr size_t WS_CTL = 0, CTL_ZERO_BYTES = 65536;
constexpr size_t WS_CS = 1 * MiB;
constexpr size_t WS_SSQ = 2 * MiB;
constexpr size_t WS_WI = 3 * MiB;
constexpr size_t WS_SMALLW = 4 * MiB;
constexpr size_t SMALLW_LAYER = 98304 + 131072 + 262144;
constexpr size_t WS_W = 6 * MiB;
constexpr size_t W_LAYER = 29 * MiB, W_OFF_IN = 0, W_OFF_PAB = (size_t)NZ * 1024 * 2, W_OFF_OUT = W_OFF_PAB + 2 * MiB, W_OFF_GU = W_OFF_OUT + 2 * MiB, W_OFF_D = W_OFF_GU + (size_t)NGU * 1024 * 2;
static_assert(W_OFF_D + (size_t)1024 * DFF * 2 == W_LAYER, "weight map");
constexpr size_t WS_X16 = 64 * MiB;
constexpr size_t WS_QY = 96 * MiB;
constexpr size_t WS_QI = 128 * MiB;
constexpr size_t WS_MISC = 144 * MiB;
constexpr size_t WS_KV = 152 * MiB;
constexpr size_t WS_KI = 157 * MiB;
constexpr size_t WS_X1 = 128 * MiB;
constexpr size_t WS_GATES = 160 * MiB;
constexpr size_t WS_UV = 224 * MiB;
constexpr size_t WS_ACT = 160 * MiB;
constexpr size_t WS_END = 256 * MiB;
static_assert(WS_KV + (size_t)M * KVP * 2 <= WS_KI && WS_KI + (size_t)M * 64 * 2 <= WS_GATES && WS_ACT + (size_t)M * DFF * 2 <= WS_END, "ws map");

constexpr int LDS_BYTES = 155648;
constexpr int LDS_MISC = 151552;

#define RLX_AGENT __ATOMIC_RELAXED, __HIP_MEMORY_SCOPE_AGENT
#define LDS_WAIT() asm volatile("s_waitcnt lgkmcnt(0)" ::: "memory")
#define VM_WAIT() asm volatile("s_waitcnt vmcnt(0)" ::: "memory")

#define XB_TMO      128
#define XB_XCNT(j)  (256  + 64 * (j))
#define XB_XSUB(j)  (1280 + 64 * (j))
#define XB_XGEN(j)  (2304 + 64 * (j))
#define XB_TOP      3328
#define XB_TOPGEN   3392
#define XCD_BAR_WORDS 3456
#define XB_SPIN_CAP (1u << 18)
__device__ __forceinline__ unsigned xb_ld(unsigned* p)              { return __hip_atomic_load(p, __ATOMIC_RELAXED, __HIP_MEMORY_SCOPE_AGENT); }
__device__ __forceinline__ unsigned xb_add(unsigned* p, unsigned v) { return __hip_atomic_fetch_add(p, v, __ATOMIC_RELAXED, __HIP_MEMORY_SCOPE_AGENT); }
__device__ __forceinline__ unsigned xb_xcc_id() { return (unsigned)__builtin_amdgcn_s_getreg((3 << 11) | 20) & 0xFu; }
#define XB_SPIN(cond, bar) do { unsigned _sp = 0; while (cond) { __builtin_amdgcn_s_sleep(1); \
    if ((++_sp & 255u) == 0u) { if (xb_ld(&(bar)[XB_TMO])) break; if (_sp > XB_SPIN_CAP) { atomicAdd(&(bar)[XB_TMO], 1u); break; } } } } while (0)
struct XcdBarrier { unsigned* bar; unsigned x; volatile LAS unsigned* st; };
__device__ __forceinline__ XcdBarrier xcd_barrier_post(unsigned* bar, volatile LAS unsigned* st) {
    XcdBarrier b; b.bar = bar; b.x = xb_xcc_id(); b.st = st;
    if (threadIdx.x == 0) (void)xb_add(&bar[XB_XCNT(b.x)], 1u);
    return b;
}
__device__ __forceinline__ void xcd_barrier_complete(unsigned* bar, unsigned x, unsigned& nloc, unsigned& nx) {
    const unsigned G = gridDim.x * gridDim.y * gridDim.z;
    unsigned sum, cnt, mine, sp = 0u;
    for (;;) {
        sum = 0u; cnt = 0u; mine = 0u;
#pragma unroll
        for (unsigned j = 0; j < 16; ++j) { const unsigned c = xb_ld(&bar[XB_XCNT(j)]); sum += c; cnt += (c > 0u) ? 1u : 0u; mine = (j == x) ? c : mine; }
        if (sum == G) break;
        __builtin_amdgcn_s_sleep(1);
        if ((++sp & 255u) == 0u) { if (xb_ld(&bar[XB_TMO])) break; if (sp > XB_SPIN_CAP) { atomicAdd(&bar[XB_TMO], 1u); break; } }
    }
    nloc = mine > 0u ? mine : 1u; nx = cnt > 0u ? cnt : 1u;
}
__device__ __forceinline__ void xcd_barrier(const XcdBarrier& b) {
    asm volatile("s_waitcnt vmcnt(0)" ::: "memory");
    __syncthreads();
    if (threadIdx.x == 0) {
        unsigned* bar = b.bar;
        __builtin_amdgcn_s_waitcnt(0);
        unsigned nloc = b.st[0], nx = b.st[1];
        if (nloc == 0u) { xcd_barrier_complete(bar, b.x, nloc, nx); b.st[0] = nloc; b.st[1] = nx; }
        const unsigned old = xb_add(&bar[XB_XSUB(b.x)], 1u);
        const unsigned gen = old / nloc;
        if (old + 1u == (gen + 1u) * nloc) {
            __builtin_amdgcn_fence(__ATOMIC_RELEASE, "agent");
            asm volatile("s_waitcnt vmcnt(0)" ::: "memory");
            const unsigned og = xb_add(&bar[XB_TOP], 1u);
            const unsigned tg = og / nx;
            if (og + 1u == (tg + 1u) * nx) xb_add(&bar[XB_TOPGEN], 1u);
            else XB_SPIN(xb_ld(&bar[XB_TOPGEN]) == tg, bar);
            __builtin_amdgcn_fence(__ATOMIC_ACQUIRE, "agent");
            xb_add(&bar[XB_XGEN(b.x)], 1u);
            asm volatile("s_waitcnt vmcnt(0)" ::: "memory");
        } else {
            XB_SPIN(xb_ld(&bar[XB_XGEN(b.x)]) == gen, bar);
            __builtin_amdgcn_fence(__ATOMIC_ACQUIRE, "agent");
            asm volatile("s_waitcnt vmcnt(0)" ::: "memory");
        }
    }
    __syncthreads();
}

__device__ __forceinline__ float gelu_tanh_f(float x) {
    const float u = 0.7978845608028654f * (x + 0.044715f * x * x * x);
    const float e = __builtin_amdgcn_exp2f(-2.0f * LOG2E * u);
    return x * __builtin_amdgcn_rcpf(1.0f + e);
}
__device__ __forceinline__ float sigmoid_f(float x) { return __builtin_amdgcn_rcpf(1.0f + __builtin_amdgcn_exp2f(-LOG2E * x)); }

struct Frame {
    LAS unsigned char* lds;
    int tid, lane, wave, vcu, G;
    unsigned char* ws;
    const float* const* in;
};
struct In {
    const float* x; const int* pos; const float* norm_mix; const float* w_in; const float* kv_norm; const float* w_uk; const float* w_uv; const float* ln_v_g; const float* ln_v_b;
    const float* w_s; const float* b_s; const float* w_proj_a; const float* w_proj_b; const float* w_out; const float* norm_ffn; const float* w_gate; const float* w_up; const float* w_down; const float* final_norm;
};

__device__ __constant__ float c_inv[8] = {1.0f, 0.19392274474868576f, 0.03760603093086393f, 0.007292664737217109f, 0.001414213562373095f, 0.0002742481756762073f, 5.318295896944988e-05f, 1.031338537721246e-05f};

__device__ __forceinline__ void transpose_item(const float* Wl, int Nsrc, h16* WT, int ldt, int n0, int k0, const float* gain, LAS float* scr, int lane) {
#pragma unroll 8
    for (int i = 0; i < 32; ++i) { const int kk = 2 * i + (lane >> 5); float v = Wl ? Wl[(size_t)(k0 + kk) * Nsrc] : 0.f; if (gain) v *= gain[k0 + kk]; scr[kk * 33 + (lane & 31)] = v; }
    LDS_WAIT(); asm volatile("" ::: "memory");
    const int c = lane & 7;
#pragma unroll
    for (int j = 0; j < 4; ++j) { const int n = (lane >> 3) + 8 * j; const LAS float* s = scr + (8 * c) * 33 + n;
        u32x4 o; o.x = pkh(s[0 * 33], s[1 * 33]); o.y = pkh(s[2 * 33], s[3 * 33]); o.z = pkh(s[4 * 33], s[5 * 33]); o.w = pkh(s[6 * 33], s[7 * 33]);
        *(u32x4*)(WT + (size_t)(n0 + n) * ldt + k0 + 8 * c) = o; }
    LDS_WAIT(); asm volatile("" ::: "memory");
}
__device__ __forceinline__ int win_src_col(int n) {
    if (n < 512) return n;
    if (n < 1024) return 656 + (n - 512);
    if (n < 2048) return 1240 + (n - 1024);
    if (n < 4096) return 2264 + (n - 2048);
    if (n < 4224) return 512 + (n - 4096);
    if (n < 4240) return 640 + (n - 4224);
    if (n < 4304) return 1168 + (n - 4240);
    if (n < 4312) return 1232 + (n - 4304);
    return -1;
}
__device__ __forceinline__ void p0_prologue(const Frame& F, const In& I) {
    LAS float* scr = (LAS float*)(F.lds + F.wave * 8448);
    int lane = F.lane; asm volatile("" : "+v"(lane));
    const int gw = F.vcu * NWAVES + F.wave, NGW = F.G * NWAVES;
    constexpr int I_IN = (NZ / 32) * 16, I_PA = 32 * 8, I_OUT = 32 * 16, I_GU = (NGU / 32) * 16, I_D = 32 * (DFF / 64);
    constexpr int I_LAYER = I_IN + 2 * I_PA + I_OUT + I_GU + I_D;
    for (int it = gw; it < NLAYER * I_LAYER; it += NGW) {
        const int l = it / I_LAYER; int r = it - l * I_LAYER;
        unsigned char* wl = F.ws + WS_W + (size_t)l * W_LAYER;
        if (r < I_IN) { const int nb = r / 16, kb = r % 16, sc = win_src_col(nb * 32 + (lane & 31));
            transpose_item(sc >= 0 ? I.w_in + (size_t)l * DM * DIN + sc : nullptr, DIN, (h16*)(wl + W_OFF_IN), 1024, nb * 32, kb * 64, I.norm_mix + l * DM, scr, lane); continue; }
        r -= I_IN;
        if (r < I_PA) { const int nb = r / 8, kb = r % 8;
            transpose_item(I.w_proj_a + (size_t)l * 512 * 1024 + nb * 32 + (lane & 31), 1024, (h16*)(wl + W_OFF_PAB), 1024, nb * 32, kb * 64, nullptr, scr, lane); continue; }
        r -= I_PA;
        if (r < I_PA) { const int nb = r / 8, kb = r % 8;
            transpose_item(I.w_proj_b + (size_t)l * 512 * 1024 + nb * 32 + (lane & 31), 1024, (h16*)(wl + W_OFF_PAB) + 512, 1024, nb * 32, kb * 64, nullptr, scr, lane); continue; }
        r -= I_PA;
        if (r < I_OUT) { const int nb = r / 16, kb = r % 16;
            transpose_item(I.w_out + (size_t)l * 1024 * 1024 + nb * 32 + (lane & 31), 1024, (h16*)(wl + W_OFF_OUT), 1024, nb * 32, kb * 64, nullptr, scr, lane); continue; }
        r -= I_OUT;
        if (r < I_GU) { const int nb = r / 16, kb = r % 16, R = nb * 32 + (lane & 31), pn = R >> 8, rem = R & 255;
            const int a = 128 * pn + 64 * (rem >> 7) + 16 * ((rem >> 5) & 3) + 4 * ((rem >> 3) & 3) + (rem & 3);
            const float* src = (((rem >> 2) & 1) ? I.w_up : I.w_gate) + (size_t)l * DM * DFF + a;
            transpose_item(src, DFF, (h16*)(wl + W_OFF_GU), 1024, nb * 32, kb * 64, I.norm_ffn + l * DM, scr, lane); continue; }
        r -= I_GU;
        { const int nb = r / (DFF / 64), kb = r % (DFF / 64);
            transpose_item(I.w_down + (size_t)l * DFF * 1024 + nb * 32 + (lane & 31), 1024, (h16*)(wl + W_OFF_D), DFF, nb * 32, kb * 64, nullptr, scr, lane); }
    }
    const int gt = F.vcu * NTHREADS + F.tid, NGT = F.G * NTHREADS;
    for (int i = gt; i < NLAYER * 49152; i += NGT) { const int l = i / 49152, e = i % 49152, h = e / (128 * 48), c = (e / 48) % 128, n = e % 48;
        ((h16*)(F.ws + WS_SMALLW + (size_t)l * SMALLW_LAYER))[e] = (h16)I.w_uk[(((size_t)l * 8 + h) * 48 + n) * 128 + c]; }
    for (int i = gt; i < NLAYER * 65536; i += NGT) { const int l = i / 65536, e = i % 65536, h = e / (64 * 128), d = (e / 128) % 64, c = e % 128;
        ((h16*)(F.ws + WS_SMALLW + (size_t)l * SMALLW_LAYER + 98304))[e] = (h16)I.w_uv[(((size_t)l * 8 + h) * 128 + c) * 64 + d]; }
    for (int i = gt; i < NLAYER * 131072; i += NGT) { const int l = i / 131072, e = i % 131072, t = (e / 128) % 128, s = e % 128;
        ((h16*)(F.ws + WS_SMALLW + (size_t)l * SMALLW_LAYER + 98304 + 131072))[e] = (s <= t) ? (h16)I.w_s[(size_t)l * 131072 + e] : (h16)0.f; }
    for (int i = gt; i < M * 8; i += NGT) { const int tok = i >> 3, f = i & 7; const float ang = (float)I.pos[tok] * c_inv[f];
        float* cs = (float*)(F.ws + WS_CS) + (size_t)tok * 16; cs[f] = cosf(ang); cs[8 + f] = sinf(ang); }
    for (int m = gw; m < M; m += NGW) {
        const f32x4* xr = (const f32x4*)(I.x + (size_t)m * DM) + lane; u32x2* o8 = (u32x2*)((h16*)(F.ws + WS_X16) + (size_t)m * DM) + lane;
#pragma unroll
        for (int j = 0; j < 4; ++j) { const f32x4 v = xr[64 * j]; float s = (v.x * v.x + v.y * v.y) + (v.z * v.z + v.w * v.w);
#pragma unroll
            for (int o = 1; o < 64; o <<= 1) s += __shfl_xor(s, o);
            o8[64 * j] = (u32x2){pkh(v.x, v.y), pkh(v.z, v.w)};
            if (lane == 0) ((float*)(F.ws + WS_SSQ))[(size_t)m * 4 + j] = s; }
    }
}

__device__ __forceinline__ float row_rstd(const float* ssq, int row) {
    const f32x4 a = *(const f32x4*)(ssq + (size_t)row * 4);
    return rsqrtf(((a.x + a.y) + (a.z + a.w)) * (1.0f / DM) + EPS_RMS);
}

typedef f32x4 Acc[2][2][4][2];

struct EpiA {
    static constexpr bool PERM = true;
    unsigned char* ws;
    __device__ __forceinline__ void operator()(Acc& acc, const pg8::Unit& u, int wr, int wc, int fr, int fq) const {
        const int pn = u.pn; h16* base; int ldc, colt; bool act = false;
        if (pn < 2) { base = (h16*)(ws + WS_QY); ldc = 1024; colt = pn * 256; }
        else if (pn < 4) { base = (h16*)(ws + WS_QI); ldc = 512; colt = (pn - 2) * 256; }
        else if (pn < 8) { base = (h16*)(ws + WS_UV); ldc = 1024; colt = (pn - 4) * 256; act = true; }
        else if (pn < 16) { base = (h16*)(ws + WS_GATES); ldc = 2048; colt = (pn - 8) * 256; }
        else { base = (h16*)(ws + WS_MISC); ldc = 256; colt = 0; }
        const int row0 = u.pm * 256 + wr * 64 + fr, col0 = colt + wc * 32 + 8 * fq;
        const float* ssq = (const float*)(ws + WS_SSQ);
#pragma unroll
        for (int ai = 0; ai < 2; ++ai)
#pragma unroll
            for (int m = 0; m < 4; ++m) { const int row = row0 + ai * 128 + m * 16; const float rs = row_rstd(ssq, row); h16* rowp = base + (size_t)row * ldc + col0;
#pragma unroll
                for (int bj = 0; bj < 2; ++bj) { f32x4 v0 = acc[ai][bj][m][0] * rs, v1 = acc[ai][bj][m][1] * rs;
                    if (act) {
#pragma unroll
                        for (int i = 0; i < 4; ++i) { v0[i] = gelu_tanh_f(v0[i]); v1[i] = gelu_tanh_f(v1[i]); } }
                    u32x4 w; w.x = pkh(v0[0], v0[1]); w.y = pkh(v0[2], v0[3]); w.z = pkh(v1[0], v1[1]); w.w = pkh(v1[2], v1[3]);
                    *(u32x4*)(rowp + bj * 128) = w; }
                asm volatile("" ::: "memory"); }
    }
};

struct EpiD {
    static constexpr bool PERM = true;
    unsigned char* ws;
    __device__ __forceinline__ void operator()(Acc& acc, const pg8::Unit& u, int wr, int wc, int fr, int fq) const {
        const int row0 = u.pm * 256 + wr * 64 + fr, col0 = u.pn * 256 + wc * 32 + 8 * fq;
        const h16* gates = (const h16*)(ws + WS_GATES); h16* mg = (h16*)(ws + WS_X16);
#pragma unroll
        for (int ai = 0; ai < 2; ++ai)
#pragma unroll
            for (int m = 0; m < 4; ++m) { const int row = row0 + ai * 128 + m * 16;
#pragma unroll
                for (int bj = 0; bj < 2; ++bj) { const int col = col0 + bj * 128;
                    const h16x8 gb = *(const h16x8*)(gates + (size_t)row * 2048 + 1024 + col);
                    if (u.kind == 0) { const h16x8 ga = *(const h16x8*)(gates + (size_t)row * 2048 + col);
#pragma unroll
                        for (int i = 0; i < 8; ++i) { const float a = fminf(fmaxf((float)ga[i], -30.f), 30.f), b = fminf(fmaxf((float)gb[i], -30.f), 30.f);
                            const float ratio = (1.0f + __builtin_amdgcn_exp2f(-LOG2E * b)) * __builtin_amdgcn_rcpf(1.0f + __builtin_amdgcn_exp2f(-LOG2E * a));
                            acc[ai][bj][m][i >> 2][i & 3] *= ratio; }
                    } else { float v[8];
#pragma unroll
                        for (int i = 0; i < 8; ++i) { const float b = fminf(fmaxf((float)gb[i], -30.f), 30.f); v[i] = acc[ai][bj][m][i >> 2][i & 3] * sigmoid_f(b); }
                        u32x4 w; w.x = pkh(v[0], v[1]); w.y = pkh(v[2], v[3]); w.z = pkh(v[4], v[5]); w.w = pkh(v[6], v[7]);
                        *(u32x4*)(mg + (size_t)row * 1024 + col) = w; } }
                asm volatile("" ::: "memory"); }
    }
};

struct EpiRes {
    static constexpr bool PERM = false;
    const float* resid; float* out; h16* x16; float* ssq; LAS float* P;
    __device__ __forceinline__ void operator()(Acc& acc, const pg8::Unit& u, int wr, int wc, int fr, int fq) const {
        const int row0 = u.pm * 256 + wr * 64 + fr, col0 = u.pn * 256 + wc * 32 + 4 * fq;
#pragma unroll
        for (int ai = 0; ai < 2; ++ai)
#pragma unroll
            for (int m = 0; m < 4; ++m) { const int row = row0 + ai * 128 + m * 16; float ss = 0.f;
#pragma unroll
                for (int bj = 0; bj < 2; ++bj)
#pragma unroll
                    for (int n = 0; n < 2; ++n) { const size_t off = (size_t)row * 1024 + col0 + bj * 128 + n * 16;
                        const f32x4 v = *(const f32x4*)(resid + off) + acc[ai][bj][m][n];
                        *(f32x4*)(out + off) = v; *(u32x2*)(x16 + off) = (u32x2){pkh(v[0], v[1]), pkh(v[2], v[3])};
                        ss += (v[0] * v[0] + v[1] * v[1]) + (v[2] * v[2] + v[3] * v[3]); }
                ss += __shfl_xor(ss, 16); ss += __shfl_xor(ss, 32);
                if (fq == 0) P[(ai * 128 + wr * 64 + m * 16 + fr) * 4 + wc] = ss;
                asm volatile("" ::: "memory"); }
        asm volatile("s_waitcnt lgkmcnt(0)" ::: "memory"); __builtin_amdgcn_s_barrier(); asm volatile("" ::: "memory");
        { const int t = (wr * 4 + wc) * 64 + fq * 16 + fr; if (t < 256) { const f32x4 v = *(const LAS f32x4*)(P + t * 4); ssq[(size_t)(u.pm * 256 + t) * 4 + u.pn] = (v.x + v.y) + (v.z + v.w); } }
        asm volatile("s_waitcnt lgkmcnt(0)" ::: "memory"); __builtin_amdgcn_s_barrier(); asm volatile("" ::: "memory");
    }
};

struct EpiF {
    static constexpr bool PERM = true;
    unsigned char* ws;
    __device__ __forceinline__ void operator()(Acc& acc, const pg8::Unit& u, int wr, int wc, int fr, int fq) const {
        const int row0 = u.pm * 256 + wr * 64 + fr, col0 = u.pn * 128 + wc * 16 + 4 * fq;
        const float* ssq = (const float*)(ws + WS_SSQ); h16* act = (h16*)(ws + WS_ACT);
#pragma unroll
        for (int ai = 0; ai < 2; ++ai)
#pragma unroll
            for (int m = 0; m < 4; ++m) { const int row = row0 + ai * 128 + m * 16; const float rs = row_rstd(ssq, row);
#pragma unroll
                for (int bj = 0; bj < 2; ++bj) { const f32x4 g = acc[ai][bj][m][0] * rs, uu = acc[ai][bj][m][1] * rs; float v[4];
#pragma unroll
                    for (int i = 0; i < 4; ++i) v[i] = g[i] * sigmoid_f(g[i]) * uu[i];
                    *(u32x2*)(act + (size_t)row * DFF + col0 + bj * 64) = (u32x2){pkh(v[0], v[1]), pkh(v[2], v[3])}; }
                asm volatile("" ::: "memory"); }
    }
};

__device__ __forceinline__ void final_norm_phase(const Frame& F, float* out, const float* g) {
    int lane = F.lane; asm volatile("" : "+v"(lane));
    const int gw = F.vcu * NWAVES + F.wave, NGW = F.G * NWAVES;
    for (int m = gw; m < M; m += NGW) {
        f32x4* xr = (f32x4*)(out + (size_t)m * DM) + lane; f32x4 v[4]; float s = 0.f;
#pragma unroll
        for (int j = 0; j < 4; ++j) { v[j] = xr[64 * j]; s += (v[j].x * v[j].x + v[j].y * v[j].y) + (v[j].z * v[j].z + v[j].w * v[j].w); }
#pragma unroll
        for (int o = 1; o < 64; o <<= 1) s += __shfl_xor(s, o);
        const float rs = rsqrtf(s * (1.0f / DM) + EPS_RMS);
#pragma unroll
        for (int j = 0; j < 4; ++j) { const f32x4 gg = ((const f32x4*)g)[lane + 64 * j]; xr[64 * j] = v[j] * rs * gg; }
    }
}
__device__ __forceinline__ unsigned wlane(unsigned val, int ln, unsigned old) {
    unsigned keep;
    asm volatile("s_mov_b32 %1, m0\n\ts_mov_b32 m0, %3\n\ts_nop 3\n\tv_writelane_b32 %0, %2, m0\n\ts_mov_b32 m0, %1" : "+v"(old), "=&s"(keep) : "s"(val), "s"(ln));
    return old;
}
__device__ __forceinline__ int crow(int R, int hf) { return (R & 3) + 8 * (R >> 2) + 4 * hf; }
__device__ __forceinline__ float half_swap_max(float v) { auto rr = __builtin_amdgcn_permlane32_swap(__float_as_uint(v), __float_as_uint(v), false, false); return fmaxf(__uint_as_float(rr[0]), __uint_as_float(rr[1])); }
__device__ __forceinline__ float half_swap_sum(float v) { auto rr = __builtin_amdgcn_permlane32_swap(__float_as_uint(v), __float_as_uint(v), false, false); return __uint_as_float(rr[0]) + __uint_as_float(rr[1]); }
__device__ __forceinline__ void rope8(const h16x8 x1, const h16x8 x2, const float* cs, int which, float scale, float (&o)[8]) {
    const f32x4 c0 = *(const f32x4*)(cs), c1 = *(const f32x4*)(cs + 4), s0 = *(const f32x4*)(cs + 8), s1 = *(const f32x4*)(cs + 12);
#pragma unroll
    for (int j = 0; j < 8; ++j) { const float c = j < 4 ? c0[j & 3] : c1[j & 3], s = j < 4 ? s0[j & 3] : s1[j & 3]; const float a = (float)x1[j], b = (float)x2[j];
        o[j] = (which == 0 ? (a * c - b * s) : (b * c + a * s)) * scale; }
}
__device__ __forceinline__ u32x4 pack8(const float (&v)[8]) { u32x4 w; w.x = pkh(v[0], v[1]); w.y = pkh(v[2], v[3]); w.z = pkh(v[4], v[5]); w.w = pkh(v[6], v[7]); return w; }

__device__ __forceinline__ void phaseB(const Frame& F, const In& I, int l) {
    unsigned char* ws = F.ws; asm volatile("" : "+s"(ws)); int lane = F.lane, tid = F.tid; asm volatile("" : "+v"(lane), "+v"(tid)); const int w = F.wave;
    const h16* MISC = (const h16*)(ws + WS_MISC); h16* KV = (h16*)(ws + WS_KV); h16* KI = (h16*)(ws + WS_KI); float* WI = (float*)(ws + WS_WI); const float* CS = (const float*)(ws + WS_CS);
    const int blk = F.vcu;
#pragma unroll 1
    for (int it = 0; it < 2; ++it) {
        const int tok = blk * 64 + w * 8 + it * 4 + (lane >> 4), i = lane & 15;
        const h16* mr = MISC + (size_t)tok * 256; const float* cs = CS + (size_t)tok * 16;
        const h16x8 x = *(const h16x8*)(mr + 8 * i);
        float ss = 0.f;
#pragma unroll
        for (int j = 0; j < 8; ++j) ss += (float)x[j] * (float)x[j];
        ss += __shfl_xor(ss, 1); ss += __shfl_xor(ss, 2); ss += __shfl_xor(ss, 4); ss += __shfl_xor(ss, 8);
        const float rs = rsqrtf(ss * (1.0f / 128.f) + EPS_RMS);
        { float o[8]; const float* kn = I.kv_norm + l * 128 + 8 * i;
#pragma unroll
          for (int j = 0; j < 8; ++j) o[j] = (float)x[j] * rs * kn[j];
          *(u32x4*)(KV + (size_t)tok * KVP + 8 * i) = pack8(o); }
        if (i < 2) { float o[8]; rope8(*(const h16x8*)(mr + 128), *(const h16x8*)(mr + 136), cs, i, 1.0f, o); *(u32x4*)(KV + (size_t)tok * KVP + 128 + 8 * i) = pack8(o); }
        else if (i == 2) { *(u32x4*)(KV + (size_t)tok * KVP + 144) = (u32x4){0u, 0u, 0u, 0u}; }
        else if (i < 11) { const int ii = i - 3;
            if (ii < 2) { float o[8]; rope8(*(const h16x8*)(mr + 144), *(const h16x8*)(mr + 152), cs, ii, 1.0f, o); *(u32x4*)(KI + (size_t)tok * 64 + 8 * ii) = pack8(o); }
            else *(u32x4*)(KI + (size_t)tok * 64 + 8 * ii) = *(const u32x4*)(mr + 144 + 8 * ii); }
        else if (i == 11) { const h16x8 wv = *(const h16x8*)(mr + 208); const float sc = 0.35355339059327373f * 0.125f;
            *(f32x4*)(WI + (size_t)tok * 8) = (f32x4){(float)wv[0] * sc, (float)wv[1] * sc, (float)wv[2] * sc, (float)wv[3] * sc};
            *(f32x4*)(WI + (size_t)tok * 8 + 4) = (f32x4){(float)wv[4] * sc, (float)wv[5] * sc, (float)wv[6] * sc, (float)wv[7] * sc}; }
    }
    const int b = blk >> 5, chunk = (blk >> 1) & 15, gh = blk & 1;
    const size_t tok0 = (size_t)b * SEQ + chunk * 128;
    const h16* UV = (const h16*)(ws + WS_UV); h16* QY = (h16*)(ws + WS_QY);
    LAS float* MU = (LAS float*)(F.lds); LAS float* RS = MU + 128; LAS h16* VNT = (LAS h16*)(F.lds + 1024);
    constexpr int VP = 136;
#pragma unroll 1
    for (int rr = 0; rr < 16; ++rr) { const int t = 16 * w + rr; const h16x8 v = *(const h16x8*)(UV + (tok0 + t) * 1024 + 512 + 8 * lane);
        float s = 0.f;
#pragma unroll
        for (int j = 0; j < 8; ++j) s += (float)v[j];
#pragma unroll
        for (int o = 1; o < 64; o <<= 1) s += __shfl_xor(s, o);
        const float mu = s * (1.0f / 512.f); float q = 0.f;
#pragma unroll
        for (int j = 0; j < 8; ++j) { const float d = (float)v[j] - mu; q += d * d; }
#pragma unroll
        for (int o = 1; o < 64; o <<= 1) q += __shfl_xor(q, o);
        if (lane == 0) { MU[t] = mu; RS[t] = rsqrtf(q * (1.0f / 512.f) + 1e-5f); } }
    LDS_WAIT(); __syncthreads();
#pragma unroll 1
    for (int itx = 0; itx < 8; ++itx) { const int p = tid + 512 * itx, t = p >> 5, c0 = (p & 31) * 8, col = 256 * gh + c0;
        const h16x8 v = *(const h16x8*)(UV + (tok0 + t) * 1024 + 512 + col); const float mu = MU[t], rs = RS[t];
        const float* lg = I.ln_v_g + l * 512 + col; const float* lb = I.ln_v_b + l * 512 + col;
#pragma unroll
        for (int j = 0; j < 8; ++j) { const int c = c0 + j; VNT[((c >> 6) * 64 + (c & 63)) * VP + t] = (h16)(((float)v[j] - mu) * rs * lg[j] + lb[j]); } }
    LDS_WAIT(); __syncthreads();
    { const int gp = w & 3, g = 4 * gh + gp, rh = w >> 2, r = lane & 31, hf = lane >> 5;
      const h16* WS16 = (const h16*)(ws + WS_SMALLW + (size_t)l * SMALLW_LAYER + 98304 + 131072) + (size_t)g * 128 * 128;
#pragma unroll 1
      for (int tb = 0; tb < 2; ++tb) { const int trow0 = 64 * rh + 32 * tb; const int nks = 4 * rh + 2 * tb + 2;
#pragma unroll 1
        for (int db = 0; db < 2; ++db) { f32x16 D = {};
#pragma unroll
            for (int s = 0; s < 8; ++s) if (s < nks) {
                const h16x8 a = *(const h16x8*)(WS16 + (size_t)(trow0 + r) * 128 + 16 * s + 8 * hf);
                const h16x8 bb = *(const LAS h16x8*)(VNT + (gp * 64 + 32 * db + r) * VP + 16 * s + 8 * hf);
                D = __builtin_amdgcn_mfma_f32_32x32x16_f16(a, bb, D, 0, 0, 0); }
#pragma unroll
            for (int R = 0; R < 16; ++R) { const int t = trow0 + crow(R, hf); const size_t tk = tok0 + t; const int d = g * 64 + 32 * db + r;
                const float sv = D[R] + I.b_s[((size_t)l * 8 + g) * 128 + t];
                const float u = (float)UV[tk * 1024 + d];
                QY[tk * 1024 + 512 + d] = (h16)(u * sv); } } } }
    __syncthreads();
}

constexpr int C_KIB = 0, C_KIP = 144;
constexpr int C_QL = 0, C_QLW = KVP * 2 * 32;
constexpr int C_WQ = 81920;
constexpr int C_KVS = 90112, C_KVSLOT = 32 * KVP * 2;

__device__ __forceinline__ void phaseC_select(const Frame& F, int l, int b, int qt) {
    unsigned char* ws = F.ws; asm volatile("" : "+s"(ws)); int lane = F.lane, tid = F.tid; asm volatile("" : "+v"(lane), "+v"(tid)); const int w = F.wave, r = lane & 31, hf = lane >> 5;
    const h16* QI = (const h16*)(ws + WS_QI); const h16* KI = (const h16*)(ws + WS_KI); const float* WI = (const float*)(ws + WS_WI); const float* CS = (const float*)(ws + WS_CS);
    h16* QY = (h16*)(ws + WS_QY); const h16* KV = (const h16*)(ws + WS_KV);
    const h16* WUKT = (const h16*)(ws + WS_SMALLW + (size_t)l * SMALLW_LAYER); const h16* WUVT = (const h16*)(ws + WS_SMALLW + (size_t)l * SMALLW_LAYER + 98304);
    LAS unsigned char* lds = F.lds;
    const int t0 = 32 * qt, NT = qt + 1; const size_t tokbase = (size_t)b * SEQ;
    h16x8 afr[4]; float wreg[16];
    { const int qq = 2 * ((r >> 2) & 1) + (r >> 4), head = (r & 3) + 4 * ((r >> 3) & 1); const size_t tokA = tokbase + t0 + 4 * w + qq;
      const h16* qsrc = QI + tokA * 512 + head * 64;
      { float o[8]; rope8(*(const h16x8*)(qsrc), *(const h16x8*)(qsrc + 8), CS + tokA * 16, hf, 1.0f, o); afr[0] = __builtin_bit_cast(h16x8, pack8(o)); }
#pragma unroll
      for (int s = 1; s < 4; ++s) afr[s] = *(const h16x8*)(qsrc + 16 * s + 8 * hf);
      const float* wp = WI + (tokbase + t0 + 4 * w + 2 * hf) * 8;
#pragma unroll
      for (int R = 0; R < 16; ++R) wreg[R] = wp[R]; }
    float SC[128];
#pragma unroll
    for (int i = 0; i < 128; ++i) SC[i] = -INFINITY;
    const int NCK = (NT + 7) >> 3, tq0 = t0 + 4 * w + 2 * hf;
#pragma unroll 1
    for (int ck = 0; ck < NCK; ++ck) {
        if (ck > 0) __syncthreads();
#pragma unroll
        for (int i = 0; i < 4; ++i) { const int p = tid + 512 * i, row = p >> 3, ch = p & 7;
            const u32x4 v = *(const u32x4*)(KI + (tokbase + 256 * ck + row) * 64 + 8 * ch); *(LAS u32x4*)(lds + C_KIB + row * C_KIP + ch * 16) = v; }
        LDS_WAIT(); __syncthreads();
#pragma unroll
        for (int i = 0; i < 112; ++i) SC[i] = SC[i + 16];
#pragma unroll
        for (int jj = 0; jj < 8; ++jj) {
            f32x16 D = {};
#pragma unroll
            for (int s = 0; s < 4; ++s) { const h16x8 bb = *(const LAS h16x8*)(lds + C_KIB + (32 * jj + r) * C_KIP + 32 * s + 16 * hf); D = __builtin_amdgcn_mfma_f32_32x32x16_f16(afr[s], bb, D, 0, 0, 0); }
            float s0 = 0.f, s1 = 0.f;
#pragma unroll
            for (int R = 0; R < 8; ++R) { s0 = fmaf(wreg[R], fmaxf(D[R], 0.f), s0); s1 = fmaf(wreg[8 + R], fmaxf(D[8 + R], 0.f), s1); }
            const int k = 256 * ck + 32 * jj + r;
            SC[112 + 2 * jj] = (k > tq0) ? -INFINITY : s0; SC[113 + 2 * jj] = (k > tq0 + 1) ? -INFINITY : s1;
        }
    }
    const int G0 = 8 - NCK;
    float tau0 = -3.0e38f, tau1 = -3.0e38f;
    if (qt >= 8) {
        float lo0 = INFINITY, lo1 = INFINITY, hi0 = -INFINITY, hi1 = -INFINITY;
#pragma unroll
        for (int j = 0; j < 64; ++j) { const float a = SC[2 * j], c = SC[2 * j + 1];
            lo0 = fminf(lo0, a == -INFINITY ? INFINITY : a); hi0 = fmaxf(hi0, a); lo1 = fminf(lo1, c == -INFINITY ? INFINITY : c); hi1 = fmaxf(hi1, c); }
#pragma unroll
        for (int o = 1; o < 32; o <<= 1) { lo0 = fminf(lo0, __shfl_xor(lo0, o)); lo1 = fminf(lo1, __shfl_xor(lo1, o)); hi0 = fmaxf(hi0, __shfl_xor(hi0, o)); hi1 = fmaxf(hi1, __shfl_xor(hi1, o)); }
        bool done0 = false, done1 = false;
#pragma unroll 1
        for (int it = 0; it < 64; ++it) {
            const float mid0 = 0.5f * (lo0 + hi0), mid1 = 0.5f * (lo1 + hi1);
            if (!done0 && (mid0 <= lo0 || mid0 >= hi0)) done0 = true;
            if (!done1 && (mid1 <= lo1 || mid1 >= hi1)) done1 = true;
            if (__all(done0 && done1)) break;
            int c0 = 0, c1 = 0;
#pragma unroll
            for (int g = 0; g < 8; ++g) if (g >= G0) {
#pragma unroll
                for (int jj = 0; jj < 8; ++jj) { const int j = 8 * g + jj; c0 += (SC[2 * j] >= mid0) ? 1 : 0; c1 += (SC[2 * j + 1] >= mid1) ? 1 : 0; } }
#pragma unroll
            for (int o = 1; o < 32; o <<= 1) { c0 += __shfl_xor(c0, o); c1 += __shfl_xor(c1, o); }
            if (!done0) { if (c0 >= 256) { lo0 = mid0; if (c0 == 256) done0 = true; } else hi0 = mid0; }
            if (!done1) { if (c1 >= 256) { lo1 = mid1; if (c1 == 256) done1 = true; } else hi1 = mid1; }
        }
        tau0 = lo0; tau1 = lo1;
    }
    unsigned w00 = 0u, w01 = 0u, w10 = 0u, w11 = 0u;
#pragma unroll
    for (int g = 0; g < 8; ++g) if (g >= G0) {
#pragma unroll
        for (int jj = 0; jj < 8; ++jj) { const int j = 8 * g + jj, jt = 8 * (g - G0) + jj;
            const unsigned long long m0 = __ballot(SC[2 * j] >= tau0), m1 = __ballot(SC[2 * j + 1] >= tau1);
            w00 = wlane((unsigned)m0, jt, w00); w10 = wlane((unsigned)(m0 >> 32), jt, w10);
            w01 = wlane((unsigned)m1, jt, w01); w11 = wlane((unsigned)(m1 >> 32), jt, w11); } }
    { LAS unsigned* WQ = (LAS unsigned*)(lds + C_WQ);
      WQ[(4 * w + 0) * 64 + lane] = w00; WQ[(4 * w + 1) * 64 + lane] = w01; WQ[(4 * w + 2) * 64 + lane] = w10; WQ[(4 * w + 3) * 64 + lane] = w11; }
    LDS_WAIT(); __syncthreads();
}

__device__ __forceinline__ void phaseC_attn(const Frame& F, int l, int b, int qt) {
    unsigned char* ws = F.ws; asm volatile("" : "+s"(ws)); const int w = F.wave;
    int lane = F.lane, tid = F.tid; asm volatile("" : "+v"(lane), "+v"(tid));
    const int r = lane & 31, hf = lane >> 5;
    const float* CS = (const float*)(ws + WS_CS);
    h16* QY = (h16*)(ws + WS_QY); const h16* KV = (const h16*)(ws + WS_KV);
    const h16* WUKT = (const h16*)(ws + WS_SMALLW + (size_t)l * SMALLW_LAYER); const h16* WUVT = (const h16*)(ws + WS_SMALLW + (size_t)l * SMALLW_LAYER + 98304);
    LAS unsigned char* lds = F.lds;
    const int t0 = 32 * qt, NT = qt + 1; const size_t tokbase = (size_t)b * SEQ;
    const int h = w; const size_t tokQ = tokbase + t0 + r;
    LAS h16* ql = (LAS h16*)(lds + C_QL + w * C_QLW);
    { h16x8 bq[3];
#pragma unroll
      for (int s = 0; s < 3; ++s) bq[s] = *(const h16x8*)(QY + tokQ * 1024 + h * 64 + 16 + 16 * s + 8 * hf);
#pragma unroll
      for (int cb = 0; cb < 4; ++cb) { f32x16 D = {};
#pragma unroll
          for (int s = 0; s < 3; ++s) { const h16x8 a = *(const h16x8*)(WUKT + ((size_t)(h * 128 + 32 * cb + r)) * 48 + 16 * s + 8 * hf); D = __builtin_amdgcn_mfma_f32_32x32x16_f16(a, bq[s], D, 0, 0, 0); }
#pragma unroll
          for (int g = 0; g < 4; ++g) { const int c = 32 * cb + 8 * g + 4 * hf;
              *(LAS u32x2*)(ql + r * KVP + c) = (u32x2){pkh(D[4 * g] * QSCALE, D[4 * g + 1] * QSCALE), pkh(D[4 * g + 2] * QSCALE, D[4 * g + 3] * QSCALE)}; } }
      { float o[8]; rope8(*(const h16x8*)(QY + tokQ * 1024 + h * 64), *(const h16x8*)(QY + tokQ * 1024 + h * 64 + 8), CS + tokQ * 16, hf, QSCALE, o); *(LAS u32x4*)(ql + r * KVP + 128 + 8 * hf) = pack8(o); } }
    LDS_WAIT();
    h16x8 qfr[9];
#pragma unroll
    for (int s = 0; s < 9; ++s) qfr[s] = *(const LAS h16x8*)(ql + r * KVP + 16 * s + 8 * hf);
    const h16* kvsrc = KV + tokbase * KVP;
    u32x4 kvA, kvB = {0u, 0u, 0u, 0u};
    kvA = *(const u32x4*)((const char*)kvsrc + (size_t)tid * 16); if (tid < 96) kvB = *(const u32x4*)((const char*)kvsrc + (size_t)(512 + tid) * 16);
    *(LAS u32x4*)(lds + C_KVS + tid * 16) = kvA; if (tid < 96) *(LAS u32x4*)(lds + C_KVS + (512 + tid) * 16) = kvB;
    LDS_WAIT(); __syncthreads();
    float mrun = -INFINITY, lrun = 0.f; f32x16 O[4];
#pragma unroll
    for (int db = 0; db < 4; ++db) O[db] = (f32x16){};
    const LAS unsigned* WQr = (const LAS unsigned*)(lds + C_WQ) + r * 64;
    const int troff = ((lane & 15) >> 2) * (KVP * 2) + (16 * ((lane >> 4) & 1) + 4 * (lane & 3)) * 2 + 4 * hf * (KVP * 2);
#pragma unroll 1
    for (int j = 0; j < NT; ++j) {
        if (j + 1 < NT) { const char* src = (const char*)kvsrc + (size_t)(j + 1) * C_KVSLOT; kvA = *(const u32x4*)(src + (size_t)tid * 16); if (tid < 96) kvB = *(const u32x4*)(src + (size_t)(512 + tid) * 16); }
        LAS unsigned char* slot = lds + C_KVS + (j & 1) * C_KVSLOT;
        f32x16 S = {};
#pragma unroll
        for (int s = 0; s < 9; ++s) { const h16x8 a = *(const LAS h16x8*)(slot + r * (KVP * 2) + 32 * s + 16 * hf); S = __builtin_amdgcn_mfma_f32_32x32x16_f16(a, qfr[s], S, 0, 0, 0); }
        float mt = S[0];
#pragma unroll
        for (int R = 1; R < 16; ++R) mt = fmaxf(mt, S[R]);
        mt = half_swap_max(mt);
        if (__any(mt > mrun + 8.0f)) { const float mnew = fmaxf(mrun, mt), alpha = __builtin_amdgcn_exp2f(mrun - mnew);
#pragma unroll
            for (int db = 0; db < 4; ++db) O[db] = O[db] * alpha;
            lrun *= alpha; mrun = mnew; }
        const unsigned wq = WQr[j] >> (4 * hf);
        float p[16];
#pragma unroll
        for (int R = 0; R < 16; ++R) { const float e = __builtin_amdgcn_exp2f(S[R] - mrun); p[R] = ((wq >> ((R & 3) + 8 * (R >> 2))) & 1u) ? e : 0.f; lrun += p[R]; }
        h16x8 pf[2];
#pragma unroll
        for (int sp = 0; sp < 2; ++sp) { u32x4 t; t.x = pkh(p[8 * sp], p[8 * sp + 1]); t.y = pkh(p[8 * sp + 2], p[8 * sp + 3]); t.z = pkh(p[8 * sp + 4], p[8 * sp + 5]); t.w = pkh(p[8 * sp + 6], p[8 * sp + 7]); pf[sp] = __builtin_bit_cast(h16x8, t); }
#pragma unroll
        for (int db = 0; db < 4; ++db)
#pragma unroll
            for (int sp = 0; sp < 2; ++sp) {
                const v4i16_t lo = __builtin_amdgcn_ds_read_tr16_b64_v4i16((LAS v4i16_t*)(slot + troff + (16 * sp) * (KVP * 2) + 64 * db));
                const v4i16_t hi = __builtin_amdgcn_ds_read_tr16_b64_v4i16((LAS v4i16_t*)(slot + troff + (16 * sp + 8) * (KVP * 2) + 64 * db));
                typedef short s16x8 __attribute__((ext_vector_type(8)));
                const s16x8 av = {lo[0], lo[1], lo[2], lo[3], hi[0], hi[1], hi[2], hi[3]};
                O[db] = __builtin_amdgcn_mfma_f32_32x32x16_f16(__builtin_bit_cast(h16x8, av), pf[sp], O[db], 0, 0, 0); }
        if (j + 1 < NT) { LAS unsigned char* nslot = lds + C_KVS + ((j + 1) & 1) * C_KVSLOT; *(LAS u32x4*)(nslot + tid * 16) = kvA; if (tid < 96) *(LAS u32x4*)(nslot + (512 + tid) * 16) = kvB; }
        LDS_WAIT(); __syncthreads();
    }
    { const float inv = 1.0f / half_swap_sum(lrun);
#pragma unroll
      for (int db = 0; db < 4; ++db)
#pragma unroll
          for (int g = 0; g < 4; ++g) { const int c = 32 * db + 8 * g + 4 * hf;
              *(LAS u32x2*)(ql + r * KVP + c) = (u32x2){pkh(O[db][4 * g] * inv, O[db][4 * g + 1] * inv), pkh(O[db][4 * g + 2] * inv, O[db][4 * g + 3] * inv)}; } }
    LDS_WAIT();
    { h16x8 ao[8];
#pragma unroll
      for (int s = 0; s < 8; ++s) ao[s] = *(const LAS h16x8*)(ql + r * KVP + 16 * s + 8 * hf);
#pragma unroll
      for (int d2 = 0; d2 < 2; ++d2) { f32x16 D = {};
#pragma unroll
          for (int s = 0; s < 8; ++s) { const h16x8 bw = *(const h16x8*)(WUVT + ((size_t)(h * 64 + 32 * d2 + r)) * 128 + 16 * s + 8 * hf); D = __builtin_amdgcn_mfma_f32_32x32x16_f16(ao[s], bw, D, 0, 0, 0); }
#pragma unroll
          for (int R = 0; R < 16; ++R) QY[(tokbase + t0 + crow(R, hf)) * 1024 + h * 64 + 32 * d2 + r] = (h16)D[R]; } }
    LDS_WAIT(); __syncthreads();
}

__device__ __forceinline__ void phaseC(const Frame& F, int l) {
    const int b = F.vcu >> 5, i = F.vcu & 31;
#pragma unroll 1
    for (int u = 0; u < 2; ++u) { const int qt = (u == 0) ? 63 - i : i; phaseC_select(F, l, b, qt); phaseC_attn(F, l, b, qt); }
}
#ifndef MK_N_LAUNCHES
#define MK_N_LAUNCHES 1
#endif
constexpr int N_PHASES = 2 + 7 * NLAYER;
struct Args { In in; float* out; unsigned char* ws; int ph_lo, ph_hi; };

__global__ void __launch_bounds__(NTHREADS, 2) mk_fwd(Args args) {
    extern __shared__ __attribute__((aligned(16))) unsigned char lds_raw[];
    Frame F; F.lds = (LAS unsigned char*)lds_raw; F.tid = threadIdx.x; F.lane = F.tid & 63; F.wave = __builtin_amdgcn_readfirstlane(F.tid >> 6);
    F.G = gridDim.x; { const int bx = blockIdx.x; F.vcu = (F.G % 8 == 0) ? (bx % 8) * (F.G / 8) + bx / 8 : bx; }
    F.ws = args.ws; F.in = nullptr;
    const In& I = args.in; unsigned char* ws = args.ws; (void)ws;
    volatile LAS unsigned* MISCW = (volatile LAS unsigned*)(F.lds + LDS_MISC);
    if (F.tid < 64) MISCW[F.tid] = 0u;
    __syncthreads();
    const bool one_launch = (args.ph_hi - args.ph_lo) > 1;
    XcdBarrier bar; bar.bar = (unsigned*)(ws + WS_CTL) + 1024; bar.x = 0; bar.st = nullptr;
    if (one_launch) bar = xcd_barrier_post((unsigned*)(ws + WS_CTL) + 1024, MISCW + 8);
#define IN(k) (args.ph_lo <= (k) && (k) < args.ph_hi)
#define SEAM(k) do { if (IN(k) && IN((k) + 1)) xcd_barrier(bar); } while (0)
    if (IN(0)) { p0_prologue(F, I); SEAM(0); }
#define OPQ(x) asm volatile("" : "+s"(x))
#pragma unroll 1
    for (int l0 = 0; l0 < NLAYER; ++l0) {
        const int p = 1 + 7 * l0;
        if (IN(p)) {
            unsigned char* wsq = args.ws; int l = l0; OPQ(wsq); OPQ(l); unsigned char* wl = wsq + WS_W + (size_t)l * W_LAYER;
            pg8::Gemm g{(const h16*)(wsq + WS_X16), (const h16*)(wl + W_OFF_IN), 1024, 1024, 1024, M / 256, NZ / 256, 1, 0};
            pg8::Order S; S.init(g.nM, g.nN, F.G, (int)blockIdx.x, 1); EpiA E{wsq};
            pg8::gemm_phase<EpiA>(F.lds, g, S, E); SEAM(p); }
        if (IN(p + 1)) { int l = l0; OPQ(l); phaseB(F, I, l); SEAM(p + 1); }
        if (IN(p + 2)) { int l = l0; OPQ(l); phaseC(F, l); SEAM(p + 2); }
        if (IN(p + 3)) {
            unsigned char* wsq = args.ws; int l = l0; OPQ(wsq); OPQ(l); unsigned char* wl = wsq + WS_W + (size_t)l * W_LAYER;
            pg8::Gemm g{(const h16*)(wsq + WS_QY), (const h16*)(wl + W_OFF_PAB), 1024, 1024, 512, M / 256, 4, 2, 512};
            pg8::Order S; S.init(g.nM, g.nN, F.G, (int)blockIdx.x, 2); EpiD E{wsq};
            pg8::gemm_phase<EpiD>(F.lds, g, S, E); SEAM(p + 3); }
        if (IN(p + 4)) {
            unsigned char* wsq = args.ws; int l = l0; OPQ(wsq); OPQ(l); unsigned char* wl = wsq + WS_W + (size_t)l * W_LAYER;
            pg8::Gemm g{(const h16*)(wsq + WS_X16), (const h16*)(wl + W_OFF_OUT), 1024, 1024, 1024, M / 256, 4, 1, 0};
            pg8::Order S; S.init(g.nM, g.nN, F.G, (int)blockIdx.x, 1);
            EpiRes E{l == 0 ? args.in.x : args.out, args.out, (h16*)(wsq + WS_X1), (float*)(wsq + WS_SSQ), (LAS float*)(F.lds + 131072)};
            pg8::gemm_phase<EpiRes>(F.lds, g, S, E); SEAM(p + 4); }
        if (IN(p + 5)) {
            unsigned char* wsq = args.ws; int l = l0; OPQ(wsq); OPQ(l); unsigned char* wl = wsq + WS_W + (size_t)l * W_LAYER;
            pg8::Gemm g{(const h16*)(wsq + WS_X1), (const h16*)(wl + W_OFF_GU), 1024, 1024, 1024, M / 256, NGU / 256, 1, 0};
            pg8::Order S; S.init(g.nM, g.nN, F.G, (int)blockIdx.x, 1); EpiF E{wsq};
            pg8::gemm_phase<EpiF>(F.lds, g, S, E); SEAM(p + 5); }
        if (IN(p + 6)) {
            unsigned char* wsq = args.ws; int l = l0; OPQ(wsq); OPQ(l); unsigned char* wl = wsq + WS_W + (size_t)l * W_LAYER;
            pg8::Gemm g{(const h16*)(wsq + WS_ACT), (const h16*)(wl + W_OFF_D), DFF, DFF, DFF, M / 256, 4, 1, 0};
            pg8::Order S; S.init(g.nM, g.nN, F.G, (int)blockIdx.x, 1);
            EpiRes E{args.out, args.out, (h16*)(wsq + WS_X16), (float*)(wsq + WS_SSQ), (LAS float*)(F.lds + 131072)};
            pg8::gemm_phase<EpiRes>(F.lds, g, S, E); SEAM(p + 6); }
    }
    if (IN(N_PHASES - 1)) final_norm_phase(F, args.out, I.final_norm);
#undef IN
#undef SEAM
}

extern "C" void kernel_launch(void* const* d_in, const int* in_sizes, int n_in, void* d_out, int out_size, void* d_ws, size_t ws_size, hipStream_t stream) {
    static int grid = 0;
    if (grid == 0) {
        if (n_in != 19 || out_size != M * DM || ws_size < WS_END) { fprintf(stderr, "kernel_launch: unexpected shapes (n_in %d out %d ws %zu)\n", n_in, out_size, ws_size); grid = -1; return; }
        int dev = 0, cus = 0, per_cu = 0;
        hipGetDevice(&dev); hipDeviceGetAttribute(&cus, hipDeviceAttributeMultiprocessorCount, dev);
        hipFuncSetAttribute((const void*)mk_fwd, hipFuncAttributeMaxDynamicSharedMemorySize, LDS_BYTES);
        hipOccupancyMaxActiveBlocksPerMultiprocessor(&per_cu, (const void*)mk_fwd, NTHREADS, LDS_BYTES);
        (void)hipGetLastError();
        if (per_cu < 1) fprintf(stderr, "kernel_launch: occupancy query reports %d blocks per CU\n", per_cu);
        grid = cus;
    }
    if (grid < 0) return;
    hipMemsetAsync((char*)d_ws + WS_CTL, 0, CTL_ZERO_BYTES, stream);
    Args a{};
    const void** ip = (const void**)&a.in;
    for (int i = 0; i < 19; ++i) ip[i] = d_in[i];
    a.out = (float*)d_out; a.ws = (unsigned char*)d_ws;
#if MK_N_LAUNCHES == 1
    a.ph_lo = 0; a.ph_hi = N_PHASES;
    { void* kargs[] = {&a}; hipError_t e = hipLaunchCooperativeKernel((const void*)mk_fwd, dim3(grid), dim3(NTHREADS), kargs, LDS_BYTES, stream);
      if (e != hipSuccess) fprintf(stderr, "cooperative launch failed: %s (grid %d)\n", hipGetErrorString(e), grid); }
#else
    for (int p = 0; p < N_PHASES; ++p) { a.ph_lo = p; a.ph_hi = p + 1; hipLaunchKernelGGL(mk_fwd, dim3(grid), dim3(NTHREADS), LDS_BYTES, stream, a); }
#endif
}
```

```cpp
#define MK_N_LAUNCHES 1
#include <hip/hip_runtime.h>
#include <stdint.h>
#include <math.h>
#include <cstdio>

#define LAS __attribute__((address_space(3)))
#define GAS __attribute__((address_space(1)))
typedef _Float16 h16;
typedef h16 h16x8 __attribute__((ext_vector_type(8)));
typedef h16 h16x4 __attribute__((ext_vector_type(4)));
typedef h16 h16x2 __attribute__((ext_vector_type(2)));
typedef float f32x2 __attribute__((ext_vector_type(2)));
typedef float f32x4 __attribute__((ext_vector_type(4)));
typedef float f32x16 __attribute__((ext_vector_type(16)));
typedef unsigned u32x2 __attribute__((ext_vector_type(2)));
typedef unsigned u32x4 __attribute__((ext_vector_type(4)));
typedef short v4i16_t __attribute__((ext_vector_type(4)));

__device__ __forceinline__ unsigned pkh(float lo, float hi) { h16x2 v = {(h16)lo, (h16)hi}; return __builtin_bit_cast(unsigned, v); }
__device__ __forceinline__ float h2f_lo(unsigned u) { h16x2 v = __builtin_bit_cast(h16x2, u); return (float)v[0]; }
__device__ __forceinline__ float h2f_hi(unsigned u) { h16x2 v = __builtin_bit_cast(h16x2, u); return (float)v[1]; }

namespace pg8 {
constexpr int BM = 256, BK = 64, HALF = 128, HTB = HALF * BK * 2, STAGE_BYTES = 8 * HTB, NXCD = 8, WGM = 8;
__host__ __device__ __forceinline__ int lds_byte(int r, int c) { const int st = (r >> 4) * 2 + (c >> 5), rr = r & 15, cc = c & 31, ob = rr * 64 + cc * 2; return st * 1024 + (ob ^ (((ob >> 9) & 1) << 5)); }
__host__ __device__ __forceinline__ void stage_rc(int b, int& R, int& C) { const int st = b / 1024, sb = b % 1024, swz = sb ^ (((sb >> 9) & 1) << 5); R = (st >> 1) * 16 + swz / 64; C = (st & 1) * 32 + (swz % 64) / 2; }
__host__ __device__ __forceinline__ int perm32(int rho) { const int n = rho >> 4, i = rho & 15; return 8 * (i >> 2) + 4 * n + (i & 3); }

struct Unit { int pm, pn, kind; };
struct Gemm { const h16* A; const h16* Bt; int lda, ldb, K, nM, nN, nkind, koff; };

struct Order {
    int nM, nN, nwg, G, c, nk;
    __device__ void init(int nM_, int nN_, int G_, int c_, int nk_) { nM = nM_; nN = nN_; nwg = nM * nN; G = G_; c = c_; nk = nk_; }
    __device__ bool next(int i, Unit& u) const {
        const int ti = i / nk; u.kind = i - ti * nk;
        const long L = (long)ti * G + c; if (L >= nwg) return false;
        int wgid = (int)L; { const int q = nwg / NXCD, r = nwg % NXCD, xcd = wgid % NXCD, off = wgid / NXCD; wgid = (xcd < r ? xcd * (q + 1) : r * (q + 1) + (xcd - r) * q) + off; }
        const int nig = WGM * nN, gid = wgid / nig, fm = gid * WGM, gsz = (nM - fm) < WGM ? (nM - fm) : WGM;
        u.pm = fm + ((wgid % nig) % gsz); u.pn = (wgid % nig) / gsz; return true;
    }
};

template <class Epi>
__device__ __forceinline__ void gemm_phase(LAS unsigned char* lds, const Gemm g, const Order& S, const Epi& E) {
    const int tid = threadIdx.x, wid = __builtin_amdgcn_readfirstlane(tid >> 6), lane = tid & 63, wr = wid >> 2, wc = wid & 3, fr = lane & 15, fq = lane >> 4;
    const int nt = g.K / BK;
    unsigned voffA[2], voffB[2];
#pragma unroll
    for (int i = 0; i < 2; ++i) { int R, C; stage_rc(tid * 16 + i * 8192, R, C); const int Rb = Epi::PERM ? ((R & ~31) + perm32(R & 31)) : R;
        voffA[i] = (unsigned)(R * g.lda + C) * 2u; voffB[i] = (unsigned)(Rb * g.ldb + C) * 2u; }
    const size_t kstep = (size_t)(BK * 2);
    const size_t hstepA = (size_t)HALF * g.lda * 2, hstepB = (size_t)HALF * g.ldb * 2;
    const unsigned ldsw = (unsigned)wid * 1024u;
    const int aoff = lds_byte(wr * 64 + fr, fq * 8), boff = lds_byte(wc * 32 + fr, fq * 8);
#define PG8_SA(b, h) (((b) * 2 + (h)) * HTB)
#define PG8_SB(b, h) ((4 + (b) * 2 + (h)) * HTB)
#define PG8_STAGE(bufoff, gbase, voff) do { _Pragma("unroll") for (int _i = 0; _i < 2; ++_i) \
        __builtin_amdgcn_global_load_lds((const unsigned*)((const char*)(gbase) + (voff)[_i]), (LAS unsigned*)(lds + (bufoff) + ldsw + _i * 8192), 16, 0, 0); } while (0)
#define PG8_LDA(dst, b, h) do { _Pragma("unroll") for (int m = 0; m < 4; ++m) _Pragma("unroll") for (int k = 0; k < 2; ++k) dst[m][k] = *(const LAS h16x8*)(lds + PG8_SA(b, h) + aoff + m * 2048 + k * 1024); } while (0)
#define PG8_LDB(dst, b, h) do { _Pragma("unroll") for (int n = 0; n < 2; ++n) _Pragma("unroll") for (int k = 0; k < 2; ++k) dst[n][k] = *(const LAS h16x8*)(lds + PG8_SB(b, h) + boff + n * 2048 + k * 1024); } while (0)
#define PG8_MMA(ai, bj, At, Bt) do { __builtin_amdgcn_s_setprio(1); _Pragma("unroll") for (int m = 0; m < 4; ++m) _Pragma("unroll") for (int n = 0; n < 2; ++n) _Pragma("unroll") for (int k = 0; k < 2; ++k) \
        acc[ai][bj][m][n] = __builtin_amdgcn_mfma_f32_16x16x32_f16(Bt[n][k], At[m][k], acc[ai][bj][m][n], 0, 0, 0); __builtin_amdgcn_s_setprio(0); } while (0)
#define PG8_WAIT_V(n) asm volatile("s_waitcnt vmcnt(" #n ")" ::: "memory")
#define PG8_WAIT_L(n) asm volatile("s_waitcnt lgkmcnt(" #n ")" ::: "memory")
#define PG8_BAR __builtin_amdgcn_s_barrier()
#define PG8_SCHED __builtin_amdgcn_sched_barrier(0)
#define PG8_PA(u) ((const char*)g.A + ((size_t)(u).pm * 256 * g.lda + (size_t)(u).kind * g.koff) * 2)
#define PG8_PB(u) ((const char*)g.Bt + ((size_t)(u).pn * 256 * g.ldb + (size_t)(u).kind * g.koff) * 2)
    Unit cur, nxt; int ui = 0;
    if (!S.next(0, cur)) return;
    f32x4 acc[2][2][4][2];
#pragma unroll
    for (int a = 0; a < 2; ++a)
#pragma unroll
        for (int b = 0; b < 2; ++b)
#pragma unroll
            for (int m = 0; m < 4; ++m)
#pragma unroll
                for (int n = 0; n < 2; ++n) acc[a][b][m][n] = (f32x4){0.f, 0.f, 0.f, 0.f};
    h16x8 At[4][2], B0[2][2], B1[2][2];
    const char* cA = PG8_PA(cur); const char* cB = PG8_PB(cur);
    PG8_STAGE(PG8_SB(0, 0), cB, voffB); PG8_STAGE(PG8_SB(0, 1), cB + hstepB, voffB); PG8_STAGE(PG8_SA(0, 0), cA, voffA); PG8_STAGE(PG8_SA(0, 1), cA + hstepA, voffA);
    if (wr == 1) PG8_BAR;
    PG8_WAIT_V(2); PG8_BAR;
    PG8_STAGE(PG8_SB(1, 0), cB + kstep, voffB); PG8_STAGE(PG8_SA(1, 0), cA + kstep, voffA); PG8_STAGE(PG8_SB(1, 1), cB + hstepB + kstep, voffB);
    PG8_WAIT_V(6); PG8_BAR;
    for (;;) {
        const bool has_next = S.next(ui + 1, nxt);
        const char* nA = has_next ? PG8_PA(nxt) : cA; const char* nB = has_next ? PG8_PB(nxt) : cB;
        for (int t = 0; t < nt; t += 2) {
            const bool last = (t == nt - 2);
            const char* a1 = cA + (size_t)(t + 1) * kstep;
            const char* a2 = last ? nA : cA + (size_t)(t + 2) * kstep; const char* b2 = last ? nB : cB + (size_t)(t + 2) * kstep;
            const char* a3 = a2 + kstep; const char* b3 = b2 + kstep;
            PG8_LDB(B0, 0, 0); PG8_LDB(B1, 0, 1); PG8_SCHED; PG8_LDA(At, 0, 0); PG8_STAGE(PG8_SA(1, 1), a1 + hstepA, voffA);
            PG8_WAIT_V(8); PG8_WAIT_L(0); PG8_BAR; PG8_MMA(0, 0, At, B0); PG8_MMA(0, 1, At, B1); PG8_BAR; PG8_SCHED;
            PG8_LDA(At, 0, 1); PG8_STAGE(PG8_SB(0, 0), b2, voffB); PG8_STAGE(PG8_SB(0, 1), b2 + hstepB, voffB); PG8_STAGE(PG8_SA(0, 0), a2, voffA);
            PG8_WAIT_V(8); PG8_WAIT_L(0); PG8_BAR; PG8_MMA(1, 0, At, B0); PG8_MMA(1, 1, At, B1); PG8_BAR; PG8_SCHED;
            PG8_LDB(B0, 1, 0); PG8_LDB(B1, 1, 1); PG8_SCHED; PG8_LDA(At, 1, 0); PG8_STAGE(PG8_SA(0, 1), a2 + hstepA, voffA);
            PG8_WAIT_V(8); PG8_WAIT_L(0); PG8_BAR; PG8_MMA(0, 0, At, B0); PG8_MMA(0, 1, At, B1); PG8_BAR; PG8_SCHED;
            PG8_LDA(At, 1, 1); PG8_STAGE(PG8_SB(1, 0), b3, voffB); PG8_STAGE(PG8_SB(1, 1), b3 + hstepB, voffB); PG8_STAGE(PG8_SA(1, 0), a3, voffA);
            PG8_WAIT_V(8); PG8_WAIT_L(0); PG8_BAR; PG8_MMA(1, 0, At, B0); PG8_MMA(1, 1, At, B1); PG8_BAR; PG8_SCHED;
        }
        if (wr == 0) PG8_BAR;
        { int fr_ = fr, fq_ = fq; asm volatile("" : "+v"(fr_), "+v"(fq_)); E(acc, cur, wr, wc, fr_, fq_); }
        if (!has_next) break;
        if (nxt.kind == 0) {
#pragma unroll
            for (int a = 0; a < 2; ++a)
#pragma unroll
                for (int b = 0; b < 2; ++b)
#pragma unroll
                    for (int m = 0; m < 4; ++m)
#pragma unroll
                        for (int n = 0; n < 2; ++n) acc[a][b][m][n] = (f32x4){0.f, 0.f, 0.f, 0.f};
        }
        cur = nxt; cA = nA; cB = nB; ++ui;
        if (wr == 1) PG8_BAR;
    }
    PG8_WAIT_V(0);
    PG8_BAR;
#undef PG8_SA
#undef PG8_SB
#undef PG8_STAGE
#undef PG8_LDA
#undef PG8_LDB
#undef PG8_MMA
#undef PG8_WAIT_V
#undef PG8_WAIT_L
#undef PG8_BAR
#undef PG8_SCHED
#undef PG8_PA
#undef PG8_PB
}
}
constexpr int NWAVES = 8, NTHREADS = 512;
constexpr int NB = 8, SEQ = 2048, DM = 1024, M = NB * SEQ, DIN = 4312, DFF = 2816, NLAYER = 2;
constexpr int NZ = 4352;
constexpr int NGU = 2 * DFF;
constexpr float EPS_RMS = 1e-6f;
constexpr float LOG2E = 1.4426950408889634f;
constexpr float QSCALE = 0.125f * LOG2E;
constexpr int KVP = 152;

constexpr size_t MiB = 1u << 20;
constexpr size_t WS_CTL = 0, CTL_ZERO_BYTES = 65536;
constexpr size_t WS_CS = 1 * MiB;
constexpr size_t WS_SSQ = 2 * MiB;
constexpr size_t WS_WI = 3 * MiB;
constexpr size_t WS_SMALLW = 4 * MiB;
constexpr size_t SMALLW_LAYER = 98304 + 131072 + 262144;
constexpr size_t WS_W = 6 * MiB;
constexpr size_t W_LAYER = 29 * MiB, W_OFF_IN = 0, W_OFF_PAB = (size_t)NZ * 1024 * 2, W_OFF_OUT = W_OFF_PAB + 2 * MiB, W_OFF_GU = W_OFF_OUT + 2 * MiB, W_OFF_D = W_OFF_GU + (size_t)NGU * 1024 * 2;
static_assert(W_OFF_D + (size_t)1024 * DFF * 2 == W_LAYER, "weight map");
constexpr size_t WS_X16 = 64 * MiB;
constexpr size_t WS_QY = 96 * MiB;
constexpr size_t WS_QI = 128 * MiB;
constexpr size_t WS_MISC = 144 * MiB;
constexpr size_t WS_KV = 152 * MiB;
constexpr size_t WS_KI = 157 * MiB;
constexpr size_t WS_X1 = 128 * MiB;
constexpr size_t WS_GATES = 160 * MiB;
constexpr size_t WS_UV = 224 * MiB;
constexpr size_t WS_ACT = 160 * MiB;
constexpr size_t WS_END = 256 * MiB;
static_assert(WS_KV + (size_t)M * KVP * 2 <= WS_KI && WS_KI + (size_t)M * 64 * 2 <= WS_GATES && WS_ACT + (size_t)M * DFF * 2 <= WS_END, "ws map");

constexpr int LDS_BYTES = 155648;
constexpr int LDS_MISC = 151552;

#define RLX_AGENT __ATOMIC_RELAXED, __HIP_MEMORY_SCOPE_AGENT
#define LDS_WAIT() asm volatile("s_waitcnt lgkmcnt(0)" ::: "memory")
#define VM_WAIT() asm volatile("s_waitcnt vmcnt(0)" ::: "memory")

#define XB_TMO      128
#define XB_XCNT(j)  (256  + 64 * (j))
#define XB_XSUB(j)  (1280 + 64 * (j))
#define XB_XGEN(j)  (2304 + 64 * (j))
#define XB_TOP      3328
#define XB_TOPGEN   3392
#define XCD_BAR_WORDS 3456
#define XB_SPIN_CAP (1u << 18)
__device__ __forceinline__ unsigned xb_ld(unsigned* p)              { return __hip_atomic_load(p, __ATOMIC_RELAXED, __HIP_MEMORY_SCOPE_AGENT); }
__device__ __forceinline__ unsigned xb_add(unsigned* p, unsigned v) { return __hip_atomic_fetch_add(p, v, __ATOMIC_RELAXED, __HIP_MEMORY_SCOPE_AGENT); }
__device__ __forceinline__ unsigned xb_xcc_id() { return (unsigned)__builtin_amdgcn_s_getreg((3 << 11) | 20) & 0xFu; }
#define XB_SPIN(cond, bar) do { unsigned _sp = 0; while (cond) { __builtin_amdgcn_s_sleep(1); \
    if ((++_sp & 255u) == 0u) { if (xb_ld(&(bar)[XB_TMO])) break; if (_sp > XB_SPIN_CAP) { atomicAdd(&(bar)[XB_TMO], 1u); break; } } } } while (0)
struct XcdBarrier { unsigned* bar; unsigned x; volatile LAS unsigned* st; };
__device__ __forceinline__ XcdBarrier xcd_barrier_post(unsigned* bar, volatile LAS unsigned* st) {
    XcdBarrier b; b.bar = bar; b.x = xb_xcc_id(); b.st = st;
    if (threadIdx.x == 0) (void)xb_add(&bar[XB_XCNT(b.x)], 1u);
    return b;
}
__device__ __forceinline__ void xcd_barrier_complete(unsigned* bar, unsigned x, unsigned& nloc, unsigned& nx) {
    const unsigned G = gridDim.x * gridDim.y * gridDim.z;
    unsigned sum, cnt, mine, sp = 0u;
    for (;;) {
        sum = 0u; cnt = 0u; mine = 0u;
#pragma unroll
        for (unsigned j = 0; j < 16; ++j) { const unsigned c = xb_ld(&bar[XB_XCNT(j)]); sum += c; cnt += (c > 0u) ? 1u : 0u; mine = (j == x) ? c : mine; }
        if (sum == G) break;
        __builtin_amdgcn_s_sleep(1);
        if ((++sp & 255u) == 0u) { if (xb_ld(&bar[XB_TMO])) break; if (sp > XB_SPIN_CAP) { atomicAdd(&bar[XB_TMO], 1u); break; } }
    }
    nloc = mine > 0u ? mine : 1u; nx = cnt > 0u ? cnt : 1u;
}
__device__ __forceinline__ void xcd_barrier(const XcdBarrier& b) {
    asm volatile("s_waitcnt vmcnt(0)" ::: "memory");
    __syncthreads();
    if (threadIdx.x == 0) {
        unsigned* bar = b.bar;
        __builtin_amdgcn_s_waitcnt(0);
        unsigned nloc = b.st[0], nx = b.st[1];
        if (nloc == 0u) { xcd_barrier_complete(bar, b.x, nloc, nx); b.st[0] = nloc; b.st[1] = nx; }
        const unsigned old = xb_add(&bar[XB_XSUB(b.x)], 1u);
        const unsigned gen = old / nloc;
        if (old + 1u == (gen + 1u) * nloc) {
            __builtin_amdgcn_fence(__ATOMIC_RELEASE, "agent");
            asm volatile("s_waitcnt vmcnt(0)" ::: "memory");
            const unsigned og = xb_add(&bar[XB_TOP], 1u);
            const unsigned tg = og / nx;
            if (og + 1u == (tg + 1u) * nx) xb_add(&bar[XB_TOPGEN], 1u);
            else XB_SPIN(xb_ld(&bar[XB_TOPGEN]) == tg, bar);
            __builtin_amdgcn_fence(__ATOMIC_ACQUIRE, "agent");
            xb_add(&bar[XB_XGEN(b.x)], 1u);
            asm volatile("s_waitcnt vmcnt(0)" ::: "memory");
        } else {
            XB_SPIN(xb_ld(&bar[XB_XGEN(b.x)]) == gen, bar);
            __builtin_amdgcn_fence(__ATOMIC_ACQUIRE, "agent");
            asm volatile("s_waitcnt vmcnt(0)" ::: "memory");
        }
    }
    __syncthreads();
}

__device__ __forceinline__ float gelu_tanh_f(float x) {
    const float u = 0.7978845608028654f * (x + 0.044715f * x * x * x);
    const float e = __builtin_amdgcn_exp2f(-2.0f * LOG2E * u);
    return x * __builtin_amdgcn_rcpf(1.0f + e);
}
__device__ __forceinline__ float sigmoid_f(float x) { return __builtin_amdgcn_rcpf(1.0f + __builtin_amdgcn_exp2f(-LOG2E * x)); }

struct Frame {
    LAS unsigned char* lds;
    int tid, lane, wave, vcu, G;
    unsigned char* ws;
    const float* const* in;
};
struct In {
    const float* x; const int* pos; const float* norm_mix; const float* w_in; const float* kv_norm; const float* w_uk; const float* w_uv; const float* ln_v_g; const float* ln_v_b;
    const float* w_s; const float* b_s; const float* w_proj_a; const float* w_proj_b; const float* w_out; const float* norm_ffn; const float* w_gate; const float* w_up; const float* w_down; const float* final_norm;
};

__device__ __constant__ float c_inv[8] = {1.0f, 0.19392274474868576f, 0.03760603093086393f, 0.007292664737217109f, 0.001414213562373095f, 0.0002742481756762073f, 5.318295896944988e-05f, 1.031338537721246e-05f};

__device__ __forceinline__ void transpose_item(const float* Wl, int Nsrc, h16* WT, int ldt, int n0, int k0, const float* gain, LAS float* scr, int lane) {
#pragma unroll 8
    for (int i = 0; i < 32; ++i) { const int kk = 2 * i + (lane >> 5); float v = Wl ? Wl[(size_t)(k0 + kk) * Nsrc] : 0.f; if (gain) v *= gain[k0 + kk]; scr[kk * 33 + (lane & 31)] = v; }
    LDS_WAIT(); asm volatile("" ::: "memory");
    const int c = lane & 7;
#pragma unroll
    for (int j = 0; j < 4; ++j) { const int n = (lane >> 3) + 8 * j; const LAS float* s = scr + (8 * c) * 33 + n;
        u32x4 o; o.x = pkh(s[0 * 33], s[1 * 33]); o.y = pkh(s[2 * 33], s[3 * 33]); o.z = pkh(s[4 * 33], s[5 * 33]); o.w = pkh(s[6 * 33], s[7 * 33]);
        *(u32x4*)(WT + (size_t)(n0 + n) * ldt + k0 + 8 * c) = o; }
    LDS_WAIT(); asm volatile("" ::: "memory");
}
__device__ __forceinline__ int win_src_col(int n) {
    if (n < 512) return n;
    if (n < 1024) return 656 + (n - 512);
    if (n < 2048) return 1240 + (n - 1024);
    if (n < 4096) return 2264 + (n - 2048);
    if (n < 4224) return 512 + (n - 4096);
    if (n < 4240) return 640 + (n - 4224);
    if (n < 4304) return 1168 + (n - 4240);
    if (n < 4312) return 1232 + (n - 4304);
    return -1;
}
__device__ __forceinline__ void p0_prologue(const Frame& F, const In& I) {
    LAS float* scr = (LAS float*)(F.lds + F.wave * 8448);
    int lane = F.lane; asm volatile("" : "+v"(lane));
    const int gw = F.vcu * NWAVES + F.wave, NGW = F.G * NWAVES;
    constexpr int I_IN = (NZ / 32) * 16, I_PA = 32 * 8, I_OUT = 32 * 16, I_GU = (NGU / 32) * 16, I_D = 32 * (DFF / 64);
    constexpr int I_LAYER = I_IN + 2 * I_PA + I_OUT + I_GU + I_D;
    for (int it = gw; it < NLAYER * I_LAYER; it += NGW) {
        const int l = it / I_LAYER; int r = it - l * I_LAYER;
        unsigned char* wl = F.ws + WS_W + (size_t)l * W_LAYER;
        if (r < I_IN) { const int nb = r / 16, kb = r % 16, sc = win_src_col(nb * 32 + (lane & 31));
            transpose_item(sc >= 0 ? I.w_in + (size_t)l * DM * DIN + sc : nullptr, DIN, (h16*)(wl + W_OFF_IN), 1024, nb * 32, kb * 64, I.norm_mix + l * DM, scr, lane); continue; }
        r -= I_IN;
        if (r < I_PA) { const int nb = r / 8, kb = r % 8;
            transpose_item(I.w_proj_a + (size_t)l * 512 * 1024 + nb * 32 + (lane & 31), 1024, (h16*)(wl + W_OFF_PAB), 1024, nb * 32, kb * 64, nullptr, scr, lane); continue; }
        r -= I_PA;
        if (r < I_PA) { const int nb = r / 8, kb = r % 8;
            transpose_item(I.w_proj_b + (size_t)l * 512 * 1024 + nb * 32 + (lane & 31), 1024, (h16*)(wl + W_OFF_PAB) + 512, 1024, nb * 32, kb * 64, nullptr, scr, lane); continue; }
        r -= I_PA;
        if (r < I_OUT) { const int nb = r / 16, kb = r % 16;
            transpose_item(I.w_out + (size_t)l * 1024 * 1024 + nb * 32 + (lane & 31), 1024, (h16*)(wl + W_OFF_OUT), 1024, nb * 32, kb * 64, nullptr, scr, lane); continue; }
        r -= I_OUT;
        if (r < I_GU) { const int nb = r / 16, kb = r % 16, R = nb * 32 + (lane & 31), pn = R >> 8, rem = R & 255;
            const int a = 128 * pn + 64 * (rem >> 7) + 16 * ((rem >> 5) & 3) + 4 * ((rem >> 3) & 3) + (rem & 3);
            const float* src = (((rem >> 2) & 1) ? I.w_up : I.w_gate) + (size_t)l * DM * DFF + a;
            transpose_item(src, DFF, (h16*)(wl + W_OFF_GU), 1024, nb * 32, kb * 64, I.norm_ffn + l * DM, scr, lane); continue; }
        r -= I_GU;
        { const int nb = r / (DFF / 64), kb = r % (DFF / 64);
            transpose_item(I.w_down + (size_t)l * DFF * 1024 + nb * 32 + (lane & 31), 1024, (h16*)(wl + W_OFF_D), DFF, nb * 32, kb * 64, nullptr, scr, lane); }
    }
    const int gt = F.vcu * NTHREADS + F.tid, NGT = F.G * NTHREADS;
    for (int i = gt; i < NLAYER * 49152; i += NGT) { const int l = i / 49152, e = i % 49152, h = e / (128 * 48), c = (e / 48) % 128, n = e % 48;
        ((h16*)(F.ws + WS_SMALLW + (size_t)l * SMALLW_LAYER))[e] = (h16)I.w_uk[(((size_t)l * 8 + h) * 48 + n) * 128 + c]; }
    for (int i = gt; i < NLAYER * 65536; i += NGT) { const int l = i / 65536, e = i % 65536, h = e / (64 * 128), d = (e / 128) % 64, c = e % 128;
        ((h16*)(F.ws + WS_SMALLW + (size_t)l * SMALLW_LAYER + 98304))[e] = (h16)I.w_uv[(((size_t)l * 8 + h) * 128 + c) * 64 + d]; }
    for (int i = gt; i < NLAYER * 131072; i += NGT) { const int l = i / 131072, e = i % 131072, t = (e / 128) % 128, s = e % 128;
        ((h16*)(F.ws + WS_SMALLW + (size_t)l * SMALLW_LAYER + 98304 + 131072))[e] = (s <= t) ? (h16)I.w_s[(size_t)l * 131072 + e] : (h16)0.f; }
    for (int i = gt; i < M * 8; i += NGT) { const int tok = i >> 3, f = i & 7; const float ang = (float)I.pos[tok] * c_inv[f];
        float* cs = (float*)(F.ws + WS_CS) + (size_t)tok * 16; cs[f] = cosf(ang); cs[8 + f] = sinf(ang); }
    for (int m = gw; m < M; m += NGW) {
        const f32x4* xr = (const f32x4*)(I.x + (size_t)m * DM) + lane; u32x2* o8 = (u32x2*)((h16*)(F.ws + WS_X16) + (size_t)m * DM) + lane;
#pragma unroll
        for (int j = 0; j < 4; ++j) { const f32x4 v = xr[64 * j]; float s = (v.x * v.x + v.y * v.y) + (v.z * v.z + v.w * v.w);
#pragma unroll
            for (int o = 1; o < 64; o <<= 1) s += __shfl_xor(s, o);
            o8[64 * j] = (u32x2){pkh(v.x, v.y), pkh(v.z, v.w)};
            if (lane == 0) ((float*)(F.ws + WS_SSQ))[(size_t)m * 4 + j] = s; }
    }
}

__device__ __forceinline__ float row_rstd(const float* ssq, int row) {
    const f32x4 a = *(const f32x4*)(ssq + (size_t)row * 4);
    return rsqrtf(((a.x + a.y) + (a.z + a.w)) * (1.0f / DM) + EPS_RMS);
}

typedef f32x4 Acc[2][2][4][2];

struct EpiA {
    static constexpr bool PERM = true;
    unsigned char* ws;
    __device__ __forceinline__ void operator()(Acc& acc, const pg8::Unit& u, int wr, int wc, int fr, int fq) const {
        const int pn = u.pn; h16* base; int ldc, colt; bool act = false;
        if (pn < 2) { base = (h16*)(ws + WS_QY); ldc = 1024; colt = pn * 256; }
        else if (pn < 4) { base = (h16*)(ws + WS_QI); ldc = 512; colt = (pn - 2) * 256; }
        else if (pn < 8) { base = (h16*)(ws + WS_UV); ldc = 1024; colt = (pn - 4) * 256; act = true; }
        else if (pn < 16) { base = (h16*)(ws + WS_GATES); ldc = 2048; colt = (pn - 8) * 256; }
        else { base = (h16*)(ws + WS_MISC); ldc = 256; colt = 0; }
        const int row0 = u.pm * 256 + wr * 64 + fr, col0 = colt + wc * 32 + 8 * fq;
        const float* ssq = (const float*)(ws + WS_SSQ);
#pragma unroll
        for (int ai = 0; ai < 2; ++ai)
#pragma unroll
            for (int m = 0; m < 4; ++m) { const int row = row0 + ai * 128 + m * 16; const float rs = row_rstd(ssq, row); h16* rowp = base + (size_t)row * ldc + col0;
#pragma unroll
                for (int bj = 0; bj < 2; ++bj) { f32x4 v0 = acc[ai][bj][m][0] * rs, v1 = acc[ai][bj][m][1] * rs;
                    if (act) {
#pragma unroll
                        for (int i = 0; i < 4; ++i) { v0[i] = gelu_tanh_f(v0[i]); v1[i] = gelu_tanh_f(v1[i]); } }
                    u32x4 w; w.x = pkh(v0[0], v0[1]); w.y = pkh(v0[2], v0[3]); w.z = pkh(v1[0], v1[1]); w.w = pkh(v1[2], v1[3]);
                    *(u32x4*)(rowp + bj * 128) = w; }
                asm volatile("" ::: "memory"); }
    }
};

struct EpiD {
    static constexpr bool PERM = true;
    unsigned char* ws;
    __device__ __forceinline__ void operator()(Acc& acc, const pg8::Unit& u, int wr, int wc, int fr, int fq) const {
        const int row0 = u.pm * 256 + wr * 64 + fr, col0 = u.pn * 256 + wc * 32 + 8 * fq;
        const h16* gates = (const h16*)(ws + WS_GATES); h16* mg = (h16*)(ws + WS_X16);
#pragma unroll
        for (int ai = 0; ai < 2; ++ai)
#pragma unroll
            for (int m = 0; m < 4; ++m) { const int row = row0 + ai * 128 + m * 16;
#pragma unroll
                for (int bj = 0; bj < 2; ++bj) { const int col = col0 + bj * 128;
                    const h16x8 gb = *(const h16x8*)(gates + (size_t)row * 2048 + 1024 + col);
                    if (u.kind == 0) { const h16x8 ga = *(const h16x8*)(gates + (size_t)row * 2048 + col);
#pragma unroll
                        for (int i = 0; i < 8; ++i) { const float a = fminf(fmaxf((float)ga[i], -30.f), 30.f), b = fminf(fmaxf((float)gb[i], -30.f), 30.f);
                            const float ratio = (1.0f + __builtin_amdgcn_exp2f(-LOG2E * b)) * __builtin_amdgcn_rcpf(1.0f + __builtin_amdgcn_exp2f(-LOG2E * a));
                            acc[ai][bj][m][i >> 2][i & 3] *= ratio; }
                    } else { float v[8];
#pragma unroll
                        for (int i = 0; i < 8; ++i) { const float b = fminf(fmaxf((float)gb[i], -30.f), 30.f); v[i] = acc[ai][bj][m][i >> 2][i & 3] * sigmoid_f(b); }
                        u32x4 w; w.x = pkh(v[0], v[1]); w.y = pkh(v[2], v[3]); w.z = pkh(v[4], v[5]); w.w = pkh(v[6], v[7]);
                        *(u32x4*)(mg + (size_t)row * 1024 + col) = w; } }
                asm volatile("" ::: "memory"); }
    }
};

struct EpiRes {
    static constexpr bool PERM = false;
    const float* resid; float* out; h16* x16; float* ssq; LAS float* P;
    __device__ __forceinline__ void operator()(Acc& acc, const pg8::Unit& u, int wr, int wc, int fr, int fq) const {
        const int row0 = u.pm * 256 + wr * 64 + fr, col0 = u.pn * 256 + wc * 32 + 4 * fq;
#pragma unroll
        for (int ai = 0; ai < 2; ++ai)
#pragma unroll
            for (int m = 0; m < 4; ++m) { const int row = row0 + ai * 128 + m * 16; float ss = 0.f;
#pragma unroll
                for (int bj = 0; bj < 2; ++bj)
#pragma unroll
                    for (int n = 0; n < 2; ++n) { const size_t off = (size_t)row * 1024 + col0 + bj * 128 + n * 16;
                        const f32x4 v = *(const f32x4*)(resid + off) + acc[ai][bj][m][n];
                        *(f32x4*)(out + off) = v; *(u32x2*)(x16 + off) = (u32x2){pkh(v[0], v[1]), pkh(v[2], v[3])};
                        ss += (v[0] * v[0] + v[1] * v[1]) + (v[2] * v[2] + v[3] * v[3]); }
                ss += __shfl_xor(ss, 16); ss += __shfl_xor(ss, 32);
                if (fq == 0) P[(ai * 128 + wr * 64 + m * 16 + fr) * 4 + wc] = ss;
                asm volatile("" ::: "memory"); }
        asm volatile("s_waitcnt lgkmcnt(0)" ::: "memory"); __builtin_amdgcn_s_barrier(); asm volatile("" ::: "memory");
        { const int t = (wr * 4 + wc) * 64 + fq * 16 + fr; if (t < 256) { const f32x4 v = *(const LAS f32x4*)(P + t * 4); ssq[(size_t)(u.pm * 256 + t) * 4 + u.pn] = (v.x + v.y) + (v.z + v.w); } }
        asm volatile("s_waitcnt lgkmcnt(0)" ::: "memory"); __builtin_amdgcn_s_barrier(); asm volatile("" ::: "memory");
    }
};

struct EpiF {
    static constexpr bool PERM = true;
    unsigned char* ws;
    __device__ __forceinline__ void operator()(Acc& acc, const pg8::Unit& u, int wr, int wc, int fr, int fq) const {
        const int row0 = u.pm * 256 + wr * 64 + fr, col0 = u.pn * 128 + wc * 16 + 4 * fq;
        const float* ssq = (const float*)(ws + WS_SSQ); h16* act = (h16*)(ws + WS_ACT);
#pragma unroll
        for (int ai = 0; ai < 2; ++ai)
#pragma unroll
            for (int m = 0; m < 4; ++m) { const int row = row0 + ai * 128 + m * 16; const float rs = row_rstd(ssq, row);
#pragma unroll
                for (int bj = 0; bj < 2; ++bj) { const f32x4 g = acc[ai][bj][m][0] * rs, uu = acc[ai][bj][m][1] * rs; float v[4];
#pragma unroll
                    for (int i = 0; i < 4; ++i) v[i] = g[i] * sigmoid_f(g[i]) * uu[i];
                    *(u32x2*)(act + (size_t)row * DFF + col0 + bj * 64) = (u32x2){pkh(v[0], v[1]), pkh(v[2], v[3])}; }
                asm volatile("" ::: "memory"); }
    }
};

__device__ __forceinline__ void final_norm_phase(const Frame& F, float* out, const float* g) {
    int lane = F.lane; asm volatile("" : "+v"(lane));
    const int gw = F.vcu * NWAVES + F.wave, NGW = F.G * NWAVES;
    for (int m = gw; m < M; m += NGW) {
        f32x4* xr = (f32x4*)(out + (size_t)m * DM) + lane; f32x4 v[4]; float s = 0.f;
#pragma unroll
        for (int j = 0; j < 4; ++j) { v[j] = xr[64 * j]; s += (v[j].x * v[j].x + v[j].y * v[j].y) + (v[j].z * v[j].z + v[j].w * v[j].w); }
#pragma unroll
        for (int o = 1; o < 64; o <<= 1) s += __shfl_xor(s, o);
        const float rs = rsqrtf(s * (1.0f / DM) + EPS_RMS);
#pragma unroll
        for (int j = 0; j < 4; ++j) { const f32x4 gg = ((const f32x4*)g)[lane + 64 * j]; xr[64 * j] = v[j] * rs * gg; }
    }
}
__device__ __forceinline__ unsigned wlane(unsigned val, int ln, unsigned old) {
    unsigned keep;
    asm volatile("s_mov_b32 %1, m0\n\ts_mov_b32 m0, %3\n\ts_nop 3\n\tv_writelane_b32 %0, %2, m0\n\ts_mov_b32 m0, %1" : "+v"(old), "=&s"(keep) : "s"(val), "s"(ln));
    return old;
}
__device__ __forceinline__ int crow(int R, int hf) { return (R & 3) + 8 * (R >> 2) + 4 * hf; }
__device__ __forceinline__ float half_swap_max(float v) { auto rr = __builtin_amdgcn_permlane32_swap(__float_as_uint(v), __float_as_uint(v), false, false); return fmaxf(__uint_as_float(rr[0]), __uint_as_float(rr[1])); }
__device__ __forceinline__ float half_swap_sum(float v) { auto rr = __builtin_amdgcn_permlane32_swap(__float_as_uint(v), __float_as_uint(v), false, false); return __uint_as_float(rr[0]) + __uint_as_float(rr[1]); }
__device__ __forceinline__ void rope8(const h16x8 x1, const h16x8 x2, const float* cs, int which, float scale, float (&o)[8]) {
    const f32x4 c0 = *(const f32x4*)(cs), c1 = *(const f32x4*)(cs + 4), s0 = *(const f32x4*)(cs + 8), s1 = *(const f32x4*)(cs + 12);
#pragma unroll
    for (int j = 0; j < 8; ++j) { const float c = j < 4 ? c0[j & 3] : c1[j & 3], s = j < 4 ? s0[j & 3] : s1[j & 3]; const float a = (float)x1[j], b = (float)x2[j];
        o[j] = (which == 0 ? (a * c - b * s) : (b * c + a * s)) * scale; }
}
__device__ __forceinline__ u32x4 pack8(const float (&v)[8]) { u32x4 w; w.x = pkh(v[0], v[1]); w.y = pkh(v[2], v[3]); w.z = pkh(v[4], v[5]); w.w = pkh(v[6], v[7]); return w; }

__device__ __forceinline__ void phaseB(const Frame& F, const In& I, int l) {
    unsigned char* ws = F.ws; asm volatile("" : "+s"(ws)); int lane = F.lane, tid = F.tid; asm volatile("" : "+v"(lane), "+v"(tid)); const int w = F.wave;
    const h16* MISC = (const h16*)(ws + WS_MISC); h16* KV = (h16*)(ws + WS_KV); h16* KI = (h16*)(ws + WS_KI); float* WI = (float*)(ws + WS_WI); const float* CS = (const float*)(ws + WS_CS);
    const int blk = F.vcu;
#pragma unroll 1
    for (int it = 0; it < 2; ++it) {
        const int tok = blk * 64 + w * 8 + it * 4 + (lane >> 4), i = lane & 15;
        const h16* mr = MISC + (size_t)tok * 256; const float* cs = CS + (size_t)tok * 16;
        const h16x8 x = *(const h16x8*)(mr + 8 * i);
        float ss = 0.f;
#pragma unroll
        for (int j = 0; j < 8; ++j) ss += (float)x[j] * (float)x[j];
        ss += __shfl_xor(ss, 1); ss += __shfl_xor(ss, 2); ss += __shfl_xor(ss, 4); ss += __shfl_xor(ss, 8);
        const float rs = rsqrtf(ss * (1.0f / 128.f) + EPS_RMS);
        { float o[8]; const float* kn = I.kv_norm + l * 128 + 8 * i;
#pragma unroll
          for (int j = 0; j < 8; ++j) o[j] = (float)x[j] * rs * kn[j];
          *(u32x4*)(KV + (size_t)tok * KVP + 8 * i) = pack8(o); }
        if (i < 2) { float o[8]; rope8(*(const h16x8*)(mr + 128), *(const h16x8*)(mr + 136), cs, i, 1.0f, o); *(u32x4*)(KV + (size_t)tok * KVP + 128 + 8 * i) = pack8(o); }
        else if (i == 2) { *(u32x4*)(KV + (size_t)tok * KVP + 144) = (u32x4){0u, 0u, 0u, 0u}; }
        else if (i < 11) { const int ii = i - 3;
            if (ii < 2) { float o[8]; rope8(*(const h16x8*)(mr + 144), *(const h16x8*)(mr + 152), cs, ii, 1.0f, o); *(u32x4*)(KI + (size_t)tok * 64 + 8 * ii) = pack8(o); }
            else *(u32x4*)(KI + (size_t)tok * 64 + 8 * ii) = *(const u32x4*)(mr + 144 + 8 * ii); }
        else if (i == 11) { const h16x8 wv = *(const h16x8*)(mr + 208); const float sc = 0.35355339059327373f * 0.125f;
            *(f32x4*)(WI + (size_t)tok * 8) = (f32x4){(float)wv[0] * sc, (float)wv[1] * sc, (float)wv[2] * sc, (float)wv[3] * sc};
            *(f32x4*)(WI + (size_t)tok * 8 + 4) = (f32x4){(float)wv[4] * sc, (float)wv[5] * sc, (float)wv[6] * sc, (float)wv[7] * sc}; }
    }
    const int b = blk >> 5, chunk = (blk >> 1) & 15, gh = blk & 1;
    const size_t tok0 = (size_t)b * SEQ + chunk * 128;
    const h16* UV = (const h16*)(ws + WS_UV); h16* QY = (h16*)(ws + WS_QY);
    LAS float* MU = (LAS float*)(F.lds); LAS float* RS = MU + 128; LAS h16* VNT = (LAS h16*)(F.lds + 1024);
    constexpr int VP = 136;
#pragma unroll 1
    for (int rr = 0; rr < 16; ++rr) { const int t = 16 * w + rr; const h16x8 v = *(const h16x8*)(UV + (tok0 + t) * 1024 + 512 + 8 * lane);
        float s = 0.f;
#pragma unroll
        for (int j = 0; j < 8; ++j) s += (float)v[j];
#pragma unroll
        for (int o = 1; o < 64; o <<= 1) s += __shfl_xor(s, o);
        const float mu = s * (1.0f / 512.f); float q = 0.f;
#pragma unroll
        for (int j = 0; j < 8; ++j) { const float d = (float)v[j] - mu; q += d * d; }
#pragma unroll
        for (int o = 1; o < 64; o <<= 1) q += __shfl_xor(q, o);
        if (lane == 0) { MU[t] = mu; RS[t] = rsqrtf(q * (1.0f / 512.f) + 1e-5f); } }
    LDS_WAIT(); __syncthreads();
#pragma unroll 1
    for (int itx = 0; itx < 8; ++itx) { const int p = tid + 512 * itx, t = p >> 5, c0 = (p & 31) * 8, col = 256 * gh + c0;
        const h16x8 v = *(const h16x8*)(UV + (tok0 + t) * 1024 + 512 + col); const float mu = MU[t], rs = RS[t];
        const float* lg = I.ln_v_g + l * 512 + col; const float* lb = I.ln_v_b + l * 512 + col;
#pragma unroll
        for (int j = 0; j < 8; ++j) { const int c = c0 + j; VNT[((c >> 6) * 64 + (c & 63)) * VP + t] = (h16)(((float)v[j] - mu) * rs * lg[j] + lb[j]); } }
    LDS_WAIT(); __syncthreads();
    { const int gp = w & 3, g = 4 * gh + gp, rh = w >> 2, r = lane & 31, hf = lane >> 5;
      const h16* WS16 = (const h16*)(ws + WS_SMALLW + (size_t)l * SMALLW_LAYER + 98304 + 131072) + (size_t)g * 128 * 128;
#pragma unroll 1
      for (int tb = 0; tb < 2; ++tb) { const int trow0 = 64 * rh + 32 * tb; const int nks = 4 * rh + 2 * tb + 2;
#pragma unroll 1
        for (int db = 0; db < 2; ++db) { f32x16 D = {};
#pragma unroll
            for (int s = 0; s < 8; ++s) if (s < nks) {
                const h16x8 a = *(const h16x8*)(WS16 + (size_t)(trow0 + r) * 128 + 16 * s + 8 * hf);
                const h16x8 bb = *(const LAS h16x8*)(VNT + (gp * 64 + 32 * db + r) * VP + 16 * s + 8 * hf);
                D = __builtin_amdgcn_mfma_f32_32x32x16_f16(a, bb, D, 0, 0, 0); }
#pragma unroll
            for (int R = 0; R < 16; ++R) { const int t = trow0 + crow(R, hf); const size_t tk = tok0 + t; const int d = g * 64 + 32 * db + r;
                const float sv = D[R] + I.b_s[((size_t)l * 8 + g) * 128 + t];
                const float u = (float)UV[tk * 1024 + d];
                QY[tk * 1024 + 512 + d] = (h16)(u * sv); } } } }
    __syncthreads();
}

constexpr int C_KIB = 0, C_KIP = 144;
constexpr int C_QL = 0, C_QLW = KVP * 2 * 32;
constexpr int C_WQ = 81920;
constexpr int C_KVS = 90112, C_KVSLOT = 32 * KVP * 2;

__device__ __forceinline__ void phaseC_select(const Frame& F, int l, int b, int qt) {
    unsigned char* ws = F.ws; asm volatile("" : "+s"(ws)); int lane = F.lane, tid = F.tid; asm volatile("" : "+v"(lane), "+v"(tid)); const int w = F.wave, r = lane & 31, hf = lane >> 5;
    const h16* QI = (const h16*)(ws + WS_QI); const h16* KI = (const h16*)(ws + WS_KI); const float* WI = (const float*)(ws + WS_WI); const float* CS = (const float*)(ws + WS_CS);
    h16* QY = (h16*)(ws + WS_QY); const h16* KV = (const h16*)(ws + WS_KV);
    const h16* WUKT = (const h16*)(ws + WS_SMALLW + (size_t)l * SMALLW_LAYER); const h16* WUVT = (const h16*)(ws + WS_SMALLW + (size_t)l * SMALLW_LAYER + 98304);
    LAS unsigned char* lds = F.lds;
    const int t0 = 32 * qt, NT = qt + 1; const size_t tokbase = (size_t)b * SEQ;
    h16x8 afr[4]; float wreg[16];
    { const int qq = 2 * ((r >> 2) & 1) + (r >> 4), head = (r & 3) + 4 * ((r >> 3) & 1); const size_t tokA = tokbase + t0 + 4 * w + qq;
      const h16* qsrc = QI + tokA * 512 + head * 64;
      { float o[8]; rope8(*(const h16x8*)(qsrc), *(const h16x8*)(qsrc + 8), CS + tokA * 16, hf, 1.0f, o); afr[0] = __builtin_bit_cast(h16x8, pack8(o)); }
#pragma unroll
      for (int s = 1; s < 4; ++s) afr[s] = *(const h16x8*)(qsrc + 16 * s + 8 * hf);
      const float* wp = WI + (tokbase + t0 + 4 * w + 2 * hf) * 8;
#pragma unroll
      for (int R = 0; R < 16; ++R) wreg[R] = wp[R]; }
    float SC[128];
#pragma unroll
    for (int i = 0; i < 128; ++i) SC[i] = -INFINITY;
    const int NCK = (NT + 7) >> 3, tq0 = t0 + 4 * w + 2 * hf;
#pragma unroll 1
    for (int ck = 0; ck < NCK; ++ck) {
        if (ck > 0) __syncthreads();
#pragma unroll
        for (int i = 0; i < 4; ++i) { const int p = tid + 512 * i, row = p >> 3, ch = p & 7;
            const u32x4 v = *(const u32x4*)(KI + (tokbase + 256 * ck + row) * 64 + 8 * ch); *(LAS u32x4*)(lds + C_KIB + row * C_KIP + ch * 16) = v; }
        LDS_WAIT(); __syncthreads();
#pragma unroll
        for (int i = 0; i < 112; ++i) SC[i] = SC[i + 16];
#pragma unroll
        for (int jj = 0; jj < 8; ++jj) {
            f32x16 D = {};
#pragma unroll
            for (int s = 0; s < 4; ++s) { const h16x8 bb = *(const LAS h16x8*)(lds + C_KIB + (32 * jj + r) * C_KIP + 32 * s + 16 * hf); D = __builtin_amdgcn_mfma_f32_32x32x16_f16(afr[s], bb, D, 0, 0, 0); }
            float s0 = 0.f, s1 = 0.f;
#pragma unroll
            for (int R = 0; R < 8; ++R) { s0 = fmaf(wreg[R], fmaxf(D[R], 0.f), s0); s1 = fmaf(wreg[8 + R], fmaxf(D[8 + R], 0.f), s1); }
            const int k = 256 * ck + 32 * jj + r;
            SC[112 + 2 * jj] = (k > tq0) ? -INFINITY : s0; SC[113 + 2 * jj] = (k > tq0 + 1) ? -INFINITY : s1;
        }
    }
    const int G0 = 8 - NCK;
    float tau0 = -3.0e38f, tau1 = -3.0e38f;
    if (qt >= 8) {
        float lo0 = INFINITY, lo1 = INFINITY, hi0 = -INFINITY, hi1 = -INFINITY;
#pragma unroll
        for (int j = 0; j < 64; ++j) { const float a = SC[2 * j], c = SC[2 * j + 1];
            lo0 = fminf(lo0, a == -INFINITY ? INFINITY : a); hi0 = fmaxf(hi0, a); lo1 = fminf(lo1, c == -INFINITY ? INFINITY : c); hi1 = fmaxf(hi1, c); }
#pragma unroll
        for (int o = 1; o < 32; o <<= 1) { lo0 = fminf(lo0, __shfl_xor(lo0, o)); lo1 = fminf(lo1, __shfl_xor(lo1, o)); hi0 = fmaxf(hi0, __shfl_xor(hi0, o)); hi1 = fmaxf(hi1, __shfl_xor(hi1, o)); }
        bool done0 = false, done1 = false;
#pragma unroll 1
        for (int it = 0; it < 64; ++it) {
            const float mid0 = 0.5f * (lo0 + hi0), mid1 = 0.5f * (lo1 + hi1);
            if (!done0 && (mid0 <= lo0 || mid0 >= hi0)) done0 = true;
            if (!done1 && (mid1 <= lo1 || mid1 >= hi1)) done1 = true;
            if (__all(done0 && done1)) break;
            int c0 = 0, c1 = 0;
#pragma unroll
            for (int g = 0; g < 8; ++g) if (g >= G0) {
#pragma unroll
                for (int jj = 0; jj < 8; ++jj) { const int j = 8 * g + jj; c0 += (SC[2 * j] >= mid0) ? 1 : 0; c1 += (SC[2 * j + 1] >= mid1) ? 1 : 0; } }
#pragma unroll
            for (int o = 1; o < 32; o <<= 1) { c0 += __shfl_xor(c0, o); c1 += __shfl_xor(c1, o); }
            if (!done0) { if (c0 >= 256) { lo0 = mid0; if (c0 == 256) done0 = true; } else hi0 = mid0; }
            if (!done1) { if (c1 >= 256) { lo1 = mid1; if (c1 == 256) done1 = true; } else hi1 = mid1; }
        }
        tau0 = lo0; tau1 = lo1;
    }
    unsigned w00 = 0u, w01 = 0u, w10 = 0u, w11 = 0u;
#pragma unroll
    for (int g = 0; g < 8; ++g) if (g >= G0) {
#pragma unroll
        for (int jj = 0; jj < 8; ++jj) { const int j = 8 * g + jj, jt = 8 * (g - G0) + jj;
            const unsigned long long m0 = __ballot(SC[2 * j] >= tau0), m1 = __ballot(SC[2 * j + 1] >= tau1);
            w00 = wlane((unsigned)m0, jt, w00); w10 = wlane((unsigned)(m0 >> 32), jt, w10);
            w01 = wlane((unsigned)m1, jt, w01); w11 = wlane((unsigned)(m1 >> 32), jt, w11); } }
    { LAS unsigned* WQ = (LAS unsigned*)(lds + C_WQ);
      WQ[(4 * w + 0) * 64 + lane] = w00; WQ[(4 * w + 1) * 64 + lane] = w01; WQ[(4 * w + 2) * 64 + lane] = w10; WQ[(4 * w + 3) * 64 + lane] = w11; }
    LDS_WAIT(); __syncthreads();
}

__device__ __forceinline__ void phaseC_attn(const Frame& F, int l, int b, int qt) {
    unsigned char* ws = F.ws; asm volatile("" : "+s"(ws)); const int w = F.wave;
    int lane = F.lane, tid = F.tid; asm volatile("" : "+v"(lane), "+v"(tid));
    const int r = lane & 31, hf = lane >> 5;
    const float* CS = (const float*)(ws + WS_CS);
    h16* QY = (h16*)(ws + WS_QY); const h16* KV = (const h16*)(ws + WS_KV);
    const h16* WUKT = (const h16*)(ws + WS_SMALLW + (size_t)l * SMALLW_LAYER); const h16* WUVT = (const h16*)(ws + WS_SMALLW + (size_t)l * SMALLW_LAYER + 98304);
    LAS unsigned char* lds = F.lds;
    const int t0 = 32 * qt, NT = qt + 1; const size_t tokbase = (size_t)b * SEQ;
    const int h = w; const size_t tokQ = tokbase + t0 + r;
    LAS h16* ql = (LAS h16*)(lds + C_QL + w * C_QLW);
    { h16x8 bq[3];
#pragma unroll
      for (int s = 0; s < 3; ++s) bq[s] = *(const h16x8*)(QY + tokQ * 1024 + h * 64 + 16 + 16 * s + 8 * hf);
#pragma unroll
      for (int cb = 0; cb < 4; ++cb) { f32x16 D = {};
#pragma unroll
          for (int s = 0; s < 3; ++s) { const h16x8 a = *(const h16x8*)(WUKT + ((size_t)(h * 128 + 32 * cb + r)) * 48 + 16 * s + 8 * hf); D = __builtin_amdgcn_mfma_f32_32x32x16_f16(a, bq[s], D, 0, 0, 0); }
#pragma unroll
          for (int g = 0; g < 4; ++g) { const int c = 32 * cb + 8 * g + 4 * hf;
              *(LAS u32x2*)(ql + r * KVP + c) = (u32x2){pkh(D[4 * g] * QSCALE, D[4 * g + 1] * QSCALE), pkh(D[4 * g + 2] * QSCALE, D[4 * g + 3] * QSCALE)}; } }
      { float o[8]; rope8(*(const h16x8*)(QY + tokQ * 1024 + h * 64), *(const h16x8*)(QY + tokQ * 1024 + h * 64 + 8), CS + tokQ * 16, hf, QSCALE, o); *(LAS u32x4*)(ql + r * KVP + 128 + 8 * hf) = pack8(o); } }
    LDS_WAIT();
    h16x8 qfr[9];
#pragma unroll
    for (int s = 0; s < 9; ++s) qfr[s] = *(const LAS h16x8*)(ql + r * KVP + 16 * s + 8 * hf);
    const h16* kvsrc = KV + tokbase * KVP;
    u32x4 kvA, kvB = {0u, 0u, 0u, 0u};
    kvA = *(const u32x4*)((const char*)kvsrc + (size_t)tid * 16); if (tid < 96) kvB = *(const u32x4*)((const char*)kvsrc + (size_t)(512 + tid) * 16);
    *(LAS u32x4*)(lds + C_KVS + tid * 16) = kvA; if (tid < 96) *(LAS u32x4*)(lds + C_KVS + (512 + tid) * 16) = kvB;
    LDS_WAIT(); __syncthreads();
    float mrun = -INFINITY, lrun = 0.f; f32x16 O[4];
#pragma unroll
    for (int db = 0; db < 4; ++db) O[db] = (f32x16){};
    const LAS unsigned* WQr = (const LAS unsigned*)(lds + C_WQ) + r * 64;
    const int troff = ((lane & 15) >> 2) * (KVP * 2) + (16 * ((lane >> 4) & 1) + 4 * (lane & 3)) * 2 + 4 * hf * (KVP * 2);
#pragma unroll 1
    for (int j = 0; j < NT; ++j) {
        if (j + 1 < NT) { const char* src = (const char*)kvsrc + (size_t)(j + 1) * C_KVSLOT; kvA = *(const u32x4*)(src + (size_t)tid * 16); if (tid < 96) kvB = *(const u32x4*)(src + (size_t)(512 + tid) * 16); }
        LAS unsigned char* slot = lds + C_KVS + (j & 1) * C_KVSLOT;
        f32x16 S = {};
#pragma unroll
        for (int s = 0; s < 9; ++s) { const h16x8 a = *(const LAS h16x8*)(slot + r * (KVP * 2) + 32 * s + 16 * hf); S = __builtin_amdgcn_mfma_f32_32x32x16_f16(a, qfr[s], S, 0, 0, 0); }
        float mt = S[0];
#pragma unroll
        for (int R = 1; R < 16; ++R) mt = fmaxf(mt, S[R]);
        mt = half_swap_max(mt);
        if (__any(mt > mrun + 8.0f)) { const float mnew = fmaxf(mrun, mt), alpha = __builtin_amdgcn_exp2f(mrun - mnew);
#pragma unroll
            for (int db = 0; db < 4; ++db) O[db] = O[db] * alpha;
            lrun *= alpha; mrun = mnew; }
        const unsigned wq = WQr[j] >> (4 * hf);
        float p[16];
#pragma unroll
        for (int R = 0; R < 16; ++R) { const float e = __builtin_amdgcn_exp2f(S[R] - mrun); p[R] = ((wq >> ((R & 3) + 8 * (R >> 2))) & 1u) ? e : 0.f; lrun += p[R]; }
        h16x8 pf[2];
#pragma unroll
        for (int sp = 0; sp < 2; ++sp) { u32x4 t; t.x = pkh(p[8 * sp], p[8 * sp + 1]); t.y = pkh(p[8 * sp + 2], p[8 * sp + 3]); t.z = pkh(p[8 * sp + 4], p[8 * sp + 5]); t.w = pkh(p[8 * sp + 6], p[8 * sp + 7]); pf[sp] = __builtin_bit_cast(h16x8, t); }
#pragma unroll
        for (int db = 0; db < 4; ++db)
#pragma unroll
            for (int sp = 0; sp < 2; ++sp) {
                const v4i16_t lo = __builtin_amdgcn_ds_read_tr16_b64_v4i16((LAS v4i16_t*)(slot + troff + (16 * sp) * (KVP * 2) + 64 * db));
                const v4i16_t hi = __builtin_amdgcn_ds_read_tr16_b64_v4i16((LAS v4i16_t*)(slot + troff + (16 * sp + 8) * (KVP * 2) + 64 * db));
                typedef short s16x8 __attribute__((ext_vector_type(8)));
                const s16x8 av = {lo[0], lo[1], lo[2], lo[3], hi[0], hi[1], hi[2], hi[3]};
                O[db] = __builtin_amdgcn_mfma_f32_32x32x16_f16(__builtin_bit_cast(h16x8, av), pf[sp], O[db], 0, 0, 0); }
        if (j + 1 < NT) { LAS unsigned char* nslot = lds + C_KVS + ((j + 1) & 1) * C_KVSLOT; *(LAS u32x4*)(nslot + tid * 16) = kvA; if (tid < 96) *(LAS u32x4*)(nslot + (512 + tid) * 16) = kvB; }
        LDS_WAIT(); __syncthreads();
    }
    { const float inv = 1.0f / half_swap_sum(lrun);
#pragma unroll
      for (int db = 0; db < 4; ++db)
#pragma unroll
          for (int g = 0; g < 4; ++g) { const int c = 32 * db + 8 * g + 4 * hf;
              *(LAS u32x2*)(ql + r * KVP + c) = (u32x2){pkh(O[db][4 * g] * inv, O[db][4 * g + 1] * inv), pkh(O[db][4 * g + 2] * inv, O[db][4 * g + 3] * inv)}; } }
    LDS_WAIT();
    { h16x8 ao[8];
#pragma unroll
      for (int s = 0; s < 8; ++s) ao[s] = *(const LAS h16x8*)(ql + r * KVP + 16 * s + 8 * hf);
#pragma unroll
      for (int d2 = 0; d2 < 2; ++d2) { f32x16 D = {};
#pragma unroll
          for (int s = 0; s < 8; ++s) { const h16x8 bw = *(const h16x8*)(WUVT + ((size_t)(h * 64 + 32 * d2 + r)) * 128 + 16 * s + 8 * hf); D = __builtin_amdgcn_mfma_f32_32x32x16_f16(ao[s], bw, D, 0, 0, 0); }
#pragma unroll
          for (int R = 0; R < 16; ++R) QY[(tokbase + t0 + crow(R, hf)) * 1024 + h * 64 + 32 * d2 + r] = (h16)D[R]; } }
    LDS_WAIT(); __syncthreads();
}

__device__ __forceinline__ void phaseC(const Frame& F, int l) {
    const int b = F.vcu >> 5, i = F.vcu & 31;
#pragma unroll 1
    for (int u = 0; u < 2; ++u) { const int qt = (u == 0) ? 63 - i : i; phaseC_select(F, l, b, qt); phaseC_attn(F, l, b, qt); }
}
#ifndef MK_N_LAUNCHES
#define MK_N_LAUNCHES 1
#endif
constexpr int N_PHASES = 2 + 7 * NLAYER;
struct Args { In in; float* out; unsigned char* ws; int ph_lo, ph_hi; };

__global__ void __launch_bounds__(NTHREADS, 2) mk_fwd(Args args) {
    extern __shared__ __attribute__((aligned(16))) unsigned char lds_raw[];
    Frame F; F.lds = (LAS unsigned char*)lds_raw; F.tid = threadIdx.x; F.lane = F.tid & 63; F.wave = __builtin_amdgcn_readfirstlane(F.tid >> 6);
    F.G = gridDim.x; { const int bx = blockIdx.x; F.vcu = (F.G % 8 == 0) ? (bx % 8) * (F.G / 8) + bx / 8 : bx; }
    F.ws = args.ws; F.in = nullptr;
    const In& I = args.in; unsigned char* ws = args.ws; (void)ws;
    volatile LAS unsigned* MISCW = (volatile LAS unsigned*)(F.lds + LDS_MISC);
    if (F.tid < 64) MISCW[F.tid] = 0u;
    __syncthreads();
    const bool one_launch = (args.ph_hi - args.ph_lo) > 1;
    XcdBarrier bar; bar.bar = (unsigned*)(ws + WS_CTL) + 1024; bar.x = 0; bar.st = nullptr;
    if (one_launch) bar = xcd_barrier_post((unsigned*)(ws + WS_CTL) + 1024, MISCW + 8);
#define IN(k) (args.ph_lo <= (k) && (k) < args.ph_hi)
#define SEAM(k) do { if (IN(k) && IN((k) + 1)) xcd_barrier(bar); } while (0)
    if (IN(0)) { p0_prologue(F, I); SEAM(0); }
#define OPQ(x) asm volatile("" : "+s"(x))
#pragma unroll 1
    for (int l0 = 0; l0 < NLAYER; ++l0) {
        const int p = 1 + 7 * l0;
        if (IN(p)) {
            unsigned char* wsq = args.ws; int l = l0; OPQ(wsq); OPQ(l); unsigned char* wl = wsq + WS_W + (size_t)l * W_LAYER;
            pg8::Gemm g{(const h16*)(wsq + WS_X16), (const h16*)(wl + W_OFF_IN), 1024, 1024, 1024, M / 256, NZ / 256, 1, 0};
            pg8::Order S; S.init(g.nM, g.nN, F.G, (int)blockIdx.x, 1); EpiA E{wsq};
            pg8::gemm_phase<EpiA>(F.lds, g, S, E); SEAM(p); }
        if (IN(p + 1)) { int l = l0; OPQ(l); phaseB(F, I, l); SEAM(p + 1); }
        if (IN(p + 2)) { int l = l0; OPQ(l); phaseC(F, l); SEAM(p + 2); }
        if (IN(p + 3)) {
            unsigned char* wsq = args.ws; int l = l0; OPQ(wsq); OPQ(l); unsigned char* wl = wsq + WS_W + (size_t)l * W_LAYER;
            pg8::Gemm g{(const h16*)(wsq + WS_QY), (const h16*)(wl + W_OFF_PAB), 1024, 1024, 512, M / 256, 4, 2, 512};
            pg8::Order S; S.init(g.nM, g.nN, F.G, (int)blockIdx.x, 2); EpiD E{wsq};
            pg8::gemm_phase<EpiD>(F.lds, g, S, E); SEAM(p + 3); }
        if (IN(p + 4)) {
            unsigned char* wsq = args.ws; int l = l0; OPQ(wsq); OPQ(l); unsigned char* wl = wsq + WS_W + (size_t)l * W_LAYER;
            pg8::Gemm g{(const h16*)(wsq + WS_X16), (const h16*)(wl + W_OFF_OUT), 1024, 1024, 1024, M / 256, 4, 1, 0};
            pg8::Order S; S.init(g.nM, g.nN, F.G, (int)blockIdx.x, 1);
            EpiRes E{l == 0 ? args.in.x : args.out, args.out, (h16*)(wsq + WS_X1), (float*)(wsq + WS_SSQ), (LAS float*)(F.lds + 131072)};
            pg8::gemm_phase<EpiRes>(F.lds, g, S, E); SEAM(p + 4); }
        if (IN(p + 5)) {
            unsigned char* wsq = args.ws; int l = l0; OPQ(wsq); OPQ(l); unsigned char* wl = wsq + WS_W + (size_t)l * W_LAYER;
            pg8::Gemm g{(const h16*)(wsq + WS_X1), (const h16*)(wl + W_OFF_GU), 1024, 1024, 1024, M / 256, NGU / 256, 1, 0};
            pg8::Order S; S.init(g.nM, g.nN, F.G, (int)blockIdx.x, 1); EpiF E{wsq};
            pg8::gemm_phase<EpiF>(F.lds, g, S, E); SEAM(p + 5); }
        if (IN(p + 6)) {
            unsigned char* wsq = args.ws; int l = l0; OPQ(wsq); OPQ(l); unsigned char* wl = wsq + WS_W + (size_t)l * W_LAYER;
            pg8::Gemm g{(const h16*)(wsq + WS_ACT), (const h16*)(wl + W_OFF_D), DFF, DFF, DFF, M / 256, 4, 1, 0};
            pg8::Order S; S.init(g.nM, g.nN, F.G, (int)blockIdx.x, 1);
            EpiRes E{args.out, args.out, (h16*)(wsq + WS_X16), (float*)(wsq + WS_SSQ), (LAS float*)(F.lds + 131072)};
            pg8::gemm_phase<EpiRes>(F.lds, g, S, E); SEAM(p + 6); }
    }
    if (IN(N_PHASES - 1)) final_norm_phase(F, args.out, I.final_norm);
#undef IN
#undef SEAM
}

extern "C" void kernel_launch(void* const* d_in, const int* in_sizes, int n_in, void* d_out, int out_size, void* d_ws, size_t ws_size, hipStream_t stream) {
    static int grid = 0;
    if (grid == 0) {
        if (n_in != 19 || out_size != M * DM || ws_size < WS_END) { fprintf(stderr, "kernel_launch: unexpected shapes (n_in %d out %d ws %zu)\n", n_in, out_size, ws_size); grid = -1; return; }
        int dev = 0, cus = 0, per_cu = 0;
        hipGetDevice(&dev); hipDeviceGetAttribute(&cus, hipDeviceAttributeMultiprocessorCount, dev);
        hipFuncSetAttribute((const void*)mk_fwd, hipFuncAttributeMaxDynamicSharedMemorySize, LDS_BYTES);
        hipOccupancyMaxActiveBlocksPerMultiprocessor(&per_cu, (const void*)mk_fwd, NTHREADS, LDS_BYTES);
        (void)hipGetLastError();
        if (per_cu < 1) fprintf(stderr, "kernel_launch: occupancy query reports %d blocks per CU\n", per_cu);
        grid = cus;
    }
    if (grid < 0) return;
    hipMemsetAsync((char*)d_ws + WS_CTL, 0, CTL_ZERO_BYTES, stream);
    Args a{};
    const void** ip = (const void**)&a.in;
    for (int i = 0; i < 19; ++i) ip[i] = d_in[i];
    a.out = (float*)d_out; a.ws = (unsigned char*)d_ws;
#if MK_N_LAUNCHES == 1
    a.ph_lo = 0; a.ph_hi = N_PHASES;
    { void* kargs[] = {&a}; hipError_t e = hipLaunchCooperativeKernel((const void*)mk_fwd, dim3(grid), dim3(NTHREADS), kargs, LDS_BYTES, stream);
      if (e != hipSuccess) fprintf(stderr, "cooperative launch failed: %s (grid %d)\n", hipGetErrorString(e), grid); }
#else
    for (int p = 0; p < N_PHASES; ++p) { a.ph_lo = p; a.ph_hi = p + 1; hipLaunchKernelGGL(mk_fwd, dim3(grid), dim3(NTHREADS), LDS_BYTES, stream, a); }
#endif
}
```

```cpp
#define MK_N_LAUNCHES 1
#include <hip/hip_runtime.h>
#include <stdint.h>
#include <math.h>
#include <cstdio>

#define LAS __attribute__((address_space(3)))
#define GAS __attribute__((address_space(1)))
typedef _Float16 h16;
typedef h16 h16x8 __attribute__((ext_vector_type(8)));
typedef h16 h16x4 __attribute__((ext_vector_type(4)));
typedef h16 h16x2 __attribute__((ext_vector_type(2)));
typedef float f32x2 __attribute__((ext_vector_type(2)));
typedef float f32x4 __attribute__((ext_vector_type(4)));
typedef float f32x16 __attribute__((ext_vector_type(16)));
typedef unsigned u32x2 __attribute__((ext_vector_type(2)));
typedef unsigned u32x4 __attribute__((ext_vector_type(4)));
typedef short v4i16_t __attribute__((ext_vector_type(4)));

__device__ __forceinline__ unsigned pkh(float lo, float hi) { h16x2 v = {(h16)lo, (h16)hi}; return __builtin_bit_cast(unsigned, v); }
__device__ __forceinline__ float h2f_lo(unsigned u) { h16x2 v = __builtin_bit_cast(h16x2, u); return (float)v[0]; }
__device__ __forceinline__ float h2f_hi(unsigned u) { h16x2 v = __builtin_bit_cast(h16x2, u); return (float)v[1]; }

namespace pg8 {
constexpr int BM = 256, BK = 64, HALF = 128, HTB = HALF * BK * 2, STAGE_BYTES = 8 * HTB, NXCD = 8, WGM = 8;
__host__ __device__ __forceinline__ int lds_byte(int r, int c) { const int st = (r >> 4) * 2 + (c >> 5), rr = r & 15, cc = c & 31, ob = rr * 64 + cc * 2; return st * 1024 + (ob ^ (((ob >> 9) & 1) << 5)); }
__host__ __device__ __forceinline__ void stage_rc(int b, int& R, int& C) { const int st = b / 1024, sb = b % 1024, swz = sb ^ (((sb >> 9) & 1) << 5); R = (st >> 1) * 16 + swz / 64; C = (st & 1) * 32 + (swz % 64) / 2; }
__host__ __device__ __forceinline__ int perm32(int rho) { const int n = rho >> 4, i = rho & 15; return 8 * (i >> 2) + 4 * n + (i & 3); }

struct Unit { int pm, pn, kind; };
struct Gemm { const h16* A; const h16* Bt; int lda, ldb, K, nM, nN, nkind, koff; };

struct Order {
    int nM, nN, nwg, G, c, nk;
    __device__ void init(int nM_, int nN_, int G_, int c_, int nk_) { asm volatile("" : "+s"(G_), "+s"(c_)); nM = nM_; nN = nN_; nwg = nM * nN; G = G_; c = c_; nk = nk_; }
    __device__ bool next(int i, Unit& u) const {
        const int ti = i / nk; u.kind = i - ti * nk;
        const long L = (long)ti * G + c; if (L >= nwg) return false;
        int wgid = (int)L; { const int q = nwg / NXCD, r = nwg % NXCD, xcd = wgid % NXCD, off = wgid / NXCD; wgid = (xcd < r ? xcd * (q + 1) : r * (q + 1) + (xcd - r) * q) + off; }
        const int nig = WGM * nN, gid = wgid / nig, fm = gid * WGM, gsz = (nM - fm) < WGM ? (nM - fm) : WGM;
        u.pm = fm + ((wgid % nig) % gsz); u.pn = (wgid % nig) / gsz; return true;
    }
};

template <class Epi>
__device__ __forceinline__ void gemm_phase(LAS unsigned char* lds, const Gemm g, const Order& S, const Epi& E) {
    int tid = threadIdx.x; asm volatile("" : "+v"(tid));
    const int wid = __builtin_amdgcn_readfirstlane(tid >> 6), lane = tid & 63, wr = wid >> 2, wc = wid & 3, fr = lane & 15, fq = lane >> 4;
    const int nt = g.K / BK;
    unsigned voffA[2], voffB[2];
#pragma unroll
    for (int i = 0; i < 2; ++i) { int R, C; stage_rc(tid * 16 + i * 8192, R, C); const int Rb = Epi::PERM ? ((R & ~31) + perm32(R & 31)) : R;
        voffA[i] = (unsigned)(R * g.lda + C) * 2u; voffB[i] = (unsigned)(Rb * g.ldb + C) * 2u; }
    const size_t kstep = (size_t)(BK * 2);
    const size_t hstepA = (size_t)HALF * g.lda * 2, hstepB = (size_t)HALF * g.ldb * 2;
    const unsigned ldsw = (unsigned)wid * 1024u;
    const int aoff = lds_byte(wr * 64 + fr, fq * 8), boff = lds_byte(wc * 32 + fr, fq * 8);
#define PG8_SA(b, h) (((b) * 2 + (h)) * HTB)
#define PG8_SB(b, h) ((4 + (b) * 2 + (h)) * HTB)
#define PG8_STAGE(bufoff, gbase, voff) do { _Pragma("unroll") for (int _i = 0; _i < 2; ++_i) \
        __builtin_amdgcn_global_load_lds((const unsigned*)((const char*)(gbase) + (voff)[_i]), (LAS unsigned*)(lds + (bufoff) + ldsw + _i * 8192), 16, 0, 0); } while (0)
#define PG8_LDA(dst, b, h) do { _Pragma("unroll") for (int m = 0; m < 4; ++m) _Pragma("unroll") for (int k = 0; k < 2; ++k) dst[m][k] = *(const LAS h16x8*)(lds + PG8_SA(b, h) + aoff + m * 2048 + k * 1024); } while (0)
#define PG8_LDB(dst, b, h) do { _Pragma("unroll") for (int n = 0; n < 2; ++n) _Pragma("unroll") for (int k = 0; k < 2; ++k) dst[n][k] = *(const LAS h16x8*)(lds + PG8_SB(b, h) + boff + n * 2048 + k * 1024); } while (0)
#define PG8_MMA(ai, bj, At, Bt) do { __builtin_amdgcn_s_setprio(1); _Pragma("unroll") for (int m = 0; m < 4; ++m) _Pragma("unroll") for (int n = 0; n < 2; ++n) _Pragma("unroll") for (int k = 0; k < 2; ++k) \
        acc[ai][bj][m][n] = __builtin_amdgcn_mfma_f32_16x16x32_f16(Bt[n][k], At[m][k], acc[ai][bj][m][n], 0, 0, 0); __builtin_amdgcn_s_setprio(0); } while (0)
#define PG8_WAIT_V(n) asm volatile("s_waitcnt vmcnt(" #n ")" ::: "memory")
#define PG8_WAIT_L(n) asm volatile("s_waitcnt lgkmcnt(" #n ")" ::: "memory")
#define PG8_BAR __builtin_amdgcn_s_barrier()
#define PG8_SCHED __builtin_amdgcn_sched_barrier(0)
#define PG8_PA(u) ((const char*)g.A + ((size_t)(u).pm * 256 * g.lda + (size_t)(u).kind * g.koff) * 2)
#define PG8_PB(u) ((const char*)g.Bt + ((size_t)(u).pn * 256 * g.ldb + (size_t)(u).kind * g.koff) * 2)
    Unit cur, nxt; int ui = 0;
    if (!S.next(0, cur)) return;
    f32x4 acc[2][2][4][2];
#pragma unroll
    for (int a = 0; a < 2; ++a)
#pragma unroll
        for (int b = 0; b < 2; ++b)
#pragma unroll
            for (int m = 0; m < 4; ++m)
#pragma unroll
                for (int n = 0; n < 2; ++n) acc[a][b][m][n] = (f32x4){0.f, 0.f, 0.f, 0.f};
    h16x8 At[4][2], B0[2][2], B1[2][2];
    const char* cA = PG8_PA(cur); const char* cB = PG8_PB(cur);
    PG8_STAGE(PG8_SB(0, 0), cB, voffB); PG8_STAGE(PG8_SB(0, 1), cB + hstepB, voffB); PG8_STAGE(PG8_SA(0, 0), cA, voffA); PG8_STAGE(PG8_SA(0, 1), cA + hstepA, voffA);
    if (wr == 1) PG8_BAR;
    PG8_WAIT_V(2); PG8_BAR;
    PG8_STAGE(PG8_SB(1, 0), cB + kstep, voffB); PG8_STAGE(PG8_SA(1, 0), cA + kstep, voffA); PG8_STAGE(PG8_SB(1, 1), cB + hstepB + kstep, voffB);
    PG8_WAIT_V(6); PG8_BAR;
    for (;;) {
        const bool has_next = S.next(ui + 1, nxt);
        const char* nA = has_next ? PG8_PA(nxt) : cA; const char* nB = has_next ? PG8_PB(nxt) : cB;
        for (int t = 0; t < nt; t += 2) {
            const bool last = (t == nt - 2);
            const char* a1 = cA + (size_t)(t + 1) * kstep;
            const char* a2 = last ? nA : cA + (size_t)(t + 2) * kstep; const char* b2 = last ? nB : cB + (size_t)(t + 2) * kstep;
            const char* a3 = a2 + kstep; const char* b3 = b2 + kstep;
            PG8_LDB(B0, 0, 0); PG8_LDB(B1, 0, 1); PG8_SCHED; PG8_LDA(At, 0, 0); PG8_STAGE(PG8_SA(1, 1), a1 + hstepA, voffA);
            PG8_WAIT_V(8); PG8_WAIT_L(0); PG8_BAR; PG8_MMA(0, 0, At, B0); PG8_MMA(0, 1, At, B1); PG8_BAR; PG8_SCHED;
            PG8_LDA(At, 0, 1); PG8_STAGE(PG8_SB(0, 0), b2, voffB); PG8_STAGE(PG8_SB(0, 1), b2 + hstepB, voffB); PG8_STAGE(PG8_SA(0, 0), a2, voffA);
            PG8_WAIT_V(8); PG8_WAIT_L(0); PG8_BAR; PG8_MMA(1, 0, At, B0); PG8_MMA(1, 1, At, B1); PG8_BAR; PG8_SCHED;
            PG8_LDB(B0, 1, 0); PG8_LDB(B1, 1, 1); PG8_SCHED; PG8_LDA(At, 1, 0); PG8_STAGE(PG8_SA(0, 1), a2 + hstepA, voffA);
            PG8_WAIT_V(8); PG8_WAIT_L(0); PG8_BAR; PG8_MMA(0, 0, At, B0); PG8_MMA(0, 1, At, B1); PG8_BAR; PG8_SCHED;
            PG8_LDA(At, 1, 1); PG8_STAGE(PG8_SB(1, 0), b3, voffB); PG8_STAGE(PG8_SB(1, 1), b3 + hstepB, voffB); PG8_STAGE(PG8_SA(1, 0), a3, voffA);
            PG8_WAIT_V(8); PG8_WAIT_L(0); PG8_BAR; PG8_MMA(1, 0, At, B0); PG8_MMA(1, 1, At, B1); PG8_BAR; PG8_SCHED;
        }
        if (wr == 0) PG8_BAR;
        { int fr_ = fr, fq_ = fq; asm volatile("" : "+v"(fr_), "+v"(fq_)); E(acc, cur, wr, wc, fr_, fq_); }
        if (!has_next) break;
        if (nxt.kind == 0) {
#pragma unroll
            for (int a = 0; a < 2; ++a)
#pragma unroll
                for (int b = 0; b < 2; ++b)
#pragma unroll
                    for (int m = 0; m < 4; ++m)
#pragma unroll
                        for (int n = 0; n < 2; ++n) acc[a][b][m][n] = (f32x4){0.f, 0.f, 0.f, 0.f};
        }
        cur = nxt; cA = nA; cB = nB; ++ui;
        if (wr == 1) PG8_BAR;
    }
    PG8_WAIT_V(0);
    PG8_BAR;
#undef PG8_SA
#undef PG8_SB
#undef PG8_STAGE
#undef PG8_LDA
#undef PG8_LDB
#undef PG8_MMA
#undef PG8_WAIT_V
#undef PG8_WAIT_L
#undef PG8_BAR
#undef PG8_SCHED
#undef PG8_PA
#undef PG8_PB
}
}
constexpr int NWAVES = 8, NTHREADS = 512;
constexpr int NB = 8, SEQ = 2048, DM = 1024, M = NB * SEQ, DIN = 4312, DFF = 2816, NLAYER = 2;
constexpr int NZ = 4352;
constexpr int NGU = 2 * DFF;
constexpr float EPS_RMS = 1e-6f;
constexpr float LOG2E = 1.4426950408889634f;
constexpr float QSCALE = 0.125f * LOG2E;
constexpr int KVP = 152;

constexpr size_t MiB = 1u << 20;
constexpr size_t WS_CTL = 0, CTL_ZERO_BYTES = 65536;
constexpr size_t WS_CS = 1 * MiB;
constexpr size_t WS_SSQ = 2 * MiB;
constexpr size_t WS_WI = 3 * MiB;
constexpr size_t WS_SMALLW = 4 * MiB;
constexpr size_t SMALLW_LAYER = 98304 + 131072 + 262144;
constexpr size_t WS_W = 6 * MiB;
constexpr size_t W_LAYER = 29 * MiB, W_OFF_IN = 0, W_OFF_PAB = (size_t)NZ * 1024 * 2, W_OFF_OUT = W_OFF_PAB + 2 * MiB, W_OFF_GU = W_OFF_OUT + 2 * MiB, W_OFF_D = W_OFF_GU + (size_t)NGU * 1024 * 2;
static_assert(W_OFF_D + (size_t)1024 * DFF * 2 == W_LAYER, "weight map");
constexpr size_t WS_X16 = 64 * MiB;
constexpr size_t WS_QY = 96 * MiB;
constexpr size_t WS_QI = 128 * MiB;
constexpr size_t WS_MISC = 144 * MiB;
constexpr size_t WS_KV = 152 * MiB;
constexpr size_t WS_KI = 157 * MiB;
constexpr size_t WS_X1 = 128 * MiB;
constexpr size_t WS_GATES = 160 * MiB;
constexpr size_t WS_UV = 224 * MiB;
constexpr size_t WS_ACT = 160 * MiB;
constexpr size_t WS_END = 256 * MiB;
static_assert(WS_KV + (size_t)M * KVP * 2 <= WS_KI && WS_KI + (size_t)M * 64 * 2 <= WS_GATES && WS_ACT + (size_t)M * DFF * 2 <= WS_END, "ws map");

constexpr int LDS_BYTES = 155648;
constexpr int LDS_MISC = 151552;

#define RLX_AGENT __ATOMIC_RELAXED, __HIP_MEMORY_SCOPE_AGENT
#define LDS_WAIT() asm volatile("s_waitcnt lgkmcnt(0)" ::: "memory")
#define VM_WAIT() asm volatile("s_waitcnt vmcnt(0)" ::: "memory")

#define XB_TMO      128
#define XB_XCNT(j)  (256  + 64 * (j))
#define XB_XSUB(j)  (1280 + 64 * (j))
#define XB_XGEN(j)  (2304 + 64 * (j))
#define XB_TOP      3328
#define XB_TOPGEN   3392
#define XCD_BAR_WORDS 3456
#define XB_SPIN_CAP (1u << 18)
__device__ __forceinline__ unsigned xb_ld(unsigned* p)              { return __hip_atomic_load(p, __ATOMIC_RELAXED, __HIP_MEMORY_SCOPE_AGENT); }
__device__ __forceinline__ unsigned xb_add(unsigned* p, unsigned v) { return __hip_atomic_fetch_add(p, v, __ATOMIC_RELAXED, __HIP_MEMORY_SCOPE_AGENT); }
__device__ __forceinline__ unsigned xb_xcc_id() { return (unsigned)__builtin_amdgcn_s_getreg((3 << 11) | 20) & 0xFu; }
#define XB_SPIN(cond, bar) do { unsigned _sp = 0; while (cond) { __builtin_amdgcn_s_sleep(1); \
    if ((++_sp & 255u) == 0u) { if (xb_ld(&(bar)[XB_TMO])) break; if (_sp > XB_SPIN_CAP) { atomicAdd(&(bar)[XB_TMO], 1u); break; } } } } while (0)
struct XcdBarrier { unsigned* bar; unsigned x; volatile LAS unsigned* st; };
__device__ __forceinline__ XcdBarrier xcd_barrier_post(unsigned* bar, volatile LAS unsigned* st) {
    XcdBarrier b; b.bar = bar; b.x = xb_xcc_id(); b.st = st;
    if (threadIdx.x == 0) (void)xb_add(&bar[XB_XCNT(b.x)], 1u);
    return b;
}
__device__ __forceinline__ void xcd_barrier_complete(unsigned* bar, unsigned x, unsigned& nloc, unsigned& nx) {
    const unsigned G = gridDim.x * gridDim.y * gridDim.z;
    unsigned sum, cnt, mine, sp = 0u;
    for (;;) {
        sum = 0u; cnt = 0u; mine = 0u;
#pragma unroll
        for (unsigned j = 0; j < 16; ++j) { const unsigned c = xb_ld(&bar[XB_XCNT(j)]); sum += c; cnt += (c > 0u) ? 1u : 0u; }
        mine = xb_ld(&bar[XB_XCNT(x)]);
        if (sum == G) break;
        __builtin_amdgcn_s_sleep(1);
        if ((++sp & 255u) == 0u) { if (xb_ld(&bar[XB_TMO])) break; if (sp > XB_SPIN_CAP) { atomicAdd(&bar[XB_TMO], 1u); break; } }
    }
    nloc = mine > 0u ? mine : 1u; nx = cnt > 0u ? cnt : 1u;
}
__device__ __forceinline__ void xcd_barrier(const XcdBarrier& b) {
    asm volatile("s_waitcnt vmcnt(0)" ::: "memory");
    __syncthreads();
    if (threadIdx.x == 0) {
        unsigned* bar = b.bar; asm volatile("" : "+s"(bar));
        __builtin_amdgcn_s_waitcnt(0);
        unsigned nloc = b.st[0], nx = b.st[1];
        if (nloc == 0u) { xcd_barrier_complete(bar, b.x, nloc, nx); b.st[0] = nloc; b.st[1] = nx; }
        const unsigned old = xb_add(&bar[XB_XSUB(b.x)], 1u);
        const unsigned gen = old / nloc;
        if (old + 1u == (gen + 1u) * nloc) {
            __builtin_amdgcn_fence(__ATOMIC_RELEASE, "agent");
            asm volatile("s_waitcnt vmcnt(0)" ::: "memory");
            const unsigned og = xb_add(&bar[XB_TOP], 1u);
            const unsigned tg = og / nx;
            if (og + 1u == (tg + 1u) * nx) xb_add(&bar[XB_TOPGEN], 1u);
            else XB_SPIN(xb_ld(&bar[XB_TOPGEN]) == tg, bar);
            __builtin_amdgcn_fence(__ATOMIC_ACQUIRE, "agent");
            xb_add(&bar[XB_XGEN(b.x)], 1u);
            asm volatile("s_waitcnt vmcnt(0)" ::: "memory");
        } else {
            XB_SPIN(xb_ld(&bar[XB_XGEN(b.x)]) == gen, bar);
            __builtin_amdgcn_fence(__ATOMIC_ACQUIRE, "agent");
            asm volatile("s_waitcnt vmcnt(0)" ::: "memory");
        }
    }
    __syncthreads();
}

__device__ __forceinline__ float gelu_tanh_f(float x) {
    const float u = 0.7978845608028654f * (x + 0.044715f * x * x * x);
    const float e = __builtin_amdgcn_exp2f(-2.0f * LOG2E * u);
    return x * __builtin_amdgcn_rcpf(1.0f + e);
}
__device__ __forceinline__ float sigmoid_f(float x) { return __builtin_amdgcn_rcpf(1.0f + __builtin_amdgcn_exp2f(-LOG2E * x)); }

struct Frame {
    LAS unsigned char* lds;
    int tid, lane, wave, vcu, G;
    unsigned char* ws;
    const float* const* in;
};
struct In {
    const float* x; const int* pos; const float* norm_mix; const float* w_in; const float* kv_norm; const float* w_uk; const float* w_uv; const float* ln_v_g; const float* ln_v_b;
    const float* w_s; const float* b_s; const float* w_proj_a; const float* w_proj_b; const float* w_out; const float* norm_ffn; const float* w_gate; const float* w_up; const float* w_down; const float* final_norm;
};

__device__ __constant__ float c_inv[8] = {1.0f, 0.19392274474868576f, 0.03760603093086393f, 0.007292664737217109f, 0.001414213562373095f, 0.0002742481756762073f, 5.318295896944988e-05f, 1.031338537721246e-05f};

__device__ __forceinline__ void transpose_item(const float* Wl, int Nsrc, h16* WT, int ldt, int n0, int k0, const float* gain, LAS float* scr, int lane) {
#pragma unroll 8
    for (int i = 0; i < 32; ++i) { const int kk = 2 * i + (lane >> 5); float v = Wl ? Wl[(size_t)(k0 + kk) * Nsrc] : 0.f; if (gain) v *= gain[k0 + kk]; scr[kk * 33 + (lane & 31)] = v; }
    LDS_WAIT(); asm volatile("" ::: "memory");
    const int c = lane & 7;
#pragma unroll
    for (int j = 0; j < 4; ++j) { const int n = (lane >> 3) + 8 * j; const LAS float* s = scr + (8 * c) * 33 + n;
        u32x4 o; o.x = pkh(s[0 * 33], s[1 * 33]); o.y = pkh(s[2 * 33], s[3 * 33]); o.z = pkh(s[4 * 33], s[5 * 33]); o.w = pkh(s[6 * 33], s[7 * 33]);
        *(u32x4*)(WT + (size_t)(n0 + n) * ldt + k0 + 8 * c) = o; }
    LDS_WAIT(); asm volatile("" ::: "memory");
}
__device__ __forceinline__ int win_src_col(int n) {
    if (n < 512) return n;
    if (n < 1024) return 656 + (n - 512);
    if (n < 2048) return 1240 + (n - 1024);
    if (n < 4096) return 2264 + (n - 2048);
    if (n < 4224) return 512 + (n - 4096);
    if (n < 4240) return 640 + (n - 4224);
    if (n < 4304) return 1168 + (n - 4240);
    if (n < 4312) return 1232 + (n - 4304);
    return -1;
}
__device__ __forceinline__ void p0_prologue(const Frame& F, const In& I) {
    LAS float* scr = (LAS float*)(F.lds + F.wave * 8448);
    int lane = F.lane; asm volatile("" : "+v"(lane));
    const int gw = F.vcu * NWAVES + F.wave, NGW = F.G * NWAVES;
    constexpr int I_IN = (NZ / 32) * 16, I_PA = 32 * 8, I_OUT = 32 * 16, I_GU = (NGU / 32) * 16, I_D = 32 * (DFF / 64);
    constexpr int I_LAYER = I_IN + 2 * I_PA + I_OUT + I_GU + I_D;
    for (int it = gw; it < NLAYER * I_LAYER; it += NGW) {
        const int l = it / I_LAYER; int r = it - l * I_LAYER;
        unsigned char* wl = F.ws + WS_W + (size_t)l * W_LAYER;
        if (r < I_IN) { const int nb = r / 16, kb = r % 16, sc = win_src_col(nb * 32 + (lane & 31));
            transpose_item(sc >= 0 ? I.w_in + (size_t)l * DM * DIN + sc : nullptr, DIN, (h16*)(wl + W_OFF_IN), 1024, nb * 32, kb * 64, I.norm_mix + l * DM, scr, lane); continue; }
        r -= I_IN;
        if (r < I_PA) { const int nb = r / 8, kb = r % 8;
            transpose_item(I.w_proj_a + (size_t)l * 512 * 1024 + nb * 32 + (lane & 31), 1024, (h16*)(wl + W_OFF_PAB), 1024, nb * 32, kb * 64, nullptr, scr, lane); continue; }
        r -= I_PA;
        if (r < I_PA) { const int nb = r / 8, kb = r % 8;
            transpose_item(I.w_proj_b + (size_t)l * 512 * 1024 + nb * 32 + (lane & 31), 1024, (h16*)(wl + W_OFF_PAB) + 512, 1024, nb * 32, kb * 64, nullptr, scr, lane); continue; }
        r -= I_PA;
        if (r < I_OUT) { const int nb = r / 16, kb = r % 16;
            transpose_item(I.w_out + (size_t)l * 1024 * 1024 + nb * 32 + (lane & 31), 1024, (h16*)(wl + W_OFF_OUT), 1024, nb * 32, kb * 64, nullptr, scr, lane); continue; }
        r -= I_OUT;
        if (r < I_GU) { const int nb = r / 16, kb = r % 16, R = nb * 32 + (lane & 31), pn = R >> 8, rem = R & 255;
            const int a = 128 * pn + 64 * (rem >> 7) + 16 * ((rem >> 5) & 3) + 4 * ((rem >> 3) & 3) + (rem & 3);
            const float* src = (((rem >> 2) & 1) ? I.w_up : I.w_gate) + (size_t)l * DM * DFF + a;
            transpose_item(src, DFF, (h16*)(wl + W_OFF_GU), 1024, nb * 32, kb * 64, I.norm_ffn + l * DM, scr, lane); continue; }
        r -= I_GU;
        { const int nb = r / (DFF / 64), kb = r % (DFF / 64);
            transpose_item(I.w_down + (size_t)l * DFF * 1024 + nb * 32 + (lane & 31), 1024, (h16*)(wl + W_OFF_D), DFF, nb * 32, kb * 64, nullptr, scr, lane); }
    }
    const int gt = F.vcu * NTHREADS + F.tid, NGT = F.G * NTHREADS;
    for (int i = gt; i < NLAYER * 49152; i += NGT) { const int l = i / 49152, e = i % 49152, h = e / (128 * 48), c = (e / 48) % 128, n = e % 48;
        ((h16*)(F.ws + WS_SMALLW + (size_t)l * SMALLW_LAYER))[e] = (h16)I.w_uk[(((size_t)l * 8 + h) * 48 + n) * 128 + c]; }
    for (int i = gt; i < NLAYER * 65536; i += NGT) { const int l = i / 65536, e = i % 65536, h = e / (64 * 128), d = (e / 128) % 64, c = e % 128;
        ((h16*)(F.ws + WS_SMALLW + (size_t)l * SMALLW_LAYER + 98304))[e] = (h16)I.w_uv[(((size_t)l * 8 + h) * 128 + c) * 64 + d]; }
    for (int i = gt; i < NLAYER * 131072; i += NGT) { const int l = i / 131072, e = i % 131072, t = (e / 128) % 128, s = e % 128;
        ((h16*)(F.ws + WS_SMALLW + (size_t)l * SMALLW_LAYER + 98304 + 131072))[e] = (s <= t) ? (h16)I.w_s[(size_t)l * 131072 + e] : (h16)0.f; }
    for (int i = gt; i < M * 8; i += NGT) { const int tok = i >> 3, f = i & 7; const float ang = (float)I.pos[tok] * c_inv[f];
        float* cs = (float*)(F.ws + WS_CS) + (size_t)tok * 16; cs[f] = cosf(ang); cs[8 + f] = sinf(ang); }
    for (int m = gw; m < M; m += NGW) {
        const f32x4* xr = (const f32x4*)(I.x + (size_t)m * DM) + lane; u32x2* o8 = (u32x2*)((h16*)(F.ws + WS_X16) + (size_t)m * DM) + lane;
#pragma unroll
        for (int j = 0; j < 4; ++j) { const f32x4 v = xr[64 * j]; float s = (v.x * v.x + v.y * v.y) + (v.z * v.z + v.w * v.w);
#pragma unroll
            for (int o = 1; o < 64; o <<= 1) s += __shfl_xor(s, o);
            o8[64 * j] = (u32x2){pkh(v.x, v.y), pkh(v.z, v.w)};
            if (lane == 0) ((float*)(F.ws + WS_SSQ))[(size_t)m * 4 + j] = s; }
    }
}

__device__ __forceinline__ float row_rstd(const float* ssq, int row) {
    const f32x4 a = *(const f32x4*)(ssq + (size_t)row * 4);
    return rsqrtf(((a.x + a.y) + (a.z + a.w)) * (1.0f / DM) + EPS_RMS);
}

typedef f32x4 Acc[2][2][4][2];

struct EpiA {
    static constexpr bool PERM = true;
    unsigned char* ws;
    __device__ __forceinline__ void operator()(Acc& acc, const pg8::Unit& u, int wr, int wc, int fr, int fq) const {
        const int pn = u.pn; h16* base; int ldc, colt; bool act = false;
        if (pn < 2) { base = (h16*)(ws + WS_QY); ldc = 1024; colt = pn * 256; }
        else if (pn < 4) { base = (h16*)(ws + WS_QI); ldc = 512; colt = (pn - 2) * 256; }
        else if (pn < 8) { base = (h16*)(ws + WS_UV); ldc = 1024; colt = (pn - 4) * 256; act = true; }
        else if (pn < 16) { base = (h16*)(ws + WS_GATES); ldc = 2048; colt = (pn - 8) * 256; }
        else { base = (h16*)(ws + WS_MISC); ldc = 256; colt = 0; }
        const int row0 = u.pm * 256 + wr * 64 + fr, col0 = colt + wc * 32 + 8 * fq;
        const float* ssq = (const float*)(ws + WS_SSQ);
#pragma unroll
        for (int ai = 0; ai < 2; ++ai)
#pragma unroll
            for (int m = 0; m < 4; ++m) { const int row = row0 + ai * 128 + m * 16; const float rs = row_rstd(ssq, row); h16* rowp = base + (size_t)row * ldc + col0;
#pragma unroll
                for (int bj = 0; bj < 2; ++bj) { f32x4 v0 = acc[ai][bj][m][0] * rs, v1 = acc[ai][bj][m][1] * rs;
                    if (act) {
#pragma unroll
                        for (int i = 0; i < 4; ++i) { v0[i] = gelu_tanh_f(v0[i]); v1[i] = gelu_tanh_f(v1[i]); } }
                    u32x4 w; w.x = pkh(v0[0], v0[1]); w.y = pkh(v0[2], v0[3]); w.z = pkh(v1[0], v1[1]); w.w = pkh(v1[2], v1[3]);
                    *(u32x4*)(rowp + bj * 128) = w; }
                asm volatile("" ::: "memory"); }
    }
};

struct EpiD {
    static constexpr bool PERM = true;
    unsigned char* ws;
    __device__ __forceinline__ void operator()(Acc& acc, const pg8::Unit& u, int wr, int wc, int fr, int fq) const {
        const int row0 = u.pm * 256 + wr * 64 + fr, col0 = u.pn * 256 + wc * 32 + 8 * fq;
        const h16* gates = (const h16*)(ws + WS_GATES); h16* mg = (h16*)(ws + WS_X16);
#pragma unroll
        for (int ai = 0; ai < 2; ++ai)
#pragma unroll
            for (int m = 0; m < 4; ++m) { const int row = row0 + ai * 128 + m * 16;
#pragma unroll
                for (int bj = 0; bj < 2; ++bj) { const int col = col0 + bj * 128;
                    const h16x8 gb = *(const h16x8*)(gates + (size_t)row * 2048 + 1024 + col);
                    if (u.kind == 0) { const h16x8 ga = *(const h16x8*)(gates + (size_t)row * 2048 + col);
#pragma unroll
                        for (int i = 0; i < 8; ++i) { const float a = fminf(fmaxf((float)ga[i], -30.f), 30.f), b = fminf(fmaxf((float)gb[i], -30.f), 30.f);
                            const float ratio = (1.0f + __builtin_amdgcn_exp2f(-LOG2E * b)) * __builtin_amdgcn_rcpf(1.0f + __builtin_amdgcn_exp2f(-LOG2E * a));
                            acc[ai][bj][m][i >> 2][i & 3] *= ratio; }
                    } else { float v[8];
#pragma unroll
                        for (int i = 0; i < 8; ++i) { const float b = fminf(fmaxf((float)gb[i], -30.f), 30.f); v[i] = acc[ai][bj][m][i >> 2][i & 3] * sigmoid_f(b); }
                        u32x4 w; w.x = pkh(v[0], v[1]); w.y = pkh(v[2], v[3]); w.z = pkh(v[4], v[5]); w.w = pkh(v[6], v[7]);
                        *(u32x4*)(mg + (size_t)row * 1024 + col) = w; } }
                asm volatile("" ::: "memory"); }
    }
};

struct EpiRes {
    static constexpr bool PERM = false;
    const float* resid; float* out; h16* x16; float* ssq; LAS float* P;
    __device__ __forceinline__ void operator()(Acc& acc, const pg8::Unit& u, int wr, int wc, int fr, int fq) const {
        const int row0 = u.pm * 256 + wr * 64 + fr, col0 = u.pn * 256 + wc * 32 + 4 * fq;
#pragma unroll
        for (int ai = 0; ai < 2; ++ai)
#pragma unroll
            for (int m = 0; m < 4; ++m) { const int row = row0 + ai * 128 + m * 16; float ss = 0.f;
#pragma unroll
                for (int bj = 0; bj < 2; ++bj)
#pragma unroll
                    for (int n = 0; n < 2; ++n) { const size_t off = (size_t)row * 1024 + col0 + bj * 128 + n * 16;
                        const f32x4 v = *(const f32x4*)(resid + off) + acc[ai][bj][m][n];
                        *(f32x4*)(out + off) = v; *(u32x2*)(x16 + off) = (u32x2){pkh(v[0], v[1]), pkh(v[2], v[3])};
                        ss += (v[0] * v[0] + v[1] * v[1]) + (v[2] * v[2] + v[3] * v[3]); }
                ss += __shfl_xor(ss, 16); ss += __shfl_xor(ss, 32);
                if (fq == 0) P[(ai * 128 + wr * 64 + m * 16 + fr) * 4 + wc] = ss;
                asm volatile("" ::: "memory"); }
        asm volatile("s_waitcnt lgkmcnt(0)" ::: "memory"); __builtin_amdgcn_s_barrier(); asm volatile("" ::: "memory");
        { const int t = (wr * 4 + wc) * 64 + fq * 16 + fr; if (t < 256) { const f32x4 v = *(const LAS f32x4*)(P + t * 4); ssq[(size_t)(u.pm * 256 + t) * 4 + u.pn] = (v.x + v.y) + (v.z + v.w); } }
        asm volatile("s_waitcnt lgkmcnt(0)" ::: "memory"); __builtin_amdgcn_s_barrier(); asm volatile("" ::: "memory");
    }
};

struct EpiF {
    static constexpr bool PERM = true;
    unsigned char* ws;
    __device__ __forceinline__ void operator()(Acc& acc, const pg8::Unit& u, int wr, int wc, int fr, int fq) const {
        const int row0 = u.pm * 256 + wr * 64 + fr, col0 = u.pn * 128 + wc * 16 + 4 * fq;
        const float* ssq = (const float*)(ws + WS_SSQ); h16* act = (h16*)(ws + WS_ACT);
#pragma unroll
        for (int ai = 0; ai < 2; ++ai)
#pragma unroll
            for (int m = 0; m < 4; ++m) { const int row = row0 + ai * 128 + m * 16; const float rs = row_rstd(ssq, row);
#pragma unroll
                for (int bj = 0; bj < 2; ++bj) { const f32x4 g = acc[ai][bj][m][0] * rs, uu = acc[ai][bj][m][1] * rs; float v[4];
#pragma unroll
                    for (int i = 0; i < 4; ++i) v[i] = g[i] * sigmoid_f(g[i]) * uu[i];
                    *(u32x2*)(act + (size_t)row * DFF + col0 + bj * 64) = (u32x2){pkh(v[0], v[1]), pkh(v[2], v[3])}; }
                asm volatile("" ::: "memory"); }
    }
};

__device__ __forceinline__ void final_norm_phase(const Frame& F, float* out, const float* g) {
    int lane = F.lane; asm volatile("" : "+v"(lane));
    const int gw = F.vcu * NWAVES + F.wave, NGW = F.G * NWAVES;
    for (int m = gw; m < M; m += NGW) {
        f32x4* xr = (f32x4*)(out + (size_t)m * DM) + lane; f32x4 v[4]; float s = 0.f;
#pragma unroll
        for (int j = 0; j < 4; ++j) { v[j] = xr[64 * j]; s += (v[j].x * v[j].x + v[j].y * v[j].y) + (v[j].z * v[j].z + v[j].w * v[j].w); }
#pragma unroll
        for (int o = 1; o < 64; o <<= 1) s += __shfl_xor(s, o);
        const float rs = rsqrtf(s * (1.0f / DM) + EPS_RMS);
#pragma unroll
        for (int j = 0; j < 4; ++j) { const f32x4 gg = ((const f32x4*)g)[lane + 64 * j]; xr[64 * j] = v[j] * rs * gg; }
    }
}
__device__ __forceinline__ unsigned wlane(unsigned val, int ln, unsigned old) {
    unsigned keep;
    asm volatile("s_mov_b32 %1, m0\n\ts_mov_b32 m0, %3\n\ts_nop 3\n\tv_writelane_b32 %0, %2, m0\n\ts_mov_b32 m0, %1" : "+v"(old), "=&s"(keep) : "s"(val), "s"(ln));
    return old;
}
__device__ __forceinline__ void cnt_ge(int& c, float x, float m) { asm("v_cmp_ge_f32 vcc, %1, %2\n\tv_addc_co_u32 %0, vcc, 0, %0, vcc" : "+v"(c) : "v"(x), "v"(m) : "vcc"); }
__device__ __forceinline__ void cnt_gt(int& c, float x, float m) { asm("v_cmp_gt_f32 vcc, %1, %2\n\tv_addc_co_u32 %0, vcc, 0, %0, vcc" : "+v"(c) : "v"(x), "v"(m) : "vcc"); }
__device__ __forceinline__ void ballot_ge_to_lane(unsigned& wlo, unsigned& whi, float x, float tau, int ln) {
    unsigned keep;
    asm volatile("v_cmp_ge_f32 vcc, %3, %4\n\ts_mov_b32 %2, m0\n\ts_mov_b32 m0, %5\n\ts_nop 3\n\tv_writelane_b32 %0, vcc_lo, m0\n\tv_writelane_b32 %1, vcc_hi, m0\n\ts_mov_b32 m0, %2"
                 : "+v"(wlo), "+v"(whi), "=&s"(keep) : "v"(x), "v"(tau), "s"(ln) : "vcc");
}
__device__ __forceinline__ int half_sum_dpp(int v, int hf) {
    v += __builtin_amdgcn_update_dpp(0, v, 0x111, 0xf, 0xf, true);
    v += __builtin_amdgcn_update_dpp(0, v, 0x112, 0xf, 0xf, true);
    v += __builtin_amdgcn_update_dpp(0, v, 0x114, 0xf, 0xf, true);
    v += __builtin_amdgcn_update_dpp(0, v, 0x118, 0xf, 0xf, true);
    v += __builtin_amdgcn_update_dpp(0, v, 0x142, 0xa, 0xf, false);
    const int s0 = __builtin_amdgcn_readlane(v, 31), s1 = __builtin_amdgcn_readlane(v, 63);
    return hf ? s1 : s0;
}
__device__ __forceinline__ int crow(int R, int hf) { return (R & 3) + 8 * (R >> 2) + 4 * hf; }
__device__ __forceinline__ float half_swap_max(float v) { auto rr = __builtin_amdgcn_permlane32_swap(__float_as_uint(v), __float_as_uint(v), false, false); return fmaxf(__uint_as_float(rr[0]), __uint_as_float(rr[1])); }
__device__ __forceinline__ float half_swap_sum(float v) { auto rr = __builtin_amdgcn_permlane32_swap(__float_as_uint(v), __float_as_uint(v), false, false); return __uint_as_float(rr[0]) + __uint_as_float(rr[1]); }
__device__ __forceinline__ void rope8(const h16x8 x1, const h16x8 x2, const float* cs, int which, float scale, float (&o)[8]) {
    const f32x4 c0 = *(const f32x4*)(cs), c1 = *(const f32x4*)(cs + 4), s0 = *(const f32x4*)(cs + 8), s1 = *(const f32x4*)(cs + 12);
#pragma unroll
    for (int j = 0; j < 8; ++j) { const float c = j < 4 ? c0[j & 3] : c1[j & 3], s = j < 4 ? s0[j & 3] : s1[j & 3]; const float a = (float)x1[j], b = (float)x2[j];
        o[j] = (which == 0 ? (a * c - b * s) : (b * c + a * s)) * scale; }
}
__device__ __forceinline__ u32x4 pack8(const float (&v)[8]) { u32x4 w; w.x = pkh(v[0], v[1]); w.y = pkh(v[2], v[3]); w.z = pkh(v[4], v[5]); w.w = pkh(v[6], v[7]); return w; }

__device__ __forceinline__ void phaseB(const Frame& F, const In& I, int l) {
    unsigned char* ws = F.ws; asm volatile("" : "+s"(ws)); int lane = F.lane, tid = F.tid; asm volatile("" : "+v"(lane), "+v"(tid)); const int w = F.wave;
    const h16* MISC = (const h16*)(ws + WS_MISC); h16* KV = (h16*)(ws + WS_KV); h16* KI = (h16*)(ws + WS_KI); float* WI = (float*)(ws + WS_WI); const float* CS = (const float*)(ws + WS_CS);
    int blk = F.vcu; asm volatile("" : "+s"(blk));
#pragma unroll 1
    for (int it = 0; it < 2; ++it) {
        const int tok = blk * 64 + w * 8 + it * 4 + (lane >> 4), i = lane & 15;
        const h16* mr = MISC + (size_t)tok * 256; const float* cs = CS + (size_t)tok * 16;
        const h16x8 x = *(const h16x8*)(mr + 8 * i);
        float ss = 0.f;
#pragma unroll
        for (int j = 0; j < 8; ++j) ss += (float)x[j] * (float)x[j];
        ss += __shfl_xor(ss, 1); ss += __shfl_xor(ss, 2); ss += __shfl_xor(ss, 4); ss += __shfl_xor(ss, 8);
        const float rs = rsqrtf(ss * (1.0f / 128.f) + EPS_RMS);
        { float o[8]; const float* kn = I.kv_norm + l * 128 + 8 * i;
#pragma unroll
          for (int j = 0; j < 8; ++j) o[j] = (float)x[j] * rs * kn[j];
          *(u32x4*)(KV + (size_t)tok * KVP + 8 * i) = pack8(o); }
        if (i < 2) { float o[8]; rope8(*(const h16x8*)(mr + 128), *(const h16x8*)(mr + 136), cs, i, 1.0f, o); *(u32x4*)(KV + (size_t)tok * KVP + 128 + 8 * i) = pack8(o); }
        else if (i == 2) { *(u32x4*)(KV + (size_t)tok * KVP + 144) = (u32x4){0u, 0u, 0u, 0u}; }
        else if (i < 11) { const int ii = i - 3;
            if (ii < 2) { float o[8]; rope8(*(const h16x8*)(mr + 144), *(const h16x8*)(mr + 152), cs, ii, 1.0f, o); *(u32x4*)(KI + (size_t)tok * 64 + 8 * ii) = pack8(o); }
            else *(u32x4*)(KI + (size_t)tok * 64 + 8 * ii) = *(const u32x4*)(mr + 144 + 8 * ii); }
        else if (i == 11) { const h16x8 wv = *(const h16x8*)(mr + 208); const float sc = 0.35355339059327373f * 0.125f;
            *(f32x4*)(WI + (size_t)tok * 8) = (f32x4){(float)wv[0] * sc, (float)wv[1] * sc, (float)wv[2] * sc, (float)wv[3] * sc};
            *(f32x4*)(WI + (size_t)tok * 8 + 4) = (f32x4){(float)wv[4] * sc, (float)wv[5] * sc, (float)wv[6] * sc, (float)wv[7] * sc}; }
    }
    const int b = blk >> 5, chunk = (blk >> 1) & 15, gh = blk & 1;
    const size_t tok0 = (size_t)b * SEQ + chunk * 128;
    const h16* UV = (const h16*)(ws + WS_UV); h16* QY = (h16*)(ws + WS_QY);
    LAS float* MU = (LAS float*)(F.lds); LAS float* RS = MU + 128; LAS h16* VNT = (LAS h16*)(F.lds + 1024);
    constexpr int VP = 136;
#pragma unroll 1
    for (int rr = 0; rr < 16; ++rr) { const int t = 16 * w + rr; const h16x8 v = *(const h16x8*)(UV + (tok0 + t) * 1024 + 512 + 8 * lane);
        float s = 0.f;
#pragma unroll
        for (int j = 0; j < 8; ++j) s += (float)v[j];
#pragma unroll
        for (int o = 1; o < 64; o <<= 1) s += __shfl_xor(s, o);
        const float mu = s * (1.0f / 512.f); float q = 0.f;
#pragma unroll
        for (int j = 0; j < 8; ++j) { const float d = (float)v[j] - mu; q += d * d; }
#pragma unroll
        for (int o = 1; o < 64; o <<= 1) q += __shfl_xor(q, o);
        if (lane == 0) { MU[t] = mu; RS[t] = rsqrtf(q * (1.0f / 512.f) + 1e-5f); } }
    LDS_WAIT(); __syncthreads();
#pragma unroll 1
    for (int itx = 0; itx < 8; ++itx) { const int p = tid + 512 * itx, t = p >> 5, c0 = (p & 31) * 8, col = 256 * gh + c0;
        const h16x8 v = *(const h16x8*)(UV + (tok0 + t) * 1024 + 512 + col); const float mu = MU[t], rs = RS[t];
        const float* lg = I.ln_v_g + l * 512 + col; const float* lb = I.ln_v_b + l * 512 + col;
#pragma unroll
        for (int j = 0; j < 8; ++j) { const int c = c0 + j; VNT[((c >> 6) * 64 + (c & 63)) * VP + t] = (h16)(((float)v[j] - mu) * rs * lg[j] + lb[j]); } }
    LDS_WAIT(); __syncthreads();
    { const int gp = w & 3, g = 4 * gh + gp, rh = w >> 2, r = lane & 31, hf = lane >> 5;
      const h16* WS16 = (const h16*)(ws + WS_SMALLW + (size_t)l * SMALLW_LAYER + 98304 + 131072) + (size_t)g * 128 * 128;
#pragma unroll 1
      for (int tb = 0; tb < 2; ++tb) { const int trow0 = 64 * rh + 32 * tb; const int nks = 4 * rh + 2 * tb + 2;
#pragma unroll 1
        for (int db = 0; db < 2; ++db) { f32x16 D = {};
#pragma unroll
            for (int s = 0; s < 8; ++s) if (s < nks) {
                const h16x8 a = *(const h16x8*)(WS16 + (size_t)(trow0 + r) * 128 + 16 * s + 8 * hf);
                const h16x8 bb = *(const LAS h16x8*)(VNT + (gp * 64 + 32 * db + r) * VP + 16 * s + 8 * hf);
                D = __builtin_amdgcn_mfma_f32_32x32x16_f16(a, bb, D, 0, 0, 0); }
#pragma unroll
            for (int R = 0; R < 16; ++R) { const int t = trow0 + crow(R, hf); const size_t tk = tok0 + t; const int d = g * 64 + 32 * db + r;
                const float sv = D[R] + I.b_s[((size_t)l * 8 + g) * 128 + t];
                const float u = (float)UV[tk * 1024 + d];
                QY[tk * 1024 + 512 + d] = (h16)(u * sv); } } } }
    __syncthreads();
}

constexpr int C_KIB = 0, C_KIBUF = 256 * 128;
constexpr int C_QL = 0, C_QLW = KVP * 2 * 32;
constexpr int C_WQ = 81920;
constexpr int C_KVS = 90112, C_KVSLOT = 32 * KVP * 2;

__device__ __forceinline__ void phaseC_select(const Frame& F, int l, int b, int qt) {
    unsigned char* ws = F.ws; asm volatile("" : "+s"(ws)); int lane = F.lane, tid = F.tid; asm volatile("" : "+v"(lane), "+v"(tid)); const int w = F.wave, r = lane & 31, hf = lane >> 5;
    const h16* QI = (const h16*)(ws + WS_QI); const h16* KI = (const h16*)(ws + WS_KI); const float* WI = (const float*)(ws + WS_WI); const float* CS = (const float*)(ws + WS_CS);
    h16* QY = (h16*)(ws + WS_QY); const h16* KV = (const h16*)(ws + WS_KV);
    const h16* WUKT = (const h16*)(ws + WS_SMALLW + (size_t)l * SMALLW_LAYER); const h16* WUVT = (const h16*)(ws + WS_SMALLW + (size_t)l * SMALLW_LAYER + 98304);
    LAS unsigned char* lds = F.lds;
    const int t0 = 32 * qt, NT = qt + 1; const size_t tokbase = (size_t)b * SEQ;
    h16x8 afr[4]; float wreg[16];
    { const int qq = 2 * ((r >> 2) & 1) + (r >> 4), head = (r & 3) + 4 * ((r >> 3) & 1); const size_t tokA = tokbase + t0 + 4 * w + qq;
      const h16* qsrc = QI + tokA * 512 + head * 64;
      { float o[8]; rope8(*(const h16x8*)(qsrc), *(const h16x8*)(qsrc + 8), CS + tokA * 16, hf, 1.0f, o); afr[0] = __builtin_bit_cast(h16x8, pack8(o)); }
#pragma unroll
      for (int s = 1; s < 4; ++s) afr[s] = *(const h16x8*)(qsrc + 16 * s + 8 * hf);
      const float* wp = WI + (tokbase + t0 + 4 * w + 2 * hf) * 8;
#pragma unroll
      for (int R = 0; R < 16; ++R) wreg[R] = wp[R]; }
    float SC[128];
    const float QNAN = __uint_as_float(0x7fc00000u);
#pragma unroll
    for (int i = 0; i < 128; ++i) SC[i] = QNAN;
    const int NCK = (NT + 7) >> 3, tq0 = t0 + 4 * w + 2 * hf;
    const int drow = lane >> 3, dslot = lane & 7;
    const h16* kisrc = KI + (tokbase + 32 * w + drow) * 64 + 8 * (dslot ^ drow);
#define KI_STAGE(ck_, buf_) do { _Pragma("unroll") for (int i_ = 0; i_ < 4; ++i_) \
        __builtin_amdgcn_global_load_lds((const unsigned*)(kisrc + (size_t)(256 * (ck_) + 8 * i_) * 64), (LAS unsigned*)(lds + C_KIB + (buf_) * C_KIBUF + (4 * w + i_) * 1024), 16, 0, 0); } while (0)
    KI_STAGE(0, 0);
    VM_WAIT(); __syncthreads();
    const int kroff = r * 128, kx = r & 7;
#pragma unroll 1
    for (int ck = 0; ck < NCK; ++ck) {
        LAS unsigned char* kb = lds + C_KIB + (ck & 1) * C_KIBUF;
        if (ck + 1 < NCK) KI_STAGE(ck + 1, (ck + 1) & 1);
#pragma unroll
        for (int i = 0; i < 112; ++i) SC[i] = SC[i + 16];
#pragma unroll
        for (int jj = 0; jj < 8; ++jj) {
            f32x16 D = {};
#pragma unroll
            for (int s = 0; s < 4; ++s) { const h16x8 bb = *(const LAS h16x8*)(kb + jj * 4096 + kroff + 16 * ((2 * s + hf) ^ kx)); D = __builtin_amdgcn_mfma_f32_32x32x16_f16(afr[s], bb, D, 0, 0, 0); }
            float s0 = 0.f, s1 = 0.f;
#pragma unroll
            for (int R = 0; R < 8; ++R) { s0 = fmaf(wreg[R], fmaxf(D[R], 0.f), s0); s1 = fmaf(wreg[8 + R], fmaxf(D[8 + R], 0.f), s1); }
            const int k = 256 * ck + 32 * jj + r;
            SC[112 + 2 * jj] = (k > tq0) ? QNAN : s0; SC[113 + 2 * jj] = (k > tq0 + 1) ? QNAN : s1;
        }
        LDS_WAIT(); VM_WAIT(); __syncthreads();
    }
#undef KI_STAGE
    const int G0 = 8 - NCK;
#define SEL_COUNT2(c0, c1, CNT, m0, m1) do { int a0_ = 0, a1_ = 0; \
        _Pragma("unroll") for (int g = 0; g < 8; ++g) if (g >= G0) { _Pragma("unroll") for (int jj = 0; jj < 8; ++jj) { const int j = 8 * g + jj; CNT(a0_, SC[2 * j], (m0)); CNT(a1_, SC[2 * j + 1], (m1)); } } \
        c0 = half_sum_dpp(a0_, hf); c1 = half_sum_dpp(a1_, hf); } while (0)
    float tau0 = -3.0e38f, tau1 = -3.0e38f;
    if (qt >= 8) {
        float lo0 = INFINITY, lo1 = INFINITY, hi0 = -INFINITY, hi1 = -INFINITY;
#pragma unroll
        for (int j = 0; j < 64; ++j) { const float a = SC[2 * j], c = SC[2 * j + 1]; lo0 = fminf(lo0, a); hi0 = fmaxf(hi0, a); lo1 = fminf(lo1, c); hi1 = fmaxf(hi1, c); }
#pragma unroll
        for (int o = 1; o < 32; o <<= 1) { lo0 = fminf(lo0, __shfl_xor(lo0, o)); lo1 = fminf(lo1, __shfl_xor(lo1, o)); hi0 = fmaxf(hi0, __shfl_xor(hi0, o)); hi1 = fmaxf(hi1, __shfl_xor(hi1, o)); }
        bool done0 = false, done1 = false;
        { int g0, g1, e0, e1; const float zero = 0.f; SEL_COUNT2(g0, g1, cnt_gt, zero, zero); SEL_COUNT2(e0, e1, cnt_ge, zero, zero);
          const float tiny = __uint_as_float(1u);
          if (g0 >= 256) { lo0 = 0.f; if (g0 == 256) { lo0 = tiny; done0 = true; } } else if (e0 >= 256) { lo0 = 0.f; done0 = true; } else hi0 = 0.f;
          if (g1 >= 256) { lo1 = 0.f; if (g1 == 256) { lo1 = tiny; done1 = true; } } else if (e1 >= 256) { lo1 = 0.f; done1 = true; } else hi1 = 0.f; }
#pragma unroll 1
        for (int it = 0; it < 32; ++it) {
            const float mid0 = 0.5f * (lo0 + hi0), mid1 = 0.5f * (lo1 + hi1);
            if (!done0 && (mid0 <= lo0 || mid0 >= hi0)) done0 = true;
            if (!done1 && (mid1 <= lo1 || mid1 >= hi1)) done1 = true;
            if (__all(done0 && done1)) break;
            int c0, c1; SEL_COUNT2(c0, c1, cnt_ge, mid0, mid1);
            if (!done0) { if (c0 >= 256) { lo0 = mid0; if (c0 == 256) done0 = true; } else hi0 = mid0; }
            if (!done1) { if (c1 >= 256) { lo1 = mid1; if (c1 == 256) done1 = true; } else hi1 = mid1; }
        }
        tau0 = lo0; tau1 = lo1;
    }
#undef SEL_COUNT2
    unsigned w00 = 0u, w01 = 0u, w10 = 0u, w11 = 0u;
#pragma unroll
    for (int g = 0; g < 8; ++g) if (g >= G0) {
#pragma unroll
        for (int jj = 0; jj < 8; ++jj) { const int j = 8 * g + jj, jt = 8 * (g - G0) + jj;
            ballot_ge_to_lane(w00, w10, SC[2 * j], tau0, jt); ballot_ge_to_lane(w01, w11, SC[2 * j + 1], tau1, jt); } }
    { LAS unsigned* WQ = (LAS unsigned*)(lds + C_WQ);
      WQ[(4 * w + 0) * 64 + lane] = w00; WQ[(4 * w + 1) * 64 + lane] = w01; WQ[(4 * w + 2) * 64 + lane] = w10; WQ[(4 * w + 3) * 64 + lane] = w11; }
    LDS_WAIT(); __syncthreads();
}

__device__ __forceinline__ void phaseC_attn(const Frame& F, int l, int b, int qt, bool do_store = true) {
    unsigned char* ws = F.ws; asm volatile("" : "+s"(ws)); const int w = F.wave;
    int lane = F.lane, tid = F.tid; asm volatile("" : "+v"(lane), "+v"(tid));
    const int r = lane & 31, hf = lane >> 5;
    const float* CS = (const float*)(ws + WS_CS);
    h16* QY = (h16*)(ws + WS_QY); const h16* KV = (const h16*)(ws + WS_KV);
    const h16* WUKT = (const h16*)(ws + WS_SMALLW + (size_t)l * SMALLW_LAYER); const h16* WUVT = (const h16*)(ws + WS_SMALLW + (size_t)l * SMALLW_LAYER + 98304);
    LAS unsigned char* lds = F.lds;
    const int t0 = 32 * qt, NT = qt + 1; const size_t tokbase = (size_t)b * SEQ;
    const int h = w; const size_t tokQ = tokbase + t0 + r;
    LAS h16* ql = (LAS h16*)(lds + C_QL + w * C_QLW);
    { h16x8 bq[3];
#pragma unroll
      for (int s = 0; s < 3; ++s) bq[s] = *(const h16x8*)(QY + tokQ * 1024 + h * 64 + 16 + 16 * s + 8 * hf);
#pragma unroll
      for (int cb = 0; cb < 4; ++cb) { f32x16 D = {};
#pragma unroll
          for (int s = 0; s < 3; ++s) { const h16x8 a = *(const h16x8*)(WUKT + ((size_t)(h * 128 + 32 * cb + r)) * 48 + 16 * s + 8 * hf); D = __builtin_amdgcn_mfma_f32_32x32x16_f16(a, bq[s], D, 0, 0, 0); }
#pragma unroll
          for (int g = 0; g < 4; ++g) { const int c = 32 * cb + 8 * g + 4 * hf;
              *(LAS u32x2*)(ql + r * KVP + c) = (u32x2){pkh(D[4 * g] * QSCALE, D[4 * g + 1] * QSCALE), pkh(D[4 * g + 2] * QSCALE, D[4 * g + 3] * QSCALE)}; } }
      { float o[8]; rope8(*(const h16x8*)(QY + tokQ * 1024 + h * 64), *(const h16x8*)(QY + tokQ * 1024 + h * 64 + 8), CS + tokQ * 16, hf, QSCALE, o); *(LAS u32x4*)(ql + r * KVP + 128 + 8 * hf) = pack8(o); } }
    LDS_WAIT();
    h16x8 qfr[9];
#pragma unroll
    for (int s = 0; s < 9; ++s) qfr[s] = *(const LAS h16x8*)(ql + r * KVP + 16 * s + 8 * hf);
    const h16* kvsrc = KV + tokbase * KVP;
    u32x4 kvA, kvB = {0u, 0u, 0u, 0u};
    kvA = *(const u32x4*)((const char*)kvsrc + (size_t)tid * 16); if (tid < 96) kvB = *(const u32x4*)((const char*)kvsrc + (size_t)(512 + tid) * 16);
    *(LAS u32x4*)(lds + C_KVS + tid * 16) = kvA; if (tid < 96) *(LAS u32x4*)(lds + C_KVS + (512 + tid) * 16) = kvB;
    LDS_WAIT(); __syncthreads();
    float mrun = -INFINITY, lrun = 0.f; f32x16 O[4];
#pragma unroll
    for (int db = 0; db < 4; ++db) O[db] = (f32x16){};
    const LAS unsigned* WQr = (const LAS unsigned*)(lds + C_WQ) + r * 64;
    const int troff = ((lane & 15) >> 2) * (KVP * 2) + (16 * ((lane >> 4) & 1) + 4 * (lane & 3)) * 2 + 4 * hf * (KVP * 2);
#pragma unroll 1
    for (int j = 0; j < NT; ++j) {
        if (j + 1 < NT) { const char* src = (const char*)kvsrc + (size_t)(j + 1) * C_KVSLOT; kvA = *(const u32x4*)(src + (size_t)tid * 16); if (tid < 96) kvB = *(const u32x4*)(src + (size_t)(512 + tid) * 16); }
        LAS unsigned char* slot = lds + C_KVS + (j & 1) * C_KVSLOT;
        f32x16 S = {};
#pragma unroll
        for (int s = 0; s < 9; ++s) { const h16x8 a = *(const LAS h16x8*)(slot + r * (KVP * 2) + 32 * s + 16 * hf); S = __builtin_amdgcn_mfma_f32_32x32x16_f16(a, qfr[s], S, 0, 0, 0); }
        float mt = S[0];
#pragma unroll
        for (int R = 1; R < 16; ++R) mt = fmaxf(mt, S[R]);
        mt = half_swap_max(mt);
        if (__any(mt > mrun + 8.0f)) { const float mnew = fmaxf(mrun, mt), alpha = __builtin_amdgcn_exp2f(mrun - mnew);
#pragma unroll
            for (int db = 0; db < 4; ++db) O[db] = O[db] * alpha;
            lrun *= alpha; mrun = mnew; }
        const unsigned wq = WQr[j] >> (4 * hf);
        float p[16];
#pragma unroll
        for (int R = 0; R < 16; ++R) { const float e = __builtin_amdgcn_exp2f(S[R] - mrun); p[R] = ((wq >> ((R & 3) + 8 * (R >> 2))) & 1u) ? e : 0.f; lrun += p[R]; }
        h16x8 pf[2];
#pragma unroll
        for (int sp = 0; sp < 2; ++sp) { u32x4 t; t.x = pkh(p[8 * sp], p[8 * sp + 1]); t.y = pkh(p[8 * sp + 2], p[8 * sp + 3]); t.z = pkh(p[8 * sp + 4], p[8 * sp + 5]); t.w = pkh(p[8 * sp + 6], p[8 * sp + 7]); pf[sp] = __builtin_bit_cast(h16x8, t); }
#pragma unroll
        for (int db = 0; db < 4; ++db)
#pragma unroll
            for (int sp = 0; sp < 2; ++sp) {
                const v4i16_t lo = __builtin_amdgcn_ds_read_tr16_b64_v4i16((LAS v4i16_t*)(slot + troff + (16 * sp) * (KVP * 2) + 64 * db));
                const v4i16_t hi = __builtin_amdgcn_ds_read_tr16_b64_v4i16((LAS v4i16_t*)(slot + troff + (16 * sp + 8) * (KVP * 2) + 64 * db));
                typedef short s16x8 __attribute__((ext_vector_type(8)));
                const s16x8 av = {lo[0], lo[1], lo[2], lo[3], hi[0], hi[1], hi[2], hi[3]};
                O[db] = __builtin_amdgcn_mfma_f32_32x32x16_f16(__builtin_bit_cast(h16x8, av), pf[sp], O[db], 0, 0, 0); }
        if (j + 1 < NT) { LAS unsigned char* nslot = lds + C_KVS + ((j + 1) & 1) * C_KVSLOT; *(LAS u32x4*)(nslot + tid * 16) = kvA; if (tid < 96) *(LAS u32x4*)(nslot + (512 + tid) * 16) = kvB; }
        LDS_WAIT(); __syncthreads();
    }
    { const float inv = 1.0f / half_swap_sum(lrun);
#pragma unroll
      for (int db = 0; db < 4; ++db)
#pragma unroll
          for (int g = 0; g < 4; ++g) { const int c = 32 * db + 8 * g + 4 * hf;
              *(LAS u32x2*)(ql + r * KVP + c) = (u32x2){pkh(O[db][4 * g] * inv, O[db][4 * g + 1] * inv), pkh(O[db][4 * g + 2] * inv, O[db][4 * g + 3] * inv)}; } }
    LDS_WAIT();
    { h16x8 ao[8];
#pragma unroll
      for (int s = 0; s < 8; ++s) ao[s] = *(const LAS h16x8*)(ql + r * KVP + 16 * s + 8 * hf);
#pragma unroll
      for (int d2 = 0; d2 < 2; ++d2) { f32x16 D = {};
#pragma unroll
          for (int s = 0; s < 8; ++s) { const h16x8 bw = *(const h16x8*)(WUVT + ((size_t)(h * 64 + 32 * d2 + r)) * 128 + 16 * s + 8 * hf); D = __builtin_amdgcn_mfma_f32_32x32x16_f16(ao[s], bw, D, 0, 0, 0); }
#pragma unroll
          for (int R = 0; R < 16; ++R) { if (do_store) QY[(tokbase + t0 + crow(R, hf)) * 1024 + h * 64 + 32 * d2 + r] = (h16)D[R]; else asm volatile("" :: "v"(D[R])); } } }
    LDS_WAIT(); __syncthreads();
}

__device__ __forceinline__ void phaseC(const Frame& F, int l) {
    int vc = F.vcu; asm volatile("" : "+s"(vc)); const int b = vc >> 5, i = vc & 31;
#pragma unroll 1
    for (int u = 0; u < 2; ++u) { const int qt = (u == 0) ? 63 - i : i;
#if defined(PROBE_C_SEL)
#pragma unroll 1
        for (int rep = 0; rep < 2; ++rep)
#endif
        phaseC_select(F, l, b, qt);
#if defined(PROBE_C_ATT)
#pragma unroll 1
        for (int rep = 0; rep < 2; ++rep) phaseC_attn(F, l, b, qt, rep == 1);
#else
        phaseC_attn(F, l, b, qt);
#endif
    }
}
#ifndef PROBE_MASK
#define PROBE_MASK 0u
#endif
#ifndef MK_N_LAUNCHES
#define MK_N_LAUNCHES 1
#endif
constexpr int N_PHASES = 2 + 7 * NLAYER;
struct Args { In in; float* out; unsigned char* ws; int ph_lo, ph_hi; };

__global__ void __launch_bounds__(NTHREADS, 2) mk_fwd(Args args) {
    extern __shared__ __attribute__((aligned(16))) unsigned char lds_raw[];
    Frame F; F.lds = (LAS unsigned char*)lds_raw; F.tid = threadIdx.x; F.lane = F.tid & 63; F.wave = __builtin_amdgcn_readfirstlane(F.tid >> 6);
    F.G = gridDim.x; { const int bx = blockIdx.x; F.vcu = (F.G % 8 == 0) ? (bx % 8) * (F.G / 8) + bx / 8 : bx; }
    F.ws = args.ws; F.in = nullptr;
    const In& I = args.in; unsigned char* ws = args.ws; (void)ws;
    volatile LAS unsigned* MISCW = (volatile LAS unsigned*)(F.lds + LDS_MISC);
    if (F.tid < 64) MISCW[F.tid] = 0u;
    __syncthreads();
#if MK_N_LAUNCHES == 1
    const bool one_launch = true;
#else
    const bool one_launch = (args.ph_hi - args.ph_lo) > 1;
#endif
    XcdBarrier bar; bar.bar = (unsigned*)(ws + WS_CTL) + 1024; bar.x = 0; bar.st = nullptr;
    if (one_launch) bar = xcd_barrier_post((unsigned*)(ws + WS_CTL) + 1024, MISCW + 8);
#if MK_N_LAUNCHES == 1
#define IN(k) true
#define SEAM(k) xcd_barrier(bar)
#else
#define IN(k) (args.ph_lo <= (k) && (k) < args.ph_hi)
#define SEAM(k) do { if (IN(k) && IN((k) + 1)) xcd_barrier(bar); } while (0)
#endif
    if (IN(0)) { p0_prologue(F, I); SEAM(0); }
#define OPQ(x) asm volatile("" : "+s"(x))
#pragma unroll 1
    for (int l0 = 0; l0 < NLAYER; ++l0) {
        const int p = 1 + 7 * l0;
        if (IN(p)) {
            unsigned char* wsq = args.ws; int l = l0; OPQ(wsq); OPQ(l); unsigned char* wl = wsq + WS_W + (size_t)l * W_LAYER;
            pg8::Gemm g{(const h16*)(wsq + WS_X16), (const h16*)(wl + W_OFF_IN), 1024, 1024, 1024, M / 256, NZ / 256, 1, 0};
            pg8::Order S; S.init(g.nM, g.nN, F.G, (int)blockIdx.x, 1); EpiA E{wsq};
            pg8::gemm_phase<EpiA>(F.lds, g, S, E); SEAM(p); }
        if (IN(p + 1)) { int l = l0; OPQ(l); phaseB(F, I, l); SEAM(p + 1); }
        if (IN(p + 2)) { int l = l0; OPQ(l); phaseC(F, l); SEAM(p + 2); }
        if (IN(p + 3)) {
            unsigned char* wsq = args.ws; int l = l0; OPQ(wsq); OPQ(l); unsigned char* wl = wsq + WS_W + (size_t)l * W_LAYER;
            pg8::Gemm g{(const h16*)(wsq + WS_QY), (const h16*)(wl + W_OFF_PAB), 1024, 1024, 512, M / 256, 4, 2, 512};
            pg8::Order S; S.init(g.nM, g.nN, F.G, (int)blockIdx.x, 2); EpiD E{wsq};
            pg8::gemm_phase<EpiD>(F.lds, g, S, E); SEAM(p + 3); }
        if (IN(p + 4)) {
            unsigned char* wsq = args.ws; int l = l0; OPQ(wsq); OPQ(l); unsigned char* wl = wsq + WS_W + (size_t)l * W_LAYER;
            pg8::Gemm g{(const h16*)(wsq + WS_X16), (const h16*)(wl + W_OFF_OUT), 1024, 1024, 1024, M / 256, 4, 1, 0};
            pg8::Order S; S.init(g.nM, g.nN, F.G, (int)blockIdx.x, 1);
            EpiRes E{l == 0 ? args.in.x : args.out, args.out, (h16*)(wsq + WS_X1), (float*)(wsq + WS_SSQ), (LAS float*)(F.lds + 131072)};
            pg8::gemm_phase<EpiRes>(F.lds, g, S, E); SEAM(p + 4); }
        if (IN(p + 5)) {
            unsigned char* wsq = args.ws; int l = l0; OPQ(wsq); OPQ(l); unsigned char* wl = wsq + WS_W + (size_t)l * W_LAYER;
            pg8::Gemm g{(const h16*)(wsq + WS_X1), (const h16*)(wl + W_OFF_GU), 1024, 1024, 1024, M / 256, NGU / 256, 1, 0};
            pg8::Order S; S.init(g.nM, g.nN, F.G, (int)blockIdx.x, 1); EpiF E{wsq};
            pg8::gemm_phase<EpiF>(F.lds, g, S, E); SEAM(p + 5); }
        if (IN(p + 6)) {
            unsigned char* wsq = args.ws; int l = l0; OPQ(wsq); OPQ(l); unsigned char* wl = wsq + WS_W + (size_t)l * W_LAYER;
            pg8::Gemm g{(const h16*)(wsq + WS_ACT), (const h16*)(wl + W_OFF_D), DFF, DFF, DFF, M / 256, 4, 1, 0};
            pg8::Order S; S.init(g.nM, g.nN, F.G, (int)blockIdx.x, 1);
            EpiRes E{args.out, args.out, (h16*)(wsq + WS_X16), (float*)(wsq + WS_SSQ), (LAS float*)(F.lds + 131072)};
            pg8::gemm_phase<EpiRes>(F.lds, g, S, E); SEAM(p + 6); }
    }
    if (IN(N_PHASES - 1)) final_norm_phase(F, args.out, I.final_norm);
#undef IN
#undef SEAM
}

extern "C" void kernel_launch(void* const* d_in, const int* in_sizes, int n_in, void* d_out, int out_size, void* d_ws, size_t ws_size, hipStream_t stream) {
    static int grid = 0;
    if (grid == 0) {
        if (n_in != 19 || out_size != M * DM || ws_size < WS_END) { fprintf(stderr, "kernel_launch: unexpected shapes (n_in %d out %d ws %zu)\n", n_in, out_size, ws_size); grid = -1; return; }
        int dev = 0, cus = 0, per_cu = 0;
        hipGetDevice(&dev); hipDeviceGetAttribute(&cus, hipDeviceAttributeMultiprocessorCount, dev);
        hipFuncSetAttribute((const void*)mk_fwd, hipFuncAttributeMaxDynamicSharedMemorySize, LDS_BYTES);
        hipOccupancyMaxActiveBlocksPerMultiprocessor(&per_cu, (const void*)mk_fwd, NTHREADS, LDS_BYTES);
        (void)hipGetLastError();
        if (per_cu < 1) fprintf(stderr, "kernel_launch: occupancy query reports %d blocks per CU\n", per_cu);
        grid = cus;
    }
    if (grid < 0) return;
    hipMemsetAsync((char*)d_ws + WS_CTL, 0, CTL_ZERO_BYTES, stream);
    Args a{};
    const void** ip = (const void**)&a.in;
    for (int i = 0; i < 19; ++i) ip[i] = d_in[i];
    a.out = (float*)d_out; a.ws = (unsigned char*)d_ws;
#if MK_N_LAUNCHES == 1
    a.ph_lo = 0; a.ph_hi = N_PHASES;
    { void* kargs[] = {&a}; hipError_t e = hipLaunchCooperativeKernel((const void*)mk_fwd, dim3(grid), dim3(NTHREADS), kargs, LDS_BYTES, stream);
      if (e != hipSuccess) fprintf(stderr, "cooperative launch failed: %s (grid %d)\n", hipGetErrorString(e), grid); }
#else
    for (int p = 0; p < N_PHASES; ++p) { const int reps = ((PROBE_MASK >> p) & 1u) ? 2 : 1;
        for (int rr = 0; rr < reps; ++rr) { a.ph_lo = p; a.ph_hi = p + 1; hipLaunchKernelGGL(mk_fwd, dim3(grid), dim3(NTHREADS), LDS_BYTES, stream, a); } }
#endif
}
```

```cpp
#define MK_N_LAUNCHES 1
#include <hip/hip_runtime.h>
#include <stdint.h>
#include <math.h>
#include <cstdio>

#define LAS __attribute__((address_space(3)))
#define GAS __attribute__((address_space(1)))
typedef _Float16 h16;
typedef h16 h16x8 __attribute__((ext_vector_type(8)));
typedef h16 h16x4 __attribute__((ext_vector_type(4)));
typedef h16 h16x2 __attribute__((ext_vector_type(2)));
typedef float f32x2 __attribute__((ext_vector_type(2)));
typedef float f32x4 __attribute__((ext_vector_type(4)));
typedef float f32x16 __attribute__((ext_vector_type(16)));
typedef unsigned u32x2 __attribute__((ext_vector_type(2)));
typedef unsigned u32x4 __attribute__((ext_vector_type(4)));
typedef short v4i16_t __attribute__((ext_vector_type(4)));

__device__ __forceinline__ unsigned pkh(float lo, float hi) { h16x2 v = {(h16)lo, (h16)hi}; return __builtin_bit_cast(unsigned, v); }
__device__ __forceinline__ float h2f_lo(unsigned u) { h16x2 v = __builtin_bit_cast(h16x2, u); return (float)v[0]; }
__device__ __forceinline__ float h2f_hi(unsigned u) { h16x2 v = __builtin_bit_cast(h16x2, u); return (float)v[1]; }

namespace pg8 {
constexpr int BM = 256, BK = 64, HALF = 128, HTB = HALF * BK * 2, STAGE_BYTES = 8 * HTB, NXCD = 8, WGM = 8;
__host__ __device__ __forceinline__ int lds_byte(int r, int c) { const int st = (r >> 4) * 2 + (c >> 5), rr = r & 15, cc = c & 31, ob = rr * 64 + cc * 2; return st * 1024 + (ob ^ (((ob >> 9) & 1) << 5)); }
__host__ __device__ __forceinline__ void stage_rc(int b, int& R, int& C) { const int st = b / 1024, sb = b % 1024, swz = sb ^ (((sb >> 9) & 1) << 5); R = (st >> 1) * 16 + swz / 64; C = (st & 1) * 32 + (swz % 64) / 2; }
__host__ __device__ __forceinline__ int perm32(int rho) { const int n = rho >> 4, i = rho & 15; return 8 * (i >> 2) + 4 * n + (i & 3); }

struct Unit { int pm, pn, kind; };
struct Gemm { const h16* A; const h16* Bt; int lda, ldb, K, nM, nN, nkind, koff; };

struct Order {
    int nM, nN, nwg, G, c, nk;
    __device__ void init(int nM_, int nN_, int G_, int c_, int nk_) { asm volatile("" : "+s"(G_), "+s"(c_)); nM = nM_; nN = nN_; nwg = nM * nN; G = G_; c = c_; nk = nk_; }
    __device__ bool next(int i, Unit& u) const {
        const int ti = i / nk; u.kind = i - ti * nk;
        const long L = (long)ti * G + c; if (L >= nwg) return false;
        int wgid = (int)L; { const int q = nwg / NXCD, r = nwg % NXCD, xcd = wgid % NXCD, off = wgid / NXCD; wgid = (xcd < r ? xcd * (q + 1) : r * (q + 1) + (xcd - r) * q) + off; }
        const int nig = WGM * nN, gid = wgid / nig, fm = gid * WGM, gsz = (nM - fm) < WGM ? (nM - fm) : WGM;
        u.pm = fm + ((wgid % nig) % gsz); u.pn = (wgid % nig) / gsz; return true;
    }
};

template <class Epi>
__device__ __forceinline__ void gemm_phase(LAS unsigned char* lds, const Gemm g, const Order& S, const Epi& E) {
    int tid = threadIdx.x; asm volatile("" : "+v"(tid));
    const int wid = __builtin_amdgcn_readfirstlane(tid >> 6), lane = tid & 63, wr = wid >> 2, wc = wid & 3, fr = lane & 15, fq = lane >> 4;
    const int nt = g.K / BK;
    unsigned voffA[2], voffB[2];
#pragma unroll
    for (int i = 0; i < 2; ++i) { int R, C; stage_rc(tid * 16 + i * 8192, R, C); const int Rb = Epi::PERM ? ((R & ~31) + perm32(R & 31)) : R;
        voffA[i] = (unsigned)(R * g.lda + C) * 2u; voffB[i] = (unsigned)(Rb * g.ldb + C) * 2u; }
    const size_t kstep = (size_t)(BK * 2);
    const size_t hstepA = (size_t)HALF * g.lda * 2, hstepB = (size_t)HALF * g.ldb * 2;
    const unsigned ldsw = (unsigned)wid * 1024u;
    const int aoff = lds_byte(wr * 64 + fr, fq * 8), boff = lds_byte(wc * 32 + fr, fq * 8);
#define PG8_SA(b, h) (((b) * 2 + (h)) * HTB)
#define PG8_SB(b, h) ((4 + (b) * 2 + (h)) * HTB)
#define PG8_STAGE(bufoff, gbase, voff) do { _Pragma("unroll") for (int _i = 0; _i < 2; ++_i) \
        __builtin_amdgcn_global_load_lds((const unsigned*)((const char*)(gbase) + (voff)[_i]), (LAS unsigned*)(lds + (bufoff) + ldsw + _i * 8192), 16, 0, 0); } while (0)
#define PG8_LDA(dst, b, h) do { _Pragma("unroll") for (int m = 0; m < 4; ++m) _Pragma("unroll") for (int k = 0; k < 2; ++k) dst[m][k] = *(const LAS h16x8*)(lds + PG8_SA(b, h) + aoff + m * 2048 + k * 1024); } while (0)
#define PG8_LDB(dst, b, h) do { _Pragma("unroll") for (int n = 0; n < 2; ++n) _Pragma("unroll") for (int k = 0; k < 2; ++k) dst[n][k] = *(const LAS h16x8*)(lds + PG8_SB(b, h) + boff + n * 2048 + k * 1024); } while (0)
#define PG8_MMA(ai, bj, At, Bt) do { __builtin_amdgcn_s_setprio(1); _Pragma("unroll") for (int m = 0; m < 4; ++m) _Pragma("unroll") for (int n = 0; n < 2; ++n) _Pragma("unroll") for (int k = 0; k < 2; ++k) \
        acc[ai][bj][m][n] = __builtin_amdgcn_mfma_f32_16x16x32_f16(Bt[n][k], At[m][k], acc[ai][bj][m][n], 0, 0, 0); __builtin_amdgcn_s_setprio(0); } while (0)
#define PG8_WAIT_V(n) asm volatile("s_waitcnt vmcnt(" #n ")" ::: "memory")
#define PG8_WAIT_L(n) asm volatile("s_waitcnt lgkmcnt(" #n ")" ::: "memory")
#define PG8_BAR __builtin_amdgcn_s_barrier()
#define PG8_SCHED __builtin_amdgcn_sched_barrier(0)
#define PG8_PA(u) ((const char*)g.A + ((size_t)(u).pm * 256 * g.lda + (size_t)(u).kind * g.koff) * 2)
#define PG8_PB(u) ((const char*)g.Bt + ((size_t)(u).pn * 256 * g.ldb + (size_t)(u).kind * g.koff) * 2)
    Unit cur, nxt; int ui = 0;
    if (!S.next(0, cur)) return;
    f32x4 acc[2][2][4][2];
#pragma unroll
    for (int a = 0; a < 2; ++a)
#pragma unroll
        for (int b = 0; b < 2; ++b)
#pragma unroll
            for (int m = 0; m < 4; ++m)
#pragma unroll
                for (int n = 0; n < 2; ++n) acc[a][b][m][n] = (f32x4){0.f, 0.f, 0.f, 0.f};
    h16x8 At[4][2], B0[2][2], B1[2][2];
    const char* cA = PG8_PA(cur); const char* cB = PG8_PB(cur);
    PG8_STAGE(PG8_SB(0, 0), cB, voffB); PG8_STAGE(PG8_SB(0, 1), cB + hstepB, voffB); PG8_STAGE(PG8_SA(0, 0), cA, voffA); PG8_STAGE(PG8_SA(0, 1), cA + hstepA, voffA);
    if (wr == 1) PG8_BAR;
    PG8_WAIT_V(2); PG8_BAR;
    PG8_STAGE(PG8_SB(1, 0), cB + kstep, voffB); PG8_STAGE(PG8_SA(1, 0), cA + kstep, voffA); PG8_STAGE(PG8_SB(1, 1), cB + hstepB + kstep, voffB);
    PG8_WAIT_V(6); PG8_BAR;
    for (;;) {
        const bool has_next = S.next(ui + 1, nxt);
        const char* nA = has_next ? PG8_PA(nxt) : cA; const char* nB = has_next ? PG8_PB(nxt) : cB;
        for (int t = 0; t < nt; t += 2) {
            const bool last = (t == nt - 2);
            const char* a1 = cA + (size_t)(t + 1) * kstep;
            const char* a2 = last ? nA : cA + (size_t)(t + 2) * kstep; const char* b2 = last ? nB : cB + (size_t)(t + 2) * kstep;
            const char* a3 = a2 + kstep; const char* b3 = b2 + kstep;
            PG8_LDB(B0, 0, 0); PG8_LDB(B1, 0, 1); PG8_SCHED; PG8_LDA(At, 0, 0); PG8_STAGE(PG8_SA(1, 1), a1 + hstepA, voffA);
            PG8_WAIT_V(8); PG8_WAIT_L(0); PG8_BAR; PG8_MMA(0, 0, At, B0); PG8_MMA(0, 1, At, B1); PG8_BAR; PG8_SCHED;
            PG8_LDA(At, 0, 1); PG8_STAGE(PG8_SB(0, 0), b2, voffB); PG8_STAGE(PG8_SB(0, 1), b2 + hstepB, voffB); PG8_STAGE(PG8_SA(0, 0), a2, voffA);
            PG8_WAIT_V(8); PG8_WAIT_L(0); PG8_BAR; PG8_MMA(1, 0, At, B0); PG8_MMA(1, 1, At, B1); PG8_BAR; PG8_SCHED;
            PG8_LDB(B0, 1, 0); PG8_LDB(B1, 1, 1); PG8_SCHED; PG8_LDA(At, 1, 0); PG8_STAGE(PG8_SA(0, 1), a2 + hstepA, voffA);
            PG8_WAIT_V(8); PG8_WAIT_L(0); PG8_BAR; PG8_MMA(0, 0, At, B0); PG8_MMA(0, 1, At, B1); PG8_BAR; PG8_SCHED;
            PG8_LDA(At, 1, 1); PG8_STAGE(PG8_SB(1, 0), b3, voffB); PG8_STAGE(PG8_SB(1, 1), b3 + hstepB, voffB); PG8_STAGE(PG8_SA(1, 0), a3, voffA);
            PG8_WAIT_V(8); PG8_WAIT_L(0); PG8_BAR; PG8_MMA(1, 0, At, B0); PG8_MMA(1, 1, At, B1); PG8_BAR; PG8_SCHED;
        }
        if (wr == 0) PG8_BAR;
        { int fr_ = fr, fq_ = fq; asm volatile("" : "+v"(fr_), "+v"(fq_)); E(acc, cur, wr, wc, fr_, fq_); }
        if (!has_next) break;
        if (nxt.kind == 0) {
#pragma unroll
            for (int a = 0; a < 2; ++a)
#pragma unroll
                for (int b = 0; b < 2; ++b)
#pragma unroll
                    for (int m = 0; m < 4; ++m)
#pragma unroll
                        for (int n = 0; n < 2; ++n) acc[a][b][m][n] = (f32x4){0.f, 0.f, 0.f, 0.f};
        }
        cur = nxt; cA = nA; cB = nB; ++ui;
        if (wr == 1) PG8_BAR;
    }
    PG8_WAIT_V(0);
    PG8_BAR;
#undef PG8_SA
#undef PG8_SB
#undef PG8_STAGE
#undef PG8_LDA
#undef PG8_LDB
#undef PG8_MMA
#undef PG8_WAIT_V
#undef PG8_WAIT_L
#undef PG8_BAR
#undef PG8_SCHED
#undef PG8_PA
#undef PG8_PB
}
}
constexpr int NWAVES = 8, NTHREADS = 512;
constexpr int NB = 8, SEQ = 2048, DM = 1024, M = NB * SEQ, DIN = 4312, DFF = 2816, NLAYER = 2;
constexpr int NZ = 4352;
constexpr int NGU = 2 * DFF;
constexpr float EPS_RMS = 1e-6f;
constexpr float LOG2E = 1.4426950408889634f;
constexpr float QSCALE = 0.125f * LOG2E;
constexpr int KVP = 152;

constexpr size_t MiB = 1u << 20;
constexpr size_t WS_CTL = 0, CTL_ZERO_BYTES = 65536;
constexpr size_t WS_CS = 1 * MiB;
constexpr size_t WS_SSQ = 2 * MiB;
constexpr size_t WS_WI = 3 * MiB;
constexpr size_t WS_SMALLW = 4 * MiB;
constexpr size_t SMALLW_LAYER = 98304 + 131072 + 262144;
constexpr size_t WS_W = 6 * MiB;
constexpr size_t W_LAYER = 29 * MiB, W_OFF_IN = 0, W_OFF_PAB = (size_t)NZ * 1024 * 2, W_OFF_OUT = W_OFF_PAB + 2 * MiB, W_OFF_GU = W_OFF_OUT + 2 * MiB, W_OFF_D = W_OFF_GU + (size_t)NGU * 1024 * 2;
static_assert(W_OFF_D + (size_t)1024 * DFF * 2 == W_LAYER, "weight map");
constexpr size_t WS_X16 = 64 * MiB;
constexpr size_t WS_QY = 96 * MiB;
constexpr size_t WS_QI = 128 * MiB;
constexpr size_t WS_MISC = 144 * MiB;
constexpr size_t WS_KV = 152 * MiB;
constexpr size_t WS_KI = 157 * MiB;
constexpr size_t WS_X1 = 128 * MiB;
constexpr size_t WS_GATES = 160 * MiB;
constexpr size_t WS_UV = 224 * MiB;
constexpr size_t WS_ACT = 160 * MiB;
constexpr size_t WS_END = 256 * MiB;
static_assert(WS_KV + (size_t)M * KVP * 2 <= WS_KI && WS_KI + (size_t)M * 64 * 2 <= WS_GATES && WS_ACT + (size_t)M * DFF * 2 <= WS_END, "ws map");

constexpr int LDS_BYTES = 155648;
constexpr int LDS_MISC = 151552;

#define RLX_AGENT __ATOMIC_RELAXED, __HIP_MEMORY_SCOPE_AGENT
#define LDS_WAIT() asm volatile("s_waitcnt lgkmcnt(0)" ::: "memory")
#define VM_WAIT() asm volatile("s_waitcnt vmcnt(0)" ::: "memory")

#define XB_TMO      128
#define XB_XCNT(j)  (256  + 64 * (j))
#define XB_XSUB(j)  (1280 + 64 * (j))
#define XB_XGEN(j)  (2304 + 64 * (j))
#define XB_TOP      3328
#define XB_TOPGEN   3392
#define XCD_BAR_WORDS 3456
#define XB_SPIN_CAP (1u << 18)
__device__ __forceinline__ unsigned xb_ld(unsigned* p)              { return __hip_atomic_load(p, __ATOMIC_RELAXED, __HIP_MEMORY_SCOPE_AGENT); }
__device__ __forceinline__ unsigned xb_add(unsigned* p, unsigned v) { return __hip_atomic_fetch_add(p, v, __ATOMIC_RELAXED, __HIP_MEMORY_SCOPE_AGENT); }
__device__ __forceinline__ unsigned xb_xcc_id() { return (unsigned)__builtin_amdgcn_s_getreg((3 << 11) | 20) & 0xFu; }
#define XB_SPIN(cond, bar) do { unsigned _sp = 0; while (cond) { __builtin_amdgcn_s_sleep(1); \
    if ((++_sp & 255u) == 0u) { if (xb_ld(&(bar)[XB_TMO])) break; if (_sp > XB_SPIN_CAP) { atomicAdd(&(bar)[XB_TMO], 1u); break; } } } } while (0)
struct XcdBarrier { unsigned* bar; unsigned x; volatile LAS unsigned* st; };
__device__ __forceinline__ XcdBarrier xcd_barrier_post(unsigned* bar, volatile LAS unsigned* st) {
    XcdBarrier b; b.bar = bar; b.x = xb_xcc_id(); b.st = st;
    if (threadIdx.x == 0) (void)xb_add(&bar[XB_XCNT(b.x)], 1u);
    return b;
}
__device__ __forceinline__ void xcd_barrier_complete(unsigned* bar, unsigned x, unsigned& nloc, unsigned& nx) {
    const unsigned G = gridDim.x * gridDim.y * gridDim.z;
    unsigned sum, cnt, mine, sp = 0u;
    for (;;) {
        sum = 0u; cnt = 0u; mine = 0u;
#pragma unroll
        for (unsigned j = 0; j < 16; ++j) { const unsigned c = xb_ld(&bar[XB_XCNT(j)]); sum += c; cnt += (c > 0u) ? 1u : 0u; }
        mine = xb_ld(&bar[XB_XCNT(x)]);
        if (sum == G) break;
        __builtin_amdgcn_s_sleep(1);
        if ((++sp & 255u) == 0u) { if (xb_ld(&bar[XB_TMO])) break; if (sp > XB_SPIN_CAP) { atomicAdd(&bar[XB_TMO], 1u); break; } }
    }
    nloc = mine > 0u ? mine : 1u; nx = cnt > 0u ? cnt : 1u;
}
__device__ __forceinline__ void xcd_barrier(const XcdBarrier& b) {
    asm volatile("s_waitcnt vmcnt(0)" ::: "memory");
    __syncthreads();
    if (threadIdx.x == 0) {
        unsigned* bar = b.bar; asm volatile("" : "+s"(bar));
        __builtin_amdgcn_s_waitcnt(0);
        unsigned nloc = b.st[0], nx = b.st[1];
        if (nloc == 0u) { xcd_barrier_complete(bar, b.x, nloc, nx); b.st[0] = nloc; b.st[1] = nx; }
        const unsigned old = xb_add(&bar[XB_XSUB(b.x)], 1u);
        const unsigned gen = old / nloc;
        if (old + 1u == (gen + 1u) * nloc) {
            __builtin_amdgcn_fence(__ATOMIC_RELEASE, "agent");
            asm volatile("s_waitcnt vmcnt(0)" ::: "memory");
            const unsigned og = xb_add(&bar[XB_TOP], 1u);
            const unsigned tg = og / nx;
            if (og + 1u == (tg + 1u) * nx) xb_add(&bar[XB_TOPGEN], 1u);
            else XB_SPIN(xb_ld(&bar[XB_TOPGEN]) == tg, bar);
            __builtin_amdgcn_fence(__ATOMIC_ACQUIRE, "agent");
            xb_add(&bar[XB_XGEN(b.x)], 1u);
            asm volatile("s_waitcnt vmcnt(0)" ::: "memory");
        } else {
            XB_SPIN(xb_ld(&bar[XB_XGEN(b.x)]) == gen, bar);
            __builtin_amdgcn_fence(__ATOMIC_ACQUIRE, "agent");
            asm volatile("s_waitcnt vmcnt(0)" ::: "memory");
        }
    }
    __syncthreads();
}

__device__ __forceinline__ float gelu_tanh_f(float x) {
    const float u = 0.7978845608028654f * (x + 0.044715f * x * x * x);
    const float e = __builtin_amdgcn_exp2f(-2.0f * LOG2E * u);
    return x * __builtin_amdgcn_rcpf(1.0f + e);
}
__device__ __forceinline__ float sigmoid_f(float x) { return __builtin_amdgcn_rcpf(1.0f + __builtin_amdgcn_exp2f(-LOG2E * x)); }

struct Frame {
    LAS unsigned char* lds;
    int tid, lane, wave, vcu, G;
    unsigned char* ws;
    const float* const* in;
};
struct In {
    const float* x; const int* pos; const float* norm_mix; const float* w_in; const float* kv_norm; const float* w_uk; const float* w_uv; const float* ln_v_g; const float* ln_v_b;
    const float* w_s; const float* b_s; const float* w_proj_a; const float* w_proj_b; const float* w_out; const float* norm_ffn; const float* w_gate; const float* w_up; const float* w_down; const float* final_norm;
};

__device__ __constant__ float c_inv[8] = {1.0f, 0.19392274474868576f, 0.03760603093086393f, 0.007292664737217109f, 0.001414213562373095f, 0.0002742481756762073f, 5.318295896944988e-05f, 1.031338537721246e-05f};

__device__ __forceinline__ void transpose_item64(const float* W4, int Nsrc, h16* WT, int ldt, int n0, int k0, const float* gain, LAS float* scr, int lane) {
    const int nq = lane & 15, kq = lane >> 4;
    f32x4 v[16];
#pragma unroll
    for (int i = 0; i < 16; ++i) v[i] = W4 ? *(const f32x4*)(W4 + (size_t)(k0 + 4 * i + kq) * Nsrc) : (f32x4){0.f, 0.f, 0.f, 0.f};
#pragma unroll
    for (int i = 0; i < 16; ++i) { const int kk = 4 * i + kq; f32x4 x = v[i]; if (gain) x = x * gain[k0 + kk]; *(LAS f32x4*)(scr + kk * 68 + 4 * (nq ^ (kk >> 3))) = x; }
    LDS_WAIT(); asm volatile("" ::: "memory");
    const int c = lane & 7;
#pragma unroll
    for (int j = 0; j < 8; ++j) { const int n = (lane >> 3) + 8 * j; const LAS float* sp = scr + (8 * c) * 68 + 4 * ((n >> 2) ^ c) + (n & 3);
        u32x4 o; o.x = pkh(sp[0 * 68], sp[1 * 68]); o.y = pkh(sp[2 * 68], sp[3 * 68]); o.z = pkh(sp[4 * 68], sp[5 * 68]); o.w = pkh(sp[6 * 68], sp[7 * 68]);
        *(u32x4*)(WT + (size_t)(n0 + n) * ldt + k0 + 8 * c) = o; }
    LDS_WAIT(); asm volatile("" ::: "memory");
}
__device__ __forceinline__ int win_src_col(int n) {
    if (n < 512) return n;
    if (n < 1024) return 656 + (n - 512);
    if (n < 2048) return 1240 + (n - 1024);
    if (n < 4096) return 2264 + (n - 2048);
    if (n < 4224) return 512 + (n - 4096);
    if (n < 4240) return 640 + (n - 4224);
    if (n < 4304) return 1168 + (n - 4240);
    if (n < 4312) return 1232 + (n - 4304);
    return -1;
}
__device__ __forceinline__ void p0_prologue(const Frame& F, const In& I) {
    LAS float* scr = (LAS float*)(F.lds + F.wave * 17408);
    int lane = F.lane; asm volatile("" : "+v"(lane));
    const int gw = F.vcu * NWAVES + F.wave, NGW = F.G * NWAVES;
    constexpr int I_IN = (NZ / 64) * 16, I_PA = 16 * 8, I_OUT = 16 * 16, I_GU = (NGU / 64) * 16, I_D = 16 * (DFF / 64);
    constexpr int I_LAYER = I_IN + 2 * I_PA + I_OUT + I_GU + I_D;
    const int n4 = 4 * (lane & 15);
    for (int it = gw; it < NLAYER * I_LAYER; it += NGW) {
        const int l = it / I_LAYER; int r = it - l * I_LAYER;
        unsigned char* wl = F.ws + WS_W + (size_t)l * W_LAYER;
        if (r < I_IN) { const int nb = r / 16, kb = r % 16, sc = win_src_col(nb * 64 + n4);
            transpose_item64(sc >= 0 ? I.w_in + (size_t)l * DM * DIN + sc : nullptr, DIN, (h16*)(wl + W_OFF_IN), 1024, nb * 64, kb * 64, I.norm_mix + l * DM, scr, lane); continue; }
        r -= I_IN;
        if (r < I_PA) { const int nb = r / 8, kb = r % 8;
            transpose_item64(I.w_proj_a + (size_t)l * 512 * 1024 + nb * 64 + n4, 1024, (h16*)(wl + W_OFF_PAB), 1024, nb * 64, kb * 64, nullptr, scr, lane); continue; }
        r -= I_PA;
        if (r < I_PA) { const int nb = r / 8, kb = r % 8;
            transpose_item64(I.w_proj_b + (size_t)l * 512 * 1024 + nb * 64 + n4, 1024, (h16*)(wl + W_OFF_PAB) + 512, 1024, nb * 64, kb * 64, nullptr, scr, lane); continue; }
        r -= I_PA;
        if (r < I_OUT) { const int nb = r / 16, kb = r % 16;
            transpose_item64(I.w_out + (size_t)l * 1024 * 1024 + nb * 64 + n4, 1024, (h16*)(wl + W_OFF_OUT), 1024, nb * 64, kb * 64, nullptr, scr, lane); continue; }
        r -= I_OUT;
        if (r < I_GU) { const int nb = r / 16, kb = r % 16, R = nb * 64 + n4, pn = R >> 8, rem = R & 255;
            const int a = 128 * pn + 64 * (rem >> 7) + 16 * ((rem >> 5) & 3) + 4 * ((rem >> 3) & 3);
            const float* src = (((rem >> 2) & 1) ? I.w_up : I.w_gate) + (size_t)l * DM * DFF + a;
            transpose_item64(src, DFF, (h16*)(wl + W_OFF_GU), 1024, nb * 64, kb * 64, I.norm_ffn + l * DM, scr, lane); continue; }
        r -= I_GU;
        { const int nb = r / (DFF / 64), kb = r % (DFF / 64);
            transpose_item64(I.w_down + (size_t)l * DFF * 1024 + nb * 64 + n4, 1024, (h16*)(wl + W_OFF_D), DFF, nb * 64, kb * 64, nullptr, scr, lane); }
    }
    const int gt = F.vcu * NTHREADS + F.tid, NGT = F.G * NTHREADS;
    for (int i = gt; i < NLAYER * 49152; i += NGT) { const int l = i / 49152, e = i % 49152, h = e / (128 * 48), c = (e / 48) % 128, n = e % 48;
        ((h16*)(F.ws + WS_SMALLW + (size_t)l * SMALLW_LAYER))[e] = (h16)I.w_uk[(((size_t)l * 8 + h) * 48 + n) * 128 + c]; }
    for (int i = gt; i < NLAYER * 65536; i += NGT) { const int l = i / 65536, e = i % 65536, h = e / (64 * 128), d = (e / 128) % 64, c = e % 128;
        ((h16*)(F.ws + WS_SMALLW + (size_t)l * SMALLW_LAYER + 98304))[e] = (h16)I.w_uv[(((size_t)l * 8 + h) * 128 + c) * 64 + d]; }
    for (int i = gt; i < NLAYER * 131072; i += NGT) { const int l = i / 131072, e = i % 131072, t = (e / 128) % 128, s = e % 128;
        ((h16*)(F.ws + WS_SMALLW + (size_t)l * SMALLW_LAYER + 98304 + 131072))[e] = (s <= t) ? (h16)I.w_s[(size_t)l * 131072 + e] : (h16)0.f; }
    for (int i = gt; i < M * 8; i += NGT) { const int tok = i >> 3, f = i & 7; const float ang = (float)I.pos[tok] * c_inv[f];
        float* cs = (float*)(F.ws + WS_CS) + (size_t)tok * 16; cs[f] = cosf(ang); cs[8 + f] = sinf(ang); }
    for (int m = gw; m < M; m += NGW) {
        const f32x4* xr = (const f32x4*)(I.x + (size_t)m * DM) + lane; u32x2* o8 = (u32x2*)((h16*)(F.ws + WS_X16) + (size_t)m * DM) + lane;
#pragma unroll
        for (int j = 0; j < 4; ++j) { const f32x4 v = xr[64 * j]; float s = (v.x * v.x + v.y * v.y) + (v.z * v.z + v.w * v.w);
#pragma unroll
            for (int o = 1; o < 64; o <<= 1) s += __shfl_xor(s, o);
            o8[64 * j] = (u32x2){pkh(v.x, v.y), pkh(v.z, v.w)};
            if (lane == 0) ((float*)(F.ws + WS_SSQ))[(size_t)m * 4 + j] = s; }
    }
}

__device__ __forceinline__ float row_rstd(const float* ssq, int row) {
    const f32x4 a = *(const f32x4*)(ssq + (size_t)row * 4);
    return rsqrtf(((a.x + a.y) + (a.z + a.w)) * (1.0f / DM) + EPS_RMS);
}

typedef f32x4 Acc[2][2][4][2];

struct EpiA {
    static constexpr bool PERM = true;
    unsigned char* ws;
    __device__ __forceinline__ void operator()(Acc& acc, const pg8::Unit& u, int wr, int wc, int fr, int fq) const {
        const int pn = u.pn; h16* base; int ldc, colt; bool act = false;
        if (pn < 2) { base = (h16*)(ws + WS_QY); ldc = 1024; colt = pn * 256; }
        else if (pn < 4) { base = (h16*)(ws + WS_QI); ldc = 512; colt = (pn - 2) * 256; }
        else if (pn < 8) { base = (h16*)(ws + WS_UV); ldc = 1024; colt = (pn - 4) * 256; act = true; }
        else if (pn < 16) { base = (h16*)(ws + WS_GATES); ldc = 2048; colt = (pn - 8) * 256; }
        else { base = (h16*)(ws + WS_MISC); ldc = 256; colt = 0; }
        const int row0 = u.pm * 256 + wr * 64 + fr, col0 = colt + wc * 32 + 8 * fq;
        const float* ssq = (const float*)(ws + WS_SSQ);
#pragma unroll
        for (int ai = 0; ai < 2; ++ai)
#pragma unroll
            for (int m = 0; m < 4; ++m) { const int row = row0 + ai * 128 + m * 16; const float rs = row_rstd(ssq, row); h16* rowp = base + (size_t)row * ldc + col0;
#pragma unroll
                for (int bj = 0; bj < 2; ++bj) { f32x4 v0 = acc[ai][bj][m][0] * rs, v1 = acc[ai][bj][m][1] * rs;
                    if (act) {
#pragma unroll
                        for (int i = 0; i < 4; ++i) { v0[i] = gelu_tanh_f(v0[i]); v1[i] = gelu_tanh_f(v1[i]); } }
                    u32x4 w; w.x = pkh(v0[0], v0[1]); w.y = pkh(v0[2], v0[3]); w.z = pkh(v1[0], v1[1]); w.w = pkh(v1[2], v1[3]);
                    *(u32x4*)(rowp + bj * 128) = w; }
                asm volatile("" ::: "memory"); }
    }
};

struct EpiD {
    static constexpr bool PERM = true;
    unsigned char* ws;
    __device__ __forceinline__ void operator()(Acc& acc, const pg8::Unit& u, int wr, int wc, int fr, int fq) const {
        const int row0 = u.pm * 256 + wr * 64 + fr, col0 = u.pn * 256 + wc * 32 + 8 * fq;
        const h16* gates = (const h16*)(ws + WS_GATES); h16* mg = (h16*)(ws + WS_X16);
#pragma unroll
        for (int ai = 0; ai < 2; ++ai)
#pragma unroll
            for (int m = 0; m < 4; ++m) { const int row = row0 + ai * 128 + m * 16;
#pragma unroll
                for (int bj = 0; bj < 2; ++bj) { const int col = col0 + bj * 128;
                    const h16x8 gb = *(const h16x8*)(gates + (size_t)row * 2048 + 1024 + col);
                    if (u.kind == 0) { const h16x8 ga = *(const h16x8*)(gates + (size_t)row * 2048 + col);
#pragma unroll
                        for (int i = 0; i < 8; ++i) { const float a = fminf(fmaxf((float)ga[i], -30.f), 30.f), b = fminf(fmaxf((float)gb[i], -30.f), 30.f);
                            const float ratio = (1.0f + __builtin_amdgcn_exp2f(-LOG2E * b)) * __builtin_amdgcn_rcpf(1.0f + __builtin_amdgcn_exp2f(-LOG2E * a));
                            acc[ai][bj][m][i >> 2][i & 3] *= ratio; }
                    } else { float v[8];
#pragma unroll
                        for (int i = 0; i < 8; ++i) { const float b = fminf(fmaxf((float)gb[i], -30.f), 30.f); v[i] = acc[ai][bj][m][i >> 2][i & 3] * sigmoid_f(b); }
                        u32x4 w; w.x = pkh(v[0], v[1]); w.y = pkh(v[2], v[3]); w.z = pkh(v[4], v[5]); w.w = pkh(v[6], v[7]);
                        *(u32x4*)(mg + (size_t)row * 1024 + col) = w; } }
                asm volatile("" ::: "memory"); }
    }
};

struct EpiRes {
    static constexpr bool PERM = false;
    const float* resid; float* out; h16* x16; float* ssq; LAS float* P;
    __device__ __forceinline__ void operator()(Acc& acc, const pg8::Unit& u, int wr, int wc, int fr, int fq) const {
        const int row0 = u.pm * 256 + wr * 64 + fr, col0 = u.pn * 256 + wc * 32 + 4 * fq;
#pragma unroll
        for (int ai = 0; ai < 2; ++ai)
#pragma unroll
            for (int m = 0; m < 4; ++m) { const int row = row0 + ai * 128 + m * 16; float ss = 0.f;
#pragma unroll
                for (int bj = 0; bj < 2; ++bj)
#pragma unroll
                    for (int n = 0; n < 2; ++n) { const size_t off = (size_t)row * 1024 + col0 + bj * 128 + n * 16;
                        const f32x4 v = *(const f32x4*)(resid + off) + acc[ai][bj][m][n];
                        *(f32x4*)(out + off) = v; *(u32x2*)(x16 + off) = (u32x2){pkh(v[0], v[1]), pkh(v[2], v[3])};
                        ss += (v[0] * v[0] + v[1] * v[1]) + (v[2] * v[2] + v[3] * v[3]); }
                ss += __shfl_xor(ss, 16); ss += __shfl_xor(ss, 32);
                if (fq == 0) P[(ai * 128 + wr * 64 + m * 16 + fr) * 4 + wc] = ss;
                asm volatile("" ::: "memory"); }
        asm volatile("s_waitcnt lgkmcnt(0)" ::: "memory"); __builtin_amdgcn_s_barrier(); asm volatile("" ::: "memory");
        { const int t = (wr * 4 + wc) * 64 + fq * 16 + fr; if (t < 256) { const f32x4 v = *(const LAS f32x4*)(P + t * 4); ssq[(size_t)(u.pm * 256 + t) * 4 + u.pn] = (v.x + v.y) + (v.z + v.w); } }
        asm volatile("s_waitcnt lgkmcnt(0)" ::: "memory"); __builtin_amdgcn_s_barrier(); asm volatile("" ::: "memory");
    }
};

struct EpiF {
    static constexpr bool PERM = true;
    unsigned char* ws;
    __device__ __forceinline__ void operator()(Acc& acc, const pg8::Unit& u, int wr, int wc, int fr, int fq) const {
        const int row0 = u.pm * 256 + wr * 64 + fr, col0 = u.pn * 128 + wc * 16 + 4 * fq;
        const float* ssq = (const float*)(ws + WS_SSQ); h16* act = (h16*)(ws + WS_ACT);
#pragma unroll
        for (int ai = 0; ai < 2; ++ai)
#pragma unroll
            for (int m = 0; m < 4; ++m) { const int row = row0 + ai * 128 + m * 16; const float rs = row_rstd(ssq, row);
#pragma unroll
                for (int bj = 0; bj < 2; ++bj) { const f32x4 g = acc[ai][bj][m][0] * rs, uu = acc[ai][bj][m][1] * rs; float v[4];
#pragma unroll
                    for (int i = 0; i < 4; ++i) v[i] = g[i] * sigmoid_f(g[i]) * uu[i];
                    *(u32x2*)(act + (size_t)row * DFF + col0 + bj * 64) = (u32x2){pkh(v[0], v[1]), pkh(v[2], v[3])}; }
                asm volatile("" ::: "memory"); }
    }
};

__device__ __forceinline__ void final_norm_phase(const Frame& F, float* out, const float* g) {
    int lane = F.lane; asm volatile("" : "+v"(lane));
    const int gw = F.vcu * NWAVES + F.wave, NGW = F.G * NWAVES;
    for (int m = gw; m < M; m += NGW) {
        f32x4* xr = (f32x4*)(out + (size_t)m * DM) + lane; f32x4 v[4]; float s = 0.f;
#pragma unroll
        for (int j = 0; j < 4; ++j) { v[j] = xr[64 * j]; s += (v[j].x * v[j].x + v[j].y * v[j].y) + (v[j].z * v[j].z + v[j].w * v[j].w); }
#pragma unroll
        for (int o = 1; o < 64; o <<= 1) s += __shfl_xor(s, o);
        const float rs = rsqrtf(s * (1.0f / DM) + EPS_RMS);
#pragma unroll
        for (int j = 0; j < 4; ++j) { const f32x4 gg = ((const f32x4*)g)[lane + 64 * j]; xr[64 * j] = v[j] * rs * gg; }
    }
}
__device__ __forceinline__ unsigned wlane(unsigned val, int ln, unsigned old) {
    unsigned keep;
    asm volatile("s_mov_b32 %1, m0\n\ts_mov_b32 m0, %3\n\ts_nop 3\n\tv_writelane_b32 %0, %2, m0\n\ts_mov_b32 m0, %1" : "+v"(old), "=&s"(keep) : "s"(val), "s"(ln));
    return old;
}
__device__ __forceinline__ void cnt_ge(int& c, float x, float m) { asm("v_cmp_ge_f32 vcc, %1, %2\n\tv_addc_co_u32 %0, vcc, 0, %0, vcc" : "+v"(c) : "v"(x), "v"(m) : "vcc"); }
__device__ __forceinline__ void cnt_gt(int& c, float x, float m) { asm("v_cmp_gt_f32 vcc, %1, %2\n\tv_addc_co_u32 %0, vcc, 0, %0, vcc" : "+v"(c) : "v"(x), "v"(m) : "vcc"); }
__device__ __forceinline__ void ballot_ge_to_lane(unsigned& wlo, unsigned& whi, float x, float tau, int ln) {
    unsigned keep;
    asm volatile("v_cmp_ge_f32 vcc, %3, %4\n\ts_mov_b32 %2, m0\n\ts_mov_b32 m0, %5\n\ts_nop 3\n\tv_writelane_b32 %0, vcc_lo, m0\n\tv_writelane_b32 %1, vcc_hi, m0\n\ts_mov_b32 m0, %2"
                 : "+v"(wlo), "+v"(whi), "=&s"(keep) : "v"(x), "v"(tau), "s"(ln) : "vcc");
}
__device__ __forceinline__ int half_sum_dpp(int v, int hf) {
    v += __builtin_amdgcn_update_dpp(0, v, 0x111, 0xf, 0xf, true);
    v += __builtin_amdgcn_update_dpp(0, v, 0x112, 0xf, 0xf, true);
    v += __builtin_amdgcn_update_dpp(0, v, 0x114, 0xf, 0xf, true);
    v += __builtin_amdgcn_update_dpp(0, v, 0x118, 0xf, 0xf, true);
    v += __builtin_amdgcn_update_dpp(0, v, 0x142, 0xa, 0xf, false);
    const int s0 = __builtin_amdgcn_readlane(v, 31), s1 = __builtin_amdgcn_readlane(v, 63);
    return hf ? s1 : s0;
}
__device__ __forceinline__ int crow(int R, int hf) { return (R & 3) + 8 * (R >> 2) + 4 * hf; }
__device__ __forceinline__ float half_swap_max(float v) { auto rr = __builtin_amdgcn_permlane32_swap(__float_as_uint(v), __float_as_uint(v), false, false); return fmaxf(__uint_as_float(rr[0]), __uint_as_float(rr[1])); }
__device__ __forceinline__ float half_swap_sum(float v) { auto rr = __builtin_amdgcn_permlane32_swap(__float_as_uint(v), __float_as_uint(v), false, false); return __uint_as_float(rr[0]) + __uint_as_float(rr[1]); }
__device__ __forceinline__ void rope8(const h16x8 x1, const h16x8 x2, const float* cs, int which, float scale, float (&o)[8]) {
    const f32x4 c0 = *(const f32x4*)(cs), c1 = *(const f32x4*)(cs + 4), s0 = *(const f32x4*)(cs + 8), s1 = *(const f32x4*)(cs + 12);
#pragma unroll
    for (int j = 0; j < 8; ++j) { const float c = j < 4 ? c0[j & 3] : c1[j & 3], s = j < 4 ? s0[j & 3] : s1[j & 3]; const float a = (float)x1[j], b = (float)x2[j];
        o[j] = (which == 0 ? (a * c - b * s) : (b * c + a * s)) * scale; }
}
__device__ __forceinline__ u32x4 pack8(const float (&v)[8]) { u32x4 w; w.x = pkh(v[0], v[1]); w.y = pkh(v[2], v[3]); w.z = pkh(v[4], v[5]); w.w = pkh(v[6], v[7]); return w; }

__device__ __forceinline__ void phaseB(const Frame& F, const In& I, int l) {
    unsigned char* ws = F.ws; asm volatile("" : "+s"(ws)); int lane = F.lane, tid = F.tid; asm volatile("" : "+v"(lane), "+v"(tid)); const int w = F.wave;
    const h16* MISC = (const h16*)(ws + WS_MISC); h16* KV = (h16*)(ws + WS_KV); h16* KI = (h16*)(ws + WS_KI); float* WI = (float*)(ws + WS_WI); const float* CS = (const float*)(ws + WS_CS);
    int blk = F.vcu; asm volatile("" : "+s"(blk));
#pragma unroll
    for (int it = 0; it < 2; ++it) {
        const int tok = blk * 64 + w * 8 + it * 4 + (lane >> 4), i = lane & 15;
        const h16* mr = MISC + (size_t)tok * 256; const float* cs = CS + (size_t)tok * 16;
        const h16x8 x = *(const h16x8*)(mr + 8 * i);
        float ss = 0.f;
#pragma unroll
        for (int j = 0; j < 8; ++j) ss += (float)x[j] * (float)x[j];
        ss += __shfl_xor(ss, 1); ss += __shfl_xor(ss, 2); ss += __shfl_xor(ss, 4); ss += __shfl_xor(ss, 8);
        const float rs = rsqrtf(ss * (1.0f / 128.f) + EPS_RMS);
        { float o[8]; const float* kn = I.kv_norm + l * 128 + 8 * i;
#pragma unroll
          for (int j = 0; j < 8; ++j) o[j] = (float)x[j] * rs * kn[j];
          *(u32x4*)(KV + (size_t)tok * KVP + 8 * i) = pack8(o); }
        if (i < 2) { float o[8]; rope8(*(const h16x8*)(mr + 128), *(const h16x8*)(mr + 136), cs, i, 1.0f, o); *(u32x4*)(KV + (size_t)tok * KVP + 128 + 8 * i) = pack8(o); }
        else if (i == 2) { *(u32x4*)(KV + (size_t)tok * KVP + 144) = (u32x4){0u, 0u, 0u, 0u}; }
        else if (i < 11) { const int ii = i - 3;
            if (ii < 2) { float o[8]; rope8(*(const h16x8*)(mr + 144), *(const h16x8*)(mr + 152), cs, ii, 1.0f, o); *(u32x4*)(KI + (size_t)tok * 64 + 8 * ii) = pack8(o); }
            else *(u32x4*)(KI + (size_t)tok * 64 + 8 * ii) = *(const u32x4*)(mr + 144 + 8 * ii); }
        else if (i == 11) { const h16x8 wv = *(const h16x8*)(mr + 208); const float sc = 0.35355339059327373f * 0.125f;
            *(f32x4*)(WI + (size_t)tok * 8) = (f32x4){(float)wv[0] * sc, (float)wv[1] * sc, (float)wv[2] * sc, (float)wv[3] * sc};
            *(f32x4*)(WI + (size_t)tok * 8 + 4) = (f32x4){(float)wv[4] * sc, (float)wv[5] * sc, (float)wv[6] * sc, (float)wv[7] * sc}; }
    }
    const int b = blk >> 5, chunk = (blk >> 1) & 15, gh = blk & 1;
    const size_t tok0 = (size_t)b * SEQ + chunk * 128;
    const h16* UV = (const h16*)(ws + WS_UV); h16* QY = (h16*)(ws + WS_QY);
    LAS unsigned char* VN = F.lds;
    constexpr int VPB = 576;
    { const int i16 = lane & 15, rq = lane >> 4; h16x8 v[4][4];
#pragma unroll
      for (int it = 0; it < 4; ++it)
#pragma unroll
          for (int i = 0; i < 4; ++i) v[it][i] = *(const h16x8*)(UV + (tok0 + 16 * w + 4 * it + rq) * 1024 + 512 + 8 * i16 + 128 * (i & 1) + 256 * ((i >> 1) ^ gh));
      f32x4 lgv[2][2], lbv[2][2];
#pragma unroll
      for (int i = 0; i < 2; ++i) { const int col = 256 * gh + 128 * i + 8 * i16; const float* lg = I.ln_v_g + l * 512 + col; const float* lb = I.ln_v_b + l * 512 + col;
          lgv[i][0] = *(const f32x4*)lg; lgv[i][1] = *(const f32x4*)(lg + 4); lbv[i][0] = *(const f32x4*)lb; lbv[i][1] = *(const f32x4*)(lb + 4); }
#pragma unroll
      for (int it = 0; it < 4; ++it) { float s = 0.f, q = 0.f;
#pragma unroll
          for (int i = 0; i < 4; ++i)
#pragma unroll
              for (int j = 0; j < 8; ++j) { const float x = (float)v[it][i][j]; s += x; q = fmaf(x, x, q); }
          s += __shfl_xor(s, 1); q += __shfl_xor(q, 1); s += __shfl_xor(s, 2); q += __shfl_xor(q, 2); s += __shfl_xor(s, 4); q += __shfl_xor(q, 4); s += __shfl_xor(s, 8); q += __shfl_xor(q, 8);
          const float mu = s * (1.0f / 512.f), var = fmaxf(q * (1.0f / 512.f) - mu * mu, 0.f), rs = rsqrtf(var + 1e-5f);
          const int t = 16 * w + 4 * it + rq;
#pragma unroll
          for (int i = 0; i < 2; ++i) { const h16x8 x = v[it][i]; float o[8];
#pragma unroll
              for (int j = 0; j < 8; ++j) o[j] = ((float)x[j] - mu) * rs * lgv[i][j >> 2][j & 3] + lbv[i][j >> 2][j & 3];
              *(LAS u32x4*)(VN + t * VPB + (128 * i + 8 * i16) * 2) = pack8(o); } } }
    asm volatile("" ::: "memory");
    { const int gp = w & 3, g = 4 * gh + gp, rh = w >> 2, r = lane & 31, hf = lane >> 5;
      const h16* WS16 = (const h16*)(ws + WS_SMALLW + (size_t)l * SMALLW_LAYER + 98304 + 131072) + (size_t)g * 128 * 128;
      const int troff = (8 * hf + ((lane & 15) >> 2)) * VPB + (gp * 64 + 16 * ((lane >> 4) & 1) + 4 * (lane & 3)) * 2;
      h16x8 wf[2][8];
#pragma unroll
      for (int tb = 0; tb < 2; ++tb)
#pragma unroll
          for (int s = 0; s < 8; ++s) wf[tb][s] = *(const h16x8*)(WS16 + (size_t)(64 * rh + 32 * tb + r) * 128 + 16 * s + 8 * hf);
      float bsv[2]; u32x2 uu[2][2][4];
#pragma unroll
      for (int tb = 0; tb < 2; ++tb) { const int t = 64 * rh + 32 * tb + r; bsv[tb] = I.b_s[((size_t)l * 8 + g) * 128 + t];
#pragma unroll
          for (int db = 0; db < 2; ++db)
#pragma unroll
              for (int gg = 0; gg < 4; ++gg) uu[tb][db][gg] = *(const u32x2*)(UV + (tok0 + t) * 1024 + g * 64 + 32 * db + 8 * gg + 4 * hf); }
      LDS_WAIT(); __syncthreads();
#pragma unroll
      for (int tb = 0; tb < 2; ++tb) { const int nks = 4 * rh + 2 * tb + 2; const size_t tk = tok0 + 64 * rh + 32 * tb + r;
#pragma unroll
        for (int db = 0; db < 2; ++db) { f32x16 D = {};
#pragma unroll
            for (int s = 0; s < 8; ++s) if (s < nks) {
                const v4i16_t lo = __builtin_amdgcn_ds_read_tr16_b64_v4i16((LAS v4i16_t*)(VN + troff + (16 * s) * VPB + 64 * db));
                const v4i16_t hi = __builtin_amdgcn_ds_read_tr16_b64_v4i16((LAS v4i16_t*)(VN + troff + (16 * s + 4) * VPB + 64 * db));
                typedef short s16x8 __attribute__((ext_vector_type(8)));
                const s16x8 av = {lo[0], lo[1], lo[2], lo[3], hi[0], hi[1], hi[2], hi[3]};
                D = __builtin_amdgcn_mfma_f32_32x32x16_f16(__builtin_bit_cast(h16x8, av), wf[tb][s], D, 0, 0, 0); }
#pragma unroll
            for (int gg = 0; gg < 4; ++gg) { const u32x2 uv2 = uu[tb][db][gg]; const float bb = bsv[tb];
                const float y0 = h2f_lo(uv2.x) * (D[4 * gg] + bb), y1 = h2f_hi(uv2.x) * (D[4 * gg + 1] + bb), y2 = h2f_lo(uv2.y) * (D[4 * gg + 2] + bb), y3 = h2f_hi(uv2.y) * (D[4 * gg + 3] + bb);
                *(u32x2*)(QY + tk * 1024 + 512 + g * 64 + 32 * db + 8 * gg + 4 * hf) = (u32x2){pkh(y0, y1), pkh(y2, y3)}; } } } }
    __syncthreads();
}

constexpr int C_KIB = 0, C_KIBUF = 256 * 128;
constexpr int C_QL = 0, C_QLW = KVP * 2 * 32;
constexpr int C_WQ = 81920;
constexpr int C_KVS = 90112, C_KVSLOT = 32 * KVP * 2;

__device__ __forceinline__ void phaseC_select(const Frame& F, int l, int b, int qt) {
    unsigned char* ws = F.ws; asm volatile("" : "+s"(ws)); int lane = F.lane, tid = F.tid; asm volatile("" : "+v"(lane), "+v"(tid)); const int w = F.wave, r = lane & 31, hf = lane >> 5;
    const h16* QI = (const h16*)(ws + WS_QI); const h16* KI = (const h16*)(ws + WS_KI); const float* WI = (const float*)(ws + WS_WI); const float* CS = (const float*)(ws + WS_CS);
    h16* QY = (h16*)(ws + WS_QY); const h16* KV = (const h16*)(ws + WS_KV);
    const h16* WUKT = (const h16*)(ws + WS_SMALLW + (size_t)l * SMALLW_LAYER); const h16* WUVT = (const h16*)(ws + WS_SMALLW + (size_t)l * SMALLW_LAYER + 98304);
    LAS unsigned char* lds = F.lds;
    const int t0 = 32 * qt, NT = qt + 1; const size_t tokbase = (size_t)b * SEQ;
    h16x8 afr[4]; float wreg[16];
    { const int qq = 2 * ((r >> 2) & 1) + (r >> 4), head = (r & 3) + 4 * ((r >> 3) & 1); const size_t tokA = tokbase + t0 + 4 * w + qq;
      const h16* qsrc = QI + tokA * 512 + head * 64;
      { float o[8]; rope8(*(const h16x8*)(qsrc), *(const h16x8*)(qsrc + 8), CS + tokA * 16, hf, 1.0f, o); afr[0] = __builtin_bit_cast(h16x8, pack8(o)); }
#pragma unroll
      for (int s = 1; s < 4; ++s) afr[s] = *(const h16x8*)(qsrc + 16 * s + 8 * hf);
      const float* wp = WI + (tokbase + t0 + 4 * w + 2 * hf) * 8;
#pragma unroll
      for (int R = 0; R < 16; ++R) wreg[R] = wp[R]; }
    float SC[128];
    const float QNAN = __uint_as_float(0x7fc00000u);
#pragma unroll
    for (int i = 0; i < 128; ++i) SC[i] = QNAN;
    const int NCK = (NT + 7) >> 3, tq0 = t0 + 4 * w + 2 * hf;
    const int drow = lane >> 3, dslot = lane & 7;
    const h16* kisrc = KI + (tokbase + 32 * w + drow) * 64 + 8 * (dslot ^ drow);
#define KI_STAGE(ck_, buf_) do { _Pragma("unroll") for (int i_ = 0; i_ < 4; ++i_) \
        __builtin_amdgcn_global_load_lds((const unsigned*)(kisrc + (size_t)(256 * (ck_) + 8 * i_) * 64), (LAS unsigned*)(lds + C_KIB + (buf_) * C_KIBUF + (4 * w + i_) * 1024), 16, 0, 0); } while (0)
    KI_STAGE(0, 0);
    VM_WAIT(); __syncthreads();
    const int kroff = r * 128, kx = r & 7;
#pragma unroll 1
    for (int ck = 0; ck < NCK; ++ck) {
        LAS unsigned char* kb = lds + C_KIB + (ck & 1) * C_KIBUF;
        if (ck + 1 < NCK) KI_STAGE(ck + 1, (ck + 1) & 1);
#pragma unroll
        for (int i = 0; i < 112; ++i) SC[i] = SC[i + 16];
#pragma unroll
        for (int jj = 0; jj < 8; ++jj) {
            f32x16 D = {};
#pragma unroll
            for (int s = 0; s < 4; ++s) { const h16x8 bb = *(const LAS h16x8*)(kb + jj * 4096 + kroff + 16 * ((2 * s + hf) ^ kx)); D = __builtin_amdgcn_mfma_f32_32x32x16_f16(afr[s], bb, D, 0, 0, 0); }
            float s0 = 0.f, s1 = 0.f;
#pragma unroll
            for (int R = 0; R < 8; ++R) { s0 = fmaf(wreg[R], fmaxf(D[R], 0.f), s0); s1 = fmaf(wreg[8 + R], fmaxf(D[8 + R], 0.f), s1); }
            const int k = 256 * ck + 32 * jj + r;
            SC[112 + 2 * jj] = (k > tq0) ? QNAN : s0; SC[113 + 2 * jj] = (k > tq0 + 1) ? QNAN : s1;
        }
        LDS_WAIT(); VM_WAIT(); __syncthreads();
    }
#undef KI_STAGE
    const int G0 = 8 - NCK;
#define SEL_COUNT2(c0, c1, CNT, m0, m1) do { int a0_ = 0, a1_ = 0; \
        _Pragma("unroll") for (int g = 0; g < 8; ++g) if (g >= G0) { _Pragma("unroll") for (int jj = 0; jj < 8; ++jj) { const int j = 8 * g + jj; CNT(a0_, SC[2 * j], (m0)); CNT(a1_, SC[2 * j + 1], (m1)); } } \
        c0 = half_sum_dpp(a0_, hf); c1 = half_sum_dpp(a1_, hf); } while (0)
    float tau0 = -3.0e38f, tau1 = -3.0e38f;
    if (qt >= 8) {
        float lo0 = INFINITY, lo1 = INFINITY, hi0 = -INFINITY, hi1 = -INFINITY;
#pragma unroll
        for (int j = 0; j < 64; ++j) { const float a = SC[2 * j], c = SC[2 * j + 1]; lo0 = fminf(lo0, a); hi0 = fmaxf(hi0, a); lo1 = fminf(lo1, c); hi1 = fmaxf(hi1, c); }
#pragma unroll
        for (int o = 1; o < 32; o <<= 1) { lo0 = fminf(lo0, __shfl_xor(lo0, o)); lo1 = fminf(lo1, __shfl_xor(lo1, o)); hi0 = fmaxf(hi0, __shfl_xor(hi0, o)); hi1 = fmaxf(hi1, __shfl_xor(hi1, o)); }
        bool done0 = false, done1 = false;
        { int g0, g1, e0, e1; const float zero = 0.f; SEL_COUNT2(g0, g1, cnt_gt, zero, zero); SEL_COUNT2(e0, e1, cnt_ge, zero, zero);
          const float tiny = __uint_as_float(1u);
          if (g0 >= 256) { lo0 = 0.f; if (g0 == 256) { lo0 = tiny; done0 = true; } } else if (e0 >= 256) { lo0 = 0.f; done0 = true; } else hi0 = 0.f;
          if (g1 >= 256) { lo1 = 0.f; if (g1 == 256) { lo1 = tiny; done1 = true; } } else if (e1 >= 256) { lo1 = 0.f; done1 = true; } else hi1 = 0.f; }
#pragma unroll 1
        for (int it = 0; it < 32; ++it) {
            const float mid0 = 0.5f * (lo0 + hi0), mid1 = 0.5f * (lo1 + hi1);
            if (!done0 && (mid0 <= lo0 || mid0 >= hi0)) done0 = true;
            if (!done1 && (mid1 <= lo1 || mid1 >= hi1)) done1 = true;
            if (__all(done0 && done1)) break;
            int c0, c1; SEL_COUNT2(c0, c1, cnt_ge, mid0, mid1);
            if (!done0) { if (c0 >= 256) { lo0 = mid0; if (c0 == 256) done0 = true; } else hi0 = mid0; }
            if (!done1) { if (c1 >= 256) { lo1 = mid1; if (c1 == 256) done1 = true; } else hi1 = mid1; }
        }
        tau0 = lo0; tau1 = lo1;
    }
#undef SEL_COUNT2
    unsigned w00 = 0u, w01 = 0u, w10 = 0u, w11 = 0u;
#pragma unroll
    for (int g = 0; g < 8; ++g) if (g >= G0) {
#pragma unroll
        for (int jj = 0; jj < 8; ++jj) { const int j = 8 * g + jj, jt = 8 * (g - G0) + jj;
            ballot_ge_to_lane(w00, w10, SC[2 * j], tau0, jt); ballot_ge_to_lane(w01, w11, SC[2 * j + 1], tau1, jt); } }
    { LAS unsigned* WQ = (LAS unsigned*)(lds + C_WQ);
      WQ[(4 * w + 0) * 64 + lane] = w00; WQ[(4 * w + 1) * 64 + lane] = w01; WQ[(4 * w + 2) * 64 + lane] = w10; WQ[(4 * w + 3) * 64 + lane] = w11; }
    LDS_WAIT(); __syncthreads();
}

__device__ __forceinline__ void phaseC_attn(const Frame& F, int l, int b, int qt, bool do_store = true) {
    unsigned char* ws = F.ws; asm volatile("" : "+s"(ws)); const int w = F.wave;
    int lane = F.lane, tid = F.tid; asm volatile("" : "+v"(lane), "+v"(tid));
    const int r = lane & 31, hf = lane >> 5;
    const float* CS = (const float*)(ws + WS_CS);
    h16* QY = (h16*)(ws + WS_QY); const h16* KV = (const h16*)(ws + WS_KV);
    const h16* WUKT = (const h16*)(ws + WS_SMALLW + (size_t)l * SMALLW_LAYER); const h16* WUVT = (const h16*)(ws + WS_SMALLW + (size_t)l * SMALLW_LAYER + 98304);
    LAS unsigned char* lds = F.lds;
    const int t0 = 32 * qt, NT = qt + 1; const size_t tokbase = (size_t)b * SEQ;
    const int h = w; const size_t tokQ = tokbase + t0 + r;
    LAS h16* ql = (LAS h16*)(lds + C_QL + w * C_QLW);
    { h16x8 bq[3];
#pragma unroll
      for (int s = 0; s < 3; ++s) bq[s] = *(const h16x8*)(QY + tokQ * 1024 + h * 64 + 16 + 16 * s + 8 * hf);
#pragma unroll
      for (int cb = 0; cb < 4; ++cb) { f32x16 D = {};
#pragma unroll
          for (int s = 0; s < 3; ++s) { const h16x8 a = *(const h16x8*)(WUKT + ((size_t)(h * 128 + 32 * cb + r)) * 48 + 16 * s + 8 * hf); D = __builtin_amdgcn_mfma_f32_32x32x16_f16(a, bq[s], D, 0, 0, 0); }
#pragma unroll
          for (int g = 0; g < 4; ++g) { const int c = 32 * cb + 8 * g + 4 * hf;
              *(LAS u32x2*)(ql + r * KVP + c) = (u32x2){pkh(D[4 * g] * QSCALE, D[4 * g + 1] * QSCALE), pkh(D[4 * g + 2] * QSCALE, D[4 * g + 3] * QSCALE)}; } }
      { float o[8]; rope8(*(const h16x8*)(QY + tokQ * 1024 + h * 64), *(const h16x8*)(QY + tokQ * 1024 + h * 64 + 8), CS + tokQ * 16, hf, QSCALE, o); *(LAS u32x4*)(ql + r * KVP + 128 + 8 * hf) = pack8(o); } }
    LDS_WAIT();
    h16x8 qfr[9];
#pragma unroll
    for (int s = 0; s < 9; ++s) qfr[s] = *(const LAS h16x8*)(ql + r * KVP + 16 * s + 8 * hf);
    const h16* kvsrc = KV + tokbase * KVP;
    u32x4 kvA, kvB = {0u, 0u, 0u, 0u};
    kvA = *(const u32x4*)((const char*)kvsrc + (size_t)tid * 16); if (tid < 96) kvB = *(const u32x4*)((const char*)kvsrc + (size_t)(512 + tid) * 16);
    *(LAS u32x4*)(lds + C_KVS + tid * 16) = kvA; if (tid < 96) *(LAS u32x4*)(lds + C_KVS + (512 + tid) * 16) = kvB;
    LDS_WAIT(); __syncthreads();
    float mrun = -INFINITY, lrun = 0.f; f32x16 O[4];
#pragma unroll
    for (int db = 0; db < 4; ++db) O[db] = (f32x16){};
    const LAS unsigned* WQr = (const LAS unsigned*)(lds + C_WQ) + r * 64;
    const int troff = ((lane & 15) >> 2) * (KVP * 2) + (16 * ((lane >> 4) & 1) + 4 * (lane & 3)) * 2 + 4 * hf * (KVP * 2);
#pragma unroll 1
    for (int j = 0; j < NT; ++j) {
        if (j + 1 < NT) { const char* src = (const char*)kvsrc + (size_t)(j + 1) * C_KVSLOT; kvA = *(const u32x4*)(src + (size_t)tid * 16); if (tid < 96) kvB = *(const u32x4*)(src + (size_t)(512 + tid) * 16); }
        LAS unsigned char* slot = lds + C_KVS + (j & 1) * C_KVSLOT;
        f32x16 S = {};
#pragma unroll
        for (int s = 0; s < 9; ++s) { const h16x8 a = *(const LAS h16x8*)(slot + r * (KVP * 2) + 32 * s + 16 * hf); S = __builtin_amdgcn_mfma_f32_32x32x16_f16(a, qfr[s], S, 0, 0, 0); }
        float mt = S[0];
#pragma unroll
        for (int R = 1; R < 16; ++R) mt = fmaxf(mt, S[R]);
        mt = half_swap_max(mt);
        if (__any(mt > mrun + 8.0f)) { const float mnew = fmaxf(mrun, mt), alpha = __builtin_amdgcn_exp2f(mrun - mnew);
#pragma unroll
            for (int db = 0; db < 4; ++db) O[db] = O[db] * alpha;
            lrun *= alpha; mrun = mnew; }
        const unsigned wq = WQr[j] >> (4 * hf);
        float p[16];
#pragma unroll
        for (int R = 0; R < 16; ++R) { const float e = __builtin_amdgcn_exp2f(S[R] - mrun); p[R] = ((wq >> ((R & 3) + 8 * (R >> 2))) & 1u) ? e : 0.f; lrun += p[R]; }
        h16x8 pf[2];
#pragma unroll
        for (int sp = 0; sp < 2; ++sp) { u32x4 t; t.x = pkh(p[8 * sp], p[8 * sp + 1]); t.y = pkh(p[8 * sp + 2], p[8 * sp + 3]); t.z = pkh(p[8 * sp + 4], p[8 * sp + 5]); t.w = pkh(p[8 * sp + 6], p[8 * sp + 7]); pf[sp] = __builtin_bit_cast(h16x8, t); }
#pragma unroll
        for (int db = 0; db < 4; ++db)
#pragma unroll
            for (int sp = 0; sp < 2; ++sp) {
                const v4i16_t lo = __builtin_amdgcn_ds_read_tr16_b64_v4i16((LAS v4i16_t*)(slot + troff + (16 * sp) * (KVP * 2) + 64 * db));
                const v4i16_t hi = __builtin_amdgcn_ds_read_tr16_b64_v4i16((LAS v4i16_t*)(slot + troff + (16 * sp + 8) * (KVP * 2) + 64 * db));
                typedef short s16x8 __attribute__((ext_vector_type(8)));
                const s16x8 av = {lo[0], lo[1], lo[2], lo[3], hi[0], hi[1], hi[2], hi[3]};
                O[db] = __builtin_amdgcn_mfma_f32_32x32x16_f16(__builtin_bit_cast(h16x8, av), pf[sp], O[db], 0, 0, 0); }
        if (j + 1 < NT) { LAS unsigned char* nslot = lds + C_KVS + ((j + 1) & 1) * C_KVSLOT; *(LAS u32x4*)(nslot + tid * 16) = kvA; if (tid < 96) *(LAS u32x4*)(nslot + (512 + tid) * 16) = kvB; }
        LDS_WAIT(); __syncthreads();
    }
    { const float inv = 1.0f / half_swap_sum(lrun);
#pragma unroll
      for (int db = 0; db < 4; ++db)
#pragma unroll
          for (int g = 0; g < 4; ++g) { const int c = 32 * db + 8 * g + 4 * hf;
              *(LAS u32x2*)(ql + r * KVP + c) = (u32x2){pkh(O[db][4 * g] * inv, O[db][4 * g + 1] * inv), pkh(O[db][4 * g + 2] * inv, O[db][4 * g + 3] * inv)}; } }
    LDS_WAIT();
    { h16x8 ao[8];
#pragma unroll
      for (int s = 0; s < 8; ++s) ao[s] = *(const LAS h16x8*)(ql + r * KVP + 16 * s + 8 * hf);
#pragma unroll
      for (int d2 = 0; d2 < 2; ++d2) { f32x16 D = {};
#pragma unroll
          for (int s = 0; s < 8; ++s) { const h16x8 bw = *(const h16x8*)(WUVT + ((size_t)(h * 64 + 32 * d2 + r)) * 128 + 16 * s + 8 * hf); D = __builtin_amdgcn_mfma_f32_32x32x16_f16(ao[s], bw, D, 0, 0, 0); }
#pragma unroll
          for (int R = 0; R < 16; ++R) { if (do_store) QY[(tokbase + t0 + crow(R, hf)) * 1024 + h * 64 + 32 * d2 + r] = (h16)D[R]; else asm volatile("" :: "v"(D[R])); } } }
    LDS_WAIT(); __syncthreads();
}

__device__ __forceinline__ void phaseC(const Frame& F, int l) {
    int vc = F.vcu; asm volatile("" : "+s"(vc)); const int b = vc >> 5, i = vc & 31;
#pragma unroll 1
    for (int u = 0; u < 2; ++u) { const int qt = (u == 0) ? 63 - i : i;
#if defined(PROBE_C_SEL)
#pragma unroll 1
        for (int rep = 0; rep < 2; ++rep)
#endif
        phaseC_select(F, l, b, qt);
#if defined(PROBE_C_ATT)
#pragma unroll 1
        for (int rep = 0; rep < 2; ++rep) phaseC_attn(F, l, b, qt, rep == 1);
#else
        phaseC_attn(F, l, b, qt);
#endif
    }
}
#ifndef PROBE_MASK
#define PROBE_MASK 0u
#endif
#ifndef MK_N_LAUNCHES
#define MK_N_LAUNCHES 1
#endif
constexpr int N_PHASES = 2 + 7 * NLAYER;
struct Args { In in; float* out; unsigned char* ws; int ph_lo, ph_hi; };

__global__ void __launch_bounds__(NTHREADS, 2) mk_fwd(Args args) {
    extern __shared__ __attribute__((aligned(16))) unsigned char lds_raw[];
    Frame F; F.lds = (LAS unsigned char*)lds_raw; F.tid = threadIdx.x; F.lane = F.tid & 63; F.wave = __builtin_amdgcn_readfirstlane(F.tid >> 6);
    F.G = gridDim.x; { const int bx = blockIdx.x; F.vcu = (F.G % 8 == 0) ? (bx % 8) * (F.G / 8) + bx / 8 : bx; }
    F.ws = args.ws; F.in = nullptr;
    const In& I = args.in; unsigned char* ws = args.ws; (void)ws;
    volatile LAS unsigned* MISCW = (volatile LAS unsigned*)(F.lds + LDS_MISC);
    if (F.tid < 64) MISCW[F.tid] = 0u;
    __syncthreads();
#if MK_N_LAUNCHES == 1
    const bool one_launch = true;
#else
    const bool one_launch = (args.ph_hi - args.ph_lo) > 1;
#endif
    XcdBarrier bar; bar.bar = (unsigned*)(ws + WS_CTL) + 1024; bar.x = 0; bar.st = nullptr;
    if (one_launch) bar = xcd_barrier_post((unsigned*)(ws + WS_CTL) + 1024, MISCW + 8);
#if MK_N_LAUNCHES == 1
#define IN(k) true
#define SEAM(k) xcd_barrier(bar)
#else
#define IN(k) (args.ph_lo <= (k) && (k) < args.ph_hi)
#define SEAM(k) do { if (IN(k) && IN((k) + 1)) xcd_barrier(bar); } while (0)
#endif
    if (IN(0)) { p0_prologue(F, I); SEAM(0); }
#define OPQ(x) asm volatile("" : "+s"(x))
#pragma unroll 1
    for (int l0 = 0; l0 < NLAYER; ++l0) {
        const int p = 1 + 7 * l0;
        if (IN(p)) {
            unsigned char* wsq = args.ws; int l = l0; OPQ(wsq); OPQ(l); unsigned char* wl = wsq + WS_W + (size_t)l * W_LAYER;
            pg8::Gemm g{(const h16*)(wsq + WS_X16), (const h16*)(wl + W_OFF_IN), 1024, 1024, 1024, M / 256, NZ / 256, 1, 0};
            pg8::Order S; S.init(g.nM, g.nN, F.G, (int)blockIdx.x, 1); EpiA E{wsq};
            pg8::gemm_phase<EpiA>(F.lds, g, S, E); SEAM(p); }
        if (IN(p + 1)) { int l = l0; OPQ(l); phaseB(F, I, l); SEAM(p + 1); }
        if (IN(p + 2)) { int l = l0; OPQ(l); phaseC(F, l); SEAM(p + 2); }
        if (IN(p + 3)) {
            unsigned char* wsq = args.ws; int l = l0; OPQ(wsq); OPQ(l); unsigned char* wl = wsq + WS_W + (size_t)l * W_LAYER;
            pg8::Gemm g{(const h16*)(wsq + WS_QY), (const h16*)(wl + W_OFF_PAB), 1024, 1024, 512, M / 256, 4, 2, 512};
            pg8::Order S; S.init(g.nM, g.nN, F.G, (int)blockIdx.x, 2); EpiD E{wsq};
            pg8::gemm_phase<EpiD>(F.lds, g, S, E); SEAM(p + 3); }
        if (IN(p + 4)) {
            unsigned char* wsq = args.ws; int l = l0; OPQ(wsq); OPQ(l); unsigned char* wl = wsq + WS_W + (size_t)l * W_LAYER;
            pg8::Gemm g{(const h16*)(wsq + WS_X16), (const h16*)(wl + W_OFF_OUT), 1024, 1024, 1024, M / 256, 4, 1, 0};
            pg8::Order S; S.init(g.nM, g.nN, F.G, (int)blockIdx.x, 1);
            EpiRes E{l == 0 ? args.in.x : args.out, args.out, (h16*)(wsq + WS_X1), (float*)(wsq + WS_SSQ), (LAS float*)(F.lds + 131072)};
            pg8::gemm_phase<EpiRes>(F.lds, g, S, E); SEAM(p + 4); }
        if (IN(p + 5)) {
            unsigned char* wsq = args.ws; int l = l0; OPQ(wsq); OPQ(l); unsigned char* wl = wsq + WS_W + (size_t)l * W_LAYER;
            pg8::Gemm g{(const h16*)(wsq + WS_X1), (const h16*)(wl + W_OFF_GU), 1024, 1024, 1024, M / 256, NGU / 256, 1, 0};
            pg8::Order S; S.init(g.nM, g.nN, F.G, (int)blockIdx.x, 1); EpiF E{wsq};
            pg8::gemm_phase<EpiF>(F.lds, g, S, E); SEAM(p + 5); }
        if (IN(p + 6)) {
            unsigned char* wsq = args.ws; int l = l0; OPQ(wsq); OPQ(l); unsigned char* wl = wsq + WS_W + (size_t)l * W_LAYER;
            pg8::Gemm g{(const h16*)(wsq + WS_ACT), (const h16*)(wl + W_OFF_D), DFF, DFF, DFF, M / 256, 4, 1, 0};
            pg8::Order S; S.init(g.nM, g.nN, F.G, (int)blockIdx.x, 1);
            EpiRes E{args.out, args.out, (h16*)(wsq + WS_X16), (float*)(wsq + WS_SSQ), (LAS float*)(F.lds + 131072)};
            pg8::gemm_phase<EpiRes>(F.lds, g, S, E); SEAM(p + 6); }
    }
    if (IN(N_PHASES - 1)) final_norm_phase(F, args.out, I.final_norm);
#undef IN
#undef SEAM
}

extern "C" void kernel_launch(void* const* d_in, const int* in_sizes, int n_in, void* d_out, int out_size, void* d_ws, size_t ws_size, hipStream_t stream) {
    static int grid = 0;
    if (grid == 0) {
        if (n_in != 19 || out_size != M * DM || ws_size < WS_END) { fprintf(stderr, "kernel_launch: unexpected shapes (n_in %d out %d ws %zu)\n", n_in, out_size, ws_size); grid = -1; return; }
        int dev = 0, cus = 0, per_cu = 0;
        hipGetDevice(&dev); hipDeviceGetAttribute(&cus, hipDeviceAttributeMultiprocessorCount, dev);
        hipFuncSetAttribute((const void*)mk_fwd, hipFuncAttributeMaxDynamicSharedMemorySize, LDS_BYTES);
        hipOccupancyMaxActiveBlocksPerMultiprocessor(&per_cu, (const void*)mk_fwd, NTHREADS, LDS_BYTES);
        (void)hipGetLastError();
        if (per_cu < 1) fprintf(stderr, "kernel_launch: occupancy query reports %d blocks per CU\n", per_cu);
        grid = cus;
    }
    if (grid < 0) return;
    hipMemsetAsync((char*)d_ws + WS_CTL, 0, CTL_ZERO_BYTES, stream);
    Args a{};
    const void** ip = (const void**)&a.in;
    for (int i = 0; i < 19; ++i) ip[i] = d_in[i];
    a.out = (float*)d_out; a.ws = (unsigned char*)d_ws;
#if MK_N_LAUNCHES == 1
    a.ph_lo = 0; a.ph_hi = N_PHASES;
    { void* kargs[] = {&a}; hipError_t e = hipLaunchCooperativeKernel((const void*)mk_fwd, dim3(grid), dim3(NTHREADS), kargs, LDS_BYTES, stream);
      if (e != hipSuccess) fprintf(stderr, "cooperative launch failed: %s (grid %d)\n", hipGetErrorString(e), grid); }
#else
    for (int p = 0; p < N_PHASES; ++p) { const int reps = ((PROBE_MASK >> p) & 1u) ? 2 : 1;
        for (int rr = 0; rr < reps; ++rr) { a.ph_lo = p; a.ph_hi = p + 1; hipLaunchKernelGGL(mk_fwd, dim3(grid), dim3(NTHREADS), LDS_BYTES, stream, a); } }
#endif
}
```

```cpp
#define MK_N_LAUNCHES 1
#include <hip/hip_runtime.h>
#include <stdint.h>
#include <math.h>
#include <cstdio>

#define LAS __attribute__((address_space(3)))
#define GAS __attribute__((address_space(1)))
typedef _Float16 h16;
typedef h16 h16x8 __attribute__((ext_vector_type(8)));
typedef h16 h16x4 __attribute__((ext_vector_type(4)));
typedef h16 h16x2 __attribute__((ext_vector_type(2)));
typedef float f32x2 __attribute__((ext_vector_type(2)));
typedef float f32x4 __attribute__((ext_vector_type(4)));
typedef float f32x16 __attribute__((ext_vector_type(16)));
typedef unsigned u32x2 __attribute__((ext_vector_type(2)));
typedef unsigned u32x4 __attribute__((ext_vector_type(4)));
typedef short v4i16_t __attribute__((ext_vector_type(4)));

__device__ __forceinline__ unsigned pkh(float lo, float hi) { h16x2 v = {(h16)lo, (h16)hi}; return __builtin_bit_cast(unsigned, v); }
__device__ __forceinline__ float h2f_lo(unsigned u) { h16x2 v = __builtin_bit_cast(h16x2, u); return (float)v[0]; }
__device__ __forceinline__ float h2f_hi(unsigned u) { h16x2 v = __builtin_bit_cast(h16x2, u); return (float)v[1]; }

namespace pg8 {
constexpr int BM = 256, BK = 64, HALF = 128, HTB = HALF * BK * 2, STAGE_BYTES = 8 * HTB, NXCD = 8, WGM = 8;
__host__ __device__ __forceinline__ int lds_byte(int r, int c) { const int st = (r >> 4) * 2 + (c >> 5), rr = r & 15, cc = c & 31, ob = rr * 64 + cc * 2; return st * 1024 + (ob ^ (((ob >> 9) & 1) << 5)); }
__host__ __device__ __forceinline__ void stage_rc(int b, int& R, int& C) { const int st = b / 1024, sb = b % 1024, swz = sb ^ (((sb >> 9) & 1) << 5); R = (st >> 1) * 16 + swz / 64; C = (st & 1) * 32 + (swz % 64) / 2; }
__host__ __device__ __forceinline__ int perm32(int rho) { const int n = rho >> 4, i = rho & 15; return 8 * (i >> 2) + 4 * n + (i & 3); }

struct Unit { int pm, pn, kind; };
struct Gemm { const h16* A; const h16* Bt; int lda, ldb, K, nM, nN, nkind, koff, noepi; };

struct Order {
    int nM, nN, nwg, G, c, nk;
    __device__ void init(int nM_, int nN_, int G_, int c_, int nk_) { asm volatile("" : "+s"(G_), "+s"(c_)); nM = nM_; nN = nN_; nwg = nM * nN; G = G_; c = c_; nk = nk_; }
    __device__ bool next(int i, Unit& u) const {
        const int ti = i / nk; u.kind = i - ti * nk;
        const long L = (long)ti * G + c; if (L >= nwg) return false;
        int wgid = (int)L; { const int q = nwg / NXCD, r = nwg % NXCD, xcd = wgid % NXCD, off = wgid / NXCD; wgid = (xcd < r ? xcd * (q + 1) : r * (q + 1) + (xcd - r) * q) + off; }
        const int nig = WGM * nN, gid = wgid / nig, fm = gid * WGM, gsz = (nM - fm) < WGM ? (nM - fm) : WGM;
        u.pm = fm + ((wgid % nig) % gsz); u.pn = (wgid % nig) / gsz; return true;
    }
};

template <class Epi>
__device__ __forceinline__ void gemm_phase(LAS unsigned char* lds, const Gemm g, const Order& S, const Epi& E) {
    int tid = threadIdx.x; asm volatile("" : "+v"(tid));
    const int wid = __builtin_amdgcn_readfirstlane(tid >> 6), lane = tid & 63, wr = wid >> 2, wc = wid & 3, fr = lane & 15, fq = lane >> 4;
    const int nt = g.K / BK;
    unsigned voffA[2], voffB[2];
#pragma unroll
    for (int i = 0; i < 2; ++i) { int R, C; stage_rc(tid * 16 + i * 8192, R, C); const int Rb = Epi::PERM ? ((R & ~31) + perm32(R & 31)) : R;
        voffA[i] = (unsigned)(R * g.lda + C) * 2u; voffB[i] = (unsigned)(Rb * g.ldb + C) * 2u; }
    const size_t kstep = (size_t)(BK * 2);
    const size_t hstepA = (size_t)HALF * g.lda * 2, hstepB = (size_t)HALF * g.ldb * 2;
    const unsigned ldsw = (unsigned)wid * 1024u;
    const int aoff = lds_byte(wr * 64 + fr, fq * 8), boff = lds_byte(wc * 32 + fr, fq * 8);
#define PG8_SA(b, h) (((b) * 2 + (h)) * HTB)
#define PG8_SB(b, h) ((4 + (b) * 2 + (h)) * HTB)
#define PG8_STAGE(bufoff, gbase, voff) do { _Pragma("unroll") for (int _i = 0; _i < 2; ++_i) \
        __builtin_amdgcn_global_load_lds((const unsigned*)((const char*)(gbase) + (voff)[_i]), (LAS unsigned*)(lds + (bufoff) + ldsw + _i * 8192), 16, 0, 0); } while (0)
#define PG8_LDA(dst, b, h) do { _Pragma("unroll") for (int m = 0; m < 4; ++m) _Pragma("unroll") for (int k = 0; k < 2; ++k) dst[m][k] = *(const LAS h16x8*)(lds + PG8_SA(b, h) + aoff + m * 2048 + k * 1024); } while (0)
#define PG8_LDB(dst, b, h) do { _Pragma("unroll") for (int n = 0; n < 2; ++n) _Pragma("unroll") for (int k = 0; k < 2; ++k) dst[n][k] = *(const LAS h16x8*)(lds + PG8_SB(b, h) + boff + n * 2048 + k * 1024); } while (0)
#define PG8_MMA(ai, bj, At, Bt) do { __builtin_amdgcn_s_setprio(1); _Pragma("unroll") for (int m = 0; m < 4; ++m) _Pragma("unroll") for (int n = 0; n < 2; ++n) _Pragma("unroll") for (int k = 0; k < 2; ++k) \
        acc[ai][bj][m][n] = __builtin_amdgcn_mfma_f32_16x16x32_f16(Bt[n][k], At[m][k], acc[ai][bj][m][n], 0, 0, 0); __builtin_amdgcn_s_setprio(0); } while (0)
#define PG8_WAIT_V(n) asm volatile("s_waitcnt vmcnt(" #n ")" ::: "memory")
#define PG8_WAIT_L(n) asm volatile("s_waitcnt lgkmcnt(" #n ")" ::: "memory")
#define PG8_BAR __builtin_amdgcn_s_barrier()
#define PG8_SCHED __builtin_amdgcn_sched_barrier(0)
#define PG8_PA(u) ((const char*)g.A + ((size_t)(u).pm * 256 * g.lda + (size_t)(u).kind * g.koff) * 2)
#define PG8_PB(u) ((const char*)g.Bt + ((size_t)(u).pn * 256 * g.ldb + (size_t)(u).kind * g.koff) * 2)
    Unit cur, nxt; int ui = 0;
    if (!S.next(0, cur)) return;
    f32x4 acc[2][2][4][2];
#pragma unroll
    for (int a = 0; a < 2; ++a)
#pragma unroll
        for (int b = 0; b < 2; ++b)
#pragma unroll
            for (int m = 0; m < 4; ++m)
#pragma unroll
                for (int n = 0; n < 2; ++n) acc[a][b][m][n] = (f32x4){0.f, 0.f, 0.f, 0.f};
    h16x8 At[4][2], B0[2][2], B1[2][2];
    const char* cA = PG8_PA(cur); const char* cB = PG8_PB(cur);
    PG8_STAGE(PG8_SB(0, 0), cB, voffB); PG8_STAGE(PG8_SB(0, 1), cB + hstepB, voffB); PG8_STAGE(PG8_SA(0, 0), cA, voffA); PG8_STAGE(PG8_SA(0, 1), cA + hstepA, voffA);
    if (wr == 1) PG8_BAR;
    PG8_WAIT_V(2); PG8_BAR;
    PG8_STAGE(PG8_SB(1, 0), cB + kstep, voffB); PG8_STAGE(PG8_SA(1, 0), cA + kstep, voffA); PG8_STAGE(PG8_SB(1, 1), cB + hstepB + kstep, voffB);
    PG8_WAIT_V(6); PG8_BAR;
    for (;;) {
        const bool has_next = S.next(ui + 1, nxt);
        const char* nA = has_next ? PG8_PA(nxt) : cA; const char* nB = has_next ? PG8_PB(nxt) : cB;
        for (int t = 0; t < nt; t += 2) {
            const bool last = (t == nt - 2);
            const char* a1 = cA + (size_t)(t + 1) * kstep;
            const char* a2 = last ? nA : cA + (size_t)(t + 2) * kstep; const char* b2 = last ? nB : cB + (size_t)(t + 2) * kstep;
            const char* a3 = a2 + kstep; const char* b3 = b2 + kstep;
            PG8_LDB(B0, 0, 0); PG8_LDB(B1, 0, 1); PG8_SCHED; PG8_LDA(At, 0, 0); PG8_STAGE(PG8_SA(1, 1), a1 + hstepA, voffA);
            PG8_WAIT_V(8); PG8_WAIT_L(0); PG8_BAR; PG8_MMA(0, 0, At, B0); PG8_MMA(0, 1, At, B1); PG8_BAR; PG8_SCHED;
            PG8_LDA(At, 0, 1); PG8_STAGE(PG8_SB(0, 0), b2, voffB); PG8_STAGE(PG8_SB(0, 1), b2 + hstepB, voffB); PG8_STAGE(PG8_SA(0, 0), a2, voffA);
            PG8_WAIT_V(8); PG8_WAIT_L(0); PG8_BAR; PG8_MMA(1, 0, At, B0); PG8_MMA(1, 1, At, B1); PG8_BAR; PG8_SCHED;
            PG8_LDB(B0, 1, 0); PG8_LDB(B1, 1, 1); PG8_SCHED; PG8_LDA(At, 1, 0); PG8_STAGE(PG8_SA(0, 1), a2 + hstepA, voffA);
            PG8_WAIT_V(8); PG8_WAIT_L(0); PG8_BAR; PG8_MMA(0, 0, At, B0); PG8_MMA(0, 1, At, B1); PG8_BAR; PG8_SCHED;
            PG8_LDA(At, 1, 1); PG8_STAGE(PG8_SB(1, 0), b3, voffB); PG8_STAGE(PG8_SB(1, 1), b3 + hstepB, voffB); PG8_STAGE(PG8_SA(1, 0), a3, voffA);
            PG8_WAIT_V(8); PG8_WAIT_L(0); PG8_BAR; PG8_MMA(1, 0, At, B0); PG8_MMA(1, 1, At, B1); PG8_BAR; PG8_SCHED;
        }
        if (wr == 0) PG8_BAR;
        { int fr_ = fr, fq_ = fq; asm volatile("" : "+v"(fr_), "+v"(fq_)); if (!g.noepi) E(acc, cur, wr, wc, fr_, fq_); }
        if (!has_next) break;
        if (nxt.kind == 0) {
#pragma unroll
            for (int a = 0; a < 2; ++a)
#pragma unroll
                for (int b = 0; b < 2; ++b)
#pragma unroll
                    for (int m = 0; m < 4; ++m)
#pragma unroll
                        for (int n = 0; n < 2; ++n) acc[a][b][m][n] = (f32x4){0.f, 0.f, 0.f, 0.f};
        }
        cur = nxt; cA = nA; cB = nB; ++ui;
        if (wr == 1) PG8_BAR;
    }
    PG8_WAIT_V(0);
    PG8_BAR;
#undef PG8_SA
#undef PG8_SB
#undef PG8_STAGE
#undef PG8_LDA
#undef PG8_LDB
#undef PG8_MMA
#undef PG8_WAIT_V
#undef PG8_WAIT_L
#undef PG8_BAR
#undef PG8_SCHED
#undef PG8_PA
#undef PG8_PB
}
}
constexpr int NWAVES = 8, NTHREADS = 512;
constexpr int NB = 8, SEQ = 2048, DM = 1024, M = NB * SEQ, DIN = 4312, DFF = 2816, NLAYER = 2;
constexpr int NZ = 4352;
constexpr int NGU = 2 * DFF;
constexpr float EPS_RMS = 1e-6f;
constexpr float LOG2E = 1.4426950408889634f;
constexpr float QSCALE = 0.125f * LOG2E;
constexpr int KVP = 152;

constexpr size_t MiB = 1u << 20;
constexpr size_t WS_CTL = 0, CTL_ZERO_BYTES = 65536;
constexpr size_t WS_CS = 1 * MiB;
constexpr size_t WS_SSQ = 2 * MiB;
constexpr size_t WS_WI = 3 * MiB;
constexpr size_t WS_SMALLW = 4 * MiB;
constexpr size_t SMALLW_LAYER = 98304 + 131072 + 262144;
constexpr size_t WS_W = 6 * MiB;
constexpr size_t W_LAYER = 29 * MiB, W_OFF_IN = 0, W_OFF_PAB = (size_t)NZ * 1024 * 2, W_OFF_OUT = W_OFF_PAB + 2 * MiB, W_OFF_GU = W_OFF_OUT + 2 * MiB, W_OFF_D = W_OFF_GU + (size_t)NGU * 1024 * 2;
static_assert(W_OFF_D + (size_t)1024 * DFF * 2 == W_LAYER, "weight map");
constexpr size_t WS_X16 = 64 * MiB;
constexpr size_t WS_QY = 96 * MiB;
constexpr size_t WS_QI = 128 * MiB;
constexpr size_t WS_MISC = 144 * MiB;
constexpr size_t WS_KV = 152 * MiB;
constexpr size_t WS_KI = 157 * MiB;
constexpr size_t WS_X1 = 128 * MiB;
constexpr size_t WS_GATES = 160 * MiB;
constexpr size_t WS_UV = 224 * MiB;
constexpr size_t WS_ACT = 160 * MiB;
constexpr size_t WS_END = 256 * MiB;
static_assert(WS_KV + (size_t)M * KVP * 2 <= WS_KI && WS_KI + (size_t)M * 64 * 2 <= WS_GATES && WS_ACT + (size_t)M * DFF * 2 <= WS_END, "ws map");

constexpr int LDS_BYTES = 155648;
constexpr int LDS_MISC = 151552;

#define RLX_AGENT __ATOMIC_RELAXED, __HIP_MEMORY_SCOPE_AGENT
#define LDS_WAIT() asm volatile("s_waitcnt lgkmcnt(0)" ::: "memory")
#define VM_WAIT() asm volatile("s_waitcnt vmcnt(0)" ::: "memory")

#define XB_TMO      128
#define XB_XCNT(j)  (256  + 64 * (j))
#define XB_XSUB(j)  (1280 + 64 * (j))
#define XB_XGEN(j)  (2304 + 64 * (j))
#define XB_TOP      3328
#define XB_TOPGEN   3392
#define XCD_BAR_WORDS 3456
#define XB_SPIN_CAP (1u << 18)
__device__ __forceinline__ unsigned xb_ld(unsigned* p)              { return __hip_atomic_load(p, __ATOMIC_RELAXED, __HIP_MEMORY_SCOPE_AGENT); }
__device__ __forceinline__ unsigned xb_add(unsigned* p, unsigned v) { return __hip_atomic_fetch_add(p, v, __ATOMIC_RELAXED, __HIP_MEMORY_SCOPE_AGENT); }
__device__ __forceinline__ unsigned xb_xcc_id() { return (unsigned)__builtin_amdgcn_s_getreg((3 << 11) | 20) & 0xFu; }
#define XB_SPIN(cond, bar) do { unsigned _sp = 0; while (cond) { __builtin_amdgcn_s_sleep(1); \
    if ((++_sp & 255u) == 0u) { if (xb_ld(&(bar)[XB_TMO])) break; if (_sp > XB_SPIN_CAP) { atomicAdd(&(bar)[XB_TMO], 1u); break; } } } } while (0)
struct XcdBarrier { unsigned* bar; unsigned x; volatile LAS unsigned* st; };
__device__ __forceinline__ XcdBarrier xcd_barrier_post(unsigned* bar, volatile LAS unsigned* st) {
    XcdBarrier b; b.bar = bar; b.x = xb_xcc_id(); b.st = st;
    if (threadIdx.x == 0) (void)xb_add(&bar[XB_XCNT(b.x)], 1u);
    return b;
}
__device__ __forceinline__ void xcd_barrier_complete(unsigned* bar, unsigned x, unsigned& nloc, unsigned& nx) {
    const unsigned G = gridDim.x * gridDim.y * gridDim.z;
    unsigned sum, cnt, mine, sp = 0u;
    for (;;) {
        sum = 0u; cnt = 0u; mine = 0u;
#pragma unroll
        for (unsigned j = 0; j < 16; ++j) { const unsigned c = xb_ld(&bar[XB_XCNT(j)]); sum += c; cnt += (c > 0u) ? 1u : 0u; }
        mine = xb_ld(&bar[XB_XCNT(x)]);
        if (sum == G) break;
        __builtin_amdgcn_s_sleep(1);
        if ((++sp & 255u) == 0u) { if (xb_ld(&bar[XB_TMO])) break; if (sp > XB_SPIN_CAP) { atomicAdd(&bar[XB_TMO], 1u); break; } }
    }
    nloc = mine > 0u ? mine : 1u; nx = cnt > 0u ? cnt : 1u;
}
__device__ __forceinline__ void xcd_barrier(const XcdBarrier& b) {
    asm volatile("s_waitcnt vmcnt(0)" ::: "memory");
    __syncthreads();
    if (threadIdx.x == 0) {
        unsigned* bar = b.bar; asm volatile("" : "+s"(bar));
        __builtin_amdgcn_s_waitcnt(0);
        unsigned nloc = b.st[0], nx = b.st[1];
        if (nloc == 0u) { xcd_barrier_complete(bar, b.x, nloc, nx); b.st[0] = nloc; b.st[1] = nx; }
        const unsigned old = xb_add(&bar[XB_XSUB(b.x)], 1u);
        const unsigned gen = old / nloc;
        if (old + 1u == (gen + 1u) * nloc) {
            __builtin_amdgcn_fence(__ATOMIC_RELEASE, "agent");
            asm volatile("s_waitcnt vmcnt(0)" ::: "memory");
            const unsigned og = xb_add(&bar[XB_TOP], 1u);
            const unsigned tg = og / nx;
            if (og + 1u == (tg + 1u) * nx) xb_add(&bar[XB_TOPGEN], 1u);
            else XB_SPIN(xb_ld(&bar[XB_TOPGEN]) == tg, bar);
            __builtin_amdgcn_fence(__ATOMIC_ACQUIRE, "agent");
            xb_add(&bar[XB_XGEN(b.x)], 1u);
            asm volatile("s_waitcnt vmcnt(0)" ::: "memory");
        } else {
            XB_SPIN(xb_ld(&bar[XB_XGEN(b.x)]) == gen, bar);
            __builtin_amdgcn_fence(__ATOMIC_ACQUIRE, "agent");
            asm volatile("s_waitcnt vmcnt(0)" ::: "memory");
        }
    }
    __syncthreads();
}

__device__ __forceinline__ float gelu_tanh_f(float x) {
    const float u = 0.7978845608028654f * (x + 0.044715f * x * x * x);
    const float e = __builtin_amdgcn_exp2f(-2.0f * LOG2E * u);
    return x * __builtin_amdgcn_rcpf(1.0f + e);
}
__device__ __forceinline__ float sigmoid_f(float x) { return __builtin_amdgcn_rcpf(1.0f + __builtin_amdgcn_exp2f(-LOG2E * x)); }

struct Frame {
    LAS unsigned char* lds;
    int tid, lane, wave, vcu, G;
    unsigned char* ws;
    const float* const* in;
};
struct In {
    const float* x; const int* pos; const float* norm_mix; const float* w_in; const float* kv_norm; const float* w_uk; const float* w_uv; const float* ln_v_g; const float* ln_v_b;
    const float* w_s; const float* b_s; const float* w_proj_a; const float* w_proj_b; const float* w_out; const float* norm_ffn; const float* w_gate; const float* w_up; const float* w_down; const float* final_norm;
};

__device__ __constant__ float c_inv[8] = {1.0f, 0.19392274474868576f, 0.03760603093086393f, 0.007292664737217109f, 0.001414213562373095f, 0.0002742481756762073f, 5.318295896944988e-05f, 1.031338537721246e-05f};

__device__ __forceinline__ void transpose_item64(const float* W4, int Nsrc, h16* WT, int ldt, int n0, int k0, const float* gain, LAS float* scr, int lane) {
    const int nq = lane & 15, kq = lane >> 4;
    f32x4 v[16];
#pragma unroll
    for (int i = 0; i < 16; ++i) v[i] = W4 ? *(const f32x4*)(W4 + (size_t)(k0 + 4 * i + kq) * Nsrc) : (f32x4){0.f, 0.f, 0.f, 0.f};
#pragma unroll
    for (int i = 0; i < 16; ++i) { const int kk = 4 * i + kq; f32x4 x = v[i]; if (gain) x = x * gain[k0 + kk]; *(LAS f32x4*)(scr + kk * 68 + 4 * (nq ^ (kk >> 3))) = x; }
    LDS_WAIT(); asm volatile("" ::: "memory");
    const int c = lane & 7;
#pragma unroll
    for (int j = 0; j < 8; ++j) { const int n = (lane >> 3) + 8 * j; const LAS float* sp = scr + (8 * c) * 68 + 4 * ((n >> 2) ^ c) + (n & 3);
        u32x4 o; o.x = pkh(sp[0 * 68], sp[1 * 68]); o.y = pkh(sp[2 * 68], sp[3 * 68]); o.z = pkh(sp[4 * 68], sp[5 * 68]); o.w = pkh(sp[6 * 68], sp[7 * 68]);
        *(u32x4*)(WT + (size_t)(n0 + n) * ldt + k0 + 8 * c) = o; }
    LDS_WAIT(); asm volatile("" ::: "memory");
}
__device__ __forceinline__ int win_src_col(int n) {
    if (n < 512) return n;
    if (n < 1024) return 656 + (n - 512);
    if (n < 2048) return 1240 + (n - 1024);
    if (n < 4096) return 2264 + (n - 2048);
    if (n < 4224) return 512 + (n - 4096);
    if (n < 4240) return 640 + (n - 4224);
    if (n < 4304) return 1168 + (n - 4240);
    if (n < 4312) return 1232 + (n - 4304);
    return -1;
}
__device__ __forceinline__ void p0_prologue(const Frame& F, const In& I) {
    LAS float* scr = (LAS float*)(F.lds + F.wave * 17408);
    int lane = F.lane; asm volatile("" : "+v"(lane));
    const int gw = F.vcu * NWAVES + F.wave, NGW = F.G * NWAVES;
    constexpr int I_IN = (NZ / 64) * 16, I_PA = 16 * 8, I_OUT = 16 * 16, I_GU = (NGU / 64) * 16, I_D = 16 * (DFF / 64);
    constexpr int I_LAYER = I_IN + 2 * I_PA + I_OUT + I_GU + I_D;
    const int n4 = 4 * (lane & 15);
    for (int it = gw; it < NLAYER * I_LAYER; it += NGW) {
        const int l = it / I_LAYER; int r = it - l * I_LAYER;
        unsigned char* wl = F.ws + WS_W + (size_t)l * W_LAYER;
        if (r < I_IN) { const int nb = r / 16, kb = r % 16, sc = win_src_col(nb * 64 + n4);
            transpose_item64(sc >= 0 ? I.w_in + (size_t)l * DM * DIN + sc : nullptr, DIN, (h16*)(wl + W_OFF_IN), 1024, nb * 64, kb * 64, I.norm_mix + l * DM, scr, lane); continue; }
        r -= I_IN;
        if (r < I_PA) { const int nb = r / 8, kb = r % 8;
            transpose_item64(I.w_proj_a + (size_t)l * 512 * 1024 + nb * 64 + n4, 1024, (h16*)(wl + W_OFF_PAB), 1024, nb * 64, kb * 64, nullptr, scr, lane); continue; }
        r -= I_PA;
        if (r < I_PA) { const int nb = r / 8, kb = r % 8;
            transpose_item64(I.w_proj_b + (size_t)l * 512 * 1024 + nb * 64 + n4, 1024, (h16*)(wl + W_OFF_PAB) + 512, 1024, nb * 64, kb * 64, nullptr, scr, lane); continue; }
        r -= I_PA;
        if (r < I_OUT) { const int nb = r / 16, kb = r % 16;
            transpose_item64(I.w_out + (size_t)l * 1024 * 1024 + nb * 64 + n4, 1024, (h16*)(wl + W_OFF_OUT), 1024, nb * 64, kb * 64, nullptr, scr, lane); continue; }
        r -= I_OUT;
        if (r < I_GU) { const int nb = r / 16, kb = r % 16, R = nb * 64 + n4, pn = R >> 8, rem = R & 255;
            const int a = 128 * pn + 64 * (rem >> 7) + 16 * ((rem >> 5) & 3) + 4 * ((rem >> 3) & 3);
            const float* src = (((rem >> 2) & 1) ? I.w_up : I.w_gate) + (size_t)l * DM * DFF + a;
            transpose_item64(src, DFF, (h16*)(wl + W_OFF_GU), 1024, nb * 64, kb * 64, I.norm_ffn + l * DM, scr, lane); continue; }
        r -= I_GU;
        { const int nb = r / (DFF / 64), kb = r % (DFF / 64);
            transpose_item64(I.w_down + (size_t)l * DFF * 1024 + nb * 64 + n4, 1024, (h16*)(wl + W_OFF_D), DFF, nb * 64, kb * 64, nullptr, scr, lane); }
    }
    const int gt = F.vcu * NTHREADS + F.tid, NGT = F.G * NTHREADS;
    for (int i = gt; i < NLAYER * 49152; i += NGT) { const int l = i / 49152, e = i % 49152, h = e / (128 * 48), c = (e / 48) % 128, n = e % 48;
        ((h16*)(F.ws + WS_SMALLW + (size_t)l * SMALLW_LAYER))[e] = (h16)I.w_uk[(((size_t)l * 8 + h) * 48 + n) * 128 + c]; }
    for (int i = gt; i < NLAYER * 65536; i += NGT) { const int l = i / 65536, e = i % 65536, h = e / (64 * 128), d = (e / 128) % 64, c = e % 128;
        ((h16*)(F.ws + WS_SMALLW + (size_t)l * SMALLW_LAYER + 98304))[e] = (h16)I.w_uv[(((size_t)l * 8 + h) * 128 + c) * 64 + d]; }
    for (int i = gt; i < NLAYER * 131072; i += NGT) { const int l = i / 131072, e = i % 131072, t = (e / 128) % 128, s = e % 128;
        ((h16*)(F.ws + WS_SMALLW + (size_t)l * SMALLW_LAYER + 98304 + 131072))[e] = (s <= t) ? (h16)I.w_s[(size_t)l * 131072 + e] : (h16)0.f; }
    for (int i = gt; i < M * 8; i += NGT) { const int tok = i >> 3, f = i & 7; const float ang = (float)I.pos[tok] * c_inv[f];
        float* cs = (float*)(F.ws + WS_CS) + (size_t)tok * 16; cs[f] = cosf(ang); cs[8 + f] = sinf(ang); }
    for (int m = gw; m < M; m += NGW) {
        const f32x4* xr = (const f32x4*)(I.x + (size_t)m * DM) + lane; u32x2* o8 = (u32x2*)((h16*)(F.ws + WS_X16) + (size_t)m * DM) + lane;
#pragma unroll
        for (int j = 0; j < 4; ++j) { const f32x4 v = xr[64 * j]; float s = (v.x * v.x + v.y * v.y) + (v.z * v.z + v.w * v.w);
#pragma unroll
            for (int o = 1; o < 64; o <<= 1) s += __shfl_xor(s, o);
            o8[64 * j] = (u32x2){pkh(v.x, v.y), pkh(v.z, v.w)};
            if (lane == 0) ((float*)(F.ws + WS_SSQ))[(size_t)m * 4 + j] = s; }
    }
}

__device__ __forceinline__ float row_rstd(const float* ssq, int row) {
    const f32x4 a = *(const f32x4*)(ssq + (size_t)row * 4);
    return rsqrtf(((a.x + a.y) + (a.z + a.w)) * (1.0f / DM) + EPS_RMS);
}

typedef f32x4 Acc[2][2][4][2];
__device__ __forceinline__ u32x4 pack8h(const float (&v)[8]) { u32x4 w; w.x = pkh(v[0], v[1]); w.y = pkh(v[2], v[3]); w.z = pkh(v[4], v[5]); w.w = pkh(v[6], v[7]); return w; }

struct EpiA {
    static constexpr bool PERM = true;
    unsigned char* ws;
    __device__ __forceinline__ void operator()(Acc& acc, const pg8::Unit& u, int wr, int wc, int fr, int fq) const {
        const int pn = u.pn; h16* base; int ldc, colt; bool act = false;
        if (pn < 2) { base = (h16*)(ws + WS_QY); ldc = 1024; colt = pn * 256; }
        else if (pn < 4) { base = (h16*)(ws + WS_QI); ldc = 512; colt = (pn - 2) * 256; }
        else if (pn < 8) { base = (h16*)(ws + WS_UV); ldc = 1024; colt = (pn - 4) * 256; act = true; }
        else if (pn < 16) { base = (h16*)(ws + WS_GATES); ldc = 2048; colt = (pn - 8) * 256; }
        else { base = (h16*)(ws + WS_MISC); ldc = 256; colt = 0; }
        const int row0 = u.pm * 256 + wr * 64 + fr, col0 = colt + wc * 32 + 8 * fq;
        const float* ssq = (const float*)(ws + WS_SSQ);
#pragma unroll
        for (int ai = 0; ai < 2; ++ai)
#pragma unroll
            for (int m = 0; m < 4; ++m) { const int row = row0 + ai * 128 + m * 16; const float rs = row_rstd(ssq, row); h16* rowp = base + (size_t)row * ldc + col0;
#pragma unroll
                for (int bj = 0; bj < 2; ++bj) { f32x4 v0 = acc[ai][bj][m][0] * rs, v1 = acc[ai][bj][m][1] * rs;
                    if (act) {
#pragma unroll
                        for (int i = 0; i < 4; ++i) { v0[i] = gelu_tanh_f(v0[i]); v1[i] = gelu_tanh_f(v1[i]); } }
                    u32x4 w; w.x = pkh(v0[0], v0[1]); w.y = pkh(v0[2], v0[3]); w.z = pkh(v1[0], v1[1]); w.w = pkh(v1[2], v1[3]);
                    *(u32x4*)(rowp + bj * 128) = w; }
                asm volatile("" ::: "memory"); }
    }
};

struct EpiD {
    static constexpr bool PERM = true;
    unsigned char* ws; h16* mg;
    __device__ __forceinline__ void operator()(Acc& acc, const pg8::Unit& u, int wr, int wc, int fr, int fq) const {
        const int row0 = u.pm * 256 + wr * 64 + fr, col0 = u.pn * 256 + wc * 32 + 8 * fq;
        const h16* gates = (const h16*)(ws + WS_GATES);
#pragma unroll
        for (int ai = 0; ai < 2; ++ai)
#pragma unroll
            for (int m = 0; m < 4; ++m) { const int row = row0 + ai * 128 + m * 16;
#pragma unroll
                for (int bj = 0; bj < 2; ++bj) { const int col = col0 + bj * 128;
                    const h16x8 gb = *(const h16x8*)(gates + (size_t)row * 2048 + 1024 + col);
                    if (u.kind == 0) { const h16x8 ga = *(const h16x8*)(gates + (size_t)row * 2048 + col);
#pragma unroll
                        for (int i = 0; i < 8; ++i) { const float a = fminf(fmaxf((float)ga[i], -30.f), 30.f), b = fminf(fmaxf((float)gb[i], -30.f), 30.f);
                            const float ratio = (1.0f + __builtin_amdgcn_exp2f(-LOG2E * b)) * __builtin_amdgcn_rcpf(1.0f + __builtin_amdgcn_exp2f(-LOG2E * a));
                            acc[ai][bj][m][i >> 2][i & 3] *= ratio; }
                    } else { float v[8];
#pragma unroll
                        for (int i = 0; i < 8; ++i) { const float b = fminf(fmaxf((float)gb[i], -30.f), 30.f); v[i] = acc[ai][bj][m][i >> 2][i & 3] * sigmoid_f(b); }
                        u32x4 w; w.x = pkh(v[0], v[1]); w.y = pkh(v[2], v[3]); w.z = pkh(v[4], v[5]); w.w = pkh(v[6], v[7]);
                        *(u32x4*)(mg + (size_t)row * 1024 + col) = w; } }
                asm volatile("" ::: "memory"); }
    }
};

struct EpiRes {
    static constexpr bool PERM = true;
    const h16* resid; h16* xo; float* ssq; LAS float* P;
    __device__ __forceinline__ void operator()(Acc& acc, const pg8::Unit& u, int wr, int wc, int fr, int fq) const {
        const int row0 = u.pm * 256 + wr * 64 + fr, col0 = u.pn * 256 + wc * 32 + 8 * fq;
#pragma unroll
        for (int ai = 0; ai < 2; ++ai)
#pragma unroll
            for (int m = 0; m < 4; ++m) { const int row = row0 + ai * 128 + m * 16; float ss = 0.f;
#pragma unroll
                for (int bj = 0; bj < 2; ++bj) { const size_t off = (size_t)row * 1024 + col0 + bj * 128;
                    const h16x8 rv = *(const h16x8*)(resid + off); float v[8];
#pragma unroll
                    for (int i = 0; i < 8; ++i) { v[i] = (float)rv[i] + acc[ai][bj][m][i >> 2][i & 3]; ss = fmaf(v[i], v[i], ss); }
                    *(u32x4*)(xo + off) = pack8h(v); }
                ss += __shfl_xor(ss, 16); ss += __shfl_xor(ss, 32);
                if (fq == 0) P[(ai * 128 + wr * 64 + m * 16 + fr) * 4 + wc] = ss;
                asm volatile("" ::: "memory"); }
        asm volatile("s_waitcnt lgkmcnt(0)" ::: "memory"); __builtin_amdgcn_s_barrier(); asm volatile("" ::: "memory");
        { const int t = (wr * 4 + wc) * 64 + fq * 16 + fr; if (t < 256) { const f32x4 v = *(const LAS f32x4*)(P + t * 4); ssq[(size_t)(u.pm * 256 + t) * 4 + u.pn] = (v.x + v.y) + (v.z + v.w); } }
        asm volatile("s_waitcnt lgkmcnt(0)" ::: "memory"); __builtin_amdgcn_s_barrier(); asm volatile("" ::: "memory");
    }
};

struct EpiF {
    static constexpr bool PERM = true;
    unsigned char* ws;
    __device__ __forceinline__ void operator()(Acc& acc, const pg8::Unit& u, int wr, int wc, int fr, int fq) const {
        const int row0 = u.pm * 256 + wr * 64 + fr, col0 = u.pn * 128 + wc * 16 + 4 * fq;
        const float* ssq = (const float*)(ws + WS_SSQ); h16* act = (h16*)(ws + WS_ACT);
#pragma unroll
        for (int ai = 0; ai < 2; ++ai)
#pragma unroll
            for (int m = 0; m < 4; ++m) { const int row = row0 + ai * 128 + m * 16; const float rs = row_rstd(ssq, row);
#pragma unroll
                for (int bj = 0; bj < 2; ++bj) { const f32x4 g = acc[ai][bj][m][0] * rs, uu = acc[ai][bj][m][1] * rs; float v[4];
#pragma unroll
                    for (int i = 0; i < 4; ++i) v[i] = g[i] * sigmoid_f(g[i]) * uu[i];
                    *(u32x2*)(act + (size_t)row * DFF + col0 + bj * 64) = (u32x2){pkh(v[0], v[1]), pkh(v[2], v[3])}; }
                asm volatile("" ::: "memory"); }
    }
};

__device__ __forceinline__ void final_norm_phase(const Frame& F, const h16* x16, float* out, const float* g) {
    int lane = F.lane; asm volatile("" : "+v"(lane));
    const int gw = F.vcu * NWAVES + F.wave, NGW = F.G * NWAVES;
    for (int m = gw; m < M; m += NGW) {
        const h16x8 a = *(const h16x8*)(x16 + (size_t)m * DM + 8 * lane), b = *(const h16x8*)(x16 + (size_t)m * DM + 512 + 8 * lane); float s = 0.f;
#pragma unroll
        for (int j = 0; j < 8; ++j) { s = fmaf((float)a[j], (float)a[j], s); s = fmaf((float)b[j], (float)b[j], s); }
#pragma unroll
        for (int o = 1; o < 64; o <<= 1) s += __shfl_xor(s, o);
        const float rs = rsqrtf(s * (1.0f / DM) + EPS_RMS);
#pragma unroll
        for (int hh = 0; hh < 2; ++hh) { const h16x8 v = hh ? b : a; const int c = 512 * hh + 8 * lane;
            const f32x4 g0 = *(const f32x4*)(g + c), g1 = *(const f32x4*)(g + c + 4);
            *(f32x4*)(out + (size_t)m * DM + c) = (f32x4){(float)v[0] * rs * g0.x, (float)v[1] * rs * g0.y, (float)v[2] * rs * g0.z, (float)v[3] * rs * g0.w};
            *(f32x4*)(out + (size_t)m * DM + c + 4) = (f32x4){(float)v[4] * rs * g1.x, (float)v[5] * rs * g1.y, (float)v[6] * rs * g1.z, (float)v[7] * rs * g1.w}; }
    }
}
__device__ __forceinline__ unsigned wlane(unsigned val, int ln, unsigned old) {
    unsigned keep;
    asm volatile("s_mov_b32 %1, m0\n\ts_mov_b32 m0, %3\n\ts_nop 3\n\tv_writelane_b32 %0, %2, m0\n\ts_mov_b32 m0, %1" : "+v"(old), "=&s"(keep) : "s"(val), "s"(ln));
    return old;
}
__device__ __forceinline__ void cnt_ge(int& c, float x, float m) { asm("v_cmp_ge_f32 vcc, %1, %2\n\tv_addc_co_u32 %0, vcc, 0, %0, vcc" : "+v"(c) : "v"(x), "v"(m) : "vcc"); }
__device__ __forceinline__ void cnt_gt(int& c, float x, float m) { asm("v_cmp_gt_f32 vcc, %1, %2\n\tv_addc_co_u32 %0, vcc, 0, %0, vcc" : "+v"(c) : "v"(x), "v"(m) : "vcc"); }
__device__ __forceinline__ void ballot_ge_to_lane(unsigned& wlo, unsigned& whi, float x, float tau, int ln) {
    unsigned keep;
    asm volatile("v_cmp_ge_f32 vcc, %3, %4\n\ts_mov_b32 %2, m0\n\ts_mov_b32 m0, %5\n\ts_nop 3\n\tv_writelane_b32 %0, vcc_lo, m0\n\tv_writelane_b32 %1, vcc_hi, m0\n\ts_mov_b32 m0, %2"
                 : "+v"(wlo), "+v"(whi), "=&s"(keep) : "v"(x), "v"(tau), "s"(ln) : "vcc");
}
__device__ __forceinline__ int half_sum_dpp(int v, int hf) {
    v += __builtin_amdgcn_update_dpp(0, v, 0x111, 0xf, 0xf, true);
    v += __builtin_amdgcn_update_dpp(0, v, 0x112, 0xf, 0xf, true);
    v += __builtin_amdgcn_update_dpp(0, v, 0x114, 0xf, 0xf, true);
    v += __builtin_amdgcn_update_dpp(0, v, 0x118, 0xf, 0xf, true);
    v += __builtin_amdgcn_update_dpp(0, v, 0x142, 0xa, 0xf, false);
    const int s0 = __builtin_amdgcn_readlane(v, 31), s1 = __builtin_amdgcn_readlane(v, 63);
    return hf ? s1 : s0;
}
__device__ __forceinline__ int crow(int R, int hf) { return (R & 3) + 8 * (R >> 2) + 4 * hf; }
__device__ __forceinline__ float half_swap_max(float v) { auto rr = __builtin_amdgcn_permlane32_swap(__float_as_uint(v), __float_as_uint(v), false, false); return fmaxf(__uint_as_float(rr[0]), __uint_as_float(rr[1])); }
__device__ __forceinline__ float half_swap_sum(float v) { auto rr = __builtin_amdgcn_permlane32_swap(__float_as_uint(v), __float_as_uint(v), false, false); return __uint_as_float(rr[0]) + __uint_as_float(rr[1]); }
__device__ __forceinline__ void rope8(const h16x8 x1, const h16x8 x2, const float* cs, int which, float scale, float (&o)[8]) {
    const f32x4 c0 = *(const f32x4*)(cs), c1 = *(const f32x4*)(cs + 4), s0 = *(const f32x4*)(cs + 8), s1 = *(const f32x4*)(cs + 12);
#pragma unroll
    for (int j = 0; j < 8; ++j) { const float c = j < 4 ? c0[j & 3] : c1[j & 3], s = j < 4 ? s0[j & 3] : s1[j & 3]; const float a = (float)x1[j], b = (float)x2[j];
        o[j] = (which == 0 ? (a * c - b * s) : (b * c + a * s)) * scale; }
}
__device__ __forceinline__ u32x4 pack8(const float (&v)[8]) { u32x4 w; w.x = pkh(v[0], v[1]); w.y = pkh(v[2], v[3]); w.z = pkh(v[4], v[5]); w.w = pkh(v[6], v[7]); return w; }

__device__ __forceinline__ void phaseB(const Frame& F, const In& I, int l) {
    unsigned char* ws = F.ws; asm volatile("" : "+s"(ws)); int lane = F.lane, tid = F.tid; asm volatile("" : "+v"(lane), "+v"(tid)); const int w = F.wave;
    const h16* MISC = (const h16*)(ws + WS_MISC); h16* KV = (h16*)(ws + WS_KV); h16* KI = (h16*)(ws + WS_KI); float* WI = (float*)(ws + WS_WI); const float* CS = (const float*)(ws + WS_CS);
    int blk = F.vcu; asm volatile("" : "+s"(blk));
#pragma unroll
    for (int it = 0; it < 2; ++it) {
        const int tok = blk * 64 + w * 8 + it * 4 + (lane >> 4), i = lane & 15;
        const h16* mr = MISC + (size_t)tok * 256; const float* cs = CS + (size_t)tok * 16;
        const h16x8 x = *(const h16x8*)(mr + 8 * i);
        float ss = 0.f;
#pragma unroll
        for (int j = 0; j < 8; ++j) ss += (float)x[j] * (float)x[j];
        ss += __shfl_xor(ss, 1); ss += __shfl_xor(ss, 2); ss += __shfl_xor(ss, 4); ss += __shfl_xor(ss, 8);
        const float rs = rsqrtf(ss * (1.0f / 128.f) + EPS_RMS);
        { float o[8]; const float* kn = I.kv_norm + l * 128 + 8 * i;
#pragma unroll
          for (int j = 0; j < 8; ++j) o[j] = (float)x[j] * rs * kn[j];
          *(u32x4*)(KV + (size_t)tok * KVP + 8 * i) = pack8(o); }
        if (i < 2) { float o[8]; rope8(*(const h16x8*)(mr + 128), *(const h16x8*)(mr + 136), cs, i, 1.0f, o); *(u32x4*)(KV + (size_t)tok * KVP + 128 + 8 * i) = pack8(o); }
        else if (i == 2) { u32x2 z2 = {0u, 0u}; asm volatile("" : "+v"(z2)); *(u32x2*)(KV + (size_t)tok * KVP + 144) = z2; *(u32x2*)(KV + (size_t)tok * KVP + 148) = z2; }
        else if (i < 11) { const int ii = i - 3;
            if (ii < 2) { float o[8]; rope8(*(const h16x8*)(mr + 144), *(const h16x8*)(mr + 152), cs, ii, 1.0f, o); *(u32x4*)(KI + (size_t)tok * 64 + 8 * ii) = pack8(o); }
            else *(u32x4*)(KI + (size_t)tok * 64 + 8 * ii) = *(const u32x4*)(mr + 144 + 8 * ii); }
        else if (i == 11) { const h16x8 wv = *(const h16x8*)(mr + 208); const float sc = 0.35355339059327373f * 0.125f;
            *(f32x4*)(WI + (size_t)tok * 8) = (f32x4){(float)wv[0] * sc, (float)wv[1] * sc, (float)wv[2] * sc, (float)wv[3] * sc};
            *(f32x4*)(WI + (size_t)tok * 8 + 4) = (f32x4){(float)wv[4] * sc, (float)wv[5] * sc, (float)wv[6] * sc, (float)wv[7] * sc}; }
    }
    const int b = blk >> 5, chunk = (blk >> 1) & 15, gh = blk & 1;
    const size_t tok0 = (size_t)b * SEQ + chunk * 128;
    const h16* UV = (const h16*)(ws + WS_UV); h16* QY = (h16*)(ws + WS_QY);
    LAS unsigned char* VN = F.lds;
    constexpr int VPB = 576;
    { const int i16 = lane & 15, rq = lane >> 4; h16x8 v[4][4];
#pragma unroll
      for (int it = 0; it < 4; ++it)
#pragma unroll
          for (int i = 0; i < 4; ++i) v[it][i] = *(const h16x8*)(UV + (tok0 + 16 * w + 4 * it + rq) * 1024 + 512 + 8 * i16 + 128 * (i & 1) + 256 * ((i >> 1) ^ gh));
      f32x4 lgv[2][2], lbv[2][2];
#pragma unroll
      for (int i = 0; i < 2; ++i) { const int col = 256 * gh + 128 * i + 8 * i16; const float* lg = I.ln_v_g + l * 512 + col; const float* lb = I.ln_v_b + l * 512 + col;
          lgv[i][0] = *(const f32x4*)lg; lgv[i][1] = *(const f32x4*)(lg + 4); lbv[i][0] = *(const f32x4*)lb; lbv[i][1] = *(const f32x4*)(lb + 4); }
#pragma unroll
      for (int it = 0; it < 4; ++it) { float s = 0.f, q = 0.f;
#pragma unroll
          for (int i = 0; i < 4; ++i)
#pragma unroll
              for (int j = 0; j < 8; ++j) { const float x = (float)v[it][i][j]; s += x; q = fmaf(x, x, q); }
          s += __shfl_xor(s, 1); q += __shfl_xor(q, 1); s += __shfl_xor(s, 2); q += __shfl_xor(q, 2); s += __shfl_xor(s, 4); q += __shfl_xor(q, 4); s += __shfl_xor(s, 8); q += __shfl_xor(q, 8);
          const float mu = s * (1.0f / 512.f), var = fmaxf(q * (1.0f / 512.f) - mu * mu, 0.f), rs = rsqrtf(var + 1e-5f);
          const int t = 16 * w + 4 * it + rq;
#pragma unroll
          for (int i = 0; i < 2; ++i) { const h16x8 x = v[it][i]; float o[8];
#pragma unroll
              for (int j = 0; j < 8; ++j) o[j] = ((float)x[j] - mu) * rs * lgv[i][j >> 2][j & 3] + lbv[i][j >> 2][j & 3];
              *(LAS u32x4*)(VN + t * VPB + (128 * i + 8 * i16) * 2) = pack8(o); } } }
    asm volatile("" ::: "memory");
    { const int gp = w & 3, g = 4 * gh + gp, rh = w >> 2, r = lane & 31, hf = lane >> 5;
      const h16* WS16 = (const h16*)(ws + WS_SMALLW + (size_t)l * SMALLW_LAYER + 98304 + 131072) + (size_t)g * 128 * 128;
      const int troff = (8 * hf + ((lane & 15) >> 2)) * VPB + (gp * 64 + 16 * ((lane >> 4) & 1) + 4 * (lane & 3)) * 2;
      h16x8 wf[2][8];
#pragma unroll
      for (int tb = 0; tb < 2; ++tb)
#pragma unroll
          for (int s = 0; s < 8; ++s) wf[tb][s] = *(const h16x8*)(WS16 + (size_t)(64 * rh + 32 * tb + r) * 128 + 16 * s + 8 * hf);
      float bsv[2]; u32x2 uu[2][2][4];
#pragma unroll
      for (int tb = 0; tb < 2; ++tb) { const int t = 64 * rh + 32 * tb + r; bsv[tb] = I.b_s[((size_t)l * 8 + g) * 128 + t];
#pragma unroll
          for (int db = 0; db < 2; ++db)
#pragma unroll
              for (int gg = 0; gg < 4; ++gg) uu[tb][db][gg] = *(const u32x2*)(UV + (tok0 + t) * 1024 + g * 64 + 32 * db + 8 * gg + 4 * hf); }
      LDS_WAIT(); __syncthreads();
#pragma unroll
      for (int tb = 0; tb < 2; ++tb) { const int nks = 4 * rh + 2 * tb + 2; const size_t tk = tok0 + 64 * rh + 32 * tb + r;
#pragma unroll
        for (int db = 0; db < 2; ++db) { f32x16 D = {};
#pragma unroll
            for (int s = 0; s < 8; ++s) if (s < nks) {
                const v4i16_t lo = __builtin_amdgcn_ds_read_tr16_b64_v4i16((LAS v4i16_t*)(VN + troff + (16 * s) * VPB + 64 * db));
                const v4i16_t hi = __builtin_amdgcn_ds_read_tr16_b64_v4i16((LAS v4i16_t*)(VN + troff + (16 * s + 4) * VPB + 64 * db));
                typedef short s16x8 __attribute__((ext_vector_type(8)));
                const s16x8 av = {lo[0], lo[1], lo[2], lo[3], hi[0], hi[1], hi[2], hi[3]};
                D = __builtin_amdgcn_mfma_f32_32x32x16_f16(__builtin_bit_cast(h16x8, av), wf[tb][s], D, 0, 0, 0); }
#pragma unroll
            for (int gg = 0; gg < 4; ++gg) { const u32x2 uv2 = uu[tb][db][gg]; const float bb = bsv[tb];
                const float y0 = h2f_lo(uv2.x) * (D[4 * gg] + bb), y1 = h2f_hi(uv2.x) * (D[4 * gg + 1] + bb), y2 = h2f_lo(uv2.y) * (D[4 * gg + 2] + bb), y3 = h2f_hi(uv2.y) * (D[4 * gg + 3] + bb);
                *(u32x2*)(QY + tk * 1024 + 512 + g * 64 + 32 * db + 8 * gg + 4 * hf) = (u32x2){pkh(y0, y1), pkh(y2, y3)}; } } } }
    __syncthreads();
}

constexpr int C_KIB = 0, C_KIBUF = 256 * 128;
constexpr int C_QL = 0, C_QLW = KVP * 2 * 32;
constexpr int C_WQ = 81920;
constexpr int C_KVS = 90112, C_KVSLOT = 32 * KVP * 2;

__device__ __forceinline__ void phaseC_select(const Frame& F, int l, int b, int qt) {
    unsigned char* ws = F.ws; asm volatile("" : "+s"(ws)); int lane = F.lane, tid = F.tid; asm volatile("" : "+v"(lane), "+v"(tid)); const int w = F.wave, r = lane & 31, hf = lane >> 5;
    const h16* QI = (const h16*)(ws + WS_QI); const h16* KI = (const h16*)(ws + WS_KI); const float* WI = (const float*)(ws + WS_WI); const float* CS = (const float*)(ws + WS_CS);
    h16* QY = (h16*)(ws + WS_QY); const h16* KV = (const h16*)(ws + WS_KV);
    const h16* WUKT = (const h16*)(ws + WS_SMALLW + (size_t)l * SMALLW_LAYER); const h16* WUVT = (const h16*)(ws + WS_SMALLW + (size_t)l * SMALLW_LAYER + 98304);
    LAS unsigned char* lds = F.lds;
    const int t0 = 32 * qt, NT = qt + 1; const size_t tokbase = (size_t)b * SEQ;
    h16x8 afr[4]; float wreg[16];
    { const int qq = 2 * ((r >> 2) & 1) + (r >> 4), head = (r & 3) + 4 * ((r >> 3) & 1); const size_t tokA = tokbase + t0 + 4 * w + qq;
      const h16* qsrc = QI + tokA * 512 + head * 64;
      { float o[8]; rope8(*(const h16x8*)(qsrc), *(const h16x8*)(qsrc + 8), CS + tokA * 16, hf, 1.0f, o); afr[0] = __builtin_bit_cast(h16x8, pack8(o)); }
#pragma unroll
      for (int s = 1; s < 4; ++s) afr[s] = *(const h16x8*)(qsrc + 16 * s + 8 * hf);
      const float* wp = WI + (tokbase + t0 + 4 * w + 2 * hf) * 8;
#pragma unroll
      for (int R = 0; R < 16; ++R) wreg[R] = wp[R]; }
    float SC[128];
    const float QNAN = __uint_as_float(0x7fc00000u);
#pragma unroll
    for (int i = 0; i < 128; ++i) SC[i] = QNAN;
    const int NCK = (NT + 7) >> 3, tq0 = t0 + 4 * w + 2 * hf;
    const int drow = lane >> 3, dslot = lane & 7;
    const h16* kisrc = KI + (tokbase + 32 * w + drow) * 64 + 8 * (dslot ^ drow);
#define KI_STAGE(ck_, buf_) do { _Pragma("unroll") for (int i_ = 0; i_ < 4; ++i_) \
        __builtin_amdgcn_global_load_lds((const unsigned*)(kisrc + (size_t)(256 * (ck_) + 8 * i_) * 64), (LAS unsigned*)(lds + C_KIB + (buf_) * C_KIBUF + (4 * w + i_) * 1024), 16, 0, 0); } while (0)
    KI_STAGE(0, 0);
    VM_WAIT(); __syncthreads();
    const int kroff = r * 128, kx = r & 7;
#pragma unroll 1
    for (int ck = 0; ck < NCK; ++ck) {
        LAS unsigned char* kb = lds + C_KIB + (ck & 1) * C_KIBUF;
        if (ck + 1 < NCK) KI_STAGE(ck + 1, (ck + 1) & 1);
#pragma unroll
        for (int i = 0; i < 112; ++i) SC[i] = SC[i + 16];
#pragma unroll
        for (int jj = 0; jj < 8; ++jj) {
            f32x16 D = {};
#pragma unroll
            for (int s = 0; s < 4; ++s) { const h16x8 bb = *(const LAS h16x8*)(kb + jj * 4096 + kroff + 16 * ((2 * s + hf) ^ kx)); D = __builtin_amdgcn_mfma_f32_32x32x16_f16(afr[s], bb, D, 0, 0, 0); }
            float s0 = 0.f, s1 = 0.f;
#pragma unroll
            for (int R = 0; R < 8; ++R) { s0 = fmaf(wreg[R], fmaxf(D[R], 0.f), s0); s1 = fmaf(wreg[8 + R], fmaxf(D[8 + R], 0.f), s1); }
            const int k = 256 * ck + 32 * jj + r;
            SC[112 + 2 * jj] = (k > tq0) ? QNAN : s0; SC[113 + 2 * jj] = (k > tq0 + 1) ? QNAN : s1;
        }
        LDS_WAIT(); VM_WAIT(); __syncthreads();
    }
#undef KI_STAGE
    const int G0 = 8 - NCK;
#define SEL_COUNT2(c0, c1, CNT, m0, m1) do { int a0_ = 0, a1_ = 0; \
        _Pragma("unroll") for (int g = 0; g < 8; ++g) if (g >= G0) { _Pragma("unroll") for (int jj = 0; jj < 8; ++jj) { const int j = 8 * g + jj; CNT(a0_, SC[2 * j], (m0)); CNT(a1_, SC[2 * j + 1], (m1)); } } \
        c0 = half_sum_dpp(a0_, hf); c1 = half_sum_dpp(a1_, hf); } while (0)
    float tau0 = -3.0e38f, tau1 = -3.0e38f;
    if (qt >= 8) {
        float lo0 = INFINITY, lo1 = INFINITY, hi0 = -INFINITY, hi1 = -INFINITY;
#pragma unroll
        for (int j = 0; j < 64; ++j) { const float a = SC[2 * j], c = SC[2 * j + 1]; lo0 = fminf(lo0, a); hi0 = fmaxf(hi0, a); lo1 = fminf(lo1, c); hi1 = fmaxf(hi1, c); }
#pragma unroll
        for (int o = 1; o < 32; o <<= 1) { lo0 = fminf(lo0, __shfl_xor(lo0, o)); lo1 = fminf(lo1, __shfl_xor(lo1, o)); hi0 = fmaxf(hi0, __shfl_xor(hi0, o)); hi1 = fmaxf(hi1, __shfl_xor(hi1, o)); }
        bool done0 = false, done1 = false;
        { int g0, g1, e0, e1; const float zero = 0.f; SEL_COUNT2(g0, g1, cnt_gt, zero, zero); SEL_COUNT2(e0, e1, cnt_ge, zero, zero);
          const float tiny = __uint_as_float(1u);
          if (g0 >= 256) { lo0 = 0.f; if (g0 == 256) { lo0 = tiny; done0 = true; } } else if (e0 >= 256) { lo0 = 0.f; done0 = true; } else hi0 = 0.f;
          if (g1 >= 256) { lo1 = 0.f; if (g1 == 256) { lo1 = tiny; done1 = true; } } else if (e1 >= 256) { lo1 = 0.f; done1 = true; } else hi1 = 0.f; }
#pragma unroll 1
        for (int it = 0; it < 32; ++it) {
            const float mid0 = 0.5f * (lo0 + hi0), mid1 = 0.5f * (lo1 + hi1);
            if (!done0 && (mid0 <= lo0 || mid0 >= hi0)) done0 = true;
            if (!done1 && (mid1 <= lo1 || mid1 >= hi1)) done1 = true;
            if (__all(done0 && done1)) break;
            int c0, c1; SEL_COUNT2(c0, c1, cnt_ge, mid0, mid1);
            if (!done0) { if (c0 >= 256) { lo0 = mid0; if (c0 == 256) done0 = true; } else hi0 = mid0; }
            if (!done1) { if (c1 >= 256) { lo1 = mid1; if (c1 == 256) done1 = true; } else hi1 = mid1; }
        }
        tau0 = lo0; tau1 = lo1;
    }
#undef SEL_COUNT2
    unsigned w00 = 0u, w01 = 0u, w10 = 0u, w11 = 0u;
#pragma unroll
    for (int g = 0; g < 8; ++g) if (g >= G0) {
#pragma unroll
        for (int jj = 0; jj < 8; ++jj) { const int j = 8 * g + jj, jt = 8 * (g - G0) + jj;
            ballot_ge_to_lane(w00, w10, SC[2 * j], tau0, jt); ballot_ge_to_lane(w01, w11, SC[2 * j + 1], tau1, jt); } }
    { LAS unsigned* WQ = (LAS unsigned*)(lds + C_WQ);
      WQ[(4 * w + 0) * 64 + lane] = w00; WQ[(4 * w + 1) * 64 + lane] = w01; WQ[(4 * w + 2) * 64 + lane] = w10; WQ[(4 * w + 3) * 64 + lane] = w11; }
    LDS_WAIT(); __syncthreads();
}

__device__ __forceinline__ void phaseC_attn(const Frame& F, int l, int b, int qt, bool do_store = true) {
    unsigned char* ws = F.ws; asm volatile("" : "+s"(ws)); const int w = F.wave;
    int lane = F.lane, tid = F.tid; asm volatile("" : "+v"(lane), "+v"(tid));
    const int r = lane & 31, hf = lane >> 5;
    const float* CS = (const float*)(ws + WS_CS);
    h16* QY = (h16*)(ws + WS_QY); const h16* KV = (const h16*)(ws + WS_KV);
    const h16* WUKT = (const h16*)(ws + WS_SMALLW + (size_t)l * SMALLW_LAYER); const h16* WUVT = (const h16*)(ws + WS_SMALLW + (size_t)l * SMALLW_LAYER + 98304);
    LAS unsigned char* lds = F.lds;
    const int t0 = 32 * qt, NT = qt + 1; const size_t tokbase = (size_t)b * SEQ;
    const int h = w; const size_t tokQ = tokbase + t0 + r;
    LAS h16* ql = (LAS h16*)(lds + C_QL + w * C_QLW);
    { h16x8 bq[3];
#pragma unroll
      for (int s = 0; s < 3; ++s) bq[s] = *(const h16x8*)(QY + tokQ * 1024 + h * 64 + 16 + 16 * s + 8 * hf);
#pragma unroll
      for (int cb = 0; cb < 4; ++cb) { f32x16 D = {};
#pragma unroll
          for (int s = 0; s < 3; ++s) { const h16x8 a = *(const h16x8*)(WUKT + ((size_t)(h * 128 + 32 * cb + r)) * 48 + 16 * s + 8 * hf); D = __builtin_amdgcn_mfma_f32_32x32x16_f16(a, bq[s], D, 0, 0, 0); }
#pragma unroll
          for (int g = 0; g < 4; ++g) { const int c = 32 * cb + 8 * g + 4 * hf;
              *(LAS u32x2*)(ql + r * KVP + c) = (u32x2){pkh(D[4 * g] * QSCALE, D[4 * g + 1] * QSCALE), pkh(D[4 * g + 2] * QSCALE, D[4 * g + 3] * QSCALE)}; } }
      { float o[8]; rope8(*(const h16x8*)(QY + tokQ * 1024 + h * 64), *(const h16x8*)(QY + tokQ * 1024 + h * 64 + 8), CS + tokQ * 16, hf, QSCALE, o); *(LAS u32x4*)(ql + r * KVP + 128 + 8 * hf) = pack8(o); } }
    LDS_WAIT();
    h16x8 qfr[9];
#pragma unroll
    for (int s = 0; s < 9; ++s) qfr[s] = *(const LAS h16x8*)(ql + r * KVP + 16 * s + 8 * hf);
    const h16* kvsrc = KV + tokbase * KVP;
    u32x4 kvA, kvB = {0u, 0u, 0u, 0u};
    kvA = *(const u32x4*)((const char*)kvsrc + (size_t)tid * 16); if (tid < 96) kvB = *(const u32x4*)((const char*)kvsrc + (size_t)(512 + tid) * 16);
    *(LAS u32x4*)(lds + C_KVS + tid * 16) = kvA; if (tid < 96) *(LAS u32x4*)(lds + C_KVS + (512 + tid) * 16) = kvB;
    LDS_WAIT(); __syncthreads();
    float mrun = -INFINITY, lrun = 0.f; f32x16 O[4];
#pragma unroll
    for (int db = 0; db < 4; ++db) O[db] = (f32x16){};
    const LAS unsigned* WQr = (const LAS unsigned*)(lds + C_WQ) + r * 64;
    const int troff = ((lane & 15) >> 2) * (KVP * 2) + (16 * ((lane >> 4) & 1) + 4 * (lane & 3)) * 2 + 4 * hf * (KVP * 2);
#pragma unroll 1
    for (int j = 0; j < NT; ++j) {
        if (j + 1 < NT) { const char* src = (const char*)kvsrc + (size_t)(j + 1) * C_KVSLOT; kvA = *(const u32x4*)(src + (size_t)tid * 16); if (tid < 96) kvB = *(const u32x4*)(src + (size_t)(512 + tid) * 16); }
        LAS unsigned char* slot = lds + C_KVS + (j & 1) * C_KVSLOT;
        f32x16 S = {};
#pragma unroll
        for (int s = 0; s < 9; ++s) { const h16x8 a = *(const LAS h16x8*)(slot + r * (KVP * 2) + 32 * s + 16 * hf); S = __builtin_amdgcn_mfma_f32_32x32x16_f16(a, qfr[s], S, 0, 0, 0); }
        float mt = S[0];
#pragma unroll
        for (int R = 1; R < 16; ++R) mt = fmaxf(mt, S[R]);
        mt = half_swap_max(mt);
        if (__any(mt > mrun + 8.0f)) { const float mnew = fmaxf(mrun, mt), alpha = __builtin_amdgcn_exp2f(mrun - mnew);
#pragma unroll
            for (int db = 0; db < 4; ++db) O[db] = O[db] * alpha;
            lrun *= alpha; mrun = mnew; }
        const unsigned wq = WQr[j] >> (4 * hf);
        float p[16];
#pragma unroll
        for (int R = 0; R < 16; ++R) { const float e = __builtin_amdgcn_exp2f(S[R] - mrun); p[R] = ((wq >> ((R & 3) + 8 * (R >> 2))) & 1u) ? e : 0.f; lrun += p[R]; }
        h16x8 pf[2];
#pragma unroll
        for (int sp = 0; sp < 2; ++sp) { u32x4 t; t.x = pkh(p[8 * sp], p[8 * sp + 1]); t.y = pkh(p[8 * sp + 2], p[8 * sp + 3]); t.z = pkh(p[8 * sp + 4], p[8 * sp + 5]); t.w = pkh(p[8 * sp + 6], p[8 * sp + 7]); pf[sp] = __builtin_bit_cast(h16x8, t); }
#pragma unroll
        for (int db = 0; db < 4; ++db)
#pragma unroll
            for (int sp = 0; sp < 2; ++sp) {
                const v4i16_t lo = __builtin_amdgcn_ds_read_tr16_b64_v4i16((LAS v4i16_t*)(slot + troff + (16 * sp) * (KVP * 2) + 64 * db));
                const v4i16_t hi = __builtin_amdgcn_ds_read_tr16_b64_v4i16((LAS v4i16_t*)(slot + troff + (16 * sp + 8) * (KVP * 2) + 64 * db));
                typedef short s16x8 __attribute__((ext_vector_type(8)));
                const s16x8 av = {lo[0], lo[1], lo[2], lo[3], hi[0], hi[1], hi[2], hi[3]};
                O[db] = __builtin_amdgcn_mfma_f32_32x32x16_f16(__builtin_bit_cast(h16x8, av), pf[sp], O[db], 0, 0, 0); }
        if (j + 1 < NT) { LAS unsigned char* nslot = lds + C_KVS + ((j + 1) & 1) * C_KVSLOT; *(LAS u32x4*)(nslot + tid * 16) = kvA; if (tid < 96) *(LAS u32x4*)(nslot + (512 + tid) * 16) = kvB; }
        LDS_WAIT(); __syncthreads();
    }
    { const float inv = 1.0f / half_swap_sum(lrun);
#pragma unroll
      for (int db = 0; db < 4; ++db)
#pragma unroll
          for (int g = 0; g < 4; ++g) { const int c = 32 * db + 8 * g + 4 * hf;
              *(LAS u32x2*)(ql + r * KVP + c) = (u32x2){pkh(O[db][4 * g] * inv, O[db][4 * g + 1] * inv), pkh(O[db][4 * g + 2] * inv, O[db][4 * g + 3] * inv)}; } }
    LDS_WAIT();
    { h16x8 ao[8];
#pragma unroll
      for (int s = 0; s < 8; ++s) ao[s] = *(const LAS h16x8*)(ql + r * KVP + 16 * s + 8 * hf);
#pragma unroll
      for (int d2 = 0; d2 < 2; ++d2) { f32x16 D = {};
#pragma unroll
          for (int s = 0; s < 8; ++s) { const h16x8 bw = *(const h16x8*)(WUVT + ((size_t)(h * 64 + 32 * d2 + r)) * 128 + 16 * s + 8 * hf); D = __builtin_amdgcn_mfma_f32_32x32x16_f16(ao[s], bw, D, 0, 0, 0); }
#pragma unroll
          for (int R = 0; R < 16; ++R) { if (do_store) QY[(tokbase + t0 + crow(R, hf)) * 1024 + h * 64 + 32 * d2 + r] = (h16)D[R]; else asm volatile("" :: "v"(D[R])); } } }
    LDS_WAIT(); __syncthreads();
}

__device__ __forceinline__ void phaseC(const Frame& F, int l) {
    int vc = F.vcu; asm volatile("" : "+s"(vc)); const int b = vc >> 5, i = vc & 31;
#pragma unroll 1
    for (int u = 0; u < 2; ++u) { const int qt = (u == 0) ? 63 - i : i;
#if defined(PROBE_C_SEL)
#pragma unroll 1
        for (int rep = 0; rep < 2; ++rep)
#endif
        phaseC_select(F, l, b, qt);
#if defined(PROBE_C_ATT)
#pragma unroll 1
        for (int rep = 0; rep < 2; ++rep) phaseC_attn(F, l, b, qt, rep == 1);
#else
        phaseC_attn(F, l, b, qt);
#endif
    }
}
#if defined(PROBE_EPI)
#define PROBE_NOEPI(f) (f)
#else
#define PROBE_NOEPI(f) 0
#endif
#ifndef PROBE_MASK
#define PROBE_MASK 0u
#endif
#ifndef MK_N_LAUNCHES
#define MK_N_LAUNCHES 1
#endif
constexpr int N_PHASES = 2 + 7 * NLAYER;
struct Args { In in; float* out; unsigned char* ws; int ph_lo, ph_hi, flags, pad; };

__global__ void __launch_bounds__(NTHREADS, 2) mk_fwd(Args args) {
    extern __shared__ __attribute__((aligned(16))) unsigned char lds_raw[];
    Frame F; F.lds = (LAS unsigned char*)lds_raw; F.tid = threadIdx.x; F.lane = F.tid & 63; F.wave = __builtin_amdgcn_readfirstlane(F.tid >> 6);
    F.G = gridDim.x; { const int bx = blockIdx.x; F.vcu = (F.G % 8 == 0) ? (bx % 8) * (F.G / 8) + bx / 8 : bx; }
    F.ws = args.ws; F.in = nullptr;
    const In& I = args.in; unsigned char* ws = args.ws; (void)ws;
    volatile LAS unsigned* MISCW = (volatile LAS unsigned*)(F.lds + LDS_MISC);
    if (F.tid < 64) MISCW[F.tid] = 0u;
    __syncthreads();
#if MK_N_LAUNCHES == 1
    const bool one_launch = true;
#else
    const bool one_launch = (args.ph_hi - args.ph_lo) > 1;
#endif
    XcdBarrier bar; bar.bar = (unsigned*)(ws + WS_CTL) + 1024; bar.x = 0; bar.st = nullptr;
    if (one_launch) bar = xcd_barrier_post((unsigned*)(ws + WS_CTL) + 1024, MISCW + 8);
#if MK_N_LAUNCHES == 1
#define IN(k) true
#define SEAM(k) xcd_barrier(bar)
#else
#define IN(k) (args.ph_lo <= (k) && (k) < args.ph_hi)
#define SEAM(k) do { if (IN(k) && IN((k) + 1)) xcd_barrier(bar); } while (0)
#endif
    if (IN(0)) { p0_prologue(F, I); SEAM(0); }
#define OPQ(x) asm volatile("" : "+s"(x))
#pragma unroll 1
    for (int l0 = 0; l0 < NLAYER; ++l0) {
        const int p = 1 + 7 * l0;
        if (IN(p)) {
            unsigned char* wsq = args.ws; int l = l0; OPQ(wsq); OPQ(l); unsigned char* wl = wsq + WS_W + (size_t)l * W_LAYER;
            pg8::Gemm g{(const h16*)(wsq + WS_X16), (const h16*)(wl + W_OFF_IN), 1024, 1024, 1024, M / 256, NZ / 256, 1, 0, PROBE_NOEPI(args.flags)};
            pg8::Order S; S.init(g.nM, g.nN, F.G, (int)blockIdx.x, 1); EpiA E{wsq};
            pg8::gemm_phase<EpiA>(F.lds, g, S, E); SEAM(p); }
        if (IN(p + 1)) { int l = l0; OPQ(l); phaseB(F, I, l); SEAM(p + 1); }
        if (IN(p + 2)) { int l = l0; OPQ(l); phaseC(F, l); SEAM(p + 2); }
        if (IN(p + 3)) {
            unsigned char* wsq = args.ws; int l = l0; OPQ(wsq); OPQ(l); unsigned char* wl = wsq + WS_W + (size_t)l * W_LAYER;
            pg8::Gemm g{(const h16*)(wsq + WS_QY), (const h16*)(wl + W_OFF_PAB), 1024, 1024, 512, M / 256, 4, 2, 512, PROBE_NOEPI(args.flags)};
            pg8::Order S; S.init(g.nM, g.nN, F.G, (int)blockIdx.x, 2); EpiD E{wsq, (h16*)args.out};
            pg8::gemm_phase<EpiD>(F.lds, g, S, E); SEAM(p + 3); }
        if (IN(p + 4)) {
            unsigned char* wsq = args.ws; int l = l0; OPQ(wsq); OPQ(l); unsigned char* wl = wsq + WS_W + (size_t)l * W_LAYER;
            pg8::Gemm g{(const h16*)args.out, (const h16*)(wl + W_OFF_OUT), 1024, 1024, 1024, M / 256, 4, 1, 0, PROBE_NOEPI(args.flags)};
            pg8::Order S; S.init(g.nM, g.nN, F.G, (int)blockIdx.x, 1);
            EpiRes E{(const h16*)(wsq + WS_X16), (h16*)(wsq + WS_X1), (float*)(wsq + WS_SSQ), (LAS float*)(F.lds + 131072)};
            pg8::gemm_phase<EpiRes>(F.lds, g, S, E); SEAM(p + 4); }
        if (IN(p + 5)) {
            unsigned char* wsq = args.ws; int l = l0; OPQ(wsq); OPQ(l); unsigned char* wl = wsq + WS_W + (size_t)l * W_LAYER;
            pg8::Gemm g{(const h16*)(wsq + WS_X1), (const h16*)(wl + W_OFF_GU), 1024, 1024, 1024, M / 256, NGU / 256, 1, 0, PROBE_NOEPI(args.flags)};
            pg8::Order S; S.init(g.nM, g.nN, F.G, (int)blockIdx.x, 1); EpiF E{wsq};
            pg8::gemm_phase<EpiF>(F.lds, g, S, E); SEAM(p + 5); }
        if (IN(p + 6)) {
            unsigned char* wsq = args.ws; int l = l0; OPQ(wsq); OPQ(l); unsigned char* wl = wsq + WS_W + (size_t)l * W_LAYER;
            pg8::Gemm g{(const h16*)(wsq + WS_ACT), (const h16*)(wl + W_OFF_D), DFF, DFF, DFF, M / 256, 4, 1, 0, PROBE_NOEPI(args.flags)};
            pg8::Order S; S.init(g.nM, g.nN, F.G, (int)blockIdx.x, 1);
            EpiRes E{(const h16*)(wsq + WS_X1), (h16*)(wsq + WS_X16), (float*)(wsq + WS_SSQ), (LAS float*)(F.lds + 131072)};
            pg8::gemm_phase<EpiRes>(F.lds, g, S, E); SEAM(p + 6); }
    }
    if (IN(N_PHASES - 1)) final_norm_phase(F, (const h16*)(args.ws + WS_X16), args.out, I.final_norm);
#undef IN
#undef SEAM
}

extern "C" void kernel_launch(void* const* d_in, const int* in_sizes, int n_in, void* d_out, int out_size, void* d_ws, size_t ws_size, hipStream_t stream) {
    static int grid = 0;
    if (grid == 0) {
        if (n_in != 19 || out_size != M * DM || ws_size < WS_END) { fprintf(stderr, "kernel_launch: unexpected shapes (n_in %d out %d ws %zu)\n", n_in, out_size, ws_size); grid = -1; return; }
        int dev = 0, cus = 0, per_cu = 0;
        hipGetDevice(&dev); hipDeviceGetAttribute(&cus, hipDeviceAttributeMultiprocessorCount, dev);
        hipFuncSetAttribute((const void*)mk_fwd, hipFuncAttributeMaxDynamicSharedMemorySize, LDS_BYTES);
        hipOccupancyMaxActiveBlocksPerMultiprocessor(&per_cu, (const void*)mk_fwd, NTHREADS, LDS_BYTES);
        (void)hipGetLastError();
        if (per_cu < 1) fprintf(stderr, "kernel_launch: occupancy query reports %d blocks per CU\n", per_cu);
        grid = cus;
    }
    if (grid < 0) return;
    hipMemsetAsync((char*)d_ws + WS_CTL, 0, CTL_ZERO_BYTES, stream);
    Args a{};
    const void** ip = (const void**)&a.in;
    for (int i = 0; i < 19; ++i) ip[i] = d_in[i];
    a.out = (float*)d_out; a.ws = (unsigned char*)d_ws;
#if MK_N_LAUNCHES == 1
    a.ph_lo = 0; a.ph_hi = N_PHASES;
    { void* kargs[] = {&a}; hipError_t e = hipLaunchCooperativeKernel((const void*)mk_fwd, dim3(grid), dim3(NTHREADS), kargs, LDS_BYTES, stream);
      if (e != hipSuccess) fprintf(stderr, "cooperative launch failed: %s (grid %d)\n", hipGetErrorString(e), grid); }
#else
    for (int p = 0; p < N_PHASES; ++p) { const int reps = ((PROBE_MASK >> p) & 1u) ? 2 : 1;
        for (int rr = 0; rr < reps; ++rr) { a.ph_lo = p; a.ph_hi = p + 1; a.flags = (rr > 0) ? 1 : 0; hipLaunchKernelGGL(mk_fwd, dim3(grid), dim3(NTHREADS), LDS_BYTES, stream, a); } }
#endif
}
```

```cpp
#define MK_N_LAUNCHES 1
#include <hip/hip_runtime.h>
#include <stdint.h>
#include <math.h>
#include <cstdio>

#define LAS __attribute__((address_space(3)))
#define GAS __attribute__((address_space(1)))
typedef _Float16 h16;
typedef h16 h16x8 __attribute__((ext_vector_type(8)));
typedef h16 h16x4 __attribute__((ext_vector_type(4)));
typedef h16 h16x2 __attribute__((ext_vector_type(2)));
typedef float f32x2 __attribute__((ext_vector_type(2)));
typedef float f32x4 __attribute__((ext_vector_type(4)));
typedef float f32x16 __attribute__((ext_vector_type(16)));
typedef unsigned u32x2 __attribute__((ext_vector_type(2)));
typedef unsigned u32x4 __attribute__((ext_vector_type(4)));
typedef short v4i16_t __attribute__((ext_vector_type(4)));

__device__ __forceinline__ int lane_id() { return (int)__builtin_amdgcn_mbcnt_hi(~0u, __builtin_amdgcn_mbcnt_lo(~0u, 0u)); }
__device__ __forceinline__ unsigned pkh(float lo, float hi) { h16x2 v = {(h16)lo, (h16)hi}; return __builtin_bit_cast(unsigned, v); }
__device__ __forceinline__ unsigned pkz(float lo, float hi) { return __builtin_bit_cast(unsigned, __builtin_amdgcn_cvt_pkrtz(lo, hi)); }
__device__ __forceinline__ float h2f_lo(unsigned u) { h16x2 v = __builtin_bit_cast(h16x2, u); return (float)v[0]; }
__device__ __forceinline__ float h2f_hi(unsigned u) { h16x2 v = __builtin_bit_cast(h16x2, u); return (float)v[1]; }

namespace pg8 {
constexpr int BM = 256, BK = 64, HALF = 128, HTB = HALF * BK * 2, STAGE_BYTES = 8 * HTB, NXCD = 8, WGM = 8;
__host__ __device__ __forceinline__ int lds_byte(int r, int c) { const int st = (r >> 4) * 2 + (c >> 5), rr = r & 15, cc = c & 31, ob = rr * 64 + cc * 2; return st * 1024 + (ob ^ (((ob >> 9) & 1) << 5)); }
__host__ __device__ __forceinline__ void stage_rc(int b, int& R, int& C) { const int st = b / 1024, sb = b % 1024, swz = sb ^ (((sb >> 9) & 1) << 5); R = (st >> 1) * 16 + swz / 64; C = (st & 1) * 32 + (swz % 64) / 2; }
__host__ __device__ __forceinline__ int perm32(int rho) { const int n = rho >> 4, i = rho & 15; return 8 * (i >> 2) + 4 * n + (i & 3); }

struct Unit { int pm, pn, kind; };
struct Gemm { const h16* A; const h16* Bt; int lda, ldb, K, nM, nN, nkind, koff, noepi, stagger; };

struct Order {
    int nM, nN, nwg, G, c, nk;
    __device__ void init(int nM_, int nN_, int G_, int c_, int nk_) { asm volatile("" : "+s"(G_), "+s"(c_)); nM = nM_; nN = nN_; nwg = nM * nN; G = G_; c = c_; nk = nk_; }
    __device__ bool next(int i, Unit& u) const {
        const int ti = i / nk; u.kind = i - ti * nk;
        const long L = (long)ti * G + c; if (L >= nwg) return false;
        int wgid = (int)L; { const int q = nwg / NXCD, r = nwg % NXCD, xcd = wgid % NXCD, off = wgid / NXCD; wgid = (xcd < r ? xcd * (q + 1) : r * (q + 1) + (xcd - r) * q) + off; }
        const int nig = WGM * nN, gid = wgid / nig, fm = gid * WGM, gsz = (nM - fm) < WGM ? (nM - fm) : WGM;
        u.pm = fm + ((wgid % nig) % gsz); u.pn = (wgid % nig) / gsz; return true;
    }
};

template <class Epi>
__device__ __forceinline__ void gemm_phase(LAS unsigned char* lds, const Gemm g, const Order& S, const Epi& E, int wave_) {
    int tid = wave_ * 64 + lane_id(); asm volatile("" : "+v"(tid));
    const int wid = __builtin_amdgcn_readfirstlane(tid >> 6), lane = tid & 63, wr = wid >> 2, wc = wid & 3, fr = lane & 15, fq = lane >> 4;
    const int nt = g.K / BK;
    unsigned voffA[2], voffB[2];
#pragma unroll
    for (int i = 0; i < 2; ++i) { int R, C; stage_rc(tid * 16 + i * 8192, R, C); const int Rb = Epi::PERM ? ((R & ~31) + perm32(R & 31)) : R;
        voffA[i] = (unsigned)(R * g.lda + C) * 2u; voffB[i] = (unsigned)(Rb * g.ldb + C) * 2u; }
    const size_t kstep = (size_t)(BK * 2);
    const size_t hstepA = (size_t)HALF * g.lda * 2, hstepB = (size_t)HALF * g.ldb * 2;
    const unsigned ldsw = (unsigned)wid * 1024u;
    const int aoff = lds_byte(wr * 64 + fr, fq * 8), boff = lds_byte(wc * 32 + fr, fq * 8);
#define PG8_SA(b, h) (((b) * 2 + (h)) * HTB)
#define PG8_SB(b, h) ((4 + (b) * 2 + (h)) * HTB)
#define PG8_STAGE(bufoff, gbase, voff) do { _Pragma("unroll") for (int _i = 0; _i < 2; ++_i) \
        __builtin_amdgcn_global_load_lds((const unsigned*)((const char*)(gbase) + (voff)[_i]), (LAS unsigned*)(lds + (bufoff) + ldsw + _i * 8192), 16, 0, 0); } while (0)
#define PG8_LDA(dst, b, h) do { _Pragma("unroll") for (int m = 0; m < 4; ++m) _Pragma("unroll") for (int k = 0; k < 2; ++k) dst[m][k] = *(const LAS h16x8*)(lds + PG8_SA(b, h) + aoff + m * 2048 + k * 1024); } while (0)
#define PG8_LDB(dst, b, h) do { _Pragma("unroll") for (int n = 0; n < 2; ++n) _Pragma("unroll") for (int k = 0; k < 2; ++k) dst[n][k] = *(const LAS h16x8*)(lds + PG8_SB(b, h) + boff + n * 2048 + k * 1024); } while (0)
#define PG8_MMA(ai, bj, At, Bt) do { __builtin_amdgcn_s_setprio(1); _Pragma("unroll") for (int m = 0; m < 4; ++m) _Pragma("unroll") for (int n = 0; n < 2; ++n) _Pragma("unroll") for (int k = 0; k < 2; ++k) \
        acc[ai][bj][m][n] = __builtin_amdgcn_mfma_f32_16x16x32_f16(Bt[n][k], At[m][k], acc[ai][bj][m][n], 0, 0, 0); __builtin_amdgcn_s_setprio(0); } while (0)
#define PG8_WAIT_V(n) asm volatile("s_waitcnt vmcnt(" #n ")" ::: "memory")
#define PG8_WAIT_L(n) asm volatile("s_waitcnt lgkmcnt(" #n ")" ::: "memory")
#define PG8_BAR __builtin_amdgcn_s_barrier()
#define PG8_SCHED __builtin_amdgcn_sched_barrier(0)
#define PG8_PA(u) ((const char*)g.A + ((size_t)(u).pm * 256 * g.lda + (size_t)(u).kind * g.koff) * 2)
#define PG8_PB(u) ((const char*)g.Bt + ((size_t)(u).pn * 256 * g.ldb + (size_t)(u).kind * g.koff) * 2)
    Unit cur, nxt; int ui = 0;
    if (!S.next(0, cur)) return;
    { const int nbig = S.nwg % S.G;
      if (nbig > 0 && S.c >= nbig && g.stagger) { const int ngrp = S.G / nbig, j = S.c / nbig; const unsigned long long dl = (unsigned long long)((g.K / BK) * 140 + 100) * S.nk * j / ngrp;
          const unsigned long long t0 = __builtin_amdgcn_s_memrealtime(); while (__builtin_amdgcn_s_memrealtime() - t0 < dl) __builtin_amdgcn_s_sleep(32); } }
    f32x4 acc[2][2][4][2];
#pragma unroll
    for (int a = 0; a < 2; ++a)
#pragma unroll
        for (int b = 0; b < 2; ++b)
#pragma unroll
            for (int m = 0; m < 4; ++m)
#pragma unroll
                for (int n = 0; n < 2; ++n) acc[a][b][m][n] = (f32x4){0.f, 0.f, 0.f, 0.f};
    h16x8 At[4][2], B0[2][2], B1[2][2];
    const char* cA = PG8_PA(cur); const char* cB = PG8_PB(cur);
    PG8_STAGE(PG8_SB(0, 0), cB, voffB); PG8_STAGE(PG8_SB(0, 1), cB + hstepB, voffB); PG8_STAGE(PG8_SA(0, 0), cA, voffA); PG8_STAGE(PG8_SA(0, 1), cA + hstepA, voffA);
    if (wr == 1) PG8_BAR;
    PG8_WAIT_V(2); PG8_BAR;
    PG8_STAGE(PG8_SB(1, 0), cB + kstep, voffB); PG8_STAGE(PG8_SA(1, 0), cA + kstep, voffA); PG8_STAGE(PG8_SB(1, 1), cB + hstepB + kstep, voffB);
    PG8_WAIT_V(6); PG8_BAR;
    for (;;) {
        const bool has_next = S.next(ui + 1, nxt);
        const char* nA = has_next ? PG8_PA(nxt) : cA; const char* nB = has_next ? PG8_PB(nxt) : cB;
        for (int t = 0; t < nt; t += 2) {
            const bool last = (t == nt - 2);
            const char* a1 = cA + (size_t)(t + 1) * kstep;
            const char* a2 = last ? nA : cA + (size_t)(t + 2) * kstep; const char* b2 = last ? nB : cB + (size_t)(t + 2) * kstep;
            const char* a3 = a2 + kstep; const char* b3 = b2 + kstep;
            PG8_LDB(B0, 0, 0); PG8_LDB(B1, 0, 1); PG8_SCHED; PG8_LDA(At, 0, 0); PG8_STAGE(PG8_SA(1, 1), a1 + hstepA, voffA);
            PG8_WAIT_V(8); PG8_WAIT_L(0); PG8_BAR; PG8_MMA(0, 0, At, B0); PG8_MMA(0, 1, At, B1); PG8_BAR; PG8_SCHED;
            PG8_LDA(At, 0, 1); PG8_STAGE(PG8_SB(0, 0), b2, voffB); PG8_STAGE(PG8_SB(0, 1), b2 + hstepB, voffB); PG8_STAGE(PG8_SA(0, 0), a2, voffA);
            PG8_WAIT_V(8); PG8_WAIT_L(0); PG8_BAR; PG8_MMA(1, 0, At, B0); PG8_MMA(1, 1, At, B1); PG8_BAR; PG8_SCHED;
            PG8_LDB(B0, 1, 0); PG8_LDB(B1, 1, 1); PG8_SCHED; PG8_LDA(At, 1, 0); PG8_STAGE(PG8_SA(0, 1), a2 + hstepA, voffA);
            PG8_WAIT_V(8); PG8_WAIT_L(0); PG8_BAR; PG8_MMA(0, 0, At, B0); PG8_MMA(0, 1, At, B1); PG8_BAR; PG8_SCHED;
            PG8_LDA(At, 1, 1); PG8_STAGE(PG8_SB(1, 0), b3, voffB); PG8_STAGE(PG8_SB(1, 1), b3 + hstepB, voffB); PG8_STAGE(PG8_SA(1, 0), a3, voffA);
            PG8_WAIT_V(8); PG8_WAIT_L(0); PG8_BAR; PG8_MMA(1, 0, At, B0); PG8_MMA(1, 1, At, B1); PG8_BAR; PG8_SCHED;
        }
        if (wr == 0) PG8_BAR;
        { int fr_ = fr, fq_ = fq; asm volatile("" : "+v"(fr_), "+v"(fq_)); if (!g.noepi) E(acc, cur, wr, wc, fr_, fq_); }
        if (!has_next) break;
        if (nxt.kind == 0) {
#pragma unroll
            for (int a = 0; a < 2; ++a)
#pragma unroll
                for (int b = 0; b < 2; ++b)
#pragma unroll
                    for (int m = 0; m < 4; ++m)
#pragma unroll
                        for (int n = 0; n < 2; ++n) acc[a][b][m][n] = (f32x4){0.f, 0.f, 0.f, 0.f};
        }
        cur = nxt; cA = nA; cB = nB; ++ui;
        if (wr == 1) PG8_BAR;
    }
    PG8_WAIT_V(0);
    PG8_BAR;
#undef PG8_SA
#undef PG8_SB
#undef PG8_STAGE
#undef PG8_LDA
#undef PG8_LDB
#undef PG8_MMA
#undef PG8_WAIT_V
#undef PG8_WAIT_L
#undef PG8_BAR
#undef PG8_SCHED
#undef PG8_PA
#undef PG8_PB
}
}
constexpr int NWAVES = 8, NTHREADS = 512;
constexpr int NB = 8, SEQ = 2048, DM = 1024, M = NB * SEQ, DIN = 4312, DFF = 2816, NLAYER = 2;
constexpr int NZ = 4352;
constexpr int NGU = 2 * DFF;
constexpr float EPS_RMS = 1e-6f;
constexpr float LOG2E = 1.4426950408889634f;
constexpr float QSCALE = 0.125f * LOG2E;
constexpr int KVP = 152;

constexpr size_t MiB = 1u << 20;
constexpr size_t WS_CTL = 0, CTL_ZERO_BYTES = 65536;
constexpr size_t WS_CS = 1 * MiB;
constexpr size_t WS_SSQ = 2 * MiB;
constexpr size_t WS_WI = 3 * MiB;
constexpr size_t WS_SMALLW = 4 * MiB;
constexpr size_t SMALLW_LAYER = 98304 + 131072 + 262144;
constexpr size_t WS_W = 6 * MiB;
constexpr size_t W_LAYER = 29 * MiB, W_OFF_IN = 0, W_OFF_PAB = (size_t)NZ * 1024 * 2, W_OFF_OUT = W_OFF_PAB + 2 * MiB, W_OFF_GU = W_OFF_OUT + 2 * MiB, W_OFF_D = W_OFF_GU + (size_t)NGU * 1024 * 2;
static_assert(W_OFF_D + (size_t)1024 * DFF * 2 == W_LAYER, "weight map");
constexpr size_t WS_X16 = 64 * MiB;
constexpr size_t WS_QY = 96 * MiB;
constexpr size_t WS_QI = 128 * MiB;
constexpr size_t WS_MISC = 144 * MiB;
constexpr size_t WS_KV = 152 * MiB;
constexpr size_t WS_KI = 157 * MiB;
constexpr size_t WS_X1 = 128 * MiB;
constexpr size_t WS_GATES = 160 * MiB;
constexpr size_t WS_UV = 224 * MiB;
constexpr size_t WS_ACT = 160 * MiB;
constexpr size_t WS_END = 256 * MiB;
static_assert(WS_KV + (size_t)M * KVP * 2 <= WS_KI && WS_KI + (size_t)M * 64 * 2 <= WS_GATES && WS_ACT + (size_t)M * DFF * 2 <= WS_END, "ws map");

constexpr int LDS_BYTES = 155648;
constexpr int LDS_MISC = 151552;

#define RLX_AGENT __ATOMIC_RELAXED, __HIP_MEMORY_SCOPE_AGENT
#define LDS_WAIT() asm volatile("s_waitcnt lgkmcnt(0)" ::: "memory")
#define VM_WAIT() asm volatile("s_waitcnt vmcnt(0)" ::: "memory")

#define XB_TMO      128
#define XB_XCNT(j)  (256  + 64 * (j))
#define XB_XSUB(j)  (1280 + 64 * (j))
#define XB_XGEN(j)  (2304 + 64 * (j))
#define XB_TOP      3328
#define XB_TOPGEN   3392
#define XCD_BAR_WORDS 3456
#define XB_SPIN_CAP (1u << 18)
__device__ __forceinline__ unsigned xb_ld(unsigned* p)              { return __hip_atomic_load(p, __ATOMIC_RELAXED, __HIP_MEMORY_SCOPE_AGENT); }
__device__ __forceinline__ unsigned xb_add(unsigned* p, unsigned v) { return __hip_atomic_fetch_add(p, v, __ATOMIC_RELAXED, __HIP_MEMORY_SCOPE_AGENT); }
__device__ __forceinline__ unsigned xb_xcc_id() { return (unsigned)__builtin_amdgcn_s_getreg((3 << 11) | 20) & 0xFu; }
#define XB_SPIN(cond, bar) do { unsigned _sp = 0; while (cond) { __builtin_amdgcn_s_sleep(1); \
    if ((++_sp & 255u) == 0u) { if (xb_ld(&(bar)[XB_TMO])) break; if (_sp > XB_SPIN_CAP) { atomicAdd(&(bar)[XB_TMO], 1u); break; } } } } while (0)
struct XcdBarrier { unsigned* bar; unsigned x; volatile LAS unsigned* st; };
__device__ __forceinline__ XcdBarrier xcd_barrier_post(unsigned* bar, volatile LAS unsigned* st, int wave_) {
    XcdBarrier b; b.bar = bar; b.x = xb_xcc_id(); b.st = st;
    if (wave_ == 0 && lane_id() == 0) (void)xb_add(&bar[XB_XCNT(b.x)], 1u);
    return b;
}
__device__ __forceinline__ void xcd_barrier_complete(unsigned* bar, unsigned x, unsigned& nloc, unsigned& nx) {
    const unsigned G = gridDim.x * gridDim.y * gridDim.z;
    unsigned sum, cnt, mine, sp = 0u;
    for (;;) {
        sum = 0u; cnt = 0u; mine = 0u;
#pragma unroll
        for (unsigned j = 0; j < 16; ++j) { const unsigned c = xb_ld(&bar[XB_XCNT(j)]); sum += c; cnt += (c > 0u) ? 1u : 0u; }
        mine = xb_ld(&bar[XB_XCNT(x)]);
        if (sum == G) break;
        __builtin_amdgcn_s_sleep(1);
        if ((++sp & 255u) == 0u) { if (xb_ld(&bar[XB_TMO])) break; if (sp > XB_SPIN_CAP) { atomicAdd(&bar[XB_TMO], 1u); break; } }
    }
    nloc = mine > 0u ? mine : 1u; nx = cnt > 0u ? cnt : 1u;
}
__device__ __forceinline__ void xcd_barrier(const XcdBarrier& b, int wave_) {
    asm volatile("s_waitcnt vmcnt(0)" ::: "memory");
    __syncthreads();
    if (wave_ == 0 && lane_id() == 0) {
        unsigned* bar = b.bar; asm volatile("" : "+s"(bar));
        unsigned stoff = (unsigned)(uintptr_t)b.st; asm volatile("" : "+s"(stoff)); volatile LAS unsigned* st = (volatile LAS unsigned*)(uintptr_t)stoff;
        const unsigned x = xb_xcc_id();
        __builtin_amdgcn_s_waitcnt(0);
        unsigned nloc = st[0], nx = st[1];
        if (nloc == 0u) { xcd_barrier_complete(bar, x, nloc, nx); st[0] = nloc; st[1] = nx; }
        const unsigned old = xb_add(&bar[XB_XSUB(x)], 1u);
        const unsigned gen = old / nloc;
        if (old + 1u == (gen + 1u) * nloc) {
            __builtin_amdgcn_fence(__ATOMIC_RELEASE, "agent");
            asm volatile("s_waitcnt vmcnt(0)" ::: "memory");
            const unsigned og = xb_add(&bar[XB_TOP], 1u);
            const unsigned tg = og / nx;
            if (og + 1u == (tg + 1u) * nx) xb_add(&bar[XB_TOPGEN], 1u);
            else XB_SPIN(xb_ld(&bar[XB_TOPGEN]) == tg, bar);
            __builtin_amdgcn_fence(__ATOMIC_ACQUIRE, "agent");
            xb_add(&bar[XB_XGEN(x)], 1u);
            asm volatile("s_waitcnt vmcnt(0)" ::: "memory");
        } else {
            XB_SPIN(xb_ld(&bar[XB_XGEN(x)]) == gen, bar);
            __builtin_amdgcn_fence(__ATOMIC_ACQUIRE, "agent");
            asm volatile("s_waitcnt vmcnt(0)" ::: "memory");
        }
    }
    __syncthreads();
}

__device__ __forceinline__ float gelu_tanh_f(float x) {
    const float u = 0.7978845608028654f * (x + 0.044715f * x * x * x);
    const float e = __builtin_amdgcn_exp2f(-2.0f * LOG2E * u);
    return x * __builtin_amdgcn_rcpf(1.0f + e);
}
__device__ __forceinline__ float sigmoid_f(float x) { return __builtin_amdgcn_rcpf(1.0f + __builtin_amdgcn_exp2f(-LOG2E * x)); }

struct Frame {
    LAS unsigned char* lds;
    int wave, vcu, G;
    unsigned char* ws;
    const float* const* in;
};
struct In {
    const float* x; const int* pos; const float* norm_mix; const float* w_in; const float* kv_norm; const float* w_uk; const float* w_uv; const float* ln_v_g; const float* ln_v_b;
    const float* w_s; const float* b_s; const float* w_proj_a; const float* w_proj_b; const float* w_out; const float* norm_ffn; const float* w_gate; const float* w_up; const float* w_down; const float* final_norm;
};

__device__ __constant__ float c_inv[8] = {1.0f, 0.19392274474868576f, 0.03760603093086393f, 0.007292664737217109f, 0.001414213562373095f, 0.0002742481756762073f, 5.318295896944988e-05f, 1.031338537721246e-05f};

__device__ __forceinline__ void transpose_item64(const float* W4, int Nsrc, h16* WT, int ldt, int n0, int k0, const float* gain, LAS float* scr, int lane) {
    const int nq = lane & 15, kq = lane >> 4;
    f32x4 v[16];
#pragma unroll
    for (int i = 0; i < 16; ++i) v[i] = W4 ? *(const GAS f32x4*)(W4 + (size_t)(k0 + 4 * i + kq) * Nsrc) : (f32x4){0.f, 0.f, 0.f, 0.f};
#pragma unroll
    for (int i = 0; i < 16; ++i) { const int kk = 4 * i + kq; f32x4 x = v[i]; if (gain) x = x * gain[k0 + kk]; *(LAS f32x4*)(scr + kk * 68 + 4 * (nq ^ (kk >> 3))) = x; }
    LDS_WAIT(); asm volatile("" ::: "memory");
    const int c = lane & 7;
#pragma unroll
    for (int j = 0; j < 8; ++j) { const int n = (lane >> 3) + 8 * j; const LAS float* sp = scr + (8 * c) * 68 + 4 * ((n >> 2) ^ c) + (n & 3);
        u32x4 o; o.x = pkh(sp[0 * 68], sp[1 * 68]); o.y = pkh(sp[2 * 68], sp[3 * 68]); o.z = pkh(sp[4 * 68], sp[5 * 68]); o.w = pkh(sp[6 * 68], sp[7 * 68]);
        *(GAS u32x4*)(WT + (size_t)(n0 + n) * ldt + k0 + 8 * c) = o; }
    LDS_WAIT(); asm volatile("" ::: "memory");
}
__device__ __forceinline__ int win_src_col(int n) {
    if (n < 512) return n;
    if (n < 1024) return 656 + (n - 512);
    if (n < 2048) return 1240 + (n - 1024);
    if (n < 4096) return 2264 + (n - 2048);
    if (n < 4224) return 512 + (n - 4096);
    if (n < 4240) return 640 + (n - 4224);
    if (n < 4304) return 1168 + (n - 4240);
    if (n < 4312) return 1232 + (n - 4304);
    return -1;
}
__device__ __forceinline__ void convert_layer_weights(const Frame& F, const In& I, int l, int gw, int NGW, int it_lo = 0, int it_hi = 1 << 30) {
    LAS float* scr = (LAS float*)(F.lds + F.wave * 17408);
    int lane = lane_id(); asm volatile("" : "+v"(lane));
    constexpr int I_IN = (NZ / 64) * 16, I_PA = 16 * 8, I_OUT = 16 * 16, I_GU = (NGU / 64) * 16, I_D = 16 * (DFF / 64);
    constexpr int I_LAYER = I_IN + 2 * I_PA + I_OUT + I_GU + I_D;
    const int n4 = 4 * (lane & 15);
    unsigned char* wl = F.ws + WS_W + (size_t)l * W_LAYER;
    if (it_hi > I_LAYER) it_hi = I_LAYER;
    for (int it = it_lo + gw; it < it_hi; it += NGW) {
        int r = it;
        if (r < I_IN) { const int nb = r / 16, kb = r % 16, sc = win_src_col(nb * 64 + n4);
            transpose_item64(sc >= 0 ? I.w_in + (size_t)l * DM * DIN + sc : nullptr, DIN, (h16*)(wl + W_OFF_IN), 1024, nb * 64, kb * 64, I.norm_mix + l * DM, scr, lane); continue; }
        r -= I_IN;
        if (r < I_PA) { const int nb = r / 8, kb = r % 8;
            transpose_item64(I.w_proj_a + (size_t)l * 512 * 1024 + nb * 64 + n4, 1024, (h16*)(wl + W_OFF_PAB), 1024, nb * 64, kb * 64, nullptr, scr, lane); continue; }
        r -= I_PA;
        if (r < I_PA) { const int nb = r / 8, kb = r % 8;
            transpose_item64(I.w_proj_b + (size_t)l * 512 * 1024 + nb * 64 + n4, 1024, (h16*)(wl + W_OFF_PAB) + 512, 1024, nb * 64, kb * 64, nullptr, scr, lane); continue; }
        r -= I_PA;
        if (r < I_OUT) { const int nb = r / 16, kb = r % 16;
            transpose_item64(I.w_out + (size_t)l * 1024 * 1024 + nb * 64 + n4, 1024, (h16*)(wl + W_OFF_OUT), 1024, nb * 64, kb * 64, nullptr, scr, lane); continue; }
        r -= I_OUT;
        if (r < I_GU) { const int nb = r / 16, kb = r % 16, R = nb * 64 + n4, pn = R >> 8, rem = R & 255;
            const int a = 128 * pn + 64 * (rem >> 7) + 16 * ((rem >> 5) & 3) + 4 * ((rem >> 3) & 3);
            const float* src = (((rem >> 2) & 1) ? I.w_up : I.w_gate) + (size_t)l * DM * DFF + a;
            transpose_item64(src, DFF, (h16*)(wl + W_OFF_GU), 1024, nb * 64, kb * 64, I.norm_ffn + l * DM, scr, lane); continue; }
        r -= I_GU;
        { const int nb = r / (DFF / 64), kb = r % (DFF / 64);
            transpose_item64(I.w_down + (size_t)l * DFF * 1024 + nb * 64 + n4, 1024, (h16*)(wl + W_OFF_D), DFF, nb * 64, kb * 64, nullptr, scr, lane); }
    }
}
__device__ __forceinline__ void p0_prologue(const Frame& F, const In& I) {
    int lane = lane_id(); asm volatile("" : "+v"(lane));
    const int gw = F.vcu * NWAVES + F.wave, NGW = F.G * NWAVES;
    convert_layer_weights(F, I, 0, gw, NGW);
    const int gt = F.vcu * NTHREADS + F.wave * 64 + lane, NGT = F.G * NTHREADS;
    for (int i = gt; i < NLAYER * 49152; i += NGT) { const int l = i / 49152, e = i % 49152, h = e / (128 * 48), c = (e / 48) % 128, n = e % 48;
        ((h16*)(F.ws + WS_SMALLW + (size_t)l * SMALLW_LAYER))[e] = (h16)I.w_uk[(((size_t)l * 8 + h) * 48 + n) * 128 + c]; }
    for (int i = gt; i < NLAYER * 65536; i += NGT) { const int l = i / 65536, e = i % 65536, h = e / (64 * 128), d = (e / 128) % 64, c = e % 128;
        ((h16*)(F.ws + WS_SMALLW + (size_t)l * SMALLW_LAYER + 98304))[e] = (h16)I.w_uv[(((size_t)l * 8 + h) * 128 + c) * 64 + d]; }
    for (int i = gt; i < NLAYER * 131072; i += NGT) { const int l = i / 131072, e = i % 131072, t = (e / 128) % 128, s = e % 128;
        ((h16*)(F.ws + WS_SMALLW + (size_t)l * SMALLW_LAYER + 98304 + 131072))[e] = (s <= t) ? (h16)I.w_s[(size_t)l * 131072 + e] : (h16)0.f; }
    for (int i = gt; i < M * 8; i += NGT) { const int tok = i >> 3, f = i & 7; const float ang = (float)I.pos[tok] * c_inv[f];
        float* cs = (float*)(F.ws + WS_CS) + (size_t)tok * 16; cs[f] = cosf(ang); cs[8 + f] = sinf(ang); }
    for (int m = gw; m < M; m += NGW) {
        const f32x4* xr = (const f32x4*)(I.x + (size_t)m * DM) + lane; u32x2* o8 = (u32x2*)((h16*)(F.ws + WS_X16) + (size_t)m * DM) + lane;
#pragma unroll
        for (int j = 0; j < 4; ++j) { const f32x4 v = xr[64 * j]; float s = (v.x * v.x + v.y * v.y) + (v.z * v.z + v.w * v.w);
#pragma unroll
            for (int o = 1; o < 64; o <<= 1) s += __shfl_xor(s, o);
            o8[64 * j] = (u32x2){pkh(v.x, v.y), pkh(v.z, v.w)};
            if (lane == 0) ((GAS float*)(F.ws + WS_SSQ))[(size_t)m * 4 + j] = s; }
    }
}

__device__ __forceinline__ float row_rstd(const float* ssq, int row) {
    const f32x4 a = *(const GAS f32x4*)(ssq + (size_t)row * 4);
    return rsqrtf(((a.x + a.y) + (a.z + a.w)) * (1.0f / DM) + EPS_RMS);
}

typedef f32x4 Acc[2][2][4][2];
__device__ __forceinline__ u32x4 pack8h(const float (&v)[8]) { u32x4 w; w.x = pkz(v[0], v[1]); w.y = pkz(v[2], v[3]); w.z = pkz(v[4], v[5]); w.w = pkz(v[6], v[7]); return w; }

__device__ __forceinline__ void rstd_to_lds(const float* ssq, int pm, LAS float* R, int wr, int wc, int fr, int fq) {
    const int t = (wr * 4 + wc) * 64 + fq * 16 + fr;
    if (t < 256) { const f32x4 a = *(const GAS f32x4*)(ssq + (size_t)(pm * 256 + t) * 4); R[t] = rsqrtf(((a.x + a.y) + (a.z + a.w)) * (1.0f / DM) + EPS_RMS); }
    asm volatile("s_waitcnt lgkmcnt(0)" ::: "memory"); __builtin_amdgcn_s_barrier(); asm volatile("" ::: "memory");
}
struct EpiA {
    static constexpr bool PERM = true;
    unsigned char* ws; int nostore; LAS float* R;
    __device__ __forceinline__ void operator()(Acc& acc, const pg8::Unit& u, int wr, int wc, int fr, int fq) const {
        const int pn = u.pn; h16* base; int ldc, colt;
        if (pn < 2) { base = (h16*)(ws + WS_QY); ldc = 1024; colt = pn * 256; }
        else if (pn < 4) { base = (h16*)(ws + WS_QI); ldc = 512; colt = (pn - 2) * 256; }
        else if (pn < 8) { base = (h16*)(ws + WS_UV); ldc = 1024; colt = (pn - 4) * 256; }
        else if (pn < 16) { base = (h16*)(ws + WS_GATES); ldc = 2048; colt = (pn - 8) * 256; }
        else { base = (h16*)(ws + WS_MISC); ldc = 256; colt = 0; }
        const int row0 = u.pm * 256 + wr * 64 + fr, col0 = colt + wc * 32 + 8 * fq;
        rstd_to_lds((const float*)(ws + WS_SSQ), u.pm, R, wr, wc, fr, fq);
#pragma unroll
        for (int ai = 0; ai < 2; ++ai)
#pragma unroll
            for (int m = 0; m < 4; ++m) { const int row = row0 + ai * 128 + m * 16; const float rs = R[ai * 128 + wr * 64 + m * 16 + fr]; h16* rowp = base + (size_t)row * ldc + col0;
#pragma unroll
                for (int bj = 0; bj < 2; ++bj) { f32x4 v0 = acc[ai][bj][m][0] * rs, v1 = acc[ai][bj][m][1] * rs;
                    u32x4 w; w.x = pkz(v0[0], v0[1]); w.y = pkz(v0[2], v0[3]); w.z = pkz(v1[0], v1[1]); w.w = pkz(v1[2], v1[3]);
                    if (!nostore) *(GAS u32x4*)(rowp + bj * 128) = w; else asm volatile("" :: "v"(w)); } }
        asm volatile("s_waitcnt lgkmcnt(0)" ::: "memory"); __builtin_amdgcn_s_barrier(); asm volatile("" ::: "memory");
    }
};

struct EpiD {
    static constexpr bool PERM = true;
    unsigned char* ws; h16* mg;
    __device__ __forceinline__ void operator()(Acc& acc, const pg8::Unit& u, int wr, int wc, int fr, int fq) const {
        const int row0 = u.pm * 256 + wr * 64 + fr, col0 = u.pn * 256 + wc * 32 + 8 * fq;
        const h16* gates = (const h16*)(ws + WS_GATES);
#pragma unroll
        for (int ai = 0; ai < 2; ++ai)
#pragma unroll
            for (int m = 0; m < 4; ++m) { const int row = row0 + ai * 128 + m * 16;
#pragma unroll
                for (int bj = 0; bj < 2; ++bj) { const int col = col0 + bj * 128;
                    const h16x8 gb = *(const GAS h16x8*)(gates + (size_t)row * 2048 + 1024 + col);
                    if (u.kind == 0) { const h16x8 ga = *(const GAS h16x8*)(gates + (size_t)row * 2048 + col);
#pragma unroll
                        for (int i = 0; i < 8; ++i) { const float a = fminf(fmaxf((float)ga[i], -30.f), 30.f), b = fminf(fmaxf((float)gb[i], -30.f), 30.f);
                            const float ratio = (1.0f + __builtin_amdgcn_exp2f(-LOG2E * b)) * __builtin_amdgcn_rcpf(1.0f + __builtin_amdgcn_exp2f(-LOG2E * a));
                            acc[ai][bj][m][i >> 2][i & 3] *= ratio; }
                    } else { float v[8];
#pragma unroll
                        for (int i = 0; i < 8; ++i) { const float b = fminf(fmaxf((float)gb[i], -30.f), 30.f); v[i] = acc[ai][bj][m][i >> 2][i & 3] * sigmoid_f(b); }
                        u32x4 w; w.x = pkz(v[0], v[1]); w.y = pkz(v[2], v[3]); w.z = pkz(v[4], v[5]); w.w = pkz(v[6], v[7]);
                        *(GAS u32x4*)(mg + (size_t)row * 1024 + col) = w; } }
                asm volatile("" ::: "memory"); }
    }
};

struct EpiRes {
    static constexpr bool PERM = true;
    const h16* resid; h16* xo; float* ssq; LAS float* P;
    __device__ __forceinline__ void operator()(Acc& acc, const pg8::Unit& u, int wr, int wc, int fr, int fq) const {
        const int row0 = u.pm * 256 + wr * 64 + fr, col0 = u.pn * 256 + wc * 32 + 8 * fq;
#pragma unroll
        for (int ai = 0; ai < 2; ++ai)
#pragma unroll
            for (int m = 0; m < 4; ++m) { const int row = row0 + ai * 128 + m * 16; float ss = 0.f;
#pragma unroll
                for (int bj = 0; bj < 2; ++bj) { const size_t off = (size_t)row * 1024 + col0 + bj * 128;
                    const h16x8 rv = *(const GAS h16x8*)(resid + off); float v[8];
#pragma unroll
                    for (int i = 0; i < 8; ++i) { v[i] = (float)rv[i] + acc[ai][bj][m][i >> 2][i & 3]; ss = fmaf(v[i], v[i], ss); }
                    *(GAS u32x4*)(xo + off) = pack8h(v); }
                ss += __shfl_xor(ss, 16); ss += __shfl_xor(ss, 32);
                if (fq == 0) P[(ai * 128 + wr * 64 + m * 16 + fr) * 4 + wc] = ss;
                asm volatile("" ::: "memory"); }
        asm volatile("s_waitcnt lgkmcnt(0)" ::: "memory"); __builtin_amdgcn_s_barrier(); asm volatile("" ::: "memory");
        { const int t = (wr * 4 + wc) * 64 + fq * 16 + fr; if (t < 256) { const f32x4 v = *(const LAS f32x4*)(P + t * 4); ((GAS float*)ssq)[(size_t)(u.pm * 256 + t) * 4 + u.pn] = (v.x + v.y) + (v.z + v.w); } }
        asm volatile("s_waitcnt lgkmcnt(0)" ::: "memory"); __builtin_amdgcn_s_barrier(); asm volatile("" ::: "memory");
    }
};

struct EpiF {
    static constexpr bool PERM = true;
    unsigned char* ws; LAS float* R;
    __device__ __forceinline__ void operator()(Acc& acc, const pg8::Unit& u, int wr, int wc, int fr, int fq) const {
        const int row0 = u.pm * 256 + wr * 64 + fr, col0 = u.pn * 128 + wc * 16 + 4 * fq;
        h16* act = (h16*)(ws + WS_ACT);
        rstd_to_lds((const float*)(ws + WS_SSQ), u.pm, R, wr, wc, fr, fq);
#pragma unroll
        for (int ai = 0; ai < 2; ++ai)
#pragma unroll
            for (int m = 0; m < 4; ++m) { const int row = row0 + ai * 128 + m * 16; const float rs = R[ai * 128 + wr * 64 + m * 16 + fr];
#pragma unroll
                for (int bj = 0; bj < 2; ++bj) { const f32x4 g = acc[ai][bj][m][0] * rs, uu = acc[ai][bj][m][1] * rs; float v[4];
#pragma unroll
                    for (int i = 0; i < 4; ++i) v[i] = g[i] * sigmoid_f(g[i]) * uu[i];
                    *(GAS u32x2*)(act + (size_t)row * DFF + col0 + bj * 64) = (u32x2){pkz(v[0], v[1]), pkz(v[2], v[3])}; } }
        asm volatile("s_waitcnt lgkmcnt(0)" ::: "memory"); __builtin_amdgcn_s_barrier(); asm volatile("" ::: "memory");
    }
};

__device__ __forceinline__ void final_norm_phase(const Frame& F, const h16* x16, float* out, const float* g) {
    int lane = lane_id(); asm volatile("" : "+v"(lane));
    const int gw = F.vcu * NWAVES + F.wave, NGW = F.G * NWAVES;
    for (int m = gw; m < M; m += NGW) {
        const h16x8 a = *(const GAS h16x8*)(x16 + (size_t)m * DM + 8 * lane), b = *(const GAS h16x8*)(x16 + (size_t)m * DM + 512 + 8 * lane); float s = 0.f;
#pragma unroll
        for (int j = 0; j < 8; ++j) { s = fmaf((float)a[j], (float)a[j], s); s = fmaf((float)b[j], (float)b[j], s); }
#pragma unroll
        for (int o = 1; o < 64; o <<= 1) s += __shfl_xor(s, o);
        const float rs = rsqrtf(s * (1.0f / DM) + EPS_RMS);
#pragma unroll
        for (int hh = 0; hh < 2; ++hh) { const h16x8 v = hh ? b : a; const int c = 512 * hh + 8 * lane;
            const f32x4 g0 = *(const GAS f32x4*)(g + c), g1 = *(const GAS f32x4*)(g + c + 4);
            *(GAS f32x4*)(out + (size_t)m * DM + c) = (f32x4){(float)v[0] * rs * g0.x, (float)v[1] * rs * g0.y, (float)v[2] * rs * g0.z, (float)v[3] * rs * g0.w};
            *(GAS f32x4*)(out + (size_t)m * DM + c + 4) = (f32x4){(float)v[4] * rs * g1.x, (float)v[5] * rs * g1.y, (float)v[6] * rs * g1.z, (float)v[7] * rs * g1.w}; }
    }
}
__device__ __forceinline__ unsigned wlane(unsigned val, int ln, unsigned old) {
    unsigned keep;
    asm volatile("s_mov_b32 %1, m0\n\ts_mov_b32 m0, %3\n\ts_nop 3\n\tv_writelane_b32 %0, %2, m0\n\ts_mov_b32 m0, %1" : "+v"(old), "=&s"(keep) : "s"(val), "s"(ln));
    return old;
}
__device__ __forceinline__ void cnt_ge(int& c, float x, float m) { asm("v_cmp_ge_f32 vcc, %1, %2\n\tv_addc_co_u32 %0, vcc, 0, %0, vcc" : "+v"(c) : "v"(x), "v"(m) : "vcc"); }
__device__ __forceinline__ void cnt_gt(int& c, float x, float m) { asm("v_cmp_gt_f32 vcc, %1, %2\n\tv_addc_co_u32 %0, vcc, 0, %0, vcc" : "+v"(c) : "v"(x), "v"(m) : "vcc"); }
#define SEL_CG2(OP, a, b) "v_cmp_" OP "_f32 vcc, " a ", %19\n\tv_cmp_" OP "_f32 %2, " b ", %20\n\tv_addc_co_u32 %0, vcc, 0, %0, vcc\n\tv_addc_co_u32 %1, %2, 0, %1, %2\n\t"
#define SEL_CGROUP(NAME, OP) __device__ __forceinline__ void NAME(int& c0, int& c1, const float* s, float m0, float m1) { unsigned long long tmp; \
    asm(SEL_CG2(OP, "%3", "%4") SEL_CG2(OP, "%5", "%6") SEL_CG2(OP, "%7", "%8") SEL_CG2(OP, "%9", "%10") SEL_CG2(OP, "%11", "%12") SEL_CG2(OP, "%13", "%14") SEL_CG2(OP, "%15", "%16") SEL_CG2(OP, "%17", "%18") \
        : "+v"(c0), "+v"(c1), "=&s"(tmp) : "v"(s[0]), "v"(s[1]), "v"(s[2]), "v"(s[3]), "v"(s[4]), "v"(s[5]), "v"(s[6]), "v"(s[7]), "v"(s[8]), "v"(s[9]), "v"(s[10]), "v"(s[11]), "v"(s[12]), "v"(s[13]), "v"(s[14]), "v"(s[15]), "v"(m0), "v"(m1) : "vcc"); }
SEL_CGROUP(cnt_group_ge, "ge")
SEL_CGROUP(cnt_group_gt, "gt")
__device__ __forceinline__ void ballot_ge_to_lane(unsigned& wlo, unsigned& whi, float x, float tau, int ln) {
    unsigned keep;
    asm volatile("v_cmp_ge_f32 vcc, %3, %4\n\ts_mov_b32 %2, m0\n\ts_mov_b32 m0, %5\n\ts_nop 3\n\tv_writelane_b32 %0, vcc_lo, m0\n\tv_writelane_b32 %1, vcc_hi, m0\n\ts_mov_b32 m0, %2"
                 : "+v"(wlo), "+v"(whi), "=&s"(keep) : "v"(x), "v"(tau), "s"(ln) : "vcc");
}
__device__ __forceinline__ int half_sum_dpp(int v, int hf) {
    v += __builtin_amdgcn_update_dpp(0, v, 0x111, 0xf, 0xf, true);
    v += __builtin_amdgcn_update_dpp(0, v, 0x112, 0xf, 0xf, true);
    v += __builtin_amdgcn_update_dpp(0, v, 0x114, 0xf, 0xf, true);
    v += __builtin_amdgcn_update_dpp(0, v, 0x118, 0xf, 0xf, true);
    v += __builtin_amdgcn_update_dpp(0, v, 0x142, 0xa, 0xf, false);
    const int s0 = __builtin_amdgcn_readlane(v, 31), s1 = __builtin_amdgcn_readlane(v, 63);
    return hf ? s1 : s0;
}
__device__ __forceinline__ int crow(int R, int hf) { return (R & 3) + 8 * (R >> 2) + 4 * hf; }
__device__ __forceinline__ float half_swap_max(float v) { auto rr = __builtin_amdgcn_permlane32_swap(__float_as_uint(v), __float_as_uint(v), false, false); return fmaxf(__uint_as_float(rr[0]), __uint_as_float(rr[1])); }
__device__ __forceinline__ float half_swap_sum(float v) { auto rr = __builtin_amdgcn_permlane32_swap(__float_as_uint(v), __float_as_uint(v), false, false); return __uint_as_float(rr[0]) + __uint_as_float(rr[1]); }
__device__ __forceinline__ void rope8(const h16x8 x1, const h16x8 x2, const float* cs, int which, float scale, float (&o)[8]) {
    const f32x4 c0 = *(const GAS f32x4*)(cs), c1 = *(const GAS f32x4*)(cs + 4), s0 = *(const GAS f32x4*)(cs + 8), s1 = *(const GAS f32x4*)(cs + 12);
#pragma unroll
    for (int j = 0; j < 8; ++j) { const float c = j < 4 ? c0[j & 3] : c1[j & 3], s = j < 4 ? s0[j & 3] : s1[j & 3]; const float a = (float)x1[j], b = (float)x2[j];
        o[j] = (which == 0 ? (a * c - b * s) : (b * c + a * s)) * scale; }
}
__device__ __forceinline__ u32x4 pack8(const float (&v)[8]) { u32x4 w; w.x = pkh(v[0], v[1]); w.y = pkh(v[2], v[3]); w.z = pkh(v[4], v[5]); w.w = pkh(v[6], v[7]); return w; }

__device__ __forceinline__ void phaseB(const Frame& F, const In& I, int l) {
    unsigned char* ws = F.ws; asm volatile("" : "+s"(ws)); ws = (unsigned char*)(GAS unsigned char*)ws;     int lane = lane_id(), tid = F.wave * 64 + lane; asm volatile("" : "+v"(lane), "+v"(tid)); const int w = F.wave;
    const h16* MISC = (const h16*)(ws + WS_MISC); h16* KV = (h16*)(ws + WS_KV); h16* KI = (h16*)(ws + WS_KI); float* WI = (float*)(ws + WS_WI); const float* CS = (const float*)(ws + WS_CS);
    int blk = F.vcu; asm volatile("" : "+s"(blk));
#pragma unroll
    for (int it = 0; it < 2; ++it) {
        const int tok = blk * 64 + w * 8 + it * 4 + (lane >> 4), i = lane & 15;
        const h16* mr = MISC + (size_t)tok * 256; const float* cs = CS + (size_t)tok * 16;
        const h16x8 x = *(const GAS h16x8*)(mr + 8 * i);
        float ss = 0.f;
#pragma unroll
        for (int j = 0; j < 8; ++j) ss += (float)x[j] * (float)x[j];
        ss += __shfl_xor(ss, 1); ss += __shfl_xor(ss, 2); ss += __shfl_xor(ss, 4); ss += __shfl_xor(ss, 8);
        const float rs = rsqrtf(ss * (1.0f / 128.f) + EPS_RMS);
        { float o[8]; const float* kn = I.kv_norm + l * 128 + 8 * i;
#pragma unroll
          for (int j = 0; j < 8; ++j) o[j] = (float)x[j] * rs * kn[j];
          *(GAS u32x4*)(KV + (size_t)tok * KVP + 8 * i) = pack8(o); }
        if (i < 2) { float o[8]; rope8(*(const GAS h16x8*)(mr + 128), *(const GAS h16x8*)(mr + 136), cs, i, 1.0f, o); *(GAS u32x4*)(KV + (size_t)tok * KVP + 128 + 8 * i) = pack8(o); }
        else if (i == 2) { u32x2 z2 = {0u, 0u}; asm volatile("" : "+v"(z2)); *(GAS u32x2*)(KV + (size_t)tok * KVP + 144) = z2; *(GAS u32x2*)(KV + (size_t)tok * KVP + 148) = z2; }
        else if (i < 11) { const int ii = i - 3;
            if (ii < 2) { float o[8]; rope8(*(const GAS h16x8*)(mr + 144), *(const GAS h16x8*)(mr + 152), cs, ii, 1.0f, o); *(GAS u32x4*)(KI + (size_t)tok * 64 + 8 * ii) = pack8(o); }
            else *(GAS u32x4*)(KI + (size_t)tok * 64 + 8 * ii) = *(const GAS u32x4*)(mr + 144 + 8 * ii); }
        else if (i == 11) { const h16x8 wv = *(const GAS h16x8*)(mr + 208); const float sc = 0.35355339059327373f * 0.125f;
            *(GAS f32x4*)(WI + (size_t)tok * 8) = (f32x4){(float)wv[0] * sc, (float)wv[1] * sc, (float)wv[2] * sc, (float)wv[3] * sc};
            *(GAS f32x4*)(WI + (size_t)tok * 8 + 4) = (f32x4){(float)wv[4] * sc, (float)wv[5] * sc, (float)wv[6] * sc, (float)wv[7] * sc}; }
    }
    const int b = blk >> 5, chunk = (blk >> 1) & 15, gh = blk & 1;
    const size_t tok0 = (size_t)b * SEQ + chunk * 128;
    const h16* UV = (const h16*)(ws + WS_UV); h16* QY = (h16*)(ws + WS_QY);
    LAS unsigned char* VN = F.lds;
    constexpr int VPB = 576;
    { const int i16 = lane & 15, rq = lane >> 4; h16x8 v[4][4];
#pragma unroll
      for (int it = 0; it < 4; ++it)
#pragma unroll
          for (int i = 0; i < 4; ++i) v[it][i] = *(const GAS h16x8*)(UV + (tok0 + 16 * w + 4 * it + rq) * 1024 + 512 + 8 * i16 + 128 * (i & 1) + 256 * ((i >> 1) ^ gh));
      f32x4 lgv[2][2], lbv[2][2];
#pragma unroll
      for (int i = 0; i < 2; ++i) { const int col = 256 * gh + 128 * i + 8 * i16; const float* lg = I.ln_v_g + l * 512 + col; const float* lb = I.ln_v_b + l * 512 + col;
          lgv[i][0] = *(const f32x4*)lg; lgv[i][1] = *(const GAS f32x4*)(lg + 4); lbv[i][0] = *(const f32x4*)lb; lbv[i][1] = *(const GAS f32x4*)(lb + 4); }
#pragma unroll
      for (int it = 0; it < 4; ++it) { float s = 0.f, q = 0.f; float vg[4][8];
#pragma unroll
          for (int i = 0; i < 4; ++i)
#pragma unroll
              for (int j = 0; j < 8; ++j) { const float x = gelu_tanh_f((float)v[it][i][j]); vg[i][j] = x; s += x; q = fmaf(x, x, q); }
          s += __shfl_xor(s, 1); q += __shfl_xor(q, 1); s += __shfl_xor(s, 2); q += __shfl_xor(q, 2); s += __shfl_xor(s, 4); q += __shfl_xor(q, 4); s += __shfl_xor(s, 8); q += __shfl_xor(q, 8);
          const float mu = s * (1.0f / 512.f), var = fmaxf(q * (1.0f / 512.f) - mu * mu, 0.f), rs = rsqrtf(var + 1e-5f);
          const int t = 16 * w + 4 * it + rq;
#pragma unroll
          for (int i = 0; i < 2; ++i) { float o[8];
#pragma unroll
              for (int j = 0; j < 8; ++j) o[j] = (vg[i][j] - mu) * rs * lgv[i][j >> 2][j & 3] + lbv[i][j >> 2][j & 3];
              *(LAS u32x4*)(VN + t * VPB + (128 * i + 8 * i16) * 2) = pack8(o); } } }
    asm volatile("" ::: "memory");
    { const int gp = w & 3, g = 4 * gh + gp, rh = w >> 2, r = lane & 31, hf = lane >> 5;
      const h16* WS16 = (const h16*)(ws + WS_SMALLW + (size_t)l * SMALLW_LAYER + 98304 + 131072) + (size_t)g * 128 * 128;
      const int troff = (8 * hf + ((lane & 15) >> 2)) * VPB + (gp * 64 + 16 * ((lane >> 4) & 1) + 4 * (lane & 3)) * 2;
      h16x8 wf[2][8];
#pragma unroll
      for (int tb = 0; tb < 2; ++tb)
#pragma unroll
          for (int s = 0; s < 8; ++s) wf[tb][s] = *(const GAS h16x8*)(WS16 + (size_t)(64 * rh + 32 * tb + r) * 128 + 16 * s + 8 * hf);
      float bsv[2]; u32x2 uu[2][2][4];
#pragma unroll
      for (int tb = 0; tb < 2; ++tb) { const int t = 64 * rh + 32 * tb + r; bsv[tb] = I.b_s[((size_t)l * 8 + g) * 128 + t];
#pragma unroll
          for (int db = 0; db < 2; ++db)
#pragma unroll
              for (int gg = 0; gg < 4; ++gg) uu[tb][db][gg] = *(const GAS u32x2*)(UV + (tok0 + t) * 1024 + g * 64 + 32 * db + 8 * gg + 4 * hf); }
      LDS_WAIT(); __syncthreads();
#pragma unroll
      for (int tb = 0; tb < 2; ++tb) { const int nks = 4 * rh + 2 * tb + 2; const size_t tk = tok0 + 64 * rh + 32 * tb + r;
#pragma unroll
        for (int db = 0; db < 2; ++db) { f32x16 D = {};
#pragma unroll
            for (int s = 0; s < 8; ++s) if (s < nks) {
                const v4i16_t lo = __builtin_amdgcn_ds_read_tr16_b64_v4i16((LAS v4i16_t*)(VN + troff + (16 * s) * VPB + 64 * db));
                const v4i16_t hi = __builtin_amdgcn_ds_read_tr16_b64_v4i16((LAS v4i16_t*)(VN + troff + (16 * s + 4) * VPB + 64 * db));
                typedef short s16x8 __attribute__((ext_vector_type(8)));
                const s16x8 av = {lo[0], lo[1], lo[2], lo[3], hi[0], hi[1], hi[2], hi[3]};
                D = __builtin_amdgcn_mfma_f32_32x32x16_f16(__builtin_bit_cast(h16x8, av), wf[tb][s], D, 0, 0, 0); }
#pragma unroll
            for (int gg = 0; gg < 4; ++gg) { const u32x2 uv2 = uu[tb][db][gg]; const float bb = bsv[tb];
                const float y0 = gelu_tanh_f(h2f_lo(uv2.x)) * (D[4 * gg] + bb), y1 = gelu_tanh_f(h2f_hi(uv2.x)) * (D[4 * gg + 1] + bb), y2 = gelu_tanh_f(h2f_lo(uv2.y)) * (D[4 * gg + 2] + bb), y3 = gelu_tanh_f(h2f_hi(uv2.y)) * (D[4 * gg + 3] + bb);
                *(GAS u32x2*)(QY + tk * 1024 + 512 + g * 64 + 32 * db + 8 * gg + 4 * hf) = (u32x2){pkh(y0, y1), pkh(y2, y3)}; } } } }
    __syncthreads();
}

constexpr int C_KIB = 0, C_KIBUF = 256 * 128;
constexpr int C_QL = 0, C_QLW = KVP * 2 * 32;
constexpr int C_WQ = 81920;
constexpr int C_KVS = 90112, C_KVSLOT = 10240;

__device__ __forceinline__ void phaseC_select(const Frame& F, int l, int b, int qt) {
    unsigned char* ws = F.ws; asm volatile("" : "+s"(ws)); ws = (unsigned char*)(GAS unsigned char*)ws;     int lane = lane_id(), tid = F.wave * 64 + lane; asm volatile("" : "+v"(lane), "+v"(tid)); const int w = F.wave, r = lane & 31, hf = lane >> 5;
    const h16* QI = (const h16*)(ws + WS_QI); const h16* KI = (const h16*)(ws + WS_KI); const float* WI = (const float*)(ws + WS_WI); const float* CS = (const float*)(ws + WS_CS);
    h16* QY = (h16*)(ws + WS_QY); const h16* KV = (const h16*)(ws + WS_KV);
    const h16* WUKT = (const h16*)(ws + WS_SMALLW + (size_t)l * SMALLW_LAYER); const h16* WUVT = (const h16*)(ws + WS_SMALLW + (size_t)l * SMALLW_LAYER + 98304);
    LAS unsigned char* lds = F.lds;
    const int t0 = 32 * qt, NT = qt + 1; const size_t tokbase = (size_t)b * SEQ;
    h16x8 afr[4]; float wreg[16];
    { const int qq = 2 * ((r >> 2) & 1) + (r >> 4), head = (r & 3) + 4 * ((r >> 3) & 1); const size_t tokA = tokbase + t0 + 4 * w + qq;
      const h16* qsrc = QI + tokA * 512 + head * 64;
      { float o[8]; rope8(*(const GAS h16x8*)(qsrc), *(const GAS h16x8*)(qsrc + 8), CS + tokA * 16, hf, 1.0f, o); afr[0] = __builtin_bit_cast(h16x8, pack8(o)); }
#pragma unroll
      for (int s = 1; s < 4; ++s) afr[s] = *(const GAS h16x8*)(qsrc + 16 * s + 8 * hf);
      const float* wp = WI + (tokbase + t0 + 4 * w + 2 * hf) * 8;
#pragma unroll
      for (int R4 = 0; R4 < 4; ++R4) { const f32x4 wv = *(const GAS f32x4*)(wp + 4 * R4); wreg[4 * R4] = wv.x; wreg[4 * R4 + 1] = wv.y; wreg[4 * R4 + 2] = wv.z; wreg[4 * R4 + 3] = wv.w; } }
    float SC[128];
    const float QNAN = __uint_as_float(0x7fc00000u);
#pragma unroll
    for (int i = 0; i < 128; ++i) SC[i] = QNAN;
    const int NCK = (NT + 7) >> 3, tq0 = t0 + 4 * w + 2 * hf;
    const int drow = lane >> 3, dslot = lane & 7;
    const h16* kisrc = KI + (tokbase + 32 * w + drow) * 64 + 8 * (dslot ^ drow);
#define KI_STAGE(ck_, buf_) do { _Pragma("unroll") for (int i_ = 0; i_ < 4; ++i_) \
        __builtin_amdgcn_global_load_lds((const unsigned*)(kisrc + (size_t)(256 * (ck_) + 8 * i_) * 64), (LAS unsigned*)(lds + C_KIB + (buf_) * C_KIBUF + (4 * w + i_) * 1024), 16, 0, 0); } while (0)
    KI_STAGE(0, 0);
    VM_WAIT(); __syncthreads();
    const int kroff = r * 128, kx = r & 7;
#pragma unroll 1
    for (int ck = 0; ck < NCK; ++ck) {
        LAS unsigned char* kb = lds + C_KIB + (ck & 1) * C_KIBUF;
        if (ck + 1 < NCK) KI_STAGE(ck + 1, (ck + 1) & 1);
#pragma unroll
        for (int i = 0; i < 112; ++i) SC[i] = SC[i + 16];
#pragma unroll
        for (int jj = 0; jj < 8; ++jj) {
            f32x16 D = {};
#pragma unroll
            for (int s = 0; s < 4; ++s) { const h16x8 bb = *(const LAS h16x8*)(kb + jj * 4096 + kroff + 16 * ((2 * s + hf) ^ kx)); D = __builtin_amdgcn_mfma_f32_32x32x16_f16(afr[s], bb, D, 0, 0, 0); }
            float s0 = 0.f, s1 = 0.f;
#pragma unroll
            for (int R = 0; R < 8; ++R) { s0 = fmaf(wreg[R], fmaxf(D[R], 0.f), s0); s1 = fmaf(wreg[8 + R], fmaxf(D[8 + R], 0.f), s1); }
            const int k = 256 * ck + 32 * jj + r;
            SC[112 + 2 * jj] = (k > tq0) ? QNAN : s0; SC[113 + 2 * jj] = (k > tq0 + 1) ? QNAN : s1;
        }
        LDS_WAIT(); VM_WAIT(); __syncthreads();
    }
#undef KI_STAGE
    const int G0 = 8 - NCK;
#define SEL_COUNT2(c0, c1, FN, m0, m1) do { int a0_ = 0, a1_ = 0; \
        _Pragma("unroll") for (int g = 0; g < 8; ++g) if (g >= G0) FN(a0_, a1_, &SC[16 * g], (m0), (m1)); \
        c0 = half_sum_dpp(a0_, hf); c1 = half_sum_dpp(a1_, hf); } while (0)
    float tau0 = -3.0e38f, tau1 = -3.0e38f;
    if (qt >= 8) {
        float lo0 = INFINITY, lo1 = INFINITY, hi0 = -INFINITY, hi1 = -INFINITY;
#pragma unroll
        for (int j = 0; j < 64; ++j) { const float a = SC[2 * j], c = SC[2 * j + 1]; lo0 = fminf(lo0, a); hi0 = fmaxf(hi0, a); lo1 = fminf(lo1, c); hi1 = fmaxf(hi1, c); }
#pragma unroll
        for (int o = 1; o < 32; o <<= 1) { lo0 = fminf(lo0, __shfl_xor(lo0, o)); lo1 = fminf(lo1, __shfl_xor(lo1, o)); hi0 = fmaxf(hi0, __shfl_xor(hi0, o)); hi1 = fmaxf(hi1, __shfl_xor(hi1, o)); }
        float cl0 = (float)(tq0 + 1), cl1 = (float)(tq0 + 2), ch0 = 1.f, ch1 = 1.f;
        bool done0 = false, done1 = false;
        { int g0, g1, e0, e1; const float zero = 0.f; SEL_COUNT2(g0, g1, cnt_group_gt, zero, zero); SEL_COUNT2(e0, e1, cnt_group_ge, zero, zero);
          const float tiny = __uint_as_float(1u);
          if (g0 >= 256) { lo0 = 0.f; cl0 = (float)g0; if (g0 == 256) { lo0 = tiny; done0 = true; } } else if (e0 >= 256) { lo0 = 0.f; done0 = true; } else { hi0 = 0.f; ch0 = (float)e0; }
          if (g1 >= 256) { lo1 = 0.f; cl1 = (float)g1; if (g1 == 256) { lo1 = tiny; done1 = true; } } else if (e1 >= 256) { lo1 = 0.f; done1 = true; } else { hi1 = 0.f; ch1 = (float)e1; } }
#pragma unroll 1
        for (int it = 0; it < 30; ++it) {
            const float bis0 = 0.5f * (lo0 + hi0), bis1 = 0.5f * (lo1 + hi1);
            if (!done0 && (bis0 <= lo0 || bis0 >= hi0)) done0 = true;
            if (!done1 && (bis1 <= lo1 || bis1 >= hi1)) done1 = true;
            if (__all(done0 && done1)) break;
            float mid0 = bis0, mid1 = bis1;
            if ((it % 3) != 2) { const float i0 = lo0 + (cl0 - 255.5f) / (cl0 - ch0) * (hi0 - lo0), i1 = lo1 + (cl1 - 255.5f) / (cl1 - ch1) * (hi1 - lo1);
                if (cl0 - ch0 <= 48.f && i0 > lo0 && i0 < hi0) mid0 = i0; if (cl1 - ch1 <= 48.f && i1 > lo1 && i1 < hi1) mid1 = i1; }
            int c0, c1; SEL_COUNT2(c0, c1, cnt_group_ge, mid0, mid1);
            if (!done0) { if (c0 >= 256) { lo0 = mid0; cl0 = (float)c0; if (c0 == 256) done0 = true; } else { hi0 = mid0; ch0 = (float)c0; } }
            if (!done1) { if (c1 >= 256) { lo1 = mid1; cl1 = (float)c1; if (c1 == 256) done1 = true; } else { hi1 = mid1; ch1 = (float)c1; } }
        }
        tau0 = lo0; tau1 = lo1;
    }
#undef SEL_COUNT2
    unsigned w00 = 0u, w01 = 0u, w10 = 0u, w11 = 0u;
#pragma unroll
    for (int g = 0; g < 8; ++g) if (g >= G0) {
#pragma unroll
        for (int jj = 0; jj < 8; ++jj) { const int j = 8 * g + jj, jt = 8 * (g - G0) + jj;
            ballot_ge_to_lane(w00, w10, SC[2 * j], tau0, jt); ballot_ge_to_lane(w01, w11, SC[2 * j + 1], tau1, jt); } }
    { LAS unsigned* WQ = (LAS unsigned*)(lds + C_WQ);
      WQ[(4 * w + 0) * 64 + lane] = w00; WQ[(4 * w + 1) * 64 + lane] = w01; WQ[(4 * w + 2) * 64 + lane] = w10; WQ[(4 * w + 3) * 64 + lane] = w11; }
    LDS_WAIT(); __syncthreads();
}

__device__ __forceinline__ void phaseC_attn(const Frame& F, int l, int b, int qt, bool do_store = true, int pmode = 0) {
    unsigned char* ws = F.ws; asm volatile("" : "+s"(ws)); ws = (unsigned char*)(GAS unsigned char*)ws;     const int w = F.wave;
    int lane = lane_id(), tid = F.wave * 64 + lane; asm volatile("" : "+v"(lane), "+v"(tid));
    const int r = lane & 31, hf = lane >> 5;
    const float* CS = (const float*)(ws + WS_CS);
    h16* QY = (h16*)(ws + WS_QY); const h16* KV = (const h16*)(ws + WS_KV);
    const h16* WUKT = (const h16*)(ws + WS_SMALLW + (size_t)l * SMALLW_LAYER); const h16* WUVT = (const h16*)(ws + WS_SMALLW + (size_t)l * SMALLW_LAYER + 98304);
    LAS unsigned char* lds = F.lds;
    const int t0 = 32 * qt, NT = qt + 1; const size_t tokbase = (size_t)b * SEQ;
    const int h = w; const size_t tokQ = tokbase + t0 + r;
    LAS h16* ql = (LAS h16*)(lds + C_QL + w * C_QLW);
    if (!(pmode & 64)) { h16x8 bq[3];
#pragma unroll
      for (int s = 0; s < 3; ++s) bq[s] = *(const GAS h16x8*)(QY + tokQ * 1024 + h * 64 + 16 + 16 * s + 8 * hf);
#pragma unroll
      for (int cb = 0; cb < 4; ++cb) { f32x16 D = {};
#pragma unroll
          for (int s = 0; s < 3; ++s) { const h16x8 a = *(const GAS h16x8*)(WUKT + ((size_t)(h * 128 + 32 * cb + r)) * 48 + 16 * s + 8 * hf); D = __builtin_amdgcn_mfma_f32_32x32x16_f16(a, bq[s], D, 0, 0, 0); }
#pragma unroll
          for (int g = 0; g < 4; ++g) { const int c = 32 * cb + 8 * g + 4 * hf;
              *(LAS u32x2*)(ql + r * KVP + c) = (u32x2){pkh(D[4 * g] * QSCALE, D[4 * g + 1] * QSCALE), pkh(D[4 * g + 2] * QSCALE, D[4 * g + 3] * QSCALE)}; } }
      { float o[8]; rope8(*(const GAS h16x8*)(QY + tokQ * 1024 + h * 64), *(const GAS h16x8*)(QY + tokQ * 1024 + h * 64 + 8), CS + tokQ * 16, hf, QSCALE, o); *(LAS u32x4*)(ql + r * KVP + 128 + 8 * hf) = pack8(o); } }
    LDS_WAIT();
    h16x8 qfr[9];
#pragma unroll
    for (int s = 0; s < 9; ++s) qfr[s] = *(const LAS h16x8*)(ql + r * KVP + 16 * s + 8 * hf);
    const char* kvsrc = (const char*)(KV + tokbase * KVP) + (size_t)(64 * w + lane) * 16;
    const unsigned kvdst = (unsigned)(uintptr_t)(lds + C_KVS) + (unsigned)w * 1024u;
    const int grp = w >> 2;
#define KV_DMA1(src_, dst_) do { unsigned keep_; asm volatile("s_mov_b32 %0, m0\n\ts_mov_b32 m0, %2\n\ts_nop 0\n\tglobal_load_lds_dwordx4 %1, off\n\ts_mov_b32 m0, %0" : "=&s"(keep_) : "v"(src_), "s"(dst_) : "memory"); } while (0)
#define KV_DMA(t_) do { const char* s_ = kvsrc + (size_t)(t_) * (32 * KVP * 2); const unsigned d_ = (unsigned)__builtin_amdgcn_readfirstlane((int)(kvdst + (unsigned)((t_) % 5) * (unsigned)C_KVSLOT)); \
        KV_DMA1(s_, d_); if (w < 2) { const char* s2_ = s_ + 8192; const unsigned d2_ = d_ + 8192u; KV_DMA1(s2_, d2_); } } while (0)
#define KV_WAIT(n_) do { if ((n_) <= 0) asm volatile("s_waitcnt vmcnt(0)" ::: "memory"); else if ((n_) == 1) { if (w < 2) asm volatile("s_waitcnt vmcnt(2)" ::: "memory"); else asm volatile("s_waitcnt vmcnt(1)" ::: "memory"); } \
        else { if (w < 2) asm volatile("s_waitcnt vmcnt(4)" ::: "memory"); else asm volatile("s_waitcnt vmcnt(2)" ::: "memory"); } } while (0)
    KV_DMA(0); if (NT > 1) KV_DMA(1); if (NT > 2) KV_DMA(2); if (NT > 3) KV_DMA(3);
    KV_WAIT(NT > 3 ? 2 : (NT > 2 ? 1 : 0));
    asm volatile("s_waitcnt lgkmcnt(0)" ::: "memory"); __builtin_amdgcn_s_barrier(); asm volatile("" ::: "memory");
    float mrun = 0.f, lrun = 0.f; f32x16 O[4]; f32x16 negm;
#pragma unroll
    for (int db = 0; db < 4; ++db) O[db] = (f32x16){};
#pragma unroll
    for (int R = 0; R < 16; ++R) negm[R] = 0.f;
    const LAS unsigned* WQr = (const LAS unsigned*)(lds + C_WQ) + r * 64;
    const int troff = ((lane & 15) >> 2) * (KVP * 2) + (16 * ((lane >> 4) & 1) + 4 * (lane & 3)) * 2 + 4 * hf * (KVP * 2);
    const int kbase = (int)(uintptr_t)(lds + C_KVS) + r * (KVP * 2) + 16 * hf, vbase = (int)(uintptr_t)(lds + C_KVS) + troff;
    typedef short s16x8 __attribute__((ext_vector_type(8)));
#define AT_MAX3(a_, b_, c_) ({ float r_; asm("v_max3_f32 %0, %1, %2, %3" : "=v"(r_) : "v"(a_), "v"(b_), "v"(c_)); r_; })
#define AT_MASKED(e_, w_, pos_) ({ int t_, r_; asm("v_bfe_i32 %0, %2, %3, 1\n\tv_and_b32 %1, %4, %0" : "=&v"(t_), "=v"(r_) : "v"(w_), "n"(pos_), "v"(e_)); __int_as_float(r_); })
#define AT_KLOAD(so_) h16x8 kfr[9]; do { const LAS unsigned char* sl_ = (const LAS unsigned char*)(uintptr_t)(kbase + (so_)); \
        if (!(pmode & 16)) { _Pragma("unroll") for (int s = 0; s < 9; ++s) kfr[s] = *(const LAS h16x8*)(sl_ + 32 * s); } else { _Pragma("unroll") for (int s = 0; s < 9; ++s) kfr[s] = qfr[s]; } __builtin_amdgcn_sched_barrier(0); } while (0)
#define AT_QK(S_) do { S_ = negm; if (!(pmode & 16)) { _Pragma("unroll") for (int s = 0; s < 9; ++s) S_ = __builtin_amdgcn_mfma_f32_32x32x16_f16(kfr[s], qfr[s], S_, 0, 0, 0); } } while (0)
#define AT_VLOAD(db0_) do { _Pragma("unroll") for (int db = 0; db < 2; ++db) _Pragma("unroll") for (int sp = 0; sp < 2; ++sp) { \
            vlo_[db][sp] = __builtin_amdgcn_ds_read_tr16_b64_v4i16((LAS v4i16_t*)(sl_ + (16 * sp) * (KVP * 2) + 64 * ((db0_) + db))); \
            vhi_[db][sp] = __builtin_amdgcn_ds_read_tr16_b64_v4i16((LAS v4i16_t*)(sl_ + (16 * sp + 8) * (KVP * 2) + 64 * ((db0_) + db))); } } while (0)
#define AT_PV2(db0_) do { _Pragma("unroll") for (int db = 0; db < 2; ++db) _Pragma("unroll") for (int sp = 0; sp < 2; ++sp) { \
            const s16x8 av_ = {vlo_[db][sp][0], vlo_[db][sp][1], vlo_[db][sp][2], vlo_[db][sp][3], vhi_[db][sp][0], vhi_[db][sp][1], vhi_[db][sp][2], vhi_[db][sp][3]}; \
            O[(db0_) + db] = __builtin_amdgcn_mfma_f32_32x32x16_f16(__builtin_bit_cast(h16x8, av_), pf_[sp], O[(db0_) + db], 0, 0, 0); } } while (0)
#define AT_SMPV(S_, t_, so_) do { const LAS unsigned char* sl_ = (const LAS unsigned char*)(uintptr_t)(vbase + (so_)); \
        v4i16_t vlo_[2][2], vhi_[2][2]; \
        AT_VLOAD(0); \
        const int wq_ = (int)(WQr[(t_)] >> (4 * hf)); \
        __builtin_amdgcn_sched_barrier(0); \
        float mt_ = AT_MAX3(S_[0], S_[1], S_[2]); \
        _Pragma("unroll") for (int R = 3; R < 15; R += 2) mt_ = AT_MAX3(mt_, S_[R], S_[R + 1]); \
        mt_ = half_swap_max(AT_MAX3(mt_, S_[15], S_[15])); \
        if ((t_) == 0 || __any(mt_ > 8.0f)) { const float dl_ = (t_) == 0 ? mt_ : fmaxf(mt_, 0.f), alpha_ = (t_) == 0 ? 1.f : __builtin_amdgcn_exp2f(-dl_);     \
            _Pragma("unroll") for (int db = 0; db < 4; ++db) O[db] = O[db] * alpha_; \
            _Pragma("unroll") for (int R = 0; R < 16; ++R) S_[R] -= dl_; \
            lrun *= alpha_; mrun += dl_; \
            _Pragma("unroll") for (int R = 0; R < 16; ++R) negm[R] = -mrun; } \
        float p_[16]; \
        if (!(pmode & 1)) { _Pragma("unroll") for (int R = 0; R < 16; ++R) { const float e_ = __builtin_amdgcn_exp2f(S_[R]); p_[R] = AT_MASKED(e_, wq_, (R & 3) + 8 * (R >> 2)); lrun += p_[R]; } } \
        else { _Pragma("unroll") for (int R = 0; R < 16; ++R) p_[R] = S_[R]; lrun += p_[0]; } \
        h16x8 pf_[2]; \
        _Pragma("unroll") for (int sp = 0; sp < 2; ++sp) { u32x4 t4_; t4_.x = pkz(p_[8 * sp], p_[8 * sp + 1]); t4_.y = pkz(p_[8 * sp + 2], p_[8 * sp + 3]); t4_.z = pkz(p_[8 * sp + 4], p_[8 * sp + 5]); t4_.w = pkz(p_[8 * sp + 6], p_[8 * sp + 7]); pf_[sp] = __builtin_bit_cast(h16x8, t4_); } \
        __builtin_amdgcn_sched_barrier(0); \
        if (!(pmode & 2)) { AT_PV2(0); \
        __builtin_amdgcn_sched_barrier(0); \
        AT_VLOAD(2); \
        __builtin_amdgcn_sched_barrier(0); \
        AT_PV2(2); } else { O[0][0] += (float)pf_[0][0] + (float)pf_[1][0]; } } while (0)
#define AT_BOUNDARY(b_) do {   \
        if (!(pmode & 4)) { KV_WAIT(((b_) + 3 < NT) ? 1 : 0); \
        asm volatile("s_waitcnt lgkmcnt(0)" ::: "memory"); __builtin_amdgcn_s_barrier(); asm volatile("" ::: "memory"); \
        if ((b_) + 4 < NT) KV_DMA((b_) + 4); } } while (0)
#define AT_NEXT(so_) ((so_) == 4 * C_KVSLOT ? 0 : (so_) + C_KVSLOT)
    if (grp == 0) {
        int so = 0;
#pragma unroll 1
        for (int t = 0; t < NT; ++t) { f32x16 Sx; AT_KLOAD(so); AT_QK(Sx); __builtin_amdgcn_sched_barrier(0); AT_SMPV(Sx, t, so); AT_BOUNDARY(t); so = AT_NEXT(so); }
    } else {
        f32x16 Sx; int so = 0, sop = 0; { AT_KLOAD(so); AT_QK(Sx); } AT_BOUNDARY(0);
#pragma unroll 1
        for (int t = 1; t < NT; ++t) { sop = so; so = AT_NEXT(so); AT_SMPV(Sx, t - 1, sop); __builtin_amdgcn_sched_barrier(0); AT_KLOAD(so); AT_QK(Sx); AT_BOUNDARY(t); }
        AT_SMPV(Sx, NT - 1, so);
    }
#undef AT_NEXT
#undef AT_MAX3
#undef AT_MASKED
#undef AT_BOUNDARY
#undef KV_DMA
#undef KV_DMA1
#undef KV_WAIT
#undef AT_KLOAD
#undef AT_QK
#undef AT_SMPV
#undef AT_VLOAD
#undef AT_PV2
    if (!(pmode & 32)) {
    { const float inv = 1.0f / half_swap_sum(lrun);
#pragma unroll
      for (int db = 0; db < 4; ++db)
#pragma unroll
          for (int g = 0; g < 4; ++g) { const int c = 32 * db + 8 * g + 4 * hf;
              *(LAS u32x2*)(ql + r * KVP + c) = (u32x2){pkh(O[db][4 * g] * inv, O[db][4 * g + 1] * inv), pkh(O[db][4 * g + 2] * inv, O[db][4 * g + 3] * inv)}; } }
    LDS_WAIT();
    { h16x8 ao[8];
#pragma unroll
      for (int s = 0; s < 8; ++s) ao[s] = *(const LAS h16x8*)(ql + r * KVP + 16 * s + 8 * hf);
#pragma unroll
      for (int d2 = 0; d2 < 2; ++d2) { f32x16 D = {};
#pragma unroll
          for (int s = 0; s < 8; ++s) { const h16x8 bw = *(const GAS h16x8*)(WUVT + ((size_t)(h * 64 + 32 * d2 + r)) * 128 + 16 * s + 8 * hf); D = __builtin_amdgcn_mfma_f32_32x32x16_f16(ao[s], bw, D, 0, 0, 0); }
#pragma unroll
          for (int R = 0; R < 16; ++R) { if (do_store) ((GAS h16*)QY)[(tokbase + t0 + crow(R, hf)) * 1024 + h * 64 + 32 * d2 + r] = (h16)D[R]; else asm volatile("" :: "v"(D[R])); } } }
    } else { asm volatile("" :: "v"(O[0][0]), "v"(O[1][0]), "v"(O[2][0]), "v"(O[3][0]), "v"(lrun)); }
    LDS_WAIT(); __syncthreads();
}

__device__ __forceinline__ void phaseC(const Frame& F, int l) {
    int vc = F.vcu; asm volatile("" : "+s"(vc)); const int b = vc >> 5, i = vc & 31;
#pragma unroll 1
    for (int u = 0; u < 2; ++u) { const int qt = (u == 0) ? 63 - i : i;
#if defined(PROBE_C_SEL)
#pragma unroll 1
        for (int rep = 0; rep < 2; ++rep)
#endif
        phaseC_select(F, l, b, qt);
#if defined(PROBE_C_ATT)
#pragma unroll 1
        for (int rep = 0; rep < 2; ++rep) phaseC_attn(F, l, b, qt, rep == 1, rep == 1 ? 0 : PROBE_C_ATT);
#else
        phaseC_attn(F, l, b, qt);
#endif
    }
}
#if defined(PROBE_STORE)
#define PROBE_NOSTORE(f) (f)
#else
#define PROBE_NOSTORE(f) 0
#endif
#if defined(PROBE_EPI)
#define PROBE_NOEPI(f) (f)
#else
#define PROBE_NOEPI(f) 0
#endif
#ifndef PROBE_MASK
#define PROBE_MASK 0u
#endif
#ifndef MK_N_LAUNCHES
#define MK_N_LAUNCHES 1
#endif
constexpr int N_PHASES = 2 + 7 * NLAYER;
constexpr int CONV_SPLIT = 2150;
struct Args { In in; float* out; unsigned char* ws; int ph_lo, ph_hi, flags, pad; };

__global__ void __launch_bounds__(NTHREADS, 2) mk_fwd(Args args) {
    extern __shared__ __attribute__((aligned(16))) unsigned char lds_raw[];
    Frame F; F.lds = (LAS unsigned char*)lds_raw; F.wave = __builtin_amdgcn_readfirstlane((int)threadIdx.x >> 6);
    F.G = gridDim.x; { const int bx = blockIdx.x; F.vcu = (F.G % 8 == 0) ? (bx % 8) * (F.G / 8) + bx / 8 : bx; }
    F.ws = args.ws; F.in = nullptr;
    const In& I = args.in; unsigned char* ws = args.ws; (void)ws;
    volatile LAS unsigned* MISCW = (volatile LAS unsigned*)(F.lds + LDS_MISC);
    if (F.wave == 0) MISCW[lane_id()] = 0u;
    __syncthreads();
#if MK_N_LAUNCHES == 1
    const bool one_launch = true;
#else
    const bool one_launch = (args.ph_hi - args.ph_lo) > 1;
#endif
    XcdBarrier bar; bar.bar = (unsigned*)(ws + WS_CTL) + 1024; bar.x = 0; bar.st = nullptr;
    if (one_launch) bar = xcd_barrier_post((unsigned*)(ws + WS_CTL) + 1024, MISCW + 8, F.wave);
#if MK_N_LAUNCHES == 1
#define IN(k) true
#define SEAM(k) xcd_barrier(bar, F.wave)
#else
#define IN(k) (args.ph_lo <= (k) && (k) < args.ph_hi)
#define SEAM(k) do { if (IN(k) && IN((k) + 1)) xcd_barrier(bar, F.wave); } while (0)
#endif
    if (IN(0)) { p0_prologue(F, I); SEAM(0); }
#define OPQ(x) asm volatile("" : "+s"(x))
#pragma unroll 1
    for (int l0 = 0; l0 < NLAYER; ++l0) {
        const int p = 1 + 7 * l0;
        if (IN(p)) {
            unsigned char* wsq = args.ws; int l = l0; OPQ(wsq); OPQ(l); wsq = (unsigned char*)(GAS unsigned char*)wsq; unsigned char* wl = wsq + WS_W + (size_t)l * W_LAYER;
            pg8::Gemm g{(const h16*)(wsq + WS_X16), (const h16*)(wl + W_OFF_IN), 1024, 1024, 1024, M / 256, NZ / 256, 1, 0, PROBE_NOEPI(args.flags), 0};
            pg8::Order S; S.init(g.nM, g.nN, F.G, (int)blockIdx.x, 1); EpiA E{wsq, PROBE_NOSTORE(args.flags), (LAS float*)(F.lds + 131072 + 4096)};
            pg8::gemm_phase<EpiA>(F.lds, g, S, E, F.wave);
            { constexpr int NBIG = ((M / 256) * (NZ / 256)) % 256;
              if (l + 1 < NLAYER && (int)blockIdx.x >= NBIG && F.G == 256) convert_layer_weights(F, I, l + 1, ((int)blockIdx.x - NBIG) * NWAVES + F.wave, (256 - NBIG) * NWAVES, 0, CONV_SPLIT);
              else if (l + 1 < NLAYER && F.G != 256) { xcd_barrier(bar, F.wave); convert_layer_weights(F, I, l + 1, F.vcu * NWAVES + F.wave, F.G * NWAVES); } }
            SEAM(p); }
        if (IN(p + 1)) { int l = l0; OPQ(l); phaseB(F, I, l); SEAM(p + 1); }
        if (IN(p + 2)) { int l = l0; OPQ(l); phaseC(F, l); SEAM(p + 2); }
        if (IN(p + 3)) {
            unsigned char* wsq = args.ws; int l = l0; OPQ(wsq); OPQ(l); wsq = (unsigned char*)(GAS unsigned char*)wsq; unsigned char* wl = wsq + WS_W + (size_t)l * W_LAYER;
            pg8::Gemm g{(const h16*)(wsq + WS_QY), (const h16*)(wl + W_OFF_PAB), 1024, 1024, 512, M / 256, 4, 2, 512, PROBE_NOEPI(args.flags), 0};
            pg8::Order S; S.init(g.nM, g.nN, F.G, (int)blockIdx.x, 2); EpiD E{wsq, (h16*)args.out};
            pg8::gemm_phase<EpiD>(F.lds, g, S, E, F.wave); SEAM(p + 3); }
        if (IN(p + 4)) {
            unsigned char* wsq = args.ws; int l = l0; OPQ(wsq); OPQ(l); wsq = (unsigned char*)(GAS unsigned char*)wsq; unsigned char* wl = wsq + WS_W + (size_t)l * W_LAYER;
            pg8::Gemm g{(const h16*)args.out, (const h16*)(wl + W_OFF_OUT), 1024, 1024, 1024, M / 256, 4, 1, 0, PROBE_NOEPI(args.flags), 0};
            pg8::Order S; S.init(g.nM, g.nN, F.G, (int)blockIdx.x, 1);
            EpiRes E{(const h16*)(wsq + WS_X16), (h16*)(wsq + WS_X1), (float*)(wsq + WS_SSQ), (LAS float*)(F.lds + 131072)};
            pg8::gemm_phase<EpiRes>(F.lds, g, S, E, F.wave); SEAM(p + 4); }
        if (IN(p + 5)) {
            unsigned char* wsq = args.ws; int l = l0; OPQ(wsq); OPQ(l); wsq = (unsigned char*)(GAS unsigned char*)wsq; unsigned char* wl = wsq + WS_W + (size_t)l * W_LAYER;
            pg8::Gemm g{(const h16*)(wsq + WS_X1), (const h16*)(wl + W_OFF_GU), 1024, 1024, 1024, M / 256, NGU / 256, 1, 0, PROBE_NOEPI(args.flags), 0};
            pg8::Order S; S.init(g.nM, g.nN, F.G, (int)blockIdx.x, 1); EpiF E{wsq, (LAS float*)(F.lds + 131072 + 4096)};
            pg8::gemm_phase<EpiF>(F.lds, g, S, E, F.wave);
            { constexpr int NBIG = ((M / 256) * (NGU / 256)) % 256;
              if (l + 1 < NLAYER && (int)blockIdx.x >= NBIG && F.G == 256) convert_layer_weights(F, I, l + 1, ((int)blockIdx.x - NBIG) * NWAVES + F.wave, (256 - NBIG) * NWAVES, CONV_SPLIT, 1 << 30); }
            SEAM(p + 5); }
        if (IN(p + 6)) {
            unsigned char* wsq = args.ws; int l = l0; OPQ(wsq); OPQ(l); wsq = (unsigned char*)(GAS unsigned char*)wsq; unsigned char* wl = wsq + WS_W + (size_t)l * W_LAYER;
            pg8::Gemm g{(const h16*)(wsq + WS_ACT), (const h16*)(wl + W_OFF_D), DFF, DFF, DFF, M / 256, 4, 1, 0, PROBE_NOEPI(args.flags), 0};
            pg8::Order S; S.init(g.nM, g.nN, F.G, (int)blockIdx.x, 1);
            EpiRes E{(const h16*)(wsq + WS_X1), (h16*)(wsq + WS_X16), (float*)(wsq + WS_SSQ), (LAS float*)(F.lds + 131072)};
            pg8::gemm_phase<EpiRes>(F.lds, g, S, E, F.wave); SEAM(p + 6); }
    }
    if (IN(N_PHASES - 1)) final_norm_phase(F, (const h16*)(args.ws + WS_X16), args.out, I.final_norm);
#undef IN
#undef SEAM
}

extern "C" void kernel_launch(void* const* d_in, const int* in_sizes, int n_in, void* d_out, int out_size, void* d_ws, size_t ws_size, hipStream_t stream) {
    static int grid = 0;
    if (grid == 0) {
        if (n_in != 19 || out_size != M * DM || ws_size < WS_END) { fprintf(stderr, "kernel_launch: unexpected shapes (n_in %d out %d ws %zu)\n", n_in, out_size, ws_size); grid = -1; return; }
        int dev = 0, cus = 0, per_cu = 0;
        hipGetDevice(&dev); hipDeviceGetAttribute(&cus, hipDeviceAttributeMultiprocessorCount, dev);
        hipFuncSetAttribute((const void*)mk_fwd, hipFuncAttributeMaxDynamicSharedMemorySize, LDS_BYTES);
        hipOccupancyMaxActiveBlocksPerMultiprocessor(&per_cu, (const void*)mk_fwd, NTHREADS, LDS_BYTES);
        (void)hipGetLastError();
        if (per_cu < 1) fprintf(stderr, "kernel_launch: occupancy query reports %d blocks per CU\n", per_cu);
        grid = cus;
    }
    if (grid < 0) return;
    hipMemsetAsync((char*)d_ws + WS_CTL, 0, CTL_ZERO_BYTES, stream);
    Args a{};
    const void** ip = (const void**)&a.in;
    for (int i = 0; i < 19; ++i) ip[i] = d_in[i];
    a.out = (float*)d_out; a.ws = (unsigned char*)d_ws;
#if MK_N_LAUNCHES == 1
    a.ph_lo = 0; a.ph_hi = N_PHASES;
    { void* kargs[] = {&a}; hipError_t e = hipLaunchCooperativeKernel((const void*)mk_fwd, dim3(grid), dim3(NTHREADS), kargs, LDS_BYTES, stream);
      if (e != hipSuccess) fprintf(stderr, "cooperative launch failed: %s (grid %d)\n", hipGetErrorString(e), grid); }
#else
    for (int p = 0; p < N_PHASES; ++p) { const int reps = ((PROBE_MASK >> p) & 1u) ? 2 : 1;
        for (int rr = 0; rr < reps; ++rr) { a.ph_lo = p; a.ph_hi = p + 1; a.flags = (rr > 0) ? 1 : 0; hipLaunchKernelGGL(mk_fwd, dim3(grid), dim3(NTHREADS), LDS_BYTES, stream, a); } }
#endif
}
```

```cpp
#define MK_N_LAUNCHES 1
#include <hip/hip_runtime.h>
#include <stdint.h>
#include <math.h>
#include <cstdio>

#define LAS __attribute__((address_space(3)))
#define GAS __attribute__((address_space(1)))
typedef _Float16 h16;
typedef h16 h16x8 __attribute__((ext_vector_type(8)));
typedef h16 h16x4 __attribute__((ext_vector_type(4)));
typedef h16 h16x2 __attribute__((ext_vector_type(2)));
typedef float f32x2 __attribute__((ext_vector_type(2)));
typedef float f32x4 __attribute__((ext_vector_type(4)));
typedef float f32x16 __attribute__((ext_vector_type(16)));
typedef unsigned u32x2 __attribute__((ext_vector_type(2)));
typedef unsigned u32x4 __attribute__((ext_vector_type(4)));
typedef short v4i16_t __attribute__((ext_vector_type(4)));

__device__ __forceinline__ int lane_id() { return (int)__builtin_amdgcn_mbcnt_hi(~0u, __builtin_amdgcn_mbcnt_lo(~0u, 0u)); }
__device__ __forceinline__ unsigned pkh(float lo, float hi) { h16x2 v = {(h16)lo, (h16)hi}; return __builtin_bit_cast(unsigned, v); }
__device__ __forceinline__ unsigned pkz(float lo, float hi) { return __builtin_bit_cast(unsigned, __builtin_amdgcn_cvt_pkrtz(lo, hi)); }
__device__ __forceinline__ float h2f_lo(unsigned u) { h16x2 v = __builtin_bit_cast(h16x2, u); return (float)v[0]; }
__device__ __forceinline__ float h2f_hi(unsigned u) { h16x2 v = __builtin_bit_cast(h16x2, u); return (float)v[1]; }

namespace pg8 {
constexpr int BM = 256, BK = 64, HALF = 128, HTB = HALF * BK * 2, STAGE_BYTES = 8 * HTB, NXCD = 8, WGM = 4;
__host__ __device__ __forceinline__ int lds_byte(int r, int c) { const int st = (r >> 4) * 2 + (c >> 5), rr = r & 15, cc = c & 31, ob = rr * 64 + cc * 2; return st * 1024 + (ob ^ (((ob >> 9) & 1) << 5)); }
__host__ __device__ __forceinline__ void stage_rc(int b, int& R, int& C) { const int st = b / 1024, sb = b % 1024, swz = sb ^ (((sb >> 9) & 1) << 5); R = (st >> 1) * 16 + swz / 64; C = (st & 1) * 32 + (swz % 64) / 2; }
__host__ __device__ __forceinline__ int perm32(int rho) { const int n = rho >> 4, i = rho & 15; return 8 * (i >> 2) + 4 * n + (i & 3); }

struct Unit { int pm, pn, kind; };
struct Gemm { const h16* A; const h16* Bt; int lda, ldb, K, nM, nN, nkind, koff, noepi, stagger; };

struct Order {
    int nM, nN, nwg, G, c, nk;
    __device__ void init(int nM_, int nN_, int G_, int c_, int nk_) { asm volatile("" : "+s"(G_), "+s"(c_)); nM = nM_; nN = nN_; nwg = nM * nN; G = G_; c = c_; nk = nk_; }
    __device__ bool next(int i, Unit& u) const {
        const int ti = i / nk; u.kind = i - ti * nk;
        const long L = (long)ti * G + c; if (L >= nwg) return false;
        int wgid = (int)L; { const int q = nwg / NXCD, r = nwg % NXCD, xcd = wgid % NXCD, off = wgid / NXCD; wgid = (xcd < r ? xcd * (q + 1) : r * (q + 1) + (xcd - r) * q) + off; }
        const int nig = WGM * nN, gid = wgid / nig, fm = gid * WGM, gsz = (nM - fm) < WGM ? (nM - fm) : WGM;
        u.pm = fm + ((wgid % nig) % gsz); u.pn = (wgid % nig) / gsz; return true;
    }
};

template <class Epi>
__device__ __forceinline__ void gemm_phase(LAS unsigned char* lds, const Gemm g, const Order& S, const Epi& E, int wave_) {
    int tid = wave_ * 64 + lane_id(); asm volatile("" : "+v"(tid));
    const int wid = __builtin_amdgcn_readfirstlane(tid >> 6), lane = tid & 63, wr = wid >> 2, wc = wid & 3, fr = lane & 15, fq = lane >> 4;
    const int nt = g.K / BK;
    unsigned voffA[2], voffB[2];
#pragma unroll
    for (int i = 0; i < 2; ++i) { int R, C; stage_rc(tid * 16 + i * 8192, R, C); const int Rb = Epi::PERM ? ((R & ~31) + perm32(R & 31)) : R;
        voffA[i] = (unsigned)(R * g.lda + C) * 2u; voffB[i] = (unsigned)(Rb * g.ldb + C) * 2u; }
    const size_t kstep = (size_t)(BK * 2);
    const size_t hstepA = (size_t)HALF * g.lda * 2, hstepB = (size_t)HALF * g.ldb * 2;
    const unsigned ldsw = (unsigned)wid * 1024u;
    const int aoff = lds_byte(wr * 64 + fr, fq * 8), boff = lds_byte(wc * 32 + fr, fq * 8);
#define PG8_SA(b, h) (((b) * 2 + (h)) * HTB)
#define PG8_SB(b, h) ((4 + (b) * 2 + (h)) * HTB)
#define PG8_STAGE(bufoff, gbase, voff) do { _Pragma("unroll") for (int _i = 0; _i < 2; ++_i) \
        __builtin_amdgcn_global_load_lds((const unsigned*)((const char*)(gbase) + (voff)[_i]), (LAS unsigned*)(lds + (bufoff) + ldsw + _i * 8192), 16, 0, 0); } while (0)
#define PG8_LDA(dst, b, h) do { _Pragma("unroll") for (int m = 0; m < 4; ++m) _Pragma("unroll") for (int k = 0; k < 2; ++k) dst[m][k] = *(const LAS h16x8*)(lds + PG8_SA(b, h) + aoff + m * 2048 + k * 1024); } while (0)
#define PG8_LDB(dst, b, h) do { _Pragma("unroll") for (int n = 0; n < 2; ++n) _Pragma("unroll") for (int k = 0; k < 2; ++k) dst[n][k] = *(const LAS h16x8*)(lds + PG8_SB(b, h) + boff + n * 2048 + k * 1024); } while (0)
#define PG8_MMA(ai, bj, At, Bt) do { __builtin_amdgcn_s_setprio(1); _Pragma("unroll") for (int m = 0; m < 4; ++m) _Pragma("unroll") for (int n = 0; n < 2; ++n) _Pragma("unroll") for (int k = 0; k < 2; ++k) \
        acc[ai][bj][m][n] = __builtin_amdgcn_mfma_f32_16x16x32_f16(Bt[n][k], At[m][k], acc[ai][bj][m][n], 0, 0, 0); __builtin_amdgcn_s_setprio(0); } while (0)
#define PG8_WAIT_V(n) asm volatile("s_waitcnt vmcnt(" #n ")" ::: "memory")
#define PG8_WAIT_L(n) asm volatile("s_waitcnt lgkmcnt(" #n ")" ::: "memory")
#define PG8_BAR __builtin_amdgcn_s_barrier()
#define PG8_SCHED __builtin_amdgcn_sched_barrier(0)
#define PG8_PA(u) ((const char*)g.A + ((size_t)(u).pm * 256 * g.lda + (size_t)(u).kind * g.koff) * 2)
#define PG8_PB(u) ((const char*)g.Bt + ((size_t)(u).pn * 256 * g.ldb + (size_t)(u).kind * g.koff) * 2)
    Unit cur, nxt; int ui = 0;
    if (!S.next(0, cur)) return;
    { const int nbig = S.nwg % S.G;
      if (nbig > 0 && S.c >= nbig && g.stagger) { const int ngrp = S.G / nbig, j = S.c / nbig; const unsigned long long dl = (unsigned long long)((g.K / BK) * 140 + 100) * S.nk * j / ngrp;
          const unsigned long long t0 = __builtin_amdgcn_s_memrealtime(); while (__builtin_amdgcn_s_memrealtime() - t0 < dl) __builtin_amdgcn_s_sleep(32); } }
    f32x4 acc[2][2][4][2];
#pragma unroll
    for (int a = 0; a < 2; ++a)
#pragma unroll
        for (int b = 0; b < 2; ++b)
#pragma unroll
            for (int m = 0; m < 4; ++m)
#pragma unroll
                for (int n = 0; n < 2; ++n) acc[a][b][m][n] = (f32x4){0.f, 0.f, 0.f, 0.f};
    h16x8 At[4][2], B0[2][2], B1[2][2];
    const char* cA = PG8_PA(cur); const char* cB = PG8_PB(cur);
    E.prefetch(cur, wid, lane);
    PG8_STAGE(PG8_SB(0, 0), cB, voffB); PG8_STAGE(PG8_SB(0, 1), cB + hstepB, voffB); PG8_STAGE(PG8_SA(0, 0), cA, voffA); PG8_STAGE(PG8_SA(0, 1), cA + hstepA, voffA);
    if (wr == 1) PG8_BAR;
    PG8_WAIT_V(2); PG8_BAR;
    PG8_STAGE(PG8_SB(1, 0), cB + kstep, voffB); PG8_STAGE(PG8_SA(1, 0), cA + kstep, voffA); PG8_STAGE(PG8_SB(1, 1), cB + hstepB + kstep, voffB);
    PG8_WAIT_V(6); PG8_BAR;
    for (;;) {
        const bool has_next = S.next(ui + 1, nxt);
        const char* nA = has_next ? PG8_PA(nxt) : cA; const char* nB = has_next ? PG8_PB(nxt) : cB;
        for (int t = 0; t < nt; t += 2) {
            const bool last = (t == nt - 2);
            const char* a1 = cA + (size_t)(t + 1) * kstep;
            const char* a2 = last ? nA : cA + (size_t)(t + 2) * kstep; const char* b2 = last ? nB : cB + (size_t)(t + 2) * kstep;
            const char* a3 = a2 + kstep; const char* b3 = b2 + kstep;
            PG8_LDB(B0, 0, 0); PG8_LDB(B1, 0, 1); PG8_SCHED; PG8_LDA(At, 0, 0); PG8_STAGE(PG8_SA(1, 1), a1 + hstepA, voffA);
            PG8_WAIT_V(8); PG8_WAIT_L(0); PG8_BAR; PG8_MMA(0, 0, At, B0); PG8_MMA(0, 1, At, B1); PG8_BAR; PG8_SCHED;
            PG8_LDA(At, 0, 1); PG8_STAGE(PG8_SB(0, 0), b2, voffB); PG8_STAGE(PG8_SB(0, 1), b2 + hstepB, voffB); PG8_STAGE(PG8_SA(0, 0), a2, voffA);
            PG8_WAIT_V(8); PG8_WAIT_L(0); PG8_BAR; PG8_MMA(1, 0, At, B0); PG8_MMA(1, 1, At, B1); PG8_BAR; PG8_SCHED;
            PG8_LDB(B0, 1, 0); PG8_LDB(B1, 1, 1); PG8_SCHED; PG8_LDA(At, 1, 0); PG8_STAGE(PG8_SA(0, 1), a2 + hstepA, voffA);
            PG8_WAIT_V(8); PG8_WAIT_L(0); PG8_BAR; PG8_MMA(0, 0, At, B0); PG8_MMA(0, 1, At, B1); PG8_BAR; PG8_SCHED;
            PG8_LDA(At, 1, 1); PG8_STAGE(PG8_SB(1, 0), b3, voffB); PG8_STAGE(PG8_SB(1, 1), b3 + hstepB, voffB); PG8_STAGE(PG8_SA(1, 0), a3, voffA);
            PG8_WAIT_V(8); PG8_WAIT_L(0); PG8_BAR; PG8_MMA(1, 0, At, B0); PG8_MMA(1, 1, At, B1); PG8_BAR; PG8_SCHED;
        }
        if (wr == 0) PG8_BAR;
        { int fr_ = fr, fq_ = fq; asm volatile("" : "+v"(fr_), "+v"(fq_)); if (!g.noepi) E(acc, cur, wr, wc, fr_, fq_); }
        if (!has_next) break;
        if (nxt.kind == 0) {
#pragma unroll
            for (int a = 0; a < 2; ++a)
#pragma unroll
                for (int b = 0; b < 2; ++b)
#pragma unroll
                    for (int m = 0; m < 4; ++m)
#pragma unroll
                        for (int n = 0; n < 2; ++n) acc[a][b][m][n] = (f32x4){0.f, 0.f, 0.f, 0.f};
        }
        cur = nxt; cA = nA; cB = nB; ++ui;
        if (cur.kind == 0) E.prefetch(cur, wid, lane);
        if (wr == 1) PG8_BAR;
    }
    PG8_WAIT_V(0);
    PG8_BAR;
#undef PG8_SA
#undef PG8_SB
#undef PG8_STAGE
#undef PG8_LDA
#undef PG8_LDB
#undef PG8_MMA
#undef PG8_WAIT_V
#undef PG8_WAIT_L
#undef PG8_BAR
#undef PG8_SCHED
#undef PG8_PA
#undef PG8_PB
}
}
constexpr int NWAVES = 8, NTHREADS = 512;
constexpr int NB = 8, SEQ = 2048, DM = 1024, M = NB * SEQ, DIN = 4312, DFF = 2816, NLAYER = 2;
constexpr int NZ = 4352;
constexpr int NGU = 2 * DFF;
constexpr float EPS_RMS = 1e-6f;
constexpr float LOG2E = 1.4426950408889634f;
constexpr float QSCALE = 0.125f * LOG2E;
constexpr int KVP = 152;

constexpr size_t MiB = 1u << 20;
constexpr size_t WS_CTL = 0, CTL_ZERO_BYTES = 65536;
constexpr size_t WS_CS = 1 * MiB;
constexpr size_t WS_SSQ = 2 * MiB;
constexpr size_t WS_WI = 3 * MiB;
constexpr size_t WS_SMALLW = 4 * MiB;
constexpr size_t SMALLW_LAYER = 98304 + 131072 + 262144;
constexpr size_t WS_W = 6 * MiB;
constexpr size_t W_LAYER = 29 * MiB, W_OFF_IN = 0, W_OFF_PAB = (size_t)NZ * 1024 * 2, W_OFF_OUT = W_OFF_PAB + 2 * MiB, W_OFF_GU = W_OFF_OUT + 2 * MiB, W_OFF_D = W_OFF_GU + (size_t)NGU * 1024 * 2;
static_assert(W_OFF_D + (size_t)1024 * DFF * 2 == W_LAYER, "weight map");
constexpr size_t WS_X16 = 64 * MiB;
constexpr size_t WS_QY = 96 * MiB;
constexpr size_t WS_QI = 128 * MiB;
constexpr size_t WS_MISC = 144 * MiB;
constexpr size_t WS_KV = 152 * MiB;
constexpr size_t WS_KI = 157 * MiB;
constexpr size_t WS_X1 = 128 * MiB;
constexpr size_t WS_GATES = 160 * MiB;
constexpr size_t WS_UV = 224 * MiB;
constexpr size_t WS_ACT = 160 * MiB;
constexpr size_t WS_END = 256 * MiB;
static_assert(WS_KV + (size_t)M * KVP * 2 <= WS_KI && WS_KI + (size_t)M * 64 * 2 <= WS_GATES && WS_ACT + (size_t)M * DFF * 2 <= WS_END, "ws map");

constexpr int LDS_BYTES = 155648;
constexpr int LDS_MISC = 151552;

#define RLX_AGENT __ATOMIC_RELAXED, __HIP_MEMORY_SCOPE_AGENT
#define LDS_WAIT() asm volatile("s_waitcnt lgkmcnt(0)" ::: "memory")
#define VM_WAIT() asm volatile("s_waitcnt vmcnt(0)" ::: "memory")

#define XB_TMO      128
#define XB_XCNT(j)  (256  + 64 * (j))
#define XB_XSUB(j)  (1280 + 64 * (j))
#define XB_XGEN(j)  (2304 + 64 * (j))
#define XB_TOP      3328
#define XB_TOPGEN   3392
#define XCD_BAR_WORDS 3456
#define XB_SPIN_CAP (1u << 18)
__device__ __forceinline__ unsigned xb_ld(unsigned* p)              { return __hip_atomic_load(p, __ATOMIC_RELAXED, __HIP_MEMORY_SCOPE_AGENT); }
__device__ __forceinline__ unsigned xb_add(unsigned* p, unsigned v) { return __hip_atomic_fetch_add(p, v, __ATOMIC_RELAXED, __HIP_MEMORY_SCOPE_AGENT); }
__device__ __forceinline__ unsigned xb_xcc_id() { return (unsigned)__builtin_amdgcn_s_getreg((3 << 11) | 20) & 0xFu; }
#define XB_SPIN(cond, bar) do { unsigned _sp = 0; while (cond) { __builtin_amdgcn_s_sleep(1); \
    if ((++_sp & 255u) == 0u) { if (xb_ld(&(bar)[XB_TMO])) break; if (_sp > XB_SPIN_CAP) { atomicAdd(&(bar)[XB_TMO], 1u); break; } } } } while (0)
struct XcdBarrier { unsigned* bar; unsigned x; volatile LAS unsigned* st; };
__device__ __forceinline__ XcdBarrier xcd_barrier_post(unsigned* bar, volatile LAS unsigned* st, int wave_) {
    XcdBarrier b; b.bar = bar; b.x = xb_xcc_id(); b.st = st;
    if (wave_ == 0 && lane_id() == 0) (void)xb_add(&bar[XB_XCNT(b.x)], 1u);
    return b;
}
__device__ __forceinline__ void xcd_barrier_complete(unsigned* bar, unsigned x, unsigned& nloc, unsigned& nx) {
    const unsigned G = gridDim.x * gridDim.y * gridDim.z;
    unsigned sum, cnt, mine, sp = 0u;
    for (;;) {
        sum = 0u; cnt = 0u; mine = 0u;
#pragma unroll
        for (unsigned j = 0; j < 16; ++j) { const unsigned c = xb_ld(&bar[XB_XCNT(j)]); sum += c; cnt += (c > 0u) ? 1u : 0u; }
        mine = xb_ld(&bar[XB_XCNT(x)]);
        if (sum == G) break;
        __builtin_amdgcn_s_sleep(1);
        if ((++sp & 255u) == 0u) { if (xb_ld(&bar[XB_TMO])) break; if (sp > XB_SPIN_CAP) { atomicAdd(&bar[XB_TMO], 1u); break; } }
    }
    nloc = mine > 0u ? mine : 1u; nx = cnt > 0u ? cnt : 1u;
}
__device__ __forceinline__ void xcd_barrier(const XcdBarrier& b, int wave_) {
    asm volatile("s_waitcnt vmcnt(0)" ::: "memory");
    __syncthreads();
    if (wave_ == 0 && lane_id() == 0) {
        unsigned* bar = b.bar; asm volatile("" : "+s"(bar));
        unsigned stoff = (unsigned)(uintptr_t)b.st; asm volatile("" : "+s"(stoff)); volatile LAS unsigned* st = (volatile LAS unsigned*)(uintptr_t)stoff;
        const unsigned x = xb_xcc_id();
        __builtin_amdgcn_s_waitcnt(0);
        unsigned nloc = st[0], nx = st[1];
        if (nloc == 0u) { xcd_barrier_complete(bar, x, nloc, nx); st[0] = nloc; st[1] = nx; }
        const unsigned old = xb_add(&bar[XB_XSUB(x)], 1u);
        const unsigned gen = old / nloc;
        if (old + 1u == (gen + 1u) * nloc) {
            __builtin_amdgcn_fence(__ATOMIC_RELEASE, "agent");
            asm volatile("s_waitcnt vmcnt(0)" ::: "memory");
            const unsigned og = xb_add(&bar[XB_TOP], 1u);
            const unsigned tg = og / nx;
            if (og + 1u == (tg + 1u) * nx) xb_add(&bar[XB_TOPGEN], 1u);
            else XB_SPIN(xb_ld(&bar[XB_TOPGEN]) == tg, bar);
            __builtin_amdgcn_fence(__ATOMIC_ACQUIRE, "agent");
            xb_add(&bar[XB_XGEN(x)], 1u);
            asm volatile("s_waitcnt vmcnt(0)" ::: "memory");
        } else {
            XB_SPIN(xb_ld(&bar[XB_XGEN(x)]) == gen, bar);
            __builtin_amdgcn_fence(__ATOMIC_ACQUIRE, "agent");
            asm volatile("s_waitcnt vmcnt(0)" ::: "memory");
        }
    }
    __syncthreads();
}

__device__ __forceinline__ float gelu_tanh_f(float x) {
    const float u = 0.7978845608028654f * (x + 0.044715f * x * x * x);
    const float e = __builtin_amdgcn_exp2f(-2.0f * LOG2E * u);
    return x * __builtin_amdgcn_rcpf(1.0f + e);
}
__device__ __forceinline__ float sigmoid_f(float x) { return __builtin_amdgcn_rcpf(1.0f + __builtin_amdgcn_exp2f(-LOG2E * x)); }

struct Frame {
    LAS unsigned char* lds;
    int wave, vcu, G;
    unsigned char* ws;
    const float* const* in;
};
struct In {
    const float* x; const int* pos; const float* norm_mix; const float* w_in; const float* kv_norm; const float* w_uk; const float* w_uv; const float* ln_v_g; const float* ln_v_b;
    const float* w_s; const float* b_s; const float* w_proj_a; const float* w_proj_b; const float* w_out; const float* norm_ffn; const float* w_gate; const float* w_up; const float* w_down; const float* final_norm;
};

__device__ __constant__ float c_inv[8] = {1.0f, 0.19392274474868576f, 0.03760603093086393f, 0.007292664737217109f, 0.001414213562373095f, 0.0002742481756762073f, 5.318295896944988e-05f, 1.031338537721246e-05f};

__device__ __forceinline__ void transpose_item64(const float* W4, int Nsrc, h16* WT, int ldt, int n0, int k0, const float* gain, LAS float* scr, int lane) {
    const int nq = lane & 15, kq = lane >> 4;
    f32x4 v[16];
#pragma unroll
    for (int i = 0; i < 16; ++i) v[i] = W4 ? *(const GAS f32x4*)(W4 + (size_t)(k0 + 4 * i + kq) * Nsrc) : (f32x4){0.f, 0.f, 0.f, 0.f};
#pragma unroll
    for (int i = 0; i < 16; ++i) { const int kk = 4 * i + kq; f32x4 x = v[i]; if (gain) x = x * gain[k0 + kk]; *(LAS f32x4*)(scr + kk * 68 + 4 * (nq ^ (kk >> 3))) = x; }
    LDS_WAIT(); asm volatile("" ::: "memory");
    const int c = lane & 7;
#pragma unroll
    for (int j = 0; j < 8; ++j) { const int n = (lane >> 3) + 8 * j; const LAS float* sp = scr + (8 * c) * 68 + 4 * ((n >> 2) ^ c) + (n & 3);
        u32x4 o; o.x = pkh(sp[0 * 68], sp[1 * 68]); o.y = pkh(sp[2 * 68], sp[3 * 68]); o.z = pkh(sp[4 * 68], sp[5 * 68]); o.w = pkh(sp[6 * 68], sp[7 * 68]);
        *(GAS u32x4*)(WT + (size_t)(n0 + n) * ldt + k0 + 8 * c) = o; }
    LDS_WAIT(); asm volatile("" ::: "memory");
}
__device__ __forceinline__ int win_src_col(int n) {
    if (n < 512) return n;
    if (n < 1024) return 656 + (n - 512);
    if (n < 2048) return 1240 + (n - 1024);
    if (n < 4096) return 2264 + (n - 2048);
    if (n < 4224) return 512 + (n - 4096);
    if (n < 4240) return 640 + (n - 4224);
    if (n < 4304) return 1168 + (n - 4240);
    if (n < 4312) return 1232 + (n - 4304);
    return -1;
}
__device__ __forceinline__ void convert_layer_weights(const Frame& F, const In& I, int l, int gw, int NGW, int it_lo = 0, int it_hi = 1 << 30) {
    LAS float* scr = (LAS float*)(F.lds + F.wave * 17408);
    int lane = lane_id(); asm volatile("" : "+v"(lane));
    constexpr int I_IN = (NZ / 64) * 16, I_PA = 16 * 8, I_OUT = 16 * 16, I_GU = (NGU / 64) * 16, I_D = 16 * (DFF / 64);
    constexpr int I_LAYER = I_IN + 2 * I_PA + I_OUT + I_GU + I_D;
    const int n4 = 4 * (lane & 15);
    unsigned char* wl = F.ws + WS_W + (size_t)l * W_LAYER;
    if (it_hi > I_LAYER) it_hi = I_LAYER;
    for (int it = it_lo + gw; it < it_hi; it += NGW) {
        int r = it;
        if (r < I_IN) { const int nb = r / 16, kb = r % 16, sc = win_src_col(nb * 64 + n4);
            transpose_item64(sc >= 0 ? I.w_in + (size_t)l * DM * DIN + sc : nullptr, DIN, (h16*)(wl + W_OFF_IN), 1024, nb * 64, kb * 64, I.norm_mix + l * DM, scr, lane); continue; }
        r -= I_IN;
        if (r < I_PA) { const int nb = r / 8, kb = r % 8;
            transpose_item64(I.w_proj_a + (size_t)l * 512 * 1024 + nb * 64 + n4, 1024, (h16*)(wl + W_OFF_PAB), 1024, nb * 64, kb * 64, nullptr, scr, lane); continue; }
        r -= I_PA;
        if (r < I_PA) { const int nb = r / 8, kb = r % 8;
            transpose_item64(I.w_proj_b + (size_t)l * 512 * 1024 + nb * 64 + n4, 1024, (h16*)(wl + W_OFF_PAB) + 512, 1024, nb * 64, kb * 64, nullptr, scr, lane); continue; }
        r -= I_PA;
        if (r < I_OUT) { const int nb = r / 16, kb = r % 16;
            transpose_item64(I.w_out + (size_t)l * 1024 * 1024 + nb * 64 + n4, 1024, (h16*)(wl + W_OFF_OUT), 1024, nb * 64, kb * 64, nullptr, scr, lane); continue; }
        r -= I_OUT;
        if (r < I_GU) { const int nb = r / 16, kb = r % 16, R = nb * 64 + n4, pn = R >> 8, rem = R & 255;
            const int a = 128 * pn + 64 * (rem >> 7) + 16 * ((rem >> 5) & 3) + 4 * ((rem >> 3) & 3);
            const float* src = (((rem >> 2) & 1) ? I.w_up : I.w_gate) + (size_t)l * DM * DFF + a;
            transpose_item64(src, DFF, (h16*)(wl + W_OFF_GU), 1024, nb * 64, kb * 64, I.norm_ffn + l * DM, scr, lane); continue; }
        r -= I_GU;
        { const int nb = r / (DFF / 64), kb = r % (DFF / 64);
            transpose_item64(I.w_down + (size_t)l * DFF * 1024 + nb * 64 + n4, 1024, (h16*)(wl + W_OFF_D), DFF, nb * 64, kb * 64, nullptr, scr, lane); }
    }
}
__device__ __forceinline__ void p0_prologue(const Frame& F, const In& I) {
    int lane = lane_id(); asm volatile("" : "+v"(lane));
    const int gw = F.vcu * NWAVES + F.wave, NGW = F.G * NWAVES;
    convert_layer_weights(F, I, 0, gw, NGW);
    const int gt = F.vcu * NTHREADS + F.wave * 64 + lane, NGT = F.G * NTHREADS;
    for (int i = gt; i < NLAYER * 49152; i += NGT) { const int l = i / 49152, e = i % 49152, h = e / (128 * 48), c = (e / 48) % 128, n = e % 48;
        ((h16*)(F.ws + WS_SMALLW + (size_t)l * SMALLW_LAYER))[e] = (h16)I.w_uk[(((size_t)l * 8 + h) * 48 + n) * 128 + c]; }
    for (int i = gt; i < NLAYER * 65536; i += NGT) { const int l = i / 65536, e = i % 65536, h = e / (64 * 128), d = (e / 128) % 64, c = e % 128;
        ((h16*)(F.ws + WS_SMALLW + (size_t)l * SMALLW_LAYER + 98304))[e] = (h16)I.w_uv[(((size_t)l * 8 + h) * 128 + c) * 64 + d]; }
    for (int i = gt; i < NLAYER * 131072; i += NGT) { const int l = i / 131072, e = i % 131072, t = (e / 128) % 128, s = e % 128;
        ((h16*)(F.ws + WS_SMALLW + (size_t)l * SMALLW_LAYER + 98304 + 131072))[e] = (s <= t) ? (h16)I.w_s[(size_t)l * 131072 + e] : (h16)0.f; }
    for (int i = gt; i < M * 8; i += NGT) { const int tok = i >> 3, f = i & 7; const float ang = (float)I.pos[tok] * c_inv[f];
        float* cs = (float*)(F.ws + WS_CS) + (size_t)tok * 16; cs[f] = cosf(ang); cs[8 + f] = sinf(ang); }
    for (int m = gw; m < M; m += NGW) {
        const f32x4* xr = (const f32x4*)(I.x + (size_t)m * DM) + lane; u32x2* o8 = (u32x2*)((h16*)(F.ws + WS_X16) + (size_t)m * DM) + lane;
#pragma unroll
        for (int j = 0; j < 4; ++j) { const f32x4 v = xr[64 * j]; float s = (v.x * v.x + v.y * v.y) + (v.z * v.z + v.w * v.w);
#pragma unroll
            for (int o = 1; o < 64; o <<= 1) s += __shfl_xor(s, o);
            o8[64 * j] = (u32x2){pkh(v.x, v.y), pkh(v.z, v.w)};
            if (lane == 0) ((GAS float*)(F.ws + WS_SSQ))[(size_t)m * 4 + j] = s; }
    }
}

__device__ __forceinline__ float row_rstd(const float* ssq, int row) {
    const f32x4 a = *(const GAS f32x4*)(ssq + (size_t)row * 4);
    return rsqrtf(((a.x + a.y) + (a.z + a.w)) * (1.0f / DM) + EPS_RMS);
}

typedef f32x4 Acc[2][2][4][2];
__device__ __forceinline__ u32x4 pack8h(const float (&v)[8]) { u32x4 w; w.x = pkz(v[0], v[1]); w.y = pkz(v[2], v[3]); w.z = pkz(v[4], v[5]); w.w = pkz(v[6], v[7]); return w; }

__device__ __forceinline__ void ssq_prefetch(const float* ssq, int pm, LAS float* R4, int wid, int lane) {
    if (wid < 4) __builtin_amdgcn_global_load_lds((const unsigned*)(ssq + (size_t)(pm * 256 + wid * 64 + lane) * 4), (LAS unsigned*)(R4 + wid * 256), 16, 0, 0);
}
__device__ __forceinline__ float rstd_from_lds(const LAS float* R4, int rl) { const f32x4 a = *(const LAS f32x4*)(R4 + rl * 4); return rsqrtf(((a.x + a.y) + (a.z + a.w)) * (1.0f / DM) + EPS_RMS); }
struct EpiA {
    static constexpr bool PERM = true;
    unsigned char* ws; int nostore; LAS float* R;
    __device__ __forceinline__ void prefetch(const pg8::Unit& u, int wid, int lane) const { ssq_prefetch((const float*)(ws + WS_SSQ), u.pm, R, wid, lane); }
    __device__ __forceinline__ void operator()(Acc& acc, const pg8::Unit& u, int wr, int wc, int fr, int fq) const {
        const int pn = u.pn; h16* base; int ldc, colt;
        if (pn < 2) { base = (h16*)(ws + WS_QY); ldc = 1024; colt = pn * 256; }
        else if (pn < 4) { base = (h16*)(ws + WS_QI); ldc = 512; colt = (pn - 2) * 256; }
        else if (pn < 8) { base = (h16*)(ws + WS_UV); ldc = 1024; colt = (pn - 4) * 256; }
        else if (pn < 16) { base = (h16*)(ws + WS_GATES); ldc = 2048; colt = (pn - 8) * 256; }
        else { base = (h16*)(ws + WS_MISC); ldc = 256; colt = 0; }
        const int row0 = u.pm * 256 + wr * 64 + fr, col0 = colt + wc * 32 + 8 * fq;
#pragma unroll
        for (int ai = 0; ai < 2; ++ai)
#pragma unroll
            for (int m = 0; m < 4; ++m) { const int row = row0 + ai * 128 + m * 16; const float rs = rstd_from_lds(R, ai * 128 + wr * 64 + m * 16 + fr); h16* rowp = base + (size_t)row * ldc + col0;
#pragma unroll
                for (int bj = 0; bj < 2; ++bj) { f32x4 v0 = acc[ai][bj][m][0] * rs, v1 = acc[ai][bj][m][1] * rs;
                    u32x4 w; w.x = pkz(v0[0], v0[1]); w.y = pkz(v0[2], v0[3]); w.z = pkz(v1[0], v1[1]); w.w = pkz(v1[2], v1[3]);
                    if (!nostore) *(GAS u32x4*)(rowp + bj * 128) = w; else asm volatile("" :: "v"(w)); } }
        asm volatile("s_waitcnt lgkmcnt(0)" ::: "memory"); __builtin_amdgcn_s_barrier(); asm volatile("" ::: "memory");
    }
};

struct EpiD {
    static constexpr bool PERM = true;
    unsigned char* ws; h16* mg;
    __device__ __forceinline__ void prefetch(const pg8::Unit&, int, int) const {}
    __device__ __forceinline__ void operator()(Acc& acc, const pg8::Unit& u, int wr, int wc, int fr, int fq) const {
        const int row0 = u.pm * 256 + wr * 64 + fr, col0 = u.pn * 256 + wc * 32 + 8 * fq;
        const h16* gates = (const h16*)(ws + WS_GATES);
#pragma unroll
        for (int ai = 0; ai < 2; ++ai) {
            h16x8 gbv[4][2], gav[4][2];
#pragma unroll
            for (int m = 0; m < 4; ++m)
#pragma unroll
                for (int bj = 0; bj < 2; ++bj) { const size_t off = (size_t)(row0 + ai * 128 + m * 16) * 2048 + col0 + bj * 128;
                    gbv[m][bj] = *(const GAS h16x8*)(gates + off + 1024); if (u.kind == 0) gav[m][bj] = *(const GAS h16x8*)(gates + off); }
#pragma unroll
            for (int m = 0; m < 4; ++m) { const int row = row0 + ai * 128 + m * 16;
#pragma unroll
                for (int bj = 0; bj < 2; ++bj) { const int col = col0 + bj * 128; const h16x8 gb = gbv[m][bj];
                    if (u.kind == 0) { const h16x8 ga = gav[m][bj];
#pragma unroll
                        for (int i = 0; i < 8; ++i) { const float ea = __builtin_amdgcn_exp2f(fminf(-LOG2E * (float)ga[i], 64.f)), eb = __builtin_amdgcn_exp2f(fminf(-LOG2E * (float)gb[i], 64.f));
                            acc[ai][bj][m][i >> 2][i & 3] *= (1.0f + eb) * __builtin_amdgcn_rcpf(1.0f + ea); }
                    } else { float v[8];
#pragma unroll
                        for (int i = 0; i < 8; ++i) { const float eb = __builtin_amdgcn_exp2f(fminf(-LOG2E * (float)gb[i], 64.f)); v[i] = acc[ai][bj][m][i >> 2][i & 3] * __builtin_amdgcn_rcpf(1.0f + eb); }
                        u32x4 w; w.x = pkz(v[0], v[1]); w.y = pkz(v[2], v[3]); w.z = pkz(v[4], v[5]); w.w = pkz(v[6], v[7]);
                        *(GAS u32x4*)(mg + (size_t)row * 1024 + col) = w; } } }
            asm volatile("" ::: "memory"); }
    }
};

struct EpiRes {
    static constexpr bool PERM = true;
    const h16* resid; h16* xo; float* ssq; LAS float* P;
    __device__ __forceinline__ void prefetch(const pg8::Unit&, int, int) const {}
    __device__ __forceinline__ void operator()(Acc& acc, const pg8::Unit& u, int wr, int wc, int fr, int fq) const {
        const int row0 = u.pm * 256 + wr * 64 + fr, col0 = u.pn * 256 + wc * 32 + 8 * fq;
        h16x8 rvv[2][4][2];
#pragma unroll
        for (int ai = 0; ai < 2; ++ai)
#pragma unroll
            for (int m = 0; m < 4; ++m)
#pragma unroll
                for (int bj = 0; bj < 2; ++bj) rvv[ai][m][bj] = *(const GAS h16x8*)(resid + (size_t)(row0 + ai * 128 + m * 16) * 1024 + col0 + bj * 128);
#pragma unroll
        for (int ai = 0; ai < 2; ++ai)
#pragma unroll
            for (int m = 0; m < 4; ++m) { const int row = row0 + ai * 128 + m * 16; float ss = 0.f;
#pragma unroll
                for (int bj = 0; bj < 2; ++bj) { const size_t off = (size_t)row * 1024 + col0 + bj * 128;
                    const h16x8 rv = rvv[ai][m][bj]; float v[8];
#pragma unroll
                    for (int i = 0; i < 8; ++i) { v[i] = (float)rv[i] + acc[ai][bj][m][i >> 2][i & 3]; ss = fmaf(v[i], v[i], ss); }
                    *(GAS u32x4*)(xo + off) = pack8h(v); }
                ss += __shfl_xor(ss, 16); ss += __shfl_xor(ss, 32);
                if (fq == 0) P[(ai * 128 + wr * 64 + m * 16 + fr) * 4 + wc] = ss; }
        asm volatile("s_waitcnt lgkmcnt(0)" ::: "memory"); __builtin_amdgcn_s_barrier(); asm volatile("" ::: "memory");
        { const int t = (wr * 4 + wc) * 64 + fq * 16 + fr; if (t < 256) { const f32x4 v = *(const LAS f32x4*)(P + t * 4); ((GAS float*)ssq)[(size_t)(u.pm * 256 + t) * 4 + u.pn] = (v.x + v.y) + (v.z + v.w); } }
        asm volatile("s_waitcnt lgkmcnt(0)" ::: "memory"); __builtin_amdgcn_s_barrier(); asm volatile("" ::: "memory");
    }
};

struct EpiF {
    static constexpr bool PERM = true;
    unsigned char* ws; LAS float* R;
    __device__ __forceinline__ void prefetch(const pg8::Unit& u, int wid, int lane) const { ssq_prefetch((const float*)(ws + WS_SSQ), u.pm, R, wid, lane); }
    __device__ __forceinline__ void operator()(Acc& acc, const pg8::Unit& u, int wr, int wc, int fr, int fq) const {
        const int row0 = u.pm * 256 + wr * 64 + fr, col0 = u.pn * 128 + wc * 16 + 4 * fq;
        h16* act = (h16*)(ws + WS_ACT);
#pragma unroll
        for (int ai = 0; ai < 2; ++ai)
#pragma unroll
            for (int m = 0; m < 4; ++m) { const int row = row0 + ai * 128 + m * 16; const float rs = rstd_from_lds(R, ai * 128 + wr * 64 + m * 16 + fr);
#pragma unroll
                for (int bj = 0; bj < 2; ++bj) { const f32x4 g = acc[ai][bj][m][0] * rs, uu = acc[ai][bj][m][1] * rs; float v[4];
#pragma unroll
                    for (int i = 0; i < 4; ++i) v[i] = g[i] * sigmoid_f(g[i]) * uu[i];
                    *(GAS u32x2*)(act + (size_t)row * DFF + col0 + bj * 64) = (u32x2){pkz(v[0], v[1]), pkz(v[2], v[3])}; } }
        asm volatile("s_waitcnt lgkmcnt(0)" ::: "memory"); __builtin_amdgcn_s_barrier(); asm volatile("" ::: "memory");
    }
};

__device__ __forceinline__ void final_norm_phase(const Frame& F, const h16* x16, float* out, const float* g) {
    int lane = lane_id(); asm volatile("" : "+v"(lane));
    const int gw = F.vcu * NWAVES + F.wave, NGW = F.G * NWAVES;
    f32x4 gv[2][2];
#pragma unroll
    for (int hh = 0; hh < 2; ++hh) { gv[hh][0] = *(const f32x4*)(g + 512 * hh + 8 * lane); gv[hh][1] = *(const f32x4*)(g + 512 * hh + 8 * lane + 4); }
    for (int m0 = gw; m0 < M; m0 += 8 * NGW) {
        h16x8 xa[8], xb[8];
#pragma unroll
        for (int k = 0; k < 8; ++k) { const int m = m0 + k * NGW; if (m < M) { xa[k] = *(const GAS h16x8*)(x16 + (size_t)m * DM + 8 * lane); xb[k] = *(const GAS h16x8*)(x16 + (size_t)m * DM + 512 + 8 * lane); } }
#pragma unroll
        for (int k = 0; k < 8; ++k) { const int m = m0 + k * NGW; if (m < M) { const h16x8 a = xa[k], b = xb[k]; float s = 0.f;
#pragma unroll
            for (int j = 0; j < 8; ++j) { s = fmaf((float)a[j], (float)a[j], s); s = fmaf((float)b[j], (float)b[j], s); }
#pragma unroll
            for (int o = 1; o < 64; o <<= 1) s += __shfl_xor(s, o);
            const float rs = rsqrtf(s * (1.0f / DM) + EPS_RMS);
#pragma unroll
            for (int hh = 0; hh < 2; ++hh) { const h16x8 v = hh ? b : a; const int c = 512 * hh + 8 * lane; const f32x4 g0 = gv[hh][0], g1 = gv[hh][1];
                *(GAS f32x4*)(out + (size_t)m * DM + c) = (f32x4){(float)v[0] * rs * g0.x, (float)v[1] * rs * g0.y, (float)v[2] * rs * g0.z, (float)v[3] * rs * g0.w};
                *(GAS f32x4*)(out + (size_t)m * DM + c + 4) = (f32x4){(float)v[4] * rs * g1.x, (float)v[5] * rs * g1.y, (float)v[6] * rs * g1.z, (float)v[7] * rs * g1.w}; } } }
    }
}
__device__ __forceinline__ unsigned wlane(unsigned val, int ln, unsigned old) {
    unsigned keep;
    asm volatile("s_mov_b32 %1, m0\n\ts_mov_b32 m0, %3\n\ts_nop 3\n\tv_writelane_b32 %0, %2, m0\n\ts_mov_b32 m0, %1" : "+v"(old), "=&s"(keep) : "s"(val), "s"(ln));
    return old;
}
__device__ __forceinline__ void cnt_ge(int& c, float x, float m) { asm("v_cmp_ge_f32 vcc, %1, %2\n\tv_addc_co_u32 %0, vcc, 0, %0, vcc" : "+v"(c) : "v"(x), "v"(m) : "vcc"); }
__device__ __forceinline__ void cnt_gt(int& c, float x, float m) { asm("v_cmp_gt_f32 vcc, %1, %2\n\tv_addc_co_u32 %0, vcc, 0, %0, vcc" : "+v"(c) : "v"(x), "v"(m) : "vcc"); }
#define SEL_C8(OP, m_, a0, a1, a2, a3, a4, a5, a6, a7) \
    "v_cmp_" OP "_f32 vcc, " a0 ", " m_ "\n\tv_cmp_" OP "_f32 %2, " a1 ", " m_ "\n\tv_cmp_" OP "_f32 %3, " a2 ", " m_ "\n\tv_cmp_" OP "_f32 %4, " a3 ", " m_ "\n\t" \
    "v_cmp_" OP "_f32 %5, " a4 ", " m_ "\n\tv_cmp_" OP "_f32 %6, " a5 ", " m_ "\n\tv_cmp_" OP "_f32 %7, " a6 ", " m_ "\n\tv_cmp_" OP "_f32 %8, " a7 ", " m_ "\n\t"
#define SEL_A8(c_) \
    "v_addc_co_u32 " c_ ", vcc, 0, " c_ ", vcc\n\tv_addc_co_u32 " c_ ", %2, 0, " c_ ", %2\n\tv_addc_co_u32 " c_ ", %3, 0, " c_ ", %3\n\tv_addc_co_u32 " c_ ", %4, 0, " c_ ", %4\n\t" \
    "v_addc_co_u32 " c_ ", %5, 0, " c_ ", %5\n\tv_addc_co_u32 " c_ ", %6, 0, " c_ ", %6\n\tv_addc_co_u32 " c_ ", %7, 0, " c_ ", %7\n\tv_addc_co_u32 " c_ ", %8, 0, " c_ ", %8\n\t"
#define SEL_CGROUP(NAME, OP) __device__ __forceinline__ void NAME(int& c0, int& c1, const float* s, float m0, float m1) { unsigned long long t1, t2, t3, t4, t5, t6, t7; \
    asm(SEL_C8(OP, "%25", "%9", "%11", "%13", "%15", "%17", "%19", "%21", "%23") SEL_A8("%0") SEL_C8(OP, "%26", "%10", "%12", "%14", "%16", "%18", "%20", "%22", "%24") SEL_A8("%1") \
        : "+v"(c0), "+v"(c1), "=&s"(t1), "=&s"(t2), "=&s"(t3), "=&s"(t4), "=&s"(t5), "=&s"(t6), "=&s"(t7) \
        : "v"(s[0]), "v"(s[1]), "v"(s[2]), "v"(s[3]), "v"(s[4]), "v"(s[5]), "v"(s[6]), "v"(s[7]), "v"(s[8]), "v"(s[9]), "v"(s[10]), "v"(s[11]), "v"(s[12]), "v"(s[13]), "v"(s[14]), "v"(s[15]), "v"(m0), "v"(m1) : "vcc"); }
SEL_CGROUP(cnt_group_ge, "ge")
SEL_CGROUP(cnt_group_gt, "gt")
__device__ __forceinline__ void ballot_ge_to_lane(unsigned& wlo, unsigned& whi, float x, float tau, int ln) {
    unsigned keep;
    asm volatile("v_cmp_ge_f32 vcc, %3, %4\n\ts_mov_b32 %2, m0\n\ts_mov_b32 m0, %5\n\ts_nop 3\n\tv_writelane_b32 %0, vcc_lo, m0\n\tv_writelane_b32 %1, vcc_hi, m0\n\ts_mov_b32 m0, %2"
                 : "+v"(wlo), "+v"(whi), "=&s"(keep) : "v"(x), "v"(tau), "s"(ln) : "vcc");
}
__device__ __forceinline__ int half_sum_dpp(int v, int hf) {
    v += __builtin_amdgcn_update_dpp(0, v, 0x111, 0xf, 0xf, true);
    v += __builtin_amdgcn_update_dpp(0, v, 0x112, 0xf, 0xf, true);
    v += __builtin_amdgcn_update_dpp(0, v, 0x114, 0xf, 0xf, true);
    v += __builtin_amdgcn_update_dpp(0, v, 0x118, 0xf, 0xf, true);
    v += __builtin_amdgcn_update_dpp(0, v, 0x142, 0xa, 0xf, false);
    const int s0 = __builtin_amdgcn_readlane(v, 31), s1 = __builtin_amdgcn_readlane(v, 63);
    return hf ? s1 : s0;
}
__device__ __forceinline__ int crow(int R, int hf) { return (R & 3) + 8 * (R >> 2) + 4 * hf; }
__device__ __forceinline__ float half_swap_max(float v) { auto rr = __builtin_amdgcn_permlane32_swap(__float_as_uint(v), __float_as_uint(v), false, false); return fmaxf(__uint_as_float(rr[0]), __uint_as_float(rr[1])); }
__device__ __forceinline__ float half_swap_sum(float v) { auto rr = __builtin_amdgcn_permlane32_swap(__float_as_uint(v), __float_as_uint(v), false, false); return __uint_as_float(rr[0]) + __uint_as_float(rr[1]); }
__device__ __forceinline__ void rope8(const h16x8 x1, const h16x8 x2, const float* cs, int which, float scale, float (&o)[8]) {
    const f32x4 c0 = *(const GAS f32x4*)(cs), c1 = *(const GAS f32x4*)(cs + 4), s0 = *(const GAS f32x4*)(cs + 8), s1 = *(const GAS f32x4*)(cs + 12);
#pragma unroll
    for (int j = 0; j < 8; ++j) { const float c = j < 4 ? c0[j & 3] : c1[j & 3], s = j < 4 ? s0[j & 3] : s1[j & 3]; const float a = (float)x1[j], b = (float)x2[j];
        o[j] = (which == 0 ? (a * c - b * s) : (b * c + a * s)) * scale; }
}
__device__ __forceinline__ u32x4 pack8(const float (&v)[8]) { u32x4 w; w.x = pkh(v[0], v[1]); w.y = pkh(v[2], v[3]); w.z = pkh(v[4], v[5]); w.w = pkh(v[6], v[7]); return w; }

__device__ __forceinline__ void phaseB(const Frame& F, const In& I, int l) {
    unsigned char* ws = F.ws; asm volatile("" : "+s"(ws)); ws = (unsigned char*)(GAS unsigned char*)ws;     int lane = lane_id(), tid = F.wave * 64 + lane; asm volatile("" : "+v"(lane), "+v"(tid)); const int w = F.wave;
    const h16* MISC = (const h16*)(ws + WS_MISC); h16* KV = (h16*)(ws + WS_KV); h16* KI = (h16*)(ws + WS_KI); float* WI = (float*)(ws + WS_WI); const float* CS = (const float*)(ws + WS_CS);
    int blk = F.vcu; asm volatile("" : "+s"(blk));
#pragma unroll
    for (int it = 0; it < 2; ++it) {
        const int tok = blk * 64 + w * 8 + it * 4 + (lane >> 4), i = lane & 15;
        const h16* mr = MISC + (size_t)tok * 256; const float* cs = CS + (size_t)tok * 16;
        const h16x8 x = *(const GAS h16x8*)(mr + 8 * i);
        float ss = 0.f;
#pragma unroll
        for (int j = 0; j < 8; ++j) ss += (float)x[j] * (float)x[j];
        ss += __shfl_xor(ss, 1); ss += __shfl_xor(ss, 2); ss += __shfl_xor(ss, 4); ss += __shfl_xor(ss, 8);
        const float rs = rsqrtf(ss * (1.0f / 128.f) + EPS_RMS);
        { float o[8]; const float* kn = I.kv_norm + l * 128 + 8 * i;
#pragma unroll
          for (int j = 0; j < 8; ++j) o[j] = (float)x[j] * rs * kn[j];
          *(GAS u32x4*)(KV + (size_t)tok * KVP + 8 * i) = pack8(o); }
        if (i < 2) { float o[8]; rope8(*(const GAS h16x8*)(mr + 128), *(const GAS h16x8*)(mr + 136), cs, i, 1.0f, o); *(GAS u32x4*)(KV + (size_t)tok * KVP + 128 + 8 * i) = pack8(o); }
        else if (i == 2) { u32x2 z2 = {0u, 0u}; asm volatile("" : "+v"(z2)); *(GAS u32x2*)(KV + (size_t)tok * KVP + 144) = z2; *(GAS u32x2*)(KV + (size_t)tok * KVP + 148) = z2; }
        else if (i < 11) { const int ii = i - 3;
            if (ii < 2) { float o[8]; rope8(*(const GAS h16x8*)(mr + 144), *(const GAS h16x8*)(mr + 152), cs, ii, 1.0f, o); *(GAS u32x4*)(KI + (size_t)tok * 64 + 8 * ii) = pack8(o); }
            else *(GAS u32x4*)(KI + (size_t)tok * 64 + 8 * ii) = *(const GAS u32x4*)(mr + 144 + 8 * ii); }
        else if (i == 11) { const h16x8 wv = *(const GAS h16x8*)(mr + 208); const float sc = 0.35355339059327373f * 0.125f;
            *(GAS f32x4*)(WI + (size_t)tok * 8) = (f32x4){(float)wv[0] * sc, (float)wv[1] * sc, (float)wv[2] * sc, (float)wv[3] * sc};
            *(GAS f32x4*)(WI + (size_t)tok * 8 + 4) = (f32x4){(float)wv[4] * sc, (float)wv[5] * sc, (float)wv[6] * sc, (float)wv[7] * sc}; }
    }
    const int b = blk >> 5, chunk = (blk >> 1) & 15, gh = blk & 1;
    const size_t tok0 = (size_t)b * SEQ + chunk * 128;
    const h16* UV = (const h16*)(ws + WS_UV); h16* QY = (h16*)(ws + WS_QY);
    LAS unsigned char* VN = F.lds;
    constexpr int VPB = 576;
    { const int i16 = lane & 15, rq = lane >> 4; h16x8 v[4][4];
#pragma unroll
      for (int it = 0; it < 4; ++it)
#pragma unroll
          for (int i = 0; i < 4; ++i) v[it][i] = *(const GAS h16x8*)(UV + (tok0 + 16 * w + 4 * it + rq) * 1024 + 512 + 8 * i16 + 128 * (i & 1) + 256 * ((i >> 1) ^ gh));
      f32x4 lgv[2][2], lbv[2][2];
#pragma unroll
      for (int i = 0; i < 2; ++i) { const int col = 256 * gh + 128 * i + 8 * i16; const float* lg = I.ln_v_g + l * 512 + col; const float* lb = I.ln_v_b + l * 512 + col;
          lgv[i][0] = *(const f32x4*)lg; lgv[i][1] = *(const GAS f32x4*)(lg + 4); lbv[i][0] = *(const f32x4*)lb; lbv[i][1] = *(const GAS f32x4*)(lb + 4); }
#pragma unroll
      for (int it = 0; it < 4; ++it) { float s = 0.f, q = 0.f; float vg[4][8];
#pragma unroll
          for (int i = 0; i < 4; ++i)
#pragma unroll
              for (int j = 0; j < 8; ++j) { const float x = gelu_tanh_f((float)v[it][i][j]); vg[i][j] = x; s += x; q = fmaf(x, x, q); }
          s += __shfl_xor(s, 1); q += __shfl_xor(q, 1); s += __shfl_xor(s, 2); q += __shfl_xor(q, 2); s += __shfl_xor(s, 4); q += __shfl_xor(q, 4); s += __shfl_xor(s, 8); q += __shfl_xor(q, 8);
          const float mu = s * (1.0f / 512.f), var = fmaxf(q * (1.0f / 512.f) - mu * mu, 0.f), rs = rsqrtf(var + 1e-5f);
          const int t = 16 * w + 4 * it + rq;
#pragma unroll
          for (int i = 0; i < 2; ++i) { float o[8];
#pragma unroll
              for (int j = 0; j < 8; ++j) o[j] = (vg[i][j] - mu) * rs * lgv[i][j >> 2][j & 3] + lbv[i][j >> 2][j & 3];
              *(LAS u32x4*)(VN + t * VPB + (128 * i + 8 * i16) * 2) = pack8(o); } } }
    asm volatile("" ::: "memory");
    { const int gp = w & 3, g = 4 * gh + gp, rh = w >> 2, r = lane & 31, hf = lane >> 5;
      const h16* WS16 = (const h16*)(ws + WS_SMALLW + (size_t)l * SMALLW_LAYER + 98304 + 131072) + (size_t)g * 128 * 128;
      const int troff = (8 * hf + ((lane & 15) >> 2)) * VPB + (gp * 64 + 16 * ((lane >> 4) & 1) + 4 * (lane & 3)) * 2;
      h16x8 wf[2][8];
#pragma unroll
      for (int tb = 0; tb < 2; ++tb)
#pragma unroll
          for (int s = 0; s < 8; ++s) wf[tb][s] = *(const GAS h16x8*)(WS16 + (size_t)(64 * rh + 32 * tb + r) * 128 + 16 * s + 8 * hf);
      float bsv[2]; u32x2 uu[2][2][4];
#pragma unroll
      for (int tb = 0; tb < 2; ++tb) { const int t = 64 * rh + 32 * tb + r; bsv[tb] = I.b_s[((size_t)l * 8 + g) * 128 + t];
#pragma unroll
          for (int db = 0; db < 2; ++db)
#pragma unroll
              for (int gg = 0; gg < 4; ++gg) uu[tb][db][gg] = *(const GAS u32x2*)(UV + (tok0 + t) * 1024 + g * 64 + 32 * db + 8 * gg + 4 * hf); }
      LDS_WAIT(); __syncthreads();
#pragma unroll
      for (int tb = 0; tb < 2; ++tb) { const int nks = 4 * rh + 2 * tb + 2; const size_t tk = tok0 + 64 * rh + 32 * tb + r;
#pragma unroll
        for (int db = 0; db < 2; ++db) { f32x16 D = {};
#pragma unroll
            for (int s = 0; s < 8; ++s) if (s < nks) {
                const v4i16_t lo = __builtin_amdgcn_ds_read_tr16_b64_v4i16((LAS v4i16_t*)(VN + troff + (16 * s) * VPB + 64 * db));
                const v4i16_t hi = __builtin_amdgcn_ds_read_tr16_b64_v4i16((LAS v4i16_t*)(VN + troff + (16 * s + 4) * VPB + 64 * db));
                typedef short s16x8 __attribute__((ext_vector_type(8)));
                const s16x8 av = {lo[0], lo[1], lo[2], lo[3], hi[0], hi[1], hi[2], hi[3]};
                D = __builtin_amdgcn_mfma_f32_32x32x16_f16(__builtin_bit_cast(h16x8, av), wf[tb][s], D, 0, 0, 0); }
#pragma unroll
            for (int gg = 0; gg < 4; ++gg) { const u32x2 uv2 = uu[tb][db][gg]; const float bb = bsv[tb];
                const float y0 = gelu_tanh_f(h2f_lo(uv2.x)) * (D[4 * gg] + bb), y1 = gelu_tanh_f(h2f_hi(uv2.x)) * (D[4 * gg + 1] + bb), y2 = gelu_tanh_f(h2f_lo(uv2.y)) * (D[4 * gg + 2] + bb), y3 = gelu_tanh_f(h2f_hi(uv2.y)) * (D[4 * gg + 3] + bb);
                *(GAS u32x2*)(QY + tk * 1024 + 512 + g * 64 + 32 * db + 8 * gg + 4 * hf) = (u32x2){pkh(y0, y1), pkh(y2, y3)}; } } } }
    __syncthreads();
}

constexpr int C_KIB = 0, C_KIBUF = 256 * 128;
constexpr int C_QL = 0, C_QLW = KVP * 2 * 32;
constexpr int C_WQ = 81920;
constexpr int C_KVS = 90112, C_KVSLOT = 10240;

__device__ __forceinline__ void phaseC_select(const Frame& F, int l, int b, int qt, int pmode = 0) {
    unsigned char* ws = F.ws; asm volatile("" : "+s"(ws)); ws = (unsigned char*)(GAS unsigned char*)ws;     int lane = lane_id(), tid = F.wave * 64 + lane; asm volatile("" : "+v"(lane), "+v"(tid)); const int w = F.wave, r = lane & 31, hf = lane >> 5;
    const h16* QI = (const h16*)(ws + WS_QI); const h16* KI = (const h16*)(ws + WS_KI); const float* WI = (const float*)(ws + WS_WI); const float* CS = (const float*)(ws + WS_CS);
    h16* QY = (h16*)(ws + WS_QY); const h16* KV = (const h16*)(ws + WS_KV);
    const h16* WUKT = (const h16*)(ws + WS_SMALLW + (size_t)l * SMALLW_LAYER); const h16* WUVT = (const h16*)(ws + WS_SMALLW + (size_t)l * SMALLW_LAYER + 98304);
    LAS unsigned char* lds = F.lds;
    const int t0 = 32 * qt, NT = qt + 1; const size_t tokbase = (size_t)b * SEQ;
    h16x8 afr[4]; float wreg[16];
    { const int qq = 2 * ((r >> 2) & 1) + (r >> 4), head = (r & 3) + 4 * ((r >> 3) & 1); const size_t tokA = tokbase + t0 + 4 * w + qq;
      const h16* qsrc = QI + tokA * 512 + head * 64;
      { float o[8]; rope8(*(const GAS h16x8*)(qsrc), *(const GAS h16x8*)(qsrc + 8), CS + tokA * 16, hf, 1.0f, o); afr[0] = __builtin_bit_cast(h16x8, pack8(o)); }
#pragma unroll
      for (int s = 1; s < 4; ++s) afr[s] = *(const GAS h16x8*)(qsrc + 16 * s + 8 * hf);
      const float* wp = WI + (tokbase + t0 + 4 * w + 2 * hf) * 8;
#pragma unroll
      for (int R4 = 0; R4 < 4; ++R4) { const f32x4 wv = *(const GAS f32x4*)(wp + 4 * R4); wreg[4 * R4] = wv.x; wreg[4 * R4 + 1] = wv.y; wreg[4 * R4 + 2] = wv.z; wreg[4 * R4 + 3] = wv.w; } }
    float SC[128];
    const float QNAN = __uint_as_float(0x7fc00000u);
#pragma unroll
    for (int i = 0; i < 128; ++i) SC[i] = QNAN;
    const int NCK = (NT + 7) >> 3, tq0 = t0 + 4 * w + 2 * hf;
    const int drow = lane >> 3, dslot = lane & 7;
    const h16* kisrc = KI + (tokbase + 32 * w + drow) * 64 + 8 * (dslot ^ drow);
#define KI_STAGE(ck_, buf_) do { _Pragma("unroll") for (int i_ = 0; i_ < 4; ++i_) \
        __builtin_amdgcn_global_load_lds((const unsigned*)(kisrc + (size_t)(256 * (ck_) + 8 * i_) * 64), (LAS unsigned*)(lds + C_KIB + (buf_) * C_KIBUF + (4 * w + i_) * 1024), 16, 0, 0); } while (0)
    KI_STAGE(0, 0);
    VM_WAIT(); __syncthreads();
    const int kroff = r * 128, kx = r & 7;
#pragma unroll 1
    for (int ck = 0; ck < NCK; ++ck) {
        LAS unsigned char* kb = lds + C_KIB + (ck & 1) * C_KIBUF;
        if (ck + 1 < NCK) KI_STAGE(ck + 1, (ck + 1) & 1);
#pragma unroll
        for (int i = 0; i < 112; ++i) SC[i] = SC[i + 16];
#pragma unroll
        for (int jj = 0; jj < 8; ++jj) { if (pmode & 1) { SC[112 + 2 * jj] = (float)(ck + jj + r) * 0.01f; SC[113 + 2 * jj] = (float)(ck - jj + r) * 0.01f; continue; }
            f32x16 D = {};
#pragma unroll
            for (int s = 0; s < 4; ++s) { const h16x8 bb = *(const LAS h16x8*)(kb + jj * 4096 + kroff + 16 * ((2 * s + hf) ^ kx)); D = __builtin_amdgcn_mfma_f32_32x32x16_f16(afr[s], bb, D, 0, 0, 0); }
            float s0 = 0.f, s1 = 0.f;
#pragma unroll
            for (int R = 0; R < 8; ++R) { s0 = fmaf(wreg[R], fmaxf(D[R], 0.f), s0); s1 = fmaf(wreg[8 + R], fmaxf(D[8 + R], 0.f), s1); }
            const int k = 256 * ck + 32 * jj + r;
            SC[112 + 2 * jj] = (k > tq0) ? QNAN : s0; SC[113 + 2 * jj] = (k > tq0 + 1) ? QNAN : s1;
        }
        LDS_WAIT(); VM_WAIT(); __syncthreads();
    }
#undef KI_STAGE
    const int G0 = 8 - NCK;
#define SEL_COUNT2(c0, c1, FN, m0, m1) do { int a0_ = 0, a1_ = 0; \
        _Pragma("unroll") for (int g = 0; g < 8; ++g) if (g >= G0) FN(a0_, a1_, &SC[16 * g], (m0), (m1)); \
        c0 = half_sum_dpp(a0_, hf); c1 = half_sum_dpp(a1_, hf); } while (0)
    float tau0 = -3.0e38f, tau1 = -3.0e38f;
    if (qt >= 8 && !(pmode & 2)) {
        float lo0 = INFINITY, lo1 = INFINITY, hi0 = -INFINITY, hi1 = -INFINITY;
#pragma unroll
        for (int j = 0; j < 64; ++j) { const float a = SC[2 * j], c = SC[2 * j + 1]; lo0 = fminf(lo0, a); hi0 = fmaxf(hi0, a); lo1 = fminf(lo1, c); hi1 = fmaxf(hi1, c); }
#pragma unroll
        for (int o = 1; o < 32; o <<= 1) { lo0 = fminf(lo0, __shfl_xor(lo0, o)); lo1 = fminf(lo1, __shfl_xor(lo1, o)); hi0 = fmaxf(hi0, __shfl_xor(hi0, o)); hi1 = fmaxf(hi1, __shfl_xor(hi1, o)); }
        int cl0 = tq0 + 1, cl1 = tq0 + 2, ch0 = 1, ch1 = 1;
        bool done0 = false, done1 = false;
        { int g0, g1; const float zero = 0.f; SEL_COUNT2(g0, g1, cnt_group_gt, zero, zero);
          const float tiny = __uint_as_float(1u);
          if (__any(g0 < 256 || g1 < 256)) { int e0, e1; SEL_COUNT2(e0, e1, cnt_group_ge, zero, zero);
              if (g0 < 256) { if (e0 >= 256) { lo0 = 0.f; done0 = true; } else { hi0 = 0.f; ch0 = e0; } }
              if (g1 < 256) { if (e1 >= 256) { lo1 = 0.f; done1 = true; } else { hi1 = 0.f; ch1 = e1; } } }
          if (g0 >= 256) { lo0 = tiny; cl0 = g0; if (g0 == 256) done0 = true; }
          if (g1 >= 256) { lo1 = tiny; cl1 = g1; if (g1 == 256) done1 = true; } }
#define SEL_STEP(c0, c1, mid0, mid1) do { \
            if (!done0) { if (c0 >= 256) { lo0 = mid0; cl0 = c0; if (c0 == 256) done0 = true; } else { hi0 = mid0; ch0 = c0; } } \
            if (!done1) { if (c1 >= 256) { lo1 = mid1; cl1 = c1; if (c1 == 256) done1 = true; } else { hi1 = mid1; ch1 = c1; } } } while (0)
#define SEL_EXHAUSTED(bis0, bis1) do { if (!done0 && (bis0 <= lo0 || bis0 >= hi0)) done0 = true; if (!done1 && (bis1 <= lo1 || bis1 >= hi1)) done1 = true; } while (0)
        bool compact = true;
#pragma unroll 1
        for (int it = 0; it < ((pmode & 16) ? 6 : 40); ++it) {
            const float bis0 = 0.5f * (lo0 + hi0), bis1 = 0.5f * (lo1 + hi1);
            SEL_EXHAUSTED(bis0, bis1);
            if (__all((done0 || (compact && cl0 - ch0 <= 48)) && (done1 || (compact && cl1 - ch1 <= 48)))) break;
            int c0, c1; SEL_COUNT2(c0, c1, cnt_group_ge, bis0, bis1);
            SEL_STEP(c0, c1, bis0, bis1);
            if (it == 39) { done0 = true; done1 = true; }
        }
        if (!__all(done0 && done1)) {
            LAS float* L0 = (LAS float*)(lds + w * 4096 + (2 * hf) * 1024 + r * 32); LAS float* L1 = L0 + 256;
            { const f32x4 qn = {QNAN, QNAN, QNAN, QNAN}; *(LAS f32x4*)L0 = qn; *(LAS f32x4*)(L0 + 4) = qn; *(LAS f32x4*)L1 = qn; *(LAS f32x4*)(L1 + 4) = qn; }
            int n0 = 0, n1 = 0;
#pragma unroll
            for (int g = 0; g < 8; ++g) if (g >= G0) {
#pragma unroll
                for (int jj = 0; jj < 8; ++jj) { const int j = 8 * g + jj; const float v0 = SC[2 * j], v1 = SC[2 * j + 1];
                    if (!done0 && v0 >= lo0 && v0 < hi0) { if (n0 < 8) L0[n0] = v0; ++n0; }
                    if (!done1 && v1 >= lo1 && v1 < hi1) { if (n1 < 8) L1[n1] = v1; ++n1; } } }
            LDS_WAIT();
            float CAND[16];
            { const f32x4 a0 = *(const LAS f32x4*)L0, a1 = *(const LAS f32x4*)(L0 + 4), b0 = *(const LAS f32x4*)L1, b1 = *(const LAS f32x4*)(L1 + 4);
#pragma unroll
              for (int i = 0; i < 4; ++i) { CAND[2 * i] = a0[i]; CAND[8 + 2 * i] = a1[i]; CAND[2 * i + 1] = b0[i]; CAND[8 + 2 * i + 1] = b1[i]; } }
            LDS_WAIT();
            if (__any(n0 > 8 || n1 > 8)) {
#pragma unroll 1
                for (int it = 0; it < 40; ++it) {
                    const float bis0 = 0.5f * (lo0 + hi0), bis1 = 0.5f * (lo1 + hi1);
                    SEL_EXHAUSTED(bis0, bis1);
                    if (__all(done0 && done1)) break;
                    int c0, c1; SEL_COUNT2(c0, c1, cnt_group_ge, bis0, bis1);
                    SEL_STEP(c0, c1, bis0, bis1);
                }
            } else {
                const int cb0 = ch0, cb1 = ch1;
#pragma unroll 1
                for (int it = 0; it < ((pmode & 16) ? 3 : 48); ++it) {
                    const float bis0 = 0.5f * (lo0 + hi0), bis1 = 0.5f * (lo1 + hi1);
                    SEL_EXHAUSTED(bis0, bis1);
                    if (__all(done0 && done1)) break;
                    float mid0 = bis0, mid1 = bis1;
                    if ((it % 3) != 2) { const float i0 = lo0 + ((float)cl0 - 255.5f) / (float)(cl0 - ch0) * (hi0 - lo0), i1 = lo1 + ((float)cl1 - 255.5f) / (float)(cl1 - ch1) * (hi1 - lo1);
                        if (i0 > lo0 && i0 < hi0) mid0 = i0; if (i1 > lo1 && i1 < hi1) mid1 = i1; }
                    int a0 = 0, a1 = 0; cnt_group_ge(a0, a1, CAND, mid0, mid1);
                    const int c0 = cb0 + half_sum_dpp(a0, hf), c1 = cb1 + half_sum_dpp(a1, hf);
                    SEL_STEP(c0, c1, mid0, mid1);
                }
            }
        }
#undef SEL_STEP
#undef SEL_EXHAUSTED
        tau0 = lo0; tau1 = lo1;
    }
#undef SEL_COUNT2
    unsigned w00 = 0u, w01 = 0u, w10 = 0u, w11 = 0u;
#pragma unroll
    for (int g = 0; g < 8; ++g) if (g >= G0 && !(pmode & 4)) {
#pragma unroll
        for (int jj = 0; jj < 8; ++jj) { const int j = 8 * g + jj, jt = 8 * (g - G0) + jj;
            ballot_ge_to_lane(w00, w10, SC[2 * j], tau0, jt); ballot_ge_to_lane(w01, w11, SC[2 * j + 1], tau1, jt); } }
    { LAS unsigned* WQ = (LAS unsigned*)(lds + C_WQ);
      WQ[(4 * w + 0) * 64 + lane] = w00; WQ[(4 * w + 1) * 64 + lane] = w01; WQ[(4 * w + 2) * 64 + lane] = w10; WQ[(4 * w + 3) * 64 + lane] = w11; }
    LDS_WAIT(); __syncthreads();
}

__device__ __forceinline__ void phaseC_attn(const Frame& F, int l, int b, int qt, bool do_store = true, int pmode = 0) {
    unsigned char* ws = F.ws; asm volatile("" : "+s"(ws)); ws = (unsigned char*)(GAS unsigned char*)ws;     const int w = F.wave;
    int lane = lane_id(), tid = F.wave * 64 + lane; asm volatile("" : "+v"(lane), "+v"(tid));
    const int r = lane & 31, hf = lane >> 5;
    const float* CS = (const float*)(ws + WS_CS);
    h16* QY = (h16*)(ws + WS_QY); const h16* KV = (const h16*)(ws + WS_KV);
    const h16* WUKT = (const h16*)(ws + WS_SMALLW + (size_t)l * SMALLW_LAYER); const h16* WUVT = (const h16*)(ws + WS_SMALLW + (size_t)l * SMALLW_LAYER + 98304);
    LAS unsigned char* lds = F.lds;
    const int t0 = 32 * qt, NT = qt + 1; const size_t tokbase = (size_t)b * SEQ;
    const int h = w; const size_t tokQ = tokbase + t0 + r;
    LAS h16* ql = (LAS h16*)(lds + C_QL + w * C_QLW);
    if (!(pmode & 64)) { h16x8 bq[3];
#pragma unroll
      for (int s = 0; s < 3; ++s) bq[s] = *(const GAS h16x8*)(QY + tokQ * 1024 + h * 64 + 16 + 16 * s + 8 * hf);
#pragma unroll
      for (int cb = 0; cb < 4; ++cb) { f32x16 D = {};
#pragma unroll
          for (int s = 0; s < 3; ++s) { const h16x8 a = *(const GAS h16x8*)(WUKT + ((size_t)(h * 128 + 32 * cb + r)) * 48 + 16 * s + 8 * hf); D = __builtin_amdgcn_mfma_f32_32x32x16_f16(a, bq[s], D, 0, 0, 0); }
#pragma unroll
          for (int g = 0; g < 4; ++g) { const int c = 32 * cb + 8 * g + 4 * hf;
              *(LAS u32x2*)(ql + r * KVP + c) = (u32x2){pkh(D[4 * g] * QSCALE, D[4 * g + 1] * QSCALE), pkh(D[4 * g + 2] * QSCALE, D[4 * g + 3] * QSCALE)}; } }
      { float o[8]; rope8(*(const GAS h16x8*)(QY + tokQ * 1024 + h * 64), *(const GAS h16x8*)(QY + tokQ * 1024 + h * 64 + 8), CS + tokQ * 16, hf, QSCALE, o); *(LAS u32x4*)(ql + r * KVP + 128 + 8 * hf) = pack8(o); } }
    LDS_WAIT();
    h16x8 qfr[9];
#pragma unroll
    for (int s = 0; s < 9; ++s) qfr[s] = *(const LAS h16x8*)(ql + r * KVP + 16 * s + 8 * hf);
    const char* kvsrc = (const char*)(KV + tokbase * KVP) + (size_t)(64 * w + lane) * 16;
    const unsigned kvdst = (unsigned)(uintptr_t)(lds + C_KVS) + (unsigned)w * 1024u;
    const int grp = w >> 2;
#define KV_DMA1(src_, dst_) do { unsigned keep_; asm volatile("s_mov_b32 %0, m0\n\ts_mov_b32 m0, %2\n\ts_nop 0\n\tglobal_load_lds_dwordx4 %1, off\n\ts_mov_b32 m0, %0" : "=&s"(keep_) : "v"(src_), "s"(dst_) : "memory"); } while (0)
#define KV_DMA(t_) do { const char* s_ = kvsrc + (size_t)(t_) * (32 * KVP * 2); const unsigned d_ = (unsigned)__builtin_amdgcn_readfirstlane((int)(kvdst + (unsigned)((t_) % 5) * (unsigned)C_KVSLOT)); \
        KV_DMA1(s_, d_); if (w < 2) { const char* s2_ = s_ + 8192; const unsigned d2_ = d_ + 8192u; KV_DMA1(s2_, d2_); } } while (0)
#define KV_WAIT(n_) do { if ((n_) <= 0) asm volatile("s_waitcnt vmcnt(0)" ::: "memory"); else if ((n_) == 1) { if (w < 2) asm volatile("s_waitcnt vmcnt(2)" ::: "memory"); else asm volatile("s_waitcnt vmcnt(1)" ::: "memory"); } \
        else { if (w < 2) asm volatile("s_waitcnt vmcnt(4)" ::: "memory"); else asm volatile("s_waitcnt vmcnt(2)" ::: "memory"); } } while (0)
    KV_DMA(0); if (NT > 1) KV_DMA(1); if (NT > 2) KV_DMA(2); if (NT > 3) KV_DMA(3);
    asm volatile("s_waitcnt vmcnt(0)" ::: "memory");
    asm volatile("s_waitcnt lgkmcnt(0)" ::: "memory"); __builtin_amdgcn_s_barrier(); asm volatile("" ::: "memory");
    float mrun = 0.f, lrun = 0.f; f32x16 O[4]; f32x16 negm;
#pragma unroll
    for (int db = 0; db < 4; ++db) O[db] = (f32x16){};
#pragma unroll
    for (int R = 0; R < 16; ++R) negm[R] = 0.f;
    const LAS unsigned* WQr = (const LAS unsigned*)(lds + C_WQ) + r * 64;
    const int troff = ((lane & 15) >> 2) * (KVP * 2) + (16 * ((lane >> 4) & 1) + 4 * (lane & 3)) * 2 + 4 * hf * (KVP * 2);
    const int kbase = (int)(uintptr_t)(lds + C_KVS) + r * (KVP * 2) + 16 * hf, vbase = (int)(uintptr_t)(lds + C_KVS) + troff;
    typedef short s16x8 __attribute__((ext_vector_type(8)));
#define AT_MAX3(a_, b_, c_) ({ float r_; asm("v_max3_f32 %0, %1, %2, %3" : "=v"(r_) : "v"(a_), "v"(b_), "v"(c_)); r_; })
#define AT_MASKED(e_, w_, pos_) ({ int t_, r_; asm("v_bfe_i32 %0, %2, %3, 1\n\tv_and_b32 %1, %4, %0" : "=&v"(t_), "=v"(r_) : "v"(w_), "n"(pos_), "v"(e_)); __int_as_float(r_); })
#define AT_KLOAD(so_) h16x8 kfr[9]; do { const LAS unsigned char* sl_ = (const LAS unsigned char*)(uintptr_t)(kbase + (so_)); \
        if (!(pmode & 16)) { _Pragma("unroll") for (int s = 0; s < 9; ++s) kfr[s] = *(const LAS h16x8*)(sl_ + 32 * s); } else { _Pragma("unroll") for (int s = 0; s < 9; ++s) kfr[s] = qfr[s]; } __builtin_amdgcn_sched_barrier(0); } while (0)
#define AT_QK(S_) do { S_ = negm; if (!(pmode & 16)) { _Pragma("unroll") for (int s = 0; s < 9; ++s) S_ = __builtin_amdgcn_mfma_f32_32x32x16_f16(kfr[s], qfr[s], S_, 0, 0, 0); } } while (0)
#define AT_VLOAD(db0_) do { _Pragma("unroll") for (int db = 0; db < 2; ++db) _Pragma("unroll") for (int sp = 0; sp < 2; ++sp) { \
            vlo_[db][sp] = __builtin_amdgcn_ds_read_tr16_b64_v4i16((LAS v4i16_t*)(sl_ + (16 * sp) * (KVP * 2) + 64 * ((db0_) + db))); \
            vhi_[db][sp] = __builtin_amdgcn_ds_read_tr16_b64_v4i16((LAS v4i16_t*)(sl_ + (16 * sp + 8) * (KVP * 2) + 64 * ((db0_) + db))); } } while (0)
#define AT_PV2(db0_) do { _Pragma("unroll") for (int db = 0; db < 2; ++db) _Pragma("unroll") for (int sp = 0; sp < 2; ++sp) { \
            const s16x8 av_ = {vlo_[db][sp][0], vlo_[db][sp][1], vlo_[db][sp][2], vlo_[db][sp][3], vhi_[db][sp][0], vhi_[db][sp][1], vhi_[db][sp][2], vhi_[db][sp][3]}; \
            O[(db0_) + db] = __builtin_amdgcn_mfma_f32_32x32x16_f16(__builtin_bit_cast(h16x8, av_), pf_[sp], O[(db0_) + db], 0, 0, 0); } } while (0)
#define AT_SMPV(S_, t_, so_) do { const LAS unsigned char* sl_ = (const LAS unsigned char*)(uintptr_t)(vbase + (so_)); \
        v4i16_t vlo_[2][2], vhi_[2][2]; \
        AT_VLOAD(0); \
        const int wq_ = (int)(WQr[(t_)] >> (4 * hf)); \
        __builtin_amdgcn_sched_barrier(0); \
        float mt_ = AT_MAX3(S_[0], S_[1], S_[2]); \
        _Pragma("unroll") for (int R = 3; R < 15; R += 2) mt_ = AT_MAX3(mt_, S_[R], S_[R + 1]); \
        mt_ = half_swap_max(AT_MAX3(mt_, S_[15], S_[15])); \
        if ((t_) == 0 || __any(mt_ > 8.0f)) { const float dl_ = (t_) == 0 ? mt_ : fmaxf(mt_, 0.f), alpha_ = (t_) == 0 ? 1.f : __builtin_amdgcn_exp2f(-dl_);     \
            _Pragma("unroll") for (int db = 0; db < 4; ++db) O[db] = O[db] * alpha_; \
            _Pragma("unroll") for (int R = 0; R < 16; ++R) S_[R] -= dl_; \
            lrun *= alpha_; mrun += dl_; \
            _Pragma("unroll") for (int R = 0; R < 16; ++R) negm[R] = -mrun; } \
        float p_[16]; \
        if (!(pmode & 1)) { _Pragma("unroll") for (int R = 0; R < 16; ++R) { const float e_ = __builtin_amdgcn_exp2f(S_[R]); p_[R] = AT_MASKED(e_, wq_, (R & 3) + 8 * (R >> 2)); lrun += p_[R]; } } \
        else { _Pragma("unroll") for (int R = 0; R < 16; ++R) p_[R] = S_[R]; lrun += p_[0]; } \
        h16x8 pf_[2]; \
        _Pragma("unroll") for (int sp = 0; sp < 2; ++sp) { u32x4 t4_; t4_.x = pkz(p_[8 * sp], p_[8 * sp + 1]); t4_.y = pkz(p_[8 * sp + 2], p_[8 * sp + 3]); t4_.z = pkz(p_[8 * sp + 4], p_[8 * sp + 5]); t4_.w = pkz(p_[8 * sp + 6], p_[8 * sp + 7]); pf_[sp] = __builtin_bit_cast(h16x8, t4_); } \
        __builtin_amdgcn_sched_barrier(0); \
        if (!(pmode & 2)) { AT_PV2(0); \
        __builtin_amdgcn_sched_barrier(0); \
        AT_VLOAD(2); \
        __builtin_amdgcn_sched_barrier(0); \
        AT_PV2(2); } else { O[0][0] += (float)pf_[0][0] + (float)pf_[1][0]; } } while (0)
#define AT_BOUNDARY2(g_) do {   \
        if (!(pmode & 4)) { asm volatile("s_waitcnt vmcnt(0) lgkmcnt(0)" ::: "memory"); __builtin_amdgcn_s_barrier(); asm volatile("" ::: "memory"); \
        if (2 * (g_) + 4 < NT) KV_DMA(2 * (g_) + 4); if (2 * (g_) + 5 < NT) KV_DMA(2 * (g_) + 5); } } while (0)
#define AT_NEXT(so_) ((so_) == 4 * C_KVSLOT ? 0 : (so_) + C_KVSLOT)
    const int NG = (NT + 1) >> 1;
    if (grp == 0) {
        int so = 0;
#pragma unroll 1
        for (int g = 0; g < NG; ++g) { const int t = 2 * g;
            { f32x16 Sx; AT_KLOAD(so); AT_QK(Sx); __builtin_amdgcn_sched_barrier(0); AT_SMPV(Sx, t, so); so = AT_NEXT(so); }
            if (t + 1 < NT) { f32x16 Sx; AT_KLOAD(so); AT_QK(Sx); __builtin_amdgcn_sched_barrier(0); AT_SMPV(Sx, t + 1, so); so = AT_NEXT(so); }
            AT_BOUNDARY2(g); }
    } else {
        f32x16 Sx; int so = 0, sop = 0;
        { AT_KLOAD(so); AT_QK(Sx); } sop = so; so = AT_NEXT(so);
        if (1 < NT) { AT_SMPV(Sx, 0, sop); __builtin_amdgcn_sched_barrier(0); { AT_KLOAD(so); AT_QK(Sx); } sop = so; so = AT_NEXT(so); }
        AT_BOUNDARY2(0);
#pragma unroll 1
        for (int g = 1; g < NG; ++g) { const int t = 2 * g;
            AT_SMPV(Sx, t - 1, sop); __builtin_amdgcn_sched_barrier(0); { AT_KLOAD(so); AT_QK(Sx); } sop = so; so = AT_NEXT(so);
            if (t + 1 < NT) { AT_SMPV(Sx, t, sop); __builtin_amdgcn_sched_barrier(0); { AT_KLOAD(so); AT_QK(Sx); } sop = so; so = AT_NEXT(so); }
            AT_BOUNDARY2(g); }
        AT_SMPV(Sx, NT - 1, sop);
    }
#undef AT_NEXT
#undef AT_MAX3
#undef AT_MASKED
#undef AT_BOUNDARY2
#undef KV_DMA
#undef KV_DMA1
#undef KV_WAIT
#undef AT_KLOAD
#undef AT_QK
#undef AT_SMPV
#undef AT_VLOAD
#undef AT_PV2
    if (!(pmode & 32)) {
    h16x8 bwv[2][8];
#pragma unroll
    for (int d2 = 0; d2 < 2; ++d2)
#pragma unroll
        for (int s = 0; s < 8; ++s) bwv[d2][s] = *(const GAS h16x8*)(WUVT + ((size_t)(h * 64 + 32 * d2 + r)) * 128 + 16 * s + 8 * hf);
    { const float inv = 1.0f / half_swap_sum(lrun);
#pragma unroll
      for (int db = 0; db < 4; ++db)
#pragma unroll
          for (int g = 0; g < 4; ++g) { const int c = 32 * db + 8 * g + 4 * hf;
              *(LAS u32x2*)(ql + r * KVP + c) = (u32x2){pkh(O[db][4 * g] * inv, O[db][4 * g + 1] * inv), pkh(O[db][4 * g + 2] * inv, O[db][4 * g + 3] * inv)}; } }
    LDS_WAIT();
    { h16x8 ao[8];
#pragma unroll
      for (int s = 0; s < 8; ++s) ao[s] = *(const LAS h16x8*)(ql + r * KVP + 16 * s + 8 * hf);
#pragma unroll
      for (int d2 = 0; d2 < 2; ++d2) { f32x16 D = {};
#pragma unroll
          for (int s = 0; s < 8; ++s) D = __builtin_amdgcn_mfma_f32_32x32x16_f16(ao[s], bwv[d2][s], D, 0, 0, 0);
#pragma unroll
          for (int R = 0; R < 16; ++R) { if (do_store) ((GAS h16*)QY)[(tokbase + t0 + crow(R, hf)) * 1024 + h * 64 + 32 * d2 + r] = (h16)D[R]; else asm volatile("" :: "v"(D[R])); } } }
    } else { asm volatile("" :: "v"(O[0][0]), "v"(O[1][0]), "v"(O[2][0]), "v"(O[3][0]), "v"(lrun)); }
    LDS_WAIT(); __syncthreads();
}

__device__ __forceinline__ void phaseC(const Frame& F, int l) {
    int vc = F.vcu; asm volatile("" : "+s"(vc)); const int b = vc >> 5, i = vc & 31;
#pragma unroll 1
    for (int u = 0; u < 2; ++u) { const int qt = (u == 0) ? 63 - i : i;
#if defined(PROBE_C_SEL)
#pragma unroll 1
        for (int rep = 0; rep < 2; ++rep)
        phaseC_select(F, l, b, qt, rep == 0 ? PROBE_C_SEL : 0);
#else
        phaseC_select(F, l, b, qt);
#endif
#if defined(PROBE_C_ATT)
#pragma unroll 1
        for (int rep = 0; rep < 2; ++rep) phaseC_attn(F, l, b, qt, rep == 1, rep == 1 ? 0 : PROBE_C_ATT);
#else
        phaseC_attn(F, l, b, qt);
#endif
    }
}
#if defined(PROBE_STORE)
#define PROBE_NOSTORE(f) (f)
#else
#define PROBE_NOSTORE(f) 0
#endif
#if defined(PROBE_EPI)
#define PROBE_NOEPI(f) (f)
#else
#define PROBE_NOEPI(f) 0
#endif
#ifndef PROBE_MASK
#define PROBE_MASK 0u
#endif
#ifndef MK_N_LAUNCHES
#define MK_N_LAUNCHES 1
#endif
constexpr int N_PHASES = 2 + 7 * NLAYER;
constexpr int CONV_SPLIT = 2150;
struct Args { In in; float* out; unsigned char* ws; int ph_lo, ph_hi, flags, pad; };

__global__ void __launch_bounds__(NTHREADS, 2) mk_fwd(Args args) {
    extern __shared__ __attribute__((aligned(16))) unsigned char lds_raw[];
    Frame F; F.lds = (LAS unsigned char*)lds_raw; F.wave = __builtin_amdgcn_readfirstlane((int)threadIdx.x >> 6);
    F.G = gridDim.x; { const int bx = blockIdx.x; F.vcu = (F.G % 8 == 0) ? (bx % 8) * (F.G / 8) + bx / 8 : bx; }
    F.ws = args.ws; F.in = nullptr;
    const In& I = args.in; unsigned char* ws = args.ws; (void)ws;
    volatile LAS unsigned* MISCW = (volatile LAS unsigned*)(F.lds + LDS_MISC);
    if (F.wave == 0) MISCW[lane_id()] = 0u;
    __syncthreads();
#if MK_N_LAUNCHES == 1
    const bool one_launch = true;
#else
    const bool one_launch = (args.ph_hi - args.ph_lo) > 1;
#endif
    XcdBarrier bar; bar.bar = (unsigned*)(ws + WS_CTL) + 1024; bar.x = 0; bar.st = nullptr;
    if (one_launch) bar = xcd_barrier_post((unsigned*)(ws + WS_CTL) + 1024, MISCW + 8, F.wave);
#if MK_N_LAUNCHES == 1
#define IN(k) true
#define SEAM(k) xcd_barrier(bar, F.wave)
#else
#define IN(k) (args.ph_lo <= (k) && (k) < args.ph_hi)
#define SEAM(k) do { if (IN(k) && IN((k) + 1)) xcd_barrier(bar, F.wave); } while (0)
#endif
    if (IN(0)) { p0_prologue(F, I); SEAM(0); }
#define OPQ(x) asm volatile("" : "+s"(x))
#pragma unroll 1
    for (int l0 = 0; l0 < NLAYER; ++l0) {
        const int p = 1 + 7 * l0;
        if (IN(p)) {
            unsigned char* wsq = args.ws; int l = l0; OPQ(wsq); OPQ(l); wsq = (unsigned char*)(GAS unsigned char*)wsq; unsigned char* wl = wsq + WS_W + (size_t)l * W_LAYER;
            pg8::Gemm g{(const h16*)(wsq + WS_X16), (const h16*)(wl + W_OFF_IN), 1024, 1024, 1024, M / 256, NZ / 256, 1, 0, PROBE_NOEPI(args.flags), 0};
            pg8::Order S; S.init(g.nM, g.nN, F.G, (int)blockIdx.x, 1); EpiA E{wsq, PROBE_NOSTORE(args.flags), (LAS float*)(F.lds + 131072 + 4096)};
            pg8::gemm_phase<EpiA>(F.lds, g, S, E, F.wave);
            { constexpr int NBIG = ((M / 256) * (NZ / 256)) % 256;
              if (l + 1 < NLAYER && (int)blockIdx.x >= NBIG && F.G == 256) convert_layer_weights(F, I, l + 1, ((int)blockIdx.x - NBIG) * NWAVES + F.wave, (256 - NBIG) * NWAVES, 0, CONV_SPLIT);
              else if (l + 1 < NLAYER && F.G != 256) { xcd_barrier(bar, F.wave); convert_layer_weights(F, I, l + 1, F.vcu * NWAVES + F.wave, F.G * NWAVES); } }
            SEAM(p); }
        if (IN(p + 1)) { int l = l0; OPQ(l); phaseB(F, I, l); SEAM(p + 1); }
        if (IN(p + 2)) { int l = l0; OPQ(l); phaseC(F, l); SEAM(p + 2); }
        if (IN(p + 3)) {
            unsigned char* wsq = args.ws; int l = l0; OPQ(wsq); OPQ(l); wsq = (unsigned char*)(GAS unsigned char*)wsq; unsigned char* wl = wsq + WS_W + (size_t)l * W_LAYER;
            pg8::Gemm g{(const h16*)(wsq + WS_QY), (const h16*)(wl + W_OFF_PAB), 1024, 1024, 512, M / 256, 4, 2, 512, PROBE_NOEPI(args.flags), 0};
            pg8::Order S; S.init(g.nM, g.nN, F.G, (int)blockIdx.x, 2); EpiD E{wsq, (h16*)args.out};
            pg8::gemm_phase<EpiD>(F.lds, g, S, E, F.wave); SEAM(p + 3); }
        if (IN(p + 4)) {
            unsigned char* wsq = args.ws; int l = l0; OPQ(wsq); OPQ(l); wsq = (unsigned char*)(GAS unsigned char*)wsq; unsigned char* wl = wsq + WS_W + (size_t)l * W_LAYER;
            pg8::Gemm g{(const h16*)args.out, (const h16*)(wl + W_OFF_OUT), 1024, 1024, 1024, M / 256, 4, 1, 0, PROBE_NOEPI(args.flags), 0};
            pg8::Order S; S.init(g.nM, g.nN, F.G, (int)blockIdx.x, 1);
            EpiRes E{(const h16*)(wsq + WS_X16), (h16*)(wsq + WS_X1), (float*)(wsq + WS_SSQ), (LAS float*)(F.lds + 131072)};
            pg8::gemm_phase<EpiRes>(F.lds, g, S, E, F.wave); SEAM(p + 4); }
        if (IN(p + 5)) {
            unsigned char* wsq = args.ws; int l = l0; OPQ(wsq); OPQ(l); wsq = (unsigned char*)(GAS unsigned char*)wsq; unsigned char* wl = wsq + WS_W + (size_t)l * W_LAYER;
            pg8::Gemm g{(const h16*)(wsq + WS_X1), (const h16*)(wl + W_OFF_GU), 1024, 1024, 1024, M / 256, NGU / 256, 1, 0, PROBE_NOEPI(args.flags), 0};
            pg8::Order S; S.init(g.nM, g.nN, F.G, (int)blockIdx.x, 1); EpiF E{wsq, (LAS float*)(F.lds + 131072 + 4096)};
            pg8::gemm_phase<EpiF>(F.lds, g, S, E, F.wave);
            { constexpr int NBIG = ((M / 256) * (NGU / 256)) % 256;
              if (l + 1 < NLAYER && (int)blockIdx.x >= NBIG && F.G == 256) convert_layer_weights(F, I, l + 1, ((int)blockIdx.x - NBIG) * NWAVES + F.wave, (256 - NBIG) * NWAVES, CONV_SPLIT, 1 << 30); }
            SEAM(p + 5); }
        if (IN(p + 6)) {
            unsigned char* wsq = args.ws; int l = l0; OPQ(wsq); OPQ(l); wsq = (unsigned char*)(GAS unsigned char*)wsq; unsigned char* wl = wsq + WS_W + (size_t)l * W_LAYER;
            pg8::Gemm g{(const h16*)(wsq + WS_ACT), (const h16*)(wl + W_OFF_D), DFF, DFF, DFF, M / 256, 4, 1, 0, PROBE_NOEPI(args.flags), 0};
            pg8::Order S; S.init(g.nM, g.nN, F.G, (int)blockIdx.x, 1);
            EpiRes E{(const h16*)(wsq + WS_X1), (h16*)(wsq + WS_X16), (float*)(wsq + WS_SSQ), (LAS float*)(F.lds + 131072)};
            pg8::gemm_phase<EpiRes>(F.lds, g, S, E, F.wave); SEAM(p + 6); }
    }
    if (IN(N_PHASES - 1)) final_norm_phase(F, (const h16*)(args.ws + WS_X16), args.out, I.final_norm);
#undef IN
#undef SEAM
}

extern "C" void kernel_launch(void* const* d_in, const int* in_sizes, int n_in, void* d_out, int out_size, void* d_ws, size_t ws_size, hipStream_t stream) {
    static int grid = 0;
    if (grid == 0) {
        if (n_in != 19 || out_size != M * DM || ws_size < WS_END) { fprintf(stderr, "kernel_launch: unexpected shapes (n_in %d out %d ws %zu)\n", n_in, out_size, ws_size); grid = -1; return; }
        int dev = 0, cus = 0, per_cu = 0;
        hipGetDevice(&dev); hipDeviceGetAttribute(&cus, hipDeviceAttributeMultiprocessorCount, dev);
        hipFuncSetAttribute((const void*)mk_fwd, hipFuncAttributeMaxDynamicSharedMemorySize, LDS_BYTES);
        hipOccupancyMaxActiveBlocksPerMultiprocessor(&per_cu, (const void*)mk_fwd, NTHREADS, LDS_BYTES);
        (void)hipGetLastError();
        if (per_cu < 1) fprintf(stderr, "kernel_launch: occupancy query reports %d blocks per CU\n", per_cu);
        grid = cus;
    }
    if (grid < 0) return;
    hipMemsetAsync((char*)d_ws + WS_CTL, 0, CTL_ZERO_BYTES, stream);
    Args a{};
    const void** ip = (const void**)&a.in;
    for (int i = 0; i < 19; ++i) ip[i] = d_in[i];
    a.out = (float*)d_out; a.ws = (unsigned char*)d_ws;
#if MK_N_LAUNCHES == 1
    a.ph_lo = 0; a.ph_hi = N_PHASES;
    { void* kargs[] = {&a}; hipError_t e = hipLaunchCooperativeKernel((const void*)mk_fwd, dim3(grid), dim3(NTHREADS), kargs, LDS_BYTES, stream);
      if (e != hipSuccess) fprintf(stderr, "cooperative launch failed: %s (grid %d)\n", hipGetErrorString(e), grid); }
#else
    for (int p = 0; p < N_PHASES; ++p) { const int reps = ((PROBE_MASK >> p) & 1u) ? 2 : 1;
        for (int rr = 0; rr < reps; ++rr) { a.ph_lo = p; a.ph_hi = p + 1; a.flags = (rr > 0) ? 1 : 0; hipLaunchKernelGGL(mk_fwd, dim3(grid), dim3(NTHREADS), LDS_BYTES, stream, a); } }
#endif
}
```

```cpp
#define MK_N_LAUNCHES 1
#include <hip/hip_runtime.h>
#include <stdint.h>
#include <math.h>
#include <cstdio>

#define LAS __attribute__((address_space(3)))
#define GAS __attribute__((address_space(1)))
typedef _Float16 h16;
typedef h16 h16x8 __attribute__((ext_vector_type(8)));
typedef h16 h16x4 __attribute__((ext_vector_type(4)));
typedef h16 h16x2 __attribute__((ext_vector_type(2)));
typedef float f32x2 __attribute__((ext_vector_type(2)));
typedef float f32x4 __attribute__((ext_vector_type(4)));
typedef float f32x16 __attribute__((ext_vector_type(16)));
typedef unsigned u32x2 __attribute__((ext_vector_type(2)));
typedef unsigned u32x4 __attribute__((ext_vector_type(4)));
typedef short v4i16_t __attribute__((ext_vector_type(4)));

__device__ __forceinline__ int lane_id() { return (int)__builtin_amdgcn_mbcnt_hi(~0u, __builtin_amdgcn_mbcnt_lo(~0u, 0u)); }
__device__ __forceinline__ unsigned pkh(float lo, float hi) { h16x2 v = {(h16)lo, (h16)hi}; return __builtin_bit_cast(unsigned, v); }
__device__ __forceinline__ unsigned pkz(float lo, float hi) { return __builtin_bit_cast(unsigned, __builtin_amdgcn_cvt_pkrtz(lo, hi)); }
__device__ __forceinline__ void store16_wt(void* p, u32x4 v) { asm volatile("global_store_dwordx4 %0, %1, off sc1\n\ts_nop 1" :: "v"(p), "v"(v) : "memory"); }
__device__ __forceinline__ float h2f_lo(unsigned u) { h16x2 v = __builtin_bit_cast(h16x2, u); return (float)v[0]; }
__device__ __forceinline__ float h2f_hi(unsigned u) { h16x2 v = __builtin_bit_cast(h16x2, u); return (float)v[1]; }

namespace pg8 {
constexpr int BM = 256, BK = 64, HALF = 128, HTB = HALF * BK * 2, STAGE_BYTES = 8 * HTB, NXCD = 8, WGM = 4;
__host__ __device__ __forceinline__ int lds_byte(int r, int c) { const int st = (r >> 4) * 2 + (c >> 5), rr = r & 15, cc = c & 31, ob = rr * 64 + cc * 2; return st * 1024 + (ob ^ (((ob >> 9) & 1) << 5)); }
__host__ __device__ __forceinline__ void stage_rc(int b, int& R, int& C) { const int st = b / 1024, sb = b % 1024, swz = sb ^ (((sb >> 9) & 1) << 5); R = (st >> 1) * 16 + swz / 64; C = (st & 1) * 32 + (swz % 64) / 2; }
__host__ __device__ __forceinline__ int perm32(int rho) { const int n = rho >> 4, i = rho & 15; return 8 * (i >> 2) + 4 * n + (i & 3); }

struct Unit { int pm, pn, kind; };
struct Gemm { const h16* A; const h16* Bt; int lda, ldb, K, nM, nN, nkind, koff, noepi, stagger; };

struct Order {
    int nM, nN, nwg, G, c, nk;
    __device__ void init(int nM_, int nN_, int G_, int c_, int nk_) { asm volatile("" : "+s"(G_), "+s"(c_)); nM = nM_; nN = nN_; nwg = nM * nN; G = G_; c = c_; nk = nk_; }
    __device__ bool next(int i, Unit& u) const {
        const int ti = i / nk; u.kind = i - ti * nk;
        const long L = (long)ti * G + c; if (L >= nwg) return false;
        int wgid = (int)L; { const int q = nwg / NXCD, r = nwg % NXCD, xcd = wgid % NXCD, off = wgid / NXCD; wgid = (xcd < r ? xcd * (q + 1) : r * (q + 1) + (xcd - r) * q) + off; }
        const int nig = WGM * nN, gid = wgid / nig, fm = gid * WGM, gsz = (nM - fm) < WGM ? (nM - fm) : WGM;
        u.pm = fm + ((wgid % nig) % gsz); u.pn = (wgid % nig) / gsz; return true;
    }
};

template <class Epi>
__device__ __forceinline__ void gemm_phase(LAS unsigned char* lds, const Gemm g, const Order& S, const Epi& E, int wave_) {
    int tid = wave_ * 64 + lane_id(); asm volatile("" : "+v"(tid));
    const int wid = __builtin_amdgcn_readfirstlane(tid >> 6), lane = tid & 63, wr = wid >> 2, wc = wid & 3, fr = lane & 15, fq = lane >> 4;
    const int nt = g.K / BK;
    unsigned voffA[2], voffB[2];
#pragma unroll
    for (int i = 0; i < 2; ++i) { int R, C; stage_rc(tid * 16 + i * 8192, R, C); const int Rb = Epi::PERM ? ((R & ~31) + perm32(R & 31)) : R;
        voffA[i] = (unsigned)(R * g.lda + C) * 2u; voffB[i] = (unsigned)(Rb * g.ldb + C) * 2u; }
    const size_t kstep = (size_t)(BK * 2);
    const size_t hstepA = (size_t)HALF * g.lda * 2, hstepB = (size_t)HALF * g.ldb * 2;
    const unsigned ldsw = (unsigned)wid * 1024u;
    const int aoff = lds_byte(wr * 64 + fr, fq * 8), boff = lds_byte(wc * 32 + fr, fq * 8);
#define PG8_SA(b, h) (((b) * 2 + (h)) * HTB)
#define PG8_SB(b, h) ((4 + (b) * 2 + (h)) * HTB)
#define PG8_STAGE(bufoff, gbase, voff) do { _Pragma("unroll") for (int _i = 0; _i < 2; ++_i) \
        __builtin_amdgcn_global_load_lds((const unsigned*)((const char*)(gbase) + (voff)[_i]), (LAS unsigned*)(lds + (bufoff) + ldsw + _i * 8192), 16, 0, 0); } while (0)
#define PG8_LDA(dst, b, h) do { _Pragma("unroll") for (int m = 0; m < 4; ++m) _Pragma("unroll") for (int k = 0; k < 2; ++k) dst[m][k] = *(const LAS h16x8*)(lds + PG8_SA(b, h) + aoff + m * 2048 + k * 1024); } while (0)
#define PG8_LDB(dst, b, h) do { _Pragma("unroll") for (int n = 0; n < 2; ++n) _Pragma("unroll") for (int k = 0; k < 2; ++k) dst[n][k] = *(const LAS h16x8*)(lds + PG8_SB(b, h) + boff + n * 2048 + k * 1024); } while (0)
#define PG8_MMA(ai, bj, At, Bt) do { __builtin_amdgcn_s_setprio(1); _Pragma("unroll") for (int m = 0; m < 4; ++m) _Pragma("unroll") for (int n = 0; n < 2; ++n) _Pragma("unroll") for (int k = 0; k < 2; ++k) \
        acc[ai][bj][m][n] = __builtin_amdgcn_mfma_f32_16x16x32_f16(Bt[n][k], At[m][k], acc[ai][bj][m][n], 0, 0, 0); __builtin_amdgcn_s_setprio(0); } while (0)
#define PG8_WAIT_V(n) asm volatile("s_waitcnt vmcnt(" #n ")" ::: "memory")
#define PG8_WAIT_L(n) asm volatile("s_waitcnt lgkmcnt(" #n ")" ::: "memory")
#define PG8_BAR __builtin_amdgcn_s_barrier()
#define PG8_SCHED __builtin_amdgcn_sched_barrier(0)
#define PG8_PA(u) ((const char*)g.A + ((size_t)(u).pm * 256 * g.lda + (size_t)(u).kind * g.koff) * 2)
#define PG8_PB(u) ((const char*)g.Bt + ((size_t)(u).pn * 256 * g.ldb + (size_t)(u).kind * g.koff) * 2)
    Unit cur, nxt; int ui = 0;
    if (!S.next(0, cur)) return;
    { const int nbig = S.nwg % S.G;
      if (nbig > 0 && S.c >= nbig && g.stagger) { const int ngrp = S.G / nbig, j = S.c / nbig; const unsigned long long dl = (unsigned long long)((g.K / BK) * 140 + 100) * S.nk * j / ngrp;
          const unsigned long long t0 = __builtin_amdgcn_s_memrealtime(); while (__builtin_amdgcn_s_memrealtime() - t0 < dl) __builtin_amdgcn_s_sleep(32); } }
    f32x4 acc[2][2][4][2];
#pragma unroll
    for (int a = 0; a < 2; ++a)
#pragma unroll
        for (int b = 0; b < 2; ++b)
#pragma unroll
            for (int m = 0; m < 4; ++m)
#pragma unroll
                for (int n = 0; n < 2; ++n) acc[a][b][m][n] = (f32x4){0.f, 0.f, 0.f, 0.f};
    h16x8 At[4][2], B0[2][2], B1[2][2];
    const char* cA = PG8_PA(cur); const char* cB = PG8_PB(cur);
    E.prefetch(cur, wid, lane);
    PG8_STAGE(PG8_SB(0, 0), cB, voffB); PG8_STAGE(PG8_SB(0, 1), cB + hstepB, voffB); PG8_STAGE(PG8_SA(0, 0), cA, voffA); PG8_STAGE(PG8_SA(0, 1), cA + hstepA, voffA);
    if (wr == 1) PG8_BAR;
    PG8_WAIT_V(2); PG8_BAR;
    PG8_STAGE(PG8_SB(1, 0), cB + kstep, voffB); PG8_STAGE(PG8_SA(1, 0), cA + kstep, voffA); PG8_STAGE(PG8_SB(1, 1), cB + hstepB + kstep, voffB);
    PG8_WAIT_V(6); PG8_BAR;
    for (;;) {
        const bool has_next = S.next(ui + 1, nxt);
        const char* nA = has_next ? PG8_PA(nxt) : cA; const char* nB = has_next ? PG8_PB(nxt) : cB;
        for (int t = 0; t < nt; t += 2) {
            const bool last = (t == nt - 2);
            const char* a1 = cA + (size_t)(t + 1) * kstep;
            const char* a2 = last ? nA : cA + (size_t)(t + 2) * kstep; const char* b2 = last ? nB : cB + (size_t)(t + 2) * kstep;
            const char* a3 = a2 + kstep; const char* b3 = b2 + kstep;
            PG8_LDB(B0, 0, 0); PG8_LDB(B1, 0, 1); PG8_SCHED; PG8_LDA(At, 0, 0); PG8_STAGE(PG8_SA(1, 1), a1 + hstepA, voffA);
            PG8_WAIT_V(8); PG8_WAIT_L(0); PG8_BAR; PG8_MMA(0, 0, At, B0); PG8_MMA(0, 1, At, B1); PG8_BAR; PG8_SCHED;
            PG8_LDA(At, 0, 1); PG8_STAGE(PG8_SB(0, 0), b2, voffB); PG8_STAGE(PG8_SB(0, 1), b2 + hstepB, voffB); PG8_STAGE(PG8_SA(0, 0), a2, voffA);
            PG8_WAIT_V(8); PG8_WAIT_L(0); PG8_BAR; PG8_MMA(1, 0, At, B0); PG8_MMA(1, 1, At, B1); PG8_BAR; PG8_SCHED;
            PG8_LDB(B0, 1, 0); PG8_LDB(B1, 1, 1); PG8_SCHED; PG8_LDA(At, 1, 0); PG8_STAGE(PG8_SA(0, 1), a2 + hstepA, voffA);
            PG8_WAIT_V(8); PG8_WAIT_L(0); PG8_BAR; PG8_MMA(0, 0, At, B0); PG8_MMA(0, 1, At, B1); PG8_BAR; PG8_SCHED;
            PG8_LDA(At, 1, 1); PG8_STAGE(PG8_SB(1, 0), b3, voffB); PG8_STAGE(PG8_SB(1, 1), b3 + hstepB, voffB); PG8_STAGE(PG8_SA(1, 0), a3, voffA);
            PG8_WAIT_V(8); PG8_WAIT_L(0); PG8_BAR; PG8_MMA(1, 0, At, B0); PG8_MMA(1, 1, At, B1); PG8_BAR; PG8_SCHED;
        }
        if (wr == 0) PG8_BAR;
        { int fr_ = fr, fq_ = fq; asm volatile("" : "+v"(fr_), "+v"(fq_)); if (!g.noepi) E(acc, cur, wr, wc, fr_, fq_); }
        if (!has_next) break;
        if (nxt.kind == 0) {
#pragma unroll
            for (int a = 0; a < 2; ++a)
#pragma unroll
                for (int b = 0; b < 2; ++b)
#pragma unroll
                    for (int m = 0; m < 4; ++m)
#pragma unroll
                        for (int n = 0; n < 2; ++n) acc[a][b][m][n] = (f32x4){0.f, 0.f, 0.f, 0.f};
        }
        cur = nxt; cA = nA; cB = nB; ++ui;
        if (cur.kind == 0) E.prefetch(cur, wid, lane);
        if (wr == 1) PG8_BAR;
    }
    PG8_WAIT_V(0);
    PG8_BAR;
#undef PG8_SA
#undef PG8_SB
#undef PG8_STAGE
#undef PG8_LDA
#undef PG8_LDB
#undef PG8_MMA
#undef PG8_WAIT_V
#undef PG8_WAIT_L
#undef PG8_BAR
#undef PG8_SCHED
#undef PG8_PA
#undef PG8_PB
}
}
constexpr int NWAVES = 8, NTHREADS = 512;
constexpr int NB = 8, SEQ = 2048, DM = 1024, M = NB * SEQ, DIN = 4312, DFF = 2816, NLAYER = 2;
constexpr int NZ = 4352;
constexpr int NGU = 2 * DFF;
constexpr float EPS_RMS = 1e-6f;
constexpr float LOG2E = 1.4426950408889634f;
constexpr float QSCALE = 0.125f * LOG2E;
constexpr int KVP = 152;

constexpr size_t MiB = 1u << 20;
constexpr size_t WS_CTL = 0, CTL_ZERO_BYTES = 65536;
constexpr size_t WS_CS = 1 * MiB;
constexpr size_t WS_SSQ = 2 * MiB;
constexpr size_t WS_WI = 3 * MiB;
constexpr size_t WS_SMALLW = 4 * MiB;
constexpr size_t SMALLW_LAYER = 98304 + 131072 + 262144;
constexpr size_t WS_W = 6 * MiB;
constexpr size_t W_LAYER = 29 * MiB, W_OFF_IN = 0, W_OFF_PAB = (size_t)NZ * 1024 * 2, W_OFF_OUT = W_OFF_PAB + 2 * MiB, W_OFF_GU = W_OFF_OUT + 2 * MiB, W_OFF_D = W_OFF_GU + (size_t)NGU * 1024 * 2;
static_assert(W_OFF_D + (size_t)1024 * DFF * 2 == W_LAYER, "weight map");
constexpr size_t WS_X16 = 64 * MiB;
constexpr size_t WS_QY = 96 * MiB;
constexpr size_t WS_QI = 128 * MiB;
constexpr size_t WS_MISC = 144 * MiB;
constexpr size_t WS_KV = 152 * MiB;
constexpr size_t WS_KI = 157 * MiB;
constexpr size_t WS_X1 = 128 * MiB;
constexpr size_t WS_GATES = 160 * MiB;
constexpr size_t WS_UV = 224 * MiB;
constexpr size_t WS_ACT = 160 * MiB;
constexpr size_t WS_END = 256 * MiB;
static_assert(WS_KV + (size_t)M * KVP * 2 <= WS_KI && WS_KI + (size_t)M * 64 * 2 <= WS_GATES && WS_ACT + (size_t)M * DFF * 2 <= WS_END, "ws map");

constexpr int LDS_BYTES = 155648;
constexpr int LDS_MISC = 151552;

#define RLX_AGENT __ATOMIC_RELAXED, __HIP_MEMORY_SCOPE_AGENT
#define LDS_WAIT() asm volatile("s_waitcnt lgkmcnt(0)" ::: "memory")
#define VM_WAIT() asm volatile("s_waitcnt vmcnt(0)" ::: "memory")

#define XB_TMO      128
#define XB_XCNT(j)  (256  + 64 * (j))
#define XB_XSUB(j)  (1280 + 64 * (j))
#define XB_XGEN(j)  (2304 + 64 * (j))
#define XB_TOP      3328
#define XB_TOPGEN   3392
#define XCD_BAR_WORDS 3456
#define XB_SPIN_CAP (1u << 18)
__device__ __forceinline__ unsigned xb_ld(unsigned* p)              { return __hip_atomic_load(p, __ATOMIC_RELAXED, __HIP_MEMORY_SCOPE_AGENT); }
__device__ __forceinline__ unsigned xb_add(unsigned* p, unsigned v) { return __hip_atomic_fetch_add(p, v, __ATOMIC_RELAXED, __HIP_MEMORY_SCOPE_AGENT); }
__device__ __forceinline__ unsigned xb_xcc_id() { return (unsigned)__builtin_amdgcn_s_getreg((3 << 11) | 20) & 0xFu; }
#define XB_SPIN(cond, bar) do { unsigned _sp = 0; while (cond) { __builtin_amdgcn_s_sleep(1); \
    if ((++_sp & 255u) == 0u) { if (xb_ld(&(bar)[XB_TMO])) break; if (_sp > XB_SPIN_CAP) { atomicAdd(&(bar)[XB_TMO], 1u); break; } } } } while (0)
struct XcdBarrier { unsigned* bar; unsigned x; volatile LAS unsigned* st; };
__device__ __forceinline__ XcdBarrier xcd_barrier_post(unsigned* bar, volatile LAS unsigned* st, int wave_) {
    XcdBarrier b; b.bar = bar; b.x = xb_xcc_id(); b.st = st;
    if (wave_ == 0 && lane_id() == 0) (void)xb_add(&bar[XB_XCNT(b.x)], 1u);
    return b;
}
__device__ __forceinline__ void xcd_barrier_complete(unsigned* bar, unsigned x, unsigned& nloc, unsigned& nx) {
    const unsigned G = gridDim.x * gridDim.y * gridDim.z;
    unsigned sum, cnt, mine, sp = 0u;
    for (;;) {
        sum = 0u; cnt = 0u; mine = 0u;
#pragma unroll
        for (unsigned j = 0; j < 16; ++j) { const unsigned c = xb_ld(&bar[XB_XCNT(j)]); sum += c; cnt += (c > 0u) ? 1u : 0u; }
        mine = xb_ld(&bar[XB_XCNT(x)]);
        if (sum == G) break;
        __builtin_amdgcn_s_sleep(1);
        if ((++sp & 255u) == 0u) { if (xb_ld(&bar[XB_TMO])) break; if (sp > XB_SPIN_CAP) { atomicAdd(&bar[XB_TMO], 1u); break; } }
    }
    nloc = mine > 0u ? mine : 1u; nx = cnt > 0u ? cnt : 1u;
}
__device__ __forceinline__ void xcd_barrier(const XcdBarrier& b, int wave_) {
    asm volatile("s_waitcnt vmcnt(0)" ::: "memory");
    __syncthreads();
    if (wave_ == 0 && lane_id() == 0) {
        unsigned* bar = b.bar; asm volatile("" : "+s"(bar));
        unsigned stoff = (unsigned)(uintptr_t)b.st; asm volatile("" : "+s"(stoff)); volatile LAS unsigned* st = (volatile LAS unsigned*)(uintptr_t)stoff;
        const unsigned x = xb_xcc_id();
        __builtin_amdgcn_s_waitcnt(0);
        unsigned nloc = st[0], nx = st[1];
        if (nloc == 0u) { xcd_barrier_complete(bar, x, nloc, nx); st[0] = nloc; st[1] = nx; }
        const unsigned old = xb_add(&bar[XB_XSUB(x)], 1u);
        const unsigned gen = old / nloc;
        if (old + 1u == (gen + 1u) * nloc) {
            __builtin_amdgcn_fence(__ATOMIC_RELEASE, "agent");
            asm volatile("s_waitcnt vmcnt(0)" ::: "memory");
            const unsigned og = xb_add(&bar[XB_TOP], 1u);
            const unsigned tg = og / nx;
            if (og + 1u == (tg + 1u) * nx) xb_add(&bar[XB_TOPGEN], 1u);
            else XB_SPIN(xb_ld(&bar[XB_TOPGEN]) == tg, bar);
            __builtin_amdgcn_fence(__ATOMIC_ACQUIRE, "agent");
            xb_add(&bar[XB_XGEN(x)], 1u);
            asm volatile("s_waitcnt vmcnt(0)" ::: "memory");
        } else {
            XB_SPIN(xb_ld(&bar[XB_XGEN(x)]) == gen, bar);
            __builtin_amdgcn_fence(__ATOMIC_ACQUIRE, "agent");
            asm volatile("s_waitcnt vmcnt(0)" ::: "memory");
        }
    }
    __syncthreads();
}

__device__ __forceinline__ float gelu_tanh_f(float x) {
    const float u = 0.7978845608028654f * (x + 0.044715f * x * x * x);
    const float e = __builtin_amdgcn_exp2f(-2.0f * LOG2E * u);
    return x * __builtin_amdgcn_rcpf(1.0f + e);
}
__device__ __forceinline__ float sigmoid_f(float x) { return __builtin_amdgcn_rcpf(1.0f + __builtin_amdgcn_exp2f(-LOG2E * x)); }

struct Frame {
    LAS unsigned char* lds;
    int wave, vcu, G;
    unsigned char* ws;
    const float* const* in;
};
struct In {
    const float* x; const int* pos; const float* norm_mix; const float* w_in; const float* kv_norm; const float* w_uk; const float* w_uv; const float* ln_v_g; const float* ln_v_b;
    const float* w_s; const float* b_s; const float* w_proj_a; const float* w_proj_b; const float* w_out; const float* norm_ffn; const float* w_gate; const float* w_up; const float* w_down; const float* final_norm;
};

__device__ __constant__ float c_inv[8] = {1.0f, 0.19392274474868576f, 0.03760603093086393f, 0.007292664737217109f, 0.001414213562373095f, 0.0002742481756762073f, 5.318295896944988e-05f, 1.031338537721246e-05f};

__device__ __forceinline__ void transpose_item64(const float* W4, int Nsrc, h16* WT, int ldt, int n0, int k0, const float* gain, LAS float* scr, int lane) {
    const int nq = lane & 15, kq = lane >> 4;
    f32x4 v[16];
#pragma unroll
    for (int i = 0; i < 16; ++i) v[i] = W4 ? *(const GAS f32x4*)(W4 + (size_t)(k0 + 4 * i + kq) * Nsrc) : (f32x4){0.f, 0.f, 0.f, 0.f};
#pragma unroll
    for (int i = 0; i < 16; ++i) { const int kk = 4 * i + kq; f32x4 x = v[i]; if (gain) x = x * gain[k0 + kk]; *(LAS f32x4*)(scr + kk * 68 + 4 * (nq ^ (kk >> 3))) = x; }
    LDS_WAIT(); asm volatile("" ::: "memory");
    const int c = lane & 7;
#pragma unroll
    for (int j = 0; j < 8; ++j) { const int n = (lane >> 3) + 8 * j; const LAS float* sp = scr + (8 * c) * 68 + 4 * ((n >> 2) ^ c) + (n & 3);
        u32x4 o; o.x = pkh(sp[0 * 68], sp[1 * 68]); o.y = pkh(sp[2 * 68], sp[3 * 68]); o.z = pkh(sp[4 * 68], sp[5 * 68]); o.w = pkh(sp[6 * 68], sp[7 * 68]);
        *(GAS u32x4*)(WT + (size_t)(n0 + n) * ldt + k0 + 8 * c) = o; }
    LDS_WAIT(); asm volatile("" ::: "memory");
}
__device__ __forceinline__ int win_src_col(int n) {
    if (n < 512) return n;
    if (n < 1024) return 656 + (n - 512);
    if (n < 2048) return 1240 + (n - 1024);
    if (n < 4096) return 2264 + (n - 2048);
    if (n < 4224) return 512 + (n - 4096);
    if (n < 4240) return 640 + (n - 4224);
    if (n < 4304) return 1168 + (n - 4240);
    if (n < 4312) return 1232 + (n - 4304);
    return -1;
}
constexpr int CONV_IN_ITEMS = (NZ / 64) * 16;
__device__ __forceinline__ void convert_layer_weights(const Frame& F, const In& I, int l, int gw, int NGW, int it_lo = 0, int it_hi = 1 << 30) {
    LAS float* scr = (LAS float*)(F.lds + F.wave * 17408);
    int lane = lane_id(); asm volatile("" : "+v"(lane));
    constexpr int I_IN = (NZ / 64) * 16, I_PA = 16 * 8, I_OUT = 16 * 16, I_GU = (NGU / 64) * 16, I_D = 16 * (DFF / 64);
    constexpr int I_LAYER = I_IN + 2 * I_PA + I_OUT + I_GU + I_D;
    const int n4 = 4 * (lane & 15);
    unsigned char* wl = F.ws + WS_W + (size_t)l * W_LAYER;
    if (it_hi > I_LAYER) it_hi = I_LAYER;
    for (int it = it_lo + gw; it < it_hi; it += NGW) {
        int r = it;
        if (r < I_IN) { const int nb = r / 16, kb = r % 16, sc = win_src_col(nb * 64 + n4);
            transpose_item64(sc >= 0 ? I.w_in + (size_t)l * DM * DIN + sc : nullptr, DIN, (h16*)(wl + W_OFF_IN), 1024, nb * 64, kb * 64, I.norm_mix + l * DM, scr, lane); continue; }
        r -= I_IN;
        if (r < I_PA) { const int nb = r / 8, kb = r % 8;
            transpose_item64(I.w_proj_a + (size_t)l * 512 * 1024 + nb * 64 + n4, 1024, (h16*)(wl + W_OFF_PAB), 1024, nb * 64, kb * 64, nullptr, scr, lane); continue; }
        r -= I_PA;
        if (r < I_PA) { const int nb = r / 8, kb = r % 8;
            transpose_item64(I.w_proj_b + (size_t)l * 512 * 1024 + nb * 64 + n4, 1024, (h16*)(wl + W_OFF_PAB) + 512, 1024, nb * 64, kb * 64, nullptr, scr, lane); continue; }
        r -= I_PA;
        if (r < I_OUT) { const int nb = r / 16, kb = r % 16;
            transpose_item64(I.w_out + (size_t)l * 1024 * 1024 + nb * 64 + n4, 1024, (h16*)(wl + W_OFF_OUT), 1024, nb * 64, kb * 64, nullptr, scr, lane); continue; }
        r -= I_OUT;
        if (r < I_GU) { const int nb = r / 16, kb = r % 16, R = nb * 64 + n4, pn = R >> 8, rem = R & 255;
            const int a = 128 * pn + 64 * (rem >> 7) + 16 * ((rem >> 5) & 3) + 4 * ((rem >> 3) & 3);
            const float* src = (((rem >> 2) & 1) ? I.w_up : I.w_gate) + (size_t)l * DM * DFF + a;
            transpose_item64(src, DFF, (h16*)(wl + W_OFF_GU), 1024, nb * 64, kb * 64, I.norm_ffn + l * DM, scr, lane); continue; }
        r -= I_GU;
        { const int nb = r / (DFF / 64), kb = r % (DFF / 64);
            transpose_item64(I.w_down + (size_t)l * DFF * 1024 + nb * 64 + n4, 1024, (h16*)(wl + W_OFF_D), DFF, nb * 64, kb * 64, nullptr, scr, lane); }
    }
}
__device__ __forceinline__ void p0_prologue(const Frame& F, const In& I) {
    int lane = lane_id(); asm volatile("" : "+v"(lane));
    const int gw = F.vcu * NWAVES + F.wave, NGW = F.G * NWAVES;
    convert_layer_weights(F, I, 0, gw, NGW, 0, CONV_IN_ITEMS);
    const int gt = F.vcu * NTHREADS + F.wave * 64 + lane, NGT = F.G * NTHREADS;
    for (int i = gt; i < NLAYER * 49152; i += NGT) { const int l = i / 49152, e = i % 49152, h = e / (128 * 48), c = (e / 48) % 128, n = e % 48;
        ((h16*)(F.ws + WS_SMALLW + (size_t)l * SMALLW_LAYER))[e] = (h16)I.w_uk[(((size_t)l * 8 + h) * 48 + n) * 128 + c]; }
    for (int i = gt; i < NLAYER * 65536; i += NGT) { const int l = i / 65536, e = i % 65536, h = e / (64 * 128), d = (e / 128) % 64, c = e % 128;
        ((h16*)(F.ws + WS_SMALLW + (size_t)l * SMALLW_LAYER + 98304))[e] = (h16)I.w_uv[(((size_t)l * 8 + h) * 128 + c) * 64 + d]; }
    for (int i = gt; i < NLAYER * 131072; i += NGT) { const int l = i / 131072, e = i % 131072, t = (e / 128) % 128, s = e % 128;
        ((h16*)(F.ws + WS_SMALLW + (size_t)l * SMALLW_LAYER + 98304 + 131072))[e] = (s <= t) ? (h16)I.w_s[(size_t)l * 131072 + e] : (h16)0.f; }
    for (int i = gt; i < M * 8; i += NGT) { const int tok = i >> 3, f = i & 7; const float ang = (float)I.pos[tok] * c_inv[f];
        float* cs = (float*)(F.ws + WS_CS) + (size_t)tok * 16; cs[f] = cosf(ang); cs[8 + f] = sinf(ang); }
    for (int m = gw; m < M; m += NGW) {
        const f32x4* xr = (const f32x4*)(I.x + (size_t)m * DM) + lane; u32x2* o8 = (u32x2*)((h16*)(F.ws + WS_X16) + (size_t)m * DM) + lane;
#pragma unroll
        for (int j = 0; j < 4; ++j) { const f32x4 v = xr[64 * j]; float s = (v.x * v.x + v.y * v.y) + (v.z * v.z + v.w * v.w);
#pragma unroll
            for (int o = 1; o < 64; o <<= 1) s += __shfl_xor(s, o);
            o8[64 * j] = (u32x2){pkh(v.x, v.y), pkh(v.z, v.w)};
            if (lane == 0) ((GAS float*)(F.ws + WS_SSQ))[(size_t)m * 4 + j] = s; }
    }
}

__device__ __forceinline__ float row_rstd(const float* ssq, int row) {
    const f32x4 a = *(const GAS f32x4*)(ssq + (size_t)row * 4);
    return rsqrtf(((a.x + a.y) + (a.z + a.w)) * (1.0f / DM) + EPS_RMS);
}

typedef f32x4 Acc[2][2][4][2];
__device__ __forceinline__ u32x4 pack8h(const float (&v)[8]) { u32x4 w; w.x = pkz(v[0], v[1]); w.y = pkz(v[2], v[3]); w.z = pkz(v[4], v[5]); w.w = pkz(v[6], v[7]); return w; }

__device__ __forceinline__ void ssq_prefetch(const float* ssq, int pm, LAS float* R4, int wid, int lane) {
    if (wid < 4) __builtin_amdgcn_global_load_lds((const unsigned*)(ssq + (size_t)(pm * 256 + wid * 64 + lane) * 4), (LAS unsigned*)(R4 + wid * 256), 16, 0, 0);
}
__device__ __forceinline__ float rstd_from_lds(const LAS float* R4, int rl) { const f32x4 a = *(const LAS f32x4*)(R4 + rl * 4); return rsqrtf(((a.x + a.y) + (a.z + a.w)) * (1.0f / DM) + EPS_RMS); }
struct EpiA {
    static constexpr bool PERM = true;
    unsigned char* ws; int nostore; LAS float* R;
    __device__ __forceinline__ void prefetch(const pg8::Unit& u, int wid, int lane) const { ssq_prefetch((const float*)(ws + WS_SSQ), u.pm, R, wid, lane); }
    __device__ __forceinline__ void operator()(Acc& acc, const pg8::Unit& u, int wr, int wc, int fr, int fq) const {
        const int pn = u.pn; h16* base; int ldc, colt;
        if (pn < 2) { base = (h16*)(ws + WS_QY); ldc = 1024; colt = pn * 256; }
        else if (pn < 4) { base = (h16*)(ws + WS_QI); ldc = 512; colt = (pn - 2) * 256; }
        else if (pn < 8) { base = (h16*)(ws + WS_UV); ldc = 1024; colt = (pn - 4) * 256; }
        else if (pn < 16) { base = (h16*)(ws + WS_GATES); ldc = 2048; colt = (pn - 8) * 256; }
        else { base = (h16*)(ws + WS_MISC); ldc = 256; colt = 0; }
        const int row0 = u.pm * 256 + wr * 64 + fr, col0 = colt + wc * 32 + 8 * fq;
#pragma unroll
        for (int ai = 0; ai < 2; ++ai)
#pragma unroll
            for (int m = 0; m < 4; ++m) { const int row = row0 + ai * 128 + m * 16; const float rs = rstd_from_lds(R, ai * 128 + wr * 64 + m * 16 + fr); h16* rowp = base + (size_t)row * ldc + col0;
#pragma unroll
                for (int bj = 0; bj < 2; ++bj) { f32x4 v0 = acc[ai][bj][m][0] * rs, v1 = acc[ai][bj][m][1] * rs;
                    u32x4 w; w.x = pkz(v0[0], v0[1]); w.y = pkz(v0[2], v0[3]); w.z = pkz(v1[0], v1[1]); w.w = pkz(v1[2], v1[3]);
                    if (!nostore) *(GAS u32x4*)(rowp + bj * 128) = w; else asm volatile("" :: "v"(w)); } }
        asm volatile("s_waitcnt lgkmcnt(0)" ::: "memory"); __builtin_amdgcn_s_barrier(); asm volatile("" ::: "memory");
    }
};

struct EpiD {
    static constexpr bool PERM = true;
    unsigned char* ws; h16* mg;
    __device__ __forceinline__ void prefetch(const pg8::Unit&, int, int) const {}
    __device__ __forceinline__ void operator()(Acc& acc, const pg8::Unit& u, int wr, int wc, int fr, int fq) const {
        const int row0 = u.pm * 256 + wr * 64 + fr, col0 = u.pn * 256 + wc * 32 + 8 * fq;
        const h16* gates = (const h16*)(ws + WS_GATES);
#pragma unroll
        for (int ai = 0; ai < 2; ++ai) {
            h16x8 gbv[4][2], gav[4][2];
#pragma unroll
            for (int m = 0; m < 4; ++m)
#pragma unroll
                for (int bj = 0; bj < 2; ++bj) { const size_t off = (size_t)(row0 + ai * 128 + m * 16) * 2048 + col0 + bj * 128;
                    gbv[m][bj] = *(const GAS h16x8*)(gates + off + 1024); if (u.kind == 0) gav[m][bj] = *(const GAS h16x8*)(gates + off); }
#pragma unroll
            for (int m = 0; m < 4; ++m) { const int row = row0 + ai * 128 + m * 16;
#pragma unroll
                for (int bj = 0; bj < 2; ++bj) { const int col = col0 + bj * 128; const h16x8 gb = gbv[m][bj];
                    if (u.kind == 0) { const h16x8 ga = gav[m][bj];
#pragma unroll
                        for (int i = 0; i < 8; ++i) { const float ea = __builtin_amdgcn_exp2f(fminf(-LOG2E * (float)ga[i], 64.f)), eb = __builtin_amdgcn_exp2f(fminf(-LOG2E * (float)gb[i], 64.f));
                            acc[ai][bj][m][i >> 2][i & 3] *= (1.0f + eb) * __builtin_amdgcn_rcpf(1.0f + ea); }
                    } else { float v[8];
#pragma unroll
                        for (int i = 0; i < 8; ++i) { const float eb = __builtin_amdgcn_exp2f(fminf(-LOG2E * (float)gb[i], 64.f)); v[i] = acc[ai][bj][m][i >> 2][i & 3] * __builtin_amdgcn_rcpf(1.0f + eb); }
                        u32x4 w; w.x = pkz(v[0], v[1]); w.y = pkz(v[2], v[3]); w.z = pkz(v[4], v[5]); w.w = pkz(v[6], v[7]);
                        *(GAS u32x4*)(mg + (size_t)row * 1024 + col) = w; } } }
            asm volatile("" ::: "memory"); }
    }
};

struct EpiRes {
    static constexpr bool PERM = true;
    const h16* resid; h16* xo; float* ssq; LAS float* P;
    __device__ __forceinline__ void prefetch(const pg8::Unit&, int, int) const {}
    __device__ __forceinline__ void operator()(Acc& acc, const pg8::Unit& u, int wr, int wc, int fr, int fq) const {
        const int row0 = u.pm * 256 + wr * 64 + fr, col0 = u.pn * 256 + wc * 32 + 8 * fq;
        h16x8 rvv[2][4][2];
#pragma unroll
        for (int ai = 0; ai < 2; ++ai)
#pragma unroll
            for (int m = 0; m < 4; ++m)
#pragma unroll
                for (int bj = 0; bj < 2; ++bj) rvv[ai][m][bj] = *(const GAS h16x8*)(resid + (size_t)(row0 + ai * 128 + m * 16) * 1024 + col0 + bj * 128);
#pragma unroll
        for (int ai = 0; ai < 2; ++ai)
#pragma unroll
            for (int m = 0; m < 4; ++m) { const int row = row0 + ai * 128 + m * 16; float ss = 0.f;
#pragma unroll
                for (int bj = 0; bj < 2; ++bj) { const size_t off = (size_t)row * 1024 + col0 + bj * 128;
                    const h16x8 rv = rvv[ai][m][bj]; float v[8];
#pragma unroll
                    for (int i = 0; i < 8; ++i) { v[i] = (float)rv[i] + acc[ai][bj][m][i >> 2][i & 3]; ss = fmaf(v[i], v[i], ss); }
                    *(GAS u32x4*)(xo + off) = pack8h(v); }
                ss += __shfl_xor(ss, 16); ss += __shfl_xor(ss, 32);
                if (fq == 0) P[(ai * 128 + wr * 64 + m * 16 + fr) * 4 + wc] = ss; }
        asm volatile("s_waitcnt lgkmcnt(0)" ::: "memory"); __builtin_amdgcn_s_barrier(); asm volatile("" ::: "memory");
        { const int t = (wr * 4 + wc) * 64 + fq * 16 + fr; if (t < 256) { const f32x4 v = *(const LAS f32x4*)(P + t * 4); ((GAS float*)ssq)[(size_t)(u.pm * 256 + t) * 4 + u.pn] = (v.x + v.y) + (v.z + v.w); } }
        asm volatile("s_waitcnt lgkmcnt(0)" ::: "memory"); __builtin_amdgcn_s_barrier(); asm volatile("" ::: "memory");
    }
};

struct EpiF {
    static constexpr bool PERM = true;
    unsigned char* ws; LAS float* R;
    __device__ __forceinline__ void prefetch(const pg8::Unit& u, int wid, int lane) const { ssq_prefetch((const float*)(ws + WS_SSQ), u.pm, R, wid, lane); }
    __device__ __forceinline__ void operator()(Acc& acc, const pg8::Unit& u, int wr, int wc, int fr, int fq) const {
        const int row0 = u.pm * 256 + wr * 64 + fr, col0 = u.pn * 128 + wc * 16 + 4 * fq;
        h16* act = (h16*)(ws + WS_ACT);
#pragma unroll
        for (int ai = 0; ai < 2; ++ai)
#pragma unroll
            for (int m = 0; m < 4; ++m) { const int row = row0 + ai * 128 + m * 16; const float rs = rstd_from_lds(R, ai * 128 + wr * 64 + m * 16 + fr);
#pragma unroll
                for (int bj = 0; bj < 2; ++bj) { const f32x4 g = acc[ai][bj][m][0] * rs, uu = acc[ai][bj][m][1] * rs; float v[4];
#pragma unroll
                    for (int i = 0; i < 4; ++i) v[i] = g[i] * sigmoid_f(g[i]) * uu[i];
                    *(GAS u32x2*)(act + (size_t)row * DFF + col0 + bj * 64) = (u32x2){pkz(v[0], v[1]), pkz(v[2], v[3])}; } }
        asm volatile("s_waitcnt lgkmcnt(0)" ::: "memory"); __builtin_amdgcn_s_barrier(); asm volatile("" ::: "memory");
    }
};

__device__ __forceinline__ void final_norm_phase(const Frame& F, const h16* x16, float* out, const float* g) {
    int lane = lane_id(); asm volatile("" : "+v"(lane));
    const int gw = F.vcu * NWAVES + F.wave, NGW = F.G * NWAVES;
    f32x4 gv[2][2];
#pragma unroll
    for (int hh = 0; hh < 2; ++hh) { gv[hh][0] = *(const f32x4*)(g + 512 * hh + 8 * lane); gv[hh][1] = *(const f32x4*)(g + 512 * hh + 8 * lane + 4); }
    for (int m0 = gw; m0 < M; m0 += 8 * NGW) {
        h16x8 xa[8], xb[8];
#pragma unroll
        for (int k = 0; k < 8; ++k) { const int m = m0 + k * NGW; if (m < M) { xa[k] = *(const GAS h16x8*)(x16 + (size_t)m * DM + 8 * lane); xb[k] = *(const GAS h16x8*)(x16 + (size_t)m * DM + 512 + 8 * lane); } }
#pragma unroll
        for (int k = 0; k < 8; ++k) { const int m = m0 + k * NGW; if (m < M) { const h16x8 a = xa[k], b = xb[k]; float s = 0.f;
#pragma unroll
            for (int j = 0; j < 8; ++j) { s = fmaf((float)a[j], (float)a[j], s); s = fmaf((float)b[j], (float)b[j], s); }
#pragma unroll
            for (int o = 1; o < 64; o <<= 1) s += __shfl_xor(s, o);
            const float rs = rsqrtf(s * (1.0f / DM) + EPS_RMS);
#pragma unroll
            for (int hh = 0; hh < 2; ++hh) { const h16x8 v = hh ? b : a; const int c = 512 * hh + 8 * lane; const f32x4 g0 = gv[hh][0], g1 = gv[hh][1];
                *(GAS f32x4*)(out + (size_t)m * DM + c) = (f32x4){(float)v[0] * rs * g0.x, (float)v[1] * rs * g0.y, (float)v[2] * rs * g0.z, (float)v[3] * rs * g0.w};
                *(GAS f32x4*)(out + (size_t)m * DM + c + 4) = (f32x4){(float)v[4] * rs * g1.x, (float)v[5] * rs * g1.y, (float)v[6] * rs * g1.z, (float)v[7] * rs * g1.w}; } } }
    }
}
__device__ __forceinline__ unsigned wlane(unsigned val, int ln, unsigned old) {
    unsigned keep;
    asm volatile("s_mov_b32 %1, m0\n\ts_mov_b32 m0, %3\n\ts_nop 3\n\tv_writelane_b32 %0, %2, m0\n\ts_mov_b32 m0, %1" : "+v"(old), "=&s"(keep) : "s"(val), "s"(ln));
    return old;
}
__device__ __forceinline__ void cnt_ge(int& c, float x, float m) { asm("v_cmp_ge_f32 vcc, %1, %2\n\tv_addc_co_u32 %0, vcc, 0, %0, vcc" : "+v"(c) : "v"(x), "v"(m) : "vcc"); }
__device__ __forceinline__ void cnt_gt(int& c, float x, float m) { asm("v_cmp_gt_f32 vcc, %1, %2\n\tv_addc_co_u32 %0, vcc, 0, %0, vcc" : "+v"(c) : "v"(x), "v"(m) : "vcc"); }
#define SEL_C8(OP, m_, a0, a1, a2, a3, a4, a5, a6, a7) \
    "v_cmp_" OP "_f32 vcc, " a0 ", " m_ "\n\tv_cmp_" OP "_f32 %2, " a1 ", " m_ "\n\tv_cmp_" OP "_f32 %3, " a2 ", " m_ "\n\tv_cmp_" OP "_f32 %4, " a3 ", " m_ "\n\t" \
    "v_cmp_" OP "_f32 %5, " a4 ", " m_ "\n\tv_cmp_" OP "_f32 %6, " a5 ", " m_ "\n\tv_cmp_" OP "_f32 %7, " a6 ", " m_ "\n\tv_cmp_" OP "_f32 %8, " a7 ", " m_ "\n\t"
#define SEL_A8(c_) \
    "v_addc_co_u32 " c_ ", vcc, 0, " c_ ", vcc\n\tv_addc_co_u32 " c_ ", %2, 0, " c_ ", %2\n\tv_addc_co_u32 " c_ ", %3, 0, " c_ ", %3\n\tv_addc_co_u32 " c_ ", %4, 0, " c_ ", %4\n\t" \
    "v_addc_co_u32 " c_ ", %5, 0, " c_ ", %5\n\tv_addc_co_u32 " c_ ", %6, 0, " c_ ", %6\n\tv_addc_co_u32 " c_ ", %7, 0, " c_ ", %7\n\tv_addc_co_u32 " c_ ", %8, 0, " c_ ", %8\n\t"
#define SEL_CGROUP(NAME, OP) __device__ __forceinline__ void NAME(int& c0, int& c1, const float* s, float m0, float m1) { unsigned long long t1, t2, t3, t4, t5, t6, t7; \
    asm(SEL_C8(OP, "%25", "%9", "%11", "%13", "%15", "%17", "%19", "%21", "%23") SEL_A8("%0") SEL_C8(OP, "%26", "%10", "%12", "%14", "%16", "%18", "%20", "%22", "%24") SEL_A8("%1") \
        : "+v"(c0), "+v"(c1), "=&s"(t1), "=&s"(t2), "=&s"(t3), "=&s"(t4), "=&s"(t5), "=&s"(t6), "=&s"(t7) \
        : "v"(s[0]), "v"(s[1]), "v"(s[2]), "v"(s[3]), "v"(s[4]), "v"(s[5]), "v"(s[6]), "v"(s[7]), "v"(s[8]), "v"(s[9]), "v"(s[10]), "v"(s[11]), "v"(s[12]), "v"(s[13]), "v"(s[14]), "v"(s[15]), "v"(m0), "v"(m1) : "vcc"); }
SEL_CGROUP(cnt_group_ge, "ge")
SEL_CGROUP(cnt_group_gt, "gt")
__device__ __forceinline__ void ballot_ge_to_lane(unsigned& wlo, unsigned& whi, float x, float tau, int ln) {
    unsigned keep;
    asm volatile("v_cmp_ge_f32 vcc, %3, %4\n\ts_mov_b32 %2, m0\n\ts_mov_b32 m0, %5\n\ts_nop 3\n\tv_writelane_b32 %0, vcc_lo, m0\n\tv_writelane_b32 %1, vcc_hi, m0\n\ts_mov_b32 m0, %2"
                 : "+v"(wlo), "+v"(whi), "=&s"(keep) : "v"(x), "v"(tau), "s"(ln) : "vcc");
}
__device__ __forceinline__ int half_sum_dpp(int v, int hf) {
    v += __builtin_amdgcn_update_dpp(0, v, 0x111, 0xf, 0xf, true);
    v += __builtin_amdgcn_update_dpp(0, v, 0x112, 0xf, 0xf, true);
    v += __builtin_amdgcn_update_dpp(0, v, 0x114, 0xf, 0xf, true);
    v += __builtin_amdgcn_update_dpp(0, v, 0x118, 0xf, 0xf, true);
    v += __builtin_amdgcn_update_dpp(0, v, 0x142, 0xa, 0xf, false);
    const int s0 = __builtin_amdgcn_readlane(v, 31), s1 = __builtin_amdgcn_readlane(v, 63);
    return hf ? s1 : s0;
}
__device__ __forceinline__ int crow(int R, int hf) { return (R & 3) + 8 * (R >> 2) + 4 * hf; }
__device__ __forceinline__ float half_swap_max(float v) { auto rr = __builtin_amdgcn_permlane32_swap(__float_as_uint(v), __float_as_uint(v), false, false); return fmaxf(__uint_as_float(rr[0]), __uint_as_float(rr[1])); }
__device__ __forceinline__ float half_swap_sum(float v) { auto rr = __builtin_amdgcn_permlane32_swap(__float_as_uint(v), __float_as_uint(v), false, false); return __uint_as_float(rr[0]) + __uint_as_float(rr[1]); }
__device__ __forceinline__ void rope8(const h16x8 x1, const h16x8 x2, const float* cs, int which, float scale, float (&o)[8]) {
    const f32x4 c0 = *(const GAS f32x4*)(cs), c1 = *(const GAS f32x4*)(cs + 4), s0 = *(const GAS f32x4*)(cs + 8), s1 = *(const GAS f32x4*)(cs + 12);
#pragma unroll
    for (int j = 0; j < 8; ++j) { const float c = j < 4 ? c0[j & 3] : c1[j & 3], s = j < 4 ? s0[j & 3] : s1[j & 3]; const float a = (float)x1[j], b = (float)x2[j];
        o[j] = (which == 0 ? (a * c - b * s) : (b * c + a * s)) * scale; }
}
__device__ __forceinline__ u32x4 pack8(const float (&v)[8]) { u32x4 w; w.x = pkh(v[0], v[1]); w.y = pkh(v[2], v[3]); w.z = pkh(v[4], v[5]); w.w = pkh(v[6], v[7]); return w; }

__device__ __forceinline__ void phaseB(const Frame& F, const In& I, int l) {
    unsigned char* ws = F.ws; asm volatile("" : "+s"(ws)); ws = (unsigned char*)(GAS unsigned char*)ws;     int lane = lane_id(), tid = F.wave * 64 + lane; asm volatile("" : "+v"(lane), "+v"(tid)); const int w = F.wave;
    const h16* MISC = (const h16*)(ws + WS_MISC); h16* KV = (h16*)(ws + WS_KV); h16* KI = (h16*)(ws + WS_KI); float* WI = (float*)(ws + WS_WI); const float* CS = (const float*)(ws + WS_CS);
    int blk = F.vcu; asm volatile("" : "+s"(blk));
#pragma unroll
    for (int it = 0; it < 2; ++it) {
        const int tok = blk * 64 + w * 8 + it * 4 + (lane >> 4), i = lane & 15;
        const h16* mr = MISC + (size_t)tok * 256; const float* cs = CS + (size_t)tok * 16;
        const h16x8 x = *(const GAS h16x8*)(mr + 8 * i);
        float ss = 0.f;
#pragma unroll
        for (int j = 0; j < 8; ++j) ss += (float)x[j] * (float)x[j];
        ss += __shfl_xor(ss, 1); ss += __shfl_xor(ss, 2); ss += __shfl_xor(ss, 4); ss += __shfl_xor(ss, 8);
        const float rs = rsqrtf(ss * (1.0f / 128.f) + EPS_RMS);
        { float o[8]; const float* kn = I.kv_norm + l * 128 + 8 * i;
#pragma unroll
          for (int j = 0; j < 8; ++j) o[j] = (float)x[j] * rs * kn[j];
          *(GAS u32x4*)(KV + (size_t)tok * KVP + 8 * i) = pack8(o); }
        if (i < 2) { float o[8]; rope8(*(const GAS h16x8*)(mr + 128), *(const GAS h16x8*)(mr + 136), cs, i, 1.0f, o); *(GAS u32x4*)(KV + (size_t)tok * KVP + 128 + 8 * i) = pack8(o); }
        else if (i == 2) { u32x2 z2 = {0u, 0u}; asm volatile("" : "+v"(z2)); *(GAS u32x2*)(KV + (size_t)tok * KVP + 144) = z2; *(GAS u32x2*)(KV + (size_t)tok * KVP + 148) = z2; }
        else if (i < 11) { const int ii = i - 3;
            if (ii < 2) { float o[8]; rope8(*(const GAS h16x8*)(mr + 144), *(const GAS h16x8*)(mr + 152), cs, ii, 1.0f, o); *(GAS u32x4*)(KI + (size_t)tok * 64 + 8 * ii) = pack8(o); }
            else *(GAS u32x4*)(KI + (size_t)tok * 64 + 8 * ii) = *(const GAS u32x4*)(mr + 144 + 8 * ii); }
        else if (i == 11) { const h16x8 wv = *(const GAS h16x8*)(mr + 208); const float sc = 0.35355339059327373f * 0.125f;
            *(GAS f32x4*)(WI + (size_t)tok * 8) = (f32x4){(float)wv[0] * sc, (float)wv[1] * sc, (float)wv[2] * sc, (float)wv[3] * sc};
            *(GAS f32x4*)(WI + (size_t)tok * 8 + 4) = (f32x4){(float)wv[4] * sc, (float)wv[5] * sc, (float)wv[6] * sc, (float)wv[7] * sc}; }
    }
    const int b = blk >> 5, chunk = (blk >> 1) & 15, gh = blk & 1;
    const size_t tok0 = (size_t)b * SEQ + chunk * 128;
    const h16* UV = (const h16*)(ws + WS_UV); h16* QY = (h16*)(ws + WS_QY);
    LAS unsigned char* VN = F.lds;
    constexpr int VPB = 576;
    { const int i16 = lane & 15, rq = lane >> 4; h16x8 v[4][4];
#pragma unroll
      for (int it = 0; it < 4; ++it)
#pragma unroll
          for (int i = 0; i < 4; ++i) v[it][i] = *(const GAS h16x8*)(UV + (tok0 + 16 * w + 4 * it + rq) * 1024 + 512 + 8 * i16 + 128 * (i & 1) + 256 * ((i >> 1) ^ gh));
      f32x4 lgv[2][2], lbv[2][2];
#pragma unroll
      for (int i = 0; i < 2; ++i) { const int col = 256 * gh + 128 * i + 8 * i16; const float* lg = I.ln_v_g + l * 512 + col; const float* lb = I.ln_v_b + l * 512 + col;
          lgv[i][0] = *(const f32x4*)lg; lgv[i][1] = *(const GAS f32x4*)(lg + 4); lbv[i][0] = *(const f32x4*)lb; lbv[i][1] = *(const GAS f32x4*)(lb + 4); }
#pragma unroll
      for (int it = 0; it < 4; ++it) { float s = 0.f, q = 0.f; float vg[4][8];
#pragma unroll
          for (int i = 0; i < 4; ++i)
#pragma unroll
              for (int j = 0; j < 8; ++j) { const float x = gelu_tanh_f((float)v[it][i][j]); vg[i][j] = x; s += x; q = fmaf(x, x, q); }
          s += __shfl_xor(s, 1); q += __shfl_xor(q, 1); s += __shfl_xor(s, 2); q += __shfl_xor(q, 2); s += __shfl_xor(s, 4); q += __shfl_xor(q, 4); s += __shfl_xor(s, 8); q += __shfl_xor(q, 8);
          const float mu = s * (1.0f / 512.f), var = fmaxf(q * (1.0f / 512.f) - mu * mu, 0.f), rs = rsqrtf(var + 1e-5f);
          const int t = 16 * w + 4 * it + rq;
#pragma unroll
          for (int i = 0; i < 2; ++i) { float o[8];
#pragma unroll
              for (int j = 0; j < 8; ++j) o[j] = (vg[i][j] - mu) * rs * lgv[i][j >> 2][j & 3] + lbv[i][j >> 2][j & 3];
              *(LAS u32x4*)(VN + t * VPB + (128 * i + 8 * i16) * 2) = pack8(o); } } }
    asm volatile("" ::: "memory");
    { const int gp = w & 3, g = 4 * gh + gp, rh = w >> 2, r = lane & 31, hf = lane >> 5;
      const h16* WS16 = (const h16*)(ws + WS_SMALLW + (size_t)l * SMALLW_LAYER + 98304 + 131072) + (size_t)g * 128 * 128;
      const int troff = (8 * hf + ((lane & 15) >> 2)) * VPB + (gp * 64 + 16 * ((lane >> 4) & 1) + 4 * (lane & 3)) * 2;
      h16x8 wf[2][8];
#pragma unroll
      for (int tb = 0; tb < 2; ++tb)
#pragma unroll
          for (int s = 0; s < 8; ++s) wf[tb][s] = *(const GAS h16x8*)(WS16 + (size_t)(64 * rh + 32 * tb + r) * 128 + 16 * s + 8 * hf);
      float bsv[2]; u32x2 uu[2][2][4];
#pragma unroll
      for (int tb = 0; tb < 2; ++tb) { const int t = 64 * rh + 32 * tb + r; bsv[tb] = I.b_s[((size_t)l * 8 + g) * 128 + t];
#pragma unroll
          for (int db = 0; db < 2; ++db)
#pragma unroll
              for (int gg = 0; gg < 4; ++gg) uu[tb][db][gg] = *(const GAS u32x2*)(UV + (tok0 + t) * 1024 + g * 64 + 32 * db + 8 * gg + 4 * hf); }
      LDS_WAIT(); __syncthreads();
#pragma unroll
      for (int tb = 0; tb < 2; ++tb) { const int nks = 4 * rh + 2 * tb + 2; const size_t tk = tok0 + 64 * rh + 32 * tb + r;
#pragma unroll
        for (int db = 0; db < 2; ++db) { f32x16 D = {};
#pragma unroll
            for (int s = 0; s < 8; ++s) if (s < nks) {
                const v4i16_t lo = __builtin_amdgcn_ds_read_tr16_b64_v4i16((LAS v4i16_t*)(VN + troff + (16 * s) * VPB + 64 * db));
                const v4i16_t hi = __builtin_amdgcn_ds_read_tr16_b64_v4i16((LAS v4i16_t*)(VN + troff + (16 * s + 4) * VPB + 64 * db));
                typedef short s16x8 __attribute__((ext_vector_type(8)));
                const s16x8 av = {lo[0], lo[1], lo[2], lo[3], hi[0], hi[1], hi[2], hi[3]};
                D = __builtin_amdgcn_mfma_f32_32x32x16_f16(__builtin_bit_cast(h16x8, av), wf[tb][s], D, 0, 0, 0); }
#pragma unroll
            for (int gg = 0; gg < 4; ++gg) { const u32x2 uv2 = uu[tb][db][gg]; const float bb = bsv[tb];
                const float y0 = gelu_tanh_f(h2f_lo(uv2.x)) * (D[4 * gg] + bb), y1 = gelu_tanh_f(h2f_hi(uv2.x)) * (D[4 * gg + 1] + bb), y2 = gelu_tanh_f(h2f_lo(uv2.y)) * (D[4 * gg + 2] + bb), y3 = gelu_tanh_f(h2f_hi(uv2.y)) * (D[4 * gg + 3] + bb);
                *(GAS u32x2*)(QY + tk * 1024 + 512 + g * 64 + 32 * db + 8 * gg + 4 * hf) = (u32x2){pkh(y0, y1), pkh(y2, y3)}; } } } }
    __syncthreads();
}

constexpr int C_KIB = 0, C_KIBUF = 256 * 128;
constexpr int C_QL = 0, C_QLW = KVP * 2 * 32;
constexpr int C_WQ = 81920;
constexpr int C_KVS = 90112, C_KVSLOT = 10240;

__device__ __forceinline__ void phaseC_select(const Frame& F, int l, int b, int qt, int pmode = 0) {
    unsigned char* ws = F.ws; asm volatile("" : "+s"(ws)); ws = (unsigned char*)(GAS unsigned char*)ws;     int lane = lane_id(), tid = F.wave * 64 + lane; asm volatile("" : "+v"(lane), "+v"(tid)); const int w = F.wave, r = lane & 31, hf = lane >> 5;
    const h16* QI = (const h16*)(ws + WS_QI); const h16* KI = (const h16*)(ws + WS_KI); const float* WI = (const float*)(ws + WS_WI); const float* CS = (const float*)(ws + WS_CS);
    h16* QY = (h16*)(ws + WS_QY); const h16* KV = (const h16*)(ws + WS_KV);
    const h16* WUKT = (const h16*)(ws + WS_SMALLW + (size_t)l * SMALLW_LAYER); const h16* WUVT = (const h16*)(ws + WS_SMALLW + (size_t)l * SMALLW_LAYER + 98304);
    LAS unsigned char* lds = F.lds;
    const int t0 = 32 * qt, NT = qt + 1; const size_t tokbase = (size_t)b * SEQ;
    { const char* kvsrc_ = (const char*)((const h16*)(ws + WS_KV) + tokbase * KVP) + (size_t)(64 * w + lane) * 16; const unsigned kvdst_ = (unsigned)(uintptr_t)(lds + C_KVS) + (unsigned)w * 1024u;
#pragma unroll
      for (int t_ = 0; t_ < 4; ++t_) if (t_ < NT) { const char* s_ = kvsrc_ + (size_t)t_ * (32 * KVP * 2); const unsigned d_ = (unsigned)__builtin_amdgcn_readfirstlane((int)(kvdst_ + (unsigned)t_ * (unsigned)C_KVSLOT));
          unsigned keep_; asm volatile("s_mov_b32 %0, m0\n\ts_mov_b32 m0, %2\n\ts_nop 0\n\tglobal_load_lds_dwordx4 %1, off\n\ts_mov_b32 m0, %0" : "=&s"(keep_) : "v"(s_), "s"(d_) : "memory");
          if (w < 2) { const char* s2_ = s_ + 8192; const unsigned d2_ = d_ + 8192u; asm volatile("s_mov_b32 %0, m0\n\ts_mov_b32 m0, %2\n\ts_nop 0\n\tglobal_load_lds_dwordx4 %1, off\n\ts_mov_b32 m0, %0" : "=&s"(keep_) : "v"(s2_), "s"(d2_) : "memory"); } } }
    h16x8 afr[4]; float wreg[16];
    { const int qq = 2 * ((r >> 2) & 1) + (r >> 4), head = (r & 3) + 4 * ((r >> 3) & 1); const size_t tokA = tokbase + t0 + 4 * w + qq;
      const h16* qsrc = QI + tokA * 512 + head * 64;
      { float o[8]; rope8(*(const GAS h16x8*)(qsrc), *(const GAS h16x8*)(qsrc + 8), CS + tokA * 16, hf, 1.0f, o); afr[0] = __builtin_bit_cast(h16x8, pack8(o)); }
#pragma unroll
      for (int s = 1; s < 4; ++s) afr[s] = *(const GAS h16x8*)(qsrc + 16 * s + 8 * hf);
      const float* wp = WI + (tokbase + t0 + 4 * w + 2 * hf) * 8;
#pragma unroll
      for (int R4 = 0; R4 < 4; ++R4) { const f32x4 wv = *(const GAS f32x4*)(wp + 4 * R4); wreg[4 * R4] = wv.x; wreg[4 * R4 + 1] = wv.y; wreg[4 * R4 + 2] = wv.z; wreg[4 * R4 + 3] = wv.w; } }
    float SC[128];
    const float QNAN = __uint_as_float(0x7fc00000u);
#pragma unroll
    for (int i = 0; i < 128; ++i) SC[i] = QNAN;
    const int NCK = (NT + 7) >> 3, tq0 = t0 + 4 * w + 2 * hf;
    const int drow = lane >> 3, dslot = lane & 7;
    const h16* kisrc = KI + (tokbase + 32 * w + drow) * 64 + 8 * (dslot ^ drow);
#define KI_STAGE(ck_, buf_) do { _Pragma("unroll") for (int i_ = 0; i_ < 4; ++i_) \
        __builtin_amdgcn_global_load_lds((const unsigned*)(kisrc + (size_t)(256 * (ck_) + 8 * i_) * 64), (LAS unsigned*)(lds + C_KIB + (buf_) * C_KIBUF + (4 * w + i_) * 1024), 16, 0, 0); } while (0)
    KI_STAGE(0, 0);
    VM_WAIT(); __syncthreads();
    const int kroff = r * 128, kx = r & 7;
#pragma unroll 1
    for (int ck = 0; ck < NCK; ++ck) {
        LAS unsigned char* kb = lds + C_KIB + (ck & 1) * C_KIBUF;
        if (ck + 1 < NCK) KI_STAGE(ck + 1, (ck + 1) & 1);
#pragma unroll
        for (int i = 0; i < 112; ++i) SC[i] = SC[i + 16];
#pragma unroll
        for (int jj = 0; jj < 8; ++jj) { if (pmode & 1) { SC[112 + 2 * jj] = (float)(ck + jj + r) * 0.01f; SC[113 + 2 * jj] = (float)(ck - jj + r) * 0.01f; continue; }
            f32x16 D = {};
#pragma unroll
            for (int s = 0; s < 4; ++s) { const h16x8 bb = *(const LAS h16x8*)(kb + jj * 4096 + kroff + 16 * ((2 * s + hf) ^ kx)); D = __builtin_amdgcn_mfma_f32_32x32x16_f16(afr[s], bb, D, 0, 0, 0); }
            float s0 = 0.f, s1 = 0.f;
#pragma unroll
            for (int R = 0; R < 8; ++R) { s0 = fmaf(wreg[R], fmaxf(D[R], 0.f), s0); s1 = fmaf(wreg[8 + R], fmaxf(D[8 + R], 0.f), s1); }
            const int k = 256 * ck + 32 * jj + r;
            SC[112 + 2 * jj] = (k > tq0) ? QNAN : s0; SC[113 + 2 * jj] = (k > tq0 + 1) ? QNAN : s1;
        }
        LDS_WAIT(); VM_WAIT(); __syncthreads();
    }
#undef KI_STAGE
    const int G0 = 8 - NCK;
#define SEL_COUNT2(c0, c1, FN, m0, m1) do { int a0_ = 0, a1_ = 0; \
        _Pragma("unroll") for (int g = 0; g < 8; ++g) if (g >= G0) FN(a0_, a1_, &SC[16 * g], (m0), (m1)); \
        c0 = half_sum_dpp(a0_, hf); c1 = half_sum_dpp(a1_, hf); } while (0)
    float tau0 = -3.0e38f, tau1 = -3.0e38f;
    if (qt >= 8 && !(pmode & 2)) {
        float lo0 = INFINITY, lo1 = INFINITY, hi0 = -INFINITY, hi1 = -INFINITY;
#pragma unroll
        for (int j = 0; j < 64; ++j) { const float a = SC[2 * j], c = SC[2 * j + 1]; lo0 = fminf(lo0, a); hi0 = fmaxf(hi0, a); lo1 = fminf(lo1, c); hi1 = fmaxf(hi1, c); }
#pragma unroll
        for (int o = 1; o < 32; o <<= 1) { lo0 = fminf(lo0, __shfl_xor(lo0, o)); lo1 = fminf(lo1, __shfl_xor(lo1, o)); hi0 = fmaxf(hi0, __shfl_xor(hi0, o)); hi1 = fmaxf(hi1, __shfl_xor(hi1, o)); }
        int cl0 = tq0 + 1, cl1 = tq0 + 2, ch0 = 1, ch1 = 1;
        bool done0 = false, done1 = false;
        { int g0, g1; const float zero = 0.f; SEL_COUNT2(g0, g1, cnt_group_gt, zero, zero);
          const float tiny = __uint_as_float(1u);
          if (__any(g0 < 256 || g1 < 256)) { int e0, e1; SEL_COUNT2(e0, e1, cnt_group_ge, zero, zero);
              if (g0 < 256) { if (e0 >= 256) { lo0 = 0.f; done0 = true; } else { hi0 = 0.f; ch0 = e0; } }
              if (g1 < 256) { if (e1 >= 256) { lo1 = 0.f; done1 = true; } else { hi1 = 0.f; ch1 = e1; } } }
          if (g0 >= 256) { lo0 = tiny; cl0 = g0; if (g0 == 256) done0 = true; }
          if (g1 >= 256) { lo1 = tiny; cl1 = g1; if (g1 == 256) done1 = true; } }
#define SEL_STEP(c0, c1, mid0, mid1) do { \
            if (!done0) { if (c0 >= 256) { lo0 = mid0; cl0 = c0; if (c0 == 256) done0 = true; } else { hi0 = mid0; ch0 = c0; } } \
            if (!done1) { if (c1 >= 256) { lo1 = mid1; cl1 = c1; if (c1 == 256) done1 = true; } else { hi1 = mid1; ch1 = c1; } } } while (0)
#define SEL_EXHAUSTED(bis0, bis1) do { if (!done0 && (bis0 <= lo0 || bis0 >= hi0)) done0 = true; if (!done1 && (bis1 <= lo1 || bis1 >= hi1)) done1 = true; } while (0)
        bool compact = true;
#pragma unroll 1
        for (int it = 0; it < ((pmode & 16) ? 6 : 40); ++it) {
            const float bis0 = 0.5f * (lo0 + hi0), bis1 = 0.5f * (lo1 + hi1);
            SEL_EXHAUSTED(bis0, bis1);
            if (__all((done0 || (compact && cl0 - ch0 <= 48)) && (done1 || (compact && cl1 - ch1 <= 48)))) break;
            int c0, c1; SEL_COUNT2(c0, c1, cnt_group_ge, bis0, bis1);
            SEL_STEP(c0, c1, bis0, bis1);
            if (it == 39) { done0 = true; done1 = true; }
        }
        if (!__all(done0 && done1)) {
            LAS float* L0 = (LAS float*)(lds + w * 4096 + (2 * hf) * 1024 + r * 32); LAS float* L1 = L0 + 256;
            { const f32x4 qn = {QNAN, QNAN, QNAN, QNAN}; *(LAS f32x4*)L0 = qn; *(LAS f32x4*)(L0 + 4) = qn; *(LAS f32x4*)L1 = qn; *(LAS f32x4*)(L1 + 4) = qn; }
            int n0 = 0, n1 = 0;
#pragma unroll
            for (int g = 0; g < 8; ++g) if (g >= G0) {
#pragma unroll
                for (int jj = 0; jj < 8; ++jj) { const int j = 8 * g + jj; const float v0 = SC[2 * j], v1 = SC[2 * j + 1];
                    if (!done0 && v0 >= lo0 && v0 < hi0) { if (n0 < 8) L0[n0] = v0; ++n0; }
                    if (!done1 && v1 >= lo1 && v1 < hi1) { if (n1 < 8) L1[n1] = v1; ++n1; } } }
            LDS_WAIT();
            float CAND[16];
            { const f32x4 a0 = *(const LAS f32x4*)L0, a1 = *(const LAS f32x4*)(L0 + 4), b0 = *(const LAS f32x4*)L1, b1 = *(const LAS f32x4*)(L1 + 4);
#pragma unroll
              for (int i = 0; i < 4; ++i) { CAND[2 * i] = a0[i]; CAND[8 + 2 * i] = a1[i]; CAND[2 * i + 1] = b0[i]; CAND[8 + 2 * i + 1] = b1[i]; } }
            LDS_WAIT();
            if (__any(n0 > 8 || n1 > 8)) {
#pragma unroll 1
                for (int it = 0; it < 40; ++it) {
                    const float bis0 = 0.5f * (lo0 + hi0), bis1 = 0.5f * (lo1 + hi1);
                    SEL_EXHAUSTED(bis0, bis1);
                    if (__all(done0 && done1)) break;
                    int c0, c1; SEL_COUNT2(c0, c1, cnt_group_ge, bis0, bis1);
                    SEL_STEP(c0, c1, bis0, bis1);
                }
            } else {
                const int cb0 = ch0, cb1 = ch1;
#pragma unroll 1
                for (int it = 0; it < ((pmode & 16) ? 3 : 48); ++it) {
                    const float bis0 = 0.5f * (lo0 + hi0), bis1 = 0.5f * (lo1 + hi1);
                    SEL_EXHAUSTED(bis0, bis1);
                    if (__all(done0 && done1)) break;
                    float mid0 = bis0, mid1 = bis1;
                    if ((it % 3) != 2) { const float i0 = lo0 + ((float)cl0 - 255.5f) / (float)(cl0 - ch0) * (hi0 - lo0), i1 = lo1 + ((float)cl1 - 255.5f) / (float)(cl1 - ch1) * (hi1 - lo1);
                        if (i0 > lo0 && i0 < hi0) mid0 = i0; if (i1 > lo1 && i1 < hi1) mid1 = i1; }
                    int a0 = 0, a1 = 0; cnt_group_ge(a0, a1, CAND, mid0, mid1);
                    const int c0 = cb0 + half_sum_dpp(a0, hf), c1 = cb1 + half_sum_dpp(a1, hf);
                    SEL_STEP(c0, c1, mid0, mid1);
                }
            }
        }
#undef SEL_STEP
#undef SEL_EXHAUSTED
        tau0 = lo0; tau1 = lo1;
    }
#undef SEL_COUNT2
    unsigned w00 = 0u, w01 = 0u, w10 = 0u, w11 = 0u;
#pragma unroll
    for (int g = 0; g < 8; ++g) if (g >= G0 && !(pmode & 4)) {
#pragma unroll
        for (int jj = 0; jj < 8; ++jj) { const int j = 8 * g + jj, jt = 8 * (g - G0) + jj;
            ballot_ge_to_lane(w00, w10, SC[2 * j], tau0, jt); ballot_ge_to_lane(w01, w11, SC[2 * j + 1], tau1, jt); } }
    { LAS unsigned* WQ = (LAS unsigned*)(lds + C_WQ);
      WQ[(4 * w + 0) * 64 + lane] = w00; WQ[(4 * w + 1) * 64 + lane] = w01; WQ[(4 * w + 2) * 64 + lane] = w10; WQ[(4 * w + 3) * 64 + lane] = w11; }
    LDS_WAIT(); __syncthreads();
}

__device__ __forceinline__ void phaseC_attn(const Frame& F, int l, int b, int qt, bool do_store = true, int pmode = 0) {
    unsigned char* ws = F.ws; asm volatile("" : "+s"(ws)); ws = (unsigned char*)(GAS unsigned char*)ws;     const int w = F.wave;
    int lane = lane_id(), tid = F.wave * 64 + lane; asm volatile("" : "+v"(lane), "+v"(tid));
    const int r = lane & 31, hf = lane >> 5;
    const float* CS = (const float*)(ws + WS_CS);
    h16* QY = (h16*)(ws + WS_QY); const h16* KV = (const h16*)(ws + WS_KV);
    const h16* WUKT = (const h16*)(ws + WS_SMALLW + (size_t)l * SMALLW_LAYER); const h16* WUVT = (const h16*)(ws + WS_SMALLW + (size_t)l * SMALLW_LAYER + 98304);
    LAS unsigned char* lds = F.lds;
    const int t0 = 32 * qt, NT = qt + 1; const size_t tokbase = (size_t)b * SEQ;
    const int h = w; const size_t tokQ = tokbase + t0 + r;
    LAS h16* ql = (LAS h16*)(lds + C_QL + w * C_QLW);
    if (!(pmode & 64)) { h16x8 bq[3];
#pragma unroll
      for (int s = 0; s < 3; ++s) bq[s] = *(const GAS h16x8*)(QY + tokQ * 1024 + h * 64 + 16 + 16 * s + 8 * hf);
#pragma unroll
      for (int cb = 0; cb < 4; ++cb) { f32x16 D = {};
#pragma unroll
          for (int s = 0; s < 3; ++s) { const h16x8 a = *(const GAS h16x8*)(WUKT + ((size_t)(h * 128 + 32 * cb + r)) * 48 + 16 * s + 8 * hf); D = __builtin_amdgcn_mfma_f32_32x32x16_f16(a, bq[s], D, 0, 0, 0); }
#pragma unroll
          for (int g = 0; g < 4; ++g) { const int c = 32 * cb + 8 * g + 4 * hf;
              *(LAS u32x2*)(ql + r * KVP + c) = (u32x2){pkh(D[4 * g] * QSCALE, D[4 * g + 1] * QSCALE), pkh(D[4 * g + 2] * QSCALE, D[4 * g + 3] * QSCALE)}; } }
      { float o[8]; rope8(*(const GAS h16x8*)(QY + tokQ * 1024 + h * 64), *(const GAS h16x8*)(QY + tokQ * 1024 + h * 64 + 8), CS + tokQ * 16, hf, QSCALE, o); *(LAS u32x4*)(ql + r * KVP + 128 + 8 * hf) = pack8(o); } }
    LDS_WAIT();
    h16x8 qfr[9];
#pragma unroll
    for (int s = 0; s < 9; ++s) qfr[s] = *(const LAS h16x8*)(ql + r * KVP + 16 * s + 8 * hf);
    const char* kvsrc = (const char*)(KV + tokbase * KVP) + (size_t)(64 * w + lane) * 16;
    const unsigned kvdst = (unsigned)(uintptr_t)(lds + C_KVS) + (unsigned)w * 1024u;
    const int grp = w >> 2;
#define KV_DMA1(src_, dst_) do { unsigned keep_; asm volatile("s_mov_b32 %0, m0\n\ts_mov_b32 m0, %2\n\ts_nop 0\n\tglobal_load_lds_dwordx4 %1, off\n\ts_mov_b32 m0, %0" : "=&s"(keep_) : "v"(src_), "s"(dst_) : "memory"); } while (0)
#define KV_DMA(t_) do { const char* s_ = kvsrc + (size_t)(t_) * (32 * KVP * 2); const unsigned d_ = (unsigned)__builtin_amdgcn_readfirstlane((int)(kvdst + (unsigned)((t_) % 5) * (unsigned)C_KVSLOT)); \
        KV_DMA1(s_, d_); if (w < 2) { const char* s2_ = s_ + 8192; const unsigned d2_ = d_ + 8192u; KV_DMA1(s2_, d2_); } } while (0)
#define KV_WAIT(n_) do { if ((n_) <= 0) asm volatile("s_waitcnt vmcnt(0)" ::: "memory"); else if ((n_) == 1) { if (w < 2) asm volatile("s_waitcnt vmcnt(2)" ::: "memory"); else asm volatile("s_waitcnt vmcnt(1)" ::: "memory"); } \
        else { if (w < 2) asm volatile("s_waitcnt vmcnt(4)" ::: "memory"); else asm volatile("s_waitcnt vmcnt(2)" ::: "memory"); } } while (0)
#if defined(PROBE_C_ATT)
    { KV_DMA(0); if (NT > 1) KV_DMA(1); if (NT > 2) KV_DMA(2); if (NT > 3) KV_DMA(3); }
#endif
    asm volatile("s_waitcnt vmcnt(0)" ::: "memory");
    asm volatile("s_waitcnt lgkmcnt(0)" ::: "memory"); __builtin_amdgcn_s_barrier(); asm volatile("" ::: "memory");
    float mrun = 0.f, lrun = 0.f; f32x16 O[4]; f32x16 negm;
#pragma unroll
    for (int db = 0; db < 4; ++db) O[db] = (f32x16){};
#pragma unroll
    for (int R = 0; R < 16; ++R) negm[R] = 0.f;
    const LAS unsigned* WQr = (const LAS unsigned*)(lds + C_WQ) + r * 64;
    const int troff = ((lane & 15) >> 2) * (KVP * 2) + (16 * ((lane >> 4) & 1) + 4 * (lane & 3)) * 2 + 4 * hf * (KVP * 2);
    const int kbase = (int)(uintptr_t)(lds + C_KVS) + r * (KVP * 2) + 16 * hf, vbase = (int)(uintptr_t)(lds + C_KVS) + troff;
    typedef short s16x8 __attribute__((ext_vector_type(8)));
#define AT_MAX3(a_, b_, c_) ({ float r_; asm("v_max3_f32 %0, %1, %2, %3" : "=v"(r_) : "v"(a_), "v"(b_), "v"(c_)); r_; })
#define AT_MASKED(e_, w_, pos_) ({ int t_, r_; asm("v_bfe_i32 %0, %2, %3, 1\n\tv_and_b32 %1, %4, %0" : "=&v"(t_), "=v"(r_) : "v"(w_), "n"(pos_), "v"(e_)); __int_as_float(r_); })
#define AT_KLOAD(so_) h16x8 kfr[9]; do { const LAS unsigned char* sl_ = (const LAS unsigned char*)(uintptr_t)(kbase + (so_)); \
        if (!(pmode & 16)) { _Pragma("unroll") for (int s = 0; s < 9; ++s) kfr[s] = *(const LAS h16x8*)(sl_ + 32 * s); } else { _Pragma("unroll") for (int s = 0; s < 9; ++s) kfr[s] = qfr[s]; } __builtin_amdgcn_sched_barrier(0); } while (0)
#define AT_QK(S_) do { S_ = negm; if (!(pmode & 16)) { __builtin_amdgcn_s_setprio(1); _Pragma("unroll") for (int s = 0; s < 9; ++s) S_ = __builtin_amdgcn_mfma_f32_32x32x16_f16(kfr[s], qfr[s], S_, 0, 0, 0); __builtin_amdgcn_s_setprio(0); } } while (0)
#define AT_VLOAD(db0_) do { _Pragma("unroll") for (int db = 0; db < 2; ++db) _Pragma("unroll") for (int sp = 0; sp < 2; ++sp) { \
            vlo_[db][sp] = __builtin_amdgcn_ds_read_tr16_b64_v4i16((LAS v4i16_t*)(sl_ + (16 * sp) * (KVP * 2) + 64 * ((db0_) + db))); \
            vhi_[db][sp] = __builtin_amdgcn_ds_read_tr16_b64_v4i16((LAS v4i16_t*)(sl_ + (16 * sp + 8) * (KVP * 2) + 64 * ((db0_) + db))); } } while (0)
#define AT_PV2(db0_) do { __builtin_amdgcn_s_setprio(1); _Pragma("unroll") for (int db = 0; db < 2; ++db) _Pragma("unroll") for (int sp = 0; sp < 2; ++sp) { \
            const s16x8 av_ = {vlo_[db][sp][0], vlo_[db][sp][1], vlo_[db][sp][2], vlo_[db][sp][3], vhi_[db][sp][0], vhi_[db][sp][1], vhi_[db][sp][2], vhi_[db][sp][3]}; \
            O[(db0_) + db] = __builtin_amdgcn_mfma_f32_32x32x16_f16(__builtin_bit_cast(h16x8, av_), pf_[sp], O[(db0_) + db], 0, 0, 0); } __builtin_amdgcn_s_setprio(0); } while (0)
#define AT_SMPV(S_, t_, so_) do { const LAS unsigned char* sl_ = (const LAS unsigned char*)(uintptr_t)(vbase + (so_)); \
        v4i16_t vlo_[2][2], vhi_[2][2]; \
        AT_VLOAD(0); \
        const int wq_ = (int)(WQr[(t_)] >> (4 * hf)); \
        __builtin_amdgcn_sched_barrier(0); \
        float mt_ = AT_MAX3(S_[0], S_[1], S_[2]); \
        _Pragma("unroll") for (int R = 3; R < 15; R += 2) mt_ = AT_MAX3(mt_, S_[R], S_[R + 1]); \
        mt_ = half_swap_max(AT_MAX3(mt_, S_[15], S_[15])); \
        if ((t_) == 0 || __any(mt_ > 8.0f)) { const float dl_ = (t_) == 0 ? mt_ : fmaxf(mt_, 0.f), alpha_ = (t_) == 0 ? 1.f : __builtin_amdgcn_exp2f(-dl_);     \
            _Pragma("unroll") for (int db = 0; db < 4; ++db) O[db] = O[db] * alpha_; \
            _Pragma("unroll") for (int R = 0; R < 16; ++R) S_[R] -= dl_; \
            lrun *= alpha_; mrun += dl_; \
            _Pragma("unroll") for (int R = 0; R < 16; ++R) negm[R] = -mrun; } \
        float p_[16]; \
        if (!(pmode & 1)) { _Pragma("unroll") for (int R = 0; R < 16; ++R) { const float e_ = __builtin_amdgcn_exp2f(S_[R]); p_[R] = AT_MASKED(e_, wq_, (R & 3) + 8 * (R >> 2)); lrun += p_[R]; } } \
        else { _Pragma("unroll") for (int R = 0; R < 16; ++R) p_[R] = S_[R]; lrun += p_[0]; } \
        h16x8 pf_[2]; \
        _Pragma("unroll") for (int sp = 0; sp < 2; ++sp) { u32x4 t4_; t4_.x = pkz(p_[8 * sp], p_[8 * sp + 1]); t4_.y = pkz(p_[8 * sp + 2], p_[8 * sp + 3]); t4_.z = pkz(p_[8 * sp + 4], p_[8 * sp + 5]); t4_.w = pkz(p_[8 * sp + 6], p_[8 * sp + 7]); pf_[sp] = __builtin_bit_cast(h16x8, t4_); } \
        __builtin_amdgcn_sched_barrier(0); \
        if (!(pmode & 2)) { AT_PV2(0); \
        __builtin_amdgcn_sched_barrier(0); \
        AT_VLOAD(2); \
        __builtin_amdgcn_sched_barrier(0); \
        AT_PV2(2); } else { O[0][0] += (float)pf_[0][0] + (float)pf_[1][0]; } } while (0)
#define AT_BOUNDARY2(g_) do {   \
        if (!(pmode & 4)) { asm volatile("s_waitcnt vmcnt(0) lgkmcnt(0)" ::: "memory"); __builtin_amdgcn_s_barrier(); asm volatile("" ::: "memory"); \
        if (2 * (g_) + 4 < NT) KV_DMA(2 * (g_) + 4); if (2 * (g_) + 5 < NT) KV_DMA(2 * (g_) + 5); } } while (0)
#define AT_NEXT(so_) ((so_) == 4 * C_KVSLOT ? 0 : (so_) + C_KVSLOT)
    const int NG = (NT + 1) >> 1;
    if (grp == 0) {
        int so = 0;
#pragma unroll 1
        for (int g = 0; g < NG; ++g) { const int t = 2 * g;
            { f32x16 Sx; AT_KLOAD(so); AT_QK(Sx); __builtin_amdgcn_sched_barrier(0); AT_SMPV(Sx, t, so); so = AT_NEXT(so); }
            if (t + 1 < NT) { f32x16 Sx; AT_KLOAD(so); AT_QK(Sx); __builtin_amdgcn_sched_barrier(0); AT_SMPV(Sx, t + 1, so); so = AT_NEXT(so); }
            AT_BOUNDARY2(g); }
    } else {
        f32x16 Sx; int so = 0, sop = 0;
        { AT_KLOAD(so); AT_QK(Sx); } sop = so; so = AT_NEXT(so);
        if (1 < NT) { AT_SMPV(Sx, 0, sop); __builtin_amdgcn_sched_barrier(0); { AT_KLOAD(so); AT_QK(Sx); } sop = so; so = AT_NEXT(so); }
        AT_BOUNDARY2(0);
#pragma unroll 1
        for (int g = 1; g < NG; ++g) { const int t = 2 * g;
            AT_SMPV(Sx, t - 1, sop); __builtin_amdgcn_sched_barrier(0); { AT_KLOAD(so); AT_QK(Sx); } sop = so; so = AT_NEXT(so);
            if (t + 1 < NT) { AT_SMPV(Sx, t, sop); __builtin_amdgcn_sched_barrier(0); { AT_KLOAD(so); AT_QK(Sx); } sop = so; so = AT_NEXT(so); }
            AT_BOUNDARY2(g); }
        AT_SMPV(Sx, NT - 1, sop);
    }
#undef AT_NEXT
#undef AT_MAX3
#undef AT_MASKED
#undef AT_BOUNDARY2
#undef KV_DMA
#undef KV_DMA1
#undef KV_WAIT
#undef AT_KLOAD
#undef AT_QK
#undef AT_SMPV
#undef AT_VLOAD
#undef AT_PV2
    if (!(pmode & 32)) {
    h16x8 bwv[2][8];
#pragma unroll
    for (int d2 = 0; d2 < 2; ++d2)
#pragma unroll
        for (int s = 0; s < 8; ++s) bwv[d2][s] = *(const GAS h16x8*)(WUVT + ((size_t)(h * 64 + 32 * d2 + r)) * 128 + 16 * s + 8 * hf);
    { const float inv = 1.0f / half_swap_sum(lrun);
#pragma unroll
      for (int db = 0; db < 4; ++db)
#pragma unroll
          for (int g = 0; g < 4; ++g) { const int c = 32 * db + 8 * g + 4 * hf;
              *(LAS u32x2*)(ql + r * KVP + c) = (u32x2){pkh(O[db][4 * g] * inv, O[db][4 * g + 1] * inv), pkh(O[db][4 * g + 2] * inv, O[db][4 * g + 3] * inv)}; } }
    LDS_WAIT();
    { h16x8 ao[8];
#pragma unroll
      for (int s = 0; s < 8; ++s) ao[s] = *(const LAS h16x8*)(ql + r * KVP + 16 * s + 8 * hf);
#pragma unroll
      for (int d2 = 0; d2 < 2; ++d2) { f32x16 D = {};
#pragma unroll
          for (int s = 0; s < 8; ++s) D = __builtin_amdgcn_mfma_f32_32x32x16_f16(bwv[d2][s], ao[s], D, 0, 0, 0);
#pragma unroll
          for (int g = 0; g < 4; ++g) { const u32x2 pk = {pkh(D[4 * g], D[4 * g + 1]), pkh(D[4 * g + 2], D[4 * g + 3])};
              if (do_store) *(GAS u32x2*)(QY + (tokbase + t0 + r) * 1024 + h * 64 + 32 * d2 + 8 * g + 4 * hf) = pk; else asm volatile("" :: "v"(pk)); } } }
    } else { asm volatile("" :: "v"(O[0][0]), "v"(O[1][0]), "v"(O[2][0]), "v"(O[3][0]), "v"(lrun)); }
    LDS_WAIT(); __syncthreads();
}

__device__ __forceinline__ void phaseC(const Frame& F, int l) {
    int vc = F.vcu; asm volatile("" : "+s"(vc)); const int b = vc >> 5, i = vc & 31;
#pragma unroll 1
    for (int u = 0; u < 2; ++u) { const int qt = (u == 0) ? 63 - i : i;
#if defined(PROBE_C_SEL)
#pragma unroll 1
        for (int rep = 0; rep < 2; ++rep)
        phaseC_select(F, l, b, qt, rep == 0 ? PROBE_C_SEL : 0);
#else
        phaseC_select(F, l, b, qt);
#endif
#if defined(PROBE_C_ATT)
#pragma unroll 1
        for (int rep = 0; rep < 2; ++rep) phaseC_attn(F, l, b, qt, rep == 1, rep == 1 ? 0 : PROBE_C_ATT);
#else
        phaseC_attn(F, l, b, qt);
#endif
    }
}
#if defined(PROBE_STORE)
#define PROBE_NOSTORE(f) (f)
#else
#define PROBE_NOSTORE(f) 0
#endif
#if defined(PROBE_EPI)
#define PROBE_NOEPI(f) (f)
#else
#define PROBE_NOEPI(f) 0
#endif
#ifndef PROBE_MASK
#define PROBE_MASK 0u
#endif
#ifndef MK_N_LAUNCHES
#define MK_N_LAUNCHES 1
#endif
constexpr int N_PHASES = 2 + 7 * NLAYER;
constexpr int CONV_SPLIT = 2150;
struct Args { In in; float* out; unsigned char* ws; int ph_lo, ph_hi, flags, pad; };

__global__ void __launch_bounds__(NTHREADS, 2) mk_fwd(Args args) {
    extern __shared__ __attribute__((aligned(16))) unsigned char lds_raw[];
    Frame F; F.lds = (LAS unsigned char*)lds_raw; F.wave = __builtin_amdgcn_readfirstlane((int)threadIdx.x >> 6);
    F.G = gridDim.x; { const int bx = blockIdx.x; F.vcu = (F.G % 8 == 0) ? (bx % 8) * (F.G / 8) + bx / 8 : bx; }
    F.ws = args.ws; F.in = nullptr;
    const In& I = args.in; unsigned char* ws = args.ws; (void)ws;
    volatile LAS unsigned* MISCW = (volatile LAS unsigned*)(F.lds + LDS_MISC);
    if (F.wave == 0) MISCW[lane_id()] = 0u;
    __syncthreads();
#if MK_N_LAUNCHES == 1
    const bool one_launch = true;
#else
    const bool one_launch = (args.ph_hi - args.ph_lo) > 1;
#endif
    XcdBarrier bar; bar.bar = (unsigned*)(ws + WS_CTL) + 1024; bar.x = 0; bar.st = nullptr;
    if (one_launch) bar = xcd_barrier_post((unsigned*)(ws + WS_CTL) + 1024, MISCW + 8, F.wave);
#if MK_N_LAUNCHES == 1
#define IN(k) true
#define SEAM(k) xcd_barrier(bar, F.wave)
#else
#define IN(k) (args.ph_lo <= (k) && (k) < args.ph_hi)
#define SEAM(k) do { if (IN(k) && IN((k) + 1)) xcd_barrier(bar, F.wave); } while (0)
#endif
    if (IN(0)) { p0_prologue(F, I); SEAM(0); }
#define OPQ(x) asm volatile("" : "+s"(x))
#pragma unroll 1
    for (int l0 = 0; l0 < NLAYER; ++l0) {
        const int p = 1 + 7 * l0;
        if (IN(p)) {
            unsigned char* wsq = args.ws; int l = l0; OPQ(wsq); OPQ(l); wsq = (unsigned char*)(GAS unsigned char*)wsq; unsigned char* wl = wsq + WS_W + (size_t)l * W_LAYER;
            pg8::Gemm g{(const h16*)(wsq + WS_X16), (const h16*)(wl + W_OFF_IN), 1024, 1024, 1024, M / 256, NZ / 256, 1, 0, PROBE_NOEPI(args.flags), 0};
            pg8::Order S; S.init(g.nM, g.nN, F.G, (int)blockIdx.x, 1); EpiA E{wsq, PROBE_NOSTORE(args.flags), (LAS float*)(F.lds + 131072 + 4096)};
            pg8::gemm_phase<EpiA>(F.lds, g, S, E, F.wave);
            { constexpr int NBIG = ((M / 256) * (NZ / 256)) % 256;
              if ((int)blockIdx.x >= NBIG && F.G == 256) convert_layer_weights(F, I, l, ((int)blockIdx.x - NBIG) * NWAVES + F.wave, (256 - NBIG) * NWAVES, CONV_IN_ITEMS, 1 << 30);
              else if (F.G != 256) { xcd_barrier(bar, F.wave); convert_layer_weights(F, I, l, F.vcu * NWAVES + F.wave, F.G * NWAVES, CONV_IN_ITEMS, 1 << 30); } }
            SEAM(p); }
        if (IN(p + 1)) { int l = l0; OPQ(l); phaseB(F, I, l); SEAM(p + 1); }
        if (IN(p + 2)) { int l = l0; OPQ(l); phaseC(F, l); SEAM(p + 2); }
        if (IN(p + 3)) {
            unsigned char* wsq = args.ws; int l = l0; OPQ(wsq); OPQ(l); wsq = (unsigned char*)(GAS unsigned char*)wsq; unsigned char* wl = wsq + WS_W + (size_t)l * W_LAYER;
            pg8::Gemm g{(const h16*)(wsq + WS_QY), (const h16*)(wl + W_OFF_PAB), 1024, 1024, 512, M / 256, 4, 2, 512, PROBE_NOEPI(args.flags), 0};
            pg8::Order S; S.init(g.nM, g.nN, F.G, (int)blockIdx.x, 2); EpiD E{wsq, (h16*)args.out};
            pg8::gemm_phase<EpiD>(F.lds, g, S, E, F.wave); SEAM(p + 3); }
        if (IN(p + 4)) {
            unsigned char* wsq = args.ws; int l = l0; OPQ(wsq); OPQ(l); wsq = (unsigned char*)(GAS unsigned char*)wsq; unsigned char* wl = wsq + WS_W + (size_t)l * W_LAYER;
            pg8::Gemm g{(const h16*)args.out, (const h16*)(wl + W_OFF_OUT), 1024, 1024, 1024, M / 256, 4, 1, 0, PROBE_NOEPI(args.flags), 0};
            pg8::Order S; S.init(g.nM, g.nN, F.G, (int)blockIdx.x, 1);
            EpiRes E{(const h16*)(wsq + WS_X16), (h16*)(wsq + WS_X1), (float*)(wsq + WS_SSQ), (LAS float*)(F.lds + 131072)};
            pg8::gemm_phase<EpiRes>(F.lds, g, S, E, F.wave); SEAM(p + 4); }
        if (IN(p + 5)) {
            unsigned char* wsq = args.ws; int l = l0; OPQ(wsq); OPQ(l); wsq = (unsigned char*)(GAS unsigned char*)wsq; unsigned char* wl = wsq + WS_W + (size_t)l * W_LAYER;
            pg8::Gemm g{(const h16*)(wsq + WS_X1), (const h16*)(wl + W_OFF_GU), 1024, 1024, 1024, M / 256, NGU / 256, 1, 0, PROBE_NOEPI(args.flags), 0};
            pg8::Order S; S.init(g.nM, g.nN, F.G, (int)blockIdx.x, 1); EpiF E{wsq, (LAS float*)(F.lds + 131072 + 4096)};
            pg8::gemm_phase<EpiF>(F.lds, g, S, E, F.wave);
            { constexpr int NBIG = ((M / 256) * (NGU / 256)) % 256;
              if (l + 1 < NLAYER && (int)blockIdx.x >= NBIG && F.G == 256) convert_layer_weights(F, I, l + 1, ((int)blockIdx.x - NBIG) * NWAVES + F.wave, (256 - NBIG) * NWAVES, 0, CONV_IN_ITEMS);
              else if (l + 1 < NLAYER && F.G != 256) { xcd_barrier(bar, F.wave); convert_layer_weights(F, I, l + 1, F.vcu * NWAVES + F.wave, F.G * NWAVES, 0, CONV_IN_ITEMS); } }
            SEAM(p + 5); }
        if (IN(p + 6)) {
            unsigned char* wsq = args.ws; int l = l0; OPQ(wsq); OPQ(l); wsq = (unsigned char*)(GAS unsigned char*)wsq; unsigned char* wl = wsq + WS_W + (size_t)l * W_LAYER;
            pg8::Gemm g{(const h16*)(wsq + WS_ACT), (const h16*)(wl + W_OFF_D), DFF, DFF, DFF, M / 256, 4, 1, 0, PROBE_NOEPI(args.flags), 0};
            pg8::Order S; S.init(g.nM, g.nN, F.G, (int)blockIdx.x, 1);
            EpiRes E{(const h16*)(wsq + WS_X1), (h16*)(wsq + WS_X16), (float*)(wsq + WS_SSQ), (LAS float*)(F.lds + 131072)};
            pg8::gemm_phase<EpiRes>(F.lds, g, S, E, F.wave); SEAM(p + 6); }
    }
    if (IN(N_PHASES - 1)) final_norm_phase(F, (const h16*)(args.ws + WS_X16), args.out, I.final_norm);
#undef IN
#undef SEAM
}

extern "C" void kernel_launch(void* const* d_in, const int* in_sizes, int n_in, void* d_out, int out_size, void* d_ws, size_t ws_size, hipStream_t stream) {
    static int grid = 0;
    if (grid == 0) {
        if (n_in != 19 || out_size != M * DM || ws_size < WS_END) { fprintf(stderr, "kernel_launch: unexpected shapes (n_in %d out %d ws %zu)\n", n_in, out_size, ws_size); grid = -1; return; }
        int dev = 0, cus = 0, per_cu = 0;
        hipGetDevice(&dev); hipDeviceGetAttribute(&cus, hipDeviceAttributeMultiprocessorCount, dev);
        hipFuncSetAttribute((const void*)mk_fwd, hipFuncAttributeMaxDynamicSharedMemorySize, LDS_BYTES);
        hipOccupancyMaxActiveBlocksPerMultiprocessor(&per_cu, (const void*)mk_fwd, NTHREADS, LDS_BYTES);
        (void)hipGetLastError();
        if (per_cu < 1) fprintf(stderr, "kernel_launch: occupancy query reports %d blocks per CU\n", per_cu);
        grid = cus;
    }
    if (grid < 0) return;
    hipMemsetAsync((char*)d_ws + WS_CTL, 0, CTL_ZERO_BYTES, stream);
    Args a{};
    const void** ip = (const void**)&a.in;
    for (int i = 0; i < 19; ++i) ip[i] = d_in[i];
    a.out = (float*)d_out; a.ws = (unsigned char*)d_ws;
#if MK_N_LAUNCHES == 1
    a.ph_lo = 0; a.ph_hi = N_PHASES;
    { void* kargs[] = {&a}; hipError_t e = hipLaunchCooperativeKernel((const void*)mk_fwd, dim3(grid), dim3(NTHREADS), kargs, LDS_BYTES, stream);
      if (e != hipSuccess) fprintf(stderr, "cooperative launch failed: %s (grid %d)\n", hipGetErrorString(e), grid); }
#else
    for (int p = 0; p < N_PHASES; ++p) { const int reps = ((PROBE_MASK >> p) & 1u) ? 2 : 1;
        for (int rr = 0; rr < reps; ++rr) { a.ph_lo = p; a.ph_hi = p + 1; a.flags = (rr > 0) ? 1 : 0; hipLaunchKernelGGL(mk_fwd, dim3(grid), dim3(NTHREADS), LDS_BYTES, stream, a); } }
#endif
}
```

```cpp
#define MK_N_LAUNCHES 1
#include <hip/hip_runtime.h>
#include <stdint.h>
#include <math.h>
#include <cstdio>

#define LAS __attribute__((address_space(3)))
#define GAS __attribute__((address_space(1)))
typedef _Float16 h16;
typedef h16 h16x8 __attribute__((ext_vector_type(8)));
typedef h16 h16x4 __attribute__((ext_vector_type(4)));
typedef h16 h16x2 __attribute__((ext_vector_type(2)));
typedef float f32x2 __attribute__((ext_vector_type(2)));
typedef float f32x4 __attribute__((ext_vector_type(4)));
typedef float f32x16 __attribute__((ext_vector_type(16)));
typedef unsigned u32x2 __attribute__((ext_vector_type(2)));
typedef unsigned u32x4 __attribute__((ext_vector_type(4)));
typedef short v4i16_t __attribute__((ext_vector_type(4)));

__device__ __forceinline__ int lane_id() { return (int)__builtin_amdgcn_mbcnt_hi(~0u, __builtin_amdgcn_mbcnt_lo(~0u, 0u)); }
__device__ __forceinline__ unsigned pkh(float lo, float hi) { h16x2 v = {(h16)lo, (h16)hi}; return __builtin_bit_cast(unsigned, v); }
__device__ __forceinline__ unsigned pkz(float lo, float hi) { return __builtin_bit_cast(unsigned, __builtin_amdgcn_cvt_pkrtz(lo, hi)); }
__device__ __forceinline__ void store16_wt(void* p, u32x4 v) { asm volatile("global_store_dwordx4 %0, %1, off sc1\n\ts_nop 1" :: "v"(p), "v"(v) : "memory"); }
__device__ __forceinline__ float h2f_lo(unsigned u) { h16x2 v = __builtin_bit_cast(h16x2, u); return (float)v[0]; }
__device__ __forceinline__ float h2f_hi(unsigned u) { h16x2 v = __builtin_bit_cast(h16x2, u); return (float)v[1]; }

namespace pg8 {
constexpr int BM = 256, BK = 64, HALF = 128, HTB = HALF * BK * 2, STAGE_BYTES = 8 * HTB, NXCD = 8, WGM = 4;
__host__ __device__ __forceinline__ int lds_byte(int r, int c) { const int st = (r >> 4) * 2 + (c >> 5), rr = r & 15, cc = c & 31, ob = rr * 64 + cc * 2; return st * 1024 + (ob ^ (((ob >> 9) & 1) << 5)); }
__host__ __device__ __forceinline__ void stage_rc(int b, int& R, int& C) { const int st = b / 1024, sb = b % 1024, swz = sb ^ (((sb >> 9) & 1) << 5); R = (st >> 1) * 16 + swz / 64; C = (st & 1) * 32 + (swz % 64) / 2; }
__host__ __device__ __forceinline__ int perm32(int rho) { const int n = rho >> 4, i = rho & 15; return 8 * (i >> 2) + 4 * n + (i & 3); }

struct Unit { int pm, pn, kind, half; };
struct Gemm { const h16* A; const h16* Bt; int lda, ldb, K, nM, nN, nkind, koff, noepi, stagger; };

struct Order {
    int nM, nN, nwg, G, c, nk, lim;
    __device__ void init(int nM_, int nN_, int G_, int c_, int nk_, int lim_ = -1) { asm volatile("" : "+s"(G_), "+s"(c_)); nM = nM_; nN = nN_; nwg = nM * nN; G = G_; c = c_; nk = nk_; lim = lim_ < 0 ? nwg : lim_; }
    __device__ void tile_of(int L, Unit& u) const {
        int wgid = L; { const int q = nwg / NXCD, r = nwg % NXCD, xcd = wgid % NXCD, off = wgid / NXCD; wgid = (xcd < r ? xcd * (q + 1) : r * (q + 1) + (xcd - r) * q) + off; }
        const int nig = WGM * nN, gid = wgid / nig, fm = gid * WGM, gsz = (nM - fm) < WGM ? (nM - fm) : WGM;
        u.pm = fm + ((wgid % nig) % gsz); u.pn = (wgid % nig) / gsz;
    }
    __device__ bool next(int i, Unit& u) const {
        const int ti = i / nk; u.kind = i - ti * nk; u.half = -1;
        const long L = (long)ti * G + c; if (L >= lim) return false;
        tile_of((int)L, u); return true;
    }
};

template <class Epi>
__device__ __forceinline__ void gemm_phase(LAS unsigned char* lds, const Gemm g, const Order& S, const Epi& E, int wave_) {
    int tid = wave_ * 64 + lane_id(); asm volatile("" : "+v"(tid));
    const int wid = __builtin_amdgcn_readfirstlane(tid >> 6), lane = tid & 63, wr = wid >> 2, wc = wid & 3, fr = lane & 15, fq = lane >> 4;
    const int nt = g.K / BK;
    unsigned voffA[2], voffB[2];
#pragma unroll
    for (int i = 0; i < 2; ++i) { int R, C; stage_rc(tid * 16 + i * 8192, R, C); const int Rb = Epi::PERM ? ((R & ~31) + perm32(R & 31)) : R;
        voffA[i] = (unsigned)(R * g.lda + C) * 2u; voffB[i] = (unsigned)(Rb * g.ldb + C) * 2u; }
    const size_t kstep = (size_t)(BK * 2);
    const size_t hstepA = (size_t)HALF * g.lda * 2, hstepB = (size_t)HALF * g.ldb * 2;
    const unsigned ldsw = (unsigned)wid * 1024u;
    const int aoff = lds_byte(wr * 64 + fr, fq * 8), boff = lds_byte(wc * 32 + fr, fq * 8);
#define PG8_SA(b, h) (((b) * 2 + (h)) * HTB)
#define PG8_SB(b, h) ((4 + (b) * 2 + (h)) * HTB)
#define PG8_STAGE(bufoff, gbase, voff) do { _Pragma("unroll") for (int _i = 0; _i < 2; ++_i) \
        __builtin_amdgcn_global_load_lds((const unsigned*)((const char*)(gbase) + (voff)[_i]), (LAS unsigned*)(lds + (bufoff) + ldsw + _i * 8192), 16, 0, 0); } while (0)
#define PG8_LDA(dst, b, h) do { _Pragma("unroll") for (int m = 0; m < 4; ++m) _Pragma("unroll") for (int k = 0; k < 2; ++k) dst[m][k] = *(const LAS h16x8*)(lds + PG8_SA(b, h) + aoff + m * 2048 + k * 1024); } while (0)
#define PG8_LDB(dst, b, h) do { _Pragma("unroll") for (int n = 0; n < 2; ++n) _Pragma("unroll") for (int k = 0; k < 2; ++k) dst[n][k] = *(const LAS h16x8*)(lds + PG8_SB(b, h) + boff + n * 2048 + k * 1024); } while (0)
#define PG8_MMA(ai, bj, At, Bt) do { __builtin_amdgcn_s_setprio(1); _Pragma("unroll") for (int m = 0; m < 4; ++m) _Pragma("unroll") for (int n = 0; n < 2; ++n) _Pragma("unroll") for (int k = 0; k < 2; ++k) \
        acc[ai][bj][m][n] = __builtin_amdgcn_mfma_f32_16x16x32_f16(Bt[n][k], At[m][k], acc[ai][bj][m][n], 0, 0, 0); __builtin_amdgcn_s_setprio(0); } while (0)
#define PG8_WAIT_V(n) asm volatile("s_waitcnt vmcnt(" #n ")" ::: "memory")
#define PG8_WAIT_L(n) asm volatile("s_waitcnt lgkmcnt(" #n ")" ::: "memory")
#define PG8_BAR __builtin_amdgcn_s_barrier()
#define PG8_SCHED __builtin_amdgcn_sched_barrier(0)
#define PG8_PA(u) ((const char*)g.A + ((size_t)(u).pm * 256 * g.lda + (size_t)(u).kind * g.koff) * 2)
#define PG8_PB(u) ((const char*)g.Bt + ((size_t)(u).pn * 256 * g.ldb + (size_t)(u).kind * g.koff) * 2)
    Unit cur, nxt; int ui = 0;
    if (!S.next(0, cur)) return;
    { const int nbig = S.nwg % S.G;
      if (nbig > 0 && S.c >= nbig && g.stagger) { const int ngrp = S.G / nbig, j = S.c / nbig; const unsigned long long dl = (unsigned long long)((g.K / BK) * 140 + 100) * S.nk * j / ngrp;
          const unsigned long long t0 = __builtin_amdgcn_s_memrealtime(); while (__builtin_amdgcn_s_memrealtime() - t0 < dl) __builtin_amdgcn_s_sleep(32); } }
    f32x4 acc[2][2][4][2];
#pragma unroll
    for (int a = 0; a < 2; ++a)
#pragma unroll
        for (int b = 0; b < 2; ++b)
#pragma unroll
            for (int m = 0; m < 4; ++m)
#pragma unroll
                for (int n = 0; n < 2; ++n) acc[a][b][m][n] = (f32x4){0.f, 0.f, 0.f, 0.f};
    h16x8 At[4][2], B0[2][2], B1[2][2];
    const char* cA = PG8_PA(cur); const char* cB = PG8_PB(cur);
    E.prefetch(cur, wid, lane);
    PG8_STAGE(PG8_SB(0, 0), cB, voffB); PG8_STAGE(PG8_SB(0, 1), cB + hstepB, voffB); PG8_STAGE(PG8_SA(0, 0), cA, voffA); PG8_STAGE(PG8_SA(0, 1), cA + hstepA, voffA);
    if (wr == 1) PG8_BAR;
    PG8_WAIT_V(2); PG8_BAR;
    PG8_STAGE(PG8_SB(1, 0), cB + kstep, voffB); PG8_STAGE(PG8_SA(1, 0), cA + kstep, voffA); PG8_STAGE(PG8_SB(1, 1), cB + hstepB + kstep, voffB);
    PG8_WAIT_V(6); PG8_BAR;
    for (;;) {
        const bool has_next = S.next(ui + 1, nxt);
        const char* nA = has_next ? PG8_PA(nxt) : cA; const char* nB = has_next ? PG8_PB(nxt) : cB;
        for (int t = 0; t < nt; t += 2) {
            const bool last = (t == nt - 2);
            const char* a1 = cA + (size_t)(t + 1) * kstep;
            const char* a2 = last ? nA : cA + (size_t)(t + 2) * kstep; const char* b2 = last ? nB : cB + (size_t)(t + 2) * kstep;
            const char* a3 = a2 + kstep; const char* b3 = b2 + kstep;
            PG8_LDB(B0, 0, 0); PG8_LDB(B1, 0, 1); PG8_SCHED; PG8_LDA(At, 0, 0); PG8_STAGE(PG8_SA(1, 1), a1 + hstepA, voffA);
            PG8_WAIT_V(8); PG8_WAIT_L(0); PG8_BAR; PG8_MMA(0, 0, At, B0); PG8_MMA(0, 1, At, B1); PG8_BAR; PG8_SCHED;
            PG8_LDA(At, 0, 1); PG8_STAGE(PG8_SB(0, 0), b2, voffB); PG8_STAGE(PG8_SB(0, 1), b2 + hstepB, voffB); PG8_STAGE(PG8_SA(0, 0), a2, voffA);
            PG8_WAIT_V(8); PG8_WAIT_L(0); PG8_BAR; PG8_MMA(1, 0, At, B0); PG8_MMA(1, 1, At, B1); PG8_BAR; PG8_SCHED;
            PG8_LDB(B0, 1, 0); PG8_LDB(B1, 1, 1); PG8_SCHED; PG8_LDA(At, 1, 0); PG8_STAGE(PG8_SA(0, 1), a2 + hstepA, voffA);
            PG8_WAIT_V(8); PG8_WAIT_L(0); PG8_BAR; PG8_MMA(0, 0, At, B0); PG8_MMA(0, 1, At, B1); PG8_BAR; PG8_SCHED;
            PG8_LDA(At, 1, 1); PG8_STAGE(PG8_SB(1, 0), b3, voffB); PG8_STAGE(PG8_SB(1, 1), b3 + hstepB, voffB); PG8_STAGE(PG8_SA(1, 0), a3, voffA);
            PG8_WAIT_V(8); PG8_WAIT_L(0); PG8_BAR; PG8_MMA(1, 0, At, B0); PG8_MMA(1, 1, At, B1); PG8_BAR; PG8_SCHED;
        }
        if (wr == 0) PG8_BAR;
        { int fr_ = fr, fq_ = fq; asm volatile("" : "+v"(fr_), "+v"(fq_)); if (!g.noepi) E(acc, cur, wr, wc, fr_, fq_); }
        if (!has_next) break;
        if (nxt.kind == 0) {
#pragma unroll
            for (int a = 0; a < 2; ++a)
#pragma unroll
                for (int b = 0; b < 2; ++b)
#pragma unroll
                    for (int m = 0; m < 4; ++m)
#pragma unroll
                        for (int n = 0; n < 2; ++n) acc[a][b][m][n] = (f32x4){0.f, 0.f, 0.f, 0.f};
        }
        cur = nxt; cA = nA; cB = nB; ++ui;
        if (cur.kind == 0) E.prefetch(cur, wid, lane);
        if (wr == 1) PG8_BAR;
    }
    PG8_WAIT_V(0);
    PG8_BAR;
#undef PG8_SA
#undef PG8_SB
#undef PG8_STAGE
#undef PG8_LDA
#undef PG8_LDB
#undef PG8_MMA
#undef PG8_WAIT_V
#undef PG8_WAIT_L
#undef PG8_BAR
#undef PG8_SCHED
#undef PG8_PA
#undef PG8_PB
}

template <class Epi>
__device__ __forceinline__ void gemm_tail_phase(LAS unsigned char* lds, const Gemm g, const Order& S, const Epi& E, int wave_) {
    const int ntail = S.nwg - S.lim;
    if (ntail <= 0 || S.c >= 2 * ntail) return;
    int tid = wave_ * 64 + lane_id(); asm volatile("" : "+v"(tid));
    const int wid = __builtin_amdgcn_readfirstlane(tid >> 6), lane = tid & 63, wr = wid >> 2, wc = wid & 3, fr = lane & 15, fq = lane >> 4;
    Unit cur; S.tile_of(S.lim + S.c % ntail, cur); cur.kind = 0; cur.half = S.c / ntail;
    const int nt = g.K / BK;
    unsigned voffA[2], voffB[2];
#pragma unroll
    for (int i = 0; i < 2; ++i) { int R, C; stage_rc(tid * 16 + i * 8192, R, C); const int Rb = Epi::PERM ? ((R & ~31) + perm32(R & 31)) : R;
        voffA[i] = (unsigned)(R * g.lda + C) * 2u; voffB[i] = (unsigned)(Rb * g.ldb + C) * 2u; }
    const size_t kstep = (size_t)(BK * 2);
    const size_t hstepA = (size_t)HALF * g.lda * 2, hstepB = (size_t)HALF * g.ldb * 2;
    const unsigned ldsw = (unsigned)wid * 1024u;
    const int aoff = lds_byte(wr * 64 + fr, fq * 8), boff = lds_byte(wc * 32 + fr, fq * 8);
    constexpr int TSTG = 3 * HTB;
    const char* cA = (const char*)g.A + ((size_t)cur.pm * 256 * g.lda) * 2 + (size_t)cur.half * hstepA; const char* cB = (const char*)g.Bt + ((size_t)cur.pn * 256 * g.ldb) * 2;
#define PT_STAGE(bufoff, gbase, voff) do { _Pragma("unroll") for (int _i = 0; _i < 2; ++_i) \
        __builtin_amdgcn_global_load_lds((const unsigned*)((const char*)(gbase) + (voff)[_i]), (LAS unsigned*)(lds + (bufoff) + ldsw + _i * 8192), 16, 0, 0); } while (0)
#define PT_STAGE_TILE(kt) do { const int so_ = ((kt) % 3) * TSTG; const char* a_ = cA + (size_t)(kt) * kstep; const char* b_ = cB + (size_t)(kt) * kstep; \
        PT_STAGE(so_, a_, voffA); PT_STAGE(so_ + HTB, b_, voffB); PT_STAGE(so_ + 2 * HTB, b_ + hstepB, voffB); } while (0)
#define PT_LD(kt) do { const int so_ = ((kt) % 3) * TSTG; \
        _Pragma("unroll") for (int n = 0; n < 2; ++n) _Pragma("unroll") for (int k_ = 0; k_ < 2; ++k_) { B0[n][k_] = *(const LAS h16x8*)(lds + so_ + HTB + boff + n * 2048 + k_ * 1024); B1[n][k_] = *(const LAS h16x8*)(lds + so_ + 2 * HTB + boff + n * 2048 + k_ * 1024); } \
        _Pragma("unroll") for (int m = 0; m < 4; ++m) _Pragma("unroll") for (int k_ = 0; k_ < 2; ++k_) At[m][k_] = *(const LAS h16x8*)(lds + so_ + aoff + m * 2048 + k_ * 1024); } while (0)
#define PT_MMA(bj, Bt_) do { __builtin_amdgcn_s_setprio(1); _Pragma("unroll") for (int m = 0; m < 4; ++m) _Pragma("unroll") for (int n = 0; n < 2; ++n) _Pragma("unroll") for (int k_ = 0; k_ < 2; ++k_) \
        acc[0][bj][m][n] = __builtin_amdgcn_mfma_f32_16x16x32_f16(Bt_[n][k_], At[m][k_], acc[0][bj][m][n], 0, 0, 0); __builtin_amdgcn_s_setprio(0); } while (0)
#define PT_WAIT_V(n) asm volatile("s_waitcnt vmcnt(" #n ")" ::: "memory")
#define PT_WAIT_L0 asm volatile("s_waitcnt lgkmcnt(0)" ::: "memory")
#define PT_BAR __builtin_amdgcn_s_barrier()
    f32x4 acc[2][2][4][2];
#pragma unroll
    for (int a = 0; a < 2; ++a)
#pragma unroll
        for (int b = 0; b < 2; ++b)
#pragma unroll
            for (int m = 0; m < 4; ++m)
#pragma unroll
                for (int n = 0; n < 2; ++n) acc[a][b][m][n] = (f32x4){0.f, 0.f, 0.f, 0.f};
    h16x8 At[4][2], B0[2][2], B1[2][2];
    E.prefetch(cur, wid, lane);
    PT_STAGE_TILE(0); PT_STAGE_TILE(1); PT_STAGE_TILE(2);
    PT_WAIT_V(12); PT_BAR;
    if (wr == 1) PT_BAR;
    if (wr == 0) {
#pragma unroll 1
        for (int k = 0; k < nt; ++k) {
            if (k >= 1 && k + 2 < nt) PT_STAGE_TILE(k + 2);
            PT_LD(k); PT_WAIT_L0; PT_BAR;
            PT_MMA(0, B0); PT_MMA(1, B1);
            if (k + 2 < nt) PT_WAIT_V(6); else PT_WAIT_V(0);
            PT_BAR; }
        PT_BAR;
    } else {
#pragma unroll 1
        for (int k = 0; k < nt; ++k) {
            PT_LD(k); PT_WAIT_L0;
            if (k + 2 < nt) PT_WAIT_V(6); else PT_WAIT_V(0);
            PT_BAR;
            if (k + 3 < nt) PT_STAGE_TILE(k + 3);
            PT_MMA(0, B0); PT_MMA(1, B1);
            PT_BAR; }
    }
    { int fr_ = fr, fq_ = fq; asm volatile("" : "+v"(fr_), "+v"(fq_)); if (!g.noepi) E(acc, cur, wr, wc, fr_, fq_); }
#undef PT_STAGE
#undef PT_STAGE_TILE
#undef PT_LD
#undef PT_MMA
#undef PT_WAIT_V
#undef PT_WAIT_L0
#undef PT_BAR
}
}
constexpr int NWAVES = 8, NTHREADS = 512;
constexpr int NB = 8, SEQ = 2048, DM = 1024, M = NB * SEQ, DIN = 4312, DFF = 2816, NLAYER = 2;
constexpr int NZ = 4352;
constexpr int NGU = 2 * DFF;
constexpr float EPS_RMS = 1e-6f;
constexpr float LOG2E = 1.4426950408889634f;
constexpr float QSCALE = 0.125f * LOG2E;
constexpr int KVP = 152;

constexpr size_t MiB = 1u << 20;
constexpr size_t WS_CTL = 0, CTL_ZERO_BYTES = 65536;
constexpr size_t WS_CS = 1 * MiB;
constexpr size_t WS_SSQ = 2 * MiB;
constexpr size_t WS_WI = 3 * MiB;
constexpr size_t WS_SMALLW = 4 * MiB;
constexpr size_t SMALLW_LAYER = 98304 + 131072 + 262144;
constexpr size_t WS_W = 6 * MiB;
constexpr size_t W_LAYER = 29 * MiB, W_OFF_IN = 0, W_OFF_PAB = (size_t)NZ * 1024 * 2, W_OFF_OUT = W_OFF_PAB + 2 * MiB, W_OFF_GU = W_OFF_OUT + 2 * MiB, W_OFF_D = W_OFF_GU + (size_t)NGU * 1024 * 2;
static_assert(W_OFF_D + (size_t)1024 * DFF * 2 == W_LAYER, "weight map");
constexpr size_t WS_X16 = 64 * MiB;
constexpr size_t WS_QY = 96 * MiB;
constexpr size_t WS_QI = 128 * MiB;
constexpr size_t WS_MISC = 144 * MiB;
constexpr size_t WS_KV = 152 * MiB;
constexpr size_t WS_KI = 157 * MiB;
constexpr size_t WS_X1 = 128 * MiB;
constexpr size_t WS_GATES = 160 * MiB;
constexpr size_t WS_UV = 224 * MiB;
constexpr size_t WS_ACT = 160 * MiB;
constexpr size_t WS_END = 256 * MiB;
static_assert(WS_KV + (size_t)M * KVP * 2 <= WS_KI && WS_KI + (size_t)M * 64 * 2 <= WS_GATES && WS_ACT + (size_t)M * DFF * 2 <= WS_END, "ws map");

constexpr int LDS_BYTES = 155648;
constexpr int LDS_MISC = 151552;

#define RLX_AGENT __ATOMIC_RELAXED, __HIP_MEMORY_SCOPE_AGENT
#define LDS_WAIT() asm volatile("s_waitcnt lgkmcnt(0)" ::: "memory")
#define VM_WAIT() asm volatile("s_waitcnt vmcnt(0)" ::: "memory")

#define XB_TMO      128
#define XB_XCNT(j)  (256  + 64 * (j))
#define XB_XSUB(j)  (1280 + 64 * (j))
#define XB_XGEN(j)  (2304 + 64 * (j))
#define XB_TOP      3328
#define XB_TOPGEN   3392
#define XCD_BAR_WORDS 3456
#define XB_SPIN_CAP (1u << 18)
__device__ __forceinline__ unsigned xb_ld(unsigned* p)              { return __hip_atomic_load(p, __ATOMIC_RELAXED, __HIP_MEMORY_SCOPE_AGENT); }
__device__ __forceinline__ unsigned xb_add(unsigned* p, unsigned v) { return __hip_atomic_fetch_add(p, v, __ATOMIC_RELAXED, __HIP_MEMORY_SCOPE_AGENT); }
__device__ __forceinline__ unsigned xb_xcc_id() { return (unsigned)__builtin_amdgcn_s_getreg((3 << 11) | 20) & 0xFu; }
#define XB_SPIN(cond, bar) do { unsigned _sp = 0; while (cond) { __builtin_amdgcn_s_sleep(1); \
    if ((++_sp & 255u) == 0u) { if (xb_ld(&(bar)[XB_TMO])) break; if (_sp > XB_SPIN_CAP) { atomicAdd(&(bar)[XB_TMO], 1u); break; } } } } while (0)
struct XcdBarrier { unsigned* bar; unsigned x; volatile LAS unsigned* st; };
__device__ __forceinline__ XcdBarrier xcd_barrier_post(unsigned* bar, volatile LAS unsigned* st, int wave_) {
    XcdBarrier b; b.bar = bar; b.x = xb_xcc_id(); b.st = st;
    if (wave_ == 0 && lane_id() == 0) (void)xb_add(&bar[XB_XCNT(b.x)], 1u);
    return b;
}
__device__ __forceinline__ void xcd_barrier_complete(unsigned* bar, unsigned x, unsigned& nloc, unsigned& nx) {
    const unsigned G = gridDim.x * gridDim.y * gridDim.z;
    unsigned sum, cnt, mine, sp = 0u;
    for (;;) {
        sum = 0u; cnt = 0u; mine = 0u;
#pragma unroll
        for (unsigned j = 0; j < 16; ++j) { const unsigned c = xb_ld(&bar[XB_XCNT(j)]); sum += c; cnt += (c > 0u) ? 1u : 0u; }
        mine = xb_ld(&bar[XB_XCNT(x)]);
        if (sum == G) break;
        __builtin_amdgcn_s_sleep(1);
        if ((++sp & 255u) == 0u) { if (xb_ld(&bar[XB_TMO])) break; if (sp > XB_SPIN_CAP) { atomicAdd(&bar[XB_TMO], 1u); break; } }
    }
    nloc = mine > 0u ? mine : 1u; nx = cnt > 0u ? cnt : 1u;
}
__device__ __forceinline__ void xcd_barrier(const XcdBarrier& b, int wave_) {
    asm volatile("s_waitcnt vmcnt(0)" ::: "memory");
    __syncthreads();
    if (wave_ == 0 && lane_id() == 0) {
        unsigned* bar = b.bar; asm volatile("" : "+s"(bar));
        unsigned stoff = (unsigned)(uintptr_t)b.st; asm volatile("" : "+s"(stoff)); volatile LAS unsigned* st = (volatile LAS unsigned*)(uintptr_t)stoff;
        const unsigned x = xb_xcc_id();
        __builtin_amdgcn_s_waitcnt(0);
        unsigned nloc = st[0], nx = st[1];
        if (nloc == 0u) { xcd_barrier_complete(bar, x, nloc, nx); st[0] = nloc; st[1] = nx; }
        const unsigned old = xb_add(&bar[XB_XSUB(x)], 1u);
        const unsigned gen = old / nloc;
        if (old + 1u == (gen + 1u) * nloc) {
            __builtin_amdgcn_fence(__ATOMIC_RELEASE, "agent");
            asm volatile("s_waitcnt vmcnt(0)" ::: "memory");
            const unsigned og = xb_add(&bar[XB_TOP], 1u);
            const unsigned tg = og / nx;
            if (og + 1u == (tg + 1u) * nx) xb_add(&bar[XB_TOPGEN], 1u);
            else XB_SPIN(xb_ld(&bar[XB_TOPGEN]) == tg, bar);
            __builtin_amdgcn_fence(__ATOMIC_ACQUIRE, "agent");
            asm volatile("s_waitcnt vmcnt(0)" ::: "memory");
        } else {
            XB_SPIN(xb_ld(&bar[XB_TOPGEN]) == gen, bar);
            __builtin_amdgcn_fence(__ATOMIC_ACQUIRE, "agent");
            asm volatile("s_waitcnt vmcnt(0)" ::: "memory");
        }
    }
    __syncthreads();
}

__device__ __forceinline__ float gelu_tanh_f(float x) {
    const float u = 0.7978845608028654f * (x + 0.044715f * x * x * x);
    const float e = __builtin_amdgcn_exp2f(-2.0f * LOG2E * u);
    return x * __builtin_amdgcn_rcpf(1.0f + e);
}
__device__ __forceinline__ float sigmoid_f(float x) { return __builtin_amdgcn_rcpf(1.0f + __builtin_amdgcn_exp2f(-LOG2E * x)); }

struct Frame {
    LAS unsigned char* lds;
    int wave, vcu, G;
    unsigned char* ws;
    const float* const* in;
};
struct In {
    const float* x; const int* pos; const float* norm_mix; const float* w_in; const float* kv_norm; const float* w_uk; const float* w_uv; const float* ln_v_g; const float* ln_v_b;
    const float* w_s; const float* b_s; const float* w_proj_a; const float* w_proj_b; const float* w_out; const float* norm_ffn; const float* w_gate; const float* w_up; const float* w_down; const float* final_norm;
};

__device__ __constant__ float c_inv[8] = {1.0f, 0.19392274474868576f, 0.03760603093086393f, 0.007292664737217109f, 0.001414213562373095f, 0.0002742481756762073f, 5.318295896944988e-05f, 1.031338537721246e-05f};

__device__ __forceinline__ void transpose_item64(const float* W4, int Nsrc, h16* WT, int ldt, int n0, int k0, const float* gain, LAS float* scr, int lane) {
    const int nq = lane & 15, kq = lane >> 4;
    f32x4 v[16];
#pragma unroll
    for (int i = 0; i < 16; ++i) v[i] = W4 ? *(const GAS f32x4*)(W4 + (size_t)(k0 + 4 * i + kq) * Nsrc) : (f32x4){0.f, 0.f, 0.f, 0.f};
#pragma unroll
    for (int i = 0; i < 16; ++i) { const int kk = 4 * i + kq; f32x4 x = v[i]; if (gain) x = x * gain[k0 + kk]; *(LAS f32x4*)(scr + kk * 68 + 4 * (nq ^ (kk >> 3))) = x; }
    LDS_WAIT(); asm volatile("" ::: "memory");
    const int c = lane & 7;
#pragma unroll
    for (int j = 0; j < 8; ++j) { const int n = (lane >> 3) + 8 * j; const LAS float* sp = scr + (8 * c) * 68 + 4 * ((n >> 2) ^ c) + (n & 3);
        u32x4 o; o.x = pkh(sp[0 * 68], sp[1 * 68]); o.y = pkh(sp[2 * 68], sp[3 * 68]); o.z = pkh(sp[4 * 68], sp[5 * 68]); o.w = pkh(sp[6 * 68], sp[7 * 68]);
        *(GAS u32x4*)(WT + (size_t)(n0 + n) * ldt + k0 + 8 * c) = o; }
    LDS_WAIT(); asm volatile("" ::: "memory");
}
__device__ __forceinline__ int win_src_col(int n) {
    if (n < 512) return n;
    if (n < 1024) return 656 + (n - 512);
    if (n < 2048) return 1240 + (n - 1024);
    if (n < 4096) return 2264 + (n - 2048);
    if (n < 4224) return 512 + (n - 4096);
    if (n < 4240) return 640 + (n - 4224);
    if (n < 4304) return 1168 + (n - 4240);
    if (n < 4312) return 1232 + (n - 4304);
    return -1;
}
constexpr int CONV_IN_ITEMS = (NZ / 64) * 16;
__device__ __forceinline__ void convert_layer_weights(const Frame& F, const In& I, int l, int gw, int NGW, int it_lo = 0, int it_hi = 1 << 30) {
    LAS float* scr = (LAS float*)(F.lds + F.wave * 17408);
    int lane = lane_id(); asm volatile("" : "+v"(lane));
    constexpr int I_IN = (NZ / 64) * 16, I_PA = 16 * 8, I_OUT = 16 * 16, I_GU = (NGU / 64) * 16, I_D = 16 * (DFF / 64);
    constexpr int I_LAYER = I_IN + 2 * I_PA + I_OUT + I_GU + I_D;
    const int n4 = 4 * (lane & 15);
    unsigned char* wl = F.ws + WS_W + (size_t)l * W_LAYER;
    if (it_hi > I_LAYER) it_hi = I_LAYER;
    for (int it = it_lo + gw; it < it_hi; it += NGW) {
        int r = it;
        if (r < I_IN) { const int nb = r / 16, kb = r % 16, sc = win_src_col(nb * 64 + n4);
            transpose_item64(sc >= 0 ? I.w_in + (size_t)l * DM * DIN + sc : nullptr, DIN, (h16*)(wl + W_OFF_IN), 1024, nb * 64, kb * 64, I.norm_mix + l * DM, scr, lane); continue; }
        r -= I_IN;
        if (r < I_PA) { const int nb = r / 8, kb = r % 8;
            transpose_item64(I.w_proj_a + (size_t)l * 512 * 1024 + nb * 64 + n4, 1024, (h16*)(wl + W_OFF_PAB), 1024, nb * 64, kb * 64, nullptr, scr, lane); continue; }
        r -= I_PA;
        if (r < I_PA) { const int nb = r / 8, kb = r % 8;
            transpose_item64(I.w_proj_b + (size_t)l * 512 * 1024 + nb * 64 + n4, 1024, (h16*)(wl + W_OFF_PAB) + 512, 1024, nb * 64, kb * 64, nullptr, scr, lane); continue; }
        r -= I_PA;
        if (r < I_OUT) { const int nb = r / 16, kb = r % 16;
            transpose_item64(I.w_out + (size_t)l * 1024 * 1024 + nb * 64 + n4, 1024, (h16*)(wl + W_OFF_OUT), 1024, nb * 64, kb * 64, nullptr, scr, lane); continue; }
        r -= I_OUT;
        if (r < I_GU) { const int nb = r / 16, kb = r % 16, R = nb * 64 + n4, pn = R >> 8, rem = R & 255;
            const int a = 128 * pn + 64 * (rem >> 7) + 16 * ((rem >> 5) & 3) + 4 * ((rem >> 3) & 3);
            const float* src = (((rem >> 2) & 1) ? I.w_up : I.w_gate) + (size_t)l * DM * DFF + a;
            transpose_item64(src, DFF, (h16*)(wl + W_OFF_GU), 1024, nb * 64, kb * 64, I.norm_ffn + l * DM, scr, lane); continue; }
        r -= I_GU;
        { const int nb = r / (DFF / 64), kb = r % (DFF / 64);
            transpose_item64(I.w_down + (size_t)l * DFF * 1024 + nb * 64 + n4, 1024, (h16*)(wl + W_OFF_D), DFF, nb * 64, kb * 64, nullptr, scr, lane); }
    }
}
__device__ __forceinline__ void p0_prologue(const Frame& F, const In& I) {
    int lane = lane_id(); asm volatile("" : "+v"(lane));
    const int hw = F.wave & 3, gw = F.vcu * 4 + hw, NGW = F.G * 4;
    if (F.wave >= 4) {
    convert_layer_weights(F, I, 0, gw, NGW, 0, CONV_IN_ITEMS);
    const int gt = F.vcu * 256 + hw * 64 + lane, NGT = F.G * 256;
    for (int i0 = gt; i0 < NLAYER * 49152; i0 += 2 * NGT) { float va[2], vg[2];
#pragma unroll
        for (int u = 0; u < 2; ++u) { const int i = i0 + u * NGT; if (i < NLAYER * 49152) { const int l = i / 49152, e = i % 49152, h = e / (128 * 48), c = (e / 48) % 128, n = e % 48;
            va[u] = I.w_uk[(((size_t)l * 8 + h) * 48 + n) * 128 + c]; vg[u] = I.kv_norm[l * 128 + c]; } }
#pragma unroll
        for (int u = 0; u < 2; ++u) { const int i = i0 + u * NGT; if (i < NLAYER * 49152) { const int l = i / 49152, e = i % 49152;
            ((h16*)(F.ws + WS_SMALLW + (size_t)l * SMALLW_LAYER))[e] = (h16)(va[u] * vg[u]); } } }
    for (int i0 = gt; i0 < NLAYER * 65536; i0 += 2 * NGT) { float va[2], vg[2];
#pragma unroll
        for (int u = 0; u < 2; ++u) { const int i = i0 + u * NGT; if (i < NLAYER * 65536) { const int l = i / 65536, e = i % 65536, h = e / (64 * 128), d = (e / 128) % 64, c = e % 128;
            va[u] = I.w_uv[(((size_t)l * 8 + h) * 128 + c) * 64 + d]; vg[u] = I.kv_norm[l * 128 + c]; } }
#pragma unroll
        for (int u = 0; u < 2; ++u) { const int i = i0 + u * NGT; if (i < NLAYER * 65536) { const int l = i / 65536, e = i % 65536;
            ((h16*)(F.ws + WS_SMALLW + (size_t)l * SMALLW_LAYER + 98304))[e] = (h16)(va[u] * vg[u]); } } }
    for (int i0 = gt; i0 < NLAYER * 131072; i0 += 4 * NGT) { float va[4];
#pragma unroll
        for (int u = 0; u < 4; ++u) { const int i = i0 + u * NGT; if (i < NLAYER * 131072) va[u] = I.w_s[i]; }
#pragma unroll
        for (int u = 0; u < 4; ++u) { const int i = i0 + u * NGT; if (i < NLAYER * 131072) { const int l = i / 131072, e = i % 131072, t = (e / 128) % 128, sx = e % 128;
            ((h16*)(F.ws + WS_SMALLW + (size_t)l * SMALLW_LAYER + 98304 + 131072))[e] = (sx <= t) ? (h16)va[u] : (h16)0.f; } } }
    for (int i0 = gt; i0 < M * 8; i0 += 2 * NGT) { int pv[2];
#pragma unroll
        for (int u = 0; u < 2; ++u) { const int i = i0 + u * NGT; if (i < M * 8) pv[u] = I.pos[i >> 3]; }
#pragma unroll
        for (int u = 0; u < 2; ++u) { const int i = i0 + u * NGT; if (i < M * 8) { const int tok = i >> 3, f = i & 7; const float ang = (float)pv[u] * c_inv[f];
            float* cs = (float*)(F.ws + WS_CS) + (size_t)tok * 16; cs[f] = cosf(ang); cs[8 + f] = sinf(ang); } } }
    } else {
    for (int m = gw; m < M; m += 4 * NGW) {
        f32x4 v[4][4];
#pragma unroll
        for (int k = 0; k < 4; ++k) { const int mm = m + k * NGW; if (mm < M) { const f32x4* xr = (const f32x4*)(I.x + (size_t)mm * DM) + lane;
#pragma unroll
            for (int j = 0; j < 4; ++j) v[k][j] = xr[64 * j]; } }
#pragma unroll
        for (int k = 0; k < 4; ++k) { const int mm = m + k * NGW; if (mm < M) { u32x2* o8 = (u32x2*)((h16*)(F.ws + WS_X16) + (size_t)mm * DM) + lane; float s = 0.f;
#pragma unroll
            for (int j = 0; j < 4; ++j) { const f32x4 t = v[k][j]; s += (t.x * t.x + t.y * t.y) + (t.z * t.z + t.w * t.w); o8[64 * j] = (u32x2){pkh(t.x, t.y), pkh(t.z, t.w)}; }
            s += __shfl_xor(s, 1); s += __shfl_xor(s, 2); s += __shfl_xor(s, 4); s += __shfl_xor(s, 8);
            if ((lane & 15) == 0) ((GAS float*)(F.ws + WS_SSQ))[(size_t)mm * 4 + (lane >> 4)] = s; } }
    }
    }
}

__device__ __forceinline__ float row_rstd(const float* ssq, int row) {
    const f32x4 a = *(const GAS f32x4*)(ssq + (size_t)row * 4);
    return rsqrtf(((a.x + a.y) + (a.z + a.w)) * (1.0f / DM) + EPS_RMS);
}

typedef f32x4 Acc[2][2][4][2];
__device__ __forceinline__ u32x4 pack8h(const float (&v)[8]) { u32x4 w; w.x = pkz(v[0], v[1]); w.y = pkz(v[2], v[3]); w.z = pkz(v[4], v[5]); w.w = pkz(v[6], v[7]); return w; }
__device__ __forceinline__ u32x4 pack8r(const float (&v)[8]) { u32x4 w; w.x = pkh(v[0], v[1]); w.y = pkh(v[2], v[3]); w.z = pkh(v[4], v[5]); w.w = pkh(v[6], v[7]); return w; }

__device__ __forceinline__ void ssq_prefetch(const float* ssq, int pm, LAS float* R4, int wid, int lane) {
    if (wid < 4) __builtin_amdgcn_global_load_lds((const unsigned*)(ssq + (size_t)(pm * 256 + wid * 64 + lane) * 4), (LAS unsigned*)(R4 + wid * 256), 16, 0, 0);
}
__device__ __forceinline__ float rstd_from_lds(const LAS float* R4, int rl) { const f32x4 a = *(const LAS f32x4*)(R4 + rl * 4); return rsqrtf(((a.x + a.y) + (a.z + a.w)) * (1.0f / DM) + EPS_RMS); }
struct EpiA {
    static constexpr bool PERM = true;
    unsigned char* ws; int nostore; LAS float* R;
    __device__ __forceinline__ void prefetch(const pg8::Unit& u, int wid, int lane) const { ssq_prefetch((const float*)(ws + WS_SSQ), u.pm, R, wid, lane); }
    __device__ __forceinline__ void misc_tile(Acc& acc, const pg8::Unit& u, int wr, int wc, int fr, int fq) const {
        const int nai = u.half < 0 ? 2 : 1, rofs = u.half < 0 ? 0 : 128 * u.half;
        const unsigned row0 = (unsigned)(u.pm * 256 + rofs + wr * 64 + fr); LAS float* P = R - 1024;
        GAS unsigned char* wsg = (GAS unsigned char*)ws;
#pragma unroll
        for (int ai = 0; ai < 2; ++ai) if (ai < nai)
#pragma unroll
            for (int m = 0; m < 4; ++m) { const int rl = rofs + ai * 128 + wr * 64 + m * 16 + fr; const float rs = rstd_from_lds(R, rl); float ss = 0.f;
#pragma unroll
                for (int bj = 0; bj < 2; ++bj) { acc[ai][bj][m][0] *= rs; acc[ai][bj][m][1] *= rs; }
#pragma unroll
                for (int i = 0; i < 8; ++i) { const float z = acc[ai][0][m][i >> 2][i & 3]; ss = fmaf(z, z, ss); }
                ss += __shfl_xor(ss, 16); ss += __shfl_xor(ss, 32);
                if (fq == 0) P[rl * 4 + wc] = ss; }
        asm volatile("s_waitcnt lgkmcnt(0)" ::: "memory"); __builtin_amdgcn_s_barrier(); asm volatile("" ::: "memory");
#pragma unroll
        for (int ai = 0; ai < 2; ++ai) if (ai < nai)
#pragma unroll
            for (int m = 0; m < 4; ++m) { const int rl = rofs + ai * 128 + wr * 64 + m * 16 + fr; const unsigned row = row0 + (unsigned)(ai * 128 + m * 16);
                const f32x4 pv = *(const LAS f32x4*)(P + rl * 4); const float rk = rsqrtf(((pv.x + pv.y) + (pv.z + pv.w)) * (1.0f / 128.f) + EPS_RMS);
                { float o[8];
#pragma unroll
                  for (int i = 0; i < 8; ++i) o[i] = acc[ai][0][m][i >> 2][i & 3] * rk;
                  *(GAS u32x4*)(wsg + ((unsigned)WS_KV + row * (unsigned)(KVP * 2) + (unsigned)(wc * 64 + 16 * fq))) = pack8r(o); }
                if (wc == 0) {
                    const unsigned co = (unsigned)WS_CS + row * 64u;
                    const f32x4 c0 = *(const GAS f32x4*)(wsg + co), c1 = *(const GAS f32x4*)(wsg + co + 16u), s0 = *(const GAS f32x4*)(wsg + co + 32u), s1 = *(const GAS f32x4*)(wsg + co + 48u);
                    float o[8];
#pragma unroll
                    for (int i = 0; i < 8; ++i) { const float own = acc[ai][1][m][i >> 2][i & 3], oth = __shfl_xor(own, 16); const float c = i < 4 ? c0[i & 3] : c1[i & 3], sn = i < 4 ? s0[i & 3] : s1[i & 3];
                        o[i] = (fq & 1) ? (own * c + oth * sn) : (own * c - oth * sn); }
                    const unsigned dst = fq < 2 ? (unsigned)WS_KV + row * (unsigned)(KVP * 2) + 256u + 16u * (unsigned)fq : (unsigned)WS_KI + row * 128u + 16u * (unsigned)(fq - 2);
                    *(GAS u32x4*)(wsg + dst) = pack8r(o);
                } else if (wc == 1) {
                    float o[8];
#pragma unroll
                    for (int i = 0; i < 8; ++i) o[i] = acc[ai][1][m][i >> 2][i & 3];
                    *(GAS u32x4*)(wsg + ((unsigned)WS_KI + row * 128u + 32u + 16u * (unsigned)fq)) = pack8r(o);
                } else if (wc == 2) {
                    if (fq < 2) { float o[8];
#pragma unroll
                        for (int i = 0; i < 8; ++i) o[i] = acc[ai][1][m][i >> 2][i & 3];
                        *(GAS u32x4*)(wsg + ((unsigned)WS_KI + row * 128u + 96u + 16u * (unsigned)fq)) = pack8r(o); }
                    else if (fq == 2) { const float sc = 0.35355339059327373f * 0.125f; const unsigned wo = (unsigned)WS_WI + row * 32u;
                        *(GAS f32x4*)(wsg + wo) = acc[ai][1][m][0] * sc; *(GAS f32x4*)(wsg + wo + 16u) = acc[ai][1][m][1] * sc; }
                    else { u32x4 z4 = {0u, 0u, 0u, 0u}; asm volatile("" : "+v"(z4)); *(GAS u32x4*)(wsg + ((unsigned)WS_KV + row * (unsigned)(KVP * 2) + 288u)) = z4; }
                } }
        asm volatile("s_waitcnt lgkmcnt(0)" ::: "memory"); __builtin_amdgcn_s_barrier(); asm volatile("" ::: "memory");
    }
    __device__ __forceinline__ void operator()(Acc& acc, const pg8::Unit& u, int wr, int wc, int fr, int fq) const {
        const int pn = u.pn; h16* base; int ldc, colt;
        if (pn == 16) { misc_tile(acc, u, wr, wc, fr, fq); return; }
        if (pn < 2) { base = (h16*)(ws + WS_QY); ldc = 1024; colt = pn * 256; }
        else if (pn < 4) { base = (h16*)(ws + WS_QI); ldc = 512; colt = (pn - 2) * 256; }
        else if (pn < 8) { base = (h16*)(ws + WS_UV); ldc = 1024; colt = (pn - 4) * 256; }
        else { base = (h16*)(ws + WS_GATES); ldc = 2048; colt = (pn - 8) * 256; }
        const int nai = u.half < 0 ? 2 : 1, rofs = u.half < 0 ? 0 : 128 * u.half;
        const int row0 = u.pm * 256 + rofs + wr * 64 + fr, col0 = colt + wc * 32 + 8 * fq;
#pragma unroll
        for (int ai = 0; ai < 2; ++ai) if (ai < nai)
#pragma unroll
            for (int m = 0; m < 4; ++m) { const int row = row0 + ai * 128 + m * 16; const float rs = rstd_from_lds(R, rofs + ai * 128 + wr * 64 + m * 16 + fr); h16* rowp = base + (size_t)row * ldc + col0;
#pragma unroll
                for (int bj = 0; bj < 2; ++bj) { f32x4 v0 = acc[ai][bj][m][0] * rs, v1 = acc[ai][bj][m][1] * rs;
                    u32x4 w; w.x = pkz(v0[0], v0[1]); w.y = pkz(v0[2], v0[3]); w.z = pkz(v1[0], v1[1]); w.w = pkz(v1[2], v1[3]);
                    if (!nostore) *(GAS u32x4*)(rowp + bj * 128) = w; else asm volatile("" :: "v"(w)); } }
        asm volatile("s_waitcnt lgkmcnt(0)" ::: "memory"); __builtin_amdgcn_s_barrier(); asm volatile("" ::: "memory");
    }
};

struct EpiD {
    static constexpr bool PERM = true;
    unsigned char* ws; h16* mg;
    __device__ __forceinline__ void prefetch(const pg8::Unit&, int, int) const {}
    __device__ __forceinline__ void operator()(Acc& acc, const pg8::Unit& u, int wr, int wc, int fr, int fq) const {
        const int row0 = u.pm * 256 + wr * 64 + fr, col0 = u.pn * 256 + wc * 32 + 8 * fq;
        const h16* gates = (const h16*)(ws + WS_GATES);
#pragma unroll
        for (int ai = 0; ai < 2; ++ai) {
            h16x8 gbv[4][2], gav[4][2];
#pragma unroll
            for (int m = 0; m < 4; ++m)
#pragma unroll
                for (int bj = 0; bj < 2; ++bj) { const size_t off = (size_t)(row0 + ai * 128 + m * 16) * 2048 + col0 + bj * 128;
                    gbv[m][bj] = *(const GAS h16x8*)(gates + off + 1024); if (u.kind == 0) gav[m][bj] = *(const GAS h16x8*)(gates + off); }
#pragma unroll
            for (int m = 0; m < 4; ++m) { const int row = row0 + ai * 128 + m * 16;
#pragma unroll
                for (int bj = 0; bj < 2; ++bj) { const int col = col0 + bj * 128; const h16x8 gb = gbv[m][bj];
                    if (u.kind == 0) { const h16x8 ga = gav[m][bj];
#pragma unroll
                        for (int i = 0; i < 8; ++i) { const float ea = __builtin_amdgcn_exp2f(fminf(-LOG2E * (float)ga[i], 64.f)), eb = __builtin_amdgcn_exp2f(fminf(-LOG2E * (float)gb[i], 64.f));
                            acc[ai][bj][m][i >> 2][i & 3] *= (1.0f + eb) * __builtin_amdgcn_rcpf(1.0f + ea); }
                    } else { float v[8];
#pragma unroll
                        for (int i = 0; i < 8; ++i) { const float eb = __builtin_amdgcn_exp2f(fminf(-LOG2E * (float)gb[i], 64.f)); v[i] = acc[ai][bj][m][i >> 2][i & 3] * __builtin_amdgcn_rcpf(1.0f + eb); }
                        u32x4 w; w.x = pkz(v[0], v[1]); w.y = pkz(v[2], v[3]); w.z = pkz(v[4], v[5]); w.w = pkz(v[6], v[7]);
                        *(GAS u32x4*)(mg + (size_t)row * 1024 + col) = w; } } }
            asm volatile("" ::: "memory"); }
    }
};

struct EpiRes {
    static constexpr bool PERM = true;
    const h16* resid; h16* xo; float* ssq; LAS float* P;
    __device__ __forceinline__ void prefetch(const pg8::Unit&, int, int) const {}
    __device__ __forceinline__ void operator()(Acc& acc, const pg8::Unit& u, int wr, int wc, int fr, int fq) const {
        const int row0 = u.pm * 256 + wr * 64 + fr, col0 = u.pn * 256 + wc * 32 + 8 * fq;
        h16x8 rvv[2][4][2];
#pragma unroll
        for (int ai = 0; ai < 2; ++ai)
#pragma unroll
            for (int m = 0; m < 4; ++m)
#pragma unroll
                for (int bj = 0; bj < 2; ++bj) rvv[ai][m][bj] = *(const GAS h16x8*)(resid + (size_t)(row0 + ai * 128 + m * 16) * 1024 + col0 + bj * 128);
#pragma unroll
        for (int ai = 0; ai < 2; ++ai)
#pragma unroll
            for (int m = 0; m < 4; ++m) { const int row = row0 + ai * 128 + m * 16; float ss = 0.f;
#pragma unroll
                for (int bj = 0; bj < 2; ++bj) { const size_t off = (size_t)row * 1024 + col0 + bj * 128;
                    const h16x8 rv = rvv[ai][m][bj]; float v[8];
#pragma unroll
                    for (int i = 0; i < 8; ++i) { v[i] = (float)rv[i] + acc[ai][bj][m][i >> 2][i & 3]; ss = fmaf(v[i], v[i], ss); }
                    *(GAS u32x4*)(xo + off) = pack8h(v); }
                ss += __shfl_xor(ss, 16); ss += __shfl_xor(ss, 32);
                if (fq == 0) P[(ai * 128 + wr * 64 + m * 16 + fr) * 4 + wc] = ss; }
        asm volatile("s_waitcnt lgkmcnt(0)" ::: "memory"); __builtin_amdgcn_s_barrier(); asm volatile("" ::: "memory");
        { const int t = (wr * 4 + wc) * 64 + fq * 16 + fr; if (t < 256) { const f32x4 v = *(const LAS f32x4*)(P + t * 4); ((GAS float*)ssq)[(size_t)(u.pm * 256 + t) * 4 + u.pn] = (v.x + v.y) + (v.z + v.w); } }
        asm volatile("s_waitcnt lgkmcnt(0)" ::: "memory"); __builtin_amdgcn_s_barrier(); asm volatile("" ::: "memory");
    }
};

struct EpiFinal {
    static constexpr bool PERM = true;
    const h16* resid; float* out; const float* gfin; float* ssq; unsigned* cnt; LAS float* P;
    __device__ __forceinline__ void prefetch(const pg8::Unit&, int, int) const {}
    __device__ __forceinline__ void operator()(Acc& acc, const pg8::Unit& u, int wr, int wc, int fr, int fq) const {
        const int row0 = u.pm * 256 + wr * 64 + fr, col0 = u.pn * 256 + wc * 32 + 8 * fq;
        LAS float* S = P + 1024;
        { h16x8 rvv[2][4][2];
#pragma unroll
          for (int ai = 0; ai < 2; ++ai)
#pragma unroll
              for (int m = 0; m < 4; ++m)
#pragma unroll
                  for (int bj = 0; bj < 2; ++bj) rvv[ai][m][bj] = *(const GAS h16x8*)(resid + (size_t)(row0 + ai * 128 + m * 16) * 1024 + col0 + bj * 128);
#pragma unroll
          for (int ai = 0; ai < 2; ++ai)
#pragma unroll
              for (int m = 0; m < 4; ++m) { float ss = 0.f;
#pragma unroll
                  for (int bj = 0; bj < 2; ++bj) { const h16x8 rv = rvv[ai][m][bj];
#pragma unroll
                      for (int i = 0; i < 8; ++i) { const float v = (float)rv[i] + acc[ai][bj][m][i >> 2][i & 3]; acc[ai][bj][m][i >> 2][i & 3] = v; ss = fmaf(v, v, ss); } }
                  ss += __shfl_xor(ss, 16); ss += __shfl_xor(ss, 32);
                  if (fq == 0) P[(ai * 128 + wr * 64 + m * 16 + fr) * 4 + wc] = ss; } }
        asm volatile("s_waitcnt lgkmcnt(0)" ::: "memory"); __builtin_amdgcn_s_barrier(); asm volatile("" ::: "memory");
        const int t = (wr * 4 + wc) * 64 + fq * 16 + fr, wid = wr * 4 + wc;
        if (t < 256) { const f32x4 v = *(const LAS f32x4*)(P + t * 4);
            __hip_atomic_store((GAS float*)ssq + (size_t)(u.pm * 256 + t) * 4 + u.pn, (v.x + v.y) + (v.z + v.w), __ATOMIC_RELAXED, __HIP_MEMORY_SCOPE_AGENT); }
        asm volatile("s_waitcnt vmcnt(0)" ::: "memory");
        unsigned* c = cnt + 64 * u.pm;
        if ((fq * 16 + fr) == 0) __hip_atomic_fetch_add(c, 1u, __ATOMIC_RELAXED, __HIP_MEMORY_SCOPE_AGENT);
        if (wid == 0) {
            const unsigned long long t0 = __builtin_amdgcn_s_memrealtime();
            while ((unsigned)__builtin_amdgcn_readfirstlane((int)__hip_atomic_load(c, __ATOMIC_RELAXED, __HIP_MEMORY_SCOPE_AGENT)) < 32u) {
                if (__builtin_amdgcn_s_memrealtime() - t0 > 2000000ull) break;
                __builtin_amdgcn_s_sleep(2); }
            __builtin_amdgcn_fence(__ATOMIC_ACQUIRE, "agent");
            asm volatile("s_waitcnt vmcnt(0)" ::: "memory"); }
        asm volatile("s_waitcnt lgkmcnt(0)" ::: "memory"); __builtin_amdgcn_s_barrier(); asm volatile("" ::: "memory");
        if (t < 256) { const GAS float* sp = (const GAS float*)ssq + (size_t)(u.pm * 256 + t) * 4; float sum = 0.f;
#pragma unroll
            for (int k = 0; k < 4; ++k) sum += __hip_atomic_load(sp + k, __ATOMIC_RELAXED, __HIP_MEMORY_SCOPE_AGENT);
            S[t] = rsqrtf(sum * (1.0f / DM) + EPS_RMS); }
        asm volatile("s_waitcnt lgkmcnt(0)" ::: "memory"); __builtin_amdgcn_s_barrier(); asm volatile("" ::: "memory");
        f32x4 gv[2][2];
#pragma unroll
        for (int bj = 0; bj < 2; ++bj) { gv[bj][0] = *(const f32x4*)(gfin + col0 + bj * 128); gv[bj][1] = *(const f32x4*)(gfin + col0 + bj * 128 + 4); }
#pragma unroll
        for (int ai = 0; ai < 2; ++ai)
#pragma unroll
            for (int m = 0; m < 4; ++m) { const int rl = ai * 128 + wr * 64 + m * 16 + fr; const float rs = S[rl]; float* op = out + (size_t)(u.pm * 256 + rl) * 1024 + col0;
#pragma unroll
                for (int bj = 0; bj < 2; ++bj) { *(GAS f32x4*)(op + bj * 128) = acc[ai][bj][m][0] * rs * gv[bj][0]; *(GAS f32x4*)(op + bj * 128 + 4) = acc[ai][bj][m][1] * rs * gv[bj][1]; } }
    }
};

struct EpiF {
    static constexpr bool PERM = true;
    unsigned char* ws; LAS float* R;
    __device__ __forceinline__ void prefetch(const pg8::Unit& u, int wid, int lane) const { ssq_prefetch((const float*)(ws + WS_SSQ), u.pm, R, wid, lane); }
    __device__ __forceinline__ void operator()(Acc& acc, const pg8::Unit& u, int wr, int wc, int fr, int fq) const {
        const int nai = u.half < 0 ? 2 : 1, rofs = u.half < 0 ? 0 : 128 * u.half;
        const int row0 = u.pm * 256 + rofs + wr * 64 + fr, col0 = u.pn * 128 + wc * 16 + 4 * fq;
        h16* act = (h16*)(ws + WS_ACT);
#pragma unroll
        for (int ai = 0; ai < 2; ++ai) if (ai < nai)
#pragma unroll
            for (int m = 0; m < 4; ++m) { const int row = row0 + ai * 128 + m * 16; const float rs = rstd_from_lds(R, rofs + ai * 128 + wr * 64 + m * 16 + fr);
#pragma unroll
                for (int bj = 0; bj < 2; ++bj) { const f32x4 g = acc[ai][bj][m][0] * rs, uu = acc[ai][bj][m][1] * rs; float v[4];
#pragma unroll
                    for (int i = 0; i < 4; ++i) v[i] = g[i] * sigmoid_f(g[i]) * uu[i];
                    *(GAS u32x2*)(act + (size_t)row * DFF + col0 + bj * 64) = (u32x2){pkz(v[0], v[1]), pkz(v[2], v[3])}; } }
        asm volatile("s_waitcnt lgkmcnt(0)" ::: "memory"); __builtin_amdgcn_s_barrier(); asm volatile("" ::: "memory");
    }
};

__device__ __forceinline__ void final_norm_phase(const Frame& F, const h16* x16, const float* ssq, float* out, const float* g) {
    int lane = lane_id(); asm volatile("" : "+v"(lane));
    const int gw = F.vcu * NWAVES + F.wave, NGW = F.G * NWAVES;
    f32x4 gv[4];
#pragma unroll
    for (int k = 0; k < 4; ++k) gv[k] = *(const f32x4*)(g + 256 * k + 4 * lane);
    for (int m0 = gw; m0 < M; m0 += 8 * NGW) {
        u32x2 xv[8][4]; f32x4 sq[8];
#pragma unroll
        for (int r = 0; r < 8; ++r) { const int m = m0 + r * NGW; if (m < M) { sq[r] = *(const GAS f32x4*)(ssq + (size_t)m * 4);
#pragma unroll
            for (int k = 0; k < 4; ++k) xv[r][k] = *(const GAS u32x2*)(x16 + (size_t)m * DM + 256 * k + 4 * lane); } }
#pragma unroll
        for (int r = 0; r < 8; ++r) { const int m = m0 + r * NGW; if (m < M) { const float rs = rsqrtf(((sq[r].x + sq[r].y) + (sq[r].z + sq[r].w)) * (1.0f / DM) + EPS_RMS);
#pragma unroll
            for (int k = 0; k < 4; ++k) { const u32x2 p = xv[r][k]; const f32x4 gk = gv[k];
                *(GAS f32x4*)(out + (size_t)m * DM + 256 * k + 4 * lane) = (f32x4){h2f_lo(p.x) * rs * gk.x, h2f_hi(p.x) * rs * gk.y, h2f_lo(p.y) * rs * gk.z, h2f_hi(p.y) * rs * gk.w}; } } }
    }
}
__device__ __forceinline__ unsigned wlane(unsigned val, int ln, unsigned old) {
    unsigned keep;
    asm volatile("s_mov_b32 %1, m0\n\ts_mov_b32 m0, %3\n\ts_nop 3\n\tv_writelane_b32 %0, %2, m0\n\ts_mov_b32 m0, %1" : "+v"(old), "=&s"(keep) : "s"(val), "s"(ln));
    return old;
}
__device__ __forceinline__ void cnt_ge(int& c, float x, float m) { asm("v_cmp_ge_f32 vcc, %1, %2\n\tv_addc_co_u32 %0, vcc, 0, %0, vcc" : "+v"(c) : "v"(x), "v"(m) : "vcc"); }
__device__ __forceinline__ void cnt_gt(int& c, float x, float m) { asm("v_cmp_gt_f32 vcc, %1, %2\n\tv_addc_co_u32 %0, vcc, 0, %0, vcc" : "+v"(c) : "v"(x), "v"(m) : "vcc"); }
#define SEL_C8(OP, m_, a0, a1, a2, a3, a4, a5, a6, a7) \
    "v_cmp_" OP "_f32 vcc, " a0 ", " m_ "\n\tv_cmp_" OP "_f32 %2, " a1 ", " m_ "\n\tv_cmp_" OP "_f32 %3, " a2 ", " m_ "\n\tv_cmp_" OP "_f32 %4, " a3 ", " m_ "\n\t" \
    "v_cmp_" OP "_f32 %5, " a4 ", " m_ "\n\tv_cmp_" OP "_f32 %6, " a5 ", " m_ "\n\tv_cmp_" OP "_f32 %7, " a6 ", " m_ "\n\tv_cmp_" OP "_f32 %8, " a7 ", " m_ "\n\t"
#define SEL_A8(c_) \
    "v_addc_co_u32 " c_ ", vcc, 0, " c_ ", vcc\n\tv_addc_co_u32 " c_ ", %2, 0, " c_ ", %2\n\tv_addc_co_u32 " c_ ", %3, 0, " c_ ", %3\n\tv_addc_co_u32 " c_ ", %4, 0, " c_ ", %4\n\t" \
    "v_addc_co_u32 " c_ ", %5, 0, " c_ ", %5\n\tv_addc_co_u32 " c_ ", %6, 0, " c_ ", %6\n\tv_addc_co_u32 " c_ ", %7, 0, " c_ ", %7\n\tv_addc_co_u32 " c_ ", %8, 0, " c_ ", %8\n\t"
#define SEL_CGROUP(NAME, OP) __device__ __forceinline__ void NAME(int& c0, int& c1, const float* s, float m0, float m1) { unsigned long long t1, t2, t3, t4, t5, t6, t7; \
    asm(SEL_C8(OP, "%25", "%9", "%11", "%13", "%15", "%17", "%19", "%21", "%23") SEL_A8("%0") SEL_C8(OP, "%26", "%10", "%12", "%14", "%16", "%18", "%20", "%22", "%24") SEL_A8("%1") \
        : "+v"(c0), "+v"(c1), "=&s"(t1), "=&s"(t2), "=&s"(t3), "=&s"(t4), "=&s"(t5), "=&s"(t6), "=&s"(t7) \
        : "v"(s[0]), "v"(s[1]), "v"(s[2]), "v"(s[3]), "v"(s[4]), "v"(s[5]), "v"(s[6]), "v"(s[7]), "v"(s[8]), "v"(s[9]), "v"(s[10]), "v"(s[11]), "v"(s[12]), "v"(s[13]), "v"(s[14]), "v"(s[15]), "v"(m0), "v"(m1) : "vcc"); }
SEL_CGROUP(cnt_group_ge, "ge")
SEL_CGROUP(cnt_group_gt, "gt")
__device__ __forceinline__ void ballot_ge_to_lane(unsigned& wlo, unsigned& whi, float x, float tau, int ln) {
    unsigned keep;
    asm volatile("v_cmp_ge_f32 vcc, %3, %4\n\ts_mov_b32 %2, m0\n\ts_mov_b32 m0, %5\n\ts_nop 3\n\tv_writelane_b32 %0, vcc_lo, m0\n\tv_writelane_b32 %1, vcc_hi, m0\n\ts_mov_b32 m0, %2"
                 : "+v"(wlo), "+v"(whi), "=&s"(keep) : "v"(x), "v"(tau), "s"(ln) : "vcc");
}
__device__ __forceinline__ int half_sum_dpp(int v, int hf) {
    v += __builtin_amdgcn_update_dpp(0, v, 0x111, 0xf, 0xf, true);
    v += __builtin_amdgcn_update_dpp(0, v, 0x112, 0xf, 0xf, true);
    v += __builtin_amdgcn_update_dpp(0, v, 0x114, 0xf, 0xf, true);
    v += __builtin_amdgcn_update_dpp(0, v, 0x118, 0xf, 0xf, true);
    v += __builtin_amdgcn_update_dpp(0, v, 0x142, 0xa, 0xf, false);
    const int s0 = __builtin_amdgcn_readlane(v, 31), s1 = __builtin_amdgcn_readlane(v, 63);
    return hf ? s1 : s0;
}
__device__ __forceinline__ int crow(int R, int hf) { return (R & 3) + 8 * (R >> 2) + 4 * hf; }
__device__ __forceinline__ float half_swap_max(float v) { auto rr = __builtin_amdgcn_permlane32_swap(__float_as_uint(v), __float_as_uint(v), false, false); return fmaxf(__uint_as_float(rr[0]), __uint_as_float(rr[1])); }
__device__ __forceinline__ float half_swap_sum(float v) { auto rr = __builtin_amdgcn_permlane32_swap(__float_as_uint(v), __float_as_uint(v), false, false); return __uint_as_float(rr[0]) + __uint_as_float(rr[1]); }
__device__ __forceinline__ void rope8(const h16x8 x1, const h16x8 x2, const float* cs, int which, float scale, float (&o)[8]) {
    const f32x4 c0 = *(const GAS f32x4*)(cs), c1 = *(const GAS f32x4*)(cs + 4), s0 = *(const GAS f32x4*)(cs + 8), s1 = *(const GAS f32x4*)(cs + 12);
#pragma unroll
    for (int j = 0; j < 8; ++j) { const float c = j < 4 ? c0[j & 3] : c1[j & 3], s = j < 4 ? s0[j & 3] : s1[j & 3]; const float a = (float)x1[j], b = (float)x2[j];
        o[j] = (which == 0 ? (a * c - b * s) : (b * c + a * s)) * scale; }
}
__device__ __forceinline__ u32x4 pack8(const float (&v)[8]) { u32x4 w; w.x = pkh(v[0], v[1]); w.y = pkh(v[2], v[3]); w.z = pkh(v[4], v[5]); w.w = pkh(v[6], v[7]); return w; }

__device__ __forceinline__ void phaseB(const Frame& F, const In& I, int l) {
    unsigned char* ws = F.ws; asm volatile("" : "+s"(ws)); ws = (unsigned char*)(GAS unsigned char*)ws;     int lane = lane_id(), tid = F.wave * 64 + lane; asm volatile("" : "+v"(lane), "+v"(tid)); const int w = F.wave;
    int blk = F.vcu; asm volatile("" : "+s"(blk));
    const int b = blk >> 5, chunk = (blk >> 1) & 15, gh = blk & 1;
    const size_t tok0 = (size_t)b * SEQ + chunk * 128;
    const h16* UV = (const h16*)(ws + WS_UV); h16* QY = (h16*)(ws + WS_QY);
    LAS unsigned char* VN = F.lds;
    constexpr int VPB = 576;
    { const int i16 = lane & 15, rq = lane >> 4; h16x8 v[4][4];
#pragma unroll
      for (int it = 0; it < 4; ++it)
#pragma unroll
          for (int i = 0; i < 4; ++i) v[it][i] = *(const GAS h16x8*)(UV + (tok0 + 16 * w + 4 * it + rq) * 1024 + 512 + 8 * i16 + 128 * (i & 1) + 256 * ((i >> 1) ^ gh));
      f32x4 lgv[2][2], lbv[2][2];
#pragma unroll
      for (int i = 0; i < 2; ++i) { const int col = 256 * gh + 128 * i + 8 * i16; const float* lg = I.ln_v_g + l * 512 + col; const float* lb = I.ln_v_b + l * 512 + col;
          lgv[i][0] = *(const f32x4*)lg; lgv[i][1] = *(const GAS f32x4*)(lg + 4); lbv[i][0] = *(const f32x4*)lb; lbv[i][1] = *(const GAS f32x4*)(lb + 4); }
#pragma unroll
      for (int it = 0; it < 4; ++it) { float s = 0.f, q = 0.f; float vg[4][8];
#pragma unroll
          for (int i = 0; i < 4; ++i)
#pragma unroll
              for (int j = 0; j < 8; ++j) { const float x = gelu_tanh_f((float)v[it][i][j]); vg[i][j] = x; s += x; q = fmaf(x, x, q); }
          s += __shfl_xor(s, 1); q += __shfl_xor(q, 1); s += __shfl_xor(s, 2); q += __shfl_xor(q, 2); s += __shfl_xor(s, 4); q += __shfl_xor(q, 4); s += __shfl_xor(s, 8); q += __shfl_xor(q, 8);
          const float mu = s * (1.0f / 512.f), var = fmaxf(q * (1.0f / 512.f) - mu * mu, 0.f), rs = rsqrtf(var + 1e-5f);
          const int t = 16 * w + 4 * it + rq;
#pragma unroll
          for (int i = 0; i < 2; ++i) { float o[8];
#pragma unroll
              for (int j = 0; j < 8; ++j) o[j] = (vg[i][j] - mu) * rs * lgv[i][j >> 2][j & 3] + lbv[i][j >> 2][j & 3];
              *(LAS u32x4*)(VN + t * VPB + (128 * i + 8 * i16) * 2) = pack8(o); } } }
    asm volatile("" ::: "memory");
    { const int gp = w & 3, g = 4 * gh + gp, rh = w >> 2, r = lane & 31, hf = lane >> 5;
      const h16* WS16 = (const h16*)(ws + WS_SMALLW + (size_t)l * SMALLW_LAYER + 98304 + 131072) + (size_t)g * 128 * 128;
      const int troff = (8 * hf + ((lane & 15) >> 2)) * VPB + (gp * 64 + 16 * ((lane >> 4) & 1) + 4 * (lane & 3)) * 2;
      h16x8 wf[2][8];
#pragma unroll
      for (int tb = 0; tb < 2; ++tb)
#pragma unroll
          for (int s = 0; s < 8; ++s) wf[tb][s] = *(const GAS h16x8*)(WS16 + (size_t)(64 * rh + 32 * tb + r) * 128 + 16 * s + 8 * hf);
      float bsv[2]; u32x2 uu[2][2][4];
#pragma unroll
      for (int tb = 0; tb < 2; ++tb) { const int t = 64 * rh + 32 * tb + r; bsv[tb] = I.b_s[((size_t)l * 8 + g) * 128 + t];
#pragma unroll
          for (int db = 0; db < 2; ++db)
#pragma unroll
              for (int gg = 0; gg < 4; ++gg) uu[tb][db][gg] = *(const GAS u32x2*)(UV + (tok0 + t) * 1024 + g * 64 + 32 * db + 8 * gg + 4 * hf); }
      LDS_WAIT(); __syncthreads();
#pragma unroll
      for (int tb = 0; tb < 2; ++tb) { const int nks = 4 * rh + 2 * tb + 2; const size_t tk = tok0 + 64 * rh + 32 * tb + r;
#pragma unroll
        for (int db = 0; db < 2; ++db) { f32x16 D = {};
#pragma unroll
            for (int s = 0; s < 8; ++s) if (s < nks) {
                const v4i16_t lo = __builtin_amdgcn_ds_read_tr16_b64_v4i16((LAS v4i16_t*)(VN + troff + (16 * s) * VPB + 64 * db));
                const v4i16_t hi = __builtin_amdgcn_ds_read_tr16_b64_v4i16((LAS v4i16_t*)(VN + troff + (16 * s + 4) * VPB + 64 * db));
                typedef short s16x8 __attribute__((ext_vector_type(8)));
                const s16x8 av = {lo[0], lo[1], lo[2], lo[3], hi[0], hi[1], hi[2], hi[3]};
                D = __builtin_amdgcn_mfma_f32_32x32x16_f16(__builtin_bit_cast(h16x8, av), wf[tb][s], D, 0, 0, 0); }
#pragma unroll
            for (int gg = 0; gg < 4; ++gg) { const u32x2 uv2 = uu[tb][db][gg]; const float bb = bsv[tb];
                const float y0 = gelu_tanh_f(h2f_lo(uv2.x)) * (D[4 * gg] + bb), y1 = gelu_tanh_f(h2f_hi(uv2.x)) * (D[4 * gg + 1] + bb), y2 = gelu_tanh_f(h2f_lo(uv2.y)) * (D[4 * gg + 2] + bb), y3 = gelu_tanh_f(h2f_hi(uv2.y)) * (D[4 * gg + 3] + bb);
                *(GAS u32x2*)(QY + tk * 1024 + 512 + g * 64 + 32 * db + 8 * gg + 4 * hf) = (u32x2){pkh(y0, y1), pkh(y2, y3)}; } } } }
    __syncthreads();
}

constexpr int C_KIB = 0, C_KIBUF = 256 * 128;
constexpr int C_QL = 0, C_QLW = KVP * 2 * 32;
constexpr int C_WQ = 81920;
constexpr int C_KVS = 90112, C_KVSLOT = 10240;

__device__ __forceinline__ void phaseC_select(const Frame& F, int l, int b, int qt, int pmode = 0) {
    unsigned char* ws = F.ws; asm volatile("" : "+s"(ws)); ws = (unsigned char*)(GAS unsigned char*)ws;     int lane = lane_id(), tid = F.wave * 64 + lane; asm volatile("" : "+v"(lane), "+v"(tid)); const int w = F.wave, r = lane & 31, hf = lane >> 5;
    const h16* QI = (const h16*)(ws + WS_QI); const h16* KI = (const h16*)(ws + WS_KI); const float* WI = (const float*)(ws + WS_WI); const float* CS = (const float*)(ws + WS_CS);
    h16* QY = (h16*)(ws + WS_QY); const h16* KV = (const h16*)(ws + WS_KV);
    const h16* WUKT = (const h16*)(ws + WS_SMALLW + (size_t)l * SMALLW_LAYER); const h16* WUVT = (const h16*)(ws + WS_SMALLW + (size_t)l * SMALLW_LAYER + 98304);
    LAS unsigned char* lds = F.lds;
    const int t0 = 32 * qt, NT = qt + 1; const size_t tokbase = (size_t)b * SEQ;
    { const char* kvsrc_ = (const char*)((const h16*)(ws + WS_KV) + tokbase * KVP) + (size_t)(64 * w + lane) * 16; const unsigned kvdst_ = (unsigned)(uintptr_t)(lds + C_KVS) + (unsigned)w * 1024u;
#pragma unroll
      for (int t_ = 0; t_ < 4; ++t_) if (t_ < NT) { const char* s_ = kvsrc_ + (size_t)t_ * (32 * KVP * 2); const unsigned d_ = (unsigned)__builtin_amdgcn_readfirstlane((int)(kvdst_ + (unsigned)t_ * (unsigned)C_KVSLOT));
          unsigned keep_; asm volatile("s_mov_b32 %0, m0\n\ts_mov_b32 m0, %2\n\ts_nop 0\n\tglobal_load_lds_dwordx4 %1, off\n\ts_mov_b32 m0, %0" : "=&s"(keep_) : "v"(s_), "s"(d_) : "memory");
          if (w < 2) { const char* s2_ = s_ + 8192; const unsigned d2_ = d_ + 8192u; asm volatile("s_mov_b32 %0, m0\n\ts_mov_b32 m0, %2\n\ts_nop 0\n\tglobal_load_lds_dwordx4 %1, off\n\ts_mov_b32 m0, %0" : "=&s"(keep_) : "v"(s2_), "s"(d2_) : "memory"); } } }
    h16x8 afr[4]; float wreg[16];
    { const int qq = 2 * ((r >> 2) & 1) + (r >> 4), head = (r & 3) + 4 * ((r >> 3) & 1); const size_t tokA = tokbase + t0 + 4 * w + qq;
      const h16* qsrc = QI + tokA * 512 + head * 64;
      { float o[8]; rope8(*(const GAS h16x8*)(qsrc), *(const GAS h16x8*)(qsrc + 8), CS + tokA * 16, hf, 1.0f, o); afr[0] = __builtin_bit_cast(h16x8, pack8(o)); }
#pragma unroll
      for (int s = 1; s < 4; ++s) afr[s] = *(const GAS h16x8*)(qsrc + 16 * s + 8 * hf);
      const float* wp = WI + (tokbase + t0 + 4 * w + 2 * hf) * 8;
#pragma unroll
      for (int R4 = 0; R4 < 4; ++R4) { const f32x4 wv = *(const GAS f32x4*)(wp + 4 * R4); wreg[4 * R4] = wv.x; wreg[4 * R4 + 1] = wv.y; wreg[4 * R4 + 2] = wv.z; wreg[4 * R4 + 3] = wv.w; } }
    float SC[128];
    const float QNAN = __uint_as_float(0x7fc00000u);
#pragma unroll
    for (int i = 0; i < 128; ++i) SC[i] = QNAN;
    const int NCK = (NT + 7) >> 3, tq0 = t0 + 4 * w + 2 * hf;
    const int drow = lane >> 3, dslot = lane & 7;
    const h16* kisrc = KI + (tokbase + 32 * w + drow) * 64 + 8 * (dslot ^ drow);
#define KI_STAGE(ck_, buf_) do { _Pragma("unroll") for (int i_ = 0; i_ < 4; ++i_) \
        __builtin_amdgcn_global_load_lds((const unsigned*)(kisrc + (size_t)(256 * (ck_) + 8 * i_) * 64), (LAS unsigned*)(lds + C_KIB + (buf_) * C_KIBUF + (4 * w + i_) * 1024), 16, 0, 0); } while (0)
    KI_STAGE(0, 0);
    VM_WAIT(); __syncthreads();
    const int kroff = r * 128, kx = r & 7;
#pragma unroll 1
    for (int ck = 0; ck < NCK; ++ck) {
        LAS unsigned char* kb = lds + C_KIB + (ck & 1) * C_KIBUF;
        if (ck + 1 < NCK) KI_STAGE(ck + 1, (ck + 1) & 1);
#pragma unroll
        for (int i = 0; i < 112; ++i) SC[i] = SC[i + 16];
#pragma unroll
        for (int jj = 0; jj < 8; ++jj) { if (pmode & 1) { SC[112 + 2 * jj] = (float)(ck + jj + r) * 0.01f; SC[113 + 2 * jj] = (float)(ck - jj + r) * 0.01f; continue; }
            f32x16 D = {};
#pragma unroll
            for (int s = 0; s < 4; ++s) { const h16x8 bb = *(const LAS h16x8*)(kb + jj * 4096 + kroff + 16 * ((2 * s + hf) ^ kx)); D = __builtin_amdgcn_mfma_f32_32x32x16_f16(afr[s], bb, D, 0, 0, 0); }
            float s0 = 0.f, s1 = 0.f;
#pragma unroll
            for (int R = 0; R < 8; ++R) { s0 = fmaf(wreg[R], fmaxf(D[R], 0.f), s0); s1 = fmaf(wreg[8 + R], fmaxf(D[8 + R], 0.f), s1); }
            const int k = 256 * ck + 32 * jj + r;
            SC[112 + 2 * jj] = (k > tq0) ? QNAN : s0; SC[113 + 2 * jj] = (k > tq0 + 1) ? QNAN : s1;
        }
        LDS_WAIT(); VM_WAIT(); __syncthreads();
    }
#undef KI_STAGE
    const int G0 = 8 - NCK;
#define SEL_COUNT2(c0, c1, FN, m0, m1) do { int a0_ = 0, a1_ = 0; \
        _Pragma("unroll") for (int g = 0; g < 8; ++g) if (g >= G0) FN(a0_, a1_, &SC[16 * g], (m0), (m1)); \
        c0 = half_sum_dpp(a0_, hf); c1 = half_sum_dpp(a1_, hf); } while (0)
    float tau0 = -3.0e38f, tau1 = -3.0e38f;
    if (qt >= 8 && !(pmode & 2)) {
        float lo0 = INFINITY, lo1 = INFINITY, hi0 = -INFINITY, hi1 = -INFINITY;
#pragma unroll
        for (int j = 0; j < 64; ++j) { const float a = SC[2 * j], c = SC[2 * j + 1]; lo0 = fminf(lo0, a); hi0 = fmaxf(hi0, a); lo1 = fminf(lo1, c); hi1 = fmaxf(hi1, c); }
#pragma unroll
        for (int o = 1; o < 32; o <<= 1) { lo0 = fminf(lo0, __shfl_xor(lo0, o)); lo1 = fminf(lo1, __shfl_xor(lo1, o)); hi0 = fmaxf(hi0, __shfl_xor(hi0, o)); hi1 = fmaxf(hi1, __shfl_xor(hi1, o)); }
        int cl0 = tq0 + 1, cl1 = tq0 + 2, ch0 = 1, ch1 = 1;
        bool done0 = false, done1 = false;
        { int g0, g1; const float zero = 0.f; SEL_COUNT2(g0, g1, cnt_group_gt, zero, zero);
          const float tiny = __uint_as_float(1u);
          if (__any(g0 < 256 || g1 < 256)) { int e0, e1; SEL_COUNT2(e0, e1, cnt_group_ge, zero, zero);
              if (g0 < 256) { if (e0 >= 256) { lo0 = 0.f; done0 = true; } else { hi0 = 0.f; ch0 = e0; } }
              if (g1 < 256) { if (e1 >= 256) { lo1 = 0.f; done1 = true; } else { hi1 = 0.f; ch1 = e1; } } }
          if (g0 >= 256) { lo0 = tiny; cl0 = g0; if (g0 == 256) done0 = true; }
          if (g1 >= 256) { lo1 = tiny; cl1 = g1; if (g1 == 256) done1 = true; } }
#define SEL_STEP(c0, c1, mid0, mid1) do { \
            if (!done0) { if (c0 >= 256) { lo0 = mid0; cl0 = c0; if (c0 == 256) done0 = true; } else { hi0 = mid0; ch0 = c0; } } \
            if (!done1) { if (c1 >= 256) { lo1 = mid1; cl1 = c1; if (c1 == 256) done1 = true; } else { hi1 = mid1; ch1 = c1; } } } while (0)
#define SEL_EXHAUSTED(bis0, bis1) do { if (!done0 && (bis0 <= lo0 || bis0 >= hi0)) done0 = true; if (!done1 && (bis1 <= lo1 || bis1 >= hi1)) done1 = true; } while (0)
        bool compact = true;
#pragma unroll 1
        for (int it = 0; it < ((pmode & 16) ? 6 : 40); ++it) {
            const float bis0 = 0.5f * (lo0 + hi0), bis1 = 0.5f * (lo1 + hi1);
            SEL_EXHAUSTED(bis0, bis1);
            if (__all((done0 || (compact && cl0 - ch0 <= 48)) && (done1 || (compact && cl1 - ch1 <= 48)))) break;
            int c0, c1; SEL_COUNT2(c0, c1, cnt_group_ge, bis0, bis1);
            SEL_STEP(c0, c1, bis0, bis1);
            if (it == 39) { done0 = true; done1 = true; }
        }
        if (!__all(done0 && done1)) {
            LAS float* L0 = (LAS float*)(lds + w * 4096 + (2 * hf) * 1024 + r * 32); LAS float* L1 = L0 + 256;
            { const f32x4 qn = {QNAN, QNAN, QNAN, QNAN}; *(LAS f32x4*)L0 = qn; *(LAS f32x4*)(L0 + 4) = qn; *(LAS f32x4*)L1 = qn; *(LAS f32x4*)(L1 + 4) = qn; }
            int n0 = 0, n1 = 0;
#pragma unroll
            for (int g = 0; g < 8; ++g) if (g >= G0) {
#pragma unroll
                for (int jj = 0; jj < 8; ++jj) { const int j = 8 * g + jj; const float v0 = SC[2 * j], v1 = SC[2 * j + 1];
                    if (!done0 && v0 >= lo0 && v0 < hi0) { if (n0 < 8) L0[n0] = v0; ++n0; }
                    if (!done1 && v1 >= lo1 && v1 < hi1) { if (n1 < 8) L1[n1] = v1; ++n1; } } }
            LDS_WAIT();
            float CAND[16];
            { const f32x4 a0 = *(const LAS f32x4*)L0, a1 = *(const LAS f32x4*)(L0 + 4), b0 = *(const LAS f32x4*)L1, b1 = *(const LAS f32x4*)(L1 + 4);
#pragma unroll
              for (int i = 0; i < 4; ++i) { CAND[2 * i] = a0[i]; CAND[8 + 2 * i] = a1[i]; CAND[2 * i + 1] = b0[i]; CAND[8 + 2 * i + 1] = b1[i]; } }
            LDS_WAIT();
            if (__any(n0 > 8 || n1 > 8)) {
#pragma unroll 1
                for (int it = 0; it < 40; ++it) {
                    const float bis0 = 0.5f * (lo0 + hi0), bis1 = 0.5f * (lo1 + hi1);
                    SEL_EXHAUSTED(bis0, bis1);
                    if (__all(done0 && done1)) break;
                    int c0, c1; SEL_COUNT2(c0, c1, cnt_group_ge, bis0, bis1);
                    SEL_STEP(c0, c1, bis0, bis1);
                }
            } else {
                const int cb0 = ch0, cb1 = ch1;
#pragma unroll 1
                for (int it = 0; it < ((pmode & 16) ? 3 : 48); ++it) {
                    const float bis0 = 0.5f * (lo0 + hi0), bis1 = 0.5f * (lo1 + hi1);
                    SEL_EXHAUSTED(bis0, bis1);
                    if (__all(done0 && done1)) break;
                    float mid0 = bis0, mid1 = bis1;
                    if ((it % 3) != 2) { const float i0 = lo0 + ((float)cl0 - 255.5f) / (float)(cl0 - ch0) * (hi0 - lo0), i1 = lo1 + ((float)cl1 - 255.5f) / (float)(cl1 - ch1) * (hi1 - lo1);
                        if (i0 > lo0 && i0 < hi0) mid0 = i0; if (i1 > lo1 && i1 < hi1) mid1 = i1; }
                    int a0 = 0, a1 = 0; cnt_group_ge(a0, a1, CAND, mid0, mid1);
                    const int c0 = cb0 + half_sum_dpp(a0, hf), c1 = cb1 + half_sum_dpp(a1, hf);
                    SEL_STEP(c0, c1, mid0, mid1);
                }
            }
        }
#undef SEL_STEP
#undef SEL_EXHAUSTED
        tau0 = lo0; tau1 = lo1;
    }
#undef SEL_COUNT2
    unsigned w00 = 0u, w01 = 0u, w10 = 0u, w11 = 0u;
#pragma unroll
    for (int g = 0; g < 8; ++g) if (g >= G0 && !(pmode & 4)) {
#pragma unroll
        for (int jj = 0; jj < 8; ++jj) { const int j = 8 * g + jj, jt = 8 * (g - G0) + jj;
            ballot_ge_to_lane(w00, w10, SC[2 * j], tau0, jt); ballot_ge_to_lane(w01, w11, SC[2 * j + 1], tau1, jt); } }
    { LAS unsigned* WQ = (LAS unsigned*)(lds + C_WQ);
      WQ[(4 * w + 0) * 64 + lane] = w00; WQ[(4 * w + 1) * 64 + lane] = w01; WQ[(4 * w + 2) * 64 + lane] = w10; WQ[(4 * w + 3) * 64 + lane] = w11; }
    LDS_WAIT(); __syncthreads();
}

__device__ __forceinline__ void phaseC_attn(const Frame& F, int l, int b, int qt, bool do_store = true, int pmode = 0) {
    unsigned char* ws = F.ws; asm volatile("" : "+s"(ws)); ws = (unsigned char*)(GAS unsigned char*)ws;     const int w = F.wave;
    int lane = lane_id(), tid = F.wave * 64 + lane; asm volatile("" : "+v"(lane), "+v"(tid));
    const int r = lane & 31, hf = lane >> 5;
    const float* CS = (const float*)(ws + WS_CS);
    h16* QY = (h16*)(ws + WS_QY); const h16* KV = (const h16*)(ws + WS_KV);
    const h16* WUKT = (const h16*)(ws + WS_SMALLW + (size_t)l * SMALLW_LAYER); const h16* WUVT = (const h16*)(ws + WS_SMALLW + (size_t)l * SMALLW_LAYER + 98304);
    LAS unsigned char* lds = F.lds;
    const int t0 = 32 * qt, NT = qt + 1; const size_t tokbase = (size_t)b * SEQ;
    const int h = w; const size_t tokQ = tokbase + t0 + r;
    LAS h16* ql = (LAS h16*)(lds + C_QL + w * C_QLW);
    if (!(pmode & 64)) { h16x8 bq[3];
#pragma unroll
      for (int s = 0; s < 3; ++s) bq[s] = *(const GAS h16x8*)(QY + tokQ * 1024 + h * 64 + 16 + 16 * s + 8 * hf);
#pragma unroll
      for (int cb = 0; cb < 4; ++cb) { f32x16 D = {};
#pragma unroll
          for (int s = 0; s < 3; ++s) { const h16x8 a = *(const GAS h16x8*)(WUKT + ((size_t)(h * 128 + 32 * cb + r)) * 48 + 16 * s + 8 * hf); D = __builtin_amdgcn_mfma_f32_32x32x16_f16(a, bq[s], D, 0, 0, 0); }
#pragma unroll
          for (int g = 0; g < 4; ++g) { const int c = 32 * cb + 8 * g + 4 * hf;
              *(LAS u32x2*)(ql + r * KVP + c) = (u32x2){pkh(D[4 * g] * QSCALE, D[4 * g + 1] * QSCALE), pkh(D[4 * g + 2] * QSCALE, D[4 * g + 3] * QSCALE)}; } }
      { float o[8]; rope8(*(const GAS h16x8*)(QY + tokQ * 1024 + h * 64), *(const GAS h16x8*)(QY + tokQ * 1024 + h * 64 + 8), CS + tokQ * 16, hf, QSCALE, o); *(LAS u32x4*)(ql + r * KVP + 128 + 8 * hf) = pack8(o); } }
    LDS_WAIT();
    h16x8 qfr[9];
#pragma unroll
    for (int s = 0; s < 9; ++s) qfr[s] = *(const LAS h16x8*)(ql + r * KVP + 16 * s + 8 * hf);
    const char* kvsrc = (const char*)(KV + tokbase * KVP) + (size_t)(64 * w + lane) * 16;
    const unsigned kvdst = (unsigned)(uintptr_t)(lds + C_KVS) + (unsigned)w * 1024u;
    const int grp = w >> 2;
#define KV_DMA1(src_, dst_) do { unsigned keep_; asm volatile("s_mov_b32 %0, m0\n\ts_mov_b32 m0, %2\n\ts_nop 0\n\tglobal_load_lds_dwordx4 %1, off\n\ts_mov_b32 m0, %0" : "=&s"(keep_) : "v"(src_), "s"(dst_) : "memory"); } while (0)
#define KV_DMA(t_) do { const char* s_ = kvsrc + (size_t)(t_) * (32 * KVP * 2); const unsigned d_ = (unsigned)__builtin_amdgcn_readfirstlane((int)(kvdst + (unsigned)((t_) % 5) * (unsigned)C_KVSLOT)); \
        KV_DMA1(s_, d_); if (w < 2) { const char* s2_ = s_ + 8192; const unsigned d2_ = d_ + 8192u; KV_DMA1(s2_, d2_); } } while (0)
#define KV_WAIT(n_) do { if ((n_) <= 0) asm volatile("s_waitcnt vmcnt(0)" ::: "memory"); else if ((n_) == 1) { if (w < 2) asm volatile("s_waitcnt vmcnt(2)" ::: "memory"); else asm volatile("s_waitcnt vmcnt(1)" ::: "memory"); } \
        else { if (w < 2) asm volatile("s_waitcnt vmcnt(4)" ::: "memory"); else asm volatile("s_waitcnt vmcnt(2)" ::: "memory"); } } while (0)
#if defined(PROBE_C_ATT)
    { KV_DMA(0); if (NT > 1) KV_DMA(1); if (NT > 2) KV_DMA(2); if (NT > 3) KV_DMA(3); }
#endif
    asm volatile("s_waitcnt vmcnt(0)" ::: "memory");
    asm volatile("s_waitcnt lgkmcnt(0)" ::: "memory"); __builtin_amdgcn_s_barrier(); asm volatile("" ::: "memory");
    float mrun = 0.f, lrun = 0.f; f32x16 O[4]; f32x16 negm;
#pragma unroll
    for (int db = 0; db < 4; ++db) O[db] = (f32x16){};
#pragma unroll
    for (int R = 0; R < 16; ++R) negm[R] = 0.f;
    const LAS unsigned* WQr = (const LAS unsigned*)(lds + C_WQ) + r * 64;
    const int troff = ((lane & 15) >> 2) * (KVP * 2) + (16 * ((lane >> 4) & 1) + 4 * (lane & 3)) * 2 + 4 * hf * (KVP * 2);
    const int kbase = (int)(uintptr_t)(lds + C_KVS) + r * (KVP * 2) + 16 * hf, vbase = (int)(uintptr_t)(lds + C_KVS) + troff;
    typedef short s16x8 __attribute__((ext_vector_type(8)));
#define AT_MAX3(a_, b_, c_) ({ float r_; asm("v_max3_f32 %0, %1, %2, %3" : "=v"(r_) : "v"(a_), "v"(b_), "v"(c_)); r_; })
#define AT_MASKED(e_, w_, pos_) ({ int t_, r_; asm("v_bfe_i32 %0, %2, %3, 1\n\tv_and_b32 %1, %4, %0" : "=&v"(t_), "=v"(r_) : "v"(w_), "n"(pos_), "v"(e_)); __int_as_float(r_); })
#define AT_KLOAD(so_) h16x8 kfr[9]; do { const LAS unsigned char* sl_ = (const LAS unsigned char*)(uintptr_t)(kbase + (so_)); \
        if (!(pmode & 16)) { _Pragma("unroll") for (int s = 0; s < 9; ++s) kfr[s] = *(const LAS h16x8*)(sl_ + 32 * s); } else { _Pragma("unroll") for (int s = 0; s < 9; ++s) kfr[s] = qfr[s]; } __builtin_amdgcn_sched_barrier(0); } while (0)
#define AT_QK(S_) do { S_ = negm; if (!(pmode & 16)) { __builtin_amdgcn_s_setprio(1); _Pragma("unroll") for (int s = 0; s < 9; ++s) S_ = __builtin_amdgcn_mfma_f32_32x32x16_f16(kfr[s], qfr[s], S_, 0, 0, 0); __builtin_amdgcn_s_setprio(0); } } while (0)
#define AT_VLOAD(db0_) do { _Pragma("unroll") for (int db = 0; db < 2; ++db) _Pragma("unroll") for (int sp = 0; sp < 2; ++sp) { \
            vlo_[db][sp] = __builtin_amdgcn_ds_read_tr16_b64_v4i16((LAS v4i16_t*)(sl_ + (16 * sp) * (KVP * 2) + 64 * ((db0_) + db))); \
            vhi_[db][sp] = __builtin_amdgcn_ds_read_tr16_b64_v4i16((LAS v4i16_t*)(sl_ + (16 * sp + 8) * (KVP * 2) + 64 * ((db0_) + db))); } } while (0)
#define AT_PV2(db0_) do { __builtin_amdgcn_s_setprio(1); _Pragma("unroll") for (int db = 0; db < 2; ++db) _Pragma("unroll") for (int sp = 0; sp < 2; ++sp) { \
            const s16x8 av_ = {vlo_[db][sp][0], vlo_[db][sp][1], vlo_[db][sp][2], vlo_[db][sp][3], vhi_[db][sp][0], vhi_[db][sp][1], vhi_[db][sp][2], vhi_[db][sp][3]}; \
            O[(db0_) + db] = __builtin_amdgcn_mfma_f32_32x32x16_f16(__builtin_bit_cast(h16x8, av_), pf_[sp], O[(db0_) + db], 0, 0, 0); } __builtin_amdgcn_s_setprio(0); } while (0)
#define AT_SMPV(S_, t_, so_) do { const LAS unsigned char* sl_ = (const LAS unsigned char*)(uintptr_t)(vbase + (so_)); \
        v4i16_t vlo_[2][2], vhi_[2][2]; \
        AT_VLOAD(0); \
        const int wq_ = (int)(WQr[(t_)] >> (4 * hf)); \
        __builtin_amdgcn_sched_barrier(0); \
        float mt_ = AT_MAX3(S_[0], S_[1], S_[2]); \
        _Pragma("unroll") for (int R = 3; R < 15; R += 2) mt_ = AT_MAX3(mt_, S_[R], S_[R + 1]); \
        mt_ = half_swap_max(AT_MAX3(mt_, S_[15], S_[15])); \
        if ((t_) == 0 || __any(mt_ > 8.0f)) { const float dl_ = (t_) == 0 ? mt_ : fmaxf(mt_, 0.f), alpha_ = (t_) == 0 ? 1.f : __builtin_amdgcn_exp2f(-dl_);     \
            _Pragma("unroll") for (int db = 0; db < 4; ++db) O[db] = O[db] * alpha_; \
            _Pragma("unroll") for (int R = 0; R < 16; ++R) S_[R] -= dl_; \
            lrun *= alpha_; mrun += dl_; \
            _Pragma("unroll") for (int R = 0; R < 16; ++R) negm[R] = -mrun; } \
        float p_[16]; \
        if (!(pmode & 1)) { _Pragma("unroll") for (int R = 0; R < 16; ++R) { const float e_ = __builtin_amdgcn_exp2f(S_[R]); p_[R] = AT_MASKED(e_, wq_, (R & 3) + 8 * (R >> 2)); lrun += p_[R]; } } \
        else { _Pragma("unroll") for (int R = 0; R < 16; ++R) p_[R] = S_[R]; lrun += p_[0]; } \
        h16x8 pf_[2]; \
        _Pragma("unroll") for (int sp = 0; sp < 2; ++sp) { u32x4 t4_; t4_.x = pkz(p_[8 * sp], p_[8 * sp + 1]); t4_.y = pkz(p_[8 * sp + 2], p_[8 * sp + 3]); t4_.z = pkz(p_[8 * sp + 4], p_[8 * sp + 5]); t4_.w = pkz(p_[8 * sp + 6], p_[8 * sp + 7]); pf_[sp] = __builtin_bit_cast(h16x8, t4_); } \
        __builtin_amdgcn_sched_barrier(0); \
        if (!(pmode & 2)) { AT_PV2(0); \
        __builtin_amdgcn_sched_barrier(0); \
        AT_VLOAD(2); \
        __builtin_amdgcn_sched_barrier(0); \
        AT_PV2(2); } else { O[0][0] += (float)pf_[0][0] + (float)pf_[1][0]; } } while (0)
#define AT_BOUNDARY2(g_) do {   \
        if (!(pmode & 4)) { asm volatile("s_waitcnt vmcnt(0) lgkmcnt(0)" ::: "memory"); __builtin_amdgcn_s_barrier(); asm volatile("" ::: "memory"); \
        if (2 * (g_) + 4 < NT) KV_DMA(2 * (g_) + 4); if (2 * (g_) + 5 < NT) KV_DMA(2 * (g_) + 5); } } while (0)
#define AT_NEXT(so_) ((so_) == 4 * C_KVSLOT ? 0 : (so_) + C_KVSLOT)
    const int NG = (NT + 1) >> 1;
    if (grp == 0) {
        int so = 0;
#pragma unroll 1
        for (int g = 0; g < NG; ++g) { const int t = 2 * g;
            { f32x16 Sx; AT_KLOAD(so); AT_QK(Sx); __builtin_amdgcn_sched_barrier(0); AT_SMPV(Sx, t, so); so = AT_NEXT(so); }
            if (t + 1 < NT) { f32x16 Sx; AT_KLOAD(so); AT_QK(Sx); __builtin_amdgcn_sched_barrier(0); AT_SMPV(Sx, t + 1, so); so = AT_NEXT(so); }
            AT_BOUNDARY2(g); }
    } else {
        f32x16 Sx; int so = 0, sop = 0;
        { AT_KLOAD(so); AT_QK(Sx); } sop = so; so = AT_NEXT(so);
        if (1 < NT) { AT_SMPV(Sx, 0, sop); __builtin_amdgcn_sched_barrier(0); { AT_KLOAD(so); AT_QK(Sx); } sop = so; so = AT_NEXT(so); }
        AT_BOUNDARY2(0);
#pragma unroll 1
        for (int g = 1; g < NG; ++g) { const int t = 2 * g;
            AT_SMPV(Sx, t - 1, sop); __builtin_amdgcn_sched_barrier(0); { AT_KLOAD(so); AT_QK(Sx); } sop = so; so = AT_NEXT(so);
            if (t + 1 < NT) { AT_SMPV(Sx, t, sop); __builtin_amdgcn_sched_barrier(0); { AT_KLOAD(so); AT_QK(Sx); } sop = so; so = AT_NEXT(so); }
            AT_BOUNDARY2(g); }
        AT_SMPV(Sx, NT - 1, sop);
    }
#undef AT_NEXT
#undef AT_MAX3
#undef AT_MASKED
#undef AT_BOUNDARY2
#undef KV_DMA
#undef KV_DMA1
#undef KV_WAIT
#undef AT_KLOAD
#undef AT_QK
#undef AT_SMPV
#undef AT_VLOAD
#undef AT_PV2
    if (!(pmode & 32)) {
    h16x8 bwv[2][8];
#pragma unroll
    for (int d2 = 0; d2 < 2; ++d2)
#pragma unroll
        for (int s = 0; s < 8; ++s) bwv[d2][s] = *(const GAS h16x8*)(WUVT + ((size_t)(h * 64 + 32 * d2 + r)) * 128 + 16 * s + 8 * hf);
    { const float inv = 1.0f / half_swap_sum(lrun);
#pragma unroll
      for (int db = 0; db < 4; ++db)
#pragma unroll
          for (int g = 0; g < 4; ++g) { const int c = 32 * db + 8 * g + 4 * hf;
              *(LAS u32x2*)(ql + r * KVP + c) = (u32x2){pkh(O[db][4 * g] * inv, O[db][4 * g + 1] * inv), pkh(O[db][4 * g + 2] * inv, O[db][4 * g + 3] * inv)}; } }
    LDS_WAIT();
    { h16x8 ao[8];
#pragma unroll
      for (int s = 0; s < 8; ++s) ao[s] = *(const LAS h16x8*)(ql + r * KVP + 16 * s + 8 * hf);
#pragma unroll
      for (int d2 = 0; d2 < 2; ++d2) { f32x16 D = {};
#pragma unroll
          for (int s = 0; s < 8; ++s) D = __builtin_amdgcn_mfma_f32_32x32x16_f16(bwv[d2][s], ao[s], D, 0, 0, 0);
#pragma unroll
          for (int g = 0; g < 4; ++g) { const u32x2 pk = {pkh(D[4 * g], D[4 * g + 1]), pkh(D[4 * g + 2], D[4 * g + 3])};
              if (do_store) *(GAS u32x2*)(QY + (tokbase + t0 + r) * 1024 + h * 64 + 32 * d2 + 8 * g + 4 * hf) = pk; else asm volatile("" :: "v"(pk)); } } }
    } else { asm volatile("" :: "v"(O[0][0]), "v"(O[1][0]), "v"(O[2][0]), "v"(O[3][0]), "v"(lrun)); }
    LDS_WAIT(); __syncthreads();
}

__device__ __forceinline__ void phaseC(const Frame& F, int l) {
    int vc = F.vcu; asm volatile("" : "+s"(vc)); const int b = vc >> 5, i = vc & 31;
#pragma unroll 1
    for (int u = 0; u < 2; ++u) { const int qt = (u == 0) ? 63 - i : i;
#if defined(PROBE_C_SEL)
#pragma unroll 1
        for (int rep = 0; rep < 2; ++rep)
        phaseC_select(F, l, b, qt, rep == 0 ? PROBE_C_SEL : 0);
#else
        phaseC_select(F, l, b, qt);
#endif
#if defined(PROBE_C_ATT)
#pragma unroll 1
        for (int rep = 0; rep < 2; ++rep) phaseC_attn(F, l, b, qt, rep == 1, rep == 1 ? 0 : PROBE_C_ATT);
#else
        phaseC_attn(F, l, b, qt);
#endif
    }
}
#if defined(PROBE_STORE)
#define PROBE_NOSTORE(f) (f)
#else
#define PROBE_NOSTORE(f) 0
#endif
#if defined(PROBE_EPI)
#define PROBE_NOEPI(f) (f)
#else
#define PROBE_NOEPI(f) 0
#endif
#ifndef PROBE_MASK
#define PROBE_MASK 0u
#endif
#ifndef MK_N_LAUNCHES
#define MK_N_LAUNCHES 1
#endif
#if MK_N_LAUNCHES == 1
constexpr bool FUSE_FINAL = false;
#else
constexpr bool FUSE_FINAL = false;
#endif
constexpr int N_PHASES = 2 + 7 * NLAYER;
constexpr int CONV_WD_FIRST = CONV_IN_ITEMS + 2 * 128 + 256 + (NGU / 64) * 16;
constexpr int CONV_SPLIT = 2150;
struct Args { In in; float* out; unsigned char* ws; int ph_lo, ph_hi, flags, pad; };

__global__ void __launch_bounds__(NTHREADS, 2) mk_fwd(Args args) {
    extern __shared__ __attribute__((aligned(16))) unsigned char lds_raw[];
    Frame F; F.lds = (LAS unsigned char*)lds_raw; F.wave = __builtin_amdgcn_readfirstlane((int)threadIdx.x >> 6);
    F.G = gridDim.x; { const int bx = blockIdx.x; F.vcu = (F.G % 8 == 0) ? (bx % 8) * (F.G / 8) + bx / 8 : bx; }
    F.ws = args.ws; F.in = nullptr;
    const In& I = args.in; unsigned char* ws = args.ws; (void)ws;
    volatile LAS unsigned* MISCW = (volatile LAS unsigned*)(F.lds + LDS_MISC);
    if (F.wave == 0) MISCW[lane_id()] = 0u;
    __syncthreads();
#if MK_N_LAUNCHES == 1
    const bool one_launch = true;
#else
    const bool one_launch = (args.ph_hi - args.ph_lo) > 1;
#endif
    XcdBarrier bar; bar.bar = (unsigned*)(ws + WS_CTL) + 1024; bar.x = 0; bar.st = nullptr;
    if (one_launch) bar = xcd_barrier_post((unsigned*)(ws + WS_CTL) + 1024, MISCW + 8, F.wave);
#if MK_N_LAUNCHES == 1
#define IN(k) true
#define SEAM(k) xcd_barrier(bar, F.wave)
#else
#define IN(k) (args.ph_lo <= (k) && (k) < args.ph_hi)
#define SEAM(k) do { if (IN(k) && IN((k) + 1)) xcd_barrier(bar, F.wave); } while (0)
#endif
    if (IN(0)) { p0_prologue(F, I); SEAM(0); }
#define OPQ(x) asm volatile("" : "+s"(x))
#pragma unroll 1
    for (int l0 = 0; l0 < NLAYER; ++l0) {
        const int p = 1 + 7 * l0;
        if (IN(p)) {
            unsigned char* wsq = args.ws; int l = l0; OPQ(wsq); OPQ(l); wsq = (unsigned char*)(GAS unsigned char*)wsq; unsigned char* wl = wsq + WS_W + (size_t)l * W_LAYER;
            pg8::Gemm g{(const h16*)(wsq + WS_X16), (const h16*)(wl + W_OFF_IN), 1024, 1024, 1024, M / 256, NZ / 256, 1, 0, PROBE_NOEPI(args.flags), 0};
            constexpr int NTILE = (M / 256) * (NZ / 256), NFULL = (NTILE / 256) * 256, NTAILWG = 2 * (NTILE - NFULL);
            const bool tailmode = (F.G == 256);
            pg8::Order S; S.init(g.nM, g.nN, F.G, (int)blockIdx.x, 1, tailmode ? NFULL : -1); EpiA E{wsq, PROBE_NOSTORE(args.flags), (LAS float*)(F.lds + 131072 + 4096)};
            pg8::gemm_phase<EpiA>(F.lds, g, S, E, F.wave);
            if (tailmode) {
                EpiA E2{wsq, PROBE_NOSTORE(args.flags), (LAS float*)(F.lds + 147456)};
                pg8::gemm_tail_phase<EpiA>(F.lds, g, S, E2, F.wave);
                if ((int)blockIdx.x >= NTAILWG) { const int cgw = ((int)blockIdx.x - NTAILWG) * NWAVES + F.wave, cng = (256 - NTAILWG) * NWAVES;
                    convert_layer_weights(F, I, l, cgw, cng, CONV_IN_ITEMS, 1 << 30);
                    if (l + 1 < NLAYER) convert_layer_weights(F, I, l + 1, cgw, cng, 0, CONV_IN_ITEMS); }
            } else { xcd_barrier(bar, F.wave); convert_layer_weights(F, I, l, F.vcu * NWAVES + F.wave, F.G * NWAVES, CONV_IN_ITEMS, 1 << 30); }
            SEAM(p); }
#if MK_N_LAUNCHES == 1
        if (IN(p + 1)) { int l = l0; OPQ(l); phaseB(F, I, l); }
#else
        if (IN(p + 1)) { int l = l0; OPQ(l); phaseB(F, I, l); SEAM(p + 1); }
#endif
        if (IN(p + 2)) { int l = l0; OPQ(l); phaseC(F, l); SEAM(p + 2); }
        if (IN(p + 3)) {
            unsigned char* wsq = args.ws; int l = l0; OPQ(wsq); OPQ(l); wsq = (unsigned char*)(GAS unsigned char*)wsq; unsigned char* wl = wsq + WS_W + (size_t)l * W_LAYER;
            pg8::Gemm g{(const h16*)(wsq + WS_QY), (const h16*)(wl + W_OFF_PAB), 1024, 1024, 512, M / 256, 4, 2, 512, PROBE_NOEPI(args.flags), 0};
            pg8::Order S; S.init(g.nM, g.nN, F.G, (int)blockIdx.x, 2); EpiD E{wsq, (h16*)args.out};
            pg8::gemm_phase<EpiD>(F.lds, g, S, E, F.wave); SEAM(p + 3); }
        if (IN(p + 4)) {
            unsigned char* wsq = args.ws; int l = l0; OPQ(wsq); OPQ(l); wsq = (unsigned char*)(GAS unsigned char*)wsq; unsigned char* wl = wsq + WS_W + (size_t)l * W_LAYER;
            pg8::Gemm g{(const h16*)args.out, (const h16*)(wl + W_OFF_OUT), 1024, 1024, 1024, M / 256, 4, 1, 0, PROBE_NOEPI(args.flags), 0};
            pg8::Order S; S.init(g.nM, g.nN, F.G, (int)blockIdx.x, 1);
            EpiRes E{(const h16*)(wsq + WS_X16), (h16*)(wsq + WS_X1), (float*)(wsq + WS_SSQ), (LAS float*)(F.lds + 131072)};
            pg8::gemm_phase<EpiRes>(F.lds, g, S, E, F.wave); SEAM(p + 4); }
        if (IN(p + 5)) {
            unsigned char* wsq = args.ws; int l = l0; OPQ(wsq); OPQ(l); wsq = (unsigned char*)(GAS unsigned char*)wsq; unsigned char* wl = wsq + WS_W + (size_t)l * W_LAYER;
            pg8::Gemm g{(const h16*)(wsq + WS_X1), (const h16*)(wl + W_OFF_GU), 1024, 1024, 1024, M / 256, NGU / 256, 1, 0, PROBE_NOEPI(args.flags), 0};
            constexpr int NTILE = (M / 256) * (NGU / 256), NFULL = (NTILE / 256) * 256;
            const bool tailmode = (F.G == 256);
            pg8::Order S; S.init(g.nM, g.nN, F.G, (int)blockIdx.x, 1, tailmode ? NFULL : -1); EpiF E{wsq, (LAS float*)(F.lds + 131072 + 4096)};
            pg8::gemm_phase<EpiF>(F.lds, g, S, E, F.wave);
            if (tailmode) { EpiF E2{wsq, (LAS float*)(F.lds + 147456)}; pg8::gemm_tail_phase<EpiF>(F.lds, g, S, E2, F.wave); }
            else if (l + 1 < NLAYER) { xcd_barrier(bar, F.wave); convert_layer_weights(F, I, l + 1, F.vcu * NWAVES + F.wave, F.G * NWAVES, 0, CONV_IN_ITEMS); }
            SEAM(p + 5); }
        if (IN(p + 6)) {
            unsigned char* wsq = args.ws; int l = l0; OPQ(wsq); OPQ(l); wsq = (unsigned char*)(GAS unsigned char*)wsq; unsigned char* wl = wsq + WS_W + (size_t)l * W_LAYER;
            pg8::Gemm g{(const h16*)(wsq + WS_ACT), (const h16*)(wl + W_OFF_D), DFF, DFF, DFF, M / 256, 4, 1, 0, PROBE_NOEPI(args.flags), 0};
            pg8::Order S; S.init(g.nM, g.nN, F.G, (int)blockIdx.x, 1);
            if (FUSE_FINAL && l == NLAYER - 1 && F.G == 256) {
                EpiFinal E{(const h16*)(wsq + WS_X1), args.out, args.in.final_norm, (float*)(wsq + WS_SSQ), (unsigned*)(wsq + WS_CTL) + 8192, (LAS float*)(F.lds + 131072)};
                pg8::gemm_phase<EpiFinal>(F.lds, g, S, E, F.wave);
            } else {
                EpiRes E{(const h16*)(wsq + WS_X1), (h16*)(wsq + WS_X16), (float*)(wsq + WS_SSQ), (LAS float*)(F.lds + 131072)};
                pg8::gemm_phase<EpiRes>(F.lds, g, S, E, F.wave); SEAM(p + 6); } }
    }
    if (IN(N_PHASES - 1) && !(FUSE_FINAL && F.G == 256)) final_norm_phase(F, (const h16*)(args.ws + WS_X16), (const float*)(args.ws + WS_SSQ), args.out, I.final_norm);
#undef IN
#undef SEAM
}

extern "C" void kernel_launch(void* const* d_in, const int* in_sizes, int n_in, void* d_out, int out_size, void* d_ws, size_t ws_size, hipStream_t stream) {
    static int grid = 0;
    if (grid == 0) {
        if (n_in != 19 || out_size != M * DM || ws_size < WS_END) { fprintf(stderr, "kernel_launch: unexpected shapes (n_in %d out %d ws %zu)\n", n_in, out_size, ws_size); grid = -1; return; }
        int dev = 0, cus = 0, per_cu = 0;
        hipGetDevice(&dev); hipDeviceGetAttribute(&cus, hipDeviceAttributeMultiprocessorCount, dev);
        hipFuncSetAttribute((const void*)mk_fwd, hipFuncAttributeMaxDynamicSharedMemorySize, LDS_BYTES);
        hipOccupancyMaxActiveBlocksPerMultiprocessor(&per_cu, (const void*)mk_fwd, NTHREADS, LDS_BYTES);
        (void)hipGetLastError();
        if (per_cu < 1) fprintf(stderr, "kernel_launch: occupancy query reports %d blocks per CU\n", per_cu);
        grid = cus < 256 ? cus : 256;
        if (grid != 256) fprintf(stderr, "kernel_launch: %d CUs: this kernel's work split assumes 256 workgroups\n", cus);
    }
    if (grid < 0) return;
    hipMemsetAsync((char*)d_ws + WS_CTL, 0, CTL_ZERO_BYTES, stream);
    Args a{};
    const void** ip = (const void**)&a.in;
    for (int i = 0; i < 19; ++i) ip[i] = d_in[i];
    a.out = (float*)d_out; a.ws = (unsigned char*)d_ws;
#if MK_N_LAUNCHES == 1
    a.ph_lo = 0; a.ph_hi = N_PHASES;
    { void* kargs[] = {&a}; hipError_t e = hipLaunchCooperativeKernel((const void*)mk_fwd, dim3(grid), dim3(NTHREADS), kargs, LDS_BYTES, stream);
      if (e != hipSuccess) fprintf(stderr, "cooperative launch failed: %s (grid %d)\n", hipGetErrorString(e), grid); }
#else
    for (int p = 0; p < N_PHASES; ++p) { const int reps = ((PROBE_MASK >> p) & 1u) ? 2 : 1;
        for (int rr = 0; rr < reps; ++rr) { a.ph_lo = p; a.ph_hi = p + 1; a.flags = (rr > 0) ? 1 : 0; hipLaunchKernelGGL(mk_fwd, dim3(grid), dim3(NTHREADS), LDS_BYTES, stream, a); } }
#endif
}
```

```cpp
#define MK_N_LAUNCHES 1
#include <hip/hip_runtime.h>
#include <stdint.h>
#include <math.h>
#include <cstdio>

#define LAS __attribute__((address_space(3)))
#define GAS __attribute__((address_space(1)))
typedef _Float16 h16;
typedef h16 h16x8 __attribute__((ext_vector_type(8)));
typedef h16 h16x4 __attribute__((ext_vector_type(4)));
typedef h16 h16x2 __attribute__((ext_vector_type(2)));
typedef float f32x2 __attribute__((ext_vector_type(2)));
typedef float f32x4 __attribute__((ext_vector_type(4)));
typedef float f32x16 __attribute__((ext_vector_type(16)));
typedef unsigned u32x2 __attribute__((ext_vector_type(2)));
typedef unsigned u32x4 __attribute__((ext_vector_type(4)));
typedef short v4i16_t __attribute__((ext_vector_type(4)));

__device__ __forceinline__ int lane_id() { return (int)__builtin_amdgcn_mbcnt_hi(~0u, __builtin_amdgcn_mbcnt_lo(~0u, 0u)); }
__device__ __forceinline__ unsigned pkh(float lo, float hi) { h16x2 v = {(h16)lo, (h16)hi}; return __builtin_bit_cast(unsigned, v); }
__device__ __forceinline__ unsigned pkz(float lo, float hi) { return __builtin_bit_cast(unsigned, __builtin_amdgcn_cvt_pkrtz(lo, hi)); }
__device__ __forceinline__ void store16_wt(void* p, u32x4 v) { asm volatile("global_store_dwordx4 %0, %1, off sc1\n\ts_nop 1" :: "v"(p), "v"(v) : "memory"); }
__device__ __forceinline__ float h2f_lo(unsigned u) { h16x2 v = __builtin_bit_cast(h16x2, u); return (float)v[0]; }
__device__ __forceinline__ float h2f_hi(unsigned u) { h16x2 v = __builtin_bit_cast(h16x2, u); return (float)v[1]; }

namespace pg8 {
constexpr int BM = 256, BK = 64, HALF = 128, HTB = HALF * BK * 2, STAGE_BYTES = 8 * HTB, NXCD = 8, WGM = 4;
__host__ __device__ __forceinline__ int lds_byte(int r, int c) { const int st = (r >> 4) * 2 + (c >> 5), rr = r & 15, cc = c & 31, ob = rr * 64 + cc * 2; return st * 1024 + (ob ^ (((ob >> 9) & 1) << 5)); }
__host__ __device__ __forceinline__ void stage_rc(int b, int& R, int& C) { const int st = b / 1024, sb = b % 1024, swz = sb ^ (((sb >> 9) & 1) << 5); R = (st >> 1) * 16 + swz / 64; C = (st & 1) * 32 + (swz % 64) / 2; }
__host__ __device__ __forceinline__ int perm32(int rho) { const int n = rho >> 4, i = rho & 15; return 8 * (i >> 2) + 4 * n + (i & 3); }

struct Unit { int pm, pn, kind; };
struct Gemm { const h16* A; const h16* Bt; int lda, ldb, K, nM, nN, nkind, koff, noepi, stagger; };

struct Order {
    int nM, nN, nwg, G, c, nk;
    __device__ void init(int nM_, int nN_, int G_, int c_, int nk_) { asm volatile("" : "+s"(G_), "+s"(c_)); nM = nM_; nN = nN_; nwg = nM * nN; G = G_; c = c_; nk = nk_; }
    __device__ bool next(int i, Unit& u) const {
        const int ti = i / nk; u.kind = i - ti * nk;
        const long L = (long)ti * G + c; if (L >= nwg) return false;
        int wgid = (int)L; { const int q = nwg / NXCD, r = nwg % NXCD, xcd = wgid % NXCD, off = wgid / NXCD; wgid = (xcd < r ? xcd * (q + 1) : r * (q + 1) + (xcd - r) * q) + off; }
        const int nig = WGM * nN, gid = wgid / nig, fm = gid * WGM, gsz = (nM - fm) < WGM ? (nM - fm) : WGM;
        u.pm = fm + ((wgid % nig) % gsz); u.pn = (wgid % nig) / gsz; return true;
    }
};

template <class Epi>
__device__ __forceinline__ void gemm_phase(LAS unsigned char* lds, const Gemm g, const Order& S, const Epi& E, int wave_) {
    int tid = wave_ * 64 + lane_id(); asm volatile("" : "+v"(tid));
    const int wid = __builtin_amdgcn_readfirstlane(tid >> 6), lane = tid & 63, wr = wid >> 2, wc = wid & 3, fr = lane & 15, fq = lane >> 4;
    const int nt = g.K / BK;
    unsigned voffA[2], voffB[2];
#pragma unroll
    for (int i = 0; i < 2; ++i) { int R, C; stage_rc(tid * 16 + i * 8192, R, C); const int Rb = Epi::PERM ? ((R & ~31) + perm32(R & 31)) : R;
        voffA[i] = (unsigned)(R * g.lda + C) * 2u; voffB[i] = (unsigned)(Rb * g.ldb + C) * 2u; }
    const size_t kstep = (size_t)(BK * 2);
    const size_t hstepA = (size_t)HALF * g.lda * 2, hstepB = (size_t)HALF * g.ldb * 2;
    const unsigned ldsw = (unsigned)wid * 1024u;
    const int aoff = lds_byte(wr * 64 + fr, fq * 8), boff = lds_byte(wc * 32 + fr, fq * 8);
#define PG8_SA(b, h) (((b) * 2 + (h)) * HTB)
#define PG8_SB(b, h) ((4 + (b) * 2 + (h)) * HTB)
#define PG8_STAGE(bufoff, gbase, voff) do { _Pragma("unroll") for (int _i = 0; _i < 2; ++_i) \
        __builtin_amdgcn_global_load_lds((const unsigned*)((const char*)(gbase) + (voff)[_i]), (LAS unsigned*)(lds + (bufoff) + ldsw + _i * 8192), 16, 0, 0); } while (0)
#define PG8_LDA(dst, b, h) do { _Pragma("unroll") for (int m = 0; m < 4; ++m) _Pragma("unroll") for (int k = 0; k < 2; ++k) dst[m][k] = *(const LAS h16x8*)(lds + PG8_SA(b, h) + aoff + m * 2048 + k * 1024); } while (0)
#define PG8_LDB(dst, b, h) do { _Pragma("unroll") for (int n = 0; n < 2; ++n) _Pragma("unroll") for (int k = 0; k < 2; ++k) dst[n][k] = *(const LAS h16x8*)(lds + PG8_SB(b, h) + boff + n * 2048 + k * 1024); } while (0)
#define PG8_MMA(ai, bj, At, Bt) do { __builtin_amdgcn_s_setprio(1); _Pragma("unroll") for (int m = 0; m < 4; ++m) _Pragma("unroll") for (int n = 0; n < 2; ++n) _Pragma("unroll") for (int k = 0; k < 2; ++k) \
        acc[ai][bj][m][n] = __builtin_amdgcn_mfma_f32_16x16x32_f16(Bt[n][k], At[m][k], acc[ai][bj][m][n], 0, 0, 0); __builtin_amdgcn_s_setprio(0); } while (0)
#define PG8_WAIT_V(n) asm volatile("s_waitcnt vmcnt(" #n ")" ::: "memory")
#define PG8_WAIT_L(n) asm volatile("s_waitcnt lgkmcnt(" #n ")" ::: "memory")
#define PG8_BAR __builtin_amdgcn_s_barrier()
#define PG8_SCHED __builtin_amdgcn_sched_barrier(0)
#define PG8_PA(u) ((const char*)g.A + ((size_t)(u).pm * 256 * g.lda + (size_t)(u).kind * g.koff) * 2)
#define PG8_PB(u) ((const char*)g.Bt + ((size_t)(u).pn * 256 * g.ldb + (size_t)(u).kind * g.koff) * 2)
    Unit cur, nxt; int ui = 0;
    if (!S.next(0, cur)) return;
    { const int nbig = S.nwg % S.G;
      if (nbig > 0 && S.c >= nbig && g.stagger) { const int ngrp = S.G / nbig, j = S.c / nbig; const unsigned long long dl = (unsigned long long)((g.K / BK) * 140 + 100) * S.nk * j / ngrp;
          const unsigned long long t0 = __builtin_amdgcn_s_memrealtime(); while (__builtin_amdgcn_s_memrealtime() - t0 < dl) __builtin_amdgcn_s_sleep(32); } }
    f32x4 acc[2][2][4][2];
#pragma unroll
    for (int a = 0; a < 2; ++a)
#pragma unroll
        for (int b = 0; b < 2; ++b)
#pragma unroll
            for (int m = 0; m < 4; ++m)
#pragma unroll
                for (int n = 0; n < 2; ++n) acc[a][b][m][n] = (f32x4){0.f, 0.f, 0.f, 0.f};
    h16x8 At[4][2], B0[2][2], B1[2][2];
    const char* cA = PG8_PA(cur); const char* cB = PG8_PB(cur);
    E.prefetch(cur, wid, lane);
    PG8_STAGE(PG8_SB(0, 0), cB, voffB); PG8_STAGE(PG8_SB(0, 1), cB + hstepB, voffB); PG8_STAGE(PG8_SA(0, 0), cA, voffA); PG8_STAGE(PG8_SA(0, 1), cA + hstepA, voffA);
    if (wr == 1) PG8_BAR;
    PG8_WAIT_V(2); PG8_BAR;
    PG8_STAGE(PG8_SB(1, 0), cB + kstep, voffB); PG8_STAGE(PG8_SA(1, 0), cA + kstep, voffA); PG8_STAGE(PG8_SB(1, 1), cB + hstepB + kstep, voffB);
    PG8_WAIT_V(6); PG8_BAR;
    for (;;) {
        const bool has_next = S.next(ui + 1, nxt);
        const char* nA = has_next ? PG8_PA(nxt) : cA; const char* nB = has_next ? PG8_PB(nxt) : cB;
        for (int t = 0; t < nt; t += 2) {
            const bool last = (t == nt - 2);
            const char* a1 = cA + (size_t)(t + 1) * kstep;
            const char* a2 = last ? nA : cA + (size_t)(t + 2) * kstep; const char* b2 = last ? nB : cB + (size_t)(t + 2) * kstep;
            const char* a3 = a2 + kstep; const char* b3 = b2 + kstep;
            PG8_LDB(B0, 0, 0); PG8_LDB(B1, 0, 1); PG8_SCHED; PG8_LDA(At, 0, 0); PG8_STAGE(PG8_SA(1, 1), a1 + hstepA, voffA);
            PG8_WAIT_V(8); PG8_WAIT_L(0); PG8_BAR; PG8_MMA(0, 0, At, B0); PG8_MMA(0, 1, At, B1); PG8_BAR; PG8_SCHED;
            PG8_LDA(At, 0, 1); PG8_STAGE(PG8_SB(0, 0), b2, voffB); PG8_STAGE(PG8_SB(0, 1), b2 + hstepB, voffB); PG8_STAGE(PG8_SA(0, 0), a2, voffA);
            PG8_WAIT_V(8); PG8_WAIT_L(0); PG8_BAR; PG8_MMA(1, 0, At, B0); PG8_MMA(1, 1, At, B1); PG8_BAR; PG8_SCHED;
            PG8_LDB(B0, 1, 0); PG8_LDB(B1, 1, 1); PG8_SCHED; PG8_LDA(At, 1, 0); PG8_STAGE(PG8_SA(0, 1), a2 + hstepA, voffA);
            PG8_WAIT_V(8); PG8_WAIT_L(0); PG8_BAR; PG8_MMA(0, 0, At, B0); PG8_MMA(0, 1, At, B1); PG8_BAR; PG8_SCHED;
            PG8_LDA(At, 1, 1); PG8_STAGE(PG8_SB(1, 0), b3, voffB); PG8_STAGE(PG8_SB(1, 1), b3 + hstepB, voffB); PG8_STAGE(PG8_SA(1, 0), a3, voffA);
            PG8_WAIT_V(8); PG8_WAIT_L(0); PG8_BAR; PG8_MMA(1, 0, At, B0); PG8_MMA(1, 1, At, B1); PG8_BAR; PG8_SCHED;
        }
        if (wr == 0) PG8_BAR;
        { int fr_ = fr, fq_ = fq; asm volatile("" : "+v"(fr_), "+v"(fq_)); if (!g.noepi) E(acc, cur, wr, wc, fr_, fq_); }
        if (!has_next) break;
        if (nxt.kind == 0) {
#pragma unroll
            for (int a = 0; a < 2; ++a)
#pragma unroll
                for (int b = 0; b < 2; ++b)
#pragma unroll
                    for (int m = 0; m < 4; ++m)
#pragma unroll
                        for (int n = 0; n < 2; ++n) acc[a][b][m][n] = (f32x4){0.f, 0.f, 0.f, 0.f};
        }
        cur = nxt; cA = nA; cB = nB; ++ui;
        if (cur.kind == 0) E.prefetch(cur, wid, lane);
        if (wr == 1) PG8_BAR;
    }
    PG8_WAIT_V(0);
    PG8_BAR;
#undef PG8_SA
#undef PG8_SB
#undef PG8_STAGE
#undef PG8_LDA
#undef PG8_LDB
#undef PG8_MMA
#undef PG8_WAIT_V
#undef PG8_WAIT_L
#undef PG8_BAR
#undef PG8_SCHED
#undef PG8_PA
#undef PG8_PB
}
}
constexpr int NWAVES = 8, NTHREADS = 512;
constexpr int NB = 8, SEQ = 2048, DM = 1024, M = NB * SEQ, DIN = 4312, DFF = 2816, NLAYER = 2;
constexpr int NZ = 4352;
constexpr int NGU = 2 * DFF;
constexpr float EPS_RMS = 1e-6f;
constexpr float LOG2E = 1.4426950408889634f;
constexpr float QSCALE = 0.125f * LOG2E;
constexpr int KVP = 152;

constexpr size_t MiB = 1u << 20;
constexpr size_t WS_CTL = 0, CTL_ZERO_BYTES = 65536;
constexpr size_t WS_CS = 1 * MiB;
constexpr size_t WS_SSQ = 2 * MiB;
constexpr size_t WS_WI = 3 * MiB;
constexpr size_t WS_SMALLW = 4 * MiB;
constexpr size_t SMALLW_LAYER = 98304 + 131072 + 262144;
constexpr size_t WS_W = 6 * MiB;
constexpr size_t W_LAYER = 29 * MiB, W_OFF_IN = 0, W_OFF_PAB = (size_t)NZ * 1024 * 2, W_OFF_OUT = W_OFF_PAB + 2 * MiB, W_OFF_GU = W_OFF_OUT + 2 * MiB, W_OFF_D = W_OFF_GU + (size_t)NGU * 1024 * 2;
static_assert(W_OFF_D + (size_t)1024 * DFF * 2 == W_LAYER, "weight map");
constexpr size_t WS_X16 = 64 * MiB;
constexpr size_t WS_QY = 96 * MiB;
constexpr size_t WS_QI = 128 * MiB;
constexpr size_t WS_MISC = 144 * MiB;
constexpr size_t WS_KV = 152 * MiB;
constexpr size_t WS_KI = 157 * MiB;
constexpr size_t WS_X1 = 128 * MiB;
constexpr size_t WS_GATES = 160 * MiB;
constexpr size_t WS_UV = 224 * MiB;
constexpr size_t WS_ACT = 160 * MiB;
constexpr size_t WS_END = 256 * MiB;
static_assert(WS_KV + (size_t)M * KVP * 2 <= WS_KI && WS_KI + (size_t)M * 64 * 2 <= WS_GATES && WS_ACT + (size_t)M * DFF * 2 <= WS_END, "ws map");

constexpr int LDS_BYTES = 155648;
constexpr int LDS_MISC = 151552;

#define RLX_AGENT __ATOMIC_RELAXED, __HIP_MEMORY_SCOPE_AGENT
#define LDS_WAIT() asm volatile("s_waitcnt lgkmcnt(0)" ::: "memory")
#define VM_WAIT() asm volatile("s_waitcnt vmcnt(0)" ::: "memory")

#define XB_TMO      128
#define XB_XCNT(j)  (256  + 64 * (j))
#define XB_XSUB(j)  (1280 + 64 * (j))
#define XB_XGEN(j)  (2304 + 64 * (j))
#define XB_TOP      3328
#define XB_TOPGEN   3392
#define XCD_BAR_WORDS 3456
#define XB_SPIN_CAP (1u << 18)
__device__ __forceinline__ unsigned xb_ld(unsigned* p)              { return __hip_atomic_load(p, __ATOMIC_RELAXED, __HIP_MEMORY_SCOPE_AGENT); }
__device__ __forceinline__ unsigned xb_add(unsigned* p, unsigned v) { return __hip_atomic_fetch_add(p, v, __ATOMIC_RELAXED, __HIP_MEMORY_SCOPE_AGENT); }
__device__ __forceinline__ unsigned xb_xcc_id() { return (unsigned)__builtin_amdgcn_s_getreg((3 << 11) | 20) & 0xFu; }
#define XB_SPIN(cond, bar) do { unsigned _sp = 0; while (cond) { __builtin_amdgcn_s_sleep(1); \
    if ((++_sp & 255u) == 0u) { if (xb_ld(&(bar)[XB_TMO])) break; if (_sp > XB_SPIN_CAP) { atomicAdd(&(bar)[XB_TMO], 1u); break; } } } } while (0)
struct XcdBarrier { unsigned* bar; unsigned x; volatile LAS unsigned* st; };
__device__ __forceinline__ XcdBarrier xcd_barrier_post(unsigned* bar, volatile LAS unsigned* st, int wave_) {
    XcdBarrier b; b.bar = bar; b.x = xb_xcc_id(); b.st = st;
    if (wave_ == 0 && lane_id() == 0) (void)xb_add(&bar[XB_XCNT(b.x)], 1u);
    return b;
}
__device__ __forceinline__ void xcd_barrier_complete(unsigned* bar, unsigned x, unsigned& nloc, unsigned& nx) {
    const unsigned G = gridDim.x * gridDim.y * gridDim.z;
    unsigned sum, cnt, mine, sp = 0u;
    for (;;) {
        sum = 0u; cnt = 0u; mine = 0u;
#pragma unroll
        for (unsigned j = 0; j < 16; ++j) { const unsigned c = xb_ld(&bar[XB_XCNT(j)]); sum += c; cnt += (c > 0u) ? 1u : 0u; }
        mine = xb_ld(&bar[XB_XCNT(x)]);
        if (sum == G) break;
        __builtin_amdgcn_s_sleep(1);
        if ((++sp & 255u) == 0u) { if (xb_ld(&bar[XB_TMO])) break; if (sp > XB_SPIN_CAP) { atomicAdd(&bar[XB_TMO], 1u); break; } }
    }
    nloc = mine > 0u ? mine : 1u; nx = cnt > 0u ? cnt : 1u;
}
__device__ __forceinline__ void xcd_barrier(const XcdBarrier& b, int wave_) {
    asm volatile("s_waitcnt vmcnt(0)" ::: "memory");
    __syncthreads();
    if (wave_ == 0 && lane_id() == 0) {
        unsigned* bar = b.bar; asm volatile("" : "+s"(bar));
        unsigned stoff = (unsigned)(uintptr_t)b.st; asm volatile("" : "+s"(stoff)); volatile LAS unsigned* st = (volatile LAS unsigned*)(uintptr_t)stoff;
        const unsigned x = xb_xcc_id();
        __builtin_amdgcn_s_waitcnt(0);
        unsigned nloc = st[0], nx = st[1];
        if (nloc == 0u) { xcd_barrier_complete(bar, x, nloc, nx); st[0] = nloc; st[1] = nx; }
        const unsigned old = xb_add(&bar[XB_XSUB(x)], 1u);
        const unsigned gen = old / nloc;
        if (old + 1u == (gen + 1u) * nloc) {
            __builtin_amdgcn_fence(__ATOMIC_RELEASE, "agent");
            asm volatile("s_waitcnt vmcnt(0)" ::: "memory");
            (void)xb_add(&bar[XB_TOP], 1u);
        }
        const unsigned target = (gen + 1u) * nx;
        XB_SPIN(xb_ld(&bar[XB_TOP]) < target, bar);
        __builtin_amdgcn_fence(__ATOMIC_ACQUIRE, "agent");
        asm volatile("s_waitcnt vmcnt(0)" ::: "memory");
    }
    __syncthreads();
}

__device__ __forceinline__ float gelu_tanh_f(float x) {
    const float u = 0.7978845608028654f * (x + 0.044715f * x * x * x);
    const float e = __builtin_amdgcn_exp2f(-2.0f * LOG2E * u);
    return x * __builtin_amdgcn_rcpf(1.0f + e);
}
__device__ __forceinline__ float sigmoid_f(float x) { return __builtin_amdgcn_rcpf(1.0f + __builtin_amdgcn_exp2f(-LOG2E * x)); }

struct Frame {
    LAS unsigned char* lds;
    int wave, vcu, G;
    unsigned char* ws;
    const float* const* in;
};
struct In {
    const float* x; const int* pos; const float* norm_mix; const float* w_in; const float* kv_norm; const float* w_uk; const float* w_uv; const float* ln_v_g; const float* ln_v_b;
    const float* w_s; const float* b_s; const float* w_proj_a; const float* w_proj_b; const float* w_out; const float* norm_ffn; const float* w_gate; const float* w_up; const float* w_down; const float* final_norm;
};

__device__ __constant__ float c_inv[8] = {1.0f, 0.19392274474868576f, 0.03760603093086393f, 0.007292664737217109f, 0.001414213562373095f, 0.0002742481756762073f, 5.318295896944988e-05f, 1.031338537721246e-05f};

__device__ __forceinline__ void transpose_item64(const float* W4, int Nsrc, h16* WT, int ldt, int n0, int k0, const float* gain, LAS float* scr, int lane) {
    const int nq = lane & 15, kq = lane >> 4;
    f32x4 v[16];
#pragma unroll
    for (int i = 0; i < 16; ++i) v[i] = W4 ? *(const GAS f32x4*)(W4 + (size_t)(k0 + 4 * i + kq) * Nsrc) : (f32x4){0.f, 0.f, 0.f, 0.f};
#pragma unroll
    for (int i = 0; i < 16; ++i) { const int kk = 4 * i + kq; f32x4 x = v[i]; if (gain) x = x * gain[k0 + kk]; *(LAS f32x4*)(scr + kk * 68 + 4 * (nq ^ (kk >> 3))) = x; }
    LDS_WAIT(); asm volatile("" ::: "memory");
    const int c = lane & 7;
#pragma unroll
    for (int j = 0; j < 8; ++j) { const int n = (lane >> 3) + 8 * j; const LAS float* sp = scr + (8 * c) * 68 + 4 * ((n >> 2) ^ c) + (n & 3);
        u32x4 o; o.x = pkh(sp[0 * 68], sp[1 * 68]); o.y = pkh(sp[2 * 68], sp[3 * 68]); o.z = pkh(sp[4 * 68], sp[5 * 68]); o.w = pkh(sp[6 * 68], sp[7 * 68]);
        *(GAS u32x4*)(WT + (size_t)(n0 + n) * ldt + k0 + 8 * c) = o; }
    LDS_WAIT(); asm volatile("" ::: "memory");
}
__device__ __forceinline__ int win_src_col(int n) {
    if (n < 512) return n;
    if (n < 1024) return 656 + (n - 512);
    if (n < 2048) return 1240 + (n - 1024);
    if (n < 4096) return 2264 + (n - 2048);
    if (n < 4224) return 512 + (n - 4096);
    if (n < 4240) return 640 + (n - 4224);
    if (n < 4304) return 1168 + (n - 4240);
    if (n < 4312) return 1232 + (n - 4304);
    return -1;
}
constexpr int CONV_IN_ITEMS = (NZ / 64) * 16;
__device__ __forceinline__ void convert_layer_weights(const Frame& F, const In& I, int l, int gw, int NGW, int it_lo = 0, int it_hi = 1 << 30) {
    LAS float* scr = (LAS float*)(F.lds + F.wave * 17408);
    int lane = lane_id(); asm volatile("" : "+v"(lane));
    constexpr int I_IN = (NZ / 64) * 16, I_PA = 16 * 8, I_OUT = 16 * 16, I_GU = (NGU / 64) * 16, I_D = 16 * (DFF / 64);
    constexpr int I_LAYER = I_IN + 2 * I_PA + I_OUT + I_GU + I_D;
    const int n4 = 4 * (lane & 15);
    unsigned char* wl = F.ws + WS_W + (size_t)l * W_LAYER;
    if (it_hi > I_LAYER) it_hi = I_LAYER;
    for (int it = it_lo + gw; it < it_hi; it += NGW) {
        int r = it;
        if (r < I_IN) { const int nb = r / 16, kb = r % 16, sc = win_src_col(nb * 64 + n4);
            transpose_item64(sc >= 0 ? I.w_in + (size_t)l * DM * DIN + sc : nullptr, DIN, (h16*)(wl + W_OFF_IN), 1024, nb * 64, kb * 64, I.norm_mix + l * DM, scr, lane); continue; }
        r -= I_IN;
        if (r < I_PA) { const int nb = r / 8, kb = r % 8;
            transpose_item64(I.w_proj_a + (size_t)l * 512 * 1024 + nb * 64 + n4, 1024, (h16*)(wl + W_OFF_PAB), 1024, nb * 64, kb * 64, nullptr, scr, lane); continue; }
        r -= I_PA;
        if (r < I_PA) { const int nb = r / 8, kb = r % 8;
            transpose_item64(I.w_proj_b + (size_t)l * 512 * 1024 + nb * 64 + n4, 1024, (h16*)(wl + W_OFF_PAB) + 512, 1024, nb * 64, kb * 64, nullptr, scr, lane); continue; }
        r -= I_PA;
        if (r < I_OUT) { const int nb = r / 16, kb = r % 16;
            transpose_item64(I.w_out + (size_t)l * 1024 * 1024 + nb * 64 + n4, 1024, (h16*)(wl + W_OFF_OUT), 1024, nb * 64, kb * 64, nullptr, scr, lane); continue; }
        r -= I_OUT;
        if (r < I_GU) { const int nb = r / 16, kb = r % 16, R = nb * 64 + n4, pn = R >> 8, rem = R & 255;
            const int a = 128 * pn + 64 * (rem >> 7) + 16 * ((rem >> 5) & 3) + 4 * ((rem >> 3) & 3);
            const float* src = (((rem >> 2) & 1) ? I.w_up : I.w_gate) + (size_t)l * DM * DFF + a;
            transpose_item64(src, DFF, (h16*)(wl + W_OFF_GU), 1024, nb * 64, kb * 64, I.norm_ffn + l * DM, scr, lane); continue; }
        r -= I_GU;
        { const int nb = r / (DFF / 64), kb = r % (DFF / 64);
            transpose_item64(I.w_down + (size_t)l * DFF * 1024 + nb * 64 + n4, 1024, (h16*)(wl + W_OFF_D), DFF, nb * 64, kb * 64, nullptr, scr, lane); }
    }
}
__device__ __forceinline__ void p0_prologue(const Frame& F, const In& I) {
    int lane = lane_id(); asm volatile("" : "+v"(lane));
    const int hw = F.wave & 3, gw = F.vcu * 4 + hw, NGW = F.G * 4;
    if (F.wave >= 4) {
    convert_layer_weights(F, I, 0, gw, NGW, 0, CONV_IN_ITEMS);
    const int gt = F.vcu * 256 + hw * 64 + lane, NGT = F.G * 256;
    for (int i0 = gt; i0 < NLAYER * 49152; i0 += 2 * NGT) { float va[2], vg[2];
#pragma unroll
        for (int u = 0; u < 2; ++u) { const int i = i0 + u * NGT; if (i < NLAYER * 49152) { const int l = i / 49152, e = i % 49152, h = e / (128 * 48), c = (e / 48) % 128, n = e % 48;
            va[u] = I.w_uk[(((size_t)l * 8 + h) * 48 + n) * 128 + c]; vg[u] = I.kv_norm[l * 128 + c]; } }
#pragma unroll
        for (int u = 0; u < 2; ++u) { const int i = i0 + u * NGT; if (i < NLAYER * 49152) { const int l = i / 49152, e = i % 49152;
            ((h16*)(F.ws + WS_SMALLW + (size_t)l * SMALLW_LAYER))[e] = (h16)(va[u] * vg[u]); } } }
    for (int i0 = gt; i0 < NLAYER * 65536; i0 += 2 * NGT) { float va[2], vg[2];
#pragma unroll
        for (int u = 0; u < 2; ++u) { const int i = i0 + u * NGT; if (i < NLAYER * 65536) { const int l = i / 65536, e = i % 65536, h = e / (64 * 128), d = (e / 128) % 64, c = e % 128;
            va[u] = I.w_uv[(((size_t)l * 8 + h) * 128 + c) * 64 + d]; vg[u] = I.kv_norm[l * 128 + c]; } }
#pragma unroll
        for (int u = 0; u < 2; ++u) { const int i = i0 + u * NGT; if (i < NLAYER * 65536) { const int l = i / 65536, e = i % 65536;
            ((h16*)(F.ws + WS_SMALLW + (size_t)l * SMALLW_LAYER + 98304))[e] = (h16)(va[u] * vg[u]); } } }
    for (int i0 = gt; i0 < NLAYER * 131072; i0 += 4 * NGT) { float va[4];
#pragma unroll
        for (int u = 0; u < 4; ++u) { const int i = i0 + u * NGT; if (i < NLAYER * 131072) va[u] = I.w_s[i]; }
#pragma unroll
        for (int u = 0; u < 4; ++u) { const int i = i0 + u * NGT; if (i < NLAYER * 131072) { const int l = i / 131072, e = i % 131072, t = (e / 128) % 128, sx = e % 128;
            ((h16*)(F.ws + WS_SMALLW + (size_t)l * SMALLW_LAYER + 98304 + 131072))[e] = (sx <= t) ? (h16)va[u] : (h16)0.f; } } }
    for (int i0 = gt; i0 < M * 8; i0 += 2 * NGT) { int pv[2];
#pragma unroll
        for (int u = 0; u < 2; ++u) { const int i = i0 + u * NGT; if (i < M * 8) pv[u] = I.pos[i >> 3]; }
#pragma unroll
        for (int u = 0; u < 2; ++u) { const int i = i0 + u * NGT; if (i < M * 8) { const int tok = i >> 3, f = i & 7; const float ang = (float)pv[u] * c_inv[f];
            float* cs = (float*)(F.ws + WS_CS) + (size_t)tok * 16; cs[f] = cosf(ang); cs[8 + f] = sinf(ang); } } }
    } else {
    for (int m = gw; m < M; m += 4 * NGW) {
        f32x4 v[4][4];
#pragma unroll
        for (int k = 0; k < 4; ++k) { const int mm = m + k * NGW; if (mm < M) { const f32x4* xr = (const f32x4*)(I.x + (size_t)mm * DM) + lane;
#pragma unroll
            for (int j = 0; j < 4; ++j) v[k][j] = xr[64 * j]; } }
#pragma unroll
        for (int k = 0; k < 4; ++k) { const int mm = m + k * NGW; if (mm < M) { u32x2* o8 = (u32x2*)((h16*)(F.ws + WS_X16) + (size_t)mm * DM) + lane; float s = 0.f;
#pragma unroll
            for (int j = 0; j < 4; ++j) { const f32x4 t = v[k][j]; s += (t.x * t.x + t.y * t.y) + (t.z * t.z + t.w * t.w); o8[64 * j] = (u32x2){pkh(t.x, t.y), pkh(t.z, t.w)}; }
            s += __shfl_xor(s, 1); s += __shfl_xor(s, 2); s += __shfl_xor(s, 4); s += __shfl_xor(s, 8);
            if ((lane & 15) == 0) ((GAS float*)(F.ws + WS_SSQ))[(size_t)mm * 4 + (lane >> 4)] = s; } }
    }
    }
}

__device__ __forceinline__ float row_rstd(const float* ssq, int row) {
    const f32x4 a = *(const GAS f32x4*)(ssq + (size_t)row * 4);
    return rsqrtf(((a.x + a.y) + (a.z + a.w)) * (1.0f / DM) + EPS_RMS);
}

typedef f32x4 Acc[2][2][4][2];
__device__ __forceinline__ u32x4 pack8h(const float (&v)[8]) { u32x4 w; w.x = pkz(v[0], v[1]); w.y = pkz(v[2], v[3]); w.z = pkz(v[4], v[5]); w.w = pkz(v[6], v[7]); return w; }
__device__ __forceinline__ u32x4 pack8r(const float (&v)[8]) { u32x4 w; w.x = pkh(v[0], v[1]); w.y = pkh(v[2], v[3]); w.z = pkh(v[4], v[5]); w.w = pkh(v[6], v[7]); return w; }

__device__ __forceinline__ void ssq_prefetch(const float* ssq, int pm, LAS float* R4, int wid, int lane) {
    if (wid < 4) __builtin_amdgcn_global_load_lds((const unsigned*)(ssq + (size_t)(pm * 256 + wid * 64 + lane) * 4), (LAS unsigned*)(R4 + wid * 256), 16, 0, 0);
}
__device__ __forceinline__ float rstd_from_lds(const LAS float* R4, int rl) { const f32x4 a = *(const LAS f32x4*)(R4 + rl * 4); return rsqrtf(((a.x + a.y) + (a.z + a.w)) * (1.0f / DM) + EPS_RMS); }
struct EpiA {
    static constexpr bool PERM = true;
    unsigned char* ws; int nostore; LAS float* R;
    __device__ __forceinline__ void prefetch(const pg8::Unit& u, int wid, int lane) const { ssq_prefetch((const float*)(ws + WS_SSQ), u.pm, R, wid, lane); }
    __device__ __forceinline__ void misc_tile(Acc& acc, const pg8::Unit& u, int wr, int wc, int fr, int fq) const {
        const unsigned row0 = (unsigned)(u.pm * 256 + wr * 64 + fr); LAS float* P = R - 1024;
        GAS unsigned char* wsg = (GAS unsigned char*)ws;
#pragma unroll
        for (int ai = 0; ai < 2; ++ai)
#pragma unroll
            for (int m = 0; m < 4; ++m) { const int rl = ai * 128 + wr * 64 + m * 16 + fr; const float rs = rstd_from_lds(R, rl); float ss = 0.f;
#pragma unroll
                for (int bj = 0; bj < 2; ++bj) { acc[ai][bj][m][0] *= rs; acc[ai][bj][m][1] *= rs; }
#pragma unroll
                for (int i = 0; i < 8; ++i) { const float z = acc[ai][0][m][i >> 2][i & 3]; ss = fmaf(z, z, ss); }
                ss += __shfl_xor(ss, 16); ss += __shfl_xor(ss, 32);
                if (fq == 0) P[rl * 4 + wc] = ss; }
        asm volatile("s_waitcnt lgkmcnt(0)" ::: "memory"); __builtin_amdgcn_s_barrier(); asm volatile("" ::: "memory");
#pragma unroll
        for (int ai = 0; ai < 2; ++ai)
#pragma unroll
            for (int m = 0; m < 4; ++m) { const int rl = ai * 128 + wr * 64 + m * 16 + fr; const unsigned row = row0 + (unsigned)(ai * 128 + m * 16);
                const f32x4 pv = *(const LAS f32x4*)(P + rl * 4); const float rk = rsqrtf(((pv.x + pv.y) + (pv.z + pv.w)) * (1.0f / 128.f) + EPS_RMS);
                { float o[8];
#pragma unroll
                  for (int i = 0; i < 8; ++i) o[i] = acc[ai][0][m][i >> 2][i & 3] * rk;
                  *(GAS u32x4*)(wsg + ((unsigned)WS_KV + row * (unsigned)(KVP * 2) + (unsigned)(wc * 64 + 16 * fq))) = pack8r(o); }
                if (wc == 0) {
                    const unsigned co = (unsigned)WS_CS + row * 64u;
                    const f32x4 c0 = *(const GAS f32x4*)(wsg + co), c1 = *(const GAS f32x4*)(wsg + co + 16u), s0 = *(const GAS f32x4*)(wsg + co + 32u), s1 = *(const GAS f32x4*)(wsg + co + 48u);
                    float o[8];
#pragma unroll
                    for (int i = 0; i < 8; ++i) { const float own = acc[ai][1][m][i >> 2][i & 3], oth = __shfl_xor(own, 16); const float c = i < 4 ? c0[i & 3] : c1[i & 3], sn = i < 4 ? s0[i & 3] : s1[i & 3];
                        o[i] = (fq & 1) ? (own * c + oth * sn) : (own * c - oth * sn); }
                    const unsigned dst = fq < 2 ? (unsigned)WS_KV + row * (unsigned)(KVP * 2) + 256u + 16u * (unsigned)fq : (unsigned)WS_KI + row * 128u + 16u * (unsigned)(fq - 2);
                    *(GAS u32x4*)(wsg + dst) = pack8r(o);
                } else if (wc == 1) {
                    float o[8];
#pragma unroll
                    for (int i = 0; i < 8; ++i) o[i] = acc[ai][1][m][i >> 2][i & 3];
                    *(GAS u32x4*)(wsg + ((unsigned)WS_KI + row * 128u + 32u + 16u * (unsigned)fq)) = pack8r(o);
                } else if (wc == 2) {
                    if (fq < 2) { float o[8];
#pragma unroll
                        for (int i = 0; i < 8; ++i) o[i] = acc[ai][1][m][i >> 2][i & 3];
                        *(GAS u32x4*)(wsg + ((unsigned)WS_KI + row * 128u + 96u + 16u * (unsigned)fq)) = pack8r(o); }
                    else if (fq == 2) { const float sc = 0.35355339059327373f * 0.125f; const unsigned wo = (unsigned)WS_WI + row * 32u;
                        *(GAS f32x4*)(wsg + wo) = acc[ai][1][m][0] * sc; *(GAS f32x4*)(wsg + wo + 16u) = acc[ai][1][m][1] * sc; }
                    else { u32x4 z4 = {0u, 0u, 0u, 0u}; asm volatile("" : "+v"(z4)); *(GAS u32x4*)(wsg + ((unsigned)WS_KV + row * (unsigned)(KVP * 2) + 288u)) = z4; }
                } }
        asm volatile("s_waitcnt lgkmcnt(0)" ::: "memory"); __builtin_amdgcn_s_barrier(); asm volatile("" ::: "memory");
    }
    __device__ __forceinline__ void operator()(Acc& acc, const pg8::Unit& u, int wr, int wc, int fr, int fq) const {
        const int pn = u.pn; h16* base; int ldc, colt;
        if (pn == 16) { misc_tile(acc, u, wr, wc, fr, fq); return; }
        if (pn < 2) { base = (h16*)(ws + WS_QY); ldc = 1024; colt = pn * 256; }
        else if (pn < 4) { base = (h16*)(ws + WS_QI); ldc = 512; colt = (pn - 2) * 256; }
        else if (pn < 8) { base = (h16*)(ws + WS_UV); ldc = 1024; colt = (pn - 4) * 256; }
        else { base = (h16*)(ws + WS_GATES); ldc = 2048; colt = (pn - 8) * 256; }
        const int row0 = u.pm * 256 + wr * 64 + fr, col0 = colt + wc * 32 + 8 * fq;
#pragma unroll
        for (int ai = 0; ai < 2; ++ai)
#pragma unroll
            for (int m = 0; m < 4; ++m) { const int row = row0 + ai * 128 + m * 16; const float rs = rstd_from_lds(R, ai * 128 + wr * 64 + m * 16 + fr); h16* rowp = base + (size_t)row * ldc + col0;
#pragma unroll
                for (int bj = 0; bj < 2; ++bj) { f32x4 v0 = acc[ai][bj][m][0] * rs, v1 = acc[ai][bj][m][1] * rs;
                    u32x4 w; w.x = pkz(v0[0], v0[1]); w.y = pkz(v0[2], v0[3]); w.z = pkz(v1[0], v1[1]); w.w = pkz(v1[2], v1[3]);
                    if (!nostore) *(GAS u32x4*)(rowp + bj * 128) = w; else asm volatile("" :: "v"(w)); } }
        asm volatile("s_waitcnt lgkmcnt(0)" ::: "memory"); __builtin_amdgcn_s_barrier(); asm volatile("" ::: "memory");
    }
};

struct EpiD {
    static constexpr bool PERM = true;
    unsigned char* ws; h16* mg;
    __device__ __forceinline__ void prefetch(const pg8::Unit&, int, int) const {}
    __device__ __forceinline__ void operator()(Acc& acc, const pg8::Unit& u, int wr, int wc, int fr, int fq) const {
        const int row0 = u.pm * 256 + wr * 64 + fr, col0 = u.pn * 256 + wc * 32 + 8 * fq;
        const h16* gates = (const h16*)(ws + WS_GATES);
#pragma unroll
        for (int ai = 0; ai < 2; ++ai) {
            h16x8 gbv[4][2], gav[4][2];
#pragma unroll
            for (int m = 0; m < 4; ++m)
#pragma unroll
                for (int bj = 0; bj < 2; ++bj) { const size_t off = (size_t)(row0 + ai * 128 + m * 16) * 2048 + col0 + bj * 128;
                    gbv[m][bj] = *(const GAS h16x8*)(gates + off + 1024); if (u.kind == 0) gav[m][bj] = *(const GAS h16x8*)(gates + off); }
#pragma unroll
            for (int m = 0; m < 4; ++m) { const int row = row0 + ai * 128 + m * 16;
#pragma unroll
                for (int bj = 0; bj < 2; ++bj) { const int col = col0 + bj * 128; const h16x8 gb = gbv[m][bj];
                    if (u.kind == 0) { const h16x8 ga = gav[m][bj];
#pragma unroll
                        for (int i = 0; i < 8; ++i) { const float ea = __builtin_amdgcn_exp2f(fminf(-LOG2E * (float)ga[i], 64.f)), eb = __builtin_amdgcn_exp2f(fminf(-LOG2E * (float)gb[i], 64.f));
                            acc[ai][bj][m][i >> 2][i & 3] *= (1.0f + eb) * __builtin_amdgcn_rcpf(1.0f + ea); }
                    } else { float v[8];
#pragma unroll
                        for (int i = 0; i < 8; ++i) { const float eb = __builtin_amdgcn_exp2f(fminf(-LOG2E * (float)gb[i], 64.f)); v[i] = acc[ai][bj][m][i >> 2][i & 3] * __builtin_amdgcn_rcpf(1.0f + eb); }
                        u32x4 w; w.x = pkz(v[0], v[1]); w.y = pkz(v[2], v[3]); w.z = pkz(v[4], v[5]); w.w = pkz(v[6], v[7]);
                        *(GAS u32x4*)(mg + (size_t)row * 1024 + col) = w; } } }
            asm volatile("" ::: "memory"); }
    }
};

struct EpiRes {
    static constexpr bool PERM = true;
    const h16* resid; h16* xo; float* ssq; LAS float* P;
    __device__ __forceinline__ void prefetch(const pg8::Unit&, int, int) const {}
    __device__ __forceinline__ void operator()(Acc& acc, const pg8::Unit& u, int wr, int wc, int fr, int fq) const {
        const int row0 = u.pm * 256 + wr * 64 + fr, col0 = u.pn * 256 + wc * 32 + 8 * fq;
        h16x8 rvv[2][4][2];
#pragma unroll
        for (int ai = 0; ai < 2; ++ai)
#pragma unroll
            for (int m = 0; m < 4; ++m)
#pragma unroll
                for (int bj = 0; bj < 2; ++bj) rvv[ai][m][bj] = *(const GAS h16x8*)(resid + (size_t)(row0 + ai * 128 + m * 16) * 1024 + col0 + bj * 128);
#pragma unroll
        for (int ai = 0; ai < 2; ++ai)
#pragma unroll
            for (int m = 0; m < 4; ++m) { const int row = row0 + ai * 128 + m * 16; float ss = 0.f;
#pragma unroll
                for (int bj = 0; bj < 2; ++bj) { const size_t off = (size_t)row * 1024 + col0 + bj * 128;
                    const h16x8 rv = rvv[ai][m][bj]; float v[8];
#pragma unroll
                    for (int i = 0; i < 8; ++i) { v[i] = (float)rv[i] + acc[ai][bj][m][i >> 2][i & 3]; ss = fmaf(v[i], v[i], ss); }
                    *(GAS u32x4*)(xo + off) = pack8h(v); }
                ss += __shfl_xor(ss, 16); ss += __shfl_xor(ss, 32);
                if (fq == 0) P[(ai * 128 + wr * 64 + m * 16 + fr) * 4 + wc] = ss; }
        asm volatile("s_waitcnt lgkmcnt(0)" ::: "memory"); __builtin_amdgcn_s_barrier(); asm volatile("" ::: "memory");
        { const int t = (wr * 4 + wc) * 64 + fq * 16 + fr; if (t < 256) { const f32x4 v = *(const LAS f32x4*)(P + t * 4); ((GAS float*)ssq)[(size_t)(u.pm * 256 + t) * 4 + u.pn] = (v.x + v.y) + (v.z + v.w); } }
        asm volatile("s_waitcnt lgkmcnt(0)" ::: "memory"); __builtin_amdgcn_s_barrier(); asm volatile("" ::: "memory");
    }
};

struct EpiFinal {
    static constexpr bool PERM = true;
    const h16* resid; float* out; const float* gfin; float* ssq; unsigned* cnt; LAS float* P;
    __device__ __forceinline__ void prefetch(const pg8::Unit&, int, int) const {}
    __device__ __forceinline__ void operator()(Acc& acc, const pg8::Unit& u, int wr, int wc, int fr, int fq) const {
        const int row0 = u.pm * 256 + wr * 64 + fr, col0 = u.pn * 256 + wc * 32 + 8 * fq;
        LAS float* S = P + 1024;
        { h16x8 rvv[2][4][2];
#pragma unroll
          for (int ai = 0; ai < 2; ++ai)
#pragma unroll
              for (int m = 0; m < 4; ++m)
#pragma unroll
                  for (int bj = 0; bj < 2; ++bj) rvv[ai][m][bj] = *(const GAS h16x8*)(resid + (size_t)(row0 + ai * 128 + m * 16) * 1024 + col0 + bj * 128);
#pragma unroll
          for (int ai = 0; ai < 2; ++ai)
#pragma unroll
              for (int m = 0; m < 4; ++m) { float ss = 0.f;
#pragma unroll
                  for (int bj = 0; bj < 2; ++bj) { const h16x8 rv = rvv[ai][m][bj];
#pragma unroll
                      for (int i = 0; i < 8; ++i) { const float v = (float)rv[i] + acc[ai][bj][m][i >> 2][i & 3]; acc[ai][bj][m][i >> 2][i & 3] = v; ss = fmaf(v, v, ss); } }
                  ss += __shfl_xor(ss, 16); ss += __shfl_xor(ss, 32);
                  if (fq == 0) P[(ai * 128 + wr * 64 + m * 16 + fr) * 4 + wc] = ss; } }
        asm volatile("s_waitcnt lgkmcnt(0)" ::: "memory"); __builtin_amdgcn_s_barrier(); asm volatile("" ::: "memory");
        const int t = (wr * 4 + wc) * 64 + fq * 16 + fr, wid = wr * 4 + wc;
        if (t < 256) { const f32x4 v = *(const LAS f32x4*)(P + t * 4);
            __hip_atomic_store((GAS float*)ssq + (size_t)(u.pm * 256 + t) * 4 + u.pn, (v.x + v.y) + (v.z + v.w), __ATOMIC_RELAXED, __HIP_MEMORY_SCOPE_AGENT); }
        asm volatile("s_waitcnt vmcnt(0)" ::: "memory");
        unsigned* c = cnt + 64 * u.pm;
        if ((fq * 16 + fr) == 0) __hip_atomic_fetch_add(c, 1u, __ATOMIC_RELAXED, __HIP_MEMORY_SCOPE_AGENT);
        if (wid == 0) {
            const unsigned long long t0 = __builtin_amdgcn_s_memrealtime();
            while ((unsigned)__builtin_amdgcn_readfirstlane((int)__hip_atomic_load(c, __ATOMIC_RELAXED, __HIP_MEMORY_SCOPE_AGENT)) < 32u) {
                if (__builtin_amdgcn_s_memrealtime() - t0 > 2000000ull) break;
                __builtin_amdgcn_s_sleep(2); }
            __builtin_amdgcn_fence(__ATOMIC_ACQUIRE, "agent");
            asm volatile("s_waitcnt vmcnt(0)" ::: "memory"); }
        asm volatile("s_waitcnt lgkmcnt(0)" ::: "memory"); __builtin_amdgcn_s_barrier(); asm volatile("" ::: "memory");
        if (t < 256) { const GAS float* sp = (const GAS float*)ssq + (size_t)(u.pm * 256 + t) * 4; float sum = 0.f;
#pragma unroll
            for (int k = 0; k < 4; ++k) sum += __hip_atomic_load(sp + k, __ATOMIC_RELAXED, __HIP_MEMORY_SCOPE_AGENT);
            S[t] = rsqrtf(sum * (1.0f / DM) + EPS_RMS); }
        asm volatile("s_waitcnt lgkmcnt(0)" ::: "memory"); __builtin_amdgcn_s_barrier(); asm volatile("" ::: "memory");
        f32x4 gv[2][2];
#pragma unroll
        for (int bj = 0; bj < 2; ++bj) { gv[bj][0] = *(const f32x4*)(gfin + col0 + bj * 128); gv[bj][1] = *(const f32x4*)(gfin + col0 + bj * 128 + 4); }
#pragma unroll
        for (int ai = 0; ai < 2; ++ai)
#pragma unroll
            for (int m = 0; m < 4; ++m) { const int rl = ai * 128 + wr * 64 + m * 16 + fr; const float rs = S[rl]; float* op = out + (size_t)(u.pm * 256 + rl) * 1024 + col0;
#pragma unroll
                for (int bj = 0; bj < 2; ++bj) { *(GAS f32x4*)(op + bj * 128) = acc[ai][bj][m][0] * rs * gv[bj][0]; *(GAS f32x4*)(op + bj * 128 + 4) = acc[ai][bj][m][1] * rs * gv[bj][1]; } }
    }
};

struct EpiF {
    static constexpr bool PERM = true;
    unsigned char* ws; LAS float* R;
    __device__ __forceinline__ void prefetch(const pg8::Unit& u, int wid, int lane) const { ssq_prefetch((const float*)(ws + WS_SSQ), u.pm, R, wid, lane); }
    __device__ __forceinline__ void operator()(Acc& acc, const pg8::Unit& u, int wr, int wc, int fr, int fq) const {
        const int row0 = u.pm * 256 + wr * 64 + fr, col0 = u.pn * 128 + wc * 16 + 4 * fq;
        h16* act = (h16*)(ws + WS_ACT);
#pragma unroll
        for (int ai = 0; ai < 2; ++ai)
#pragma unroll
            for (int m = 0; m < 4; ++m) { const int row = row0 + ai * 128 + m * 16; const float rs = rstd_from_lds(R, ai * 128 + wr * 64 + m * 16 + fr);
#pragma unroll
                for (int bj = 0; bj < 2; ++bj) { const f32x4 g = acc[ai][bj][m][0] * rs, uu = acc[ai][bj][m][1] * rs; float v[4];
#pragma unroll
                    for (int i = 0; i < 4; ++i) v[i] = g[i] * sigmoid_f(g[i]) * uu[i];
                    *(GAS u32x2*)(act + (size_t)row * DFF + col0 + bj * 64) = (u32x2){pkz(v[0], v[1]), pkz(v[2], v[3])}; } }
        asm volatile("s_waitcnt lgkmcnt(0)" ::: "memory"); __builtin_amdgcn_s_barrier(); asm volatile("" ::: "memory");
    }
};

__device__ __forceinline__ void final_norm_phase(const Frame& F, const h16* x16, const float* ssq, float* out, const float* g) {
    int lane = lane_id(); asm volatile("" : "+v"(lane));
    const int gw = F.vcu * NWAVES + F.wave, NGW = F.G * NWAVES;
    f32x4 gv[4];
#pragma unroll
    for (int k = 0; k < 4; ++k) gv[k] = *(const f32x4*)(g + 256 * k + 4 * lane);
    for (int m0 = gw; m0 < M; m0 += 8 * NGW) {
        u32x2 xv[8][4]; f32x4 sq[8];
#pragma unroll
        for (int r = 0; r < 8; ++r) { const int m = m0 + r * NGW; if (m < M) { sq[r] = *(const GAS f32x4*)(ssq + (size_t)m * 4);
#pragma unroll
            for (int k = 0; k < 4; ++k) xv[r][k] = *(const GAS u32x2*)(x16 + (size_t)m * DM + 256 * k + 4 * lane); } }
#pragma unroll
        for (int r = 0; r < 8; ++r) { const int m = m0 + r * NGW; if (m < M) { const float rs = rsqrtf(((sq[r].x + sq[r].y) + (sq[r].z + sq[r].w)) * (1.0f / DM) + EPS_RMS);
#pragma unroll
            for (int k = 0; k < 4; ++k) { const u32x2 p = xv[r][k]; const f32x4 gk = gv[k];
                *(GAS f32x4*)(out + (size_t)m * DM + 256 * k + 4 * lane) = (f32x4){h2f_lo(p.x) * rs * gk.x, h2f_hi(p.x) * rs * gk.y, h2f_lo(p.y) * rs * gk.z, h2f_hi(p.y) * rs * gk.w}; } } }
    }
}
__device__ __forceinline__ unsigned wlane(unsigned val, int ln, unsigned old) {
    unsigned keep;
    asm volatile("s_mov_b32 %1, m0\n\ts_mov_b32 m0, %3\n\ts_nop 3\n\tv_writelane_b32 %0, %2, m0\n\ts_mov_b32 m0, %1" : "+v"(old), "=&s"(keep) : "s"(val), "s"(ln));
    return old;
}
__device__ __forceinline__ void cnt_ge(int& c, float x, float m) { asm("v_cmp_ge_f32 vcc, %1, %2\n\tv_addc_co_u32 %0, vcc, 0, %0, vcc" : "+v"(c) : "v"(x), "v"(m) : "vcc"); }
__device__ __forceinline__ void cnt_gt(int& c, float x, float m) { asm("v_cmp_gt_f32 vcc, %1, %2\n\tv_addc_co_u32 %0, vcc, 0, %0, vcc" : "+v"(c) : "v"(x), "v"(m) : "vcc"); }
#define SEL_C8(OP, m_, a0, a1, a2, a3, a4, a5, a6, a7) \
    "v_cmp_" OP "_f32 vcc, " a0 ", " m_ "\n\tv_cmp_" OP "_f32 %2, " a1 ", " m_ "\n\tv_cmp_" OP "_f32 %3, " a2 ", " m_ "\n\tv_cmp_" OP "_f32 %4, " a3 ", " m_ "\n\t" \
    "v_cmp_" OP "_f32 %5, " a4 ", " m_ "\n\tv_cmp_" OP "_f32 %6, " a5 ", " m_ "\n\tv_cmp_" OP "_f32 %7, " a6 ", " m_ "\n\tv_cmp_" OP "_f32 %8, " a7 ", " m_ "\n\t"
#define SEL_A8(c_) \
    "v_addc_co_u32 " c_ ", vcc, 0, " c_ ", vcc\n\tv_addc_co_u32 " c_ ", %2, 0, " c_ ", %2\n\tv_addc_co_u32 " c_ ", %3, 0, " c_ ", %3\n\tv_addc_co_u32 " c_ ", %4, 0, " c_ ", %4\n\t" \
    "v_addc_co_u32 " c_ ", %5, 0, " c_ ", %5\n\tv_addc_co_u32 " c_ ", %6, 0, " c_ ", %6\n\tv_addc_co_u32 " c_ ", %7, 0, " c_ ", %7\n\tv_addc_co_u32 " c_ ", %8, 0, " c_ ", %8\n\t"
#define SEL_CGROUP(NAME, OP) __device__ __forceinline__ void NAME(int& c0, int& c1, const float* s, float m0, float m1) { unsigned long long t1, t2, t3, t4, t5, t6, t7; \
    asm(SEL_C8(OP, "%25", "%9", "%11", "%13", "%15", "%17", "%19", "%21", "%23") SEL_A8("%0") SEL_C8(OP, "%26", "%10", "%12", "%14", "%16", "%18", "%20", "%22", "%24") SEL_A8("%1") \
        : "+v"(c0), "+v"(c1), "=&s"(t1), "=&s"(t2), "=&s"(t3), "=&s"(t4), "=&s"(t5), "=&s"(t6), "=&s"(t7) \
        : "v"(s[0]), "v"(s[1]), "v"(s[2]), "v"(s[3]), "v"(s[4]), "v"(s[5]), "v"(s[6]), "v"(s[7]), "v"(s[8]), "v"(s[9]), "v"(s[10]), "v"(s[11]), "v"(s[12]), "v"(s[13]), "v"(s[14]), "v"(s[15]), "v"(m0), "v"(m1) : "vcc"); }
SEL_CGROUP(cnt_group_ge, "ge")
SEL_CGROUP(cnt_group_gt, "gt")
__device__ __forceinline__ void ballot_ge_to_lane(unsigned& wlo, unsigned& whi, float x, float tau, int ln) {
    unsigned keep;
    asm volatile("v_cmp_ge_f32 vcc, %3, %4\n\ts_mov_b32 %2, m0\n\ts_mov_b32 m0, %5\n\ts_nop 3\n\tv_writelane_b32 %0, vcc_lo, m0\n\tv_writelane_b32 %1, vcc_hi, m0\n\ts_mov_b32 m0, %2"
                 : "+v"(wlo), "+v"(whi), "=&s"(keep) : "v"(x), "v"(tau), "s"(ln) : "vcc");
}
__device__ __forceinline__ int half_sum_dpp(int v, int hf) {
    v += __builtin_amdgcn_update_dpp(0, v, 0x111, 0xf, 0xf, true);
    v += __builtin_amdgcn_update_dpp(0, v, 0x112, 0xf, 0xf, true);
    v += __builtin_amdgcn_update_dpp(0, v, 0x114, 0xf, 0xf, true);
    v += __builtin_amdgcn_update_dpp(0, v, 0x118, 0xf, 0xf, true);
    v += __builtin_amdgcn_update_dpp(0, v, 0x142, 0xa, 0xf, false);
    const int s0 = __builtin_amdgcn_readlane(v, 31), s1 = __builtin_amdgcn_readlane(v, 63);
    return hf ? s1 : s0;
}
__device__ __forceinline__ int crow(int R, int hf) { return (R & 3) + 8 * (R >> 2) + 4 * hf; }
__device__ __forceinline__ float half_swap_max(float v) { auto rr = __builtin_amdgcn_permlane32_swap(__float_as_uint(v), __float_as_uint(v), false, false); return fmaxf(__uint_as_float(rr[0]), __uint_as_float(rr[1])); }
__device__ __forceinline__ float half_swap_sum(float v) { auto rr = __builtin_amdgcn_permlane32_swap(__float_as_uint(v), __float_as_uint(v), false, false); return __uint_as_float(rr[0]) + __uint_as_float(rr[1]); }
__device__ __forceinline__ void rope8(const h16x8 x1, const h16x8 x2, const float* cs, int which, float scale, float (&o)[8]) {
    const f32x4 c0 = *(const GAS f32x4*)(cs), c1 = *(const GAS f32x4*)(cs + 4), s0 = *(const GAS f32x4*)(cs + 8), s1 = *(const GAS f32x4*)(cs + 12);
#pragma unroll
    for (int j = 0; j < 8; ++j) { const float c = j < 4 ? c0[j & 3] : c1[j & 3], s = j < 4 ? s0[j & 3] : s1[j & 3]; const float a = (float)x1[j], b = (float)x2[j];
        o[j] = (which == 0 ? (a * c - b * s) : (b * c + a * s)) * scale; }
}
__device__ __forceinline__ u32x4 pack8(const float (&v)[8]) { u32x4 w; w.x = pkh(v[0], v[1]); w.y = pkh(v[2], v[3]); w.z = pkh(v[4], v[5]); w.w = pkh(v[6], v[7]); return w; }

__device__ __forceinline__ void phaseB(const Frame& F, const In& I, int l) {
    unsigned char* ws = F.ws; asm volatile("" : "+s"(ws)); ws = (unsigned char*)(GAS unsigned char*)ws;     int lane = lane_id(), tid = F.wave * 64 + lane; asm volatile("" : "+v"(lane), "+v"(tid)); const int w = F.wave;
    int blk = F.vcu; asm volatile("" : "+s"(blk));
    const int b = blk >> 5, chunk = (blk >> 1) & 15, gh = blk & 1;
    const size_t tok0 = (size_t)b * SEQ + chunk * 128;
    const h16* UV = (const h16*)(ws + WS_UV); h16* QY = (h16*)(ws + WS_QY);
    LAS unsigned char* VN = F.lds;
    constexpr int VPB = 576;
    { const int i16 = lane & 15, rq = lane >> 4; h16x8 v[4][4];
#pragma unroll
      for (int it = 0; it < 4; ++it)
#pragma unroll
          for (int i = 0; i < 4; ++i) v[it][i] = *(const GAS h16x8*)(UV + (tok0 + 16 * w + 4 * it + rq) * 1024 + 512 + 8 * i16 + 128 * (i & 1) + 256 * ((i >> 1) ^ gh));
      f32x4 lgv[2][2], lbv[2][2];
#pragma unroll
      for (int i = 0; i < 2; ++i) { const int col = 256 * gh + 128 * i + 8 * i16; const float* lg = I.ln_v_g + l * 512 + col; const float* lb = I.ln_v_b + l * 512 + col;
          lgv[i][0] = *(const f32x4*)lg; lgv[i][1] = *(const GAS f32x4*)(lg + 4); lbv[i][0] = *(const f32x4*)lb; lbv[i][1] = *(const GAS f32x4*)(lb + 4); }
#pragma unroll
      for (int it = 0; it < 4; ++it) { float s = 0.f, q = 0.f; float vg[4][8];
#pragma unroll
          for (int i = 0; i < 4; ++i)
#pragma unroll
              for (int j = 0; j < 8; ++j) { const float x = gelu_tanh_f((float)v[it][i][j]); vg[i][j] = x; s += x; q = fmaf(x, x, q); }
          s += __shfl_xor(s, 1); q += __shfl_xor(q, 1); s += __shfl_xor(s, 2); q += __shfl_xor(q, 2); s += __shfl_xor(s, 4); q += __shfl_xor(q, 4); s += __shfl_xor(s, 8); q += __shfl_xor(q, 8);
          const float mu = s * (1.0f / 512.f), var = fmaxf(q * (1.0f / 512.f) - mu * mu, 0.f), rs = rsqrtf(var + 1e-5f);
          const int t = 16 * w + 4 * it + rq;
#pragma unroll
          for (int i = 0; i < 2; ++i) { float o[8];
#pragma unroll
              for (int j = 0; j < 8; ++j) o[j] = (vg[i][j] - mu) * rs * lgv[i][j >> 2][j & 3] + lbv[i][j >> 2][j & 3];
              *(LAS u32x4*)(VN + t * VPB + (128 * i + 8 * i16) * 2) = pack8(o); } } }
    asm volatile("" ::: "memory");
    { const int gp = w & 3, g = 4 * gh + gp, rh = w >> 2, r = lane & 31, hf = lane >> 5;
      const h16* WS16 = (const h16*)(ws + WS_SMALLW + (size_t)l * SMALLW_LAYER + 98304 + 131072) + (size_t)g * 128 * 128;
      const int troff = (8 * hf + ((lane & 15) >> 2)) * VPB + (gp * 64 + 16 * ((lane >> 4) & 1) + 4 * (lane & 3)) * 2;
      h16x8 wf[2][8];
#pragma unroll
      for (int tb = 0; tb < 2; ++tb)
#pragma unroll
          for (int s = 0; s < 8; ++s) wf[tb][s] = *(const GAS h16x8*)(WS16 + (size_t)(64 * rh + 32 * tb + r) * 128 + 16 * s + 8 * hf);
      float bsv[2]; u32x2 uu[2][2][4];
#pragma unroll
      for (int tb = 0; tb < 2; ++tb) { const int t = 64 * rh + 32 * tb + r; bsv[tb] = I.b_s[((size_t)l * 8 + g) * 128 + t];
#pragma unroll
          for (int db = 0; db < 2; ++db)
#pragma unroll
              for (int gg = 0; gg < 4; ++gg) uu[tb][db][gg] = *(const GAS u32x2*)(UV + (tok0 + t) * 1024 + g * 64 + 32 * db + 8 * gg + 4 * hf); }
      LDS_WAIT(); __syncthreads();
#pragma unroll
      for (int tb = 0; tb < 2; ++tb) { const int nks = 4 * rh + 2 * tb + 2; const size_t tk = tok0 + 64 * rh + 32 * tb + r;
#pragma unroll
        for (int db = 0; db < 2; ++db) { f32x16 D = {};
#pragma unroll
            for (int s = 0; s < 8; ++s) if (s < nks) {
                const v4i16_t lo = __builtin_amdgcn_ds_read_tr16_b64_v4i16((LAS v4i16_t*)(VN + troff + (16 * s) * VPB + 64 * db));
                const v4i16_t hi = __builtin_amdgcn_ds_read_tr16_b64_v4i16((LAS v4i16_t*)(VN + troff + (16 * s + 4) * VPB + 64 * db));
                typedef short s16x8 __attribute__((ext_vector_type(8)));
                const s16x8 av = {lo[0], lo[1], lo[2], lo[3], hi[0], hi[1], hi[2], hi[3]};
                D = __builtin_amdgcn_mfma_f32_32x32x16_f16(__builtin_bit_cast(h16x8, av), wf[tb][s], D, 0, 0, 0); }
#pragma unroll
            for (int gg = 0; gg < 4; ++gg) { const u32x2 uv2 = uu[tb][db][gg]; const float bb = bsv[tb];
                const float y0 = gelu_tanh_f(h2f_lo(uv2.x)) * (D[4 * gg] + bb), y1 = gelu_tanh_f(h2f_hi(uv2.x)) * (D[4 * gg + 1] + bb), y2 = gelu_tanh_f(h2f_lo(uv2.y)) * (D[4 * gg + 2] + bb), y3 = gelu_tanh_f(h2f_hi(uv2.y)) * (D[4 * gg + 3] + bb);
                *(GAS u32x2*)(QY + tk * 1024 + 512 + g * 64 + 32 * db + 8 * gg + 4 * hf) = (u32x2){pkh(y0, y1), pkh(y2, y3)}; } } } }
    __syncthreads();
}

constexpr int C_KIB = 0, C_KIBUF = 256 * 128;
constexpr int C_QL = 0, C_QLW = KVP * 2 * 32;
constexpr int C_WQ = 81920;
constexpr int C_KVS = 90112, C_KVSLOT = 10240;

__device__ __forceinline__ void phaseC_select(const Frame& F, int l, int b, int qt, int pmode = 0) {
    unsigned char* ws = F.ws; asm volatile("" : "+s"(ws)); ws = (unsigned char*)(GAS unsigned char*)ws;     int lane = lane_id(), tid = F.wave * 64 + lane; asm volatile("" : "+v"(lane), "+v"(tid)); const int w = F.wave, r = lane & 31, hf = lane >> 5;
    const h16* QI = (const h16*)(ws + WS_QI); const h16* KI = (const h16*)(ws + WS_KI); const float* WI = (const float*)(ws + WS_WI); const float* CS = (const float*)(ws + WS_CS);
    h16* QY = (h16*)(ws + WS_QY); const h16* KV = (const h16*)(ws + WS_KV);
    const h16* WUKT = (const h16*)(ws + WS_SMALLW + (size_t)l * SMALLW_LAYER); const h16* WUVT = (const h16*)(ws + WS_SMALLW + (size_t)l * SMALLW_LAYER + 98304);
    LAS unsigned char* lds = F.lds;
    const int t0 = 32 * qt, NT = qt + 1; const size_t tokbase = (size_t)b * SEQ;
    { const char* kvsrc_ = (const char*)((const h16*)(ws + WS_KV) + tokbase * KVP) + (size_t)(64 * w + lane) * 16; const unsigned kvdst_ = (unsigned)(uintptr_t)(lds + C_KVS) + (unsigned)w * 1024u;
#pragma unroll
      for (int t_ = 0; t_ < 4; ++t_) if (t_ < NT) { const char* s_ = kvsrc_ + (size_t)t_ * (32 * KVP * 2); const unsigned d_ = (unsigned)__builtin_amdgcn_readfirstlane((int)(kvdst_ + (unsigned)t_ * (unsigned)C_KVSLOT));
          unsigned keep_; asm volatile("s_mov_b32 %0, m0\n\ts_mov_b32 m0, %2\n\ts_nop 0\n\tglobal_load_lds_dwordx4 %1, off\n\ts_mov_b32 m0, %0" : "=&s"(keep_) : "v"(s_), "s"(d_) : "memory");
          if (w < 2) { const char* s2_ = s_ + 8192; const unsigned d2_ = d_ + 8192u; asm volatile("s_mov_b32 %0, m0\n\ts_mov_b32 m0, %2\n\ts_nop 0\n\tglobal_load_lds_dwordx4 %1, off\n\ts_mov_b32 m0, %0" : "=&s"(keep_) : "v"(s2_), "s"(d2_) : "memory"); } } }
    h16x8 afr[4]; float wreg[16];
    { const int qq = 2 * ((r >> 2) & 1) + (r >> 4), head = (r & 3) + 4 * ((r >> 3) & 1); const size_t tokA = tokbase + t0 + 4 * w + qq;
      const h16* qsrc = QI + tokA * 512 + head * 64;
      { float o[8]; rope8(*(const GAS h16x8*)(qsrc), *(const GAS h16x8*)(qsrc + 8), CS + tokA * 16, hf, 1.0f, o); afr[0] = __builtin_bit_cast(h16x8, pack8(o)); }
#pragma unroll
      for (int s = 1; s < 4; ++s) afr[s] = *(const GAS h16x8*)(qsrc + 16 * s + 8 * hf);
      const float* wp = WI + (tokbase + t0 + 4 * w + 2 * hf) * 8;
#pragma unroll
      for (int R4 = 0; R4 < 4; ++R4) { const f32x4 wv = *(const GAS f32x4*)(wp + 4 * R4); wreg[4 * R4] = wv.x; wreg[4 * R4 + 1] = wv.y; wreg[4 * R4 + 2] = wv.z; wreg[4 * R4 + 3] = wv.w; } }
    float SC[128];
    const float QNAN = __uint_as_float(0x7fc00000u);
#pragma unroll
    for (int i = 0; i < 128; ++i) SC[i] = QNAN;
    const int NCK = (NT + 7) >> 3, tq0 = t0 + 4 * w + 2 * hf;
    const int drow = lane >> 3, dslot = lane & 7;
    const h16* kisrc = KI + (tokbase + 32 * w + drow) * 64 + 8 * (dslot ^ drow);
#define KI_STAGE(ck_, buf_) do { _Pragma("unroll") for (int i_ = 0; i_ < 4; ++i_) \
        __builtin_amdgcn_global_load_lds((const unsigned*)(kisrc + (size_t)(256 * (ck_) + 8 * i_) * 64), (LAS unsigned*)(lds + C_KIB + (buf_) * C_KIBUF + (4 * w + i_) * 1024), 16, 0, 0); } while (0)
    KI_STAGE(0, 0);
    VM_WAIT(); __syncthreads();
    const int kroff = r * 128, kx = r & 7;
#pragma unroll 1
    for (int ck = 0; ck < NCK; ++ck) {
        LAS unsigned char* kb = lds + C_KIB + (ck & 1) * C_KIBUF;
        if (ck + 1 < NCK) KI_STAGE(ck + 1, (ck + 1) & 1);
#pragma unroll
        for (int i = 0; i < 112; ++i) SC[i] = SC[i + 16];
#pragma unroll
        for (int jj = 0; jj < 8; ++jj) { if (pmode & 1) { SC[112 + 2 * jj] = (float)(ck + jj + r) * 0.01f; SC[113 + 2 * jj] = (float)(ck - jj + r) * 0.01f; continue; }
            f32x16 D = {};
#pragma unroll
            for (int s = 0; s < 4; ++s) { const h16x8 bb = *(const LAS h16x8*)(kb + jj * 4096 + kroff + 16 * ((2 * s + hf) ^ kx)); D = __builtin_amdgcn_mfma_f32_32x32x16_f16(afr[s], bb, D, 0, 0, 0); }
            float s0 = 0.f, s1 = 0.f;
#pragma unroll
            for (int R = 0; R < 8; ++R) { s0 = fmaf(wreg[R], fmaxf(D[R], 0.f), s0); s1 = fmaf(wreg[8 + R], fmaxf(D[8 + R], 0.f), s1); }
            const int k = 256 * ck + 32 * jj + r;
            SC[112 + 2 * jj] = (k > tq0) ? QNAN : s0; SC[113 + 2 * jj] = (k > tq0 + 1) ? QNAN : s1;
        }
        LDS_WAIT(); VM_WAIT(); __syncthreads();
    }
#undef KI_STAGE
    const int G0 = 8 - NCK;
#define SEL_COUNT2(c0, c1, FN, m0, m1) do { int a0_ = 0, a1_ = 0; \
        _Pragma("unroll") for (int g = 0; g < 8; ++g) if (g >= G0) FN(a0_, a1_, &SC[16 * g], (m0), (m1)); \
        c0 = half_sum_dpp(a0_, hf); c1 = half_sum_dpp(a1_, hf); } while (0)
    float tau0 = -3.0e38f, tau1 = -3.0e38f;
    if (qt >= 8 && !(pmode & 2)) {
        float lo0 = INFINITY, lo1 = INFINITY, hi0 = -INFINITY, hi1 = -INFINITY;
#pragma unroll
        for (int j = 0; j < 64; ++j) { const float a = SC[2 * j], c = SC[2 * j + 1]; lo0 = fminf(lo0, a); hi0 = fmaxf(hi0, a); lo1 = fminf(lo1, c); hi1 = fmaxf(hi1, c); }
#pragma unroll
        for (int o = 1; o < 32; o <<= 1) { lo0 = fminf(lo0, __shfl_xor(lo0, o)); lo1 = fminf(lo1, __shfl_xor(lo1, o)); hi0 = fmaxf(hi0, __shfl_xor(hi0, o)); hi1 = fmaxf(hi1, __shfl_xor(hi1, o)); }
        int cl0 = tq0 + 1, cl1 = tq0 + 2, ch0 = 1, ch1 = 1;
        bool done0 = false, done1 = false;
        { int g0, g1; const float zero = 0.f; SEL_COUNT2(g0, g1, cnt_group_gt, zero, zero);
          const float tiny = __uint_as_float(1u);
          if (__any(g0 < 256 || g1 < 256)) { int e0, e1; SEL_COUNT2(e0, e1, cnt_group_ge, zero, zero);
              if (g0 < 256) { if (e0 >= 256) { lo0 = 0.f; done0 = true; } else { hi0 = 0.f; ch0 = e0; } }
              if (g1 < 256) { if (e1 >= 256) { lo1 = 0.f; done1 = true; } else { hi1 = 0.f; ch1 = e1; } } }
          if (g0 >= 256) { lo0 = tiny; cl0 = g0; if (g0 == 256) done0 = true; }
          if (g1 >= 256) { lo1 = tiny; cl1 = g1; if (g1 == 256) done1 = true; } }
#define SEL_STEP(c0, c1, mid0, mid1) do { \
            if (!done0) { if (c0 >= 256) { lo0 = mid0; cl0 = c0; if (c0 == 256) done0 = true; } else { hi0 = mid0; ch0 = c0; } } \
            if (!done1) { if (c1 >= 256) { lo1 = mid1; cl1 = c1; if (c1 == 256) done1 = true; } else { hi1 = mid1; ch1 = c1; } } } while (0)
#define SEL_EXHAUSTED(bis0, bis1) do { if (!done0 && (bis0 <= lo0 || bis0 >= hi0)) done0 = true; if (!done1 && (bis1 <= lo1 || bis1 >= hi1)) done1 = true; } while (0)
        bool compact = true;
#pragma unroll 1
        for (int it = 0; it < ((pmode & 16) ? 6 : 40); ++it) {
            const float bis0 = 0.5f * (lo0 + hi0), bis1 = 0.5f * (lo1 + hi1);
            SEL_EXHAUSTED(bis0, bis1);
            if (__all((done0 || (compact && cl0 - ch0 <= 48)) && (done1 || (compact && cl1 - ch1 <= 48)))) break;
            int c0, c1; SEL_COUNT2(c0, c1, cnt_group_ge, bis0, bis1);
            SEL_STEP(c0, c1, bis0, bis1);
            if (it == 39) { done0 = true; done1 = true; }
        }
        if (!__all(done0 && done1)) {
            LAS float* L0 = (LAS float*)(lds + w * 4096 + (2 * hf) * 1024 + r * 32); LAS float* L1 = L0 + 256;
            { const f32x4 qn = {QNAN, QNAN, QNAN, QNAN}; *(LAS f32x4*)L0 = qn; *(LAS f32x4*)(L0 + 4) = qn; *(LAS f32x4*)L1 = qn; *(LAS f32x4*)(L1 + 4) = qn; }
            int n0 = 0, n1 = 0;
#pragma unroll
            for (int g = 0; g < 8; ++g) if (g >= G0) {
#pragma unroll
                for (int jj = 0; jj < 8; ++jj) { const int j = 8 * g + jj; const float v0 = SC[2 * j], v1 = SC[2 * j + 1];
                    if (!done0 && v0 >= lo0 && v0 < hi0) { if (n0 < 8) L0[n0] = v0; ++n0; }
                    if (!done1 && v1 >= lo1 && v1 < hi1) { if (n1 < 8) L1[n1] = v1; ++n1; } } }
            LDS_WAIT();
            float CAND[16];
            { const f32x4 a0 = *(const LAS f32x4*)L0, a1 = *(const LAS f32x4*)(L0 + 4), b0 = *(const LAS f32x4*)L1, b1 = *(const LAS f32x4*)(L1 + 4);
#pragma unroll
              for (int i = 0; i < 4; ++i) { CAND[2 * i] = a0[i]; CAND[8 + 2 * i] = a1[i]; CAND[2 * i + 1] = b0[i]; CAND[8 + 2 * i + 1] = b1[i]; } }
            LDS_WAIT();
            if (__any(n0 > 8 || n1 > 8)) {
#pragma unroll 1
                for (int it = 0; it < 40; ++it) {
                    const float bis0 = 0.5f * (lo0 + hi0), bis1 = 0.5f * (lo1 + hi1);
                    SEL_EXHAUSTED(bis0, bis1);
                    if (__all(done0 && done1)) break;
                    int c0, c1; SEL_COUNT2(c0, c1, cnt_group_ge, bis0, bis1);
                    SEL_STEP(c0, c1, bis0, bis1);
                }
            } else {
                const int cb0 = ch0, cb1 = ch1;
#pragma unroll 1
                for (int it = 0; it < ((pmode & 16) ? 3 : 48); ++it) {
                    const float bis0 = 0.5f * (lo0 + hi0), bis1 = 0.5f * (lo1 + hi1);
                    SEL_EXHAUSTED(bis0, bis1);
                    if (__all(done0 && done1)) break;
                    float mid0 = bis0, mid1 = bis1;
                    if ((it % 3) != 2) { const float i0 = lo0 + ((float)cl0 - 255.5f) / (float)(cl0 - ch0) * (hi0 - lo0), i1 = lo1 + ((float)cl1 - 255.5f) / (float)(cl1 - ch1) * (hi1 - lo1);
                        if (i0 > lo0 && i0 < hi0) mid0 = i0; if (i1 > lo1 && i1 < hi1) mid1 = i1; }
                    int a0 = 0, a1 = 0; cnt_group_ge(a0, a1, CAND, mid0, mid1);
                    const int c0 = cb0 + half_sum_dpp(a0, hf), c1 = cb1 + half_sum_dpp(a1, hf);
                    SEL_STEP(c0, c1, mid0, mid1);
                }
            }
        }
#undef SEL_STEP
#undef SEL_EXHAUSTED
        tau0 = lo0; tau1 = lo1;
    }
#undef SEL_COUNT2
    unsigned w00 = 0u, w01 = 0u, w10 = 0u, w11 = 0u;
#pragma unroll
    for (int g = 0; g < 8; ++g) if (g >= G0 && !(pmode & 4)) {
#pragma unroll
        for (int jj = 0; jj < 8; ++jj) { const int j = 8 * g + jj, jt = 8 * (g - G0) + jj;
            ballot_ge_to_lane(w00, w10, SC[2 * j], tau0, jt); ballot_ge_to_lane(w01, w11, SC[2 * j + 1], tau1, jt); } }
    { LAS unsigned* WQ = (LAS unsigned*)(lds + C_WQ);
      WQ[(4 * w + 0) * 64 + lane] = w00; WQ[(4 * w + 1) * 64 + lane] = w01; WQ[(4 * w + 2) * 64 + lane] = w10; WQ[(4 * w + 3) * 64 + lane] = w11; }
    LDS_WAIT(); __syncthreads();
}

__device__ __forceinline__ void phaseC_attn(const Frame& F, int l, int b, int qt, bool do_store = true, int pmode = 0) {
    unsigned char* ws = F.ws; asm volatile("" : "+s"(ws)); ws = (unsigned char*)(GAS unsigned char*)ws;     const int w = F.wave;
    int lane = lane_id(), tid = F.wave * 64 + lane; asm volatile("" : "+v"(lane), "+v"(tid));
    const int r = lane & 31, hf = lane >> 5;
    const float* CS = (const float*)(ws + WS_CS);
    h16* QY = (h16*)(ws + WS_QY); const h16* KV = (const h16*)(ws + WS_KV);
    const h16* WUKT = (const h16*)(ws + WS_SMALLW + (size_t)l * SMALLW_LAYER); const h16* WUVT = (const h16*)(ws + WS_SMALLW + (size_t)l * SMALLW_LAYER + 98304);
    LAS unsigned char* lds = F.lds;
    const int t0 = 32 * qt, NT = qt + 1; const size_t tokbase = (size_t)b * SEQ;
    const int h = w; const size_t tokQ = tokbase + t0 + r;
    LAS h16* ql = (LAS h16*)(lds + C_QL + w * C_QLW);
    if (!(pmode & 64)) { h16x8 bq[3];
#pragma unroll
      for (int s = 0; s < 3; ++s) bq[s] = *(const GAS h16x8*)(QY + tokQ * 1024 + h * 64 + 16 + 16 * s + 8 * hf);
#pragma unroll
      for (int cb = 0; cb < 4; ++cb) { f32x16 D = {};
#pragma unroll
          for (int s = 0; s < 3; ++s) { const h16x8 a = *(const GAS h16x8*)(WUKT + ((size_t)(h * 128 + 32 * cb + r)) * 48 + 16 * s + 8 * hf); D = __builtin_amdgcn_mfma_f32_32x32x16_f16(a, bq[s], D, 0, 0, 0); }
#pragma unroll
          for (int g = 0; g < 4; ++g) { const int c = 32 * cb + 8 * g + 4 * hf;
              *(LAS u32x2*)(ql + r * KVP + c) = (u32x2){pkh(D[4 * g] * QSCALE, D[4 * g + 1] * QSCALE), pkh(D[4 * g + 2] * QSCALE, D[4 * g + 3] * QSCALE)}; } }
      { float o[8]; rope8(*(const GAS h16x8*)(QY + tokQ * 1024 + h * 64), *(const GAS h16x8*)(QY + tokQ * 1024 + h * 64 + 8), CS + tokQ * 16, hf, QSCALE, o); *(LAS u32x4*)(ql + r * KVP + 128 + 8 * hf) = pack8(o); } }
    LDS_WAIT();
    h16x8 qfr[9];
#pragma unroll
    for (int s = 0; s < 9; ++s) qfr[s] = *(const LAS h16x8*)(ql + r * KVP + 16 * s + 8 * hf);
    const char* kvsrc = (const char*)(KV + tokbase * KVP) + (size_t)(64 * w + lane) * 16;
    const unsigned kvdst = (unsigned)(uintptr_t)(lds + C_KVS) + (unsigned)w * 1024u;
    const int grp = w >> 2;
#define KV_DMA1(src_, dst_) do { unsigned keep_; asm volatile("s_mov_b32 %0, m0\n\ts_mov_b32 m0, %2\n\ts_nop 0\n\tglobal_load_lds_dwordx4 %1, off\n\ts_mov_b32 m0, %0" : "=&s"(keep_) : "v"(src_), "s"(dst_) : "memory"); } while (0)
#define KV_DMA(t_) do { const char* s_ = kvsrc + (size_t)(t_) * (32 * KVP * 2); const unsigned d_ = (unsigned)__builtin_amdgcn_readfirstlane((int)(kvdst + (unsigned)((t_) % 5) * (unsigned)C_KVSLOT)); \
        KV_DMA1(s_, d_); if (w < 2) { const char* s2_ = s_ + 8192; const unsigned d2_ = d_ + 8192u; KV_DMA1(s2_, d2_); } } while (0)
#define KV_WAIT(n_) do { if ((n_) <= 0) asm volatile("s_waitcnt vmcnt(0)" ::: "memory"); else if ((n_) == 1) { if (w < 2) asm volatile("s_waitcnt vmcnt(2)" ::: "memory"); else asm volatile("s_waitcnt vmcnt(1)" ::: "memory"); } \
        else { if (w < 2) asm volatile("s_waitcnt vmcnt(4)" ::: "memory"); else asm volatile("s_waitcnt vmcnt(2)" ::: "memory"); } } while (0)
#if defined(PROBE_C_ATT)
    { KV_DMA(0); if (NT > 1) KV_DMA(1); if (NT > 2) KV_DMA(2); if (NT > 3) KV_DMA(3); }
#endif
    asm volatile("s_waitcnt vmcnt(0)" ::: "memory");
    asm volatile("s_waitcnt lgkmcnt(0)" ::: "memory"); __builtin_amdgcn_s_barrier(); asm volatile("" ::: "memory");
    float mrun = 0.f, lrun = 0.f; f32x16 O[4]; f32x16 negm;
#pragma unroll
    for (int db = 0; db < 4; ++db) O[db] = (f32x16){};
#pragma unroll
    for (int R = 0; R < 16; ++R) negm[R] = 0.f;
    const LAS unsigned* WQr = (const LAS unsigned*)(lds + C_WQ) + r * 64;
    const int troff = ((lane & 15) >> 2) * (KVP * 2) + (16 * ((lane >> 4) & 1) + 4 * (lane & 3)) * 2 + 4 * hf * (KVP * 2);
    const int kbase = (int)(uintptr_t)(lds + C_KVS) + r * (KVP * 2) + 16 * hf, vbase = (int)(uintptr_t)(lds + C_KVS) + troff;
    typedef short s16x8 __attribute__((ext_vector_type(8)));
#define AT_MAX3(a_, b_, c_) ({ float r_; asm("v_max3_f32 %0, %1, %2, %3" : "=v"(r_) : "v"(a_), "v"(b_), "v"(c_)); r_; })
#define AT_MASKED(e_, w_, pos_) ({ int t_, r_; asm("v_bfe_i32 %0, %2, %3, 1\n\tv_and_b32 %1, %4, %0" : "=&v"(t_), "=v"(r_) : "v"(w_), "n"(pos_), "v"(e_)); __int_as_float(r_); })
#define AT_KLOAD(so_) h16x8 kfr[9]; do { const LAS unsigned char* sl_ = (const LAS unsigned char*)(uintptr_t)(kbase + (so_)); \
        if (!(pmode & 16)) { _Pragma("unroll") for (int s = 0; s < 9; ++s) kfr[s] = *(const LAS h16x8*)(sl_ + 32 * s); } else { _Pragma("unroll") for (int s = 0; s < 9; ++s) kfr[s] = qfr[s]; } __builtin_amdgcn_sched_barrier(0); } while (0)
#define AT_QK(S_) do { S_ = negm; if (!(pmode & 16)) { __builtin_amdgcn_s_setprio(1); _Pragma("unroll") for (int s = 0; s < 9; ++s) S_ = __builtin_amdgcn_mfma_f32_32x32x16_f16(kfr[s], qfr[s], S_, 0, 0, 0); __builtin_amdgcn_s_setprio(0); } } while (0)
#define AT_VLOAD(db0_) do { _Pragma("unroll") for (int db = 0; db < 2; ++db) _Pragma("unroll") for (int sp = 0; sp < 2; ++sp) { \
            vlo_[db][sp] = __builtin_amdgcn_ds_read_tr16_b64_v4i16((LAS v4i16_t*)(sl_ + (16 * sp) * (KVP * 2) + 64 * ((db0_) + db))); \
            vhi_[db][sp] = __builtin_amdgcn_ds_read_tr16_b64_v4i16((LAS v4i16_t*)(sl_ + (16 * sp + 8) * (KVP * 2) + 64 * ((db0_) + db))); } } while (0)
#define AT_PV2(db0_) do { __builtin_amdgcn_s_setprio(1); _Pragma("unroll") for (int db = 0; db < 2; ++db) _Pragma("unroll") for (int sp = 0; sp < 2; ++sp) { \
            const s16x8 av_ = {vlo_[db][sp][0], vlo_[db][sp][1], vlo_[db][sp][2], vlo_[db][sp][3], vhi_[db][sp][0], vhi_[db][sp][1], vhi_[db][sp][2], vhi_[db][sp][3]}; \
            O[(db0_) + db] = __builtin_amdgcn_mfma_f32_32x32x16_f16(__builtin_bit_cast(h16x8, av_), pf_[sp], O[(db0_) + db], 0, 0, 0); } __builtin_amdgcn_s_setprio(0); } while (0)
#define AT_SMPV(S_, t_, so_) do { const LAS unsigned char* sl_ = (const LAS unsigned char*)(uintptr_t)(vbase + (so_)); \
        v4i16_t vlo_[2][2], vhi_[2][2]; \
        AT_VLOAD(0); \
        const int wq_ = (int)(WQr[(t_)] >> (4 * hf)); \
        __builtin_amdgcn_sched_barrier(0); \
        float mt_ = AT_MAX3(S_[0], S_[1], S_[2]); \
        _Pragma("unroll") for (int R = 3; R < 15; R += 2) mt_ = AT_MAX3(mt_, S_[R], S_[R + 1]); \
        mt_ = half_swap_max(AT_MAX3(mt_, S_[15], S_[15])); \
        if ((t_) == 0 || __any(mt_ > 8.0f)) { const float dl_ = (t_) == 0 ? mt_ : fmaxf(mt_, 0.f), alpha_ = (t_) == 0 ? 1.f : __builtin_amdgcn_exp2f(-dl_);     \
            _Pragma("unroll") for (int db = 0; db < 4; ++db) O[db] = O[db] * alpha_; \
            _Pragma("unroll") for (int R = 0; R < 16; ++R) S_[R] -= dl_; \
            lrun *= alpha_; mrun += dl_; \
            _Pragma("unroll") for (int R = 0; R < 16; ++R) negm[R] = -mrun; } \
        float p_[16]; \
        if (!(pmode & 1)) { _Pragma("unroll") for (int R = 0; R < 16; ++R) { const float e_ = __builtin_amdgcn_exp2f(S_[R]); p_[R] = AT_MASKED(e_, wq_, (R & 3) + 8 * (R >> 2)); lrun += p_[R]; } } \
        else { _Pragma("unroll") for (int R = 0; R < 16; ++R) p_[R] = S_[R]; lrun += p_[0]; } \
        h16x8 pf_[2]; \
        _Pragma("unroll") for (int sp = 0; sp < 2; ++sp) { u32x4 t4_; t4_.x = pkz(p_[8 * sp], p_[8 * sp + 1]); t4_.y = pkz(p_[8 * sp + 2], p_[8 * sp + 3]); t4_.z = pkz(p_[8 * sp + 4], p_[8 * sp + 5]); t4_.w = pkz(p_[8 * sp + 6], p_[8 * sp + 7]); pf_[sp] = __builtin_bit_cast(h16x8, t4_); } \
        __builtin_amdgcn_sched_barrier(0); \
        if (!(pmode & 2)) { AT_PV2(0); \
        __builtin_amdgcn_sched_barrier(0); \
        AT_VLOAD(2); \
        __builtin_amdgcn_sched_barrier(0); \
        AT_PV2(2); } else { O[0][0] += (float)pf_[0][0] + (float)pf_[1][0]; } } while (0)
#define AT_BOUNDARY2(g_) do {   \
        if (!(pmode & 4)) { asm volatile("s_waitcnt vmcnt(0) lgkmcnt(0)" ::: "memory"); __builtin_amdgcn_s_barrier(); asm volatile("" ::: "memory"); \
        if (2 * (g_) + 4 < NT) KV_DMA(2 * (g_) + 4); if (2 * (g_) + 5 < NT) KV_DMA(2 * (g_) + 5); } } while (0)
#define AT_NEXT(so_) ((so_) == 4 * C_KVSLOT ? 0 : (so_) + C_KVSLOT)
    const int NG = (NT + 1) >> 1;
    if (grp == 0) {
        int so = 0;
#pragma unroll 1
        for (int g = 0; g < NG; ++g) { const int t = 2 * g;
            { f32x16 Sx; AT_KLOAD(so); AT_QK(Sx); __builtin_amdgcn_sched_barrier(0); AT_SMPV(Sx, t, so); so = AT_NEXT(so); }
            if (t + 1 < NT) { f32x16 Sx; AT_KLOAD(so); AT_QK(Sx); __builtin_amdgcn_sched_barrier(0); AT_SMPV(Sx, t + 1, so); so = AT_NEXT(so); }
            AT_BOUNDARY2(g); }
    } else {
        f32x16 Sx; int so = 0, sop = 0;
        { AT_KLOAD(so); AT_QK(Sx); } sop = so; so = AT_NEXT(so);
        if (1 < NT) { AT_SMPV(Sx, 0, sop); __builtin_amdgcn_sched_barrier(0); { AT_KLOAD(so); AT_QK(Sx); } sop = so; so = AT_NEXT(so); }
        AT_BOUNDARY2(0);
#pragma unroll 1
        for (int g = 1; g < NG; ++g) { const int t = 2 * g;
            AT_SMPV(Sx, t - 1, sop); __builtin_amdgcn_sched_barrier(0); { AT_KLOAD(so); AT_QK(Sx); } sop = so; so = AT_NEXT(so);
            if (t + 1 < NT) { AT_SMPV(Sx, t, sop); __builtin_amdgcn_sched_barrier(0); { AT_KLOAD(so); AT_QK(Sx); } sop = so; so = AT_NEXT(so); }
            AT_BOUNDARY2(g); }
        AT_SMPV(Sx, NT - 1, sop);
    }
#undef AT_NEXT
#undef AT_MAX3
#undef AT_MASKED
#undef AT_BOUNDARY2
#undef KV_DMA
#undef KV_DMA1
#undef KV_WAIT
#undef AT_KLOAD
#undef AT_QK
#undef AT_SMPV
#undef AT_VLOAD
#undef AT_PV2
    if (!(pmode & 32)) {
    h16x8 bwv[2][8];
#pragma unroll
    for (int d2 = 0; d2 < 2; ++d2)
#pragma unroll
        for (int s = 0; s < 8; ++s) bwv[d2][s] = *(const GAS h16x8*)(WUVT + ((size_t)(h * 64 + 32 * d2 + r)) * 128 + 16 * s + 8 * hf);
    { const float inv = 1.0f / half_swap_sum(lrun);
#pragma unroll
      for (int db = 0; db < 4; ++db)
#pragma unroll
          for (int g = 0; g < 4; ++g) { const int c = 32 * db + 8 * g + 4 * hf;
              *(LAS u32x2*)(ql + r * KVP + c) = (u32x2){pkh(O[db][4 * g] * inv, O[db][4 * g + 1] * inv), pkh(O[db][4 * g + 2] * inv, O[db][4 * g + 3] * inv)}; } }
    LDS_WAIT();
    { h16x8 ao[8];
#pragma unroll
      for (int s = 0; s < 8; ++s) ao[s] = *(const LAS h16x8*)(ql + r * KVP + 16 * s + 8 * hf);
#pragma unroll
      for (int d2 = 0; d2 < 2; ++d2) { f32x16 D = {};
#pragma unroll
          for (int s = 0; s < 8; ++s) D = __builtin_amdgcn_mfma_f32_32x32x16_f16(bwv[d2][s], ao[s], D, 0, 0, 0);
#pragma unroll
          for (int g = 0; g < 4; ++g) { const u32x2 pk = {pkh(D[4 * g], D[4 * g + 1]), pkh(D[4 * g + 2], D[4 * g + 3])};
              if (do_store) *(GAS u32x2*)(QY + (tokbase + t0 + r) * 1024 + h * 64 + 32 * d2 + 8 * g + 4 * hf) = pk; else asm volatile("" :: "v"(pk)); } } }
    } else { asm volatile("" :: "v"(O[0][0]), "v"(O[1][0]), "v"(O[2][0]), "v"(O[3][0]), "v"(lrun)); }
    LDS_WAIT(); __syncthreads();
}

__device__ __forceinline__ void phaseC(const Frame& F, int l) {
    int vc = F.vcu; asm volatile("" : "+s"(vc)); const int b = vc >> 5, i = vc & 31;
#pragma unroll 1
    for (int u = 0; u < 2; ++u) { const int qt = (u == 0) ? 63 - i : i;
#if defined(PROBE_C_SEL)
#pragma unroll 1
        for (int rep = 0; rep < 2; ++rep)
        phaseC_select(F, l, b, qt, rep == 0 ? PROBE_C_SEL : 0);
#else
        phaseC_select(F, l, b, qt);
#endif
#if defined(PROBE_C_ATT)
#pragma unroll 1
        for (int rep = 0; rep < 2; ++rep) phaseC_attn(F, l, b, qt, rep == 1, rep == 1 ? 0 : PROBE_C_ATT);
#else
        phaseC_attn(F, l, b, qt);
#endif
    }
}
#if defined(PROBE_STORE)
#define PROBE_NOSTORE(f) (f)
#else
#define PROBE_NOSTORE(f) 0
#endif
#if defined(PROBE_EPI)
#define PROBE_NOEPI(f) (f)
#else
#define PROBE_NOEPI(f) 0
#endif
#ifndef PROBE_MASK
#define PROBE_MASK 0u
#endif
#ifndef MK_N_LAUNCHES
#define MK_N_LAUNCHES 1
#endif
#if MK_N_LAUNCHES == 1
constexpr bool FUSE_FINAL = false;
#else
constexpr bool FUSE_FINAL = false;
#endif
constexpr int N_PHASES = 2 + 7 * NLAYER;
constexpr int CONV_WD_FIRST = CONV_IN_ITEMS + 2 * 128 + 256 + (NGU / 64) * 16;
constexpr int CONV_SPLIT = 2150;
struct Args { In in; float* out; unsigned char* ws; int ph_lo, ph_hi, flags, pad; };

__global__ void __launch_bounds__(NTHREADS, 2) mk_fwd(Args args) {
    extern __shared__ __attribute__((aligned(16))) unsigned char lds_raw[];
    Frame F; F.lds = (LAS unsigned char*)lds_raw; F.wave = __builtin_amdgcn_readfirstlane((int)threadIdx.x >> 6);
    F.G = gridDim.x; { const int bx = blockIdx.x; F.vcu = (F.G % 8 == 0) ? (bx % 8) * (F.G / 8) + bx / 8 : bx; }
    F.ws = args.ws; F.in = nullptr;
    const In& I = args.in; unsigned char* ws = args.ws; (void)ws;
    volatile LAS unsigned* MISCW = (volatile LAS unsigned*)(F.lds + LDS_MISC);
    if (F.wave == 0) MISCW[lane_id()] = 0u;
    __syncthreads();
#if MK_N_LAUNCHES == 1
    const bool one_launch = true;
#else
    const bool one_launch = (args.ph_hi - args.ph_lo) > 1;
#endif
    XcdBarrier bar; bar.bar = (unsigned*)(ws + WS_CTL) + 1024; bar.x = 0; bar.st = nullptr;
    if (one_launch) bar = xcd_barrier_post((unsigned*)(ws + WS_CTL) + 1024, MISCW + 8, F.wave);
#if MK_N_LAUNCHES == 1
#define IN(k) true
#define SEAM(k) xcd_barrier(bar, F.wave)
#else
#define IN(k) (args.ph_lo <= (k) && (k) < args.ph_hi)
#define SEAM(k) do { if (IN(k) && IN((k) + 1)) xcd_barrier(bar, F.wave); } while (0)
#endif
    if (IN(0)) { p0_prologue(F, I); SEAM(0); }
#define OPQ(x) asm volatile("" : "+s"(x))
#pragma unroll 1
    for (int l0 = 0; l0 < NLAYER; ++l0) {
        const int p = 1 + 7 * l0;
        if (IN(p)) {
            unsigned char* wsq = args.ws; int l = l0; OPQ(wsq); OPQ(l); wsq = (unsigned char*)(GAS unsigned char*)wsq; unsigned char* wl = wsq + WS_W + (size_t)l * W_LAYER;
            pg8::Gemm g{(const h16*)(wsq + WS_X16), (const h16*)(wl + W_OFF_IN), 1024, 1024, 1024, M / 256, NZ / 256, 1, 0, PROBE_NOEPI(args.flags), 0};
            pg8::Order S; S.init(g.nM, g.nN, F.G, (int)blockIdx.x, 1); EpiA E{wsq, PROBE_NOSTORE(args.flags), (LAS float*)(F.lds + 131072 + 4096)};
            pg8::gemm_phase<EpiA>(F.lds, g, S, E, F.wave);
            { constexpr int NBIG = ((M / 256) * (NZ / 256)) % 256;
              if ((int)blockIdx.x >= NBIG && F.G == 256) convert_layer_weights(F, I, l, ((int)blockIdx.x - NBIG) * NWAVES + F.wave, (256 - NBIG) * NWAVES, CONV_IN_ITEMS, 1 << 30);
              else if (F.G != 256) { xcd_barrier(bar, F.wave); convert_layer_weights(F, I, l, F.vcu * NWAVES + F.wave, F.G * NWAVES, CONV_IN_ITEMS, 1 << 30); } }
            SEAM(p); }
#if MK_N_LAUNCHES == 1
        if (IN(p + 1)) { int l = l0; OPQ(l); phaseB(F, I, l); }
#else
        if (IN(p + 1)) { int l = l0; OPQ(l); phaseB(F, I, l); SEAM(p + 1); }
#endif
        if (IN(p + 2)) { int l = l0; OPQ(l); phaseC(F, l); SEAM(p + 2); }
        if (IN(p + 3)) {
            unsigned char* wsq = args.ws; int l = l0; OPQ(wsq); OPQ(l); wsq = (unsigned char*)(GAS unsigned char*)wsq; unsigned char* wl = wsq + WS_W + (size_t)l * W_LAYER;
            pg8::Gemm g{(const h16*)(wsq + WS_QY), (const h16*)(wl + W_OFF_PAB), 1024, 1024, 512, M / 256, 4, 2, 512, PROBE_NOEPI(args.flags), 0};
            pg8::Order S; S.init(g.nM, g.nN, F.G, (int)blockIdx.x, 2); EpiD E{wsq, (h16*)args.out};
            pg8::gemm_phase<EpiD>(F.lds, g, S, E, F.wave); SEAM(p + 3); }
        if (IN(p + 4)) {
            unsigned char* wsq = args.ws; int l = l0; OPQ(wsq); OPQ(l); wsq = (unsigned char*)(GAS unsigned char*)wsq; unsigned char* wl = wsq + WS_W + (size_t)l * W_LAYER;
            pg8::Gemm g{(const h16*)args.out, (const h16*)(wl + W_OFF_OUT), 1024, 1024, 1024, M / 256, 4, 1, 0, PROBE_NOEPI(args.flags), 0};
            pg8::Order S; S.init(g.nM, g.nN, F.G, (int)blockIdx.x, 1);
            EpiRes E{(const h16*)(wsq + WS_X16), (h16*)(wsq + WS_X1), (float*)(wsq + WS_SSQ), (LAS float*)(F.lds + 131072)};
            pg8::gemm_phase<EpiRes>(F.lds, g, S, E, F.wave); SEAM(p + 4); }
        if (IN(p + 5)) {
            unsigned char* wsq = args.ws; int l = l0; OPQ(wsq); OPQ(l); wsq = (unsigned char*)(GAS unsigned char*)wsq; unsigned char* wl = wsq + WS_W + (size_t)l * W_LAYER;
            pg8::Gemm g{(const h16*)(wsq + WS_X1), (const h16*)(wl + W_OFF_GU), 1024, 1024, 1024, M / 256, NGU / 256, 1, 0, PROBE_NOEPI(args.flags), 0};
            pg8::Order S; S.init(g.nM, g.nN, F.G, (int)blockIdx.x, 1); EpiF E{wsq, (LAS float*)(F.lds + 131072 + 4096)};
            pg8::gemm_phase<EpiF>(F.lds, g, S, E, F.wave);
            { constexpr int NBIG = ((M / 256) * (NGU / 256)) % 256;
              if (l + 1 < NLAYER && (int)blockIdx.x >= NBIG && F.G == 256) convert_layer_weights(F, I, l + 1, ((int)blockIdx.x - NBIG) * NWAVES + F.wave, (256 - NBIG) * NWAVES, 0, CONV_IN_ITEMS);
              else if (l + 1 < NLAYER && F.G != 256) { xcd_barrier(bar, F.wave); convert_layer_weights(F, I, l + 1, F.vcu * NWAVES + F.wave, F.G * NWAVES, 0, CONV_IN_ITEMS); } }
            SEAM(p + 5); }
        if (IN(p + 6)) {
            unsigned char* wsq = args.ws; int l = l0; OPQ(wsq); OPQ(l); wsq = (unsigned char*)(GAS unsigned char*)wsq; unsigned char* wl = wsq + WS_W + (size_t)l * W_LAYER;
            pg8::Gemm g{(const h16*)(wsq + WS_ACT), (const h16*)(wl + W_OFF_D), DFF, DFF, DFF, M / 256, 4, 1, 0, PROBE_NOEPI(args.flags), 0};
            pg8::Order S; S.init(g.nM, g.nN, F.G, (int)blockIdx.x, 1);
            if (FUSE_FINAL && l == NLAYER - 1 && F.G == 256) {
                EpiFinal E{(const h16*)(wsq + WS_X1), args.out, args.in.final_norm, (float*)(wsq + WS_SSQ), (unsigned*)(wsq + WS_CTL) + 8192, (LAS float*)(F.lds + 131072)};
                pg8::gemm_phase<EpiFinal>(F.lds, g, S, E, F.wave);
            } else {
                EpiRes E{(const h16*)(wsq + WS_X1), (h16*)(wsq + WS_X16), (float*)(wsq + WS_SSQ), (LAS float*)(F.lds + 131072)};
                pg8::gemm_phase<EpiRes>(F.lds, g, S, E, F.wave); SEAM(p + 6); } }
    }
    if (IN(N_PHASES - 1) && !(FUSE_FINAL && F.G == 256)) final_norm_phase(F, (const h16*)(args.ws + WS_X16), (const float*)(args.ws + WS_SSQ), args.out, I.final_norm);
#undef IN
#undef SEAM
}

extern "C" void kernel_launch(void* const* d_in, const int* in_sizes, int n_in, void* d_out, int out_size, void* d_ws, size_t ws_size, hipStream_t stream) {
    static int grid = 0;
    if (grid == 0) {
        if (n_in != 19 || out_size != M * DM || ws_size < WS_END) { fprintf(stderr, "kernel_launch: unexpected shapes (n_in %d out %d ws %zu)\n", n_in, out_size, ws_size); grid = -1; return; }
        int dev = 0, cus = 0, per_cu = 0;
        hipGetDevice(&dev); hipDeviceGetAttribute(&cus, hipDeviceAttributeMultiprocessorCount, dev);
        hipFuncSetAttribute((const void*)mk_fwd, hipFuncAttributeMaxDynamicSharedMemorySize, LDS_BYTES);
        hipOccupancyMaxActiveBlocksPerMultiprocessor(&per_cu, (const void*)mk_fwd, NTHREADS, LDS_BYTES);
        (void)hipGetLastError();
        if (per_cu < 1) fprintf(stderr, "kernel_launch: occupancy query reports %d blocks per CU\n", per_cu);
        grid = cus < 256 ? cus : 256;
        if (grid != 256) fprintf(stderr, "kernel_launch: %d CUs: this kernel's work split assumes 256 workgroups\n", cus);
    }
    if (grid < 0) return;
    hipMemsetAsync((char*)d_ws + WS_CTL, 0, CTL_ZERO_BYTES, stream);
    Args a{};
    const void** ip = (const void**)&a.in;
    for (int i = 0; i < 19; ++i) ip[i] = d_in[i];
    a.out = (float*)d_out; a.ws = (unsigned char*)d_ws;
#if MK_N_LAUNCHES == 1
    a.ph_lo = 0; a.ph_hi = N_PHASES;
    { void* kargs[] = {&a}; hipError_t e = hipLaunchCooperativeKernel((const void*)mk_fwd, dim3(grid), dim3(NTHREADS), kargs, LDS_BYTES, stream);
      if (e != hipSuccess) fprintf(stderr, "cooperative launch failed: %s (grid %d)\n", hipGetErrorString(e), grid); }
#else
    for (int p = 0; p < N_PHASES; ++p) { const int reps = ((PROBE_MASK >> p) & 1u) ? 2 : 1;
        for (int rr = 0; rr < reps; ++rr) { a.ph_lo = p; a.ph_hi = p + 1; a.flags = (rr > 0) ? 1 : 0; hipLaunchKernelGGL(mk_fwd, dim3(grid), dim3(NTHREADS), LDS_BYTES, stream, a); } }
#endif
}
```

```cpp
#define MK_N_LAUNCHES 1
#include <hip/hip_runtime.h>
#include <stdint.h>
#include <math.h>
#include <cstdio>

#define LAS __attribute__((address_space(3)))
#define GAS __attribute__((address_space(1)))
typedef _Float16 h16;
typedef h16 h16x8 __attribute__((ext_vector_type(8)));
typedef h16 h16x4 __attribute__((ext_vector_type(4)));
typedef h16 h16x2 __attribute__((ext_vector_type(2)));
typedef float f32x2 __attribute__((ext_vector_type(2)));
typedef float f32x4 __attribute__((ext_vector_type(4)));
typedef float f32x16 __attribute__((ext_vector_type(16)));
typedef unsigned u32x2 __attribute__((ext_vector_type(2)));
typedef unsigned u32x4 __attribute__((ext_vector_type(4)));
typedef short v4i16_t __attribute__((ext_vector_type(4)));

__device__ __forceinline__ int lane_id() { return (int)__builtin_amdgcn_mbcnt_hi(~0u, __builtin_amdgcn_mbcnt_lo(~0u, 0u)); }
__device__ __forceinline__ unsigned pkh(float lo, float hi) { h16x2 v = {(h16)lo, (h16)hi}; return __builtin_bit_cast(unsigned, v); }
__device__ __forceinline__ unsigned pkz(float lo, float hi) { return __builtin_bit_cast(unsigned, __builtin_amdgcn_cvt_pkrtz(lo, hi)); }
__device__ __forceinline__ void store16_wt(void* p, u32x4 v) { asm volatile("global_store_dwordx4 %0, %1, off sc1\n\ts_nop 1" :: "v"(p), "v"(v) : "memory"); }
__device__ __forceinline__ float h2f_lo(unsigned u) { h16x2 v = __builtin_bit_cast(h16x2, u); return (float)v[0]; }
__device__ __forceinline__ float h2f_hi(unsigned u) { h16x2 v = __builtin_bit_cast(h16x2, u); return (float)v[1]; }

namespace pg8 {
constexpr int BM = 256, BK = 64, HALF = 128, HTB = HALF * BK * 2, STAGE_BYTES = 8 * HTB, NXCD = 8, WGM = 4;
__host__ __device__ __forceinline__ int lds_byte(int r, int c) { const int st = (r >> 4) * 2 + (c >> 5), rr = r & 15, cc = c & 31, ob = rr * 64 + cc * 2; return st * 1024 + (ob ^ (((ob >> 9) & 1) << 5)); }
__host__ __device__ __forceinline__ void stage_rc(int b, int& R, int& C) { const int st = b / 1024, sb = b % 1024, swz = sb ^ (((sb >> 9) & 1) << 5); R = (st >> 1) * 16 + swz / 64; C = (st & 1) * 32 + (swz % 64) / 2; }
__host__ __device__ __forceinline__ int perm32(int rho) { const int n = rho >> 4, i = rho & 15; return 8 * (i >> 2) + 4 * n + (i & 3); }

struct Unit { int pm, pn, kind, half; };
struct Gemm { const h16* A; const h16* Bt; int lda, ldb, K, nM, nN, nkind, koff, noepi, stagger; };

struct Order {
    int nM, nN, nwg, G, c, nk, lim;
    __device__ void init(int nM_, int nN_, int G_, int c_, int nk_, int lim_ = -1) { asm volatile("" : "+s"(G_), "+s"(c_)); nM = nM_; nN = nN_; nwg = nM * nN; G = G_; c = c_; nk = nk_; lim = lim_ < 0 ? nwg : lim_; }
    __device__ void tile_of(int L, Unit& u) const {
        int wgid = L; { const int q = nwg / NXCD, r = nwg % NXCD, xcd = wgid % NXCD, off = wgid / NXCD; wgid = (xcd < r ? xcd * (q + 1) : r * (q + 1) + (xcd - r) * q) + off; }
        const int nig = WGM * nN, gid = wgid / nig, fm = gid * WGM, gsz = (nM - fm) < WGM ? (nM - fm) : WGM;
        u.pm = fm + ((wgid % nig) % gsz); u.pn = (wgid % nig) / gsz;
    }
    __device__ bool next(int i, Unit& u) const {
        const int ti = i / nk; u.kind = i - ti * nk; u.half = -1;
        const long L = (long)ti * G + c; if (L >= lim) return false;
        tile_of((int)L, u); return true;
    }
};

template <class Epi>
__device__ __forceinline__ void gemm_phase(LAS unsigned char* lds, const Gemm g, const Order& S, const Epi& E, int wave_) {
    int tid = wave_ * 64 + lane_id(); asm volatile("" : "+v"(tid));
    const int wid = __builtin_amdgcn_readfirstlane(tid >> 6), lane = tid & 63, wr = wid >> 2, wc = wid & 3, fr = lane & 15, fq = lane >> 4;
    const int nt = g.K / BK;
    unsigned voffA[2], voffB[2];
#pragma unroll
    for (int i = 0; i < 2; ++i) { int R, C; stage_rc(tid * 16 + i * 8192, R, C); const int Rb = Epi::PERM ? ((R & ~31) + perm32(R & 31)) : R;
        voffA[i] = (unsigned)(R * g.lda + C) * 2u; voffB[i] = (unsigned)(Rb * g.ldb + C) * 2u; }
    const size_t kstep = (size_t)(BK * 2);
    const size_t hstepA = (size_t)HALF * g.lda * 2, hstepB = (size_t)HALF * g.ldb * 2;
    const unsigned ldsw = (unsigned)wid * 1024u;
    const int aoff = lds_byte(wr * 64 + fr, fq * 8), boff = lds_byte(wc * 32 + fr, fq * 8);
#define PG8_SA(b, h) (((b) * 2 + (h)) * HTB)
#define PG8_SB(b, h) ((4 + (b) * 2 + (h)) * HTB)
#define PG8_STAGE(bufoff, gbase, voff) do { _Pragma("unroll") for (int _i = 0; _i < 2; ++_i) \
        __builtin_amdgcn_global_load_lds((const unsigned*)((const char*)(gbase) + (voff)[_i]), (LAS unsigned*)(lds + (bufoff) + ldsw + _i * 8192), 16, 0, 0); } while (0)
#define PG8_LDA(dst, b, h) do { _Pragma("unroll") for (int m = 0; m < 4; ++m) _Pragma("unroll") for (int k = 0; k < 2; ++k) dst[m][k] = *(const LAS h16x8*)(lds + PG8_SA(b, h) + aoff + m * 2048 + k * 1024); } while (0)
#define PG8_LDB(dst, b, h) do { _Pragma("unroll") for (int n = 0; n < 2; ++n) _Pragma("unroll") for (int k = 0; k < 2; ++k) dst[n][k] = *(const LAS h16x8*)(lds + PG8_SB(b, h) + boff + n * 2048 + k * 1024); } while (0)
#define PG8_MMA(ai, bj, At, Bt) do { __builtin_amdgcn_s_setprio(1); _Pragma("unroll") for (int m = 0; m < 4; ++m) _Pragma("unroll") for (int n = 0; n < 2; ++n) _Pragma("unroll") for (int k = 0; k < 2; ++k) \
        acc[ai][bj][m][n] = __builtin_amdgcn_mfma_f32_16x16x32_f16(Bt[n][k], At[m][k], acc[ai][bj][m][n], 0, 0, 0); __builtin_amdgcn_s_setprio(0); } while (0)
#define PG8_WAIT_V(n) asm volatile("s_waitcnt vmcnt(" #n ")" ::: "memory")
#define PG8_WAIT_L(n) asm volatile("s_waitcnt lgkmcnt(" #n ")" ::: "memory")
#define PG8_BAR __builtin_amdgcn_s_barrier()
#define PG8_SCHED __builtin_amdgcn_sched_barrier(0)
#define PG8_PA(u) ((const char*)g.A + ((size_t)(u).pm * 256 * g.lda + (size_t)(u).kind * g.koff) * 2)
#define PG8_PB(u) ((const char*)g.Bt + ((size_t)(u).pn * 256 * g.ldb + (size_t)(u).kind * g.koff) * 2)
    Unit cur, nxt; int ui = 0;
    if (!S.next(0, cur)) return;
    { const int nbig = S.nwg % S.G;
      if (nbig > 0 && S.c >= nbig && g.stagger) { const int ngrp = S.G / nbig, j = S.c / nbig; const unsigned long long dl = (unsigned long long)((g.K / BK) * 140 + 100) * S.nk * j / ngrp;
          const unsigned long long t0 = __builtin_amdgcn_s_memrealtime(); while (__builtin_amdgcn_s_memrealtime() - t0 < dl) __builtin_amdgcn_s_sleep(32); } }
    f32x4 acc[2][2][4][2];
#pragma unroll
    for (int a = 0; a < 2; ++a)
#pragma unroll
        for (int b = 0; b < 2; ++b)
#pragma unroll
            for (int m = 0; m < 4; ++m)
#pragma unroll
                for (int n = 0; n < 2; ++n) acc[a][b][m][n] = (f32x4){0.f, 0.f, 0.f, 0.f};
    h16x8 At[4][2], B0[2][2], B1[2][2];
    const char* cA = PG8_PA(cur); const char* cB = PG8_PB(cur);
    E.prefetch(cur, wid, lane);
    PG8_STAGE(PG8_SB(0, 0), cB, voffB); PG8_STAGE(PG8_SB(0, 1), cB + hstepB, voffB); PG8_STAGE(PG8_SA(0, 0), cA, voffA); PG8_STAGE(PG8_SA(0, 1), cA + hstepA, voffA);
    if (wr == 1) PG8_BAR;
    PG8_WAIT_V(2); PG8_BAR;
    PG8_STAGE(PG8_SB(1, 0), cB + kstep, voffB); PG8_STAGE(PG8_SA(1, 0), cA + kstep, voffA); PG8_STAGE(PG8_SB(1, 1), cB + hstepB + kstep, voffB);
    PG8_WAIT_V(6); PG8_BAR;
    for (;;) {
        const bool has_next = S.next(ui + 1, nxt);
        const char* nA = has_next ? PG8_PA(nxt) : cA; const char* nB = has_next ? PG8_PB(nxt) : cB;
        for (int t = 0; t < nt; t += 2) {
            const bool last = (t == nt - 2);
            const char* a1 = cA + (size_t)(t + 1) * kstep;
            const char* a2 = last ? nA : cA + (size_t)(t + 2) * kstep; const char* b2 = last ? nB : cB + (size_t)(t + 2) * kstep;
            const char* a3 = a2 + kstep; const char* b3 = b2 + kstep;
            PG8_LDB(B0, 0, 0); PG8_LDB(B1, 0, 1); PG8_SCHED; PG8_LDA(At, 0, 0); PG8_STAGE(PG8_SA(1, 1), a1 + hstepA, voffA);
            PG8_WAIT_V(8); PG8_WAIT_L(0); PG8_BAR; PG8_MMA(0, 0, At, B0); PG8_MMA(0, 1, At, B1); PG8_BAR; PG8_SCHED;
            PG8_LDA(At, 0, 1); PG8_STAGE(PG8_SB(0, 0), b2, voffB); PG8_STAGE(PG8_SB(0, 1), b2 + hstepB, voffB); PG8_STAGE(PG8_SA(0, 0), a2, voffA);
            PG8_WAIT_V(8); PG8_WAIT_L(0); PG8_BAR; PG8_MMA(1, 0, At, B0); PG8_MMA(1, 1, At, B1); PG8_BAR; PG8_SCHED;
            PG8_LDB(B0, 1, 0); PG8_LDB(B1, 1, 1); PG8_SCHED; PG8_LDA(At, 1, 0); PG8_STAGE(PG8_SA(0, 1), a2 + hstepA, voffA);
            PG8_WAIT_V(8); PG8_WAIT_L(0); PG8_BAR; PG8_MMA(0, 0, At, B0); PG8_MMA(0, 1, At, B1); PG8_BAR; PG8_SCHED;
            PG8_LDA(At, 1, 1); PG8_STAGE(PG8_SB(1, 0), b3, voffB); PG8_STAGE(PG8_SB(1, 1), b3 + hstepB, voffB); PG8_STAGE(PG8_SA(1, 0), a3, voffA);
            PG8_WAIT_V(8); PG8_WAIT_L(0); PG8_BAR; PG8_MMA(1, 0, At, B0); PG8_MMA(1, 1, At, B1); PG8_BAR; PG8_SCHED;
        }
        if (wr == 0) PG8_BAR;
        { int fr_ = fr, fq_ = fq; asm volatile("" : "+v"(fr_), "+v"(fq_)); if (!g.noepi) E(acc, cur, wr, wc, fr_, fq_); }
        if (!has_next) break;
        if (nxt.kind == 0) {
#pragma unroll
            for (int a = 0; a < 2; ++a)
#pragma unroll
                for (int b = 0; b < 2; ++b)
#pragma unroll
                    for (int m = 0; m < 4; ++m)
#pragma unroll
                        for (int n = 0; n < 2; ++n) acc[a][b][m][n] = (f32x4){0.f, 0.f, 0.f, 0.f};
        }
        cur = nxt; cA = nA; cB = nB; ++ui;
        if (cur.kind == 0) E.prefetch(cur, wid, lane);
        if (wr == 1) PG8_BAR;
    }
    PG8_WAIT_V(0);
    PG8_BAR;
#undef PG8_SA
#undef PG8_SB
#undef PG8_STAGE
#undef PG8_LDA
#undef PG8_LDB
#undef PG8_MMA
#undef PG8_WAIT_V
#undef PG8_WAIT_L
#undef PG8_BAR
#undef PG8_SCHED
#undef PG8_PA
#undef PG8_PB
}

template <class Epi>
__device__ __forceinline__ void gemm_tail_phase(LAS unsigned char* lds, const Gemm g, const Order& S, const Epi& E, int wave_) {
    const int ntail = S.nwg - S.lim;
    if (ntail <= 0 || S.c >= 2 * ntail) return;
    int tid = wave_ * 64 + lane_id(); asm volatile("" : "+v"(tid));
    const int wid = __builtin_amdgcn_readfirstlane(tid >> 6), lane = tid & 63, wr = wid >> 2, wc = wid & 3, fr = lane & 15, fq = lane >> 4;
    Unit cur; S.tile_of(S.lim + S.c % ntail, cur); cur.kind = 0; cur.half = S.c / ntail;
    const int nt = g.K / BK;
    unsigned voffA[2], voffB[2];
#pragma unroll
    for (int i = 0; i < 2; ++i) { int R, C; stage_rc(tid * 16 + i * 8192, R, C); const int Rb = Epi::PERM ? ((R & ~31) + perm32(R & 31)) : R;
        voffA[i] = (unsigned)(R * g.lda + C) * 2u; voffB[i] = (unsigned)(Rb * g.ldb + C) * 2u; }
    const size_t kstep = (size_t)(BK * 2);
    const size_t hstepA = (size_t)HALF * g.lda * 2, hstepB = (size_t)HALF * g.ldb * 2;
    const unsigned ldsw = (unsigned)wid * 1024u;
    const int aoff = lds_byte(wr * 64 + fr, fq * 8), boff = lds_byte(wc * 32 + fr, fq * 8);
    constexpr int TSTG = 3 * HTB;
    const char* cA = (const char*)g.A + ((size_t)cur.pm * 256 * g.lda) * 2 + (size_t)cur.half * hstepA; const char* cB = (const char*)g.Bt + ((size_t)cur.pn * 256 * g.ldb) * 2;
#define PT_STAGE(bufoff, gbase, voff) do { _Pragma("unroll") for (int _i = 0; _i < 2; ++_i) \
        __builtin_amdgcn_global_load_lds((const unsigned*)((const char*)(gbase) + (voff)[_i]), (LAS unsigned*)(lds + (bufoff) + ldsw + _i * 8192), 16, 0, 0); } while (0)
#define PT_STAGE_TILE(kt) do { const int so_ = ((kt) % 3) * TSTG; const char* a_ = cA + (size_t)(kt) * kstep; const char* b_ = cB + (size_t)(kt) * kstep; \
        PT_STAGE(so_, a_, voffA); PT_STAGE(so_ + HTB, b_, voffB); PT_STAGE(so_ + 2 * HTB, b_ + hstepB, voffB); } while (0)
#define PT_LD(kt) do { const int so_ = ((kt) % 3) * TSTG; \
        _Pragma("unroll") for (int n = 0; n < 2; ++n) _Pragma("unroll") for (int k_ = 0; k_ < 2; ++k_) { B0[n][k_] = *(const LAS h16x8*)(lds + so_ + HTB + boff + n * 2048 + k_ * 1024); B1[n][k_] = *(const LAS h16x8*)(lds + so_ + 2 * HTB + boff + n * 2048 + k_ * 1024); } \
        _Pragma("unroll") for (int m = 0; m < 4; ++m) _Pragma("unroll") for (int k_ = 0; k_ < 2; ++k_) At[m][k_] = *(const LAS h16x8*)(lds + so_ + aoff + m * 2048 + k_ * 1024); } while (0)
#define PT_MMA(bj, Bt_) do { __builtin_amdgcn_s_setprio(1); _Pragma("unroll") for (int m = 0; m < 4; ++m) _Pragma("unroll") for (int n = 0; n < 2; ++n) _Pragma("unroll") for (int k_ = 0; k_ < 2; ++k_) \
        acc[0][bj][m][n] = __builtin_amdgcn_mfma_f32_16x16x32_f16(Bt_[n][k_], At[m][k_], acc[0][bj][m][n], 0, 0, 0); __builtin_amdgcn_s_setprio(0); } while (0)
#define PT_WAIT_V(n) asm volatile("s_waitcnt vmcnt(" #n ")" ::: "memory")
#define PT_WAIT_L0 asm volatile("s_waitcnt lgkmcnt(0)" ::: "memory")
#define PT_BAR __builtin_amdgcn_s_barrier()
    f32x4 acc[2][2][4][2];
#pragma unroll
    for (int a = 0; a < 2; ++a)
#pragma unroll
        for (int b = 0; b < 2; ++b)
#pragma unroll
            for (int m = 0; m < 4; ++m)
#pragma unroll
                for (int n = 0; n < 2; ++n) acc[a][b][m][n] = (f32x4){0.f, 0.f, 0.f, 0.f};
    h16x8 At[4][2], B0[2][2], B1[2][2];
    E.prefetch(cur, wid, lane);
    PT_STAGE_TILE(0); PT_STAGE_TILE(1); PT_STAGE_TILE(2);
    PT_WAIT_V(12); PT_BAR;
    if (wr == 1) PT_BAR;
    if (wr == 0) {
#pragma unroll 1
        for (int k = 0; k < nt; ++k) {
            if (k >= 1 && k + 2 < nt) PT_STAGE_TILE(k + 2);
            PT_LD(k); PT_WAIT_L0; PT_BAR;
            PT_MMA(0, B0); PT_MMA(1, B1);
            if (k + 2 < nt) PT_WAIT_V(6); else PT_WAIT_V(0);
            PT_BAR; }
        PT_BAR;
    } else {
#pragma unroll 1
        for (int k = 0; k < nt; ++k) {
            if (k >= 1 && k + 2 < nt) PT_STAGE_TILE(k + 2);
            PT_LD(k); PT_WAIT_L0;
            if (k + 2 < nt) PT_WAIT_V(6); else PT_WAIT_V(0);
            PT_BAR;
            PT_MMA(0, B0); PT_MMA(1, B1);
            PT_BAR; }
    }
    { int fr_ = fr, fq_ = fq; asm volatile("" : "+v"(fr_), "+v"(fq_)); if (!g.noepi) E(acc, cur, wr, wc, fr_, fq_); }
#undef PT_STAGE
#undef PT_STAGE_TILE
#undef PT_LD
#undef PT_MMA
#undef PT_WAIT_V
#undef PT_WAIT_L0
#undef PT_BAR
}
}
constexpr int NWAVES = 8, NTHREADS = 512;
constexpr int NB = 8, SEQ = 2048, DM = 1024, M = NB * SEQ, DIN = 4312, DFF = 2816, NLAYER = 2;
constexpr int NZ = 4352;
constexpr int NGU = 2 * DFF;
constexpr float EPS_RMS = 1e-6f;
constexpr float LOG2E = 1.4426950408889634f;
constexpr float QSCALE = 0.125f * LOG2E;
constexpr int KVP = 152;

constexpr size_t MiB = 1u << 20;
constexpr size_t WS_CTL = 0, CTL_ZERO_BYTES = 65536;
constexpr size_t WS_CS = 1 * MiB;
constexpr size_t WS_SSQ = 2 * MiB;
constexpr size_t WS_WI = 3 * MiB;
constexpr size_t WS_SMALLW = 4 * MiB;
constexpr size_t SMALLW_LAYER = 98304 + 131072 + 262144;
constexpr size_t WS_W = 6 * MiB;
constexpr size_t W_LAYER = 29 * MiB, W_OFF_IN = 0, W_OFF_PAB = (size_t)NZ * 1024 * 2, W_OFF_OUT = W_OFF_PAB + 2 * MiB, W_OFF_GU = W_OFF_OUT + 2 * MiB, W_OFF_D = W_OFF_GU + (size_t)NGU * 1024 * 2;
static_assert(W_OFF_D + (size_t)1024 * DFF * 2 == W_LAYER, "weight map");
constexpr size_t WS_X16 = 64 * MiB;
constexpr size_t WS_QY = 96 * MiB;
constexpr size_t WS_QI = 128 * MiB;
constexpr size_t WS_MISC = 144 * MiB;
constexpr size_t WS_KV = 152 * MiB;
constexpr size_t WS_KI = 157 * MiB;
constexpr size_t WS_X1 = 128 * MiB;
constexpr size_t WS_GATES = 160 * MiB;
constexpr size_t WS_UV = 224 * MiB;
constexpr size_t WS_ACT = 160 * MiB;
constexpr size_t WS_END = 256 * MiB;
static_assert(WS_KV + (size_t)M * KVP * 2 <= WS_KI && WS_KI + (size_t)M * 64 * 2 <= WS_GATES && WS_ACT + (size_t)M * DFF * 2 <= WS_END, "ws map");

constexpr int LDS_BYTES = 155648;
constexpr int LDS_MISC = 151552;

#define RLX_AGENT __ATOMIC_RELAXED, __HIP_MEMORY_SCOPE_AGENT
#define LDS_WAIT() asm volatile("s_waitcnt lgkmcnt(0)" ::: "memory")
#define VM_WAIT() asm volatile("s_waitcnt vmcnt(0)" ::: "memory")

#define XB_TMO      128
#define XB_XCNT(j)  (256  + 64 * (j))
#define XB_XSUB(j)  (1280 + 64 * (j))
#define XB_XGEN(j)  (2304 + 64 * (j))
#define XB_TOP      3328
#define XB_TOPGEN   3392
#define XCD_BAR_WORDS 3456
#define XB_SPIN_CAP (1u << 18)
__device__ __forceinline__ unsigned xb_ld(unsigned* p)              { return __hip_atomic_load(p, __ATOMIC_RELAXED, __HIP_MEMORY_SCOPE_AGENT); }
__device__ __forceinline__ unsigned xb_add(unsigned* p, unsigned v) { return __hip_atomic_fetch_add(p, v, __ATOMIC_RELAXED, __HIP_MEMORY_SCOPE_AGENT); }
__device__ __forceinline__ unsigned xb_xcc_id() { return (unsigned)__builtin_amdgcn_s_getreg((3 << 11) | 20) & 0xFu; }
#define XB_SPIN(cond, bar) do { unsigned _sp = 0; while (cond) { __builtin_amdgcn_s_sleep(1); \
    if ((++_sp & 255u) == 0u) { if (xb_ld(&(bar)[XB_TMO])) break; if (_sp > XB_SPIN_CAP) { atomicAdd(&(bar)[XB_TMO], 1u); break; } } } } while (0)
struct XcdBarrier { unsigned* bar; unsigned x; volatile LAS unsigned* st; };
__device__ __forceinline__ XcdBarrier xcd_barrier_post(unsigned* bar, volatile LAS unsigned* st, int wave_) {
    XcdBarrier b; b.bar = bar; b.x = xb_xcc_id(); b.st = st;
    if (wave_ == 0 && lane_id() == 0) (void)xb_add(&bar[XB_XCNT(b.x)], 1u);
    return b;
}
__device__ __forceinline__ void xcd_barrier_complete(unsigned* bar, unsigned x, unsigned& nloc, unsigned& nx) {
    const unsigned G = gridDim.x * gridDim.y * gridDim.z;
    unsigned sum, cnt, mine, sp = 0u;
    for (;;) {
        sum = 0u; cnt = 0u; mine = 0u;
#pragma unroll
        for (unsigned j = 0; j < 16; ++j) { const unsigned c = xb_ld(&bar[XB_XCNT(j)]); sum += c; cnt += (c > 0u) ? 1u : 0u; }
        mine = xb_ld(&bar[XB_XCNT(x)]);
        if (sum == G) break;
        __builtin_amdgcn_s_sleep(1);
        if ((++sp & 255u) == 0u) { if (xb_ld(&bar[XB_TMO])) break; if (sp > XB_SPIN_CAP) { atomicAdd(&bar[XB_TMO], 1u); break; } }
    }
    nloc = mine > 0u ? mine : 1u; nx = cnt > 0u ? cnt : 1u;
}
__device__ __forceinline__ void xcd_barrier(const XcdBarrier& b, int wave_) {
    asm volatile("s_waitcnt vmcnt(0)" ::: "memory");
    __syncthreads();
    if (wave_ == 0 && lane_id() == 0) {
        unsigned* bar = b.bar; asm volatile("" : "+s"(bar));
        unsigned stoff = (unsigned)(uintptr_t)b.st; asm volatile("" : "+s"(stoff)); volatile LAS unsigned* st = (volatile LAS unsigned*)(uintptr_t)stoff;
        const unsigned x = xb_xcc_id();
        __builtin_amdgcn_s_waitcnt(0);
        unsigned nloc = st[0], nx = st[1];
        if (nloc == 0u) { xcd_barrier_complete(bar, x, nloc, nx); st[0] = nloc; st[1] = nx; }
        const unsigned old = xb_add(&bar[XB_XSUB(x)], 1u);
        const unsigned gen = old / nloc;
        if (old + 1u == (gen + 1u) * nloc) {
            __builtin_amdgcn_fence(__ATOMIC_RELEASE, "agent");
            asm volatile("s_waitcnt vmcnt(0)" ::: "memory");
            const unsigned og = xb_add(&bar[XB_TOP], 1u);
            const unsigned tg = og / nx;
            if (og + 1u == (tg + 1u) * nx) xb_add(&bar[XB_TOPGEN], 1u);
            else XB_SPIN(xb_ld(&bar[XB_TOPGEN]) == tg, bar);
            __builtin_amdgcn_fence(__ATOMIC_ACQUIRE, "agent");
            asm volatile("s_waitcnt vmcnt(0)" ::: "memory");
        } else {
            XB_SPIN(xb_ld(&bar[XB_TOPGEN]) == gen, bar);
            __builtin_amdgcn_fence(__ATOMIC_ACQUIRE, "agent");
            asm volatile("s_waitcnt vmcnt(0)" ::: "memory");
        }
    }
    __syncthreads();
}

__device__ __forceinline__ float gelu_tanh_f(float x) {
    const float u = 0.7978845608028654f * (x + 0.044715f * x * x * x);
    const float e = __builtin_amdgcn_exp2f(-2.0f * LOG2E * u);
    return x * __builtin_amdgcn_rcpf(1.0f + e);
}
__device__ __forceinline__ float sigmoid_f(float x) { return __builtin_amdgcn_rcpf(1.0f + __builtin_amdgcn_exp2f(-LOG2E * x)); }

struct Frame {
    LAS unsigned char* lds;
    int wave, vcu, G;
    unsigned char* ws;
    const float* const* in;
};
struct In {
    const float* x; const int* pos; const float* norm_mix; const float* w_in; const float* kv_norm; const float* w_uk; const float* w_uv; const float* ln_v_g; const float* ln_v_b;
    const float* w_s; const float* b_s; const float* w_proj_a; const float* w_proj_b; const float* w_out; const float* norm_ffn; const float* w_gate; const float* w_up; const float* w_down; const float* final_norm;
};

__device__ __constant__ float c_inv[8] = {1.0f, 0.19392274474868576f, 0.03760603093086393f, 0.007292664737217109f, 0.001414213562373095f, 0.0002742481756762073f, 5.318295896944988e-05f, 1.031338537721246e-05f};

__device__ __forceinline__ void transpose_item64(const float* W4, int Nsrc, h16* WT, int ldt, int n0, int k0, const float* gain, LAS float* scr, int lane) {
    const int nq = lane & 15, kq = lane >> 4;
    f32x4 v[16];
#pragma unroll
    for (int i = 0; i < 16; ++i) v[i] = W4 ? *(const GAS f32x4*)(W4 + (size_t)(k0 + 4 * i + kq) * Nsrc) : (f32x4){0.f, 0.f, 0.f, 0.f};
#pragma unroll
    for (int i = 0; i < 16; ++i) { const int kk = 4 * i + kq; f32x4 x = v[i]; if (gain) x = x * gain[k0 + kk]; *(LAS f32x4*)(scr + kk * 68 + 4 * (nq ^ (kk >> 3))) = x; }
    LDS_WAIT(); asm volatile("" ::: "memory");
    const int c = lane & 7;
#pragma unroll
    for (int j = 0; j < 8; ++j) { const int n = (lane >> 3) + 8 * j; const LAS float* sp = scr + (8 * c) * 68 + 4 * ((n >> 2) ^ c) + (n & 3);
        u32x4 o; o.x = pkh(sp[0 * 68], sp[1 * 68]); o.y = pkh(sp[2 * 68], sp[3 * 68]); o.z = pkh(sp[4 * 68], sp[5 * 68]); o.w = pkh(sp[6 * 68], sp[7 * 68]);
        *(GAS u32x4*)(WT + (size_t)(n0 + n) * ldt + k0 + 8 * c) = o; }
    LDS_WAIT(); asm volatile("" ::: "memory");
}
__device__ __forceinline__ int win_src_col(int n) {
    if (n < 512) return n;
    if (n < 1024) return 656 + (n - 512);
    if (n < 2048) return 1240 + (n - 1024);
    if (n < 4096) return 2264 + (n - 2048);
    if (n < 4224) return 512 + (n - 4096);
    if (n < 4240) return 640 + (n - 4224);
    if (n < 4304) return 1168 + (n - 4240);
    if (n < 4312) return 1232 + (n - 4304);
    return -1;
}
constexpr int CONV_IN_ITEMS = (NZ / 64) * 16;
__device__ __forceinline__ void convert_layer_weights(const Frame& F, const In& I, int l, int gw, int NGW, int it_lo = 0, int it_hi = 1 << 30) {
    LAS float* scr = (LAS float*)(F.lds + F.wave * 17408);
    int lane = lane_id(); asm volatile("" : "+v"(lane));
    constexpr int I_IN = (NZ / 64) * 16, I_PA = 16 * 8, I_OUT = 16 * 16, I_GU = (NGU / 64) * 16, I_D = 16 * (DFF / 64);
    constexpr int I_LAYER = I_IN + 2 * I_PA + I_OUT + I_GU + I_D;
    const int n4 = 4 * (lane & 15);
    unsigned char* wl = F.ws + WS_W + (size_t)l * W_LAYER;
    if (it_hi > I_LAYER) it_hi = I_LAYER;
    for (int it = it_lo + gw; it < it_hi; it += NGW) {
        int r = it;
        if (r < I_IN) { const int nb = r / 16, kb = r % 16, sc = win_src_col(nb * 64 + n4);
            transpose_item64(sc >= 0 ? I.w_in + (size_t)l * DM * DIN + sc : nullptr, DIN, (h16*)(wl + W_OFF_IN), 1024, nb * 64, kb * 64, I.norm_mix + l * DM, scr, lane); continue; }
        r -= I_IN;
        if (r < I_PA) { const int nb = r / 8, kb = r % 8;
            transpose_item64(I.w_proj_a + (size_t)l * 512 * 1024 + nb * 64 + n4, 1024, (h16*)(wl + W_OFF_PAB), 1024, nb * 64, kb * 64, nullptr, scr, lane); continue; }
        r -= I_PA;
        if (r < I_PA) { const int nb = r / 8, kb = r % 8;
            transpose_item64(I.w_proj_b + (size_t)l * 512 * 1024 + nb * 64 + n4, 1024, (h16*)(wl + W_OFF_PAB) + 512, 1024, nb * 64, kb * 64, nullptr, scr, lane); continue; }
        r -= I_PA;
        if (r < I_OUT) { const int nb = r / 16, kb = r % 16;
            transpose_item64(I.w_out + (size_t)l * 1024 * 1024 + nb * 64 + n4, 1024, (h16*)(wl + W_OFF_OUT), 1024, nb * 64, kb * 64, nullptr, scr, lane); continue; }
        r -= I_OUT;
        if (r < I_GU) { const int nb = r / 16, kb = r % 16, R = nb * 64 + n4, pn = R >> 8, rem = R & 255;
            const int a = 128 * pn + 64 * (rem >> 7) + 16 * ((rem >> 5) & 3) + 4 * ((rem >> 3) & 3);
            const float* src = (((rem >> 2) & 1) ? I.w_up : I.w_gate) + (size_t)l * DM * DFF + a;
            transpose_item64(src, DFF, (h16*)(wl + W_OFF_GU), 1024, nb * 64, kb * 64, I.norm_ffn + l * DM, scr, lane); continue; }
        r -= I_GU;
        { const int nb = r / (DFF / 64), kb = r % (DFF / 64);
            transpose_item64(I.w_down + (size_t)l * DFF * 1024 + nb * 64 + n4, 1024, (h16*)(wl + W_OFF_D), DFF, nb * 64, kb * 64, nullptr, scr, lane); }
    }
}
__device__ __forceinline__ void p0_prologue(const Frame& F, const In& I) {
    int lane = lane_id(); asm volatile("" : "+v"(lane));
    const int hw = F.wave & 3, gw = F.vcu * 4 + hw, NGW = F.G * 4;
    if (F.wave >= 4) {
    convert_layer_weights(F, I, 0, gw, NGW, 0, CONV_IN_ITEMS);
    const int gt = F.vcu * 256 + hw * 64 + lane, NGT = F.G * 256;
    for (int i0 = gt; i0 < NLAYER * 49152; i0 += 2 * NGT) { float va[2], vg[2];
#pragma unroll
        for (int u = 0; u < 2; ++u) { const int i = i0 + u * NGT; if (i < NLAYER * 49152) { const int l = i / 49152, e = i % 49152, h = e / (128 * 48), c = (e / 48) % 128, n = e % 48;
            va[u] = I.w_uk[(((size_t)l * 8 + h) * 48 + n) * 128 + c]; vg[u] = I.kv_norm[l * 128 + c]; } }
#pragma unroll
        for (int u = 0; u < 2; ++u) { const int i = i0 + u * NGT; if (i < NLAYER * 49152) { const int l = i / 49152, e = i % 49152;
            ((h16*)(F.ws + WS_SMALLW + (size_t)l * SMALLW_LAYER))[e] = (h16)(va[u] * vg[u]); } } }
    for (int i0 = gt; i0 < NLAYER * 65536; i0 += 2 * NGT) { float va[2], vg[2];
#pragma unroll
        for (int u = 0; u < 2; ++u) { const int i = i0 + u * NGT; if (i < NLAYER * 65536) { const int l = i / 65536, e = i % 65536, h = e / (64 * 128), d = (e / 128) % 64, c = e % 128;
            va[u] = I.w_uv[(((size_t)l * 8 + h) * 128 + c) * 64 + d]; vg[u] = I.kv_norm[l * 128 + c]; } }
#pragma unroll
        for (int u = 0; u < 2; ++u) { const int i = i0 + u * NGT; if (i < NLAYER * 65536) { const int l = i / 65536, e = i % 65536;
            ((h16*)(F.ws + WS_SMALLW + (size_t)l * SMALLW_LAYER + 98304))[e] = (h16)(va[u] * vg[u]); } } }
    for (int i0 = gt; i0 < NLAYER * 131072; i0 += 4 * NGT) { float va[4];
#pragma unroll
        for (int u = 0; u < 4; ++u) { const int i = i0 + u * NGT; if (i < NLAYER * 131072) va[u] = I.w_s[i]; }
#pragma unroll
        for (int u = 0; u < 4; ++u) { const int i = i0 + u * NGT; if (i < NLAYER * 131072) { const int l = i / 131072, e = i % 131072, t = (e / 128) % 128, sx = e % 128;
            ((h16*)(F.ws + WS_SMALLW + (size_t)l * SMALLW_LAYER + 98304 + 131072))[e] = (sx <= t) ? (h16)va[u] : (h16)0.f; } } }
    for (int i0 = gt; i0 < M * 8; i0 += 2 * NGT) { int pv[2];
#pragma unroll
        for (int u = 0; u < 2; ++u) { const int i = i0 + u * NGT; if (i < M * 8) pv[u] = I.pos[i >> 3]; }
#pragma unroll
        for (int u = 0; u < 2; ++u) { const int i = i0 + u * NGT; if (i < M * 8) { const int tok = i >> 3, f = i & 7; const float ang = (float)pv[u] * c_inv[f];
            float* cs = (float*)(F.ws + WS_CS) + (size_t)tok * 16; cs[f] = cosf(ang); cs[8 + f] = sinf(ang); } } }
    } else {
    for (int m = gw; m < M; m += 4 * NGW) {
        f32x4 v[4][4];
#pragma unroll
        for (int k = 0; k < 4; ++k) { const int mm = m + k * NGW; if (mm < M) { const f32x4* xr = (const f32x4*)(I.x + (size_t)mm * DM) + lane;
#pragma unroll
            for (int j = 0; j < 4; ++j) v[k][j] = xr[64 * j]; } }
#pragma unroll
        for (int k = 0; k < 4; ++k) { const int mm = m + k * NGW; if (mm < M) { u32x2* o8 = (u32x2*)((h16*)(F.ws + WS_X16) + (size_t)mm * DM) + lane; float s = 0.f;
#pragma unroll
            for (int j = 0; j < 4; ++j) { const f32x4 t = v[k][j]; s += (t.x * t.x + t.y * t.y) + (t.z * t.z + t.w * t.w); o8[64 * j] = (u32x2){pkh(t.x, t.y), pkh(t.z, t.w)}; }
            s += __shfl_xor(s, 1); s += __shfl_xor(s, 2); s += __shfl_xor(s, 4); s += __shfl_xor(s, 8);
            if ((lane & 15) == 0) ((GAS float*)(F.ws + WS_SSQ))[(size_t)mm * 4 + (lane >> 4)] = s; } }
    }
    }
}

__device__ __forceinline__ float row_rstd(const float* ssq, int row) {
    const f32x4 a = *(const GAS f32x4*)(ssq + (size_t)row * 4);
    return rsqrtf(((a.x + a.y) + (a.z + a.w)) * (1.0f / DM) + EPS_RMS);
}

typedef f32x4 Acc[2][2][4][2];
__device__ __forceinline__ u32x4 pack8h(const float (&v)[8]) { u32x4 w; w.x = pkz(v[0], v[1]); w.y = pkz(v[2], v[3]); w.z = pkz(v[4], v[5]); w.w = pkz(v[6], v[7]); return w; }
__device__ __forceinline__ u32x4 pack8r(const float (&v)[8]) { u32x4 w; w.x = pkh(v[0], v[1]); w.y = pkh(v[2], v[3]); w.z = pkh(v[4], v[5]); w.w = pkh(v[6], v[7]); return w; }

__device__ __forceinline__ void ssq_prefetch(const float* ssq, int pm, LAS float* R4, int wid, int lane) {
    if (wid < 4) __builtin_amdgcn_global_load_lds((const unsigned*)(ssq + (size_t)(pm * 256 + wid * 64 + lane) * 4), (LAS unsigned*)(R4 + wid * 256), 16, 0, 0);
}
__device__ __forceinline__ float rstd_from_lds(const LAS float* R4, int rl) { const f32x4 a = *(const LAS f32x4*)(R4 + rl * 4); return rsqrtf(((a.x + a.y) + (a.z + a.w)) * (1.0f / DM) + EPS_RMS); }
struct EpiA {
    static constexpr bool PERM = true;
    unsigned char* ws; int nostore; LAS float* R;
    __device__ __forceinline__ void prefetch(const pg8::Unit& u, int wid, int lane) const { ssq_prefetch((const float*)(ws + WS_SSQ), u.pm, R, wid, lane); }
    __device__ __forceinline__ void misc_tile(Acc& acc, const pg8::Unit& u, int wr, int wc, int fr, int fq) const {
        const int nai = u.half < 0 ? 2 : 1, rofs = u.half < 0 ? 0 : 128 * u.half;
        const unsigned row0 = (unsigned)(u.pm * 256 + rofs + wr * 64 + fr); LAS float* P = R - 1024;
        GAS unsigned char* wsg = (GAS unsigned char*)ws;
#pragma unroll
        for (int ai = 0; ai < 2; ++ai) if (ai < nai)
#pragma unroll
            for (int m = 0; m < 4; ++m) { const int rl = rofs + ai * 128 + wr * 64 + m * 16 + fr; const float rs = rstd_from_lds(R, rl); float ss = 0.f;
#pragma unroll
                for (int bj = 0; bj < 2; ++bj) { acc[ai][bj][m][0] *= rs; acc[ai][bj][m][1] *= rs; }
#pragma unroll
                for (int i = 0; i < 8; ++i) { const float z = acc[ai][0][m][i >> 2][i & 3]; ss = fmaf(z, z, ss); }
                ss += __shfl_xor(ss, 16); ss += __shfl_xor(ss, 32);
                if (fq == 0) P[rl * 4 + wc] = ss; }
        asm volatile("s_waitcnt lgkmcnt(0)" ::: "memory"); __builtin_amdgcn_s_barrier(); asm volatile("" ::: "memory");
#pragma unroll
        for (int ai = 0; ai < 2; ++ai) if (ai < nai)
#pragma unroll
            for (int m = 0; m < 4; ++m) { const int rl = rofs + ai * 128 + wr * 64 + m * 16 + fr; const unsigned row = row0 + (unsigned)(ai * 128 + m * 16);
                const f32x4 pv = *(const LAS f32x4*)(P + rl * 4); const float rk = rsqrtf(((pv.x + pv.y) + (pv.z + pv.w)) * (1.0f / 128.f) + EPS_RMS);
                { float o[8];
#pragma unroll
                  for (int i = 0; i < 8; ++i) o[i] = acc[ai][0][m][i >> 2][i & 3] * rk;
                  *(GAS u32x4*)(wsg + ((unsigned)WS_KV + row * (unsigned)(KVP * 2) + (unsigned)(wc * 64 + 16 * fq))) = pack8r(o); }
                if (wc == 0) {
                    const unsigned co = (unsigned)WS_CS + row * 64u;
                    const f32x4 c0 = *(const GAS f32x4*)(wsg + co), c1 = *(const GAS f32x4*)(wsg + co + 16u), s0 = *(const GAS f32x4*)(wsg + co + 32u), s1 = *(const GAS f32x4*)(wsg + co + 48u);
                    float o[8];
#pragma unroll
                    for (int i = 0; i < 8; ++i) { const float own = acc[ai][1][m][i >> 2][i & 3], oth = __shfl_xor(own, 16); const float c = i < 4 ? c0[i & 3] : c1[i & 3], sn = i < 4 ? s0[i & 3] : s1[i & 3];
                        o[i] = (fq & 1) ? (own * c + oth * sn) : (own * c - oth * sn); }
                    const unsigned dst = fq < 2 ? (unsigned)WS_KV + row * (unsigned)(KVP * 2) + 256u + 16u * (unsigned)fq : (unsigned)WS_KI + row * 128u + 16u * (unsigned)(fq - 2);
                    *(GAS u32x4*)(wsg + dst) = pack8r(o);
                } else if (wc == 1) {
                    float o[8];
#pragma unroll
                    for (int i = 0; i < 8; ++i) o[i] = acc[ai][1][m][i >> 2][i & 3];
                    *(GAS u32x4*)(wsg + ((unsigned)WS_KI + row * 128u + 32u + 16u * (unsigned)fq)) = pack8r(o);
                } else if (wc == 2) {
                    if (fq < 2) { float o[8];
#pragma unroll
                        for (int i = 0; i < 8; ++i) o[i] = acc[ai][1][m][i >> 2][i & 3];
                        *(GAS u32x4*)(wsg + ((unsigned)WS_KI + row * 128u + 96u + 16u * (unsigned)fq)) = pack8r(o); }
                    else if (fq == 2) { const float sc = 0.35355339059327373f * 0.125f; const unsigned wo = (unsigned)WS_WI + row * 32u;
                        *(GAS f32x4*)(wsg + wo) = acc[ai][1][m][0] * sc; *(GAS f32x4*)(wsg + wo + 16u) = acc[ai][1][m][1] * sc; }
                    else { u32x4 z4 = {0u, 0u, 0u, 0u}; asm volatile("" : "+v"(z4)); *(GAS u32x4*)(wsg + ((unsigned)WS_KV + row * (unsigned)(KVP * 2) + 288u)) = z4; }
                } }
        asm volatile("s_waitcnt lgkmcnt(0)" ::: "memory"); __builtin_amdgcn_s_barrier(); asm volatile("" ::: "memory");
    }
    __device__ __forceinline__ void operator()(Acc& acc, const pg8::Unit& u, int wr, int wc, int fr, int fq) const {
        const int pn = u.pn; h16* base; int ldc, colt;
        if (pn == 16) { misc_tile(acc, u, wr, wc, fr, fq); return; }
        if (pn < 2) { base = (h16*)(ws + WS_QY); ldc = 1024; colt = pn * 256; }
        else if (pn < 4) { base = (h16*)(ws + WS_QI); ldc = 512; colt = (pn - 2) * 256; }
        else if (pn < 8) { base = (h16*)(ws + WS_UV); ldc = 1024; colt = (pn - 4) * 256; }
        else { base = (h16*)(ws + WS_GATES); ldc = 2048; colt = (pn - 8) * 256; }
        const int nai = u.half < 0 ? 2 : 1, rofs = u.half < 0 ? 0 : 128 * u.half;
        const int row0 = u.pm * 256 + rofs + wr * 64 + fr, col0 = colt + wc * 32 + 8 * fq;
#pragma unroll
        for (int ai = 0; ai < 2; ++ai) if (ai < nai)
#pragma unroll
            for (int m = 0; m < 4; ++m) { const int row = row0 + ai * 128 + m * 16; const float rs = rstd_from_lds(R, rofs + ai * 128 + wr * 64 + m * 16 + fr); h16* rowp = base + (size_t)row * ldc + col0;
#pragma unroll
                for (int bj = 0; bj < 2; ++bj) { f32x4 v0 = acc[ai][bj][m][0] * rs, v1 = acc[ai][bj][m][1] * rs;
                    u32x4 w; w.x = pkz(v0[0], v0[1]); w.y = pkz(v0[2], v0[3]); w.z = pkz(v1[0], v1[1]); w.w = pkz(v1[2], v1[3]);
                    if (!nostore) *(GAS u32x4*)(rowp + bj * 128) = w; else asm volatile("" :: "v"(w)); } }
        asm volatile("s_waitcnt lgkmcnt(0)" ::: "memory"); __builtin_amdgcn_s_barrier(); asm volatile("" ::: "memory");
    }
};

struct EpiD {
    static constexpr bool PERM = true;
    unsigned char* ws; h16* mg;
    __device__ __forceinline__ void prefetch(const pg8::Unit&, int, int) const {}
    __device__ __forceinline__ void operator()(Acc& acc, const pg8::Unit& u, int wr, int wc, int fr, int fq) const {
        const int row0 = u.pm * 256 + wr * 64 + fr, col0 = u.pn * 256 + wc * 32 + 8 * fq;
        const h16* gates = (const h16*)(ws + WS_GATES);
#pragma unroll
        for (int ai = 0; ai < 2; ++ai) {
            h16x8 gbv[4][2], gav[4][2];
#pragma unroll
            for (int m = 0; m < 4; ++m)
#pragma unroll
                for (int bj = 0; bj < 2; ++bj) { const size_t off = (size_t)(row0 + ai * 128 + m * 16) * 2048 + col0 + bj * 128;
                    gbv[m][bj] = *(const GAS h16x8*)(gates + off + 1024); if (u.kind == 0) gav[m][bj] = *(const GAS h16x8*)(gates + off); }
#pragma unroll
            for (int m = 0; m < 4; ++m) { const int row = row0 + ai * 128 + m * 16;
#pragma unroll
                for (int bj = 0; bj < 2; ++bj) { const int col = col0 + bj * 128; const h16x8 gb = gbv[m][bj];
                    if (u.kind == 0) { const h16x8 ga = gav[m][bj];
#pragma unroll
                        for (int i = 0; i < 8; ++i) { const float ea = __builtin_amdgcn_exp2f(fminf(-LOG2E * (float)ga[i], 64.f)), eb = __builtin_amdgcn_exp2f(fminf(-LOG2E * (float)gb[i], 64.f));
                            acc[ai][bj][m][i >> 2][i & 3] *= (1.0f + eb) * __builtin_amdgcn_rcpf(1.0f + ea); }
                    } else { float v[8];
#pragma unroll
                        for (int i = 0; i < 8; ++i) { const float eb = __builtin_amdgcn_exp2f(fminf(-LOG2E * (float)gb[i], 64.f)); v[i] = acc[ai][bj][m][i >> 2][i & 3] * __builtin_amdgcn_rcpf(1.0f + eb); }
                        u32x4 w; w.x = pkz(v[0], v[1]); w.y = pkz(v[2], v[3]); w.z = pkz(v[4], v[5]); w.w = pkz(v[6], v[7]);
                        *(GAS u32x4*)(mg + (size_t)row * 1024 + col) = w; } } }
            asm volatile("" ::: "memory"); }
    }
};

struct EpiRes {
    static constexpr bool PERM = true;
    const h16* resid; h16* xo; float* ssq; LAS float* P;
    __device__ __forceinline__ void prefetch(const pg8::Unit&, int, int) const {}
    __device__ __forceinline__ void operator()(Acc& acc, const pg8::Unit& u, int wr, int wc, int fr, int fq) const {
        const int row0 = u.pm * 256 + wr * 64 + fr, col0 = u.pn * 256 + wc * 32 + 8 * fq;
        h16x8 rvv[2][4][2];
#pragma unroll
        for (int ai = 0; ai < 2; ++ai)
#pragma unroll
            for (int m = 0; m < 4; ++m)
#pragma unroll
                for (int bj = 0; bj < 2; ++bj) rvv[ai][m][bj] = *(const GAS h16x8*)(resid + (size_t)(row0 + ai * 128 + m * 16) * 1024 + col0 + bj * 128);
#pragma unroll
        for (int ai = 0; ai < 2; ++ai)
#pragma unroll
            for (int m = 0; m < 4; ++m) { const int row = row0 + ai * 128 + m * 16; float ss = 0.f;
#pragma unroll
                for (int bj = 0; bj < 2; ++bj) { const size_t off = (size_t)row * 1024 + col0 + bj * 128;
                    const h16x8 rv = rvv[ai][m][bj]; float v[8];
#pragma unroll
                    for (int i = 0; i < 8; ++i) { v[i] = (float)rv[i] + acc[ai][bj][m][i >> 2][i & 3]; ss = fmaf(v[i], v[i], ss); }
                    *(GAS u32x4*)(xo + off) = pack8h(v); }
                ss += __shfl_xor(ss, 16); ss += __shfl_xor(ss, 32);
                if (fq == 0) P[(ai * 128 + wr * 64 + m * 16 + fr) * 4 + wc] = ss; }
        asm volatile("s_waitcnt lgkmcnt(0)" ::: "memory"); __builtin_amdgcn_s_barrier(); asm volatile("" ::: "memory");
        { const int t = (wr * 4 + wc) * 64 + fq * 16 + fr; if (t < 256) { const f32x4 v = *(const LAS f32x4*)(P + t * 4); ((GAS float*)ssq)[(size_t)(u.pm * 256 + t) * 4 + u.pn] = (v.x + v.y) + (v.z + v.w); } }
        asm volatile("s_waitcnt lgkmcnt(0)" ::: "memory"); __builtin_amdgcn_s_barrier(); asm volatile("" ::: "memory");
    }
};

struct EpiFinal {
    static constexpr bool PERM = true;
    const h16* resid; float* out; const float* gfin; float* ssq; unsigned* cnt; LAS float* P;
    __device__ __forceinline__ void prefetch(const pg8::Unit&, int, int) const {}
    __device__ __forceinline__ void operator()(Acc& acc, const pg8::Unit& u, int wr, int wc, int fr, int fq) const {
        const int row0 = u.pm * 256 + wr * 64 + fr, col0 = u.pn * 256 + wc * 32 + 8 * fq;
        LAS float* S = P + 1024;
        { h16x8 rvv[2][4][2];
#pragma unroll
          for (int ai = 0; ai < 2; ++ai)
#pragma unroll
              for (int m = 0; m < 4; ++m)
#pragma unroll
                  for (int bj = 0; bj < 2; ++bj) rvv[ai][m][bj] = *(const GAS h16x8*)(resid + (size_t)(row0 + ai * 128 + m * 16) * 1024 + col0 + bj * 128);
#pragma unroll
          for (int ai = 0; ai < 2; ++ai)
#pragma unroll
              for (int m = 0; m < 4; ++m) { float ss = 0.f;
#pragma unroll
                  for (int bj = 0; bj < 2; ++bj) { const h16x8 rv = rvv[ai][m][bj];
#pragma unroll
                      for (int i = 0; i < 8; ++i) { const float v = (float)rv[i] + acc[ai][bj][m][i >> 2][i & 3]; acc[ai][bj][m][i >> 2][i & 3] = v; ss = fmaf(v, v, ss); } }
                  ss += __shfl_xor(ss, 16); ss += __shfl_xor(ss, 32);
                  if (fq == 0) P[(ai * 128 + wr * 64 + m * 16 + fr) * 4 + wc] = ss; } }
        asm volatile("s_waitcnt lgkmcnt(0)" ::: "memory"); __builtin_amdgcn_s_barrier(); asm volatile("" ::: "memory");
        const int t = (wr * 4 + wc) * 64 + fq * 16 + fr, wid = wr * 4 + wc;
        if (t < 256) { const f32x4 v = *(const LAS f32x4*)(P + t * 4);
            __hip_atomic_store((GAS float*)ssq + (size_t)(u.pm * 256 + t) * 4 + u.pn, (v.x + v.y) + (v.z + v.w), __ATOMIC_RELAXED, __HIP_MEMORY_SCOPE_AGENT); }
        asm volatile("s_waitcnt vmcnt(0)" ::: "memory");
        unsigned* c = cnt + 64 * u.pm;
        if ((fq * 16 + fr) == 0) __hip_atomic_fetch_add(c, 1u, __ATOMIC_RELAXED, __HIP_MEMORY_SCOPE_AGENT);
        if (wid == 0) {
            const unsigned long long t0 = __builtin_amdgcn_s_memrealtime();
            while ((unsigned)__builtin_amdgcn_readfirstlane((int)__hip_atomic_load(c, __ATOMIC_RELAXED, __HIP_MEMORY_SCOPE_AGENT)) < 32u) {
                if (__builtin_amdgcn_s_memrealtime() - t0 > 2000000ull) break;
                __builtin_amdgcn_s_sleep(2); }
            __builtin_amdgcn_fence(__ATOMIC_ACQUIRE, "agent");
            asm volatile("s_waitcnt vmcnt(0)" ::: "memory"); }
        asm volatile("s_waitcnt lgkmcnt(0)" ::: "memory"); __builtin_amdgcn_s_barrier(); asm volatile("" ::: "memory");
        if (t < 256) { const GAS float* sp = (const GAS float*)ssq + (size_t)(u.pm * 256 + t) * 4; float sum = 0.f;
#pragma unroll
            for (int k = 0; k < 4; ++k) sum += __hip_atomic_load(sp + k, __ATOMIC_RELAXED, __HIP_MEMORY_SCOPE_AGENT);
            S[t] = rsqrtf(sum * (1.0f / DM) + EPS_RMS); }
        asm volatile("s_waitcnt lgkmcnt(0)" ::: "memory"); __builtin_amdgcn_s_barrier(); asm volatile("" ::: "memory");
        f32x4 gv[2][2];
#pragma unroll
        for (int bj = 0; bj < 2; ++bj) { gv[bj][0] = *(const f32x4*)(gfin + col0 + bj * 128); gv[bj][1] = *(const f32x4*)(gfin + col0 + bj * 128 + 4); }
#pragma unroll
        for (int ai = 0; ai < 2; ++ai)
#pragma unroll
            for (int m = 0; m < 4; ++m) { const int rl = ai * 128 + wr * 64 + m * 16 + fr; const float rs = S[rl]; float* op = out + (size_t)(u.pm * 256 + rl) * 1024 + col0;
#pragma unroll
                for (int bj = 0; bj < 2; ++bj) { *(GAS f32x4*)(op + bj * 128) = acc[ai][bj][m][0] * rs * gv[bj][0]; *(GAS f32x4*)(op + bj * 128 + 4) = acc[ai][bj][m][1] * rs * gv[bj][1]; } }
    }
};

struct EpiF {
    static constexpr bool PERM = true;
    unsigned char* ws; LAS float* R;
    __device__ __forceinline__ void prefetch(const pg8::Unit& u, int wid, int lane) const { ssq_prefetch((const float*)(ws + WS_SSQ), u.pm, R, wid, lane); }
    __device__ __forceinline__ void operator()(Acc& acc, const pg8::Unit& u, int wr, int wc, int fr, int fq) const {
        const int nai = u.half < 0 ? 2 : 1, rofs = u.half < 0 ? 0 : 128 * u.half;
        const int row0 = u.pm * 256 + rofs + wr * 64 + fr, col0 = u.pn * 128 + wc * 16 + 4 * fq;
        h16* act = (h16*)(ws + WS_ACT);
#pragma unroll
        for (int ai = 0; ai < 2; ++ai) if (ai < nai)
#pragma unroll
            for (int m = 0; m < 4; ++m) { const int row = row0 + ai * 128 + m * 16; const float rs = rstd_from_lds(R, rofs + ai * 128 + wr * 64 + m * 16 + fr);
#pragma unroll
                for (int bj = 0; bj < 2; ++bj) { const f32x4 g = acc[ai][bj][m][0] * rs, uu = acc[ai][bj][m][1] * rs; float v[4];
#pragma unroll
                    for (int i = 0; i < 4; ++i) v[i] = g[i] * sigmoid_f(g[i]) * uu[i];
                    *(GAS u32x2*)(act + (size_t)row * DFF + col0 + bj * 64) = (u32x2){pkz(v[0], v[1]), pkz(v[2], v[3])}; } }
        asm volatile("s_waitcnt lgkmcnt(0)" ::: "memory"); __builtin_amdgcn_s_barrier(); asm volatile("" ::: "memory");
    }
};

__device__ __forceinline__ void final_norm_phase(const Frame& F, const h16* x16, const float* ssq, float* out, const float* g) {
    int lane = lane_id(); asm volatile("" : "+v"(lane));
    const int gw = F.vcu * NWAVES + F.wave, NGW = F.G * NWAVES;
    f32x4 gv[4];
#pragma unroll
    for (int k = 0; k < 4; ++k) gv[k] = *(const f32x4*)(g + 256 * k + 4 * lane);
    for (int m0 = gw; m0 < M; m0 += 8 * NGW) {
        u32x2 xv[8][4]; f32x4 sq[8];
#pragma unroll
        for (int r = 0; r < 8; ++r) { const int m = m0 + r * NGW; if (m < M) { sq[r] = *(const GAS f32x4*)(ssq + (size_t)m * 4);
#pragma unroll
            for (int k = 0; k < 4; ++k) xv[r][k] = *(const GAS u32x2*)(x16 + (size_t)m * DM + 256 * k + 4 * lane); } }
#pragma unroll
        for (int r = 0; r < 8; ++r) { const int m = m0 + r * NGW; if (m < M) { const float rs = rsqrtf(((sq[r].x + sq[r].y) + (sq[r].z + sq[r].w)) * (1.0f / DM) + EPS_RMS);
#pragma unroll
            for (int k = 0; k < 4; ++k) { const u32x2 p = xv[r][k]; const f32x4 gk = gv[k];
                *(GAS f32x4*)(out + (size_t)m * DM + 256 * k + 4 * lane) = (f32x4){h2f_lo(p.x) * rs * gk.x, h2f_hi(p.x) * rs * gk.y, h2f_lo(p.y) * rs * gk.z, h2f_hi(p.y) * rs * gk.w}; } } }
    }
}
__device__ __forceinline__ unsigned wlane(unsigned val, int ln, unsigned old) {
    unsigned keep;
    asm volatile("s_mov_b32 %1, m0\n\ts_mov_b32 m0, %3\n\ts_nop 3\n\tv_writelane_b32 %0, %2, m0\n\ts_mov_b32 m0, %1" : "+v"(old), "=&s"(keep) : "s"(val), "s"(ln));
    return old;
}
__device__ __forceinline__ void cnt_ge(int& c, float x, float m) { asm("v_cmp_ge_f32 vcc, %1, %2\n\tv_addc_co_u32 %0, vcc, 0, %0, vcc" : "+v"(c) : "v"(x), "v"(m) : "vcc"); }
__device__ __forceinline__ void cnt_gt(int& c, float x, float m) { asm("v_cmp_gt_f32 vcc, %1, %2\n\tv_addc_co_u32 %0, vcc, 0, %0, vcc" : "+v"(c) : "v"(x), "v"(m) : "vcc"); }
#define SEL_C8(OP, m_, a0, a1, a2, a3, a4, a5, a6, a7) \
    "v_cmp_" OP "_f32 vcc, " a0 ", " m_ "\n\tv_cmp_" OP "_f32 %2, " a1 ", " m_ "\n\tv_cmp_" OP "_f32 %3, " a2 ", " m_ "\n\tv_cmp_" OP "_f32 %4, " a3 ", " m_ "\n\t" \
    "v_cmp_" OP "_f32 %5, " a4 ", " m_ "\n\tv_cmp_" OP "_f32 %6, " a5 ", " m_ "\n\tv_cmp_" OP "_f32 %7, " a6 ", " m_ "\n\tv_cmp_" OP "_f32 %8, " a7 ", " m_ "\n\t"
#define SEL_A8(c_) \
    "v_addc_co_u32 " c_ ", vcc, 0, " c_ ", vcc\n\tv_addc_co_u32 " c_ ", %2, 0, " c_ ", %2\n\tv_addc_co_u32 " c_ ", %3, 0, " c_ ", %3\n\tv_addc_co_u32 " c_ ", %4, 0, " c_ ", %4\n\t" \
    "v_addc_co_u32 " c_ ", %5, 0, " c_ ", %5\n\tv_addc_co_u32 " c_ ", %6, 0, " c_ ", %6\n\tv_addc_co_u32 " c_ ", %7, 0, " c_ ", %7\n\tv_addc_co_u32 " c_ ", %8, 0, " c_ ", %8\n\t"
#define SEL_CGROUP(NAME, OP) __device__ __forceinline__ void NAME(int& c0, int& c1, const float* s, float m0, float m1) { unsigned long long t1, t2, t3, t4, t5, t6, t7; \
    asm(SEL_C8(OP, "%25", "%9", "%11", "%13", "%15", "%17", "%19", "%21", "%23") SEL_A8("%0") SEL_C8(OP, "%26", "%10", "%12", "%14", "%16", "%18", "%20", "%22", "%24") SEL_A8("%1") \
        : "+v"(c0), "+v"(c1), "=&s"(t1), "=&s"(t2), "=&s"(t3), "=&s"(t4), "=&s"(t5), "=&s"(t6), "=&s"(t7) \
        : "v"(s[0]), "v"(s[1]), "v"(s[2]), "v"(s[3]), "v"(s[4]), "v"(s[5]), "v"(s[6]), "v"(s[7]), "v"(s[8]), "v"(s[9]), "v"(s[10]), "v"(s[11]), "v"(s[12]), "v"(s[13]), "v"(s[14]), "v"(s[15]), "v"(m0), "v"(m1) : "vcc"); }
SEL_CGROUP(cnt_group_ge, "ge")
SEL_CGROUP(cnt_group_gt, "gt")
__device__ __forceinline__ void ballot_ge_to_lane(unsigned& wlo, unsigned& whi, float x, float tau, int ln) {
    unsigned keep;
    asm volatile("v_cmp_ge_f32 vcc, %3, %4\n\ts_mov_b32 %2, m0\n\ts_mov_b32 m0, %5\n\ts_nop 3\n\tv_writelane_b32 %0, vcc_lo, m0\n\tv_writelane_b32 %1, vcc_hi, m0\n\ts_mov_b32 m0, %2"
                 : "+v"(wlo), "+v"(whi), "=&s"(keep) : "v"(x), "v"(tau), "s"(ln) : "vcc");
}
__device__ __forceinline__ int half_sum_dpp(int v, int hf) {
    v += __builtin_amdgcn_update_dpp(0, v, 0x111, 0xf, 0xf, true);
    v += __builtin_amdgcn_update_dpp(0, v, 0x112, 0xf, 0xf, true);
    v += __builtin_amdgcn_update_dpp(0, v, 0x114, 0xf, 0xf, true);
    v += __builtin_amdgcn_update_dpp(0, v, 0x118, 0xf, 0xf, true);
    v += __builtin_amdgcn_update_dpp(0, v, 0x142, 0xa, 0xf, false);
    const int s0 = __builtin_amdgcn_readlane(v, 31), s1 = __builtin_amdgcn_readlane(v, 63);
    return hf ? s1 : s0;
}
__device__ __forceinline__ int crow(int R, int hf) { return (R & 3) + 8 * (R >> 2) + 4 * hf; }
__device__ __forceinline__ float half_swap_max(float v) { auto rr = __builtin_amdgcn_permlane32_swap(__float_as_uint(v), __float_as_uint(v), false, false); return fmaxf(__uint_as_float(rr[0]), __uint_as_float(rr[1])); }
__device__ __forceinline__ float half_swap_sum(float v) { auto rr = __builtin_amdgcn_permlane32_swap(__float_as_uint(v), __float_as_uint(v), false, false); return __uint_as_float(rr[0]) + __uint_as_float(rr[1]); }
__device__ __forceinline__ void rope8(const h16x8 x1, const h16x8 x2, const float* cs, int which, float scale, float (&o)[8]) {
    const f32x4 c0 = *(const GAS f32x4*)(cs), c1 = *(const GAS f32x4*)(cs + 4), s0 = *(const GAS f32x4*)(cs + 8), s1 = *(const GAS f32x4*)(cs + 12);
#pragma unroll
    for (int j = 0; j < 8; ++j) { const float c = j < 4 ? c0[j & 3] : c1[j & 3], s = j < 4 ? s0[j & 3] : s1[j & 3]; const float a = (float)x1[j], b = (float)x2[j];
        o[j] = (which == 0 ? (a * c - b * s) : (b * c + a * s)) * scale; }
}
__device__ __forceinline__ u32x4 pack8(const float (&v)[8]) { u32x4 w; w.x = pkh(v[0], v[1]); w.y = pkh(v[2], v[3]); w.z = pkh(v[4], v[5]); w.w = pkh(v[6], v[7]); return w; }

__device__ __forceinline__ void phaseB(const Frame& F, const In& I, int l) {
    unsigned char* ws = F.ws; asm volatile("" : "+s"(ws)); ws = (unsigned char*)(GAS unsigned char*)ws;     int lane = lane_id(), tid = F.wave * 64 + lane; asm volatile("" : "+v"(lane), "+v"(tid)); const int w = F.wave;
    int blk = F.vcu; asm volatile("" : "+s"(blk));
    const int b = blk >> 5, chunk = (blk >> 1) & 15, gh = blk & 1;
    const size_t tok0 = (size_t)b * SEQ + chunk * 128;
    const h16* UV = (const h16*)(ws + WS_UV); h16* QY = (h16*)(ws + WS_QY);
    LAS unsigned char* VN = F.lds;
    constexpr int VPB = 576;
    { const int i16 = lane & 15, rq = lane >> 4; h16x8 v[4][4];
#pragma unroll
      for (int it = 0; it < 4; ++it)
#pragma unroll
          for (int i = 0; i < 4; ++i) v[it][i] = *(const GAS h16x8*)(UV + (tok0 + 16 * w + 4 * it + rq) * 1024 + 512 + 8 * i16 + 128 * (i & 1) + 256 * ((i >> 1) ^ gh));
      f32x4 lgv[2][2], lbv[2][2];
#pragma unroll
      for (int i = 0; i < 2; ++i) { const int col = 256 * gh + 128 * i + 8 * i16; const float* lg = I.ln_v_g + l * 512 + col; const float* lb = I.ln_v_b + l * 512 + col;
          lgv[i][0] = *(const f32x4*)lg; lgv[i][1] = *(const GAS f32x4*)(lg + 4); lbv[i][0] = *(const f32x4*)lb; lbv[i][1] = *(const GAS f32x4*)(lb + 4); }
#pragma unroll
      for (int it = 0; it < 4; ++it) { float s = 0.f, q = 0.f; float vg[4][8];
#pragma unroll
          for (int i = 0; i < 4; ++i)
#pragma unroll
              for (int j = 0; j < 8; ++j) { const float x = gelu_tanh_f((float)v[it][i][j]); vg[i][j] = x; s += x; q = fmaf(x, x, q); }
          s += __shfl_xor(s, 1); q += __shfl_xor(q, 1); s += __shfl_xor(s, 2); q += __shfl_xor(q, 2); s += __shfl_xor(s, 4); q += __shfl_xor(q, 4); s += __shfl_xor(s, 8); q += __shfl_xor(q, 8);
          const float mu = s * (1.0f / 512.f), var = fmaxf(q * (1.0f / 512.f) - mu * mu, 0.f), rs = rsqrtf(var + 1e-5f);
          const int t = 16 * w + 4 * it + rq;
#pragma unroll
          for (int i = 0; i < 2; ++i) { float o[8];
#pragma unroll
              for (int j = 0; j < 8; ++j) o[j] = (vg[i][j] - mu) * rs * lgv[i][j >> 2][j & 3] + lbv[i][j >> 2][j & 3];
              *(LAS u32x4*)(VN + t * VPB + (128 * i + 8 * i16) * 2) = pack8(o); } } }
    asm volatile("" ::: "memory");
    { const int gp = w & 3, g = 4 * gh + gp, rh = w >> 2, r = lane & 31, hf = lane >> 5;
      const h16* WS16 = (const h16*)(ws + WS_SMALLW + (size_t)l * SMALLW_LAYER + 98304 + 131072) + (size_t)g * 128 * 128;
      const int troff = (8 * hf + ((lane & 15) >> 2)) * VPB + (gp * 64 + 16 * ((lane >> 4) & 1) + 4 * (lane & 3)) * 2;
      h16x8 wf[2][8];
#pragma unroll
      for (int tb = 0; tb < 2; ++tb)
#pragma unroll
          for (int s = 0; s < 8; ++s) wf[tb][s] = *(const GAS h16x8*)(WS16 + (size_t)(64 * rh + 32 * tb + r) * 128 + 16 * s + 8 * hf);
      float bsv[2]; u32x2 uu[2][2][4];
#pragma unroll
      for (int tb = 0; tb < 2; ++tb) { const int t = 64 * rh + 32 * tb + r; bsv[tb] = I.b_s[((size_t)l * 8 + g) * 128 + t];
#pragma unroll
          for (int db = 0; db < 2; ++db)
#pragma unroll
              for (int gg = 0; gg < 4; ++gg) uu[tb][db][gg] = *(const GAS u32x2*)(UV + (tok0 + t) * 1024 + g * 64 + 32 * db + 8 * gg + 4 * hf); }
      LDS_WAIT(); __syncthreads();
#pragma unroll
      for (int tb = 0; tb < 2; ++tb) { const int nks = 4 * rh + 2 * tb + 2; const size_t tk = tok0 + 64 * rh + 32 * tb + r;
#pragma unroll
        for (int db = 0; db < 2; ++db) { f32x16 D = {};
#pragma unroll
            for (int s = 0; s < 8; ++s) if (s < nks) {
                const v4i16_t lo = __builtin_amdgcn_ds_read_tr16_b64_v4i16((LAS v4i16_t*)(VN + troff + (16 * s) * VPB + 64 * db));
                const v4i16_t hi = __builtin_amdgcn_ds_read_tr16_b64_v4i16((LAS v4i16_t*)(VN + troff + (16 * s + 4) * VPB + 64 * db));
                typedef short s16x8 __attribute__((ext_vector_type(8)));
                const s16x8 av = {lo[0], lo[1], lo[2], lo[3], hi[0], hi[1], hi[2], hi[3]};
                D = __builtin_amdgcn_mfma_f32_32x32x16_f16(__builtin_bit_cast(h16x8, av), wf[tb][s], D, 0, 0, 0); }
#pragma unroll
            for (int gg = 0; gg < 4; ++gg) { const u32x2 uv2 = uu[tb][db][gg]; const float bb = bsv[tb];
                const float y0 = gelu_tanh_f(h2f_lo(uv2.x)) * (D[4 * gg] + bb), y1 = gelu_tanh_f(h2f_hi(uv2.x)) * (D[4 * gg + 1] + bb), y2 = gelu_tanh_f(h2f_lo(uv2.y)) * (D[4 * gg + 2] + bb), y3 = gelu_tanh_f(h2f_hi(uv2.y)) * (D[4 * gg + 3] + bb);
                *(GAS u32x2*)(QY + tk * 1024 + 512 + g * 64 + 32 * db + 8 * gg + 4 * hf) = (u32x2){pkh(y0, y1), pkh(y2, y3)}; } } } }
    __syncthreads();
}

constexpr int C_KIB = 0, C_KIBUF = 256 * 128;
constexpr int C_QL = 0, C_QLW = KVP * 2 * 32;
constexpr int C_WQ = 81920;
constexpr int C_KVS = 90112, C_KVSLOT = 10240;

__device__ __forceinline__ void phaseC_select(const Frame& F, int l, int b, int qt, int pmode = 0) {
    unsigned char* ws = F.ws; asm volatile("" : "+s"(ws)); ws = (unsigned char*)(GAS unsigned char*)ws;     int lane = lane_id(), tid = F.wave * 64 + lane; asm volatile("" : "+v"(lane), "+v"(tid)); const int w = F.wave, r = lane & 31, hf = lane >> 5;
    const h16* QI = (const h16*)(ws + WS_QI); const h16* KI = (const h16*)(ws + WS_KI); const float* WI = (const float*)(ws + WS_WI); const float* CS = (const float*)(ws + WS_CS);
    h16* QY = (h16*)(ws + WS_QY); const h16* KV = (const h16*)(ws + WS_KV);
    const h16* WUKT = (const h16*)(ws + WS_SMALLW + (size_t)l * SMALLW_LAYER); const h16* WUVT = (const h16*)(ws + WS_SMALLW + (size_t)l * SMALLW_LAYER + 98304);
    LAS unsigned char* lds = F.lds;
    const int t0 = 32 * qt, NT = qt + 1; const size_t tokbase = (size_t)b * SEQ;
    { const char* kvsrc_ = (const char*)((const h16*)(ws + WS_KV) + tokbase * KVP) + (size_t)(64 * w + lane) * 16; const unsigned kvdst_ = (unsigned)(uintptr_t)(lds + C_KVS) + (unsigned)w * 1024u;
#pragma unroll
      for (int t_ = 0; t_ < 4; ++t_) if (t_ < NT) { const char* s_ = kvsrc_ + (size_t)t_ * (32 * KVP * 2); const unsigned d_ = (unsigned)__builtin_amdgcn_readfirstlane((int)(kvdst_ + (unsigned)t_ * (unsigned)C_KVSLOT));
          unsigned keep_; asm volatile("s_mov_b32 %0, m0\n\ts_mov_b32 m0, %2\n\ts_nop 0\n\tglobal_load_lds_dwordx4 %1, off\n\ts_mov_b32 m0, %0" : "=&s"(keep_) : "v"(s_), "s"(d_) : "memory");
          if (w < 2) { const char* s2_ = s_ + 8192; const unsigned d2_ = d_ + 8192u; asm volatile("s_mov_b32 %0, m0\n\ts_mov_b32 m0, %2\n\ts_nop 0\n\tglobal_load_lds_dwordx4 %1, off\n\ts_mov_b32 m0, %0" : "=&s"(keep_) : "v"(s2_), "s"(d2_) : "memory"); } } }
    h16x8 afr[4]; float wreg[16];
    { const int qq = 2 * ((r >> 2) & 1) + (r >> 4), head = (r & 3) + 4 * ((r >> 3) & 1); const size_t tokA = tokbase + t0 + 4 * w + qq;
      const h16* qsrc = QI + tokA * 512 + head * 64;
      { float o[8]; rope8(*(const GAS h16x8*)(qsrc), *(const GAS h16x8*)(qsrc + 8), CS + tokA * 16, hf, 1.0f, o); afr[0] = __builtin_bit_cast(h16x8, pack8(o)); }
#pragma unroll
      for (int s = 1; s < 4; ++s) afr[s] = *(const GAS h16x8*)(qsrc + 16 * s + 8 * hf);
      const float* wp = WI + (tokbase + t0 + 4 * w + 2 * hf) * 8;
#pragma unroll
      for (int R4 = 0; R4 < 4; ++R4) { const f32x4 wv = *(const GAS f32x4*)(wp + 4 * R4); wreg[4 * R4] = wv.x; wreg[4 * R4 + 1] = wv.y; wreg[4 * R4 + 2] = wv.z; wreg[4 * R4 + 3] = wv.w; } }
    float SC[128];
    const float QNAN = __uint_as_float(0x7fc00000u);
#pragma unroll
    for (int i = 0; i < 128; ++i) SC[i] = QNAN;
    const int NCK = (NT + 7) >> 3, tq0 = t0 + 4 * w + 2 * hf;
    const int drow = lane >> 3, dslot = lane & 7;
    const h16* kisrc = KI + (tokbase + 32 * w + drow) * 64 + 8 * (dslot ^ drow);
#define KI_STAGE(ck_, buf_) do { _Pragma("unroll") for (int i_ = 0; i_ < 4; ++i_) \
        __builtin_amdgcn_global_load_lds((const unsigned*)(kisrc + (size_t)(256 * (ck_) + 8 * i_) * 64), (LAS unsigned*)(lds + C_KIB + (buf_) * C_KIBUF + (4 * w + i_) * 1024), 16, 0, 0); } while (0)
    KI_STAGE(0, 0);
    VM_WAIT(); __syncthreads();
    const int kroff = r * 128, kx = r & 7;
#pragma unroll 1
    for (int ck = 0; ck < NCK; ++ck) {
        LAS unsigned char* kb = lds + C_KIB + (ck & 1) * C_KIBUF;
        if (ck + 1 < NCK) KI_STAGE(ck + 1, (ck + 1) & 1);
#pragma unroll
        for (int i = 0; i < 112; ++i) SC[i] = SC[i + 16];
#pragma unroll
        for (int jj = 0; jj < 8; ++jj) { if (pmode & 1) { SC[112 + 2 * jj] = (float)(ck + jj + r) * 0.01f; SC[113 + 2 * jj] = (float)(ck - jj + r) * 0.01f; continue; }
            f32x16 D = {};
#pragma unroll
            for (int s = 0; s < 4; ++s) { const h16x8 bb = *(const LAS h16x8*)(kb + jj * 4096 + kroff + 16 * ((2 * s + hf) ^ kx)); D = __builtin_amdgcn_mfma_f32_32x32x16_f16(afr[s], bb, D, 0, 0, 0); }
            float s0 = 0.f, s1 = 0.f;
#pragma unroll
            for (int R = 0; R < 8; ++R) { s0 = fmaf(wreg[R], fmaxf(D[R], 0.f), s0); s1 = fmaf(wreg[8 + R], fmaxf(D[8 + R], 0.f), s1); }
            const int k = 256 * ck + 32 * jj + r;
            SC[112 + 2 * jj] = (k > tq0) ? QNAN : s0; SC[113 + 2 * jj] = (k > tq0 + 1) ? QNAN : s1;
        }
        LDS_WAIT(); VM_WAIT(); __syncthreads();
    }
#undef KI_STAGE
    const int G0 = 8 - NCK;
#define SEL_COUNT2(c0, c1, FN, m0, m1) do { int a0_ = 0, a1_ = 0; \
        _Pragma("unroll") for (int g = 0; g < 8; ++g) if (g >= G0) FN(a0_, a1_, &SC[16 * g], (m0), (m1)); \
        c0 = half_sum_dpp(a0_, hf); c1 = half_sum_dpp(a1_, hf); } while (0)
    float tau0 = -3.0e38f, tau1 = -3.0e38f;
    if (qt >= 8 && !(pmode & 2)) {
        float lo0 = INFINITY, lo1 = INFINITY, hi0 = -INFINITY, hi1 = -INFINITY;
#pragma unroll
        for (int j = 0; j < 64; ++j) { const float a = SC[2 * j], c = SC[2 * j + 1]; lo0 = fminf(lo0, a); hi0 = fmaxf(hi0, a); lo1 = fminf(lo1, c); hi1 = fmaxf(hi1, c); }
#pragma unroll
        for (int o = 1; o < 32; o <<= 1) { lo0 = fminf(lo0, __shfl_xor(lo0, o)); lo1 = fminf(lo1, __shfl_xor(lo1, o)); hi0 = fmaxf(hi0, __shfl_xor(hi0, o)); hi1 = fmaxf(hi1, __shfl_xor(hi1, o)); }
        int cl0 = tq0 + 1, cl1 = tq0 + 2, ch0 = 1, ch1 = 1;
        bool done0 = false, done1 = false;
        { int g0, g1; const float zero = 0.f; SEL_COUNT2(g0, g1, cnt_group_gt, zero, zero);
          const float tiny = __uint_as_float(1u);
          if (__any(g0 < 256 || g1 < 256)) { int e0, e1; SEL_COUNT2(e0, e1, cnt_group_ge, zero, zero);
              if (g0 < 256) { if (e0 >= 256) { lo0 = 0.f; done0 = true; } else { hi0 = 0.f; ch0 = e0; } }
              if (g1 < 256) { if (e1 >= 256) { lo1 = 0.f; done1 = true; } else { hi1 = 0.f; ch1 = e1; } } }
          if (g0 >= 256) { lo0 = tiny; cl0 = g0; if (g0 == 256) done0 = true; }
          if (g1 >= 256) { lo1 = tiny; cl1 = g1; if (g1 == 256) done1 = true; } }
#define SEL_STEP(c0, c1, mid0, mid1) do { \
            if (!done0) { if (c0 >= 256) { lo0 = mid0; cl0 = c0; if (c0 == 256) done0 = true; } else { hi0 = mid0; ch0 = c0; } } \
            if (!done1) { if (c1 >= 256) { lo1 = mid1; cl1 = c1; if (c1 == 256) done1 = true; } else { hi1 = mid1; ch1 = c1; } } } while (0)
#define SEL_EXHAUSTED(bis0, bis1) do { if (!done0 && (bis0 <= lo0 || bis0 >= hi0)) done0 = true; if (!done1 && (bis1 <= lo1 || bis1 >= hi1)) done1 = true; } while (0)
        bool compact = true;
#pragma unroll 1
        for (int it = 0; it < ((pmode & 16) ? 6 : 40); ++it) {
            const float bis0 = 0.5f * (lo0 + hi0), bis1 = 0.5f * (lo1 + hi1);
            SEL_EXHAUSTED(bis0, bis1);
            if (__all((done0 || (compact && cl0 - ch0 <= 48)) && (done1 || (compact && cl1 - ch1 <= 48)))) break;
            int c0, c1; SEL_COUNT2(c0, c1, cnt_group_ge, bis0, bis1);
            SEL_STEP(c0, c1, bis0, bis1);
            if (it == 39) { done0 = true; done1 = true; }
        }
        if (!__all(done0 && done1)) {
            LAS float* L0 = (LAS float*)(lds + w * 4096 + (2 * hf) * 1024 + r * 32); LAS float* L1 = L0 + 256;
            { const f32x4 qn = {QNAN, QNAN, QNAN, QNAN}; *(LAS f32x4*)L0 = qn; *(LAS f32x4*)(L0 + 4) = qn; *(LAS f32x4*)L1 = qn; *(LAS f32x4*)(L1 + 4) = qn; }
            int n0 = 0, n1 = 0;
#pragma unroll
            for (int g = 0; g < 8; ++g) if (g >= G0) {
#pragma unroll
                for (int jj = 0; jj < 8; ++jj) { const int j = 8 * g + jj; const float v0 = SC[2 * j], v1 = SC[2 * j + 1];
                    if (!done0 && v0 >= lo0 && v0 < hi0) { if (n0 < 8) L0[n0] = v0; ++n0; }
                    if (!done1 && v1 >= lo1 && v1 < hi1) { if (n1 < 8) L1[n1] = v1; ++n1; } } }
            LDS_WAIT();
            float CAND[16];
            { const f32x4 a0 = *(const LAS f32x4*)L0, a1 = *(const LAS f32x4*)(L0 + 4), b0 = *(const LAS f32x4*)L1, b1 = *(const LAS f32x4*)(L1 + 4);
#pragma unroll
              for (int i = 0; i < 4; ++i) { CAND[2 * i] = a0[i]; CAND[8 + 2 * i] = a1[i]; CAND[2 * i + 1] = b0[i]; CAND[8 + 2 * i + 1] = b1[i]; } }
            LDS_WAIT();
            if (__any(n0 > 8 || n1 > 8)) {
#pragma unroll 1
                for (int it = 0; it < 40; ++it) {
                    const float bis0 = 0.5f * (lo0 + hi0), bis1 = 0.5f * (lo1 + hi1);
                    SEL_EXHAUSTED(bis0, bis1);
                    if (__all(done0 && done1)) break;
                    int c0, c1; SEL_COUNT2(c0, c1, cnt_group_ge, bis0, bis1);
                    SEL_STEP(c0, c1, bis0, bis1);
                }
            } else {
                const int cb0 = ch0, cb1 = ch1;
#pragma unroll 1
                for (int it = 0; it < ((pmode & 16) ? 3 : 48); ++it) {
                    const float bis0 = 0.5f * (lo0 + hi0), bis1 = 0.5f * (lo1 + hi1);
                    SEL_EXHAUSTED(bis0, bis1);
                    if (__all(done0 && done1)) break;
                    float mid0 = bis0, mid1 = bis1;
                    if ((it % 3) != 2) { const float i0 = lo0 + ((float)cl0 - 255.5f) / (float)(cl0 - ch0) * (hi0 - lo0), i1 = lo1 + ((float)cl1 - 255.5f) / (float)(cl1 - ch1) * (hi1 - lo1);
                        if (i0 > lo0 && i0 < hi0) mid0 = i0; if (i1 > lo1 && i1 < hi1) mid1 = i1; }
                    int a0 = 0, a1 = 0; cnt_group_ge(a0, a1, CAND, mid0, mid1);
                    const int c0 = cb0 + half_sum_dpp(a0, hf), c1 = cb1 + half_sum_dpp(a1, hf);
                    SEL_STEP(c0, c1, mid0, mid1);
                }
            }
        }
#undef SEL_STEP
#undef SEL_EXHAUSTED
        tau0 = lo0; tau1 = lo1;
    }
#undef SEL_COUNT2
    unsigned w00 = 0u, w01 = 0u, w10 = 0u, w11 = 0u;
#pragma unroll
    for (int g = 0; g < 8; ++g) if (g >= G0 && !(pmode & 4)) {
#pragma unroll
        for (int jj = 0; jj < 8; ++jj) { const int j = 8 * g + jj, jt = 8 * (g - G0) + jj;
            ballot_ge_to_lane(w00, w10, SC[2 * j], tau0, jt); ballot_ge_to_lane(w01, w11, SC[2 * j + 1], tau1, jt); } }
    { LAS unsigned* WQ = (LAS unsigned*)(lds + C_WQ);
      WQ[(4 * w + 0) * 64 + lane] = w00; WQ[(4 * w + 1) * 64 + lane] = w01; WQ[(4 * w + 2) * 64 + lane] = w10; WQ[(4 * w + 3) * 64 + lane] = w11; }
    LDS_WAIT(); __syncthreads();
}

__device__ __forceinline__ void phaseC_attn(const Frame& F, int l, int b, int qt, bool do_store = true, int pmode = 0) {
    unsigned char* ws = F.ws; asm volatile("" : "+s"(ws)); ws = (unsigned char*)(GAS unsigned char*)ws;     const int w = F.wave;
    int lane = lane_id(), tid = F.wave * 64 + lane; asm volatile("" : "+v"(lane), "+v"(tid));
    const int r = lane & 31, hf = lane >> 5;
    const float* CS = (const float*)(ws + WS_CS);
    h16* QY = (h16*)(ws + WS_QY); const h16* KV = (const h16*)(ws + WS_KV);
    const h16* WUKT = (const h16*)(ws + WS_SMALLW + (size_t)l * SMALLW_LAYER); const h16* WUVT = (const h16*)(ws + WS_SMALLW + (size_t)l * SMALLW_LAYER + 98304);
    LAS unsigned char* lds = F.lds;
    const int t0 = 32 * qt, NT = qt + 1; const size_t tokbase = (size_t)b * SEQ;
    const int h = w; const size_t tokQ = tokbase + t0 + r;
    LAS h16* ql = (LAS h16*)(lds + C_QL + w * C_QLW);
    if (!(pmode & 64)) { h16x8 bq[3];
#pragma unroll
      for (int s = 0; s < 3; ++s) bq[s] = *(const GAS h16x8*)(QY + tokQ * 1024 + h * 64 + 16 + 16 * s + 8 * hf);
#pragma unroll
      for (int cb = 0; cb < 4; ++cb) { f32x16 D = {};
#pragma unroll
          for (int s = 0; s < 3; ++s) { const h16x8 a = *(const GAS h16x8*)(WUKT + ((size_t)(h * 128 + 32 * cb + r)) * 48 + 16 * s + 8 * hf); D = __builtin_amdgcn_mfma_f32_32x32x16_f16(a, bq[s], D, 0, 0, 0); }
#pragma unroll
          for (int g = 0; g < 4; ++g) { const int c = 32 * cb + 8 * g + 4 * hf;
              *(LAS u32x2*)(ql + r * KVP + c) = (u32x2){pkh(D[4 * g] * QSCALE, D[4 * g + 1] * QSCALE), pkh(D[4 * g + 2] * QSCALE, D[4 * g + 3] * QSCALE)}; } }
      { float o[8]; rope8(*(const GAS h16x8*)(QY + tokQ * 1024 + h * 64), *(const GAS h16x8*)(QY + tokQ * 1024 + h * 64 + 8), CS + tokQ * 16, hf, QSCALE, o); *(LAS u32x4*)(ql + r * KVP + 128 + 8 * hf) = pack8(o); } }
    LDS_WAIT();
    h16x8 qfr[9];
#pragma unroll
    for (int s = 0; s < 9; ++s) qfr[s] = *(const LAS h16x8*)(ql + r * KVP + 16 * s + 8 * hf);
    const char* kvsrc = (const char*)(KV + tokbase * KVP) + (size_t)(64 * w + lane) * 16;
    const unsigned kvdst = (unsigned)(uintptr_t)(lds + C_KVS) + (unsigned)w * 1024u;
    const int grp = w >> 2;
#define KV_DMA1(src_, dst_) do { unsigned keep_; asm volatile("s_mov_b32 %0, m0\n\ts_mov_b32 m0, %2\n\ts_nop 0\n\tglobal_load_lds_dwordx4 %1, off\n\ts_mov_b32 m0, %0" : "=&s"(keep_) : "v"(src_), "s"(dst_) : "memory"); } while (0)
#define KV_DMA(t_) do { const char* s_ = kvsrc + (size_t)(t_) * (32 * KVP * 2); const unsigned d_ = (unsigned)__builtin_amdgcn_readfirstlane((int)(kvdst + (unsigned)((t_) % 5) * (unsigned)C_KVSLOT)); \
        KV_DMA1(s_, d_); if (w < 2) { const char* s2_ = s_ + 8192; const unsigned d2_ = d_ + 8192u; KV_DMA1(s2_, d2_); } } while (0)
#define KV_WAIT(n_) do { if ((n_) <= 0) asm volatile("s_waitcnt vmcnt(0)" ::: "memory"); else if ((n_) == 1) { if (w < 2) asm volatile("s_waitcnt vmcnt(2)" ::: "memory"); else asm volatile("s_waitcnt vmcnt(1)" ::: "memory"); } \
        else { if (w < 2) asm volatile("s_waitcnt vmcnt(4)" ::: "memory"); else asm volatile("s_waitcnt vmcnt(2)" ::: "memory"); } } while (0)
#if defined(PROBE_C_ATT)
    { KV_DMA(0); if (NT > 1) KV_DMA(1); if (NT > 2) KV_DMA(2); if (NT > 3) KV_DMA(3); }
#endif
    asm volatile("s_waitcnt vmcnt(0)" ::: "memory");
    asm volatile("s_waitcnt lgkmcnt(0)" ::: "memory"); __builtin_amdgcn_s_barrier(); asm volatile("" ::: "memory");
    float mrun = 0.f, lrun = 0.f; f32x16 O[4]; f32x16 negm;
#pragma unroll
    for (int db = 0; db < 4; ++db) O[db] = (f32x16){};
#pragma unroll
    for (int R = 0; R < 16; ++R) negm[R] = 0.f;
    const LAS unsigned* WQr = (const LAS unsigned*)(lds + C_WQ) + r * 64;
    const int troff = ((lane & 15) >> 2) * (KVP * 2) + (16 * ((lane >> 4) & 1) + 4 * (lane & 3)) * 2 + 4 * hf * (KVP * 2);
    const int kbase = (int)(uintptr_t)(lds + C_KVS) + r * (KVP * 2) + 16 * hf, vbase = (int)(uintptr_t)(lds + C_KVS) + troff;
    typedef short s16x8 __attribute__((ext_vector_type(8)));
#define AT_MAX3(a_, b_, c_) ({ float r_; asm("v_max3_f32 %0, %1, %2, %3" : "=v"(r_) : "v"(a_), "v"(b_), "v"(c_)); r_; })
#define AT_MASKED(e_, w_, pos_) ({ int t_, r_; asm("v_bfe_i32 %0, %2, %3, 1\n\tv_and_b32 %1, %4, %0" : "=&v"(t_), "=v"(r_) : "v"(w_), "n"(pos_), "v"(e_)); __int_as_float(r_); })
#define AT_KLOAD(so_) h16x8 kfr[9]; do { const LAS unsigned char* sl_ = (const LAS unsigned char*)(uintptr_t)(kbase + (so_)); \
        if (!(pmode & 16)) { _Pragma("unroll") for (int s = 0; s < 9; ++s) kfr[s] = *(const LAS h16x8*)(sl_ + 32 * s); } else { _Pragma("unroll") for (int s = 0; s < 9; ++s) kfr[s] = qfr[s]; } __builtin_amdgcn_sched_barrier(0); } while (0)
#define AT_QK(S_) do { S_ = negm; if (!(pmode & 16)) { __builtin_amdgcn_s_setprio(1); _Pragma("unroll") for (int s = 0; s < 9; ++s) S_ = __builtin_amdgcn_mfma_f32_32x32x16_f16(kfr[s], qfr[s], S_, 0, 0, 0); __builtin_amdgcn_s_setprio(0); } } while (0)
#define AT_VLOAD(db0_) do { _Pragma("unroll") for (int db = 0; db < 2; ++db) _Pragma("unroll") for (int sp = 0; sp < 2; ++sp) { \
            vlo_[db][sp] = __builtin_amdgcn_ds_read_tr16_b64_v4i16((LAS v4i16_t*)(sl_ + (16 * sp) * (KVP * 2) + 64 * ((db0_) + db))); \
            vhi_[db][sp] = __builtin_amdgcn_ds_read_tr16_b64_v4i16((LAS v4i16_t*)(sl_ + (16 * sp + 8) * (KVP * 2) + 64 * ((db0_) + db))); } } while (0)
#define AT_PV2(db0_) do { __builtin_amdgcn_s_setprio(1); _Pragma("unroll") for (int db = 0; db < 2; ++db) _Pragma("unroll") for (int sp = 0; sp < 2; ++sp) { \
            const s16x8 av_ = {vlo_[db][sp][0], vlo_[db][sp][1], vlo_[db][sp][2], vlo_[db][sp][3], vhi_[db][sp][0], vhi_[db][sp][1], vhi_[db][sp][2], vhi_[db][sp][3]}; \
            O[(db0_) + db] = __builtin_amdgcn_mfma_f32_32x32x16_f16(__builtin_bit_cast(h16x8, av_), pf_[sp], O[(db0_) + db], 0, 0, 0); } __builtin_amdgcn_s_setprio(0); } while (0)
#define AT_SMPV(S_, t_, so_) do { const LAS unsigned char* sl_ = (const LAS unsigned char*)(uintptr_t)(vbase + (so_)); \
        v4i16_t vlo_[2][2], vhi_[2][2]; \
        AT_VLOAD(0); \
        const int wq_ = (int)(WQr[(t_)] >> (4 * hf)); \
        __builtin_amdgcn_sched_barrier(0); \
        float mt_ = AT_MAX3(S_[0], S_[1], S_[2]); \
        _Pragma("unroll") for (int R = 3; R < 15; R += 2) mt_ = AT_MAX3(mt_, S_[R], S_[R + 1]); \
        mt_ = half_swap_max(AT_MAX3(mt_, S_[15], S_[15])); \
        if ((t_) == 0 || __any(mt_ > 8.0f)) { const float dl_ = (t_) == 0 ? mt_ : fmaxf(mt_, 0.f), alpha_ = (t_) == 0 ? 1.f : __builtin_amdgcn_exp2f(-dl_);     \
            _Pragma("unroll") for (int db = 0; db < 4; ++db) O[db] = O[db] * alpha_; \
            _Pragma("unroll") for (int R = 0; R < 16; ++R) S_[R] -= dl_; \
            lrun *= alpha_; mrun += dl_; \
            _Pragma("unroll") for (int R = 0; R < 16; ++R) negm[R] = -mrun; } \
        float p_[16]; \
        if (!(pmode & 1)) { _Pragma("unroll") for (int R = 0; R < 16; ++R) { const float e_ = __builtin_amdgcn_exp2f(S_[R]); p_[R] = AT_MASKED(e_, wq_, (R & 3) + 8 * (R >> 2)); lrun += p_[R]; } } \
        else { _Pragma("unroll") for (int R = 0; R < 16; ++R) p_[R] = S_[R]; lrun += p_[0]; } \
        h16x8 pf_[2]; \
        _Pragma("unroll") for (int sp = 0; sp < 2; ++sp) { u32x4 t4_; t4_.x = pkz(p_[8 * sp], p_[8 * sp + 1]); t4_.y = pkz(p_[8 * sp + 2], p_[8 * sp + 3]); t4_.z = pkz(p_[8 * sp + 4], p_[8 * sp + 5]); t4_.w = pkz(p_[8 * sp + 6], p_[8 * sp + 7]); pf_[sp] = __builtin_bit_cast(h16x8, t4_); } \
        __builtin_amdgcn_sched_barrier(0); \
        if (!(pmode & 2)) { AT_PV2(0); \
        __builtin_amdgcn_sched_barrier(0); \
        AT_VLOAD(2); \
        __builtin_amdgcn_sched_barrier(0); \
        AT_PV2(2); } else { O[0][0] += (float)pf_[0][0] + (float)pf_[1][0]; } } while (0)
#define AT_BOUNDARY2(g_) do {   \
        if (!(pmode & 4)) { asm volatile("s_waitcnt vmcnt(0) lgkmcnt(0)" ::: "memory"); __builtin_amdgcn_s_barrier(); asm volatile("" ::: "memory"); \
        if (2 * (g_) + 4 < NT) KV_DMA(2 * (g_) + 4); if (2 * (g_) + 5 < NT) KV_DMA(2 * (g_) + 5); } } while (0)
#define AT_NEXT(so_) ((so_) == 4 * C_KVSLOT ? 0 : (so_) + C_KVSLOT)
    const int NG = (NT + 1) >> 1;
    if (grp == 0) {
        int so = 0;
#pragma unroll 1
        for (int g = 0; g < NG; ++g) { const int t = 2 * g;
            { f32x16 Sx; AT_KLOAD(so); AT_QK(Sx); __builtin_amdgcn_sched_barrier(0); AT_SMPV(Sx, t, so); so = AT_NEXT(so); }
            if (t + 1 < NT) { f32x16 Sx; AT_KLOAD(so); AT_QK(Sx); __builtin_amdgcn_sched_barrier(0); AT_SMPV(Sx, t + 1, so); so = AT_NEXT(so); }
            AT_BOUNDARY2(g); }
    } else {
        f32x16 Sx; int so = 0, sop = 0;
        { AT_KLOAD(so); AT_QK(Sx); } sop = so; so = AT_NEXT(so);
        if (1 < NT) { AT_SMPV(Sx, 0, sop); __builtin_amdgcn_sched_barrier(0); { AT_KLOAD(so); AT_QK(Sx); } sop = so; so = AT_NEXT(so); }
        AT_BOUNDARY2(0);
#pragma unroll 1
        for (int g = 1; g < NG; ++g) { const int t = 2 * g;
            AT_SMPV(Sx, t - 1, sop); __builtin_amdgcn_sched_barrier(0); { AT_KLOAD(so); AT_QK(Sx); } sop = so; so = AT_NEXT(so);
            if (t + 1 < NT) { AT_SMPV(Sx, t, sop); __builtin_amdgcn_sched_barrier(0); { AT_KLOAD(so); AT_QK(Sx); } sop = so; so = AT_NEXT(so); }
            AT_BOUNDARY2(g); }
        AT_SMPV(Sx, NT - 1, sop);
    }
#undef AT_NEXT
#undef AT_MAX3
#undef AT_MASKED
#undef AT_BOUNDARY2
#undef KV_DMA
#undef KV_DMA1
#undef KV_WAIT
#undef AT_KLOAD
#undef AT_QK
#undef AT_SMPV
#undef AT_VLOAD
#undef AT_PV2
    if (!(pmode & 32)) {
    h16x8 bwv[2][8];
#pragma unroll
    for (int d2 = 0; d2 < 2; ++d2)
#pragma unroll
        for (int s = 0; s < 8; ++s) bwv[d2][s] = *(const GAS h16x8*)(WUVT + ((size_t)(h * 64 + 32 * d2 + r)) * 128 + 16 * s + 8 * hf);
    { const float inv = 1.0f / half_swap_sum(lrun);
#pragma unroll
      for (int db = 0; db < 4; ++db)
#pragma unroll
          for (int g = 0; g < 4; ++g) { const int c = 32 * db + 8 * g + 4 * hf;
              *(LAS u32x2*)(ql + r * KVP + c) = (u32x2){pkh(O[db][4 * g] * inv, O[db][4 * g + 1] * inv), pkh(O[db][4 * g + 2] * inv, O[db][4 * g + 3] * inv)}; } }
    LDS_WAIT();
    { h16x8 ao[8];
#pragma unroll
      for (int s = 0; s < 8; ++s) ao[s] = *(const LAS h16x8*)(ql + r * KVP + 16 * s + 8 * hf);
#pragma unroll
      for (int d2 = 0; d2 < 2; ++d2) { f32x16 D = {};
#pragma unroll
          for (int s = 0; s < 8; ++s) D = __builtin_amdgcn_mfma_f32_32x32x16_f16(bwv[d2][s], ao[s], D, 0, 0, 0);
#pragma unroll
          for (int g = 0; g < 4; ++g) { const u32x2 pk = {pkh(D[4 * g], D[4 * g + 1]), pkh(D[4 * g + 2], D[4 * g + 3])};
              if (do_store) *(GAS u32x2*)(QY + (tokbase + t0 + r) * 1024 + h * 64 + 32 * d2 + 8 * g + 4 * hf) = pk; else asm volatile("" :: "v"(pk)); } } }
    } else { asm volatile("" :: "v"(O[0][0]), "v"(O[1][0]), "v"(O[2][0]), "v"(O[3][0]), "v"(lrun)); }
    LDS_WAIT(); __syncthreads();
}

__device__ __forceinline__ void phaseC(const Frame& F, int l) {
    int vc = F.vcu; asm volatile("" : "+s"(vc)); const int b = vc >> 5, i = vc & 31;
#pragma unroll 1
    for (int u = 0; u < 2; ++u) { const int qt = (u == 0) ? 63 - i : i;
#if defined(PROBE_C_SEL)
#pragma unroll 1
        for (int rep = 0; rep < 2; ++rep)
        phaseC_select(F, l, b, qt, rep == 0 ? PROBE_C_SEL : 0);
#else
        phaseC_select(F, l, b, qt);
#endif
#if defined(PROBE_C_ATT)
#pragma unroll 1
        for (int rep = 0; rep < 2; ++rep) phaseC_attn(F, l, b, qt, rep == 1, rep == 1 ? 0 : PROBE_C_ATT);
#else
        phaseC_attn(F, l, b, qt);
#endif
    }
}
#if defined(PROBE_STORE)
#define PROBE_NOSTORE(f) (f)
#else
#define PROBE_NOSTORE(f) 0
#endif
#if defined(PROBE_EPI)
#define PROBE_NOEPI(f) (f)
#else
#define PROBE_NOEPI(f) 0
#endif
#ifndef PROBE_MASK
#define PROBE_MASK 0u
#endif
#ifndef MK_N_LAUNCHES
#define MK_N_LAUNCHES 1
#endif
#if MK_N_LAUNCHES == 1
constexpr bool FUSE_FINAL = false;
#else
constexpr bool FUSE_FINAL = false;
#endif
constexpr int N_PHASES = 2 + 7 * NLAYER;
constexpr int CONV_WD_FIRST = CONV_IN_ITEMS + 2 * 128 + 256 + (NGU / 64) * 16;
constexpr int CONV_SPLIT = 2150;
struct Args { In in; float* out; unsigned char* ws; int ph_lo, ph_hi, flags, pad; };

__global__ void __launch_bounds__(NTHREADS, 2) mk_fwd(Args args) {
    extern __shared__ __attribute__((aligned(16))) unsigned char lds_raw[];
    Frame F; F.lds = (LAS unsigned char*)lds_raw; F.wave = __builtin_amdgcn_readfirstlane((int)threadIdx.x >> 6);
    F.G = gridDim.x; { const int bx = blockIdx.x; F.vcu = (F.G % 8 == 0) ? (bx % 8) * (F.G / 8) + bx / 8 : bx; }
    F.ws = args.ws; F.in = nullptr;
    const In& I = args.in; unsigned char* ws = args.ws; (void)ws;
    volatile LAS unsigned* MISCW = (volatile LAS unsigned*)(F.lds + LDS_MISC);
    if (F.wave == 0) MISCW[lane_id()] = 0u;
    __syncthreads();
#if MK_N_LAUNCHES == 1
    const bool one_launch = true;
#else
    const bool one_launch = (args.ph_hi - args.ph_lo) > 1;
#endif
    XcdBarrier bar; bar.bar = (unsigned*)(ws + WS_CTL) + 1024; bar.x = 0; bar.st = nullptr;
    if (one_launch) bar = xcd_barrier_post((unsigned*)(ws + WS_CTL) + 1024, MISCW + 8, F.wave);
#if MK_N_LAUNCHES == 1
#define IN(k) true
#define SEAM(k) xcd_barrier(bar, F.wave)
#else
#define IN(k) (args.ph_lo <= (k) && (k) < args.ph_hi)
#define SEAM(k) do { if (IN(k) && IN((k) + 1)) xcd_barrier(bar, F.wave); } while (0)
#endif
    if (IN(0)) { p0_prologue(F, I); SEAM(0); }
#define OPQ(x) asm volatile("" : "+s"(x))
#pragma unroll 1
    for (int l0 = 0; l0 < NLAYER; ++l0) {
        const int p = 1 + 7 * l0;
        if (IN(p)) {
            unsigned char* wsq = args.ws; int l = l0; OPQ(wsq); OPQ(l); wsq = (unsigned char*)(GAS unsigned char*)wsq; unsigned char* wl = wsq + WS_W + (size_t)l * W_LAYER;
            pg8::Gemm g{(const h16*)(wsq + WS_X16), (const h16*)(wl + W_OFF_IN), 1024, 1024, 1024, M / 256, NZ / 256, 1, 0, PROBE_NOEPI(args.flags), 0};
            constexpr int NTILE = (M / 256) * (NZ / 256), NFULL = (NTILE / 256) * 256, NTAILWG = 2 * (NTILE - NFULL);
            const bool tailmode = (F.G == 256);
            pg8::Order S; S.init(g.nM, g.nN, F.G, (int)blockIdx.x, 1, tailmode ? NFULL : -1); EpiA E{wsq, PROBE_NOSTORE(args.flags), (LAS float*)(F.lds + 131072 + 4096)};
            pg8::gemm_phase<EpiA>(F.lds, g, S, E, F.wave);
            if (tailmode) {
                EpiA E2{wsq, PROBE_NOSTORE(args.flags), (LAS float*)(F.lds + 147456)};
                pg8::gemm_tail_phase<EpiA>(F.lds, g, S, E2, F.wave);
                if ((int)blockIdx.x >= NTAILWG) { const int cgw = ((int)blockIdx.x - NTAILWG) * NWAVES + F.wave, cng = (256 - NTAILWG) * NWAVES;
                    convert_layer_weights(F, I, l, cgw, cng, CONV_IN_ITEMS, 1 << 30);
                    if (l + 1 < NLAYER) convert_layer_weights(F, I, l + 1, cgw, cng, 0, CONV_IN_ITEMS); }
            } else { xcd_barrier(bar, F.wave); convert_layer_weights(F, I, l, F.vcu * NWAVES + F.wave, F.G * NWAVES, CONV_IN_ITEMS, 1 << 30); }
            SEAM(p); }
#if MK_N_LAUNCHES == 1
        if (IN(p + 1)) { int l = l0; OPQ(l); phaseB(F, I, l); }
#else
        if (IN(p + 1)) { int l = l0; OPQ(l); phaseB(F, I, l); SEAM(p + 1); }
#endif
        if (IN(p + 2)) { int l = l0; OPQ(l); phaseC(F, l); SEAM(p + 2); }
        if (IN(p + 3)) {
            unsigned char* wsq = args.ws; int l = l0; OPQ(wsq); OPQ(l); wsq = (unsigned char*)(GAS unsigned char*)wsq; unsigned char* wl = wsq + WS_W + (size_t)l * W_LAYER;
            pg8::Gemm g{(const h16*)(wsq + WS_QY), (const h16*)(wl + W_OFF_PAB), 1024, 1024, 512, M / 256, 4, 2, 512, PROBE_NOEPI(args.flags), 0};
            pg8::Order S; S.init(g.nM, g.nN, F.G, (int)blockIdx.x, 2); EpiD E{wsq, (h16*)args.out};
            pg8::gemm_phase<EpiD>(F.lds, g, S, E, F.wave); SEAM(p + 3); }
        if (IN(p + 4)) {
            unsigned char* wsq = args.ws; int l = l0; OPQ(wsq); OPQ(l); wsq = (unsigned char*)(GAS unsigned char*)wsq; unsigned char* wl = wsq + WS_W + (size_t)l * W_LAYER;
            pg8::Gemm g{(const h16*)args.out, (const h16*)(wl + W_OFF_OUT), 1024, 1024, 1024, M / 256, 4, 1, 0, PROBE_NOEPI(args.flags), 0};
            pg8::Order S; S.init(g.nM, g.nN, F.G, (int)blockIdx.x, 1);
            EpiRes E{(const h16*)(wsq + WS_X16), (h16*)(wsq + WS_X1), (float*)(wsq + WS_SSQ), (LAS float*)(F.lds + 131072)};
            pg8::gemm_phase<EpiRes>(F.lds, g, S, E, F.wave); SEAM(p + 4); }
        if (IN(p + 5)) {
            unsigned char* wsq = args.ws; int l = l0; OPQ(wsq); OPQ(l); wsq = (unsigned char*)(GAS unsigned char*)wsq; unsigned char* wl = wsq + WS_W + (size_t)l * W_LAYER;
            pg8::Gemm g{(const h16*)(wsq + WS_X1), (const h16*)(wl + W_OFF_GU), 1024, 1024, 1024, M / 256, NGU / 256, 1, 0, PROBE_NOEPI(args.flags), 0};
            constexpr int NTILE = (M / 256) * (NGU / 256), NFULL = (NTILE / 256) * 256;
            const bool tailmode = (F.G == 256);
            pg8::Order S; S.init(g.nM, g.nN, F.G, (int)blockIdx.x, 1, tailmode ? NFULL : -1); EpiF E{wsq, (LAS float*)(F.lds + 131072 + 4096)};
            pg8::gemm_phase<EpiF>(F.lds, g, S, E, F.wave);
            if (tailmode) { EpiF E2{wsq, (LAS float*)(F.lds + 147456)}; pg8::gemm_tail_phase<EpiF>(F.lds, g, S, E2, F.wave); }
            else if (l + 1 < NLAYER) { xcd_barrier(bar, F.wave); convert_layer_weights(F, I, l + 1, F.vcu * NWAVES + F.wave, F.G * NWAVES, 0, CONV_IN_ITEMS); }
            SEAM(p + 5); }
        if (IN(p + 6)) {
            unsigned char* wsq = args.ws; int l = l0; OPQ(wsq); OPQ(l); wsq = (unsigned char*)(GAS unsigned char*)wsq; unsigned char* wl = wsq + WS_W + (size_t)l * W_LAYER;
            pg8::Gemm g{(const h16*)(wsq + WS_ACT), (const h16*)(wl + W_OFF_D), DFF, DFF, DFF, M / 256, 4, 1, 0, PROBE_NOEPI(args.flags), 0};
            pg8::Order S; S.init(g.nM, g.nN, F.G, (int)blockIdx.x, 1);
            if (FUSE_FINAL && l == NLAYER - 1 && F.G == 256) {
                EpiFinal E{(const h16*)(wsq + WS_X1), args.out, args.in.final_norm, (float*)(wsq + WS_SSQ), (unsigned*)(wsq + WS_CTL) + 8192, (LAS float*)(F.lds + 131072)};
                pg8::gemm_phase<EpiFinal>(F.lds, g, S, E, F.wave);
            } else {
                EpiRes E{(const h16*)(wsq + WS_X1), (h16*)(wsq + WS_X16), (float*)(wsq + WS_SSQ), (LAS float*)(F.lds + 131072)};
                pg8::gemm_phase<EpiRes>(F.lds, g, S, E, F.wave); SEAM(p + 6); } }
    }
    if (IN(N_PHASES - 1) && !(FUSE_FINAL && F.G == 256)) final_norm_phase(F, (const h16*)(args.ws + WS_X16), (const float*)(args.ws + WS_SSQ), args.out, I.final_norm);
#undef IN
#undef SEAM
}

extern "C" void kernel_launch(void* const* d_in, const int* in_sizes, int n_in, void* d_out, int out_size, void* d_ws, size_t ws_size, hipStream_t stream) {
    static int grid = 0;
    if (grid == 0) {
        if (n_in != 19 || out_size != M * DM || ws_size < WS_END) { fprintf(stderr, "kernel_launch: unexpected shapes (n_in %d out %d ws %zu)\n", n_in, out_size, ws_size); grid = -1; return; }
        int dev = 0, cus = 0, per_cu = 0;
        hipGetDevice(&dev); hipDeviceGetAttribute(&cus, hipDeviceAttributeMultiprocessorCount, dev);
        hipFuncSetAttribute((const void*)mk_fwd, hipFuncAttributeMaxDynamicSharedMemorySize, LDS_BYTES);
        hipOccupancyMaxActiveBlocksPerMultiprocessor(&per_cu, (const void*)mk_fwd, NTHREADS, LDS_BYTES);
        (void)hipGetLastError();
        if (per_cu < 1) fprintf(stderr, "kernel_launch: occupancy query reports %d blocks per CU\n", per_cu);
        grid = cus < 256 ? cus : 256;
        if (grid != 256) fprintf(stderr, "kernel_launch: %d CUs: this kernel's work split assumes 256 workgroups\n", cus);
    }
    if (grid < 0) return;
    hipMemsetAsync((char*)d_ws + WS_CTL, 0, CTL_ZERO_BYTES, stream);
    Args a{};
    const void** ip = (const void**)&a.in;
    for (int i = 0; i < 19; ++i) ip[i] = d_in[i];
    a.out = (float*)d_out; a.ws = (unsigned char*)d_ws;
#if MK_N_LAUNCHES == 1
    a.ph_lo = 0; a.ph_hi = N_PHASES;
    { void* kargs[] = {&a}; hipError_t e = hipLaunchCooperativeKernel((const void*)mk_fwd, dim3(grid), dim3(NTHREADS), kargs, LDS_BYTES, stream);
      if (e != hipSuccess) fprintf(stderr, "cooperative launch failed: %s (grid %d)\n", hipGetErrorString(e), grid); }
#else
    for (int p = 0; p < N_PHASES; ++p) { const int reps = ((PROBE_MASK >> p) & 1u) ? 2 : 1;
        for (int rr = 0; rr < reps; ++rr) { a.ph_lo = p; a.ph_hi = p + 1; a.flags = (rr > 0) ? 1 : 0; hipLaunchKernelGGL(mk_fwd, dim3(grid), dim3(NTHREADS), LDS_BYTES, stream, a); } }
#endif
}
```

```cpp
#define MK_N_LAUNCHES 1
#include <hip/hip_runtime.h>
#include <stdint.h>
#include <math.h>
#include <cstdio>

#define LAS __attribute__((address_space(3)))
#define GAS __attribute__((address_space(1)))
typedef _Float16 h16;
typedef h16 h16x8 __attribute__((ext_vector_type(8)));
typedef h16 h16x4 __attribute__((ext_vector_type(4)));
typedef h16 h16x2 __attribute__((ext_vector_type(2)));
typedef float f32x2 __attribute__((ext_vector_type(2)));
typedef float f32x4 __attribute__((ext_vector_type(4)));
typedef float f32x16 __attribute__((ext_vector_type(16)));
typedef unsigned u32x2 __attribute__((ext_vector_type(2)));
typedef unsigned u32x4 __attribute__((ext_vector_type(4)));
typedef short v4i16_t __attribute__((ext_vector_type(4)));

__device__ __forceinline__ int lane_id() { return (int)__builtin_amdgcn_mbcnt_hi(~0u, __builtin_amdgcn_mbcnt_lo(~0u, 0u)); }
__device__ __forceinline__ unsigned pkh(float lo, float hi) { h16x2 v = {(h16)lo, (h16)hi}; return __builtin_bit_cast(unsigned, v); }
__device__ __forceinline__ unsigned pkz(float lo, float hi) { return __builtin_bit_cast(unsigned, __builtin_amdgcn_cvt_pkrtz(lo, hi)); }
__device__ __forceinline__ void store16_wt(void* p, u32x4 v) { asm volatile("global_store_dwordx4 %0, %1, off sc1\n\ts_nop 1" :: "v"(p), "v"(v) : "memory"); }
__device__ __forceinline__ float h2f_lo(unsigned u) { h16x2 v = __builtin_bit_cast(h16x2, u); return (float)v[0]; }
__device__ __forceinline__ float h2f_hi(unsigned u) { h16x2 v = __builtin_bit_cast(h16x2, u); return (float)v[1]; }

namespace pg8 {
constexpr int BM = 256, BK = 64, HALF = 128, HTB = HALF * BK * 2, STAGE_BYTES = 8 * HTB, NXCD = 8, WGM = 4;
__host__ __device__ __forceinline__ int lds_byte(int r, int c) { const int st = (r >> 4) * 2 + (c >> 5), rr = r & 15, cc = c & 31, ob = rr * 64 + cc * 2; return st * 1024 + (ob ^ (((ob >> 9) & 1) << 5)); }
__host__ __device__ __forceinline__ void stage_rc(int b, int& R, int& C) { const int st = b / 1024, sb = b % 1024, swz = sb ^ (((sb >> 9) & 1) << 5); R = (st >> 1) * 16 + swz / 64; C = (st & 1) * 32 + (swz % 64) / 2; }
__host__ __device__ __forceinline__ int perm32(int rho) { const int n = rho >> 4, i = rho & 15; return 8 * (i >> 2) + 4 * n + (i & 3); }

struct Unit { int pm, pn, kind, half; };
struct Gemm { const h16* A; const h16* Bt; int lda, ldb, K, nM, nN, nkind, koff, noepi, stagger; };

struct Order {
    int nM, nN, nwg, G, c, nk, lim;
    __device__ void init(int nM_, int nN_, int G_, int c_, int nk_, int lim_ = -1) { asm volatile("" : "+s"(G_), "+s"(c_)); nM = nM_; nN = nN_; nwg = nM * nN; G = G_; c = c_; nk = nk_; lim = lim_ < 0 ? nwg : lim_; }
    __device__ void tile_of(int L, Unit& u) const {
        int wgid = L; { const int q = nwg / NXCD, r = nwg % NXCD, xcd = wgid % NXCD, off = wgid / NXCD; wgid = (xcd < r ? xcd * (q + 1) : r * (q + 1) + (xcd - r) * q) + off; }
        const int nig = WGM * nN, gid = wgid / nig, fm = gid * WGM, gsz = (nM - fm) < WGM ? (nM - fm) : WGM;
        u.pm = fm + ((wgid % nig) % gsz); u.pn = (wgid % nig) / gsz;
    }
    __device__ bool next(int i, Unit& u) const {
        const int ti = i / nk; u.kind = i - ti * nk; u.half = -1;
        const long L = (long)ti * G + c; if (L >= lim) return false;
        tile_of((int)L, u); return true;
    }
};

template <class Epi>
__device__ __forceinline__ void gemm_phase(LAS unsigned char* lds, const Gemm g, const Order& S, const Epi& E, int wave_) {
    int tid = wave_ * 64 + lane_id(); asm volatile("" : "+v"(tid));
    const int wid = __builtin_amdgcn_readfirstlane(tid >> 6), lane = tid & 63, wr = wid >> 2, wc = wid & 3, fr = lane & 15, fq = lane >> 4;
    const int nt = g.K / BK;
    unsigned voffA[2], voffB[2];
#pragma unroll
    for (int i = 0; i < 2; ++i) { int R, C; stage_rc(tid * 16 + i * 8192, R, C); const int Rb = Epi::PERM ? ((R & ~31) + perm32(R & 31)) : R;
        voffA[i] = (unsigned)(R * g.lda + C) * 2u; voffB[i] = (unsigned)(Rb * g.ldb + C) * 2u; }
    const size_t kstep = (size_t)(BK * 2);
    const size_t hstepA = (size_t)HALF * g.lda * 2, hstepB = (size_t)HALF * g.ldb * 2;
    const unsigned ldsw = (unsigned)wid * 1024u;
    const int aoff = lds_byte(wr * 64 + fr, fq * 8), boff = lds_byte(wc * 32 + fr, fq * 8);
#define PG8_SA(b, h) (((b) * 2 + (h)) * HTB)
#define PG8_SB(b, h) ((4 + (b) * 2 + (h)) * HTB)
#define PG8_STAGE(bufoff, gbase, voff) do { _Pragma("unroll") for (int _i = 0; _i < 2; ++_i) \
        __builtin_amdgcn_global_load_lds((const unsigned*)((const char*)(gbase) + (voff)[_i]), (LAS unsigned*)(lds + (bufoff) + ldsw + _i * 8192), 16, 0, 0); } while (0)
#define PG8_LDA(dst, b, h) do { _Pragma("unroll") for (int m = 0; m < 4; ++m) _Pragma("unroll") for (int k = 0; k < 2; ++k) dst[m][k] = *(const LAS h16x8*)(lds + PG8_SA(b, h) + aoff + m * 2048 + k * 1024); } while (0)
#define PG8_LDB(dst, b, h) do { _Pragma("unroll") for (int n = 0; n < 2; ++n) _Pragma("unroll") for (int k = 0; k < 2; ++k) dst[n][k] = *(const LAS h16x8*)(lds + PG8_SB(b, h) + boff + n * 2048 + k * 1024); } while (0)
#define PG8_MMA(ai, bj, At, Bt) do { __builtin_amdgcn_s_setprio(1); _Pragma("unroll") for (int m = 0; m < 4; ++m) _Pragma("unroll") for (int n = 0; n < 2; ++n) _Pragma("unroll") for (int k = 0; k < 2; ++k) \
        acc[ai][bj][m][n] = __builtin_amdgcn_mfma_f32_16x16x32_f16(Bt[n][k], At[m][k], acc[ai][bj][m][n], 0, 0, 0); __builtin_amdgcn_s_setprio(0); } while (0)
#define PG8_WAIT_V(n) asm volatile("s_waitcnt vmcnt(" #n ")" ::: "memory")
#define PG8_WAIT_L(n) asm volatile("s_waitcnt lgkmcnt(" #n ")" ::: "memory")
#define PG8_BAR __builtin_amdgcn_s_barrier()
#define PG8_SCHED __builtin_amdgcn_sched_barrier(0)
#define PG8_PA(u) ((const char*)g.A + ((size_t)(u).pm * 256 * g.lda + (size_t)(u).kind * g.koff) * 2)
#define PG8_PB(u) ((const char*)g.Bt + ((size_t)(u).pn * 256 * g.ldb + (size_t)(u).kind * g.koff) * 2)
    Unit cur, nxt; int ui = 0;
    if (!S.next(0, cur)) return;
    { const int nbig = S.nwg % S.G;
      if (nbig > 0 && S.c >= nbig && g.stagger) { const int ngrp = S.G / nbig, j = S.c / nbig; const unsigned long long dl = (unsigned long long)((g.K / BK) * 140 + 100) * S.nk * j / ngrp;
          const unsigned long long t0 = __builtin_amdgcn_s_memrealtime(); while (__builtin_amdgcn_s_memrealtime() - t0 < dl) __builtin_amdgcn_s_sleep(32); } }
    f32x4 acc[2][2][4][2];
#pragma unroll
    for (int a = 0; a < 2; ++a)
#pragma unroll
        for (int b = 0; b < 2; ++b)
#pragma unroll
            for (int m = 0; m < 4; ++m)
#pragma unroll
                for (int n = 0; n < 2; ++n) acc[a][b][m][n] = (f32x4){0.f, 0.f, 0.f, 0.f};
    h16x8 At[4][2], B0[2][2], B1[2][2];
    const char* cA = PG8_PA(cur); const char* cB = PG8_PB(cur);
    E.prefetch(cur, wid, lane);
    PG8_STAGE(PG8_SB(0, 0), cB, voffB); PG8_STAGE(PG8_SB(0, 1), cB + hstepB, voffB); PG8_STAGE(PG8_SA(0, 0), cA, voffA); PG8_STAGE(PG8_SA(0, 1), cA + hstepA, voffA);
    if (wr == 1) PG8_BAR;
    PG8_WAIT_V(2); PG8_BAR;
    PG8_STAGE(PG8_SB(1, 0), cB + kstep, voffB); PG8_STAGE(PG8_SA(1, 0), cA + kstep, voffA); PG8_STAGE(PG8_SB(1, 1), cB + hstepB + kstep, voffB);
    PG8_WAIT_V(6); PG8_BAR;
    for (;;) {
        const bool has_next = S.next(ui + 1, nxt);
        const char* nA = has_next ? PG8_PA(nxt) : cA; const char* nB = has_next ? PG8_PB(nxt) : cB;
        for (int t = 0; t < nt; t += 2) {
            const bool last = (t == nt - 2);
            const char* a1 = cA + (size_t)(t + 1) * kstep;
            const char* a2 = last ? nA : cA + (size_t)(t + 2) * kstep; const char* b2 = last ? nB : cB + (size_t)(t + 2) * kstep;
            const char* a3 = a2 + kstep; const char* b3 = b2 + kstep;
            PG8_LDB(B0, 0, 0); PG8_LDB(B1, 0, 1); PG8_SCHED; PG8_LDA(At, 0, 0); PG8_STAGE(PG8_SA(1, 1), a1 + hstepA, voffA);
            PG8_WAIT_V(8); PG8_WAIT_L(0); PG8_BAR; PG8_MMA(0, 0, At, B0); PG8_MMA(0, 1, At, B1); PG8_BAR; PG8_SCHED;
            PG8_LDA(At, 0, 1); PG8_STAGE(PG8_SB(0, 0), b2, voffB); PG8_STAGE(PG8_SB(0, 1), b2 + hstepB, voffB); PG8_STAGE(PG8_SA(0, 0), a2, voffA);
            PG8_WAIT_V(8); PG8_WAIT_L(0); PG8_BAR; PG8_MMA(1, 0, At, B0); PG8_MMA(1, 1, At, B1); PG8_BAR; PG8_SCHED;
            PG8_LDB(B0, 1, 0); PG8_LDB(B1, 1, 1); PG8_SCHED; PG8_LDA(At, 1, 0); PG8_STAGE(PG8_SA(0, 1), a2 + hstepA, voffA);
            PG8_WAIT_V(8); PG8_WAIT_L(0); PG8_BAR; PG8_MMA(0, 0, At, B0); PG8_MMA(0, 1, At, B1); PG8_BAR; PG8_SCHED;
            PG8_LDA(At, 1, 1); PG8_STAGE(PG8_SB(1, 0), b3, voffB); PG8_STAGE(PG8_SB(1, 1), b3 + hstepB, voffB); PG8_STAGE(PG8_SA(1, 0), a3, voffA);
            PG8_WAIT_V(8); PG8_WAIT_L(0); PG8_BAR; PG8_MMA(1, 0, At, B0); PG8_MMA(1, 1, At, B1); PG8_BAR; PG8_SCHED;
        }
        if (wr == 0) PG8_BAR;
        { int fr_ = fr, fq_ = fq; asm volatile("" : "+v"(fr_), "+v"(fq_)); if (!g.noepi) E(acc, cur, wr, wc, fr_, fq_); }
        if (!has_next) break;
        if (nxt.kind == 0) {
#pragma unroll
            for (int a = 0; a < 2; ++a)
#pragma unroll
                for (int b = 0; b < 2; ++b)
#pragma unroll
                    for (int m = 0; m < 4; ++m)
#pragma unroll
                        for (int n = 0; n < 2; ++n) acc[a][b][m][n] = (f32x4){0.f, 0.f, 0.f, 0.f};
        }
        cur = nxt; cA = nA; cB = nB; ++ui;
        if (cur.kind == 0) E.prefetch(cur, wid, lane);
        if (wr == 1) PG8_BAR;
    }
    PG8_WAIT_V(0);
    PG8_BAR;
#undef PG8_SA
#undef PG8_SB
#undef PG8_STAGE
#undef PG8_LDA
#undef PG8_LDB
#undef PG8_MMA
#undef PG8_WAIT_V
#undef PG8_WAIT_L
#undef PG8_BAR
#undef PG8_SCHED
#undef PG8_PA
#undef PG8_PB
}

template <class Epi>
__device__ __forceinline__ void gemm_tail_phase(LAS unsigned char* lds, const Gemm g, const Order& S, const Epi& E, int wave_) {
    const int ntail = S.nwg - S.lim;
    if (ntail <= 0 || S.c >= 2 * ntail) return;
    int tid = wave_ * 64 + lane_id(); asm volatile("" : "+v"(tid));
    const int wid = __builtin_amdgcn_readfirstlane(tid >> 6), lane = tid & 63, wr = wid >> 2, wc = wid & 3, fr = lane & 15, fq = lane >> 4;
    Unit cur; S.tile_of(S.lim + S.c % ntail, cur); cur.kind = 0; cur.half = S.c / ntail;
    const int nt = g.K / BK;
    unsigned voffA[2], voffB[2];
#pragma unroll
    for (int i = 0; i < 2; ++i) { int R, C; stage_rc(tid * 16 + i * 8192, R, C); const int Rb = Epi::PERM ? ((R & ~31) + perm32(R & 31)) : R;
        voffA[i] = (unsigned)(R * g.lda + C) * 2u; voffB[i] = (unsigned)(Rb * g.ldb + C) * 2u; }
    const size_t kstep = (size_t)(BK * 2);
    const size_t hstepA = (size_t)HALF * g.lda * 2, hstepB = (size_t)HALF * g.ldb * 2;
    const unsigned ldsw = (unsigned)wid * 1024u;
    const int aoff = lds_byte(wr * 64 + fr, fq * 8), boff = lds_byte(wc * 32 + fr, fq * 8);
    constexpr int TSTG = 3 * HTB;
    const char* cA = (const char*)g.A + ((size_t)cur.pm * 256 * g.lda) * 2 + (size_t)cur.half * hstepA; const char* cB = (const char*)g.Bt + ((size_t)cur.pn * 256 * g.ldb) * 2;
#define PT_STAGE(bufoff, gbase, voff) do { _Pragma("unroll") for (int _i = 0; _i < 2; ++_i) \
        __builtin_amdgcn_global_load_lds((const unsigned*)((const char*)(gbase) + (voff)[_i]), (LAS unsigned*)(lds + (bufoff) + ldsw + _i * 8192), 16, 0, 0); } while (0)
#define PT_STAGE_TILE(kt) do { const int so_ = ((kt) % 3) * TSTG; const char* a_ = cA + (size_t)(kt) * kstep; const char* b_ = cB + (size_t)(kt) * kstep; \
        PT_STAGE(so_, a_, voffA); PT_STAGE(so_ + HTB, b_, voffB); PT_STAGE(so_ + 2 * HTB, b_ + hstepB, voffB); } while (0)
#define PT_LD(kt) do { const int so_ = ((kt) % 3) * TSTG; \
        _Pragma("unroll") for (int n = 0; n < 2; ++n) _Pragma("unroll") for (int k_ = 0; k_ < 2; ++k_) { B0[n][k_] = *(const LAS h16x8*)(lds + so_ + HTB + boff + n * 2048 + k_ * 1024); B1[n][k_] = *(const LAS h16x8*)(lds + so_ + 2 * HTB + boff + n * 2048 + k_ * 1024); } \
        _Pragma("unroll") for (int m = 0; m < 4; ++m) _Pragma("unroll") for (int k_ = 0; k_ < 2; ++k_) At[m][k_] = *(const LAS h16x8*)(lds + so_ + aoff + m * 2048 + k_ * 1024); } while (0)
#define PT_MMA(bj, Bt_) do { __builtin_amdgcn_s_setprio(1); _Pragma("unroll") for (int m = 0; m < 4; ++m) _Pragma("unroll") for (int n = 0; n < 2; ++n) _Pragma("unroll") for (int k_ = 0; k_ < 2; ++k_) \
        acc[0][bj][m][n] = __builtin_amdgcn_mfma_f32_16x16x32_f16(Bt_[n][k_], At[m][k_], acc[0][bj][m][n], 0, 0, 0); __builtin_amdgcn_s_setprio(0); } while (0)
#define PT_WAIT_V(n) asm volatile("s_waitcnt vmcnt(" #n ")" ::: "memory")
#define PT_WAIT_L0 asm volatile("s_waitcnt lgkmcnt(0)" ::: "memory")
#define PT_BAR __builtin_amdgcn_s_barrier()
    f32x4 acc[2][2][4][2];
#pragma unroll
    for (int a = 0; a < 2; ++a)
#pragma unroll
        for (int b = 0; b < 2; ++b)
#pragma unroll
            for (int m = 0; m < 4; ++m)
#pragma unroll
                for (int n = 0; n < 2; ++n) acc[a][b][m][n] = (f32x4){0.f, 0.f, 0.f, 0.f};
    h16x8 At[4][2], B0[2][2], B1[2][2];
    E.prefetch(cur, wid, lane);
    PT_STAGE_TILE(0); PT_STAGE_TILE(1); PT_STAGE_TILE(2);
    PT_WAIT_V(12); PT_BAR;
    if (wr == 1) PT_BAR;
    if (wr == 0) {
#pragma unroll 1
        for (int k = 0; k < nt; ++k) {
            if (k >= 1 && k + 2 < nt) PT_STAGE_TILE(k + 2);
            PT_LD(k); PT_WAIT_L0; PT_BAR;
            PT_MMA(0, B0); PT_MMA(1, B1);
            if (k + 2 < nt) PT_WAIT_V(6); else PT_WAIT_V(0);
            PT_BAR; }
        PT_BAR;
    } else {
#pragma unroll 1
        for (int k = 0; k < nt; ++k) {
            if (k >= 1 && k + 2 < nt) PT_STAGE_TILE(k + 2);
            PT_LD(k); PT_WAIT_L0;
            if (k + 2 < nt) PT_WAIT_V(6); else PT_WAIT_V(0);
            PT_BAR;
            PT_MMA(0, B0); PT_MMA(1, B1);
            PT_BAR; }
    }
    { int fr_ = fr, fq_ = fq; asm volatile("" : "+v"(fr_), "+v"(fq_)); if (!g.noepi) E(acc, cur, wr, wc, fr_, fq_); }
#undef PT_STAGE
#undef PT_STAGE_TILE
#undef PT_LD
#undef PT_MMA
#undef PT_WAIT_V
#undef PT_WAIT_L0
#undef PT_BAR
}
}
constexpr int NWAVES = 8, NTHREADS = 512;
constexpr int NB = 8, SEQ = 2048, DM = 1024, M = NB * SEQ, DIN = 4312, DFF = 2816, NLAYER = 2;
constexpr int NZ = 4352;
constexpr int NGU = 2 * DFF;
constexpr float EPS_RMS = 1e-6f;
constexpr float LOG2E = 1.4426950408889634f;
constexpr float QSCALE = 0.125f * LOG2E;
constexpr int KVP = 152;

constexpr size_t MiB = 1u << 20;
constexpr size_t WS_CTL = 0, CTL_ZERO_BYTES = 65536;
constexpr size_t WS_CS = 1 * MiB;
constexpr size_t WS_SSQ = 2 * MiB;
constexpr size_t WS_WI = 3 * MiB;
constexpr size_t WS_SMALLW = 4 * MiB;
constexpr size_t SMALLW_LAYER = 98304 + 131072 + 262144;
constexpr size_t WS_W = 6 * MiB;
constexpr size_t W_LAYER = 29 * MiB, W_OFF_IN = 0, W_OFF_PAB = (size_t)NZ * 1024 * 2, W_OFF_OUT = W_OFF_PAB + 2 * MiB, W_OFF_GU = W_OFF_OUT + 2 * MiB, W_OFF_D = W_OFF_GU + (size_t)NGU * 1024 * 2;
static_assert(W_OFF_D + (size_t)1024 * DFF * 2 == W_LAYER, "weight map");
constexpr size_t WS_X16 = 64 * MiB;
constexpr size_t WS_QY = 96 * MiB;
constexpr size_t WS_QI = 128 * MiB;
constexpr size_t WS_MISC = 144 * MiB;
constexpr size_t WS_KV = 152 * MiB;
constexpr size_t WS_KI = 157 * MiB;
constexpr size_t WS_X1 = 128 * MiB;
constexpr size_t WS_GATES = 160 * MiB;
constexpr size_t WS_UV = 224 * MiB;
constexpr size_t WS_ACT = 160 * MiB;
constexpr size_t WS_END = 256 * MiB;
static_assert(WS_KV + (size_t)M * KVP * 2 <= WS_KI && WS_KI + (size_t)M * 64 * 2 <= WS_GATES && WS_ACT + (size_t)M * DFF * 2 <= WS_END, "ws map");

constexpr int LDS_BYTES = 155648;
constexpr int LDS_MISC = 151552;

#define RLX_AGENT __ATOMIC_RELAXED, __HIP_MEMORY_SCOPE_AGENT
#define LDS_WAIT() asm volatile("s_waitcnt lgkmcnt(0)" ::: "memory")
#define VM_WAIT() asm volatile("s_waitcnt vmcnt(0)" ::: "memory")

#define XB_TMO      128
#define XB_XCNT(j)  (256  + 64 * (j))
#define XB_XSUB(j)  (1280 + 64 * (j))
#define XB_XGEN(j)  (2304 + 64 * (j))
#define XB_TOP      3328
#define XB_TOPGEN   3392
#define XCD_BAR_WORDS 3456
#define XB_SPIN_CAP (1u << 18)
__device__ __forceinline__ unsigned xb_ld(unsigned* p)              { return __hip_atomic_load(p, __ATOMIC_RELAXED, __HIP_MEMORY_SCOPE_AGENT); }
__device__ __forceinline__ unsigned xb_add(unsigned* p, unsigned v) { return __hip_atomic_fetch_add(p, v, __ATOMIC_RELAXED, __HIP_MEMORY_SCOPE_AGENT); }
__device__ __forceinline__ unsigned xb_xcc_id() { return (unsigned)__builtin_amdgcn_s_getreg((3 << 11) | 20) & 0xFu; }
#define XB_SPIN(cond, bar) do { unsigned _sp = 0; while (cond) { __builtin_amdgcn_s_sleep(1); \
    if ((++_sp & 255u) == 0u) { if (xb_ld(&(bar)[XB_TMO])) break; if (_sp > XB_SPIN_CAP) { atomicAdd(&(bar)[XB_TMO], 1u); break; } } } } while (0)
struct XcdBarrier { unsigned* bar; unsigned x; volatile LAS unsigned* st; };
__device__ __forceinline__ XcdBarrier xcd_barrier_post(unsigned* bar, volatile LAS unsigned* st, int wave_) {
    XcdBarrier b; b.bar = bar; b.x = xb_xcc_id(); b.st = st;
    if (wave_ == 0 && lane_id() == 0) (void)xb_add(&bar[XB_XCNT(b.x)], 1u);
    return b;
}
__device__ __forceinline__ void xcd_barrier_complete(unsigned* bar, unsigned x, unsigned& nloc, unsigned& nx) {
    const unsigned G = gridDim.x * gridDim.y * gridDim.z;
    unsigned sum, cnt, mine, sp = 0u;
    for (;;) {
        sum = 0u; cnt = 0u; mine = 0u;
#pragma unroll
        for (unsigned j = 0; j < 16; ++j) { const unsigned c = xb_ld(&bar[XB_XCNT(j)]); sum += c; cnt += (c > 0u) ? 1u : 0u; }
        mine = xb_ld(&bar[XB_XCNT(x)]);
        if (sum == G) break;
        __builtin_amdgcn_s_sleep(1);
        if ((++sp & 255u) == 0u) { if (xb_ld(&bar[XB_TMO])) break; if (sp > XB_SPIN_CAP) { atomicAdd(&bar[XB_TMO], 1u); break; } }
    }
    nloc = mine > 0u ? mine : 1u; nx = cnt > 0u ? cnt : 1u;
}
__device__ __forceinline__ void xcd_barrier(const XcdBarrier& b, int wave_) {
    asm volatile("s_waitcnt vmcnt(0)" ::: "memory");
    __syncthreads();
    if (wave_ == 0 && lane_id() == 0) {
        unsigned* bar = b.bar; asm volatile("" : "+s"(bar));
        unsigned stoff = (unsigned)(uintptr_t)b.st; asm volatile("" : "+s"(stoff)); volatile LAS unsigned* st = (volatile LAS unsigned*)(uintptr_t)stoff;
        const unsigned x = xb_xcc_id();
        __builtin_amdgcn_s_waitcnt(0);
        unsigned nloc = st[0], nx = st[1];
        if (nloc == 0u) { xcd_barrier_complete(bar, x, nloc, nx); st[0] = nloc; st[1] = nx; }
        const unsigned old = xb_add(&bar[XB_XSUB(x)], 1u);
        const unsigned gen = old / nloc;
        if (old + 1u == (gen + 1u) * nloc) {
            __builtin_amdgcn_fence(__ATOMIC_RELEASE, "agent");
            asm volatile("s_waitcnt vmcnt(0)" ::: "memory");
            const unsigned og = xb_add(&bar[XB_TOP], 1u);
            const unsigned tg = og / nx;
            if (og + 1u == (tg + 1u) * nx) xb_add(&bar[XB_TOPGEN], 1u);
            else XB_SPIN(xb_ld(&bar[XB_TOPGEN]) == tg, bar);
            __builtin_amdgcn_fence(__ATOMIC_ACQUIRE, "agent");
            asm volatile("s_waitcnt vmcnt(0)" ::: "memory");
        } else {
            XB_SPIN(xb_ld(&bar[XB_TOPGEN]) == gen, bar);
            __builtin_amdgcn_fence(__ATOMIC_ACQUIRE, "agent");
            asm volatile("s_waitcnt vmcnt(0)" ::: "memory");
        }
    }
    __syncthreads();
}

__device__ __forceinline__ float gelu_tanh_f(float x) {
    const float u = 0.7978845608028654f * (x + 0.044715f * x * x * x);
    const float e = __builtin_amdgcn_exp2f(-2.0f * LOG2E * u);
    return x * __builtin_amdgcn_rcpf(1.0f + e);
}
__device__ __forceinline__ float sigmoid_f(float x) { return __builtin_amdgcn_rcpf(1.0f + __builtin_amdgcn_exp2f(-LOG2E * x)); }

struct Frame {
    LAS unsigned char* lds;
    int wave, vcu, G;
    unsigned char* ws;
    const float* const* in;
};
struct In {
    const float* x; const int* pos; const float* norm_mix; const float* w_in; const float* kv_norm; const float* w_uk; const float* w_uv; const float* ln_v_g; const float* ln_v_b;
    const float* w_s; const float* b_s; const float* w_proj_a; const float* w_proj_b; const float* w_out; const float* norm_ffn; const float* w_gate; const float* w_up; const float* w_down; const float* final_norm;
};

__device__ __constant__ float c_inv[8] = {1.0f, 0.19392274474868576f, 0.03760603093086393f, 0.007292664737217109f, 0.001414213562373095f, 0.0002742481756762073f, 5.318295896944988e-05f, 1.031338537721246e-05f};

__device__ __forceinline__ void transpose_item64(const float* W4, int Nsrc, h16* WT, int ldt, int n0, int k0, const float* gain, LAS float* scr, int lane) {
    const int nq = lane & 15, kq = lane >> 4;
    f32x4 v[16];
#pragma unroll
    for (int i = 0; i < 16; ++i) v[i] = W4 ? *(const GAS f32x4*)(W4 + (size_t)(k0 + 4 * i + kq) * Nsrc) : (f32x4){0.f, 0.f, 0.f, 0.f};
#pragma unroll
    for (int i = 0; i < 16; ++i) { const int kk = 4 * i + kq; f32x4 x = v[i]; if (gain) x = x * gain[k0 + kk]; *(LAS f32x4*)(scr + kk * 68 + 4 * (nq ^ (kk >> 3))) = x; }
    LDS_WAIT(); asm volatile("" ::: "memory");
    const int c = lane & 7;
#pragma unroll
    for (int j = 0; j < 8; ++j) { const int n = (lane >> 3) + 8 * j; const LAS float* sp = scr + (8 * c) * 68 + 4 * ((n >> 2) ^ c) + (n & 3);
        u32x4 o; o.x = pkh(sp[0 * 68], sp[1 * 68]); o.y = pkh(sp[2 * 68], sp[3 * 68]); o.z = pkh(sp[4 * 68], sp[5 * 68]); o.w = pkh(sp[6 * 68], sp[7 * 68]);
        *(GAS u32x4*)(WT + (size_t)(n0 + n) * ldt + k0 + 8 * c) = o; }
    LDS_WAIT(); asm volatile("" ::: "memory");
}
__device__ __forceinline__ int win_src_col(int n) {
    if (n < 512) return n;
    if (n < 1024) return 656 + (n - 512);
    if (n < 2048) return 1240 + (n - 1024);
    if (n < 4096) return 2264 + (n - 2048);
    if (n < 4224) return 512 + (n - 4096);
    if (n < 4240) return 640 + (n - 4224);
    if (n < 4304) return 1168 + (n - 4240);
    if (n < 4312) return 1232 + (n - 4304);
    return -1;
}
constexpr int CONV_IN_ITEMS = (NZ / 64) * 16;
__device__ __forceinline__ void convert_layer_weights(const Frame& F, const In& I, int l, int gw, int NGW, int it_lo = 0, int it_hi = 1 << 30) {
    LAS float* scr = (LAS float*)(F.lds + F.wave * 17408);
    int lane = lane_id(); asm volatile("" : "+v"(lane));
    constexpr int I_IN = (NZ / 64) * 16, I_PA = 16 * 8, I_OUT = 16 * 16, I_GU = (NGU / 64) * 16, I_D = 16 * (DFF / 64);
    constexpr int I_LAYER = I_IN + 2 * I_PA + I_OUT + I_GU + I_D;
    const int n4 = 4 * (lane & 15);
    unsigned char* wl = F.ws + WS_W + (size_t)l * W_LAYER;
    if (it_hi > I_LAYER) it_hi = I_LAYER;
    for (int it = it_lo + gw; it < it_hi; it += NGW) {
        int r = it;
        if (r < I_IN) { const int nb = r / 16, kb = r % 16, sc = win_src_col(nb * 64 + n4);
            transpose_item64(sc >= 0 ? I.w_in + (size_t)l * DM * DIN + sc : nullptr, DIN, (h16*)(wl + W_OFF_IN), 1024, nb * 64, kb * 64, I.norm_mix + l * DM, scr, lane); continue; }
        r -= I_IN;
        if (r < I_PA) { const int nb = r / 8, kb = r % 8;
            transpose_item64(I.w_proj_a + (size_t)l * 512 * 1024 + nb * 64 + n4, 1024, (h16*)(wl + W_OFF_PAB), 1024, nb * 64, kb * 64, nullptr, scr, lane); continue; }
        r -= I_PA;
        if (r < I_PA) { const int nb = r / 8, kb = r % 8;
            transpose_item64(I.w_proj_b + (size_t)l * 512 * 1024 + nb * 64 + n4, 1024, (h16*)(wl + W_OFF_PAB) + 512, 1024, nb * 64, kb * 64, nullptr, scr, lane); continue; }
        r -= I_PA;
        if (r < I_OUT) { const int nb = r / 16, kb = r % 16;
            transpose_item64(I.w_out + (size_t)l * 1024 * 1024 + nb * 64 + n4, 1024, (h16*)(wl + W_OFF_OUT), 1024, nb * 64, kb * 64, nullptr, scr, lane); continue; }
        r -= I_OUT;
        if (r < I_GU) { const int nb = r / 16, kb = r % 16, R = nb * 64 + n4, pn = R >> 8, rem = R & 255;
            const int a = 128 * pn + 64 * (rem >> 7) + 16 * ((rem >> 5) & 3) + 4 * ((rem >> 3) & 3);
            const float* src = (((rem >> 2) & 1) ? I.w_up : I.w_gate) + (size_t)l * DM * DFF + a;
            transpose_item64(src, DFF, (h16*)(wl + W_OFF_GU), 1024, nb * 64, kb * 64, I.norm_ffn + l * DM, scr, lane); continue; }
        r -= I_GU;
        { const int nb = r / (DFF / 64), kb = r % (DFF / 64);
            transpose_item64(I.w_down + (size_t)l * DFF * 1024 + nb * 64 + n4, 1024, (h16*)(wl + W_OFF_D), DFF, nb * 64, kb * 64, nullptr, scr, lane); }
    }
}
__device__ __forceinline__ void p0_prologue(const Frame& F, const In& I) {
    int lane = lane_id(); asm volatile("" : "+v"(lane));
    const int hw = F.wave & 3, gw = F.vcu * 4 + hw, NGW = F.G * 4;
    if (F.wave >= 4) {
    convert_layer_weights(F, I, 0, gw, NGW, 0, CONV_IN_ITEMS);
    const int gt = F.vcu * 256 + hw * 64 + lane, NGT = F.G * 256;
    for (int i0 = gt; i0 < NLAYER * 49152; i0 += 2 * NGT) { float va[2], vg[2];
#pragma unroll
        for (int u = 0; u < 2; ++u) { const int i = i0 + u * NGT; if (i < NLAYER * 49152) { const int l = i / 49152, e = i % 49152, h = e / (128 * 48), c = (e / 48) % 128, n = e % 48;
            va[u] = I.w_uk[(((size_t)l * 8 + h) * 48 + n) * 128 + c]; vg[u] = I.kv_norm[l * 128 + c]; } }
#pragma unroll
        for (int u = 0; u < 2; ++u) { const int i = i0 + u * NGT; if (i < NLAYER * 49152) { const int l = i / 49152, e = i % 49152;
            ((h16*)(F.ws + WS_SMALLW + (size_t)l * SMALLW_LAYER))[e] = (h16)(va[u] * vg[u]); } } }
    for (int i0 = gt; i0 < NLAYER * 65536; i0 += 2 * NGT) { float va[2], vg[2];
#pragma unroll
        for (int u = 0; u < 2; ++u) { const int i = i0 + u * NGT; if (i < NLAYER * 65536) { const int l = i / 65536, e = i % 65536, h = e / (64 * 128), d = (e / 128) % 64, c = e % 128;
            va[u] = I.w_uv[(((size_t)l * 8 + h) * 128 + c) * 64 + d]; vg[u] = I.kv_norm[l * 128 + c]; } }
#pragma unroll
        for (int u = 0; u < 2; ++u) { const int i = i0 + u * NGT; if (i < NLAYER * 65536) { const int l = i / 65536, e = i % 65536;
            ((h16*)(F.ws + WS_SMALLW + (size_t)l * SMALLW_LAYER + 98304))[e] = (h16)(va[u] * vg[u]); } } }
    for (int i0 = gt; i0 < NLAYER * 131072; i0 += 4 * NGT) { float va[4];
#pragma unroll
        for (int u = 0; u < 4; ++u) { const int i = i0 + u * NGT; if (i < NLAYER * 131072) va[u] = I.w_s[i]; }
#pragma unroll
        for (int u = 0; u < 4; ++u) { const int i = i0 + u * NGT; if (i < NLAYER * 131072) { const int l = i / 131072, e = i % 131072, t = (e / 128) % 128, sx = e % 128;
            ((h16*)(F.ws + WS_SMALLW + (size_t)l * SMALLW_LAYER + 98304 + 131072))[e] = (sx <= t) ? (h16)va[u] : (h16)0.f; } } }
    for (int i0 = gt; i0 < M * 8; i0 += 2 * NGT) { int pv[2];
#pragma unroll
        for (int u = 0; u < 2; ++u) { const int i = i0 + u * NGT; if (i < M * 8) pv[u] = I.pos[i >> 3]; }
#pragma unroll
        for (int u = 0; u < 2; ++u) { const int i = i0 + u * NGT; if (i < M * 8) { const int tok = i >> 3, f = i & 7; const float ang = (float)pv[u] * c_inv[f];
            float* cs = (float*)(F.ws + WS_CS) + (size_t)tok * 16; cs[f] = cosf(ang); cs[8 + f] = sinf(ang); } } }
    } else {
    for (int m = gw; m < M; m += 4 * NGW) {
        f32x4 v[4][4];
#pragma unroll
        for (int k = 0; k < 4; ++k) { const int mm = m + k * NGW; if (mm < M) { const f32x4* xr = (const f32x4*)(I.x + (size_t)mm * DM) + lane;
#pragma unroll
            for (int j = 0; j < 4; ++j) v[k][j] = xr[64 * j]; } }
#pragma unroll
        for (int k = 0; k < 4; ++k) { const int mm = m + k * NGW; if (mm < M) { u32x2* o8 = (u32x2*)((h16*)(F.ws + WS_X16) + (size_t)mm * DM) + lane; float s = 0.f;
#pragma unroll
            for (int j = 0; j < 4; ++j) { const f32x4 t = v[k][j]; s += (t.x * t.x + t.y * t.y) + (t.z * t.z + t.w * t.w); o8[64 * j] = (u32x2){pkh(t.x, t.y), pkh(t.z, t.w)}; }
            s += __shfl_xor(s, 1); s += __shfl_xor(s, 2); s += __shfl_xor(s, 4); s += __shfl_xor(s, 8);
            if ((lane & 15) == 0) ((GAS float*)(F.ws + WS_SSQ))[(size_t)mm * 4 + (lane >> 4)] = s; } }
    }
    }
}

__device__ __forceinline__ float row_rstd(const float* ssq, int row) {
    const f32x4 a = *(const GAS f32x4*)(ssq + (size_t)row * 4);
    return rsqrtf(((a.x + a.y) + (a.z + a.w)) * (1.0f / DM) + EPS_RMS);
}

typedef f32x4 Acc[2][2][4][2];
__device__ __forceinline__ u32x4 pack8h(const float (&v)[8]) { u32x4 w; w.x = pkz(v[0], v[1]); w.y = pkz(v[2], v[3]); w.z = pkz(v[4], v[5]); w.w = pkz(v[6], v[7]); return w; }
__device__ __forceinline__ u32x4 pack8r(const float (&v)[8]) { u32x4 w; w.x = pkh(v[0], v[1]); w.y = pkh(v[2], v[3]); w.z = pkh(v[4], v[5]); w.w = pkh(v[6], v[7]); return w; }

__device__ __forceinline__ void ssq_prefetch(const float* ssq, int pm, LAS float* R4, int wid, int lane) {
    if (wid < 4) __builtin_amdgcn_global_load_lds((const unsigned*)(ssq + (size_t)(pm * 256 + wid * 64 + lane) * 4), (LAS unsigned*)(R4 + wid * 256), 16, 0, 0);
}
__device__ __forceinline__ float rstd_from_lds(const LAS float* R4, int rl) { const f32x4 a = *(const LAS f32x4*)(R4 + rl * 4); return rsqrtf(((a.x + a.y) + (a.z + a.w)) * (1.0f / DM) + EPS_RMS); }
struct EpiA {
    static constexpr bool PERM = true;
    unsigned char* ws; int nostore; LAS float* R;
    __device__ __forceinline__ void prefetch(const pg8::Unit& u, int wid, int lane) const { ssq_prefetch((const float*)(ws + WS_SSQ), u.pm, R, wid, lane); }
    __device__ __forceinline__ void misc_tile(Acc& acc, const pg8::Unit& u, int wr, int wc, int fr, int fq) const {
        const int nai = u.half < 0 ? 2 : 1, rofs = u.half < 0 ? 0 : 128 * u.half;
        const unsigned row0 = (unsigned)(u.pm * 256 + rofs + wr * 64 + fr); LAS float* P = R - 1024;
        GAS unsigned char* wsg = (GAS unsigned char*)ws;
#pragma unroll
        for (int ai = 0; ai < 2; ++ai) if (ai < nai)
#pragma unroll
            for (int m = 0; m < 4; ++m) { const int rl = rofs + ai * 128 + wr * 64 + m * 16 + fr; const float rs = rstd_from_lds(R, rl); float ss = 0.f;
#pragma unroll
                for (int bj = 0; bj < 2; ++bj) { acc[ai][bj][m][0] *= rs; acc[ai][bj][m][1] *= rs; }
#pragma unroll
                for (int i = 0; i < 8; ++i) { const float z = acc[ai][0][m][i >> 2][i & 3]; ss = fmaf(z, z, ss); }
                ss += __shfl_xor(ss, 16); ss += __shfl_xor(ss, 32);
                if (fq == 0) P[rl * 4 + wc] = ss; }
        asm volatile("s_waitcnt lgkmcnt(0)" ::: "memory"); __builtin_amdgcn_s_barrier(); asm volatile("" ::: "memory");
#pragma unroll
        for (int ai = 0; ai < 2; ++ai) if (ai < nai)
#pragma unroll
            for (int m = 0; m < 4; ++m) { const int rl = rofs + ai * 128 + wr * 64 + m * 16 + fr; const unsigned row = row0 + (unsigned)(ai * 128 + m * 16);
                const f32x4 pv = *(const LAS f32x4*)(P + rl * 4); const float rk = rsqrtf(((pv.x + pv.y) + (pv.z + pv.w)) * (1.0f / 128.f) + EPS_RMS);
                { float o[8];
#pragma unroll
                  for (int i = 0; i < 8; ++i) o[i] = acc[ai][0][m][i >> 2][i & 3] * rk;
                  *(GAS u32x4*)(wsg + ((unsigned)WS_KV + row * (unsigned)(KVP * 2) + (unsigned)(wc * 64 + 16 * fq))) = pack8r(o); }
                if (wc == 0) {
                    const unsigned co = (unsigned)WS_CS + row * 64u;
                    const f32x4 c0 = *(const GAS f32x4*)(wsg + co), c1 = *(const GAS f32x4*)(wsg + co + 16u), s0 = *(const GAS f32x4*)(wsg + co + 32u), s1 = *(const GAS f32x4*)(wsg + co + 48u);
                    float o[8];
#pragma unroll
                    for (int i = 0; i < 8; ++i) { const float own = acc[ai][1][m][i >> 2][i & 3], oth = __shfl_xor(own, 16); const float c = i < 4 ? c0[i & 3] : c1[i & 3], sn = i < 4 ? s0[i & 3] : s1[i & 3];
                        o[i] = (fq & 1) ? (own * c + oth * sn) : (own * c - oth * sn); }
                    const unsigned dst = fq < 2 ? (unsigned)WS_KV + row * (unsigned)(KVP * 2) + 256u + 16u * (unsigned)fq : (unsigned)WS_KI + row * 128u + 16u * (unsigned)(fq - 2);
                    *(GAS u32x4*)(wsg + dst) = pack8r(o);
                } else if (wc == 1) {
                    float o[8];
#pragma unroll
                    for (int i = 0; i < 8; ++i) o[i] = acc[ai][1][m][i >> 2][i & 3];
                    *(GAS u32x4*)(wsg + ((unsigned)WS_KI + row * 128u + 32u + 16u * (unsigned)fq)) = pack8r(o);
                } else if (wc == 2) {
                    if (fq < 2) { float o[8];
#pragma unroll
                        for (int i = 0; i < 8; ++i) o[i] = acc[ai][1][m][i >> 2][i & 3];
                        *(GAS u32x4*)(wsg + ((unsigned)WS_KI + row * 128u + 96u + 16u * (unsigned)fq)) = pack8r(o); }
                    else if (fq == 2) { const float sc = 0.35355339059327373f * 0.125f; const unsigned wo = (unsigned)WS_WI + row * 32u;
                        *(GAS f32x4*)(wsg + wo) = acc[ai][1][m][0] * sc; *(GAS f32x4*)(wsg + wo + 16u) = acc[ai][1][m][1] * sc; }
                    else { u32x4 z4 = {0u, 0u, 0u, 0u}; asm volatile("" : "+v"(z4)); *(GAS u32x4*)(wsg + ((unsigned)WS_KV + row * (unsigned)(KVP * 2) + 288u)) = z4; }
                } }
        asm volatile("s_waitcnt lgkmcnt(0)" ::: "memory"); __builtin_amdgcn_s_barrier(); asm volatile("" ::: "memory");
    }
    __device__ __forceinline__ void operator()(Acc& acc, const pg8::Unit& u, int wr, int wc, int fr, int fq) const {
        const int pn = u.pn; h16* base; int ldc, colt;
        if (pn == 16) { misc_tile(acc, u, wr, wc, fr, fq); return; }
        if (pn < 2) { base = (h16*)(ws + WS_QY); ldc = 1024; colt = pn * 256; }
        else if (pn < 4) { base = (h16*)(ws + WS_QI); ldc = 512; colt = (pn - 2) * 256; }
        else if (pn < 8) { base = (h16*)(ws + WS_UV); ldc = 1024; colt = (pn - 4) * 256; }
        else { base = (h16*)(ws + WS_GATES); ldc = 2048; colt = (pn - 8) * 256; }
        const int nai = u.half < 0 ? 2 : 1, rofs = u.half < 0 ? 0 : 128 * u.half;
        const int row0 = u.pm * 256 + rofs + wr * 64 + fr, col0 = colt + wc * 32 + 8 * fq;
#pragma unroll
        for (int ai = 0; ai < 2; ++ai) if (ai < nai)
#pragma unroll
            for (int m = 0; m < 4; ++m) { const int row = row0 + ai * 128 + m * 16; const float rs = rstd_from_lds(R, rofs + ai * 128 + wr * 64 + m * 16 + fr); h16* rowp = base + (size_t)row * ldc + col0;
#pragma unroll
                for (int bj = 0; bj < 2; ++bj) { f32x4 v0 = acc[ai][bj][m][0] * rs, v1 = acc[ai][bj][m][1] * rs;
                    u32x4 w; w.x = pkz(v0[0], v0[1]); w.y = pkz(v0[2], v0[3]); w.z = pkz(v1[0], v1[1]); w.w = pkz(v1[2], v1[3]);
                    if (!nostore) *(GAS u32x4*)(rowp + bj * 128) = w; else asm volatile("" :: "v"(w)); } }
        asm volatile("s_waitcnt lgkmcnt(0)" ::: "memory"); __builtin_amdgcn_s_barrier(); asm volatile("" ::: "memory");
    }
};

struct EpiD {
    static constexpr bool PERM = true;
    unsigned char* ws; h16* mg;
    __device__ __forceinline__ void prefetch(const pg8::Unit&, int, int) const {}
    __device__ __forceinline__ void operator()(Acc& acc, const pg8::Unit& u, int wr, int wc, int fr, int fq) const {
        const int row0 = u.pm * 256 + wr * 64 + fr, col0 = u.pn * 256 + wc * 32 + 8 * fq;
        const h16* gates = (const h16*)(ws + WS_GATES);
#pragma unroll
        for (int ai = 0; ai < 2; ++ai) {
            h16x8 gbv[4][2], gav[4][2];
#pragma unroll
            for (int m = 0; m < 4; ++m)
#pragma unroll
                for (int bj = 0; bj < 2; ++bj) { const size_t off = (size_t)(row0 + ai * 128 + m * 16) * 2048 + col0 + bj * 128;
                    gbv[m][bj] = *(const GAS h16x8*)(gates + off + 1024); if (u.kind == 0) gav[m][bj] = *(const GAS h16x8*)(gates + off); }
#pragma unroll
            for (int m = 0; m < 4; ++m) { const int row = row0 + ai * 128 + m * 16;
#pragma unroll
                for (int bj = 0; bj < 2; ++bj) { const int col = col0 + bj * 128; const h16x8 gb = gbv[m][bj];
                    if (u.kind == 0) { const h16x8 ga = gav[m][bj];
#pragma unroll
                        for (int i = 0; i < 8; ++i) { const float ea = __builtin_amdgcn_exp2f(fminf(-LOG2E * (float)ga[i], 64.f)), eb = __builtin_amdgcn_exp2f(fminf(-LOG2E * (float)gb[i], 64.f));
                            acc[ai][bj][m][i >> 2][i & 3] *= (1.0f + eb) * __builtin_amdgcn_rcpf(1.0f + ea); }
                    } else { float v[8];
#pragma unroll
                        for (int i = 0; i < 8; ++i) { const float eb = __builtin_amdgcn_exp2f(fminf(-LOG2E * (float)gb[i], 64.f)); v[i] = acc[ai][bj][m][i >> 2][i & 3] * __builtin_amdgcn_rcpf(1.0f + eb); }
                        u32x4 w; w.x = pkz(v[0], v[1]); w.y = pkz(v[2], v[3]); w.z = pkz(v[4], v[5]); w.w = pkz(v[6], v[7]);
                        *(GAS u32x4*)(mg + (size_t)row * 1024 + col) = w; } } }
            asm volatile("" ::: "memory"); }
    }
};

struct EpiRes {
    static constexpr bool PERM = true;
    const h16* resid; h16* xo; float* ssq; LAS float* P;
    __device__ __forceinline__ void prefetch(const pg8::Unit&, int, int) const {}
    __device__ __forceinline__ void operator()(Acc& acc, const pg8::Unit& u, int wr, int wc, int fr, int fq) const {
        const int row0 = u.pm * 256 + wr * 64 + fr, col0 = u.pn * 256 + wc * 32 + 8 * fq;
        h16x8 rvv[2][4][2];
#pragma unroll
        for (int ai = 0; ai < 2; ++ai)
#pragma unroll
            for (int m = 0; m < 4; ++m)
#pragma unroll
                for (int bj = 0; bj < 2; ++bj) rvv[ai][m][bj] = *(const GAS h16x8*)(resid + (size_t)(row0 + ai * 128 + m * 16) * 1024 + col0 + bj * 128);
#pragma unroll
        for (int ai = 0; ai < 2; ++ai)
#pragma unroll
            for (int m = 0; m < 4; ++m) { const int row = row0 + ai * 128 + m * 16; float ss = 0.f;
#pragma unroll
                for (int bj = 0; bj < 2; ++bj) { const size_t off = (size_t)row * 1024 + col0 + bj * 128;
                    const h16x8 rv = rvv[ai][m][bj]; float v[8];
#pragma unroll
                    for (int i = 0; i < 8; ++i) { v[i] = (float)rv[i] + acc[ai][bj][m][i >> 2][i & 3]; ss = fmaf(v[i], v[i], ss); }
                    *(GAS u32x4*)(xo + off) = pack8h(v); }
                ss += __shfl_xor(ss, 16); ss += __shfl_xor(ss, 32);
                if (fq == 0) P[(ai * 128 + wr * 64 + m * 16 + fr) * 4 + wc] = ss; }
        asm volatile("s_waitcnt lgkmcnt(0)" ::: "memory"); __builtin_amdgcn_s_barrier(); asm volatile("" ::: "memory");
        { const int t = (wr * 4 + wc) * 64 + fq * 16 + fr; if (t < 256) { const f32x4 v = *(const LAS f32x4*)(P + t * 4); ((GAS float*)ssq)[(size_t)(u.pm * 256 + t) * 4 + u.pn] = (v.x + v.y) + (v.z + v.w); } }
        asm volatile("s_waitcnt lgkmcnt(0)" ::: "memory"); __builtin_amdgcn_s_barrier(); asm volatile("" ::: "memory");
    }
};

struct EpiFinal {
    static constexpr bool PERM = true;
    const h16* resid; float* out; const float* gfin; float* ssq; unsigned* cnt; LAS float* P;
    __device__ __forceinline__ void prefetch(const pg8::Unit&, int, int) const {}
    __device__ __forceinline__ void operator()(Acc& acc, const pg8::Unit& u, int wr, int wc, int fr, int fq) const {
        const int row0 = u.pm * 256 + wr * 64 + fr, col0 = u.pn * 256 + wc * 32 + 8 * fq;
        LAS float* S = P + 1024;
        { h16x8 rvv[2][4][2];
#pragma unroll
          for (int ai = 0; ai < 2; ++ai)
#pragma unroll
              for (int m = 0; m < 4; ++m)
#pragma unroll
                  for (int bj = 0; bj < 2; ++bj) rvv[ai][m][bj] = *(const GAS h16x8*)(resid + (size_t)(row0 + ai * 128 + m * 16) * 1024 + col0 + bj * 128);
#pragma unroll
          for (int ai = 0; ai < 2; ++ai)
#pragma unroll
              for (int m = 0; m < 4; ++m) { float ss = 0.f;
#pragma unroll
                  for (int bj = 0; bj < 2; ++bj) { const h16x8 rv = rvv[ai][m][bj];
#pragma unroll
                      for (int i = 0; i < 8; ++i) { const float v = (float)rv[i] + acc[ai][bj][m][i >> 2][i & 3]; acc[ai][bj][m][i >> 2][i & 3] = v; ss = fmaf(v, v, ss); } }
                  ss += __shfl_xor(ss, 16); ss += __shfl_xor(ss, 32);
                  if (fq == 0) P[(ai * 128 + wr * 64 + m * 16 + fr) * 4 + wc] = ss; } }
        asm volatile("s_waitcnt lgkmcnt(0)" ::: "memory"); __builtin_amdgcn_s_barrier(); asm volatile("" ::: "memory");
        const int t = (wr * 4 + wc) * 64 + fq * 16 + fr, wid = wr * 4 + wc;
        if (t < 256) { const f32x4 v = *(const LAS f32x4*)(P + t * 4);
            __hip_atomic_store((GAS float*)ssq + (size_t)(u.pm * 256 + t) * 4 + u.pn, (v.x + v.y) + (v.z + v.w), __ATOMIC_RELAXED, __HIP_MEMORY_SCOPE_AGENT); }
        asm volatile("s_waitcnt vmcnt(0)" ::: "memory");
        unsigned* c = cnt + 64 * u.pm;
        if ((fq * 16 + fr) == 0) __hip_atomic_fetch_add(c, 1u, __ATOMIC_RELAXED, __HIP_MEMORY_SCOPE_AGENT);
        if (wid == 0) {
            const unsigned long long t0 = __builtin_amdgcn_s_memrealtime();
            while ((unsigned)__builtin_amdgcn_readfirstlane((int)__hip_atomic_load(c, __ATOMIC_RELAXED, __HIP_MEMORY_SCOPE_AGENT)) < 32u) {
                if (__builtin_amdgcn_s_memrealtime() - t0 > 2000000ull) break;
                __builtin_amdgcn_s_sleep(2); }
            __builtin_amdgcn_fence(__ATOMIC_ACQUIRE, "agent");
            asm volatile("s_waitcnt vmcnt(0)" ::: "memory"); }
        asm volatile("s_waitcnt lgkmcnt(0)" ::: "memory"); __builtin_amdgcn_s_barrier(); asm volatile("" ::: "memory");
        if (t < 256) { const GAS float* sp = (const GAS float*)ssq + (size_t)(u.pm * 256 + t) * 4; float sum = 0.f;
#pragma unroll
            for (int k = 0; k < 4; ++k) sum += __hip_atomic_load(sp + k, __ATOMIC_RELAXED, __HIP_MEMORY_SCOPE_AGENT);
            S[t] = rsqrtf(sum * (1.0f / DM) + EPS_RMS); }
        asm volatile("s_waitcnt lgkmcnt(0)" ::: "memory"); __builtin_amdgcn_s_barrier(); asm volatile("" ::: "memory");
        f32x4 gv[2][2];
#pragma unroll
        for (int bj = 0; bj < 2; ++bj) { gv[bj][0] = *(const f32x4*)(gfin + col0 + bj * 128); gv[bj][1] = *(const f32x4*)(gfin + col0 + bj * 128 + 4); }
#pragma unroll
        for (int ai = 0; ai < 2; ++ai)
#pragma unroll
            for (int m = 0; m < 4; ++m) { const int rl = ai * 128 + wr * 64 + m * 16 + fr; const float rs = S[rl]; float* op = out + (size_t)(u.pm * 256 + rl) * 1024 + col0;
#pragma unroll
                for (int bj = 0; bj < 2; ++bj) { *(GAS f32x4*)(op + bj * 128) = acc[ai][bj][m][0] * rs * gv[bj][0]; *(GAS f32x4*)(op + bj * 128 + 4) = acc[ai][bj][m][1] * rs * gv[bj][1]; } }
    }
};

struct EpiF {
    static constexpr bool PERM = true;
    unsigned char* ws; LAS float* R;
    __device__ __forceinline__ void prefetch(const pg8::Unit& u, int wid, int lane) const { ssq_prefetch((const float*)(ws + WS_SSQ), u.pm, R, wid, lane); }
    __device__ __forceinline__ void operator()(Acc& acc, const pg8::Unit& u, int wr, int wc, int fr, int fq) const {
        const int nai = u.half < 0 ? 2 : 1, rofs = u.half < 0 ? 0 : 128 * u.half;
        const int row0 = u.pm * 256 + rofs + wr * 64 + fr, col0 = u.pn * 128 + wc * 16 + 4 * fq;
        h16* act = (h16*)(ws + WS_ACT);
#pragma unroll
        for (int ai = 0; ai < 2; ++ai) if (ai < nai)
#pragma unroll
            for (int m = 0; m < 4; ++m) { const int row = row0 + ai * 128 + m * 16; const float rs = rstd_from_lds(R, rofs + ai * 128 + wr * 64 + m * 16 + fr);
#pragma unroll
                for (int bj = 0; bj < 2; ++bj) { const f32x4 g = acc[ai][bj][m][0] * rs, uu = acc[ai][bj][m][1] * rs; float v[4];
#pragma unroll
                    for (int i = 0; i < 4; ++i) v[i] = g[i] * sigmoid_f(g[i]) * uu[i];
                    *(GAS u32x2*)(act + (size_t)row * DFF + col0 + bj * 64) = (u32x2){pkz(v[0], v[1]), pkz(v[2], v[3])}; } }
        asm volatile("s_waitcnt lgkmcnt(0)" ::: "memory"); __builtin_amdgcn_s_barrier(); asm volatile("" ::: "memory");
    }
};

__device__ __forceinline__ void final_norm_phase(const Frame& F, const h16* x16, const float* ssq, float* out, const float* g) {
    int lane = lane_id(); asm volatile("" : "+v"(lane));
    const int gw = F.vcu * NWAVES + F.wave, NGW = F.G * NWAVES;
    f32x4 gv[4];
#pragma unroll
    for (int k = 0; k < 4; ++k) gv[k] = *(const f32x4*)(g + 256 * k + 4 * lane);
    for (int m0 = gw; m0 < M; m0 += 8 * NGW) {
        u32x2 xv[8][4]; f32x4 sq[8];
#pragma unroll
        for (int r = 0; r < 8; ++r) { const int m = m0 + r * NGW; if (m < M) { sq[r] = *(const GAS f32x4*)(ssq + (size_t)m * 4);
#pragma unroll
            for (int k = 0; k < 4; ++k) xv[r][k] = *(const GAS u32x2*)(x16 + (size_t)m * DM + 256 * k + 4 * lane); } }
#pragma unroll
        for (int r = 0; r < 8; ++r) { const int m = m0 + r * NGW; if (m < M) { const float rs = rsqrtf(((sq[r].x + sq[r].y) + (sq[r].z + sq[r].w)) * (1.0f / DM) + EPS_RMS);
#pragma unroll
            for (int k = 0; k < 4; ++k) { const u32x2 p = xv[r][k]; const f32x4 gk = gv[k];
                *(GAS f32x4*)(out + (size_t)m * DM + 256 * k + 4 * lane) = (f32x4){h2f_lo(p.x) * rs * gk.x, h2f_hi(p.x) * rs * gk.y, h2f_lo(p.y) * rs * gk.z, h2f_hi(p.y) * rs * gk.w}; } } }
    }
}
__device__ __forceinline__ unsigned wlane(unsigned val, int ln, unsigned old) {
    unsigned keep;
    asm volatile("s_mov_b32 %1, m0\n\ts_mov_b32 m0, %3\n\ts_nop 3\n\tv_writelane_b32 %0, %2, m0\n\ts_mov_b32 m0, %1" : "+v"(old), "=&s"(keep) : "s"(val), "s"(ln));
    return old;
}
__device__ __forceinline__ void cnt_ge(int& c, float x, float m) { asm("v_cmp_ge_f32 vcc, %1, %2\n\tv_addc_co_u32 %0, vcc, 0, %0, vcc" : "+v"(c) : "v"(x), "v"(m) : "vcc"); }
__device__ __forceinline__ void cnt_gt(int& c, float x, float m) { asm("v_cmp_gt_f32 vcc, %1, %2\n\tv_addc_co_u32 %0, vcc, 0, %0, vcc" : "+v"(c) : "v"(x), "v"(m) : "vcc"); }
#define SEL_C8(OP, m_, a0, a1, a2, a3, a4, a5, a6, a7) \
    "v_cmp_" OP "_f32 vcc, " a0 ", " m_ "\n\tv_cmp_" OP "_f32 %2, " a1 ", " m_ "\n\tv_cmp_" OP "_f32 %3, " a2 ", " m_ "\n\tv_cmp_" OP "_f32 %4, " a3 ", " m_ "\n\t" \
    "v_cmp_" OP "_f32 %5, " a4 ", " m_ "\n\tv_cmp_" OP "_f32 %6, " a5 ", " m_ "\n\tv_cmp_" OP "_f32 %7, " a6 ", " m_ "\n\tv_cmp_" OP "_f32 %8, " a7 ", " m_ "\n\t"
#define SEL_A8(c_) \
    "v_addc_co_u32 " c_ ", vcc, 0, " c_ ", vcc\n\tv_addc_co_u32 " c_ ", %2, 0, " c_ ", %2\n\tv_addc_co_u32 " c_ ", %3, 0, " c_ ", %3\n\tv_addc_co_u32 " c_ ", %4, 0, " c_ ", %4\n\t" \
    "v_addc_co_u32 " c_ ", %5, 0, " c_ ", %5\n\tv_addc_co_u32 " c_ ", %6, 0, " c_ ", %6\n\tv_addc_co_u32 " c_ ", %7, 0, " c_ ", %7\n\tv_addc_co_u32 " c_ ", %8, 0, " c_ ", %8\n\t"
#define SEL_CGROUP(NAME, OP) __device__ __forceinline__ void NAME(int& c0, int& c1, const float* s, float m0, float m1) { unsigned long long t1, t2, t3, t4, t5, t6, t7; \
    asm(SEL_C8(OP, "%25", "%9", "%11", "%13", "%15", "%17", "%19", "%21", "%23") SEL_A8("%0") SEL_C8(OP, "%26", "%10", "%12", "%14", "%16", "%18", "%20", "%22", "%24") SEL_A8("%1") \
        : "+v"(c0), "+v"(c1), "=&s"(t1), "=&s"(t2), "=&s"(t3), "=&s"(t4), "=&s"(t5), "=&s"(t6), "=&s"(t7) \
        : "v"(s[0]), "v"(s[1]), "v"(s[2]), "v"(s[3]), "v"(s[4]), "v"(s[5]), "v"(s[6]), "v"(s[7]), "v"(s[8]), "v"(s[9]), "v"(s[10]), "v"(s[11]), "v"(s[12]), "v"(s[13]), "v"(s[14]), "v"(s[15]), "v"(m0), "v"(m1) : "vcc"); }
SEL_CGROUP(cnt_group_ge, "ge")
SEL_CGROUP(cnt_group_gt, "gt")
__device__ __forceinline__ void ballot_ge_to_lane(unsigned& wlo, unsigned& whi, float x, float tau, int ln) {
    unsigned keep;
    asm volatile("v_cmp_ge_f32 vcc, %3, %4\n\ts_mov_b32 %2, m0\n\ts_mov_b32 m0, %5\n\ts_nop 3\n\tv_writelane_b32 %0, vcc_lo, m0\n\tv_writelane_b32 %1, vcc_hi, m0\n\ts_mov_b32 m0, %2"
                 : "+v"(wlo), "+v"(whi), "=&s"(keep) : "v"(x), "v"(tau), "s"(ln) : "vcc");
}
__device__ __forceinline__ int half_sum_dpp(int v, int hf) {
    v += __builtin_amdgcn_update_dpp(0, v, 0x111, 0xf, 0xf, true);
    v += __builtin_amdgcn_update_dpp(0, v, 0x112, 0xf, 0xf, true);
    v += __builtin_amdgcn_update_dpp(0, v, 0x114, 0xf, 0xf, true);
    v += __builtin_amdgcn_update_dpp(0, v, 0x118, 0xf, 0xf, true);
    v += __builtin_amdgcn_update_dpp(0, v, 0x142, 0xa, 0xf, false);
    const int s0 = __builtin_amdgcn_readlane(v, 31), s1 = __builtin_amdgcn_readlane(v, 63);
    return hf ? s1 : s0;
}
__device__ __forceinline__ int crow(int R, int hf) { return (R & 3) + 8 * (R >> 2) + 4 * hf; }
__device__ __forceinline__ float half_swap_max(float v) { auto rr = __builtin_amdgcn_permlane32_swap(__float_as_uint(v), __float_as_uint(v), false, false); return fmaxf(__uint_as_float(rr[0]), __uint_as_float(rr[1])); }
__device__ __forceinline__ float half_swap_sum(float v) { auto rr = __builtin_amdgcn_permlane32_swap(__float_as_uint(v), __float_as_uint(v), false, false); return __uint_as_float(rr[0]) + __uint_as_float(rr[1]); }
__device__ __forceinline__ void rope8(const h16x8 x1, const h16x8 x2, const float* cs, int which, float scale, float (&o)[8]) {
    const f32x4 c0 = *(const GAS f32x4*)(cs), c1 = *(const GAS f32x4*)(cs + 4), s0 = *(const GAS f32x4*)(cs + 8), s1 = *(const GAS f32x4*)(cs + 12);
#pragma unroll
    for (int j = 0; j < 8; ++j) { const float c = j < 4 ? c0[j & 3] : c1[j & 3], s = j < 4 ? s0[j & 3] : s1[j & 3]; const float a = (float)x1[j], b = (float)x2[j];
        o[j] = (which == 0 ? (a * c - b * s) : (b * c + a * s)) * scale; }
}
__device__ __forceinline__ u32x4 pack8(const float (&v)[8]) { u32x4 w; w.x = pkh(v[0], v[1]); w.y = pkh(v[2], v[3]); w.z = pkh(v[4], v[5]); w.w = pkh(v[6], v[7]); return w; }

__device__ __forceinline__ void phaseB(const Frame& F, const In& I, int l) {
    unsigned char* ws = F.ws; asm volatile("" : "+s"(ws)); ws = (unsigned char*)(GAS unsigned char*)ws;     int lane = lane_id(), tid = F.wave * 64 + lane; asm volatile("" : "+v"(lane), "+v"(tid)); const int w = F.wave;
    int blk = F.vcu; asm volatile("" : "+s"(blk));
    const int b = blk >> 5, chunk = (blk >> 1) & 15, gh = blk & 1;
    const size_t tok0 = (size_t)b * SEQ + chunk * 128;
    const h16* UV = (const h16*)(ws + WS_UV); h16* QY = (h16*)(ws + WS_QY);
    LAS unsigned char* VN = F.lds;
    constexpr int VPB = 576;
    { const int i16 = lane & 15, rq = lane >> 4; h16x8 v[4][4];
#pragma unroll
      for (int it = 0; it < 4; ++it)
#pragma unroll
          for (int i = 0; i < 4; ++i) v[it][i] = *(const GAS h16x8*)(UV + (tok0 + 16 * w + 4 * it + rq) * 1024 + 512 + 8 * i16 + 128 * (i & 1) + 256 * ((i >> 1) ^ gh));
      f32x4 lgv[2][2], lbv[2][2];
#pragma unroll
      for (int i = 0; i < 2; ++i) { const int col = 256 * gh + 128 * i + 8 * i16; const float* lg = I.ln_v_g + l * 512 + col; const float* lb = I.ln_v_b + l * 512 + col;
          lgv[i][0] = *(const f32x4*)lg; lgv[i][1] = *(const GAS f32x4*)(lg + 4); lbv[i][0] = *(const f32x4*)lb; lbv[i][1] = *(const GAS f32x4*)(lb + 4); }
#pragma unroll
      for (int it = 0; it < 4; ++it) { float s = 0.f, q = 0.f; float vg[4][8];
#pragma unroll
          for (int i = 0; i < 4; ++i)
#pragma unroll
              for (int j = 0; j < 8; ++j) { const float x = gelu_tanh_f((float)v[it][i][j]); vg[i][j] = x; s += x; q = fmaf(x, x, q); }
          s += __shfl_xor(s, 1); q += __shfl_xor(q, 1); s += __shfl_xor(s, 2); q += __shfl_xor(q, 2); s += __shfl_xor(s, 4); q += __shfl_xor(q, 4); s += __shfl_xor(s, 8); q += __shfl_xor(q, 8);
          const float mu = s * (1.0f / 512.f), var = fmaxf(q * (1.0f / 512.f) - mu * mu, 0.f), rs = rsqrtf(var + 1e-5f);
          const int t = 16 * w + 4 * it + rq;
#pragma unroll
          for (int i = 0; i < 2; ++i) { float o[8];
#pragma unroll
              for (int j = 0; j < 8; ++j) o[j] = (vg[i][j] - mu) * rs * lgv[i][j >> 2][j & 3] + lbv[i][j >> 2][j & 3];
              *(LAS u32x4*)(VN + t * VPB + (128 * i + 8 * i16) * 2) = pack8(o); } } }
    asm volatile("" ::: "memory");
    { const int gp = w & 3, g = 4 * gh + gp, rh = w >> 2, r = lane & 31, hf = lane >> 5;
      const h16* WS16 = (const h16*)(ws + WS_SMALLW + (size_t)l * SMALLW_LAYER + 98304 + 131072) + (size_t)g * 128 * 128;
      const int troff = (8 * hf + ((lane & 15) >> 2)) * VPB + (gp * 64 + 16 * ((lane >> 4) & 1) + 4 * (lane & 3)) * 2;
      h16x8 wf[2][8];
#pragma unroll
      for (int tb = 0; tb < 2; ++tb)
#pragma unroll
          for (int s = 0; s < 8; ++s) wf[tb][s] = *(const GAS h16x8*)(WS16 + (size_t)(64 * rh + 32 * tb + r) * 128 + 16 * s + 8 * hf);
      float bsv[2]; u32x2 uu[2][2][4];
#pragma unroll
      for (int tb = 0; tb < 2; ++tb) { const int t = 64 * rh + 32 * tb + r; bsv[tb] = I.b_s[((size_t)l * 8 + g) * 128 + t];
#pragma unroll
          for (int db = 0; db < 2; ++db)
#pragma unroll
              for (int gg = 0; gg < 4; ++gg) uu[tb][db][gg] = *(const GAS u32x2*)(UV + (tok0 + t) * 1024 + g * 64 + 32 * db + 8 * gg + 4 * hf); }
      LDS_WAIT(); __syncthreads();
#pragma unroll
      for (int tb = 0; tb < 2; ++tb) { const int nks = 4 * rh + 2 * tb + 2; const size_t tk = tok0 + 64 * rh + 32 * tb + r;
#pragma unroll
        for (int db = 0; db < 2; ++db) { f32x16 D = {};
#pragma unroll
            for (int s = 0; s < 8; ++s) if (s < nks) {
                const v4i16_t lo = __builtin_amdgcn_ds_read_tr16_b64_v4i16((LAS v4i16_t*)(VN + troff + (16 * s) * VPB + 64 * db));
                const v4i16_t hi = __builtin_amdgcn_ds_read_tr16_b64_v4i16((LAS v4i16_t*)(VN + troff + (16 * s + 4) * VPB + 64 * db));
                typedef short s16x8 __attribute__((ext_vector_type(8)));
                const s16x8 av = {lo[0], lo[1], lo[2], lo[3], hi[0], hi[1], hi[2], hi[3]};
                D = __builtin_amdgcn_mfma_f32_32x32x16_f16(__builtin_bit_cast(h16x8, av), wf[tb][s], D, 0, 0, 0); }
#pragma unroll
            for (int gg = 0; gg < 4; ++gg) { const u32x2 uv2 = uu[tb][db][gg]; const float bb = bsv[tb];
                const float y0 = gelu_tanh_f(h2f_lo(uv2.x)) * (D[4 * gg] + bb), y1 = gelu_tanh_f(h2f_hi(uv2.x)) * (D[4 * gg + 1] + bb), y2 = gelu_tanh_f(h2f_lo(uv2.y)) * (D[4 * gg + 2] + bb), y3 = gelu_tanh_f(h2f_hi(uv2.y)) * (D[4 * gg + 3] + bb);
                *(GAS u32x2*)(QY + tk * 1024 + 512 + g * 64 + 32 * db + 8 * gg + 4 * hf) = (u32x2){pkh(y0, y1), pkh(y2, y3)}; } } } }
    __syncthreads();
}

constexpr int C_KIB = 0, C_KIBUF = 256 * 128;
constexpr int C_QL = 0, C_QLW = KVP * 2 * 32;
constexpr int C_WQ = 81920;
constexpr int C_KVS = 90112, C_KVSLOT = 10240;

__device__ __forceinline__ void phaseC_select(const Frame& F, int l, int b, int qt, int pmode = 0) {
    unsigned char* ws = F.ws; asm volatile("" : "+s"(ws)); ws = (unsigned char*)(GAS unsigned char*)ws;     int lane = lane_id(), tid = F.wave * 64 + lane; asm volatile("" : "+v"(lane), "+v"(tid)); const int w = F.wave, r = lane & 31, hf = lane >> 5;
    const h16* QI = (const h16*)(ws + WS_QI); const h16* KI = (const h16*)(ws + WS_KI); const float* WI = (const float*)(ws + WS_WI); const float* CS = (const float*)(ws + WS_CS);
    h16* QY = (h16*)(ws + WS_QY); const h16* KV = (const h16*)(ws + WS_KV);
    const h16* WUKT = (const h16*)(ws + WS_SMALLW + (size_t)l * SMALLW_LAYER); const h16* WUVT = (const h16*)(ws + WS_SMALLW + (size_t)l * SMALLW_LAYER + 98304);
    LAS unsigned char* lds = F.lds;
    const int t0 = 32 * qt, NT = qt + 1; const size_t tokbase = (size_t)b * SEQ;
    { const char* kvsrc_ = (const char*)((const h16*)(ws + WS_KV) + tokbase * KVP) + (size_t)(64 * w + lane) * 16; const unsigned kvdst_ = (unsigned)(uintptr_t)(lds + C_KVS) + (unsigned)w * 1024u;
#pragma unroll
      for (int t_ = 0; t_ < 4; ++t_) if (t_ < NT) { const char* s_ = kvsrc_ + (size_t)t_ * (32 * KVP * 2); const unsigned d_ = (unsigned)__builtin_amdgcn_readfirstlane((int)(kvdst_ + (unsigned)t_ * (unsigned)C_KVSLOT));
          unsigned keep_; asm volatile("s_mov_b32 %0, m0\n\ts_mov_b32 m0, %2\n\ts_nop 0\n\tglobal_load_lds_dwordx4 %1, off\n\ts_mov_b32 m0, %0" : "=&s"(keep_) : "v"(s_), "s"(d_) : "memory");
          if (w < 2) { const char* s2_ = s_ + 8192; const unsigned d2_ = d_ + 8192u; asm volatile("s_mov_b32 %0, m0\n\ts_mov_b32 m0, %2\n\ts_nop 0\n\tglobal_load_lds_dwordx4 %1, off\n\ts_mov_b32 m0, %0" : "=&s"(keep_) : "v"(s2_), "s"(d2_) : "memory"); } } }
    h16x8 afr[4]; float wreg[16];
    { const int qq = 2 * ((r >> 2) & 1) + (r >> 4), head = (r & 3) + 4 * ((r >> 3) & 1); const size_t tokA = tokbase + t0 + 4 * w + qq;
      const h16* qsrc = QI + tokA * 512 + head * 64;
      { float o[8]; rope8(*(const GAS h16x8*)(qsrc), *(const GAS h16x8*)(qsrc + 8), CS + tokA * 16, hf, 1.0f, o); afr[0] = __builtin_bit_cast(h16x8, pack8(o)); }
#pragma unroll
      for (int s = 1; s < 4; ++s) afr[s] = *(const GAS h16x8*)(qsrc + 16 * s + 8 * hf);
      const float* wp = WI + (tokbase + t0 + 4 * w + 2 * hf) * 8;
#pragma unroll
      for (int R4 = 0; R4 < 4; ++R4) { const f32x4 wv = *(const GAS f32x4*)(wp + 4 * R4); wreg[4 * R4] = wv.x; wreg[4 * R4 + 1] = wv.y; wreg[4 * R4 + 2] = wv.z; wreg[4 * R4 + 3] = wv.w; } }
    float SC[128];
    const float QNAN = __uint_as_float(0x7fc00000u);
#pragma unroll
    for (int i = 0; i < 128; ++i) SC[i] = QNAN;
    const int NCK = (NT + 7) >> 3, tq0 = t0 + 4 * w + 2 * hf;
    const int drow = lane >> 3, dslot = lane & 7;
    const h16* kisrc = KI + (tokbase + 32 * w + drow) * 64 + 8 * (dslot ^ drow);
#define KI_STAGE(ck_, buf_) do { _Pragma("unroll") for (int i_ = 0; i_ < 4; ++i_) \
        __builtin_amdgcn_global_load_lds((const unsigned*)(kisrc + (size_t)(256 * (ck_) + 8 * i_) * 64), (LAS unsigned*)(lds + C_KIB + (buf_) * C_KIBUF + (4 * w + i_) * 1024), 16, 0, 0); } while (0)
    KI_STAGE(0, 0);
    VM_WAIT(); __syncthreads();
    const int kroff = r * 128, kx = r & 7;
#pragma unroll 1
    for (int ck = 0; ck < NCK; ++ck) {
        LAS unsigned char* kb = lds + C_KIB + (ck & 1) * C_KIBUF;
        if (ck + 1 < NCK) KI_STAGE(ck + 1, (ck + 1) & 1);
#pragma unroll
        for (int i = 0; i < 112; ++i) SC[i] = SC[i + 16];
#pragma unroll
        for (int jj = 0; jj < 8; ++jj) { if (pmode & 1) { SC[112 + 2 * jj] = (float)(ck + jj + r) * 0.01f; SC[113 + 2 * jj] = (float)(ck - jj + r) * 0.01f; continue; }
            f32x16 D = {};
#pragma unroll
            for (int s = 0; s < 4; ++s) { const h16x8 bb = *(const LAS h16x8*)(kb + jj * 4096 + kroff + 16 * ((2 * s + hf) ^ kx)); D = __builtin_amdgcn_mfma_f32_32x32x16_f16(afr[s], bb, D, 0, 0, 0); }
            float s0 = 0.f, s1 = 0.f;
#pragma unroll
            for (int R = 0; R < 8; ++R) { s0 = fmaf(wreg[R], fmaxf(D[R], 0.f), s0); s1 = fmaf(wreg[8 + R], fmaxf(D[8 + R], 0.f), s1); }
            const int k = 256 * ck + 32 * jj + r;
            SC[112 + 2 * jj] = (k > tq0) ? QNAN : s0; SC[113 + 2 * jj] = (k > tq0 + 1) ? QNAN : s1;
        }
        LDS_WAIT(); VM_WAIT(); __syncthreads();
    }
#undef KI_STAGE
    const int G0 = 8 - NCK;
#define SEL_COUNT2(c0, c1, FN, m0, m1) do { int a0_ = 0, a1_ = 0; \
        _Pragma("unroll") for (int g = 0; g < 8; ++g) if (g >= G0) FN(a0_, a1_, &SC[16 * g], (m0), (m1)); \
        c0 = half_sum_dpp(a0_, hf); c1 = half_sum_dpp(a1_, hf); } while (0)
    float tau0 = -3.0e38f, tau1 = -3.0e38f;
    if (qt >= 8 && !(pmode & 2)) {
        float lo0 = INFINITY, lo1 = INFINITY, hi0 = -INFINITY, hi1 = -INFINITY;
#pragma unroll
        for (int j = 0; j < 64; ++j) { const float a = SC[2 * j], c = SC[2 * j + 1]; lo0 = fminf(lo0, a); hi0 = fmaxf(hi0, a); lo1 = fminf(lo1, c); hi1 = fmaxf(hi1, c); }
#pragma unroll
        for (int o = 1; o < 32; o <<= 1) { lo0 = fminf(lo0, __shfl_xor(lo0, o)); lo1 = fminf(lo1, __shfl_xor(lo1, o)); hi0 = fmaxf(hi0, __shfl_xor(hi0, o)); hi1 = fmaxf(hi1, __shfl_xor(hi1, o)); }
        int cl0 = tq0 + 1, cl1 = tq0 + 2, ch0 = 1, ch1 = 1;
        bool done0 = false, done1 = false;
        { int g0, g1; const float zero = 0.f; SEL_COUNT2(g0, g1, cnt_group_gt, zero, zero);
          const float tiny = __uint_as_float(1u);
          if (__any(g0 < 256 || g1 < 256)) { int e0, e1; SEL_COUNT2(e0, e1, cnt_group_ge, zero, zero);
              if (g0 < 256) { if (e0 >= 256) { lo0 = 0.f; done0 = true; } else { hi0 = 0.f; ch0 = e0; } }
              if (g1 < 256) { if (e1 >= 256) { lo1 = 0.f; done1 = true; } else { hi1 = 0.f; ch1 = e1; } } }
          if (g0 >= 256) { lo0 = tiny; cl0 = g0; if (g0 == 256) done0 = true; }
          if (g1 >= 256) { lo1 = tiny; cl1 = g1; if (g1 == 256) done1 = true; } }
#define SEL_STEP(c0, c1, mid0, mid1) do { \
            if (!done0) { if (c0 >= 256) { lo0 = mid0; cl0 = c0; if (c0 == 256) done0 = true; } else { hi0 = mid0; ch0 = c0; } } \
            if (!done1) { if (c1 >= 256) { lo1 = mid1; cl1 = c1; if (c1 == 256) done1 = true; } else { hi1 = mid1; ch1 = c1; } } } while (0)
#define SEL_EXHAUSTED(bis0, bis1) do { if (!done0 && (bis0 <= lo0 || bis0 >= hi0)) done0 = true; if (!done1 && (bis1 <= lo1 || bis1 >= hi1)) done1 = true; } while (0)
        bool compact = true;
#pragma unroll 1
        for (int it = 0; it < ((pmode & 16) ? 6 : 40); ++it) {
            const float bis0 = 0.5f * (lo0 + hi0), bis1 = 0.5f * (lo1 + hi1);
            SEL_EXHAUSTED(bis0, bis1);
            if (__all((done0 || (compact && cl0 - ch0 <= 48)) && (done1 || (compact && cl1 - ch1 <= 48)))) break;
            int c0, c1; SEL_COUNT2(c0, c1, cnt_group_ge, bis0, bis1);
            SEL_STEP(c0, c1, bis0, bis1);
            if (it == 39) { done0 = true; done1 = true; }
        }
        if (!__all(done0 && done1)) {
            LAS float* L0 = (LAS float*)(lds + w * 4096 + (2 * hf) * 1024 + r * 32); LAS float* L1 = L0 + 256;
            { const f32x4 qn = {QNAN, QNAN, QNAN, QNAN}; *(LAS f32x4*)L0 = qn; *(LAS f32x4*)(L0 + 4) = qn; *(LAS f32x4*)L1 = qn; *(LAS f32x4*)(L1 + 4) = qn; }
            int n0 = 0, n1 = 0;
#pragma unroll
            for (int g = 0; g < 8; ++g) if (g >= G0) {
#pragma unroll
                for (int jj = 0; jj < 8; ++jj) { const int j = 8 * g + jj; const float v0 = SC[2 * j], v1 = SC[2 * j + 1];
                    if (!done0 && v0 >= lo0 && v0 < hi0) { if (n0 < 8) L0[n0] = v0; ++n0; }
                    if (!done1 && v1 >= lo1 && v1 < hi1) { if (n1 < 8) L1[n1] = v1; ++n1; } } }
            LDS_WAIT();
            float CAND[16];
            { const f32x4 a0 = *(const LAS f32x4*)L0, a1 = *(const LAS f32x4*)(L0 + 4), b0 = *(const LAS f32x4*)L1, b1 = *(const LAS f32x4*)(L1 + 4);
#pragma unroll
              for (int i = 0; i < 4; ++i) { CAND[2 * i] = a0[i]; CAND[8 + 2 * i] = a1[i]; CAND[2 * i + 1] = b0[i]; CAND[8 + 2 * i + 1] = b1[i]; } }
            LDS_WAIT();
            if (__any(n0 > 8 || n1 > 8)) {
#pragma unroll 1
                for (int it = 0; it < 40; ++it) {
                    const float bis0 = 0.5f * (lo0 + hi0), bis1 = 0.5f * (lo1 + hi1);
                    SEL_EXHAUSTED(bis0, bis1);
                    if (__all(done0 && done1)) break;
                    int c0, c1; SEL_COUNT2(c0, c1, cnt_group_ge, bis0, bis1);
                    SEL_STEP(c0, c1, bis0, bis1);
                }
            } else {
                const int cb0 = ch0, cb1 = ch1;
#pragma unroll 1
                for (int it = 0; it < ((pmode & 16) ? 3 : 48); ++it) {
                    const float bis0 = 0.5f * (lo0 + hi0), bis1 = 0.5f * (lo1 + hi1);
                    SEL_EXHAUSTED(bis0, bis1);
                    if (__all(done0 && done1)) break;
                    float mid0 = bis0, mid1 = bis1;
                    if ((it % 3) != 2) { const float i0 = lo0 + ((float)cl0 - 255.5f) / (float)(cl0 - ch0) * (hi0 - lo0), i1 = lo1 + ((float)cl1 - 255.5f) / (float)(cl1 - ch1) * (hi1 - lo1);
                        if (i0 > lo0 && i0 < hi0) mid0 = i0; if (i1 > lo1 && i1 < hi1) mid1 = i1; }
                    int a0 = 0, a1 = 0; cnt_group_ge(a0, a1, CAND, mid0, mid1);
                    const int c0 = cb0 + half_sum_dpp(a0, hf), c1 = cb1 + half_sum_dpp(a1, hf);
                    SEL_STEP(c0, c1, mid0, mid1);
                }
            }
        }
#undef SEL_STEP
#undef SEL_EXHAUSTED
        tau0 = lo0; tau1 = lo1;
    }
#undef SEL_COUNT2
    unsigned w00 = 0u, w01 = 0u, w10 = 0u, w11 = 0u;
#pragma unroll
    for (int g = 0; g < 8; ++g) if (g >= G0 && !(pmode & 4)) {
#pragma unroll
        for (int jj = 0; jj < 8; ++jj) { const int j = 8 * g + jj, jt = 8 * (g - G0) + jj;
            ballot_ge_to_lane(w00, w10, SC[2 * j], tau0, jt); ballot_ge_to_lane(w01, w11, SC[2 * j + 1], tau1, jt); } }
    { LAS unsigned* WQ = (LAS unsigned*)(lds + C_WQ);
      WQ[(4 * w + 0) * 64 + lane] = w00; WQ[(4 * w + 1) * 64 + lane] = w01; WQ[(4 * w + 2) * 64 + lane] = w10; WQ[(4 * w + 3) * 64 + lane] = w11; }
    LDS_WAIT(); __syncthreads();
}

__device__ __forceinline__ void phaseC_attn(const Frame& F, int l, int b, int qt, bool do_store = true, int pmode = 0) {
    unsigned char* ws = F.ws; asm volatile("" : "+s"(ws)); ws = (unsigned char*)(GAS unsigned char*)ws;     const int w = F.wave;
    int lane = lane_id(), tid = F.wave * 64 + lane; asm volatile("" : "+v"(lane), "+v"(tid));
    const int r = lane & 31, hf = lane >> 5;
    const float* CS = (const float*)(ws + WS_CS);
    h16* QY = (h16*)(ws + WS_QY); const h16* KV = (const h16*)(ws + WS_KV);
    const h16* WUKT = (const h16*)(ws + WS_SMALLW + (size_t)l * SMALLW_LAYER); const h16* WUVT = (const h16*)(ws + WS_SMALLW + (size_t)l * SMALLW_LAYER + 98304);
    LAS unsigned char* lds = F.lds;
    const int t0 = 32 * qt, NT = qt + 1; const size_t tokbase = (size_t)b * SEQ;
    const int h = w; const size_t tokQ = tokbase + t0 + r;
    LAS h16* ql = (LAS h16*)(lds + C_QL + w * C_QLW);
    if (!(pmode & 64)) { h16x8 bq[3];
#pragma unroll
      for (int s = 0; s < 3; ++s) bq[s] = *(const GAS h16x8*)(QY + tokQ * 1024 + h * 64 + 16 + 16 * s + 8 * hf);
#pragma unroll
      for (int cb = 0; cb < 4; ++cb) { f32x16 D = {};
#pragma unroll
          for (int s = 0; s < 3; ++s) { const h16x8 a = *(const GAS h16x8*)(WUKT + ((size_t)(h * 128 + 32 * cb + r)) * 48 + 16 * s + 8 * hf); D = __builtin_amdgcn_mfma_f32_32x32x16_f16(a, bq[s], D, 0, 0, 0); }
#pragma unroll
          for (int g = 0; g < 4; ++g) { const int c = 32 * cb + 8 * g + 4 * hf;
              *(LAS u32x2*)(ql + r * KVP + c) = (u32x2){pkh(D[4 * g] * QSCALE, D[4 * g + 1] * QSCALE), pkh(D[4 * g + 2] * QSCALE, D[4 * g + 3] * QSCALE)}; } }
      { float o[8]; rope8(*(const GAS h16x8*)(QY + tokQ * 1024 + h * 64), *(const GAS h16x8*)(QY + tokQ * 1024 + h * 64 + 8), CS + tokQ * 16, hf, QSCALE, o); *(LAS u32x4*)(ql + r * KVP + 128 + 8 * hf) = pack8(o); } }
    LDS_WAIT();
    h16x8 qfr[9];
#pragma unroll
    for (int s = 0; s < 9; ++s) qfr[s] = *(const LAS h16x8*)(ql + r * KVP + 16 * s + 8 * hf);
    const char* kvsrc = (const char*)(KV + tokbase * KVP) + (size_t)(64 * w + lane) * 16;
    const unsigned kvdst = (unsigned)(uintptr_t)(lds + C_KVS) + (unsigned)w * 1024u;
    const int grp = w >> 2;
#define KV_DMA1(src_, dst_) do { unsigned keep_; asm volatile("s_mov_b32 %0, m0\n\ts_mov_b32 m0, %2\n\ts_nop 0\n\tglobal_load_lds_dwordx4 %1, off\n\ts_mov_b32 m0, %0" : "=&s"(keep_) : "v"(src_), "s"(dst_) : "memory"); } while (0)
#define KV_DMA(t_) do { const char* s_ = kvsrc + (size_t)(t_) * (32 * KVP * 2); const unsigned d_ = (unsigned)__builtin_amdgcn_readfirstlane((int)(kvdst + (unsigned)((t_) % 5) * (unsigned)C_KVSLOT)); \
        KV_DMA1(s_, d_); if (w < 2) { const char* s2_ = s_ + 8192; const unsigned d2_ = d_ + 8192u; KV_DMA1(s2_, d2_); } } while (0)
#define KV_WAIT(n_) do { if ((n_) <= 0) asm volatile("s_waitcnt vmcnt(0)" ::: "memory"); else if ((n_) == 1) { if (w < 2) asm volatile("s_waitcnt vmcnt(2)" ::: "memory"); else asm volatile("s_waitcnt vmcnt(1)" ::: "memory"); } \
        else { if (w < 2) asm volatile("s_waitcnt vmcnt(4)" ::: "memory"); else asm volatile("s_waitcnt vmcnt(2)" ::: "memory"); } } while (0)
#if defined(PROBE_C_ATT)
    { KV_DMA(0); if (NT > 1) KV_DMA(1); if (NT > 2) KV_DMA(2); if (NT > 3) KV_DMA(3); }
#endif
    asm volatile("s_waitcnt vmcnt(0)" ::: "memory");
    asm volatile("s_waitcnt lgkmcnt(0)" ::: "memory"); __builtin_amdgcn_s_barrier(); asm volatile("" ::: "memory");
    float mrun = 0.f, lrun = 0.f; f32x16 O[4]; f32x16 negm;
#pragma unroll
    for (int db = 0; db < 4; ++db) O[db] = (f32x16){};
#pragma unroll
    for (int R = 0; R < 16; ++R) negm[R] = 0.f;
    const LAS unsigned* WQr = (const LAS unsigned*)(lds + C_WQ) + r * 64;
    const int troff = ((lane & 15) >> 2) * (KVP * 2) + (16 * ((lane >> 4) & 1) + 4 * (lane & 3)) * 2 + 4 * hf * (KVP * 2);
    const int kbase = (int)(uintptr_t)(lds + C_KVS) + r * (KVP * 2) + 16 * hf, vbase = (int)(uintptr_t)(lds + C_KVS) + troff;
    typedef short s16x8 __attribute__((ext_vector_type(8)));
#define AT_MAX3(a_, b_, c_) ({ float r_; asm("v_max3_f32 %0, %1, %2, %3" : "=v"(r_) : "v"(a_), "v"(b_), "v"(c_)); r_; })
#define AT_MASKED(e_, w_, pos_) ({ int t_, r_; asm("v_bfe_i32 %0, %2, %3, 1\n\tv_and_b32 %1, %4, %0" : "=&v"(t_), "=v"(r_) : "v"(w_), "n"(pos_), "v"(e_)); __int_as_float(r_); })
#define AT_KLOAD(so_) h16x8 kfr[9]; do { const LAS unsigned char* sl_ = (const LAS unsigned char*)(uintptr_t)(kbase + (so_)); \
        if (!(pmode & 16)) { _Pragma("unroll") for (int s = 0; s < 9; ++s) kfr[s] = *(const LAS h16x8*)(sl_ + 32 * s); } else { _Pragma("unroll") for (int s = 0; s < 9; ++s) kfr[s] = qfr[s]; } __builtin_amdgcn_sched_barrier(0); } while (0)
#define AT_QK(S_) do { S_ = negm; if (!(pmode & 16)) { __builtin_amdgcn_s_setprio(1); _Pragma("unroll") for (int s = 0; s < 9; ++s) S_ = __builtin_amdgcn_mfma_f32_32x32x16_f16(kfr[s], qfr[s], S_, 0, 0, 0); __builtin_amdgcn_s_setprio(0); } } while (0)
#define AT_VLOAD(db0_) do { _Pragma("unroll") for (int db = 0; db < 2; ++db) _Pragma("unroll") for (int sp = 0; sp < 2; ++sp) { \
            vlo_[db][sp] = __builtin_amdgcn_ds_read_tr16_b64_v4i16((LAS v4i16_t*)(sl_ + (16 * sp) * (KVP * 2) + 64 * ((db0_) + db))); \
            vhi_[db][sp] = __builtin_amdgcn_ds_read_tr16_b64_v4i16((LAS v4i16_t*)(sl_ + (16 * sp + 8) * (KVP * 2) + 64 * ((db0_) + db))); } } while (0)
#define AT_PV2(db0_) do { __builtin_amdgcn_s_setprio(1); _Pragma("unroll") for (int db = 0; db < 2; ++db) _Pragma("unroll") for (int sp = 0; sp < 2; ++sp) { \
            const s16x8 av_ = {vlo_[db][sp][0], vlo_[db][sp][1], vlo_[db][sp][2], vlo_[db][sp][3], vhi_[db][sp][0], vhi_[db][sp][1], vhi_[db][sp][2], vhi_[db][sp][3]}; \
            O[(db0_) + db] = __builtin_amdgcn_mfma_f32_32x32x16_f16(__builtin_bit_cast(h16x8, av_), pf_[sp], O[(db0_) + db], 0, 0, 0); } __builtin_amdgcn_s_setprio(0); } while (0)
#define AT_SMPV(S_, t_, so_) do { const LAS unsigned char* sl_ = (const LAS unsigned char*)(uintptr_t)(vbase + (so_)); \
        v4i16_t vlo_[2][2], vhi_[2][2]; \
        AT_VLOAD(0); \
        const int wq_ = (int)(WQr[(t_)] >> (4 * hf)); \
        __builtin_amdgcn_sched_barrier(0); \
        float mt_ = AT_MAX3(S_[0], S_[1], S_[2]); \
        _Pragma("unroll") for (int R = 3; R < 15; R += 2) mt_ = AT_MAX3(mt_, S_[R], S_[R + 1]); \
        mt_ = half_swap_max(AT_MAX3(mt_, S_[15], S_[15])); \
        if ((t_) == 0 || __any(mt_ > 8.0f)) { const float dl_ = (t_) == 0 ? mt_ : fmaxf(mt_, 0.f), alpha_ = (t_) == 0 ? 1.f : __builtin_amdgcn_exp2f(-dl_);     \
            _Pragma("unroll") for (int db = 0; db < 4; ++db) O[db] = O[db] * alpha_; \
            _Pragma("unroll") for (int R = 0; R < 16; ++R) S_[R] -= dl_; \
            lrun *= alpha_; mrun += dl_; \
            _Pragma("unroll") for (int R = 0; R < 16; ++R) negm[R] = -mrun; } \
        float p_[16]; \
        if (!(pmode & 1)) { _Pragma("unroll") for (int R = 0; R < 16; ++R) { const float e_ = __builtin_amdgcn_exp2f(S_[R]); p_[R] = AT_MASKED(e_, wq_, (R & 3) + 8 * (R >> 2)); lrun += p_[R]; } } \
        else { _Pragma("unroll") for (int R = 0; R < 16; ++R) p_[R] = S_[R]; lrun += p_[0]; } \
        h16x8 pf_[2]; \
        _Pragma("unroll") for (int sp = 0; sp < 2; ++sp) { u32x4 t4_; t4_.x = pkz(p_[8 * sp], p_[8 * sp + 1]); t4_.y = pkz(p_[8 * sp + 2], p_[8 * sp + 3]); t4_.z = pkz(p_[8 * sp + 4], p_[8 * sp + 5]); t4_.w = pkz(p_[8 * sp + 6], p_[8 * sp + 7]); pf_[sp] = __builtin_bit_cast(h16x8, t4_); } \
        __builtin_amdgcn_sched_barrier(0); \
        if (!(pmode & 2)) { AT_PV2(0); \
        __builtin_amdgcn_sched_barrier(0); \
        AT_VLOAD(2); \
        __builtin_amdgcn_sched_barrier(0); \
        AT_PV2(2); } else { O[0][0] += (float)pf_[0][0] + (float)pf_[1][0]; } } while (0)
#define AT_BOUNDARY2(g_) do {   \
        if (!(pmode & 4)) { asm volatile("s_waitcnt vmcnt(0) lgkmcnt(0)" ::: "memory"); __builtin_amdgcn_s_barrier(); asm volatile("" ::: "memory"); \
        if (2 * (g_) + 4 < NT) KV_DMA(2 * (g_) + 4); if (2 * (g_) + 5 < NT) KV_DMA(2 * (g_) + 5); } } while (0)
#define AT_NEXT(so_) ((so_) == 4 * C_KVSLOT ? 0 : (so_) + C_KVSLOT)
    const int NG = (NT + 1) >> 1;
    if (grp == 0) {
        int so = 0;
#pragma unroll 1
        for (int g = 0; g < NG; ++g) { const int t = 2 * g;
            { f32x16 Sx; AT_KLOAD(so); AT_QK(Sx); __builtin_amdgcn_sched_barrier(0); AT_SMPV(Sx, t, so); so = AT_NEXT(so); }
            if (t + 1 < NT) { f32x16 Sx; AT_KLOAD(so); AT_QK(Sx); __builtin_amdgcn_sched_barrier(0); AT_SMPV(Sx, t + 1, so); so = AT_NEXT(so); }
            AT_BOUNDARY2(g); }
    } else {
        f32x16 Sx; int so = 0, sop = 0;
        { AT_KLOAD(so); AT_QK(Sx); } sop = so; so = AT_NEXT(so);
        if (1 < NT) { AT_SMPV(Sx, 0, sop); __builtin_amdgcn_sched_barrier(0); { AT_KLOAD(so); AT_QK(Sx); } sop = so; so = AT_NEXT(so); }
        AT_BOUNDARY2(0);
#pragma unroll 1
        for (int g = 1; g < NG; ++g) { const int t = 2 * g;
            AT_SMPV(Sx, t - 1, sop); __builtin_amdgcn_sched_barrier(0); { AT_KLOAD(so); AT_QK(Sx); } sop = so; so = AT_NEXT(so);
            if (t + 1 < NT) { AT_SMPV(Sx, t, sop); __builtin_amdgcn_sched_barrier(0); { AT_KLOAD(so); AT_QK(Sx); } sop = so; so = AT_NEXT(so); }
            AT_BOUNDARY2(g); }
        AT_SMPV(Sx, NT - 1, sop);
    }
#undef AT_NEXT
#undef AT_MAX3
#undef AT_MASKED
#undef AT_BOUNDARY2
#undef KV_DMA
#undef KV_DMA1
#undef KV_WAIT
#undef AT_KLOAD
#undef AT_QK
#undef AT_SMPV
#undef AT_VLOAD
#undef AT_PV2
    if (!(pmode & 32)) {
    h16x8 bwv[2][8];
#pragma unroll
    for (int d2 = 0; d2 < 2; ++d2)
#pragma unroll
        for (int s = 0; s < 8; ++s) bwv[d2][s] = *(const GAS h16x8*)(WUVT + ((size_t)(h * 64 + 32 * d2 + r)) * 128 + 16 * s + 8 * hf);
    { const float inv = 1.0f / half_swap_sum(lrun);
#pragma unroll
      for (int db = 0; db < 4; ++db)
#pragma unroll
          for (int g = 0; g < 4; ++g) { const int c = 32 * db + 8 * g + 4 * hf;
              *(LAS u32x2*)(ql + r * KVP + c) = (u32x2){pkh(O[db][4 * g] * inv, O[db][4 * g + 1] * inv), pkh(O[db][4 * g + 2] * inv, O[db][4 * g + 3] * inv)}; } }
    LDS_WAIT();
    { h16x8 ao[8];
#pragma unroll
      for (int s = 0; s < 8; ++s) ao[s] = *(const LAS h16x8*)(ql + r * KVP + 16 * s + 8 * hf);
#pragma unroll
      for (int d2 = 0; d2 < 2; ++d2) { f32x16 D = {};
#pragma unroll
          for (int s = 0; s < 8; ++s) D = __builtin_amdgcn_mfma_f32_32x32x16_f16(bwv[d2][s], ao[s], D, 0, 0, 0);
#pragma unroll
          for (int g = 0; g < 4; ++g) { const u32x2 pk = {pkh(D[4 * g], D[4 * g + 1]), pkh(D[4 * g + 2], D[4 * g + 3])};
              if (do_store) *(GAS u32x2*)(QY + (tokbase + t0 + r) * 1024 + h * 64 + 32 * d2 + 8 * g + 4 * hf) = pk; else asm volatile("" :: "v"(pk)); } } }
    } else { asm volatile("" :: "v"(O[0][0]), "v"(O[1][0]), "v"(O[2][0]), "v"(O[3][0]), "v"(lrun)); }
    LDS_WAIT(); __syncthreads();
}

__device__ __forceinline__ void phaseC(const Frame& F, int l) {
    int vc = F.vcu; asm volatile("" : "+s"(vc)); const int b = vc >> 5, i = vc & 31;
#pragma unroll 1
    for (int u = 0; u < 2; ++u) { const int qt = (u == 0) ? 63 - i : i;
#if defined(PROBE_C_SEL)
#pragma unroll 1
        for (int rep = 0; rep < 2; ++rep)
        phaseC_select(F, l, b, qt, rep == 0 ? PROBE_C_SEL : 0);
#else
        phaseC_select(F, l, b, qt);
#endif
#if defined(PROBE_C_ATT)
#pragma unroll 1
        for (int rep = 0; rep < 2; ++rep) phaseC_attn(F, l, b, qt, rep == 1, rep == 1 ? 0 : PROBE_C_ATT);
#else
        phaseC_attn(F, l, b, qt);
#endif
    }
}
#if defined(PROBE_STORE)
#define PROBE_NOSTORE(f) (f)
#else
#define PROBE_NOSTORE(f) 0
#endif
#if defined(PROBE_EPI)
#define PROBE_NOEPI(f) (f)
#else
#define PROBE_NOEPI(f) 0
#endif
#ifndef PROBE_MASK
#define PROBE_MASK 0u
#endif
#ifndef MK_N_LAUNCHES
#define MK_N_LAUNCHES 1
#endif
#if MK_N_LAUNCHES == 1
constexpr bool FUSE_FINAL = false;
#else
constexpr bool FUSE_FINAL = false;
#endif
constexpr int N_PHASES = 2 + 7 * NLAYER;
constexpr int CONV_WD_FIRST = CONV_IN_ITEMS + 2 * 128 + 256 + (NGU / 64) * 16;
constexpr int CONV_SPLIT = 2150;
struct Args { In in; float* out; unsigned char* ws; int ph_lo, ph_hi, flags, pad; };

__global__ void __launch_bounds__(NTHREADS, 2) mk_fwd(Args args) {
    extern __shared__ __attribute__((aligned(16))) unsigned char lds_raw[];
    Frame F; F.lds = (LAS unsigned char*)lds_raw; F.wave = __builtin_amdgcn_readfirstlane((int)threadIdx.x >> 6);
    F.G = gridDim.x; { const int bx = blockIdx.x; F.vcu = (F.G % 8 == 0) ? (bx % 8) * (F.G / 8) + bx / 8 : bx; }
    F.ws = args.ws; F.in = nullptr;
    const In& I = args.in; unsigned char* ws = args.ws; (void)ws;
    volatile LAS unsigned* MISCW = (volatile LAS unsigned*)(F.lds + LDS_MISC);
    if (F.wave == 0) MISCW[lane_id()] = 0u;
    __syncthreads();
#if MK_N_LAUNCHES == 1
    const bool one_launch = true;
#else
    const bool one_launch = (args.ph_hi - args.ph_lo) > 1;
#endif
    XcdBarrier bar; bar.bar = (unsigned*)(ws + WS_CTL) + 1024; bar.x = 0; bar.st = nullptr;
    if (one_launch) bar = xcd_barrier_post((unsigned*)(ws + WS_CTL) + 1024, MISCW + 8, F.wave);
#if MK_N_LAUNCHES == 1
#define IN(k) true
#define SEAM(k) xcd_barrier(bar, F.wave)
#else
#define IN(k) (args.ph_lo <= (k) && (k) < args.ph_hi)
#define SEAM(k) do { if (IN(k) && IN((k) + 1)) xcd_barrier(bar, F.wave); } while (0)
#endif
    if (IN(0)) { p0_prologue(F, I); SEAM(0); }
#define OPQ(x) asm volatile("" : "+s"(x))
#pragma unroll 1
    for (int l0 = 0; l0 < NLAYER; ++l0) {
        const int p = 1 + 7 * l0;
        if (IN(p)) {
            unsigned char* wsq = args.ws; int l = l0; OPQ(wsq); OPQ(l); wsq = (unsigned char*)(GAS unsigned char*)wsq; unsigned char* wl = wsq + WS_W + (size_t)l * W_LAYER;
            pg8::Gemm g{(const h16*)(wsq + WS_X16), (const h16*)(wl + W_OFF_IN), 1024, 1024, 1024, M / 256, NZ / 256, 1, 0, PROBE_NOEPI(args.flags), 0};
            constexpr int NTILE = (M / 256) * (NZ / 256), NFULL = (NTILE / 256) * 256, NTAILWG = 2 * (NTILE - NFULL);
            const bool tailmode = (F.G == 256);
            pg8::Order S; S.init(g.nM, g.nN, F.G, (int)blockIdx.x, 1, tailmode ? NFULL : -1); EpiA E{wsq, PROBE_NOSTORE(args.flags), (LAS float*)(F.lds + 131072 + 4096)};
            pg8::gemm_phase<EpiA>(F.lds, g, S, E, F.wave);
            if (tailmode) {
                EpiA E2{wsq, PROBE_NOSTORE(args.flags), (LAS float*)(F.lds + 147456)};
                pg8::gemm_tail_phase<EpiA>(F.lds, g, S, E2, F.wave);
                if ((int)blockIdx.x >= NTAILWG) { const int cgw = ((int)blockIdx.x - NTAILWG) * NWAVES + F.wave, cng = (256 - NTAILWG) * NWAVES;
                    convert_layer_weights(F, I, l, cgw, cng, CONV_IN_ITEMS, 1 << 30); }
            } else { xcd_barrier(bar, F.wave); convert_layer_weights(F, I, l, F.vcu * NWAVES + F.wave, F.G * NWAVES, CONV_IN_ITEMS, 1 << 30); }
            SEAM(p); }
#if MK_N_LAUNCHES == 1
        if (IN(p + 1)) { int l = l0; OPQ(l); phaseB(F, I, l); }
#else
        if (IN(p + 1)) { int l = l0; OPQ(l); phaseB(F, I, l); SEAM(p + 1); }
#endif
        if (IN(p + 2)) { int l = l0; OPQ(l); phaseC(F, l); SEAM(p + 2); }
        if (IN(p + 3)) {
            unsigned char* wsq = args.ws; int l = l0; OPQ(wsq); OPQ(l); wsq = (unsigned char*)(GAS unsigned char*)wsq; unsigned char* wl = wsq + WS_W + (size_t)l * W_LAYER;
            pg8::Gemm g{(const h16*)(wsq + WS_QY), (const h16*)(wl + W_OFF_PAB), 1024, 1024, 512, M / 256, 4, 2, 512, PROBE_NOEPI(args.flags), 0};
            pg8::Order S; S.init(g.nM, g.nN, F.G, (int)blockIdx.x, 2); EpiD E{wsq, (h16*)args.out};
            pg8::gemm_phase<EpiD>(F.lds, g, S, E, F.wave); SEAM(p + 3); }
        if (IN(p + 4)) {
            unsigned char* wsq = args.ws; int l = l0; OPQ(wsq); OPQ(l); wsq = (unsigned char*)(GAS unsigned char*)wsq; unsigned char* wl = wsq + WS_W + (size_t)l * W_LAYER;
            pg8::Gemm g{(const h16*)args.out, (const h16*)(wl + W_OFF_OUT), 1024, 1024, 1024, M / 256, 4, 1, 0, PROBE_NOEPI(args.flags), 0};
            pg8::Order S; S.init(g.nM, g.nN, F.G, (int)blockIdx.x, 1);
            EpiRes E{(const h16*)(wsq + WS_X16), (h16*)(wsq + WS_X1), (float*)(wsq + WS_SSQ), (LAS float*)(F.lds + 131072)};
            pg8::gemm_phase<EpiRes>(F.lds, g, S, E, F.wave); SEAM(p + 4); }
        if (IN(p + 5)) {
            unsigned char* wsq = args.ws; int l = l0; OPQ(wsq); OPQ(l); wsq = (unsigned char*)(GAS unsigned char*)wsq; unsigned char* wl = wsq + WS_W + (size_t)l * W_LAYER;
            pg8::Gemm g{(const h16*)(wsq + WS_X1), (const h16*)(wl + W_OFF_GU), 1024, 1024, 1024, M / 256, NGU / 256, 1, 0, PROBE_NOEPI(args.flags), 0};
            pg8::Order S; S.init(g.nM, g.nN, F.G, (int)blockIdx.x, 1); EpiF E{wsq, (LAS float*)(F.lds + 131072 + 4096)};
            pg8::gemm_phase<EpiF>(F.lds, g, S, E, F.wave);
            { constexpr int NBIG = ((M / 256) * (NGU / 256)) % 256;
              if (l + 1 < NLAYER && (int)blockIdx.x >= NBIG && F.G == 256) convert_layer_weights(F, I, l + 1, ((int)blockIdx.x - NBIG) * NWAVES + F.wave, (256 - NBIG) * NWAVES, 0, CONV_IN_ITEMS);
              else if (l + 1 < NLAYER && F.G != 256) { xcd_barrier(bar, F.wave); convert_layer_weights(F, I, l + 1, F.vcu * NWAVES + F.wave, F.G * NWAVES, 0, CONV_IN_ITEMS); } }
            SEAM(p + 5); }
        if (IN(p + 6)) {
            unsigned char* wsq = args.ws; int l = l0; OPQ(wsq); OPQ(l); wsq = (unsigned char*)(GAS unsigned char*)wsq; unsigned char* wl = wsq + WS_W + (size_t)l * W_LAYER;
            pg8::Gemm g{(const h16*)(wsq + WS_ACT), (const h16*)(wl + W_OFF_D), DFF, DFF, DFF, M / 256, 4, 1, 0, PROBE_NOEPI(args.flags), 0};
            pg8::Order S; S.init(g.nM, g.nN, F.G, (int)blockIdx.x, 1);
            if (FUSE_FINAL && l == NLAYER - 1 && F.G == 256) {
                EpiFinal E{(const h16*)(wsq + WS_X1), args.out, args.in.final_norm, (float*)(wsq + WS_SSQ), (unsigned*)(wsq + WS_CTL) + 8192, (LAS float*)(F.lds + 131072)};
                pg8::gemm_phase<EpiFinal>(F.lds, g, S, E, F.wave);
            } else {
                EpiRes E{(const h16*)(wsq + WS_X1), (h16*)(wsq + WS_X16), (float*)(wsq + WS_SSQ), (LAS float*)(F.lds + 131072)};
                pg8::gemm_phase<EpiRes>(F.lds, g, S, E, F.wave); SEAM(p + 6); } }
    }
    if (IN(N_PHASES - 1) && !(FUSE_FINAL && F.G == 256)) final_norm_phase(F, (const h16*)(args.ws + WS_X16), (const float*)(args.ws + WS_SSQ), args.out, I.final_norm);
#undef IN
#undef SEAM
}

extern "C" void kernel_launch(void* const* d_in, const int* in_sizes, int n_in, void* d_out, int out_size, void* d_ws, size_t ws_size, hipStream_t stream) {
    static int grid = 0;
    if (grid == 0) {
        if (n_in != 19 || out_size != M * DM || ws_size < WS_END) { fprintf(stderr, "kernel_launch: unexpected shapes (n_in %d out %d ws %zu)\n", n_in, out_size, ws_size); grid = -1; return; }
        int dev = 0, cus = 0, per_cu = 0;
        hipGetDevice(&dev); hipDeviceGetAttribute(&cus, hipDeviceAttributeMultiprocessorCount, dev);
        hipFuncSetAttribute((const void*)mk_fwd, hipFuncAttributeMaxDynamicSharedMemorySize, LDS_BYTES);
        hipOccupancyMaxActiveBlocksPerMultiprocessor(&per_cu, (const void*)mk_fwd, NTHREADS, LDS_BYTES);
        (void)hipGetLastError();
        if (per_cu < 1) fprintf(stderr, "kernel_launch: occupancy query reports %d blocks per CU\n", per_cu);
        grid = cus < 256 ? cus : 256;
        if (grid != 256) fprintf(stderr, "kernel_launch: %d CUs: this kernel's work split assumes 256 workgroups\n", cus);
    }
    if (grid < 0) return;
    hipMemsetAsync((char*)d_ws + WS_CTL, 0, CTL_ZERO_BYTES, stream);
    Args a{};
    const void** ip = (const void**)&a.in;
    for (int i = 0; i < 19; ++i) ip[i] = d_in[i];
    a.out = (float*)d_out; a.ws = (unsigned char*)d_ws;
#if MK_N_LAUNCHES == 1
    a.ph_lo = 0; a.ph_hi = N_PHASES;
    { void* kargs[] = {&a}; hipError_t e = hipLaunchCooperativeKernel((const void*)mk_fwd, dim3(grid), dim3(NTHREADS), kargs, LDS_BYTES, stream);
      if (e != hipSuccess) fprintf(stderr, "cooperative launch failed: %s (grid %d)\n", hipGetErrorString(e), grid); }
#else
    for (int p = 0; p < N_PHASES; ++p) { const int reps = ((PROBE_MASK >> p) & 1u) ? 2 : 1;
        for (int rr = 0; rr < reps; ++rr) { a.ph_lo = p; a.ph_hi = p + 1; a.flags = (rr > 0) ? 1 : 0; hipLaunchKernelGGL(mk_fwd, dim3(grid), dim3(NTHREADS), LDS_BYTES, stream, a); } }
#endif
}
```
